# Optimizing an MI355X kernel written in HIP

```python
import jax, jax.numpy as jnp
from jax import lax
import numpy as np

D_MODEL = 1024
BATCH = 4
SEQ = 4096
DEPTH = 4
DEC_BATCH = 128
DEC_SEQ = 4
PAST_LEN = 8192
PAGE_SIZE = 128

D_MIX = D_MODEL
D_CONV = D_MIX // 4
D_POOL = D_MIX // 4
D_ATTN = D_MIX - D_CONV - D_POOL
HEAD_DIM = 64
N_HEADS = D_ATTN // HEAD_DIM
N_KV_HEADS = 2
GROUP = N_HEADS // N_KV_HEADS
D_KV = N_KV_HEADS * HEAD_DIM
WINDOW = 128
BLOCK = 128
CONV_WIDTH = 31
CONV_BUF = CONV_WIDTH - 1
POOL_WINDOWS = (2, 4, 8, 16)
N_POOL_GROUPS = len(POOL_WINDOWS)
POOL_GROUP_DIM = D_POOL // N_POOL_GROUPS
POOL_BUF = max(POOL_WINDOWS) - 1
ROPE_THETA = 10000.0
LN_EPS = 1e-5
ALPHA = (2.0 * DEPTH) ** 0.25
BETA = (8.0 * DEPTH) ** -0.25
MASK_VALUE = -1e30
IN_SIZES = (D_CONV, D_CONV, D_CONV, D_POOL, D_POOL, D_ATTN, D_KV, D_KV, D_ATTN)
D_IN = sum(IN_SIZES)
IN_SPLITS = tuple(int(s) for s in np.cumsum(IN_SIZES)[:-1])

kernel_name = "hymba_conv_pool_swa_deepnorm_step"


def _layernorm(x, g=None, b=None):
    xf = x.astype(jnp.float32)
    mu = jnp.mean(xf, axis=-1, keepdims=True)
    var = jnp.mean(jnp.square(xf - mu), axis=-1, keepdims=True)
    y = (xf - mu) * lax.rsqrt(var + LN_EPS)
    if g is not None:
        y = y * g.astype(jnp.float32) + b.astype(jnp.float32)
    return y.astype(x.dtype)


def _rope(x, pos):
    half = HEAD_DIM // 2
    inv_freq = ROPE_THETA ** (-jnp.arange(half, dtype=jnp.float32) * (2.0 / HEAD_DIM))
    ang = pos.astype(jnp.float32)[:, None] * inv_freq[None, :]
    cos = jnp.concatenate([jnp.cos(ang), jnp.cos(ang)], -1)[None, :, None, :]
    sin = jnp.concatenate([jnp.sin(ang), jnp.sin(ang)], -1)[None, :, None, :]
    xf = x.astype(jnp.float32)
    rot = jnp.concatenate([-xf[..., half:], xf[..., :half]], -1)
    return (xf * cos + rot * sin).astype(x.dtype)


def _sink_attention(q, k, v, q_pos, k_pos, sinks):
    s = jnp.einsum('...qhgd,...khd->...hgqk', q, k).astype(jnp.float32) * (HEAD_DIM ** -0.5)
    kp = k_pos[..., None, :]
    qp = q_pos[..., :, None]
    mask = (kp <= qp) & (kp > qp - WINDOW) & (kp >= 0)
    s = jnp.where(mask[..., None, None, :, :], s, MASK_VALUE)
    sink = sinks.astype(jnp.float32).reshape(N_KV_HEADS, GROUP, 1)
    m = jnp.maximum(jnp.max(s, axis=-1), sink)
    p = jnp.exp(s - m[..., None])
    denom = jnp.sum(p, axis=-1) + jnp.exp(sink - m)
    probs = (p / denom[..., None]).astype(v.dtype)
    return jnp.einsum('...hgqk,...khd->...qhgd', probs, v)


def _causal_dwconv(buf, a, w, b):
    xcat = jnp.concatenate([buf, a], axis=1)
    out = lax.conv_general_dilated(
        xcat, w.astype(xcat.dtype)[:, None, :], window_strides=(1,), padding='VALID',
        dimension_numbers=('NWC', 'WIO', 'NWC'), feature_group_count=D_CONV)
    return out + b.astype(out.dtype), xcat[:, -CONV_BUF:]


def _pool_mix(buf, v, pos0, pool_w, pool_scale):
    B, T, _ = v.shape
    xcat = jnp.concatenate([buf, v], axis=1)
    cs = jnp.cumsum(xcat.astype(jnp.float32), axis=1)
    cs0 = jnp.concatenate([jnp.zeros((B, 1, D_POOL), jnp.float32), cs], axis=1)
    pos = (pos0 + jnp.arange(T)).astype(jnp.float32)
    end = cs0[:, POOL_BUF + 1:POOL_BUF + 1 + T]
    means = []
    for gi, w in enumerate(POOL_WINDOWS):
        sl = slice(gi * POOL_GROUP_DIM, (gi + 1) * POOL_GROUP_DIM)
        start = cs0[:, POOL_BUF + 1 - w:POOL_BUF + 1 - w + T, sl]
        cnt = jnp.minimum(jnp.float32(w), pos + 1.0)[None, :, None]
        means.append((end[..., sl] - start) / cnt)
    pooled = (jnp.concatenate(means, -1) - v.astype(jnp.float32)).astype(v.dtype)
    y = jnp.einsum('btgc,gcd->btgd', pooled.reshape(B, T, N_POOL_GROUPS, POOL_GROUP_DIM), pool_w)
    return y.reshape(B, T, D_POOL) * pool_scale, xcat[:, -POOL_BUF:]


def _layer(x, c, conv_buf, pool_buf, k_buf, v_buf, pos0,
           w_in, w_out, conv_w, conv_b, cnorm_g, cnorm_b, pool_w, pool_scale,
           sinks, w_mod, b_mod, ln_g, ln_b):
    B, T, _ = x.shape
    mod = jax.nn.silu(c) @ w_mod + b_mod
    shift, scale, gate = jnp.split(mod, 3, axis=-1)
    h = _layernorm(x) * (1.0 + scale[:, None]) + shift[:, None]
    proj = h @ w_in
    u, g, zc, pv, zp, q, k, v, za = jnp.split(proj, IN_SPLITS, axis=-1)

    a = u * jax.nn.sigmoid(g)
    conv, new_conv = _causal_dwconv(conv_buf, a, conv_w, conv_b)
    ya = jax.nn.silu(_layernorm(conv, cnorm_g, cnorm_b)) * jax.nn.silu(zc)

    pooled, new_pool = _pool_mix(pool_buf, pv, pos0, pool_w, pool_scale)
    yb = pooled * jax.nn.silu(zp)

    pos = pos0 + jnp.arange(T, dtype=jnp.int32)
    q = _rope(q.reshape(B, T, N_HEADS, HEAD_DIM), pos).reshape(B, T, N_KV_HEADS, GROUP, HEAD_DIM)
    k = _rope(k.reshape(B, T, N_KV_HEADS, HEAD_DIM), pos)
    v = v.reshape(B, T, N_KV_HEADS, HEAD_DIM)
    if k_buf is None:
        nb = T // BLOCK
        qb = q.reshape(B, nb, BLOCK, N_KV_HEADS, GROUP, HEAD_DIM)
        kb = k.reshape(B, nb, BLOCK, N_KV_HEADS, HEAD_DIM)
        vb = v.reshape(B, nb, BLOCK, N_KV_HEADS, HEAD_DIM)
        kk = jnp.concatenate([jnp.concatenate([jnp.zeros_like(kb[:, :1]), kb[:, :-1]], 1), kb], 2)
        vv = jnp.concatenate([jnp.concatenate([jnp.zeros_like(vb[:, :1]), vb[:, :-1]], 1), vb], 2)
        pos_b = pos.reshape(nb, BLOCK)
        kpos = jnp.concatenate([pos_b - BLOCK, pos_b], axis=1)
        o = _sink_attention(qb, kk, vv, pos_b, kpos, sinks)
        new_k, new_v = k[:, -WINDOW:], v[:, -WINDOW:]
    else:
        wb = k_buf.shape[1]
        kk = jnp.concatenate([k_buf, k], axis=1)
        vv = jnp.concatenate([v_buf, v], axis=1)
        kpos = pos0 - wb + jnp.arange(wb + T, dtype=jnp.int32)
        o = _sink_attention(q, kk, vv, pos, kpos, sinks)
        new_k, new_v = kk[:, -wb:], vv[:, -wb:]
    yc = o.reshape(B, T, D_ATTN) * jax.nn.silu(za)

    mix = jnp.concatenate([ya, yb, yc], axis=-1) @ w_out
    x = _layernorm(ALPHA * x + (1.0 + gate[:, None]) * mix, ln_g, ln_b)
    return x, new_conv, new_pool, new_k, new_v


def setup_inputs(seed: int = 0) -> dict:
    key = jax.random.key(seed)
    ks = jax.random.split(key, 24)
    f = jnp.float32
    wb = min(WINDOW, PAST_LEN)
    n = lambda i, shape, s=1.0: s * jax.random.normal(ks[i], shape, f)
    return {
        'x_prompt': n(0, (BATCH, SEQ, D_MODEL)),
        'x_sample': n(1, (DEC_BATCH, DEC_SEQ, D_MODEL)),
        'cache_conv': n(2, (DEPTH, DEC_BATCH, CONV_BUF, D_CONV), 0.5),
        'cache_pool': n(3, (DEPTH, DEC_BATCH, POOL_BUF, D_POOL)),
        'cache_k': n(4, (DEPTH, DEC_BATCH, wb, N_KV_HEADS, HEAD_DIM)),
        'cache_v': n(5, (DEPTH, DEC_BATCH, wb, N_KV_HEADS, HEAD_DIM)),
        'c_prompt': n(6, (BATCH, D_MODEL)),
        'c_sample': n(7, (DEC_BATCH, D_MODEL)),
        'w_in': n(8, (DEPTH, D_MODEL, D_IN), D_MODEL ** -0.5),
        'w_out': n(9, (DEPTH, D_MIX, D_MODEL), BETA * D_MIX ** -0.5),
        'conv_w': n(10, (DEPTH, CONV_WIDTH, D_CONV), CONV_WIDTH ** -0.5),
        'conv_b': n(11, (DEPTH, D_CONV), 0.02),
        'cnorm_g': 1.0 + n(12, (DEPTH, D_CONV), 0.02),
        'cnorm_b': n(13, (DEPTH, D_CONV), 0.02),
        'pool_w': n(14, (DEPTH, N_POOL_GROUPS, POOL_GROUP_DIM, POOL_GROUP_DIM), POOL_GROUP_DIM ** -0.5),
        'pool_scale': 1.0 + n(15, (DEPTH, D_POOL), 0.1),
        'sinks': n(16, (DEPTH, N_HEADS), 0.5),
        'w_mod': n(17, (DEPTH, D_MODEL, 3 * D_MODEL), 0.5 * D_MODEL ** -0.5),
        'b_mod': n(18, (DEPTH, 3 * D_MODEL), 0.02),
        'ln_g': 1.0 + n(19, (DEPTH, D_MODEL), 0.02),
        'ln_b': n(20, (DEPTH, D_MODEL), 0.02),
    }


def reference(x_prompt, x_sample, cache_conv, cache_pool, cache_k, cache_v, c_prompt, c_sample,
              w_in, w_out, conv_w, conv_b, cnorm_g, cnorm_b, pool_w, pool_scale, sinks,
              w_mod, b_mod, ln_g, ln_b):
    xp, xs = x_prompt, x_sample
    B = xp.shape[0]
    conv_p, pool_p, k_p, v_p = [], [], [], []
    conv_s, pool_s, k_s, v_s = [], [], [], []
    for l in range(DEPTH):
        params = (w_in[l], w_out[l], conv_w[l], conv_b[l], cnorm_g[l], cnorm_b[l],
                  pool_w[l], pool_scale[l], sinks[l], w_mod[l], b_mod[l], ln_g[l], ln_b[l])
        zc = jnp.zeros((B, CONV_BUF, D_CONV), xp.dtype)
        zp = jnp.zeros((B, POOL_BUF, D_POOL), xp.dtype)
        xp, cp, pp, kp, vp = _layer(xp, c_prompt, zc, zp, None, None, 0, *params)
        xs, cs, ps, ksn, vsn = _layer(xs, c_sample, cache_conv[l], cache_pool[l],
                                      cache_k[l], cache_v[l], PAST_LEN, *params)
        conv_p.append(cp); pool_p.append(pp); k_p.append(kp); v_p.append(vp)
        conv_s.append(cs); pool_s.append(ps); k_s.append(ksn); v_s.append(vsn)
    return (xp, xs,
            jnp.stack(conv_p), jnp.stack(pool_p), jnp.stack(k_p), jnp.stack(v_p),
            jnp.stack(conv_s), jnp.stack(pool_s), jnp.stack(k_s), jnp.stack(v_s))
```

```cpp
#include <hip/hip_runtime.h>
#include <cstdint>
#include <cstdio>
#include <cmath>

#define DBG_REPORT_ID -1
#ifndef MK_N_LAUNCHES
#define MK_N_LAUNCHES 1
#endif

#define DI __device__ __forceinline__
#define GAS __attribute__((address_space(1)))
#define LAS __attribute__((address_space(3)))
typedef unsigned short u16;
typedef _Float16 h8 __attribute__((ext_vector_type(8)));
typedef _Float16 h4 __attribute__((ext_vector_type(4)));
typedef _Float16 h2 __attribute__((ext_vector_type(2)));
typedef float f32x2 __attribute__((ext_vector_type(2)));
typedef float f32x4 __attribute__((ext_vector_type(4)));
typedef float f32x16 __attribute__((ext_vector_type(16)));
typedef unsigned u32x4 __attribute__((ext_vector_type(4)));
typedef unsigned u32x2 __attribute__((ext_vector_type(2)));
typedef short v4i16_t __attribute__((ext_vector_type(4)));

constexpr int D = 1024, DIN = 2560, NB = 4, SEQ = 4096, DEPTH = 4, DB = 128, DS = 4;
constexpr int MP = NB * SEQ, MS = DB * DS, M = MP + MS;
constexpr int NMOD = NB + DB;
constexpr int PAST = 8192;
constexpr float LN_EPS = 1e-5f;
constexpr float ALPHA = 1.681792830507429f;
constexpr float LOG2E = 1.4426950408889634f;
constexpr float QSCALE = 0.125f * LOG2E;
constexpr size_t OFF_YP = 0, OFF_YS = OFF_YP + (size_t)MP * D, OFF_CONVP = OFF_YS + (size_t)MS * D, OFF_POOLP = OFF_CONVP + (size_t)DEPTH * NB * 30 * 256,
                 OFF_KP = OFF_POOLP + (size_t)DEPTH * NB * 15 * 256, OFF_VP = OFF_KP + (size_t)DEPTH * NB * 128 * 128, OFF_CONVS = OFF_VP + (size_t)DEPTH * NB * 128 * 128,
                 OFF_POOLS = OFF_CONVS + (size_t)DEPTH * DB * 30 * 256, OFF_KS = OFF_POOLS + (size_t)DEPTH * DB * 15 * 256, OFF_VS = OFF_KS + (size_t)DEPTH * DB * 128 * 128,
                 OUT_TOTAL = OFF_VS + (size_t)DEPTH * DB * 128 * 128;
constexpr size_t MiB = 1u << 20;
constexpr size_t WS_CTL = 0, CTL_ZERO_BYTES = 64 * 1024;
constexpr size_t WS_WIN = 1 * MiB;
constexpr size_t WS_WOUT = 21 * MiB;
constexpr size_t WS_MOD = 29 * MiB;
constexpr size_t WS_TAB = 36 * MiB;
constexpr size_t WS_ZH = 38 * MiB;
constexpr size_t WS_XR = 71 * MiB;
constexpr size_t WS_MIX = 104 * MiB;
constexpr size_t WS_PA = 137 * MiB;
constexpr size_t WS_PSZC = WS_PA + (size_t)M * 256 * 2, WS_PPV = WS_PSZC + (size_t)M * 256 * 2, WS_PSZP = WS_PPV + (size_t)M * 256 * 2;
constexpr size_t WS_PQ = WS_PSZP + (size_t)M * 256 * 2;
constexpr size_t WS_PSZA = WS_PQ + (size_t)M * 512 * 2;
constexpr size_t WS_PK = WS_PSZA + (size_t)M * 512 * 2;
constexpr size_t WS_PV = WS_PK + (size_t)M * 128 * 2;
constexpr size_t WS_END = WS_PV + (size_t)M * 128 * 2;
static_assert(WS_END <= 256 * MiB, "d_ws map");
constexpr int CW_BAR = 1024;

DI unsigned pkh(float a, float b) { f32x2 v = {a, b}; h2 r = __builtin_convertvector(v, h2); return __builtin_bit_cast(unsigned, r); }
DI u32x4 pack8(const float* v) { u32x4 w; w.x = pkh(v[0], v[1]); w.y = pkh(v[2], v[3]); w.z = pkh(v[4], v[5]); w.w = pkh(v[6], v[7]); return w; }
DI void unpack8(u32x4 w, float* o) {
    const h8 v = __builtin_bit_cast(h8, w);
#pragma unroll
    for (int j = 0; j < 8; ++j) o[j] = (float)v[j];
}
DI float ex2(float x) { return __builtin_amdgcn_exp2f(x); }
DI float sigm(float x) { return __builtin_amdgcn_rcpf(1.f + ex2(-x * LOG2E)); }
DI float silu(float x) { return x * sigm(x); }
DI float wave_sum(float v) {
#pragma unroll
    for (int o = 1; o < 64; o <<= 1) v += __shfl_xor(v, o);
    return v;
}
DI float wave_max(float v) {
#pragma unroll
    for (int o = 1; o < 64; o <<= 1) v = fmaxf(v, __shfl_xor(v, o));
    return v;
}
DI int crow(int r, int hi) { return (r & 3) + 8 * (r >> 2) + 4 * hi; }

__host__ __device__ __forceinline__ int pperm(int bj, int c7) { return 128 * bj + 32 * (c7 >> 5) + 16 * ((c7 >> 2) & 1) + 4 * ((c7 >> 3) & 3) + (c7 & 3); }
__host__ __device__ __forceinline__ int perm_in(int col) {
    if (col < 512) { const int bj = col >> 8, ch = col & 255; return 256 * (ch >> 7) + pperm(bj, ch & 127); }
    if (col < 1280) { const int base = col < 768 ? 512 : (col < 1024 ? 768 : 1024); const int x = col - base; return base + pperm(x >> 7, x & 127); }
    if (col < 1792) { const int x = col - 1280, head = x >> 6, d = x & 63; return 256 * (5 + (head >> 2)) + pperm(d >> 5, 32 * (head & 3) + (d & 31)); }
    if (col < 2048) { const int x = col - 1792, hh = x >> 6, d = x & 63; return 1792 + pperm(d >> 5, 32 * hh + (d & 31)); }
    { const int x = col - 2048; return 2048 + 256 * (x >> 8) + pperm((x >> 7) & 1, x & 127); }
}
__host__ __device__ __forceinline__ int perm_out(int col) { const int y = col & 255; return (col & ~255) + pperm(y >> 7, y & 127); }

namespace pg8 {
constexpr int BM = 256, BK = 64, HALF = 128, HTB = HALF * BK * 2, STAGE_BYTES = 8 * HTB, NXCD = 8, WGM = 8;
__host__ __device__ __forceinline__ int lds_byte(int r, int c) { const int st = (r >> 4) * 2 + (c >> 5), rr = r & 15, cc = c & 31, ob = rr * 64 + cc * 2; return st * 1024 + (ob ^ (((ob >> 9) & 1) << 5)); }
__host__ __device__ __forceinline__ void stage_rc(int b, int& R, int& C) { const int st = b / 1024, sb = b % 1024, swz = sb ^ (((sb >> 9) & 1) << 5); R = (st >> 1) * 16 + swz / 64; C = (st & 1) * 32 + (swz % 64) / 2; }
struct Unit { int pm, pn; };
struct Gemm { const u16* A; const u16* Bt; int M, N, K; };
struct StaticOrder {
    int nM, nN, nwg, G, c;
    __host__ __device__ void init(int M_, int N_, int G_, int c_) { nM = M_ / BM; nN = N_ / BM; nwg = nM * nN; G = G_; c = c_; }
    __host__ __device__ bool next(int i, Unit& u) const {
        const long L = (long)i * G + c; if (L >= nwg) return false;
        int wgid = (int)L; { const int q = nwg / NXCD, r = nwg % NXCD, xcd = wgid % NXCD, off = wgid / NXCD; wgid = (xcd < r ? xcd * (q + 1) : r * (q + 1) + (xcd - r) * q) + off; }
        const int nig = WGM * nN, gid = wgid / nig, fm = gid * WGM, gsz = (nM - fm) < WGM ? (nM - fm) : WGM;
        u.pm = fm + ((wgid % nig) % gsz); u.pn = (wgid % nig) / gsz; return true;
    }
};

template <class Epi, bool ALIGN_EPI>
DI void gemm_phase(LAS unsigned char* lds, const Gemm g, const StaticOrder& S, const Epi& E, const int tid) {
    const int wid = __builtin_amdgcn_readfirstlane(tid >> 6), lane = tid & 63, wr = wid >> 2, wc = wid & 3, fr = lane & 15, fq = lane >> 4;
    const int K = g.K, nt = K / BK;
    unsigned voffA[2];
#pragma unroll
    for (int i = 0; i < 2; ++i) { int R, C; stage_rc(tid * 16 + i * 8192, R, C); voffA[i] = (unsigned)(R * K + C) * 2u; }
    const size_t kstep = (size_t)(BK * 2);
    const size_t hstep = (size_t)HALF * K * 2;
    const size_t tstep = 2 * hstep;
    const unsigned ldsw = (unsigned)wid * 1024u;
    const int aoff = lds_byte(wr * 64 + fr, fq * 8), boff = lds_byte(wc * 32 + fr, fq * 8);
#define PG8_SA(b, h) (((b) * 2 + (h)) * HTB)
#define PG8_SB(b, h) ((4 + (b) * 2 + (h)) * HTB)
#define PG8_STAGE(bufoff, gbase) do { _Pragma("unroll") for (int _i = 0; _i < 2; ++_i) \
        __builtin_amdgcn_global_load_lds((const unsigned*)((const char*)(gbase) + voffA[_i]), (LAS unsigned*)(lds + (bufoff) + ldsw + _i * 8192), 16, 0, 0); } while (0)
#define PG8_LDA(dst, b, h) do { _Pragma("unroll") for (int m = 0; m < 4; ++m) _Pragma("unroll") for (int k = 0; k < 2; ++k) dst[m][k] = *(const LAS h8*)(lds + PG8_SA(b, h) + aoff + m * 2048 + k * 1024); } while (0)
#define PG8_LDB(dst, b, h) do { _Pragma("unroll") for (int n = 0; n < 2; ++n) _Pragma("unroll") for (int k = 0; k < 2; ++k) dst[n][k] = *(const LAS h8*)(lds + PG8_SB(b, h) + boff + n * 2048 + k * 1024); } while (0)
#define PG8_MMA(ai, bj, At, Bt) do { __builtin_amdgcn_s_setprio(1); _Pragma("unroll") for (int m = 0; m < 4; ++m) _Pragma("unroll") for (int n = 0; n < 2; ++n) _Pragma("unroll") for (int k = 0; k < 2; ++k) \
        acc[ai][bj][m][n] = __builtin_amdgcn_mfma_f32_16x16x32_f16(Bt[n][k], At[m][k], acc[ai][bj][m][n], 0, 0, 0); __builtin_amdgcn_s_setprio(0); } while (0)
#define PG8_WAIT_V(n) asm volatile("s_waitcnt vmcnt(" #n ")" ::: "memory")
#define PG8_WAIT_L(n) asm volatile("s_waitcnt lgkmcnt(" #n ")" ::: "memory")
#define PG8_BAR __builtin_amdgcn_s_barrier()
#define PG8_SCHED __builtin_amdgcn_sched_barrier(0)
    Unit cur, nxt; int ui = 0;
    if (!S.next(0, cur)) return;
    f32x4 acc[2][2][4][2];
#pragma unroll
    for (int a = 0; a < 2; ++a)
#pragma unroll
        for (int b = 0; b < 2; ++b)
#pragma unroll
            for (int m = 0; m < 4; ++m)
#pragma unroll
                for (int n = 0; n < 2; ++n) acc[a][b][m][n] = (f32x4){0.f, 0.f, 0.f, 0.f};
    h8 At[4][2], B0[2][2], B1[2][2];
    const char* cA = (const char*)g.A + (size_t)cur.pm * tstep; const char* cB = (const char*)g.Bt + (size_t)cur.pn * tstep;
    PG8_STAGE(PG8_SB(0, 0), cB); PG8_STAGE(PG8_SB(0, 1), cB + hstep); PG8_STAGE(PG8_SA(0, 0), cA); PG8_STAGE(PG8_SA(0, 1), cA + hstep);
    if (wr == 1) PG8_BAR;
    PG8_WAIT_V(2); PG8_BAR;
    PG8_STAGE(PG8_SB(1, 0), cB + kstep); PG8_STAGE(PG8_SA(1, 0), cA + kstep); PG8_STAGE(PG8_SB(1, 1), cB + hstep + kstep);
    PG8_WAIT_V(6); PG8_BAR;
    for (;;) {
        const bool has_next = S.next(ui + 1, nxt);
        const char* nA = has_next ? (const char*)g.A + (size_t)nxt.pm * tstep : cA; const char* nB = has_next ? (const char*)g.Bt + (size_t)nxt.pn * tstep : cB;
        for (int t = 0; t < nt; t += 2) {
            const bool last = (t == nt - 2);
            const char* a1 = cA + (size_t)(t + 1) * kstep;
            const char* a2 = last ? nA : cA + (size_t)(t + 2) * kstep; const char* b2 = last ? nB : cB + (size_t)(t + 2) * kstep;
            const char* a3 = a2 + kstep; const char* b3 = b2 + kstep;
            PG8_LDB(B0, 0, 0); PG8_LDB(B1, 0, 1); PG8_SCHED; PG8_LDA(At, 0, 0); PG8_STAGE(PG8_SA(1, 1), a1 + hstep);
            PG8_WAIT_V(8); PG8_WAIT_L(0); PG8_BAR; PG8_MMA(0, 0, At, B0); PG8_MMA(0, 1, At, B1); PG8_BAR; PG8_SCHED;
            PG8_LDA(At, 0, 1); PG8_STAGE(PG8_SB(0, 0), b2); PG8_STAGE(PG8_SB(0, 1), b2 + hstep); PG8_STAGE(PG8_SA(0, 0), a2);
            PG8_WAIT_V(8); PG8_WAIT_L(0); PG8_BAR; PG8_MMA(1, 0, At, B0); PG8_MMA(1, 1, At, B1); PG8_BAR; PG8_SCHED;
            PG8_LDB(B0, 1, 0); PG8_LDB(B1, 1, 1); PG8_SCHED; PG8_LDA(At, 1, 0); PG8_STAGE(PG8_SA(0, 1), a2 + hstep);
            PG8_WAIT_V(8); PG8_WAIT_L(0); PG8_BAR; PG8_MMA(0, 0, At, B0); PG8_MMA(0, 1, At, B1); PG8_BAR; PG8_SCHED;
            PG8_LDA(At, 1, 1); PG8_STAGE(PG8_SB(1, 0), b3); PG8_STAGE(PG8_SB(1, 1), b3 + hstep); PG8_STAGE(PG8_SA(1, 0), a3);
            PG8_WAIT_V(8); PG8_WAIT_L(0); PG8_BAR; PG8_MMA(1, 0, At, B0); PG8_MMA(1, 1, At, B1); PG8_BAR; PG8_SCHED;
        }
        if constexpr (ALIGN_EPI) { if (wr == 0) PG8_BAR; }
        E(acc, cur, wr, wc, fr, fq);
        if (!has_next) break;
#pragma unroll
        for (int a = 0; a < 2; ++a)
#pragma unroll
            for (int b = 0; b < 2; ++b)
#pragma unroll
                for (int m = 0; m < 4; ++m)
#pragma unroll
                    for (int n = 0; n < 2; ++n) acc[a][b][m][n] = (f32x4){0.f, 0.f, 0.f, 0.f};
        cur = nxt; cA = nA; cB = nB; ++ui;
        if constexpr (ALIGN_EPI) { if (wr == 1) PG8_BAR; }
    }
    PG8_WAIT_V(0);
    if constexpr (!ALIGN_EPI) { if (wr == 0) PG8_BAR; }
    PG8_BAR;
#undef PG8_SA
#undef PG8_SB
#undef PG8_STAGE
#undef PG8_LDA
#undef PG8_LDB
#undef PG8_MMA
#undef PG8_WAIT_V
#undef PG8_WAIT_L
#undef PG8_BAR
#undef PG8_SCHED
}
}

struct Params {
    const float* x_prompt; const float* x_sample; const float* cache_conv; const float* cache_pool; const float* cache_k; const float* cache_v;
    const float* c_prompt; const float* c_sample; const float* w_in; const float* w_out; const float* conv_w; const float* conv_b; const float* cnorm_g; const float* cnorm_b;
    const float* pool_w; const float* pool_scale; const float* sinks; const float* w_mod; const float* b_mod; const float* ln_g; const float* ln_b;
    float* out; unsigned char* ws;
    int ph_lo, ph_hi;
    float inv_freq[32];
};
struct ParamsHead { const float* ptrs[21]; float* out; unsigned char* ws; int ph_lo, ph_hi; };

DI void row_info(int row, bool& smp, int& b, int& t) { smp = row >= MP; if (!smp) { b = row >> 12; t = row & (SEQ - 1); } else { const int s = row - MP; b = s >> 2; t = s & 3; } }
DI void st8f(float* dst, const float* v) { *(f32x4*)dst = (f32x4){v[0], v[1], v[2], v[3]}; *(f32x4*)(dst + 4) = (f32x4){v[4], v[5], v[6], v[7]}; }

struct EpiIn {
    int l; unsigned char* ws; float* out;
    DI void operator()(const f32x4 (&acc)[2][2][4][2], const pg8::Unit& u, int wr, int wc, int fr, int fq) const {
        asm volatile("" : "+v"(fr), "+v"(fq));
        const int pn = u.pn;
        u16* const PA = (u16*)(ws + WS_PA); u16* const PSZC = (u16*)(ws + WS_PSZC); u16* const PPV = (u16*)(ws + WS_PPV); u16* const PSZP = (u16*)(ws + WS_PSZP);
        u16* const PQ = (u16*)(ws + WS_PQ); u16* const PSZA = (u16*)(ws + WS_PSZA); u16* const PK = (u16*)(ws + WS_PK); u16* const PV = (u16*)(ws + WS_PV); const f32x2* const tab = (const f32x2*)(ws + WS_TAB);
#pragma unroll
        for (int ai = 0; ai < 2; ++ai)
#pragma unroll
            for (int m = 0; m < 4; ++m) {
                const int row = u.pm * 256 + ai * 128 + wr * 64 + m * 16 + fr;
                bool smp; int b, t; row_info(row, smp, b, t);
                if (pn < 2) {
                    const int c8 = pn * 128 + wc * 32 + fq * 8; float a[8];
#pragma unroll
                    for (int n = 0; n < 2; ++n)
#pragma unroll
                        for (int j = 0; j < 4; ++j) a[4 * n + j] = acc[ai][0][m][n][j] * sigm(acc[ai][1][m][n][j]);
                    *(u32x4*)(PA + (size_t)row * 256 + c8) = pack8(a);
                    if (smp) st8f(out + OFF_CONVS + ((size_t)(l * DB + b) * 30 + 26 + t) * 256 + c8, a);
                    else if (t >= SEQ - 30) st8f(out + OFF_CONVP + ((size_t)(l * NB + b) * 30 + (t - (SEQ - 30))) * 256 + c8, a);
                } else if (pn == 2 || pn == 4) {
                    u16* P = pn == 2 ? PSZC : PSZP;
#pragma unroll
                    for (int bj = 0; bj < 2; ++bj) { const int c8 = bj * 128 + wc * 32 + fq * 8; float v[8];
#pragma unroll
                        for (int n = 0; n < 2; ++n)
#pragma unroll
                            for (int j = 0; j < 4; ++j) v[4 * n + j] = silu(acc[ai][bj][m][n][j]);
                        *(u32x4*)(P + (size_t)row * 256 + c8) = pack8(v); }
                } else if (pn == 3) {
#pragma unroll
                    for (int bj = 0; bj < 2; ++bj) { const int c8 = bj * 128 + wc * 32 + fq * 8; float v[8];
#pragma unroll
                        for (int n = 0; n < 2; ++n)
#pragma unroll
                            for (int j = 0; j < 4; ++j) v[4 * n + j] = acc[ai][bj][m][n][j];
                        *(u32x4*)(PPV + (size_t)row * 256 + c8) = pack8(v);
                        if (smp) st8f(out + OFF_POOLS + ((size_t)(l * DB + b) * 15 + 11 + t) * 256 + c8, v);
                        else if (t >= SEQ - 15) st8f(out + OFF_POOLP + ((size_t)(l * NB + b) * 15 + (t - (SEQ - 15))) * 256 + c8, v); }
                } else if (pn >= 8) {
#pragma unroll
                    for (int bj = 0; bj < 2; ++bj) { const int c8 = (pn - 8) * 256 + bj * 128 + wc * 32 + fq * 8; float v[8];
#pragma unroll
                        for (int n = 0; n < 2; ++n)
#pragma unroll
                            for (int j = 0; j < 4; ++j) v[4 * n + j] = silu(acc[ai][bj][m][n][j]);
                        *(u32x4*)(PSZA + (size_t)row * 512 + c8) = pack8(v); }
                } else if (pn == 7 && wc >= 2) {
                    const int hv = wc - 2;
#pragma unroll
                    for (int bj = 0; bj < 2; ++bj) { const int d8 = 32 * bj + 8 * fq; float v[8];
#pragma unroll
                        for (int n = 0; n < 2; ++n)
#pragma unroll
                            for (int j = 0; j < 4; ++j) v[4 * n + j] = acc[ai][bj][m][n][j];
                        *(u32x4*)(PV + (size_t)row * 128 + hv * 64 + d8) = pack8(v);
                        if (smp) st8f(out + OFF_VS + (((size_t)(l * DB + b) * 128 + 124 + t) * 2 + hv) * 64 + d8, v);
                        else if (t >= SEQ - 128) st8f(out + OFF_VP + (((size_t)(l * NB + b) * 128 + (t - (SEQ - 128))) * 2 + hv) * 64 + d8, v); }
                } else {
                    const int d8 = 8 * fq; const int pidx = smp ? SEQ + t : t;
                    const f32x4* tp = (const f32x4*)(tab + (size_t)pidx * 32 + d8);
                    float x1[8], x2[8], o1[8], o2[8];
#pragma unroll
                    for (int n = 0; n < 2; ++n)
#pragma unroll
                        for (int j = 0; j < 4; ++j) { x1[4 * n + j] = acc[ai][0][m][n][j]; x2[4 * n + j] = acc[ai][1][m][n][j]; }
                    const float sc = pn == 7 ? 1.f : QSCALE;
#pragma unroll
                    for (int k2 = 0; k2 < 4; ++k2) { const f32x4 cs = tp[k2];
                        o1[2 * k2] = (x1[2 * k2] * cs[0] - x2[2 * k2] * cs[1]) * sc;         o2[2 * k2] = (x2[2 * k2] * cs[0] + x1[2 * k2] * cs[1]) * sc;
                        o1[2 * k2 + 1] = (x1[2 * k2 + 1] * cs[2] - x2[2 * k2 + 1] * cs[3]) * sc; o2[2 * k2 + 1] = (x2[2 * k2 + 1] * cs[2] + x1[2 * k2 + 1] * cs[3]) * sc; }
                    if (pn == 7) { const int hk = wc;
                        *(u32x4*)(PK + (size_t)row * 128 + hk * 64 + d8) = pack8(o1); *(u32x4*)(PK + (size_t)row * 128 + hk * 64 + 32 + d8) = pack8(o2);
                        float* dst = nullptr;
                        if (smp) dst = out + OFF_KS + (((size_t)(l * DB + b) * 128 + 124 + t) * 2 + hk) * 64 + d8;
                        else if (t >= SEQ - 128) dst = out + OFF_KP + (((size_t)(l * NB + b) * 128 + (t - (SEQ - 128))) * 2 + hk) * 64 + d8;
                        if (dst) { st8f(dst, o1); st8f(dst + 32, o2); }
                    } else { const int head = (pn - 5) * 4 + wc;
                        *(u32x4*)(PQ + (size_t)row * 512 + head * 64 + d8) = pack8(o1); *(u32x4*)(PQ + (size_t)row * 512 + head * 64 + 32 + d8) = pack8(o2); }
                }
            }
    }
};

struct EpiOut {
    unsigned char* ws; int l;
    DI void operator()(const f32x4 (&acc)[2][2][4][2], const pg8::Unit& u, int wr, int wc, int fr, int fq) const {
        asm volatile("" : "+v"(fr), "+v"(fq));
        const u16* const XR = (const u16*)(ws + WS_XR); u16* const ZH = (u16*)(ws + WS_ZH); const float* const modl = (const float*)(ws + WS_MOD) + (size_t)l * NMOD * 3072;
#pragma unroll
        for (int ai = 0; ai < 2; ++ai)
#pragma unroll
            for (int m = 0; m < 4; ++m) {
                const int row = u.pm * 256 + ai * 128 + wr * 64 + m * 16 + fr;
                const int bidx = row < MP ? (row >> 12) : NB + ((row - MP) >> 2);
                const float* gate = modl + (size_t)bidx * 3072 + 2048;
#pragma unroll
                for (int bj = 0; bj < 2; ++bj) { const int c8 = u.pn * 256 + bj * 128 + wc * 32 + fq * 8;
                    float xr[8], z[8]; unpack8(*(const u32x4*)(XR + (size_t)row * D + c8), xr);
                    const f32x4 g0 = *(const f32x4*)(gate + c8), g1 = *(const f32x4*)(gate + c8 + 4);
#pragma unroll
                    for (int j = 0; j < 4; ++j) { z[j] = ALPHA * xr[j] + (1.f + g0[j]) * acc[ai][bj][m][0][j]; z[4 + j] = ALPHA * xr[4 + j] + (1.f + g1[j]) * acc[ai][bj][m][1][j]; }
                    *(u32x4*)(ZH + (size_t)row * D + c8) = pack8(z); }
            }
    }
};

#define XB_TMO      128
#define XB_XCNT(j)  (256  + 64 * (j))
#define XB_XSUB(j)  (1280 + 64 * (j))
#define XB_XGEN(j)  (2304 + 64 * (j))
#define XB_TOP      3328
#define XB_TOPGEN   3392
#define XCD_BAR_WORDS 3456
#define XB_SPIN_CAP (1u << 18)
DI unsigned xb_ld(unsigned* p)              { return __hip_atomic_load(p, __ATOMIC_RELAXED, __HIP_MEMORY_SCOPE_AGENT); }
DI unsigned xb_add(unsigned* p, unsigned v) { return __hip_atomic_fetch_add(p, v, __ATOMIC_RELAXED, __HIP_MEMORY_SCOPE_AGENT); }
DI unsigned xb_xcc_id() { return (unsigned)__builtin_amdgcn_s_getreg((3 << 11) | 20) & 0xFu; }
#define XB_SPIN(cond, bar) do { unsigned _sp = 0; while (cond) { __builtin_amdgcn_s_sleep(1); \
    if ((++_sp & 255u) == 0u) { if (xb_ld(&(bar)[XB_TMO])) break; if (_sp > XB_SPIN_CAP) { atomicAdd(&(bar)[XB_TMO], 1u); break; } } } } while (0)
struct XcdBarrier { unsigned* bar; unsigned x; volatile LAS unsigned* st; };
DI XcdBarrier xcd_barrier_post(unsigned* bar, volatile LAS unsigned* st) {
    XcdBarrier b; b.bar = bar; b.x = xb_xcc_id(); b.st = st;
    if (threadIdx.x == 0) (void)xb_add(&bar[XB_XCNT(b.x)], 1u);
    return b;
}
DI void xcd_barrier_complete(unsigned* bar, unsigned x, unsigned& nloc, unsigned& nx) {
    const unsigned G = gridDim.x * gridDim.y * gridDim.z;
    unsigned sum, cnt, mine, sp = 0u;
    for (;;) {
        sum = 0u; cnt = 0u; mine = 0u;
#pragma unroll
        for (unsigned j = 0; j < 16; ++j) { const unsigned c = xb_ld(&bar[XB_XCNT(j)]); sum += c; cnt += (c > 0u) ? 1u : 0u; mine = (j == x) ? c : mine; }
        if (sum == G) break;
        __builtin_amdgcn_s_sleep(1);
        if ((++sp & 255u) == 0u) { if (xb_ld(&bar[XB_TMO])) break; if (sp > XB_SPIN_CAP) { atomicAdd(&bar[XB_TMO], 1u); break; } }
    }
    nloc = mine > 0u ? mine : 1u; nx = cnt > 0u ? cnt : 1u;
}
DI void xcd_barrier(const XcdBarrier& b) {
    asm volatile("s_waitcnt vmcnt(0)" ::: "memory");
    __syncthreads();
    if (threadIdx.x == 0) {
        unsigned* bar = b.bar;
        __builtin_amdgcn_s_waitcnt(0);
        unsigned nloc = b.st[0], nx = b.st[1];
        if (nloc == 0u) { xcd_barrier_complete(bar, b.x, nloc, nx); b.st[0] = nloc; b.st[1] = nx; }
        const unsigned old = xb_add(&bar[XB_XSUB(b.x)], 1u);
        const unsigned gen = old / nloc;
        if (old + 1u == (gen + 1u) * nloc) {
            __builtin_amdgcn_fence(__ATOMIC_RELEASE, "agent");
            asm volatile("s_waitcnt vmcnt(0)" ::: "memory");
            const unsigned og = xb_add(&bar[XB_TOP], 1u);
            const unsigned tg = og / nx;
            if (og + 1u == (tg + 1u) * nx) xb_add(&bar[XB_TOPGEN], 1u);
            else XB_SPIN(xb_ld(&bar[XB_TOPGEN]) == tg, bar);
            __builtin_amdgcn_fence(__ATOMIC_ACQUIRE, "agent");
            xb_add(&bar[XB_XGEN(b.x)], 1u);
            asm volatile("s_waitcnt vmcnt(0)" ::: "memory");
        } else {
            XB_SPIN(xb_ld(&bar[XB_XGEN(b.x)]) == gen, bar);
            __builtin_amdgcn_fence(__ATOMIC_ACQUIRE, "agent");
            asm volatile("s_waitcnt vmcnt(0)" ::: "memory");
        }
    }
    __syncthreads();
}

constexpr int NWAVES = 8, NTHR = 512;
constexpr int LDS_BYTES = 147456;
constexpr int RING_BYTES = 131072, MISC_OFF = RING_BYTES + 320;

DI void p0_transpose_item(const float* W, int K, int N, u16* WT, LAS float* scr, int item, int lane, bool isin) {
    const int nblk = N / 32, kb = item / nblk, nb = item % nblk, k0 = 64 * kb, n0 = 32 * nb;
#pragma unroll 8
    for (int i = 0; i < 32; ++i) { const int kk = 2 * i + (lane >> 5); scr[kk * 33 + (lane & 31)] = W[(size_t)(k0 + kk) * N + n0 + (lane & 31)]; }
    asm volatile("s_waitcnt lgkmcnt(0)" ::: "memory");
    const int c = lane & 7;
#pragma unroll
    for (int j = 0; j < 4; ++j) { const int n = (lane >> 3) + 8 * j; const LAS float* s = scr + (8 * c) * 33 + n;
        u32x4 o; o.x = pkh(s[0 * 33], s[1 * 33]); o.y = pkh(s[2 * 33], s[3 * 33]); o.z = pkh(s[4 * 33], s[5 * 33]); o.w = pkh(s[6 * 33], s[7 * 33]);
        const int dst = isin ? perm_in(n0 + n) : perm_out(n0 + n);
        *(u32x4*)(WT + (size_t)dst * K + k0 + 8 * c) = o; }
    asm volatile("s_waitcnt lgkmcnt(0)" ::: "memory");
}
DI void mod_unit(const Params& p, LAS unsigned char* lds, int unit, int tid, int lane, int wave) {
    const int l = unit >> 6, n0 = (unit & 63) * 48;
    const float* W = p.w_mod + (size_t)l * D * 3072;
    float* MOD = (float*)(p.ws + WS_MOD);
    const int fr = lane & 15, fq = lane >> 4;
    f32x4 acc[9][3];
#pragma unroll
    for (int rt = 0; rt < 9; ++rt)
#pragma unroll
        for (int ct = 0; ct < 3; ++ct) acc[rt][ct] = (f32x4){0.f, 0.f, 0.f, 0.f};
    for (int ks = 0; ks < 4; ++ks) {
        const int k0 = wave * 128 + ks * 32 + fq * 8;
        h8 bfr[3];
#pragma unroll
        for (int ct = 0; ct < 3; ++ct) { const float* wp = W + (size_t)k0 * 3072 + n0 + 16 * ct + fr;
#pragma unroll
            for (int j = 0; j < 8; ++j) bfr[ct][j] = (_Float16)wp[(size_t)j * 3072]; }
#pragma unroll
        for (int rt = 0; rt < 9; ++rt) { const int row = 16 * rt + fr; h8 a;
            if (row < NMOD) { const float* c = row < NB ? p.c_prompt + (size_t)row * D : p.c_sample + (size_t)(row - NB) * D;
                const f32x4 c0 = *(const f32x4*)(c + k0), c1 = *(const f32x4*)(c + k0 + 4);
#pragma unroll
                for (int j = 0; j < 4; ++j) { a[j] = (_Float16)silu(c0[j]); a[4 + j] = (_Float16)silu(c1[j]); } }
            else {
#pragma unroll
                for (int j = 0; j < 8; ++j) a[j] = (_Float16)0.f; }
#pragma unroll
            for (int ct = 0; ct < 3; ++ct) acc[rt][ct] = __builtin_amdgcn_mfma_f32_16x16x32_f16(a, bfr[ct], acc[rt][ct], 0, 0, 0); }
    }
    LAS float* part = (LAS float*)lds;
#pragma unroll
    for (int rg = 0; rg < 3; ++rg) {
        __syncthreads();
#pragma unroll
        for (int r3 = 0; r3 < 3; ++r3)
#pragma unroll
            for (int ct = 0; ct < 3; ++ct)
#pragma unroll
                for (int i = 0; i < 4; ++i) part[(wave * 48 + r3 * 16 + 4 * fq + i) * 48 + 16 * ct + fr] = acc[rg * 3 + r3][ct][i];
        __syncthreads();
        for (int o = tid; o < 48 * 48; o += NTHR) { const int r48 = o / 48, col = o % 48, row = 48 * rg + r48; float sacc = 0.f;
#pragma unroll
            for (int w = 0; w < 8; ++w) sacc += part[(w * 48 + r48) * 48 + col];
            if (row < NMOD) MOD[((size_t)l * NMOD + row) * 3072 + n0 + col] = sacc + p.b_mod[(size_t)l * 3072 + n0 + col]; }
    }
    __syncthreads();
}
DI void sincos_d(double a, float& c, float& s) {
    const double k = __builtin_rint(a * 0.63661977236758134308);
    const double r = __builtin_fma(-k, 1.2246467991473532e-16 * 0.5, __builtin_fma(-k, 1.5707963267948966, a));
    const double r2 = r * r;
    double sp = -1.0 / 6227020800.0; sp = sp * r2 + 1.0 / 39916800.0; sp = sp * r2 - 1.0 / 362880.0; sp = sp * r2 + 1.0 / 5040.0; sp = sp * r2 - 1.0 / 120.0; sp = sp * r2 + 1.0 / 6.0;
    const double sn = r - r * r2 * sp;
    double cp = 1.0 / 87178291200.0; cp = cp * r2 - 1.0 / 479001600.0; cp = cp * r2 + 1.0 / 3628800.0; cp = cp * r2 - 1.0 / 40320.0; cp = cp * r2 + 1.0 / 720.0; cp = cp * r2 - 1.0 / 24.0; cp = cp * r2 + 0.5;
    const double cn = 1.0 - r2 * cp;
    const long long q = (long long)k & 3;
    const double cc = (q == 0) ? cn : (q == 1) ? -sn : (q == 2) ? -cn : sn;
    const double ss = (q == 0) ? sn : (q == 1) ? cn : (q == 2) ? -sn : -cn;
    c = (float)cc; s = (float)ss;
}
DI void p0_prologue(const Params& p, const __attribute__((address_space(4))) float* invf, LAS unsigned char* lds, int vcu, int G, int tid, int lane, int wave) {
    for (int u = vcu; u < 256; u += G) mod_unit(p, lds, u, tid, lane, wave);
    LAS float* scr = (LAS float*)(lds + wave * 16384);
    const int gw = vcu * NWAVES + wave, NGW = G * NWAVES;
    constexpr int I_IN = (D / 64) * (DIN / 32), I_OUT = (D / 64) * (D / 32);
    for (int it = gw; it < DEPTH * (I_IN + I_OUT); it += NGW) {
        const int l = it / (I_IN + I_OUT), r = it % (I_IN + I_OUT);
        if (r < I_IN) p0_transpose_item(p.w_in + (size_t)l * D * DIN, D, DIN, (u16*)(p.ws + WS_WIN) + (size_t)l * DIN * D, scr, r, lane, true);
        else p0_transpose_item(p.w_out + (size_t)l * D * D, D, D, (u16*)(p.ws + WS_WOUT) + (size_t)l * D * D, scr, r - I_IN, lane, false);
    }
    f32x2* tab = (f32x2*)(p.ws + WS_TAB);
    for (int e = vcu * NTHR + tid; e < (SEQ + DS) * 32; e += G * NTHR) {
        const int pi = e >> 5, i = e & 31; const int pos = pi < SEQ ? pi : PAST + (pi - SEQ);
        const float ang = (float)pos * invf[i];
        float c, s; sincos_d((double)ang, c, s);
        tab[e] = (f32x2){c, s};
    }
}

template <bool FIRST>
DI void ln_phase(const Params& p, int l, int gw, int NGW, int lane) {
    const float* modl = (const float*)(p.ws + WS_MOD) + (size_t)l * NMOD * 3072;
    u16* ZH = (u16*)(p.ws + WS_ZH); u16* XR = (u16*)(p.ws + WS_XR);
    const float* lg = p.ln_g + (size_t)(l - 1) * D; const float* lb = p.ln_b + (size_t)(l - 1) * D;
    for (int row = gw; row < M; row += NGW) {
        const int bidx = row < MP ? (row >> 12) : NB + ((row - MP) >> 2);
        float v[16];
        if (FIRST) { const float* x = row < MP ? p.x_prompt + (size_t)row * D : p.x_sample + (size_t)(row - MP) * D;
#pragma unroll
            for (int j2 = 0; j2 < 2; ++j2) { const f32x4 a = *(const f32x4*)(x + 512 * j2 + 8 * lane), b = *(const f32x4*)(x + 512 * j2 + 8 * lane + 4);
#pragma unroll
                for (int k = 0; k < 4; ++k) { v[8 * j2 + k] = a[k]; v[8 * j2 + 4 + k] = b[k]; } }
        } else {
#pragma unroll
            for (int j2 = 0; j2 < 2; ++j2) unpack8(*(const u32x4*)(ZH + (size_t)row * D + 512 * j2 + 8 * lane), v + 8 * j2);
            float s = 0.f;
#pragma unroll
            for (int k = 0; k < 16; ++k) s += v[k];
            const float mean = wave_sum(s) * (1.f / D); float q = 0.f;
#pragma unroll
            for (int k = 0; k < 16; ++k) { v[k] -= mean; q += v[k] * v[k]; }
            const float rstd = 1.f / sqrtf(wave_sum(q) * (1.f / D) + LN_EPS);
#pragma unroll
            for (int j2 = 0; j2 < 2; ++j2)
#pragma unroll
                for (int h = 0; h < 2; ++h) { const f32x4 g = *(const f32x4*)(lg + 512 * j2 + 8 * lane + 4 * h), bb = *(const f32x4*)(lb + 512 * j2 + 8 * lane + 4 * h);
#pragma unroll
                    for (int k = 0; k < 4; ++k) v[8 * j2 + 4 * h + k] = v[8 * j2 + 4 * h + k] * rstd * g[k] + bb[k]; }
        }
#pragma unroll
        for (int j2 = 0; j2 < 2; ++j2) *(u32x4*)(XR + (size_t)row * D + 512 * j2 + 8 * lane) = pack8(v + 8 * j2);
        float s = 0.f;
#pragma unroll
        for (int k = 0; k < 16; ++k) s += v[k];
        const float mean = wave_sum(s) * (1.f / D); float q = 0.f;
#pragma unroll
        for (int k = 0; k < 16; ++k) { v[k] -= mean; q += v[k] * v[k]; }
        const float rstd = 1.f / sqrtf(wave_sum(q) * (1.f / D) + LN_EPS);
        const float* sh = modl + (size_t)bidx * 3072; const float* sc = sh + 1024;
#pragma unroll
        for (int j2 = 0; j2 < 2; ++j2) {
#pragma unroll
            for (int h = 0; h < 2; ++h) { const f32x4 a = *(const f32x4*)(sc + 512 * j2 + 8 * lane + 4 * h), bb = *(const f32x4*)(sh + 512 * j2 + 8 * lane + 4 * h);
#pragma unroll
                for (int k = 0; k < 4; ++k) v[8 * j2 + 4 * h + k] = v[8 * j2 + 4 * h + k] * rstd * (1.f + a[k]) + bb[k]; }
            *(u32x4*)(ZH + (size_t)row * D + 512 * j2 + 8 * lane) = pack8(v + 8 * j2); }
    }
}
DI void fin_phase(const Params& p, int gw, int NGW, int lane) {
    const u16* ZH = (const u16*)(p.ws + WS_ZH);
    const float* lg = p.ln_g + (size_t)(DEPTH - 1) * D; const float* lb = p.ln_b + (size_t)(DEPTH - 1) * D;
    for (int row = gw; row < M; row += NGW) {
        float v[16];
#pragma unroll
        for (int j2 = 0; j2 < 2; ++j2) unpack8(*(const u32x4*)(ZH + (size_t)row * D + 512 * j2 + 8 * lane), v + 8 * j2);
        float s = 0.f;
#pragma unroll
        for (int k = 0; k < 16; ++k) s += v[k];
        const float mean = wave_sum(s) * (1.f / D); float q = 0.f;
#pragma unroll
        for (int k = 0; k < 16; ++k) { v[k] -= mean; q += v[k] * v[k]; }
        const float rstd = 1.f / sqrtf(wave_sum(q) * (1.f / D) + LN_EPS);
        float* y = p.out + (size_t)row * D;
#pragma unroll
        for (int j2 = 0; j2 < 2; ++j2)
#pragma unroll
            for (int h = 0; h < 2; ++h) { const f32x4 g = *(const f32x4*)(lg + 512 * j2 + 8 * lane + 4 * h), bb = *(const f32x4*)(lb + 512 * j2 + 8 * lane + 4 * h); f32x4 o;
#pragma unroll
                for (int k = 0; k < 4; ++k) o[k] = v[8 * j2 + 4 * h + k] * rstd * g[k] + bb[k];
                *(f32x4*)(y + 512 * j2 + 8 * lane + 4 * h) = o; }
    }
}

struct MixPtrs { const u16 *PA, *PSZC, *PPV, *PSZP, *PQ, *PSZA, *PK, *PV; u16* MIX; };
DI v4i16_t ds_tr(const LAS unsigned char* a) { return __builtin_amdgcn_ds_read_tr16_b64_v4i16((LAS v4i16_t*)a); }

DI void attn_prompt_unit(const Params& p, const MixPtrs& X, int l, int unit, LAS unsigned char* lds, int tid, int lane, int wave) {
    const int b = unit >> 6, hk = (unit >> 5) & 1, nb = unit & 31, q0 = nb * 128; const size_t rb = (size_t)b * SEQ;
    LAS unsigned char* Ks = lds; LAS unsigned char* Vs = lds + 36864;
#pragma unroll
    for (int i = 0; i < 4; ++i) { const int c = tid + 512 * i, key = c >> 3, ch = c & 7, tk = q0 - 128 + key;
        if (tk >= 0) { const u32x4 kv = *(const u32x4*)(X.PK + (rb + tk) * 128 + hk * 64 + ch * 8), vv = *(const u32x4*)(X.PV + (rb + tk) * 128 + hk * 64 + ch * 8);
            *(LAS u32x4*)(Ks + key * 144 + ch * 16) = kv; *(LAS u32x4*)(Vs + (ch >> 2) * 16384 + key * 64 + (ch & 3) * 16) = vv; } }
    __syncthreads();
    const int g = wave & 3, qh = wave >> 2, head = 4 * hk + g, r = lane & 31, h = lane >> 5;
    const float sink2 = p.sinks[l * 8 + head] * LOG2E;
    const int trq = (lane & 15) >> 2, trp = lane & 3, trg = (lane >> 4) & 1;
    const float NEG = -INFINITY;
#pragma unroll 1
    for (int e = 0; e < 2; ++e) {
        const int ql = 64 * qh + 32 * e; const size_t qrow = rb + q0 + ql + r;
        h8 qf[4];
#pragma unroll
        for (int s = 0; s < 4; ++s) qf[s] = *(const h8*)(X.PQ + qrow * 512 + head * 64 + 16 * s + 8 * h);
        f32x16 S[5];
#pragma unroll
        for (int i = 0; i < 5; ++i) { const int kl = ql + 32 * i; const bool valid = (nb > 0) || (kl >= 128);
#pragma unroll
            for (int x = 0; x < 16; ++x) S[i][x] = 0.f;
            if (valid) {
#pragma unroll
                for (int s = 0; s < 4; ++s) { const h8 kf = *(const LAS h8*)(Ks + (kl + r) * 144 + (16 * s + 8 * h) * 2); S[i] = __builtin_amdgcn_mfma_f32_32x32x16_f16(kf, qf[s], S[i], 0, 0, 0); }
            } else {
#pragma unroll
                for (int x = 0; x < 16; ++x) S[i][x] = NEG; }
            if (i == 0) {
#pragma unroll
                for (int x = 0; x < 16; ++x) if (!(crow(x, h) > r)) S[i][x] = NEG; }
            if (i == 4) {
#pragma unroll
                for (int x = 0; x < 16; ++x) if (!(crow(x, h) <= r)) S[i][x] = NEG; }
        }
        float mx = sink2;
#pragma unroll
        for (int i = 0; i < 5; ++i)
#pragma unroll
            for (int x = 0; x < 16; ++x) mx = fmaxf(mx, S[i][x]);
        mx = fmaxf(mx, __shfl_xor(mx, 32));
        float sum = 0.f;
#pragma unroll
        for (int i = 0; i < 5; ++i)
#pragma unroll
            for (int x = 0; x < 16; ++x) { S[i][x] = ex2(S[i][x] - mx); sum += S[i][x]; }
        sum += __shfl_xor(sum, 32);
        const float inv = 1.f / (sum + ex2(sink2 - mx));
        f32x16 O[2];
#pragma unroll
        for (int x = 0; x < 16; ++x) { O[0][x] = 0.f; O[1][x] = 0.f; }
#pragma unroll
        for (int i = 0; i < 5; ++i) { const int kl = ql + 32 * i; const bool valid = (nb > 0) || (kl >= 128);
            if (valid) {
#pragma unroll
                for (int s2 = 0; s2 < 2; ++s2) { float pv8[8];
#pragma unroll
                    for (int j = 0; j < 8; ++j) pv8[j] = S[i][8 * s2 + j] * inv;
                    const h8 pa = __builtin_bit_cast(h8, pack8(pv8));
#pragma unroll
                    for (int db = 0; db < 2; ++db) { const LAS unsigned char* va = Vs + db * 16384 + (kl + 16 * s2 + 4 * h + trq) * 64 + trg * 32 + trp * 8;
                        const v4i16_t lo = ds_tr(va), hi = ds_tr(va + 512);
                        const h8 vf = __builtin_bit_cast(h8, __builtin_shufflevector(lo, hi, 0, 1, 2, 3, 4, 5, 6, 7));
                        O[db] = __builtin_amdgcn_mfma_f32_32x32x16_f16(vf, pa, O[db], 0, 0, 0); } } } }
#pragma unroll
        for (int db = 0; db < 2; ++db)
#pragma unroll
            for (int xq = 0; xq < 4; ++xq) { const int col = head * 64 + 32 * db + 8 * xq + 4 * h;
                const h4 z = *(const h4*)(X.PSZA + qrow * 512 + col);
                u32x2 w; w.x = pkh(O[db][4 * xq] * (float)z[0], O[db][4 * xq + 1] * (float)z[1]); w.y = pkh(O[db][4 * xq + 2] * (float)z[2], O[db][4 * xq + 3] * (float)z[3]);
                *(u32x2*)(X.MIX + qrow * D + 512 + col) = w; }
    }
    __syncthreads();
}

DI void conv_prompt_unit(const Params& p, const MixPtrs& X, int l, int unit, LAS unsigned char* lds, int tid, int lane, int wave) {
    const int R0 = unit * 64, b = R0 >> 12, t0 = R0 & (SEQ - 1); const size_t rb = (size_t)b * SEQ;
    LAS unsigned char* WL = lds + 94 * 512;
    for (int c = tid; c < 94 * 32; c += NTHR) { const int row = c >> 5, ch = c & 31, tk = t0 - 30 + row; u32x4 v = (u32x4){0u, 0u, 0u, 0u};
        if (tk >= 0) v = *(const u32x4*)(X.PA + (rb + tk) * 256 + ch * 8);
        *(LAS u32x4*)(lds + row * 512 + ch * 16) = v; }
    for (int c = tid; c < 31 * 64; c += NTHR) *(LAS f32x4*)(WL + c * 16) = *(const f32x4*)(p.conv_w + (size_t)l * 31 * 256 + 4 * c);
    const f32x4 bias = *(const f32x4*)(p.conv_b + l * 256 + 4 * lane), cg = *(const f32x4*)(p.cnorm_g + l * 256 + 4 * lane), cb = *(const f32x4*)(p.cnorm_b + l * 256 + 4 * lane);
    __syncthreads();
    f32x4 acc[8], win[8];
#pragma unroll
    for (int tt = 0; tt < 8; ++tt) acc[tt] = bias;
    const LAS unsigned char* arow = lds + (8 * wave) * 512 + lane * 8;
#pragma unroll
    for (int k = 0; k < 7; ++k) win[k] = __builtin_convertvector(*(const LAS h4*)(arow + k * 512), f32x4);
#pragma unroll 1
    for (int jb = 0; jb < 4; ++jb) {
#pragma unroll
        for (int jj = 0; jj < 8; ++jj) { const int j = 8 * jb + jj;
            if (j < 31) {
                win[(jj + 7) & 7] = __builtin_convertvector(*(const LAS h4*)(arow + (j + 7) * 512), f32x4);
                const f32x4 w = *(const LAS f32x4*)(WL + j * 1024 + lane * 16);
#pragma unroll
                for (int tt = 0; tt < 8; ++tt) acc[tt] += w * win[(jj + tt) & 7]; } } }
#pragma unroll
    for (int tt = 0; tt < 8; ++tt) { const size_t row = (size_t)R0 + 8 * wave + tt;
        const float mean = wave_sum((acc[tt][0] + acc[tt][1]) + (acc[tt][2] + acc[tt][3])) * (1.f / 256.f);
        const f32x4 d = acc[tt] - mean;
        const float rstd = 1.f / sqrtf(wave_sum((d[0] * d[0] + d[1] * d[1]) + (d[2] * d[2] + d[3] * d[3])) * (1.f / 256.f) + LN_EPS);
        const h4 zc = *(const h4*)(X.PSZC + row * 256 + 4 * lane); float o[4];
#pragma unroll
        for (int k = 0; k < 4; ++k) o[k] = silu(d[k] * rstd * cg[k] + cb[k]) * (float)zc[k];
        u32x2 w; w.x = pkh(o[0], o[1]); w.y = pkh(o[2], o[3]);
        *(u32x2*)(X.MIX + row * D + 4 * lane) = w; }
    __syncthreads();
}

DI void pool_prompt_unit(const Params& p, const MixPtrs& X, int l, int unit, LAS unsigned char* lds, int tid, int lane, int wave) {
    const int R0 = unit * 64, b = R0 >> 12, t0 = R0 & (SEQ - 1); const size_t rb = (size_t)b * SEQ;
    LAS unsigned char* PL = lds + 79 * 512;
    for (int c = tid; c < 79 * 32; c += NTHR) { const int row = c >> 5, ch = c & 31, tk = t0 - 15 + row; u32x4 v = (u32x4){0u, 0u, 0u, 0u};
        if (tk >= 0) v = *(const u32x4*)(X.PPV + (rb + tk) * 256 + ch * 8);
        *(LAS u32x4*)(lds + row * 512 + ch * 16) = v; }
    __syncthreads();
    { const int wlen = 2 << (lane >> 4);
        const LAS unsigned char* prow = lds + (8 * wave + 15) * 512 + lane * 8;
        f32x4 sm[8];
#pragma unroll
        for (int tt = 0; tt < 8; ++tt) sm[tt] = (f32x4){0.f, 0.f, 0.f, 0.f};
#pragma unroll 1
        for (int i = 0; i < 16; ++i) { if (i < wlen) {
#pragma unroll
            for (int tt = 0; tt < 8; ++tt) sm[tt] += __builtin_convertvector(*(const LAS h4*)(prow + (tt - i) * 512), f32x4); } }
#pragma unroll
        for (int tt = 0; tt < 8; ++tt) {
            const int t = t0 + 8 * wave + tt; const float cnt = (float)(wlen < t + 1 ? wlen : t + 1);
            const f32x4 cur = __builtin_convertvector(*(const LAS h4*)(prow + tt * 512), f32x4);
            const f32x4 pl = sm[tt] * (1.f / cnt) - cur;
            u32x2 w; w.x = pkh(pl[0], pl[1]); w.y = pkh(pl[2], pl[3]);
            *(LAS u32x2*)(PL + (8 * wave + tt) * 528 + lane * 8) = w; } }
    __syncthreads();
    { const int g = wave & 3, th = wave >> 2, r = lane & 31, h = lane >> 5;
        const float* pw = p.pool_w + ((size_t)l * 4 + g) * 64 * 64 + r;
        f32x16 Dd[2];
#pragma unroll
        for (int x = 0; x < 16; ++x) { Dd[0][x] = 0.f; Dd[1][x] = 0.f; }
#pragma unroll 1
        for (int s = 0; s < 4; ++s) { const h8 bf = *(const LAS h8*)(PL + (32 * th + r) * 528 + (64 * g + 16 * s + 8 * h) * 2);
#pragma unroll
            for (int nb = 0; nb < 2; ++nb) { h8 af;
#pragma unroll
                for (int j = 0; j < 8; ++j) af[j] = (_Float16)pw[(size_t)(16 * s + 8 * h + j) * 64 + 32 * nb];
                Dd[nb] = __builtin_amdgcn_mfma_f32_32x32x16_f16(af, bf, Dd[nb], 0, 0, 0); } }
        const size_t row = (size_t)R0 + 32 * th + r;
#pragma unroll
        for (int nb = 0; nb < 2; ++nb)
#pragma unroll
            for (int xq = 0; xq < 4; ++xq) { const int col = 64 * g + 32 * nb + 8 * xq + 4 * h;
                const f32x4 ps = *(const f32x4*)(p.pool_scale + l * 256 + col); const h4 z = *(const h4*)(X.PSZP + row * 256 + col);
                u32x2 w; w.x = pkh(Dd[nb][4 * xq] * ps[0] * (float)z[0], Dd[nb][4 * xq + 1] * ps[1] * (float)z[1]); w.y = pkh(Dd[nb][4 * xq + 2] * ps[2] * (float)z[2], Dd[nb][4 * xq + 3] * ps[3] * (float)z[3]);
                *(u32x2*)(X.MIX + row * D + 256 + col) = w; } }
    __syncthreads();
}

DI void convpool_sample_unit(const Params& p, const MixPtrs& X, int l, int b, LAS unsigned char* lds, int tid, int lane, int wave) {
    LAS float* cv = (LAS float*)lds;
    LAS float* pl = cv + 1024;
    const int c = tid & 255, tp = tid >> 8; const size_t r0 = (size_t)MP + 4 * b;
    const float* cc = p.cache_conv + (size_t)(l * DB + b) * 30 * 256; const float* cp = p.cache_pool + (size_t)(l * DB + b) * 15 * 256;
    {
        auto xc = [&](int ri) -> float { return ri < 30 ? cc[(size_t)ri * 256 + c] : (float)(*(const _Float16*)(X.PA + (r0 + (ri - 30)) * 256 + c)); };
        float a0 = p.conv_b[l * 256 + c], a1 = a0, prev = xc(2 * tp);
#pragma unroll 2
        for (int j = 0; j < 31; ++j) { const float cur = xc(2 * tp + j + 1); const float w = p.conv_w[((size_t)l * 31 + j) * 256 + c]; a0 += w * prev; a1 += w * cur; prev = cur; }
        cv[(2 * tp) * 256 + c] = a0; cv[(2 * tp + 1) * 256 + c] = a1; }
    {
        auto xp = [&](int ri) -> float { return ri < 15 ? cp[(size_t)ri * 256 + c] : (float)(*(const _Float16*)(X.PPV + (r0 + (ri - 15)) * 256 + c)); };
        const int wlen = 2 << (c >> 6); float s0 = 0.f, s1 = 0.f;
#pragma unroll 2
        for (int i = 0; i < 16; ++i) if (i < wlen) { s0 += xp(15 + 2 * tp - i); s1 += xp(16 + 2 * tp - i); }
        const float iw = 1.f / (float)wlen;
        pl[(2 * tp) * 256 + c] = s0 * iw - xp(15 + 2 * tp); pl[(2 * tp + 1) * 256 + c] = s1 * iw - xp(16 + 2 * tp); }
    { float* oc = p.out + OFF_CONVS + (size_t)(l * DB + b) * 30 * 256; float* op = p.out + OFF_POOLS + (size_t)(l * DB + b) * 15 * 256;
        for (int e = tid; e < 26 * 64; e += NTHR) *(f32x4*)(oc + 4 * e) = *(const f32x4*)(cc + 4 * 256 + 4 * e);
        for (int e = tid; e < 11 * 64; e += NTHR) *(f32x4*)(op + 4 * e) = *(const f32x4*)(cp + 4 * 256 + 4 * e); }
    __syncthreads();
    if (wave < 4) { const int t = wave; const f32x4 v = *(const LAS f32x4*)(cv + t * 256 + 4 * lane);
        const float mean = wave_sum((v[0] + v[1]) + (v[2] + v[3])) * (1.f / 256.f); const f32x4 d = v - mean;
        const float rstd = 1.f / sqrtf(wave_sum((d[0] * d[0] + d[1] * d[1]) + (d[2] * d[2] + d[3] * d[3])) * (1.f / 256.f) + LN_EPS);
        const f32x4 cg = *(const f32x4*)(p.cnorm_g + l * 256 + 4 * lane), cb = *(const f32x4*)(p.cnorm_b + l * 256 + 4 * lane);
        const h4 zc = *(const h4*)(X.PSZC + (r0 + t) * 256 + 4 * lane); float o[4];
#pragma unroll
        for (int k = 0; k < 4; ++k) o[k] = silu(d[k] * rstd * cg[k] + cb[k]) * (float)zc[k];
        u32x2 w; w.x = pkh(o[0], o[1]); w.y = pkh(o[2], o[3]);
        *(u32x2*)(X.MIX + (r0 + t) * D + 4 * lane) = w; }
    { const int g = c >> 6, n = c & 63; const float* pw = p.pool_w + ((size_t)l * 4 + g) * 64 * 64 + n; float y0 = 0.f, y1 = 0.f;
#pragma unroll 4
        for (int k = 0; k < 64; ++k) { const float w = pw[(size_t)k * 64]; y0 += pl[(2 * tp) * 256 + 64 * g + k] * w; y1 += pl[(2 * tp + 1) * 256 + 64 * g + k] * w; }
        const float ps = p.pool_scale[l * 256 + c];
        const float z0 = (float)(*(const _Float16*)(X.PSZP + (r0 + 2 * tp) * 256 + c)), z1 = (float)(*(const _Float16*)(X.PSZP + (r0 + 2 * tp + 1) * 256 + c));
        *(_Float16*)(X.MIX + (r0 + 2 * tp) * D + 256 + c) = (_Float16)(y0 * ps * z0); *(_Float16*)(X.MIX + (r0 + 2 * tp + 1) * D + 256 + c) = (_Float16)(y1 * ps * z1); }
    __syncthreads();
}

DI void attn_sample_unit(const Params& p, const MixPtrs& X, int l, int unit, LAS unsigned char* lds, int tid, int lane, int wave) {
    const int b = unit >> 1, hk = unit & 1; const size_t r0 = (size_t)MP + 4 * b;
    LAS float* Ks = (LAS float*)lds;
    LAS float* Vs = Ks + 132 * 65;
    LAS float* Qs = Vs + 132 * 64;
    LAS float* Ss = Qs + 16 * 65;
    const float* ck = p.cache_k + ((size_t)(l * DB + b) * 128 * 2 + hk) * 64; const float* cvv = p.cache_v + ((size_t)(l * DB + b) * 128 * 2 + hk) * 64;
    float* ok = p.out + OFF_KS + ((size_t)(l * DB + b) * 128 * 2 + hk) * 64; float* ov = p.out + OFF_VS + ((size_t)(l * DB + b) * 128 * 2 + hk) * 64;
#pragma unroll
    for (int i = 0; i < 4; ++i) { const int e = tid + 512 * i, j = e >> 4, d4 = (e & 15) * 4;
        const f32x4 kv = *(const f32x4*)(ck + (size_t)j * 128 + d4), vv = *(const f32x4*)(cvv + (size_t)j * 128 + d4);
        Ks[j * 65 + d4] = kv[0]; Ks[j * 65 + d4 + 1] = kv[1]; Ks[j * 65 + d4 + 2] = kv[2]; Ks[j * 65 + d4 + 3] = kv[3];
        *(LAS f32x4*)(Vs + j * 64 + d4) = vv;
        if (j >= 4) { *(f32x4*)(ok + (size_t)(j - 4) * 128 + d4) = kv; *(f32x4*)(ov + (size_t)(j - 4) * 128 + d4) = vv; } }
    if (tid < 256) { const int t = tid >> 6, d = tid & 63;
        Ks[(128 + t) * 65 + d] = (float)(*(const _Float16*)(X.PK + (r0 + t) * 128 + hk * 64 + d));
        Vs[(128 + t) * 64 + d] = (float)(*(const _Float16*)(X.PV + (r0 + t) * 128 + hk * 64 + d)); }
#pragma unroll
    for (int i = 0; i < 2; ++i) { const int e = tid + 512 * i, qr = e >> 6, d = e & 63, t = qr >> 2, g = qr & 3;
        Qs[qr * 65 + d] = (float)(*(const _Float16*)(X.PQ + (r0 + t) * 512 + (4 * hk + g) * 64 + d)); }
    __syncthreads();
    { const int qr = tid & 15, kg = tid >> 4, t = qr >> 2;
        for (int kk = kg; kk < 132; kk += 32) { float s = 0.f;
#pragma unroll 16
            for (int d = 0; d < 64; ++d) s += Qs[qr * 65 + d] * Ks[kk * 65 + d];
            Ss[qr * 133 + kk] = (kk >= t + 1 && kk <= t + 128) ? s : -INFINITY; } }
    __syncthreads();
#pragma unroll
    for (int q2 = 0; q2 < 2; ++q2) { const int qr = 2 * wave + q2, g = qr & 3; const float sink2 = p.sinks[l * 8 + 4 * hk + g] * LOG2E;
        float s0 = Ss[qr * 133 + lane], s1 = Ss[qr * 133 + 64 + lane], s2 = lane < 4 ? Ss[qr * 133 + 128 + lane] : -INFINITY;
        const float mx = fmaxf(wave_max(fmaxf(fmaxf(s0, s1), s2)), sink2);
        s0 = ex2(s0 - mx); s1 = ex2(s1 - mx); s2 = ex2(s2 - mx);
        const float inv = 1.f / (wave_sum(s0 + s1 + s2) + ex2(sink2 - mx));
        Ss[qr * 133 + lane] = s0 * inv; Ss[qr * 133 + 64 + lane] = s1 * inv; if (lane < 4) Ss[qr * 133 + 128 + lane] = s2 * inv; }
    __syncthreads();
    { const int qr = tid & 15, dg = tid >> 4, t = qr >> 2, g = qr & 3; float o0 = 0.f, o1 = 0.f;
#pragma unroll 4
        for (int kk = 0; kk < 132; ++kk) { const float pr = Ss[qr * 133 + kk]; const f32x2 v = *(const LAS f32x2*)(Vs + kk * 64 + 2 * dg); o0 += pr * v[0]; o1 += pr * v[1]; }
        const int col = (4 * hk + g) * 64 + 2 * dg;
        const h2 z = *(const h2*)(X.PSZA + (r0 + t) * 512 + col);
        *(unsigned*)(X.MIX + (r0 + t) * D + 512 + col) = pkh(o0 * (float)z[0], o1 * (float)z[1]); }
    __syncthreads();
}

constexpr int N_PHASES = 2 + 4 * DEPTH;
typedef const __attribute__((address_space(4))) Params* KParams;
#define PHASE_BEGIN() int tid = threadIdx.x; asm volatile("" : "+v"(tid)); const int lane = tid & 63, wave = __builtin_amdgcn_readfirstlane(tid >> 6); \
    KParams kq = kp; asm volatile("" : "+s"(kq)); Params p; __builtin_memcpy(&p, (const void*)kq, __builtin_offsetof(Params, inv_freq)); const int gw = vcu * NWAVES + wave, NGW = G * NWAVES; (void)lane; (void)gw; (void)NGW
__global__ void __launch_bounds__(NTHR, 2) hymba_fwd(Params p_unused) {
#if defined(__HIP_DEVICE_COMPILE__)
    extern __shared__ __attribute__((aligned(16))) unsigned char lds_raw[];
    LAS unsigned char* lds = (LAS unsigned char*)lds_raw;
    volatile LAS unsigned* MISC = (volatile LAS unsigned*)(lds + MISC_OFF);
    const KParams kp = (KParams)__builtin_amdgcn_kernarg_segment_ptr();
    const int G = gridDim.x, bx = blockIdx.x, vcu = (G % 8 == 0) ? (bx % 8) * (G / 8) + bx / 8 : bx;
    for (int u = threadIdx.x; u < (LDS_BYTES - RING_BYTES) / 4; u += NTHR) ((LAS unsigned*)(lds + RING_BYTES))[u] = 0u;
    __syncthreads();
    unsigned* ctl = (unsigned*)(kp->ws + WS_CTL);
    XcdBarrier bar; bar.bar = ctl + CW_BAR; bar.x = 0; bar.st = nullptr;
    if (MK_N_LAUNCHES == 1) bar = xcd_barrier_post(ctl + CW_BAR, MISC + 8);
    const int lo = kp->ph_lo, hi = kp->ph_hi;
#define IN(k) (lo <= (k) && (k) < hi)
#define SEAM(k) do { if (MK_N_LAUNCHES == 1 && IN((k) + 1)) xcd_barrier(bar); } while (0)
#if !defined(ONLY) || ONLY == 0
    if (IN(0)) { { PHASE_BEGIN(); p0_prologue(p, (const __attribute__((address_space(4))) float*)((const __attribute__((address_space(4))) char*)kq + __builtin_offsetof(Params, inv_freq)), lds, vcu, G, tid, lane, wave); } SEAM(0); }
#endif
#pragma unroll 1
    for (int l = 0; l < DEPTH; ++l) {
        const int ph = 1 + 4 * l;
#if !defined(ONLY) || ONLY == 1
        if (IN(ph)) { { PHASE_BEGIN(); if (l == 0) ln_phase<true>(p, l, gw, NGW, lane); else ln_phase<false>(p, l, gw, NGW, lane); } SEAM(ph); }
#endif
#if !defined(ONLY) || ONLY == 2
        if (IN(ph + 1)) {
            { PHASE_BEGIN();
            pg8::Gemm g{(const u16*)(p.ws + WS_ZH), (const u16*)(p.ws + WS_WIN) + (size_t)l * DIN * D, M, DIN, D};
            pg8::StaticOrder S; S.init(M, DIN, G, bx);
            EpiIn E{l, p.ws, p.out};
            pg8::gemm_phase<EpiIn, true>(lds, g, S, E, tid); }
            SEAM(ph + 1);
        }
#endif
#if !defined(ONLY) || ONLY == 3
        if (IN(ph + 2)) {
#define MIXPTRS() MixPtrs X; X.PA = (const u16*)(p.ws + WS_PA); X.PSZC = (const u16*)(p.ws + WS_PSZC); X.PPV = (const u16*)(p.ws + WS_PPV); X.PSZP = (const u16*)(p.ws + WS_PSZP); \
    X.PQ = (const u16*)(p.ws + WS_PQ); X.PSZA = (const u16*)(p.ws + WS_PSZA); X.PK = (const u16*)(p.ws + WS_PK); X.PV = (const u16*)(p.ws + WS_PV); X.MIX = (u16*)(p.ws + WS_MIX)
#if !defined(OM) || OM == 0
            { PHASE_BEGIN(); MIXPTRS(); for (int u = vcu; u < 256; u += G) attn_prompt_unit(p, X, l, u, lds, tid, lane, wave); }
#endif
#if !defined(OM) || OM == 1
            { PHASE_BEGIN(); MIXPTRS(); for (int u = vcu; u < 256; u += G) conv_prompt_unit(p, X, l, u, lds, tid, lane, wave); }
#endif
#if !defined(OM) || OM == 2
            { PHASE_BEGIN(); MIXPTRS(); for (int u = vcu; u < 256; u += G) pool_prompt_unit(p, X, l, u, lds, tid, lane, wave); }
#endif
#if !defined(OM) || OM == 3
            { PHASE_BEGIN(); MIXPTRS(); for (int u = vcu; u < 256; u += G) attn_sample_unit(p, X, l, u, lds, tid, lane, wave); }
#endif
#if !defined(OM) || OM == 4
            { PHASE_BEGIN(); MIXPTRS(); for (int u = vcu; u < DB; u += G) convpool_sample_unit(p, X, l, u, lds, tid, lane, wave); }
#endif
            SEAM(ph + 2); }
#endif
#if !defined(ONLY) || ONLY == 4
        if (IN(ph + 3)) {
            { PHASE_BEGIN();
            pg8::Gemm g{(const u16*)(p.ws + WS_MIX), (const u16*)(p.ws + WS_WOUT) + (size_t)l * D * D, M, D, D};
            pg8::StaticOrder S; S.init(M, D, G, bx);
            EpiOut E{p.ws, l};
            pg8::gemm_phase<EpiOut, false>(lds, g, S, E, tid); }
            SEAM(ph + 3);
        }
#endif
    }
#if !defined(ONLY) || ONLY == 5
    if (IN(N_PHASES - 1)) { PHASE_BEGIN(); fin_phase(p, gw, NGW, lane); }
#endif
#undef IN
#undef SEAM
#endif
}


#ifdef DBG
constexpr int DBG_NS = 56;
constexpr size_t WS_DBGACC = 32 * 1024;
constexpr size_t WS_DBGZ = WS_END;
__constant__ int dbg_rows_tab[DBG_NS] = {0, 1, 2, 3, 14, 15, 16, 29, 30, 31, 32, 63, 64, 65, 127, 128, 129, 255, 256, 1000, 2047, 2048, 3967, 3968, 4065, 4066, 4080, 4081, 4094, 4095, 4096, 4097, 4127, 4224,
                            8191, 8192, 8320, 12288, 12415, 16382, 16383, 16384, 16385, 16386, 16387, 16388, 16391, 16639, 16640, 16892, 16893, 16894, 16895, 5000, 9999, 15000};
__device__ int dbg_row(int i) { return dbg_rows_tab[i]; }
__device__ void dbg_acc(float* accf, int id, float e, float r) {
    __shared__ float se[256], sr[256];
    const int t = threadIdx.x; se[t] = e; sr[t] = r; __syncthreads();
    for (int o = 128; o > 0; o >>= 1) { if (t < o) { se[t] += se[t + o]; sr[t] += sr[t + o]; } __syncthreads(); }
    if (t == 0) { atomicAdd(accf + 2 * id, se[0]); atomicAdd(accf + 2 * id + 1, sr[0]); }
    __syncthreads();
}
__device__ float dbg_h(const u16* p, size_t i) { return (float)(*(const _Float16*)(p + i)); }
#define DBG_E(fast, ref) do { const float f_ = (fast), r_ = (ref); e += (f_ - r_) * (f_ - r_); rr += r_ * r_; } while (0)
__global__ void __launch_bounds__(256) dbg_p0(Params p) {
    float* accf = (float*)(p.ws + WS_DBGACC); const int t = threadIdx.x, bid = blockIdx.x;
    {
        float e = 0, rr = 0; const int ri = (bid >> 2) % 9;
        const int l = bid & 3, row = ri < 6 ? ri : (ri == 6 ? 67 : 123 + ri);
        const float* c = row < NB ? p.c_prompt + (size_t)row * D : p.c_sample + (size_t)(row - NB) * D;
        for (int n = t * 12 + (bid % 12); n < 3072; n += 256 * 12) { float a = p.b_mod[l * 3072 + n];
            for (int k = 0; k < D; ++k) { const float x = c[k]; a += x / (1.f + expf(-x)) * p.w_mod[((size_t)l * D + k) * 3072 + n]; }
            DBG_E(((const float*)(p.ws + WS_MOD))[((size_t)l * NMOD + row) * 3072 + n], a); }
        dbg_acc(accf, 0, e, rr); }
    { float e = 0, rr = 0;
        for (int i = 0; i < 64; ++i) { const int l = bid & 3, col = (bid * 37 + i * 41 + t * 10) % DIN, k = (t * 4 + i * 16 + bid) % D;
            DBG_E(dbg_h((const u16*)(p.ws + WS_WIN), ((size_t)l * DIN + perm_in(col)) * D + k), p.w_in[((size_t)l * D + k) * DIN + col]); }
        dbg_acc(accf, 1, e, rr); }
    { float e = 0, rr = 0;
        for (int i = 0; i < 64; ++i) { const int l = bid & 3, col = (bid * 37 + i * 41 + t * 4) % D, k = (t * 4 + i * 16 + bid) % D;
            DBG_E(dbg_h((const u16*)(p.ws + WS_WOUT), ((size_t)l * D + perm_out(col)) * D + k), p.w_out[((size_t)l * D + k) * D + col]); }
        dbg_acc(accf, 2, e, rr); }
    { float e = 0, rr = 0;
        for (int i = 0; i < 16; ++i) { const int pi = (bid * 113 + i * 257 + t * 16) % (SEQ + DS), f = (t + i) & 31; const int pos = pi < SEQ ? pi : PAST + pi - SEQ;
            const float ang = (float)pos * p.inv_freq[f]; const f32x2 cs = ((const f32x2*)(p.ws + WS_TAB))[pi * 32 + f];
            DBG_E(cs[0], cosf(ang)); DBG_E(cs[1], sinf(ang)); }
        dbg_acc(accf, 3, e, rr); }
}
__global__ void __launch_bounds__(256) dbg_copyz(Params p) { const int row = dbg_row(blockIdx.x); for (int c = threadIdx.x; c < D; c += 256) ((u16*)(p.ws + WS_DBGZ))[blockIdx.x * D + c] = ((const u16*)(p.ws + WS_ZH))[(size_t)row * D + c]; }
__device__ float dbg_block_sum(float v) { __shared__ float sb[256]; const int t = threadIdx.x; sb[t] = v; __syncthreads(); for (int o = 128; o > 0; o >>= 1) { if (t < o) sb[t] += sb[t + o]; __syncthreads(); } const float r = sb[0]; __syncthreads(); return r; }
__global__ void __launch_bounds__(256) dbg_ln(Params p, int l) {
    float* accf = (float*)(p.ws + WS_DBGACC); const int t = threadIdx.x, row = dbg_row(blockIdx.x), base = 4 + 16 * l;
    const int bidx = row < MP ? (row >> 12) : NB + ((row - MP) >> 2);
    float x[4];
    for (int i = 0; i < 4; ++i) { const int c = t + 256 * i;
        x[i] = l == 0 ? (row < MP ? p.x_prompt[(size_t)row * D + c] : p.x_sample[(size_t)(row - MP) * D + c]) : dbg_h((const u16*)(p.ws + WS_DBGZ), (size_t)blockIdx.x * D + c); }
    if (l > 0) { const float mean = dbg_block_sum(x[0] + x[1] + x[2] + x[3]) / D; float q = 0; for (int i = 0; i < 4; ++i) { x[i] -= mean; q += x[i] * x[i]; }
        const float rstd = 1.f / sqrtf(dbg_block_sum(q) / D + LN_EPS);
        for (int i = 0; i < 4; ++i) { const int c = t + 256 * i; x[i] = x[i] * rstd * p.ln_g[(l - 1) * D + c] + p.ln_b[(l - 1) * D + c]; } }
    float e = 0, rr = 0;
    for (int i = 0; i < 4; ++i) DBG_E(dbg_h((const u16*)(p.ws + WS_XR), (size_t)row * D + t + 256 * i), x[i]);
    dbg_acc(accf, base + 0, e, rr);
    const float mean = dbg_block_sum(x[0] + x[1] + x[2] + x[3]) / D; float q = 0; for (int i = 0; i < 4; ++i) { x[i] -= mean; q += x[i] * x[i]; }
    const float rstd = 1.f / sqrtf(dbg_block_sum(q) / D + LN_EPS);
    e = 0; rr = 0;
    const float* md = (const float*)(p.ws + WS_MOD) + ((size_t)l * NMOD + bidx) * 3072;
    for (int i = 0; i < 4; ++i) { const int c = t + 256 * i; DBG_E(dbg_h((const u16*)(p.ws + WS_ZH), (size_t)row * D + c), x[i] * rstd * (1.f + md[1024 + c]) + md[c]); }
    dbg_acc(accf, base + 1, e, rr);
}
__global__ void __launch_bounds__(256) dbg_in(Params p, int l) {
    __shared__ float pr[DIN]; __shared__ float hh[D];
    float* accf = (float*)(p.ws + WS_DBGACC); const int t = threadIdx.x, row = dbg_row(blockIdx.x), base = 4 + 16 * l;
    const bool smp = row >= MP; const int b = smp ? (row - MP) >> 2 : row >> 12, tt = smp ? (row - MP) & 3 : row & (SEQ - 1), pos = smp ? PAST + tt : tt;
    for (int c = t; c < D; c += 256) hh[c] = dbg_h((const u16*)(p.ws + WS_ZH), (size_t)row * D + c);
    __syncthreads();
    for (int i = 0; i < 10; ++i) { const int col = t + 256 * i; float a = 0; for (int k = 0; k < D; ++k) a += hh[k] * p.w_in[((size_t)l * D + k) * DIN + col]; pr[col] = a; }
    __syncthreads();
    float e, rr;
    const float av = pr[t] / (1.f + expf(-pr[256 + t]));
    e = 0; rr = 0; DBG_E(dbg_h((const u16*)(p.ws + WS_PA), (size_t)row * 256 + t), av); dbg_acc(accf, base + 2, e, rr);
    e = 0; rr = 0; { const float z = pr[512 + t]; DBG_E(dbg_h((const u16*)(p.ws + WS_PSZC), (size_t)row * 256 + t), z / (1.f + expf(-z))); } dbg_acc(accf, base + 3, e, rr);
    e = 0; rr = 0; DBG_E(dbg_h((const u16*)(p.ws + WS_PPV), (size_t)row * 256 + t), pr[768 + t]); dbg_acc(accf, base + 4, e, rr);
    e = 0; rr = 0; { const float z = pr[1024 + t]; DBG_E(dbg_h((const u16*)(p.ws + WS_PSZP), (size_t)row * 256 + t), z / (1.f + expf(-z))); } dbg_acc(accf, base + 5, e, rr);
    e = 0; rr = 0;
    for (int i = 0; i < 2; ++i) { const int c = t + 256 * i, hd = c >> 6, d = c & 63, f = d & 31; const float ang = (float)pos * p.inv_freq[f], cs = cosf(ang), sn = sinf(ang);
        const float x = pr[1280 + c], xo = d < 32 ? -pr[1280 + hd * 64 + d + 32] : pr[1280 + hd * 64 + d - 32];
        DBG_E(dbg_h((const u16*)(p.ws + WS_PQ), (size_t)row * 512 + c), (x * cs + xo * sn) * QSCALE); }
    dbg_acc(accf, base + 6, e, rr);
    e = 0; rr = 0; float kref = 0.f, vref = 0.f;
    if (t < 128) { const int hd = t >> 6, d = t & 63, f = d & 31; const float ang = (float)pos * p.inv_freq[f], cs = cosf(ang), sn = sinf(ang);
        const float x = pr[1792 + t], xo = d < 32 ? -pr[1792 + hd * 64 + d + 32] : pr[1792 + hd * 64 + d - 32]; kref = x * cs + xo * sn;
        DBG_E(dbg_h((const u16*)(p.ws + WS_PK), (size_t)row * 128 + t), kref); }
    dbg_acc(accf, base + 7, e, rr);
    e = 0; rr = 0; if (t < 128) { vref = pr[1920 + t]; DBG_E(dbg_h((const u16*)(p.ws + WS_PV), (size_t)row * 128 + t), vref); } dbg_acc(accf, base + 8, e, rr);
    e = 0; rr = 0; for (int i = 0; i < 2; ++i) { const float z = pr[2048 + t + 256 * i]; DBG_E(dbg_h((const u16*)(p.ws + WS_PSZA), (size_t)row * 512 + t + 256 * i), z / (1.f + expf(-z))); } dbg_acc(accf, base + 9, e, rr);
    e = 0; rr = 0;
    if (smp) { DBG_E(p.out[OFF_CONVS + ((size_t)(l * DB + b) * 30 + 26 + tt) * 256 + t], av); DBG_E(p.out[OFF_POOLS + ((size_t)(l * DB + b) * 15 + 11 + tt) * 256 + t], pr[768 + t]);
        if (t < 128) { DBG_E(p.out[OFF_KS + ((size_t)(l * DB + b) * 128 + 124 + tt) * 128 + t], kref); DBG_E(p.out[OFF_VS + ((size_t)(l * DB + b) * 128 + 124 + tt) * 128 + t], vref); } }
    else { if (tt >= SEQ - 30) DBG_E(p.out[OFF_CONVP + ((size_t)(l * NB + b) * 30 + tt - (SEQ - 30)) * 256 + t], av);
        if (tt >= SEQ - 15) DBG_E(p.out[OFF_POOLP + ((size_t)(l * NB + b) * 15 + tt - (SEQ - 15)) * 256 + t], pr[768 + t]);
        if (tt >= SEQ - 128 && t < 128) { DBG_E(p.out[OFF_KP + ((size_t)(l * NB + b) * 128 + tt - (SEQ - 128)) * 128 + t], kref); DBG_E(p.out[OFF_VP + ((size_t)(l * NB + b) * 128 + tt - (SEQ - 128)) * 128 + t], vref); } }
    dbg_acc(accf, base + 10, e, rr);
}
__global__ void __launch_bounds__(256) dbg_mix(Params p, int l) {
    __shared__ float sh[1024]; __shared__ float sc[136];
    float* accf = (float*)(p.ws + WS_DBGACC); const int t = threadIdx.x, row = dbg_row(blockIdx.x), base = 4 + 16 * l;
    const bool smp = row >= MP; const int b = smp ? (row - MP) >> 2 : row >> 12, tt = smp ? (row - MP) & 3 : row & (SEQ - 1);
    const u16 *PA = (const u16*)(p.ws + WS_PA), *PSZC = (const u16*)(p.ws + WS_PSZC), *PPV = (const u16*)(p.ws + WS_PPV), *PSZP = (const u16*)(p.ws + WS_PSZP), *PQ = (const u16*)(p.ws + WS_PQ),
              *PSZA = (const u16*)(p.ws + WS_PSZA), *PK = (const u16*)(p.ws + WS_PK), *PV = (const u16*)(p.ws + WS_PV), *MIX = (const u16*)(p.ws + WS_MIX);
    float e, rr;
    {
        float a = p.conv_b[l * 256 + t];
        for (int j = 0; j < 31; ++j) { float x;
            if (!smp) { const int ts = tt - 30 + j; x = ts >= 0 ? dbg_h(PA, ((size_t)b * SEQ + ts) * 256 + t) : 0.f; }
            else { const int ri = tt + j; x = ri < 30 ? p.cache_conv[((size_t)(l * DB + b) * 30 + ri) * 256 + t] : dbg_h(PA, ((size_t)MP + 4 * b + ri - 30) * 256 + t); }
            a += p.conv_w[((size_t)l * 31 + j) * 256 + t] * x; }
        const float mean = dbg_block_sum(a) / 256.f; const float d = a - mean; const float rstd = 1.f / sqrtf(dbg_block_sum(d * d) / 256.f + LN_EPS);
        const float y = d * rstd * p.cnorm_g[l * 256 + t] + p.cnorm_b[l * 256 + t];
        e = 0; rr = 0; DBG_E(dbg_h(MIX, (size_t)row * D + t), y / (1.f + expf(-y)) * dbg_h(PSZC, (size_t)row * 256 + t)); dbg_acc(accf, base + 11, e, rr); }
    {
        const int w = 2 << (t >> 6); float s = 0;
        for (int i = 0; i < w; ++i) { float x;
            if (!smp) { const int ts = tt - i; x = ts >= 0 ? dbg_h(PPV, ((size_t)b * SEQ + ts) * 256 + t) : 0.f; }
            else { const int ri = 15 + tt - i; x = ri < 15 ? p.cache_pool[((size_t)(l * DB + b) * 15 + ri) * 256 + t] : dbg_h(PPV, ((size_t)MP + 4 * b + ri - 15) * 256 + t); }
            s += x; }
        const float cnt = smp ? (float)w : (float)(w < tt + 1 ? w : tt + 1);
        sh[t] = s / cnt - dbg_h(PPV, (size_t)row * 256 + t); __syncthreads();
        const int g = t >> 6, n = t & 63; float y = 0; for (int c = 0; c < 64; ++c) y += sh[64 * g + c] * p.pool_w[(((size_t)l * 4 + g) * 64 + c) * 64 + n];
        e = 0; rr = 0; DBG_E(dbg_h(MIX, (size_t)row * D + 256 + t), y * p.pool_scale[l * 256 + t] * dbg_h(PSZP, (size_t)row * 256 + t)); dbg_acc(accf, base + 12, e, rr); __syncthreads(); }
    {
        e = 0; rr = 0;
        for (int hd = 0; hd < 8; ++hd) { const int hk = hd >> 2; __syncthreads();
            if (t < 64) sh[t] = dbg_h(PQ, (size_t)row * 512 + hd * 64 + t); __syncthreads();
            const float sink2 = p.sinks[l * 8 + hd] * LOG2E;
            if (t < 128) { float s = -INFINITY;
                if (!smp) { const int ts = tt - 127 + t; if (ts >= 0) { s = 0; for (int d = 0; d < 64; ++d) s += sh[d] * dbg_h(PK, ((size_t)b * SEQ + ts) * 128 + hk * 64 + d); } }
                else { const int ci = tt + 1 + t;
                    s = 0; for (int d = 0; d < 64; ++d) s += sh[d] * (ci < 128 ? p.cache_k[(((size_t)(l * DB + b) * 128 + ci) * 2 + hk) * 64 + d] : dbg_h(PK, ((size_t)MP + 4 * b + ci - 128) * 128 + hk * 64 + d)); }
                sc[t] = s; }
            __syncthreads();
            float mx = sink2; for (int k = 0; k < 128; ++k) mx = fmaxf(mx, sc[k]);
            float den = exp2f(sink2 - mx); for (int k = 0; k < 128; ++k) den += exp2f(sc[k] - mx);
            if (t < 64) { float o = 0;
                for (int k = 0; k < 128; ++k) { const float pk = exp2f(sc[k] - mx) / den; if (pk == 0.f) continue; float v;
                    if (!smp) { const int ts = tt - 127 + k; v = dbg_h(PV, ((size_t)b * SEQ + ts) * 128 + hk * 64 + t); }
                    else { const int ci = tt + 1 + k; v = ci < 128 ? p.cache_v[(((size_t)(l * DB + b) * 128 + ci) * 2 + hk) * 64 + t] : dbg_h(PV, ((size_t)MP + 4 * b + ci - 128) * 128 + hk * 64 + t); }
                    o += pk * v; }
                DBG_E(dbg_h(MIX, (size_t)row * D + 512 + hd * 64 + t), o * dbg_h(PSZA, (size_t)row * 512 + hd * 64 + t)); } }
        dbg_acc(accf, base + 13, e, rr); }
    if (smp) { e = 0; rr = 0;
        for (int i = 0; i < 26; ++i) DBG_E(p.out[OFF_CONVS + ((size_t)(l * DB + b) * 30 + i) * 256 + t], p.cache_conv[((size_t)(l * DB + b) * 30 + i + 4) * 256 + t]);
        for (int i = 0; i < 11; ++i) DBG_E(p.out[OFF_POOLS + ((size_t)(l * DB + b) * 15 + i) * 256 + t], p.cache_pool[((size_t)(l * DB + b) * 15 + i + 4) * 256 + t]);
        for (int i = 0; i < 124; ++i) if (t < 128) { DBG_E(p.out[OFF_KS + ((size_t)(l * DB + b) * 128 + i) * 128 + t], p.cache_k[((size_t)(l * DB + b) * 128 + i + 4) * 128 + t]);
            DBG_E(p.out[OFF_VS + ((size_t)(l * DB + b) * 128 + i) * 128 + t], p.cache_v[((size_t)(l * DB + b) * 128 + i + 4) * 128 + t]); }
        dbg_acc(accf, base + 15, e, rr); }
}
__global__ void __launch_bounds__(256) dbg_out(Params p, int l) {
    __shared__ float mm[D];
    float* accf = (float*)(p.ws + WS_DBGACC); const int t = threadIdx.x, row = dbg_row(blockIdx.x), base = 4 + 16 * l;
    const int bidx = row < MP ? (row >> 12) : NB + ((row - MP) >> 2);
    for (int c = t; c < D; c += 256) mm[c] = dbg_h((const u16*)(p.ws + WS_MIX), (size_t)row * D + c);
    __syncthreads();
    const float* md = (const float*)(p.ws + WS_MOD) + ((size_t)l * NMOD + bidx) * 3072 + 2048;
    float e = 0, rr = 0;
    float ev[6] = {0, 0, 0, 0, 0, 0}, rv[6] = {0, 0, 0, 0, 0, 0};
    for (int i = 0; i < 4; ++i) { const int c = t + 256 * i; float a = 0, at = 0; for (int k = 0; k < D; ++k) { a += mm[k] * p.w_out[((size_t)l * D + k) * D + c]; at += mm[k] * p.w_out[((size_t)l * D + c) * D + k]; }
        const float zf = dbg_h((const u16*)(p.ws + WS_ZH), (size_t)row * D + c), xr = dbg_h((const u16*)(p.ws + WS_XR), (size_t)row * D + c);
        DBG_E(zf, ALPHA * xr + (1.f + md[c]) * a);
#define DBG_V(i_, fast_, ref_) do { const float f_ = (fast_), r_ = (ref_); ev[i_] += (f_ - r_) * (f_ - r_); rv[i_] += r_ * r_; } while (0)
        DBG_V(0, zf, (1.f + md[c]) * a); DBG_V(1, zf, ALPHA * xr); DBG_V(2, dbg_h((const u16*)(p.ws + WS_ZH), (size_t)row * D + perm_out(c)), ALPHA * xr + (1.f + md[c]) * a);
        DBG_V(3, zf, ALPHA * xr + (1.f + md[c]) * at); DBG_V(4, zf, a); { const float rf = ALPHA * xr + (1.f + md[c]) * a; ev[5] += zf * zf; rv[5] += rf * rf; } }
    dbg_acc(accf, base + 14, e, rr);
    if (l == 0) for (int i = 0; i < 6; ++i) dbg_acc(accf, 100 + i, ev[i], rv[i]);
    if (l == 0) { __shared__ float pe, pr2; if (t == 0) { pe = 0; pr2 = 0; } __syncthreads(); atomicAdd(&pe, e); atomicAdd(&pr2, rr); __syncthreads();
        if (t == 0) { atomicAdd(accf + 2 * 120, (pe / pr2 < 1e-3f) ? 1.f : 0.f); atomicAdd(accf + 2 * 120 + 1, 1.f); } }
    if (l == 0) for (int i = 0; i < 4; ++i) { const int c = t + 256 * i; float a = 0; for (int k = 0; k < D; ++k) a += mm[k] * p.w_out[((size_t)l * D + k) * D + c];
        const float zf = dbg_h((const u16*)(p.ws + WS_ZH), (size_t)row * D + c), rf = ALPHA * dbg_h((const u16*)(p.ws + WS_XR), (size_t)row * D + c) + (1.f + md[c]) * a;
        dbg_acc(accf, 110 + i, (zf - rf) * (zf - rf), rf * rf); }
}
__global__ void __launch_bounds__(256) dbg_fin(Params p) {
    float* accf = (float*)(p.ws + WS_DBGACC); const int t = threadIdx.x, row = dbg_row(blockIdx.x);
    float x[4]; for (int i = 0; i < 4; ++i) x[i] = dbg_h((const u16*)(p.ws + WS_ZH), (size_t)row * D + t + 256 * i);
    const float mean = dbg_block_sum(x[0] + x[1] + x[2] + x[3]) / D; float q = 0; for (int i = 0; i < 4; ++i) { x[i] -= mean; q += x[i] * x[i]; }
    const float rstd = 1.f / sqrtf(dbg_block_sum(q) / D + LN_EPS); float e = 0, rr = 0;
    for (int i = 0; i < 4; ++i) { const int c = t + 256 * i; DBG_E(p.out[(size_t)row * D + c], x[i] * rstd * p.ln_g[3 * D + c] + p.ln_b[3 * D + c]); }
    dbg_acc(accf, 68, e, rr);
}
#ifndef DBG_REPORT_ID
#define DBG_REPORT_ID -1
#endif
__global__ void __launch_bounds__(256) dbg_report(Params p) {
    const float* accf = (const float*)(p.ws + WS_DBGACC);
    float code = 1000.f;
    if (DBG_REPORT_ID == -3) { int bits = 0; for (int i = 0; i < 6; ++i) if (accf[2 * (110 + i)] / accf[2 * (110 + i) + 1] < 1e-3f) bits |= 1 << i; code = (float)(bits + 1) * 1e4f; }
    else if (DBG_REPORT_ID == -2) { float best = 1e30f; int bi = 0; for (int i = 100; i < 106; ++i) { const float q = accf[2 * i] / accf[2 * i + 1]; if (q < best) { best = q; bi = i; } } code = (float)(bi - 99) * 1e4f; }
    else if (DBG_REPORT_ID >= 0) { const float e = accf[2 * DBG_REPORT_ID], r = accf[2 * DBG_REPORT_ID + 1]; code = (r > 0.f ? e / r : 9.9f) * 1e12f; if (!(code > 100.f)) code = 100.f; }
    else for (int i = 0; i < 128; ++i) { const float e = accf[2 * i], r = accf[2 * i + 1]; const bool expected = i < 68 || i == 68;
        if ((r > 0.f && !(e / r < 1e-3f)) || (r == 0.f && (e > 0.f || expected)) || e != e || r != r) { code = (float)(i + 1) * 1e4f; break; } }
    const float S = sqrtf(code);
    for (size_t i = (size_t)blockIdx.x * 256 + threadIdx.x; i < (size_t)MP * D; i += (size_t)gridDim.x * 256) p.out[i] = S;
}
#endif

extern "C" void kernel_launch(void* const* d_in, const int* in_sizes, int n_in, void* d_out, int out_size, void* d_ws, size_t ws_size, hipStream_t stream) {
    static int grid = 0;
    if (grid == 0) {
        if (n_in != 21 || (size_t)out_size != OUT_TOTAL || ws_size < WS_END) { fprintf(stderr, "kernel_launch: unexpected shapes (n_in %d, out %d, ws %zu)\n", n_in, out_size, ws_size); grid = -1; return; }
        int dev = 0, cus = 0;
        if (hipGetDevice(&dev) != hipSuccess || hipDeviceGetAttribute(&cus, hipDeviceAttributeMultiprocessorCount, dev) != hipSuccess) { grid = -1; return; }
        if (hipFuncSetAttribute((const void*)hymba_fwd, hipFuncAttributeMaxDynamicSharedMemorySize, LDS_BYTES) != hipSuccess) { fprintf(stderr, "kernel_launch: hipFuncSetAttribute failed\n"); grid = -1; return; }
        (void)hipGetLastError();
        grid = cus;
    }
    if (grid < 0) return;
    (void)hipMemsetAsync((char*)d_ws + WS_CTL, 0, CTL_ZERO_BYTES, stream);
    Params a{};
    a.x_prompt = (const float*)d_in[0]; a.x_sample = (const float*)d_in[1]; a.cache_conv = (const float*)d_in[2]; a.cache_pool = (const float*)d_in[3];
    a.cache_k = (const float*)d_in[4]; a.cache_v = (const float*)d_in[5]; a.c_prompt = (const float*)d_in[6]; a.c_sample = (const float*)d_in[7];
    a.w_in = (const float*)d_in[8]; a.w_out = (const float*)d_in[9]; a.conv_w = (const float*)d_in[10]; a.conv_b = (const float*)d_in[11];
    a.cnorm_g = (const float*)d_in[12]; a.cnorm_b = (const float*)d_in[13]; a.pool_w = (const float*)d_in[14]; a.pool_scale = (const float*)d_in[15];
    a.sinks = (const float*)d_in[16]; a.w_mod = (const float*)d_in[17]; a.b_mod = (const float*)d_in[18]; a.ln_g = (const float*)d_in[19]; a.ln_b = (const float*)d_in[20];
    a.out = (float*)d_out; a.ws = (unsigned char*)d_ws;
    for (int i = 0; i < 32; ++i) a.inv_freq[i] = (float)std::pow(10000.0, -(double)i * (2.0 / 64.0));
    if (MK_N_LAUNCHES == 1) { a.ph_lo = 0; a.ph_hi = N_PHASES; hipLaunchKernelGGL(hymba_fwd, dim3(grid), dim3(NTHR), LDS_BYTES, stream, a); }
    else for (int ph = 0; ph < N_PHASES; ++ph) {
#ifdef DBG
        { const int l = (ph - 1) / 4, k = (ph - 1) % 4; if (ph >= 1 && ph < N_PHASES - 1 && k == 0 && l > 0) hipLaunchKernelGGL(dbg_copyz, dim3(DBG_NS), dim3(256), 0, stream, a); }
#endif
        a.ph_lo = ph; a.ph_hi = ph + 1; hipLaunchKernelGGL(hymba_fwd, dim3(grid), dim3(NTHR), LDS_BYTES, stream, a);
#ifdef DBG
        if (ph == 0) hipLaunchKernelGGL(dbg_p0, dim3(144), dim3(256), 0, stream, a);
        else if (ph == N_PHASES - 1) { hipLaunchKernelGGL(dbg_fin, dim3(DBG_NS), dim3(256), 0, stream, a); hipLaunchKernelGGL(dbg_report, dim3(1024), dim3(256), 0, stream, a); }
        else { const int l = (ph - 1) / 4, k = (ph - 1) % 4;
            if (k == 0) hipLaunchKernelGGL(dbg_ln, dim3(DBG_NS), dim3(256), 0, stream, a, l);
            if (k == 1) hipLaunchKernelGGL(dbg_in, dim3(DBG_NS), dim3(256), 0, stream, a, l);
            if (k == 2) hipLaunchKernelGGL(dbg_mix, dim3(DBG_NS), dim3(256), 0, stream, a, l);
            if (k == 3) hipLaunchKernelGGL(dbg_out, dim3(DBG_NS), dim3(256), 0, stream, a, l); }
#endif
    }
}
```

```cpp
#include <hip/hip_runtime.h>
#include <cstdint>
#include <cstdio>
#include <cmath>

#define DBG_REPORT_ID -1
#ifndef MK_N_LAUNCHES
#define MK_N_LAUNCHES 1
#endif

#define DI __device__ __forceinline__
#define GAS __attribute__((address_space(1)))
#define LAS __attribute__((address_space(3)))
typedef unsigned short u16;
typedef _Float16 h8 __attribute__((ext_vector_type(8)));
typedef _Float16 h4 __attribute__((ext_vector_type(4)));
typedef _Float16 h2 __attribute__((ext_vector_type(2)));
typedef float f32x2 __attribute__((ext_vector_type(2)));
typedef float f32x4 __attribute__((ext_vector_type(4)));
typedef float f32x16 __attribute__((ext_vector_type(16)));
typedef unsigned u32x4 __attribute__((ext_vector_type(4)));
typedef unsigned u32x2 __attribute__((ext_vector_type(2)));
typedef short v4i16_t __attribute__((ext_vector_type(4)));

constexpr int D = 1024, DIN = 2560, NB = 4, SEQ = 4096, DEPTH = 4, DB = 128, DS = 4;
constexpr int MP = NB * SEQ, MS = DB * DS, M = MP + MS;
constexpr int NMOD = NB + DB;
constexpr int PAST = 8192;
constexpr float LN_EPS = 1e-5f;
constexpr float ALPHA = 1.681792830507429f;
constexpr float LOG2E = 1.4426950408889634f;
constexpr float QSCALE = 0.125f * LOG2E;
constexpr size_t OFF_YP = 0, OFF_YS = OFF_YP + (size_t)MP * D, OFF_CONVP = OFF_YS + (size_t)MS * D, OFF_POOLP = OFF_CONVP + (size_t)DEPTH * NB * 30 * 256,
                 OFF_KP = OFF_POOLP + (size_t)DEPTH * NB * 15 * 256, OFF_VP = OFF_KP + (size_t)DEPTH * NB * 128 * 128, OFF_CONVS = OFF_VP + (size_t)DEPTH * NB * 128 * 128,
                 OFF_POOLS = OFF_CONVS + (size_t)DEPTH * DB * 30 * 256, OFF_KS = OFF_POOLS + (size_t)DEPTH * DB * 15 * 256, OFF_VS = OFF_KS + (size_t)DEPTH * DB * 128 * 128,
                 OUT_TOTAL = OFF_VS + (size_t)DEPTH * DB * 128 * 128;
constexpr size_t MiB = 1u << 20;
constexpr size_t WS_CTL = 0, CTL_ZERO_BYTES = 64 * 1024;
constexpr size_t WS_WIN = 1 * MiB;
constexpr size_t WS_WOUT = 21 * MiB;
constexpr size_t WS_MOD = 29 * MiB;
constexpr size_t WS_TAB = 36 * MiB;
constexpr size_t WS_ZH = 38 * MiB;
constexpr size_t WS_XR = 71 * MiB;
constexpr size_t WS_MIX = 104 * MiB;
constexpr size_t WS_PA = 137 * MiB;
constexpr size_t WS_PSZC = WS_PA + (size_t)M * 256 * 2, WS_PPV = WS_PSZC + (size_t)M * 256 * 2, WS_PSZP = WS_PPV + (size_t)M * 256 * 2;
constexpr size_t WS_PQ = WS_PSZP + (size_t)M * 256 * 2;
constexpr size_t WS_PSZA = WS_PQ + (size_t)M * 512 * 2;
constexpr size_t WS_PK = WS_PSZA + (size_t)M * 512 * 2;
constexpr size_t WS_PV = WS_PK + (size_t)M * 128 * 2;
constexpr size_t WS_H = WS_PV + (size_t)M * 128 * 2;
constexpr size_t WS_PS = WS_H + (size_t)M * D * 2;
constexpr size_t WS_RC0 = WS_PS + 2 * (size_t)MP * 24 * 4;
constexpr size_t WS_MODV = WS_RC0 + (size_t)MP * 16;
constexpr size_t WS_LNC = WS_MODV + (size_t)DEPTH * NB * 4 * DIN * 4;
constexpr size_t WS_END = WS_LNC + 256;
static_assert(WS_END <= 256 * MiB, "d_ws map");
constexpr int CW_BAR = 1024;
constexpr int CW_SCNT = 12288;

DI unsigned pkh(float a, float b) { f32x2 v = {a, b}; h2 r = __builtin_convertvector(v, h2); return __builtin_bit_cast(unsigned, r); }
DI u32x4 pack8(const float* v) { u32x4 w; w.x = pkh(v[0], v[1]); w.y = pkh(v[2], v[3]); w.z = pkh(v[4], v[5]); w.w = pkh(v[6], v[7]); return w; }
DI void unpack8(u32x4 w, float* o) {
    const h8 v = __builtin_bit_cast(h8, w);
#pragma unroll
    for (int j = 0; j < 8; ++j) o[j] = (float)v[j];
}
DI float ex2(float x) { return __builtin_amdgcn_exp2f(x); }
DI float sigm(float x) { return __builtin_amdgcn_rcpf(1.f + ex2(-x * LOG2E)); }
DI float silu(float x) { return x * sigm(x); }
DI float wave_sum(float v) {
#pragma unroll
    for (int o = 1; o < 64; o <<= 1) v += __shfl_xor(v, o);
    return v;
}
DI float wave_max(float v) {
#pragma unroll
    for (int o = 1; o < 64; o <<= 1) v = fmaxf(v, __shfl_xor(v, o));
    return v;
}
DI int crow(int r, int hi) { return (r & 3) + 8 * (r >> 2) + 4 * hi; }

__host__ __device__ __forceinline__ int pperm(int bj, int c7) { return 128 * bj + 32 * (c7 >> 5) + 16 * ((c7 >> 2) & 1) + 4 * ((c7 >> 3) & 3) + (c7 & 3); }
__host__ __device__ __forceinline__ int perm_in(int col) {
    if (col < 512) { const int bj = col >> 8, ch = col & 255; return 256 * (ch >> 7) + pperm(bj, ch & 127); }
    if (col < 1280) { const int base = col < 768 ? 512 : (col < 1024 ? 768 : 1024); const int x = col - base; return base + pperm(x >> 7, x & 127); }
    if (col < 1792) { const int x = col - 1280, head = x >> 6, d = x & 63; return 256 * (5 + (head >> 2)) + pperm(d >> 5, 32 * (head & 3) + (d & 31)); }
    if (col < 2048) { const int x = col - 1792, hh = x >> 6, d = x & 63; return 1792 + pperm(d >> 5, 32 * hh + (d & 31)); }
    { const int x = col - 2048; return 2048 + 256 * (x >> 8) + pperm((x >> 7) & 1, x & 127); }
}
__host__ __device__ __forceinline__ int perm_out(int col) { const int y = col & 255; return (col & ~255) + pperm(y >> 7, y & 127); }

namespace pg8 {
constexpr int BM = 256, BK = 64, HALF = 128, HTB = HALF * BK * 2, STAGE_BYTES = 8 * HTB, NXCD = 8, WGM = 8;
__host__ __device__ __forceinline__ int lds_byte(int r, int c) { const int st = (r >> 4) * 2 + (c >> 5), rr = r & 15, cc = c & 31, ob = rr * 64 + cc * 2; return st * 1024 + (ob ^ (((ob >> 9) & 1) << 5)); }
__host__ __device__ __forceinline__ void stage_rc(int b, int& R, int& C) { const int st = b / 1024, sb = b % 1024, swz = sb ^ (((sb >> 9) & 1) << 5); R = (st >> 1) * 16 + swz / 64; C = (st & 1) * 32 + (swz % 64) / 2; }
struct Unit { int pm, pn; };
struct Gemm { const u16* A; const u16* Bt; int M, N, K; };
struct StaticOrder {
    int nM, nN, nwg, G, c;
    __host__ __device__ void init(int M_, int N_, int G_, int c_) { nM = M_ / BM; nN = N_ / BM; nwg = nM * nN; G = G_; c = c_; }
    __host__ __device__ bool next(int i, Unit& u) const {
        const long L = (long)i * G + c; if (L >= nwg) return false;
        int wgid = (int)L; { const int q = nwg / NXCD, r = nwg % NXCD, xcd = wgid % NXCD, off = wgid / NXCD; wgid = (xcd < r ? xcd * (q + 1) : r * (q + 1) + (xcd - r) * q) + off; }
        const int nig = WGM * nN, gid = wgid / nig, fm = gid * WGM, gsz = (nM - fm) < WGM ? (nM - fm) : WGM;
        u.pm = fm + ((wgid % nig) % gsz); u.pn = (wgid % nig) / gsz; return true;
    }
};

template <class Epi, bool ALIGN_EPI>
DI void gemm_phase(LAS unsigned char* lds, const Gemm g, const StaticOrder& S, const Epi& E, const int tid) {
    const int wid = __builtin_amdgcn_readfirstlane(tid >> 6), lane = tid & 63, wr = wid >> 2, wc = wid & 3, fr = lane & 15, fq = lane >> 4;
    const int K = g.K, nt = K / BK;
    unsigned voffA[2];
#pragma unroll
    for (int i = 0; i < 2; ++i) { int R, C; stage_rc(tid * 16 + i * 8192, R, C); voffA[i] = (unsigned)(R * K + C) * 2u; }
    const size_t kstep = (size_t)(BK * 2);
    const size_t hstep = (size_t)HALF * K * 2;
    const size_t tstep = 2 * hstep;
    const unsigned ldsw = (unsigned)wid * 1024u;
    const int aoff = lds_byte(wr * 64 + fr, fq * 8), boff = lds_byte(wc * 32 + fr, fq * 8);
#define PG8_SA(b, h) (((b) * 2 + (h)) * HTB)
#define PG8_SB(b, h) ((4 + (b) * 2 + (h)) * HTB)
#define PG8_STAGE(bufoff, gbase) do { _Pragma("unroll") for (int _i = 0; _i < 2; ++_i) \
        __builtin_amdgcn_global_load_lds((const unsigned*)((const char*)(gbase) + voffA[_i]), (LAS unsigned*)(lds + (bufoff) + ldsw + _i * 8192), 16, 0, 0); } while (0)
#define PG8_LDA(dst, b, h) do { _Pragma("unroll") for (int m = 0; m < 4; ++m) _Pragma("unroll") for (int k = 0; k < 2; ++k) dst[m][k] = *(const LAS h8*)(lds + PG8_SA(b, h) + aoff + m * 2048 + k * 1024); } while (0)
#define PG8_LDB(dst, b, h) do { _Pragma("unroll") for (int n = 0; n < 2; ++n) _Pragma("unroll") for (int k = 0; k < 2; ++k) dst[n][k] = *(const LAS h8*)(lds + PG8_SB(b, h) + boff + n * 2048 + k * 1024); } while (0)
#define PG8_MMA(ai, bj, At, Bt) do { __builtin_amdgcn_s_setprio(1); _Pragma("unroll") for (int m = 0; m < 4; ++m) _Pragma("unroll") for (int n = 0; n < 2; ++n) _Pragma("unroll") for (int k = 0; k < 2; ++k) \
        acc[ai][bj][m][n] = __builtin_amdgcn_mfma_f32_16x16x32_f16(Bt[n][k], At[m][k], acc[ai][bj][m][n], 0, 0, 0); __builtin_amdgcn_s_setprio(0); } while (0)
#define PG8_WAIT_V(n) asm volatile("s_waitcnt vmcnt(" #n ")" ::: "memory")
#define PG8_WAIT_L(n) asm volatile("s_waitcnt lgkmcnt(" #n ")" ::: "memory")
#define PG8_BAR __builtin_amdgcn_s_barrier()
#define PG8_SCHED __builtin_amdgcn_sched_barrier(0)
    Unit cur, nxt; int ui = 0;
    if (!S.next(0, cur)) return;
    f32x4 acc[2][2][4][2];
#pragma unroll
    for (int a = 0; a < 2; ++a)
#pragma unroll
        for (int b = 0; b < 2; ++b)
#pragma unroll
            for (int m = 0; m < 4; ++m)
#pragma unroll
                for (int n = 0; n < 2; ++n) acc[a][b][m][n] = (f32x4){0.f, 0.f, 0.f, 0.f};
    h8 At[4][2], B0[2][2], B1[2][2];
    const char* cA = (const char*)g.A + (size_t)cur.pm * tstep; const char* cB = (const char*)g.Bt + (size_t)cur.pn * tstep;
    PG8_STAGE(PG8_SB(0, 0), cB); PG8_STAGE(PG8_SB(0, 1), cB + hstep); PG8_STAGE(PG8_SA(0, 0), cA); PG8_STAGE(PG8_SA(0, 1), cA + hstep);
    if (wr == 1) PG8_BAR;
    PG8_WAIT_V(2); PG8_BAR;
    PG8_STAGE(PG8_SB(1, 0), cB + kstep); PG8_STAGE(PG8_SA(1, 0), cA + kstep); PG8_STAGE(PG8_SB(1, 1), cB + hstep + kstep);
    PG8_WAIT_V(6); PG8_BAR;
    for (;;) {
        const bool has_next = S.next(ui + 1, nxt);
        const char* nA = has_next ? (const char*)g.A + (size_t)nxt.pm * tstep : cA; const char* nB = has_next ? (const char*)g.Bt + (size_t)nxt.pn * tstep : cB;
        for (int t = 0; t < nt; t += 2) {
            const bool last = (t == nt - 2);
            const char* a1 = cA + (size_t)(t + 1) * kstep;
            const char* a2 = last ? nA : cA + (size_t)(t + 2) * kstep; const char* b2 = last ? nB : cB + (size_t)(t + 2) * kstep;
            const char* a3 = a2 + kstep; const char* b3 = b2 + kstep;
            PG8_LDB(B0, 0, 0); PG8_LDB(B1, 0, 1); PG8_SCHED; PG8_LDA(At, 0, 0); PG8_STAGE(PG8_SA(1, 1), a1 + hstep);
            PG8_WAIT_V(8); PG8_WAIT_L(0); PG8_BAR; PG8_MMA(0, 0, At, B0); PG8_MMA(0, 1, At, B1); PG8_BAR; PG8_SCHED;
            PG8_LDA(At, 0, 1); PG8_STAGE(PG8_SB(0, 0), b2); PG8_STAGE(PG8_SB(0, 1), b2 + hstep); PG8_STAGE(PG8_SA(0, 0), a2);
            PG8_WAIT_V(8); PG8_WAIT_L(0); PG8_BAR; PG8_MMA(1, 0, At, B0); PG8_MMA(1, 1, At, B1); PG8_BAR; PG8_SCHED;
            PG8_LDB(B0, 1, 0); PG8_LDB(B1, 1, 1); PG8_SCHED; PG8_LDA(At, 1, 0); PG8_STAGE(PG8_SA(0, 1), a2 + hstep);
            PG8_WAIT_V(8); PG8_WAIT_L(0); PG8_BAR; PG8_MMA(0, 0, At, B0); PG8_MMA(0, 1, At, B1); PG8_BAR; PG8_SCHED;
            PG8_LDA(At, 1, 1); PG8_STAGE(PG8_SB(1, 0), b3); PG8_STAGE(PG8_SB(1, 1), b3 + hstep); PG8_STAGE(PG8_SA(1, 0), a3);
            PG8_WAIT_V(8); PG8_WAIT_L(0); PG8_BAR; PG8_MMA(1, 0, At, B0); PG8_MMA(1, 1, At, B1); PG8_BAR; PG8_SCHED;
        }
        if constexpr (ALIGN_EPI) { if (wr == 0) PG8_BAR; }
        if constexpr (!Epi::AFTER_DRAIN) E(acc, cur, ui, wr, wc, fr, fq);
        if (!has_next) break;
#pragma unroll
        for (int a = 0; a < 2; ++a)
#pragma unroll
            for (int b = 0; b < 2; ++b)
#pragma unroll
                for (int m = 0; m < 4; ++m)
#pragma unroll
                    for (int n = 0; n < 2; ++n) acc[a][b][m][n] = (f32x4){0.f, 0.f, 0.f, 0.f};
        cur = nxt; cA = nA; cB = nB; ++ui;
        if constexpr (ALIGN_EPI) { if (wr == 1) PG8_BAR; }
    }
    PG8_WAIT_V(0);
    if constexpr (!ALIGN_EPI) { if (wr == 0) PG8_BAR; }
    PG8_BAR;
    if constexpr (Epi::AFTER_DRAIN) E.fused(acc, cur, wr, wc, fr, fq, lds, tid);
#undef PG8_SA
#undef PG8_SB
#undef PG8_STAGE
#undef PG8_LDA
#undef PG8_LDB
#undef PG8_MMA
#undef PG8_WAIT_V
#undef PG8_WAIT_L
#undef PG8_BAR
#undef PG8_SCHED
}
}

struct Params {
    const float* x_prompt; const float* x_sample; const float* cache_conv; const float* cache_pool; const float* cache_k; const float* cache_v;
    const float* c_prompt; const float* c_sample; const float* w_in; const float* w_out; const float* conv_w; const float* conv_b; const float* cnorm_g; const float* cnorm_b;
    const float* pool_w; const float* pool_scale; const float* sinks; const float* w_mod; const float* b_mod; const float* ln_g; const float* ln_b;
    float* out; unsigned char* ws;
    int ph_lo, ph_hi;
    float inv_freq[32];
};
struct ParamsHead { const float* ptrs[21]; float* out; unsigned char* ws; int ph_lo, ph_hi; };

DI void row_info(int row, bool& smp, int& b, int& t) { smp = row >= MP; if (!smp) { b = row >> 12; t = row & (SEQ - 1); } else { const int s = row - MP; b = s >> 2; t = s & 3; } }
DI void st8f(float* dst, const float* v) { *(f32x4*)dst = (f32x4){v[0], v[1], v[2], v[3]}; *(f32x4*)(dst + 4) = (f32x4){v[4], v[5], v[6], v[7]}; }

struct EpiIn {
    static constexpr bool AFTER_DRAIN = false;
    int l; unsigned char* ws; float* out; const LAS float* rcl;
    DI void operator()(f32x4 (&acc)[2][2][4][2], const pg8::Unit& u, int ui, int wr, int wc, int fr, int fq) const {
        asm volatile("" : "+v"(fr), "+v"(fq));
        const int pn = u.pn;
        if (u.pm < MP / 256) {
            const LAS f32x4* rc = (const LAS f32x4*)rcl + ui * 256 + wr * 64 + fr;
            const float* mv = (const float*)(ws + WS_MODV) + (size_t)(l * NB + (u.pm >> 4)) * 4 * DIN + pn * 256 + wc * 32 + 4 * fq;
#pragma unroll
            for (int bj = 0; bj < 2; ++bj)
#pragma unroll
                for (int n = 0; n < 2; ++n) { const float* mp = mv + 128 * bj + 16 * n;
                    const f32x4 v1 = *(const f32x4*)mp, v2 = *(const f32x4*)(mp + DIN), v3 = *(const f32x4*)(mp + 2 * DIN), v4 = *(const f32x4*)(mp + 3 * DIN);
#pragma unroll
                    for (int ai = 0; ai < 2; ++ai)
#pragma unroll
                        for (int m = 0; m < 4; ++m) { const f32x4 r = rc[ai * 128 + m * 16];
                            acc[ai][bj][m][n] = r[0] * acc[ai][bj][m][n] - r[1] * v1 + r[2] * v2 - r[3] * v3 + v4; } }
        }
        u16* const PA = (u16*)(ws + WS_PA); u16* const PSZC = (u16*)(ws + WS_PSZC); u16* const PPV = (u16*)(ws + WS_PPV); u16* const PSZP = (u16*)(ws + WS_PSZP);
        u16* const PQ = (u16*)(ws + WS_PQ); u16* const PSZA = (u16*)(ws + WS_PSZA); u16* const PK = (u16*)(ws + WS_PK); u16* const PV = (u16*)(ws + WS_PV); const f32x2* const tab = (const f32x2*)(ws + WS_TAB);
#pragma unroll
        for (int ai = 0; ai < 2; ++ai)
#pragma unroll
            for (int m = 0; m < 4; ++m) {
                const int row = u.pm * 256 + ai * 128 + wr * 64 + m * 16 + fr;
                bool smp; int b, t; row_info(row, smp, b, t);
                if (pn < 2) {
                    const int c8 = pn * 128 + wc * 32 + fq * 8; float a[8];
#pragma unroll
                    for (int n = 0; n < 2; ++n)
#pragma unroll
                        for (int j = 0; j < 4; ++j) a[4 * n + j] = acc[ai][0][m][n][j] * sigm(acc[ai][1][m][n][j]);
                    *(u32x4*)(PA + (size_t)row * 256 + c8) = pack8(a);
                    if (smp) st8f(out + OFF_CONVS + ((size_t)(l * DB + b) * 30 + 26 + t) * 256 + c8, a);
                    else if (t >= SEQ - 30) st8f(out + OFF_CONVP + ((size_t)(l * NB + b) * 30 + (t - (SEQ - 30))) * 256 + c8, a);
                } else if (pn == 2 || pn == 4) {
                    u16* P = pn == 2 ? PSZC : PSZP;
#pragma unroll
                    for (int bj = 0; bj < 2; ++bj) { const int c8 = bj * 128 + wc * 32 + fq * 8; float v[8];
#pragma unroll
                        for (int n = 0; n < 2; ++n)
#pragma unroll
                            for (int j = 0; j < 4; ++j) v[4 * n + j] = silu(acc[ai][bj][m][n][j]);
                        *(u32x4*)(P + (size_t)row * 256 + c8) = pack8(v); }
                } else if (pn == 3) {
#pragma unroll
                    for (int bj = 0; bj < 2; ++bj) { const int c8 = bj * 128 + wc * 32 + fq * 8; float v[8];
#pragma unroll
                        for (int n = 0; n < 2; ++n)
#pragma unroll
                            for (int j = 0; j < 4; ++j) v[4 * n + j] = acc[ai][bj][m][n][j];
                        *(u32x4*)(PPV + (size_t)row * 256 + c8) = pack8(v);
                        if (smp) st8f(out + OFF_POOLS + ((size_t)(l * DB + b) * 15 + 11 + t) * 256 + c8, v);
                        else if (t >= SEQ - 15) st8f(out + OFF_POOLP + ((size_t)(l * NB + b) * 15 + (t - (SEQ - 15))) * 256 + c8, v); }
                } else if (pn >= 8) {
#pragma unroll
                    for (int bj = 0; bj < 2; ++bj) { const int c8 = (pn - 8) * 256 + bj * 128 + wc * 32 + fq * 8; float v[8];
#pragma unroll
                        for (int n = 0; n < 2; ++n)
#pragma unroll
                            for (int j = 0; j < 4; ++j) v[4 * n + j] = silu(acc[ai][bj][m][n][j]);
                        *(u32x4*)(PSZA + (size_t)row * 512 + c8) = pack8(v); }
                } else if (pn == 7 && wc >= 2) {
                    const int hv = wc - 2;
#pragma unroll
                    for (int bj = 0; bj < 2; ++bj) { const int d8 = 32 * bj + 8 * fq; float v[8];
#pragma unroll
                        for (int n = 0; n < 2; ++n)
#pragma unroll
                            for (int j = 0; j < 4; ++j) v[4 * n + j] = acc[ai][bj][m][n][j];
                        *(u32x4*)(PV + (size_t)row * 128 + hv * 64 + d8) = pack8(v);
                        if (smp) st8f(out + OFF_VS + (((size_t)(l * DB + b) * 128 + 124 + t) * 2 + hv) * 64 + d8, v);
                        else if (t >= SEQ - 128) st8f(out + OFF_VP + (((size_t)(l * NB + b) * 128 + (t - (SEQ - 128))) * 2 + hv) * 64 + d8, v); }
                } else {
                    const int d8 = 8 * fq; const int pidx = smp ? SEQ + t : t;
                    const f32x4* tp = (const f32x4*)(tab + (size_t)pidx * 32 + d8);
                    float x1[8], x2[8], o1[8], o2[8];
#pragma unroll
                    for (int n = 0; n < 2; ++n)
#pragma unroll
                        for (int j = 0; j < 4; ++j) { x1[4 * n + j] = acc[ai][0][m][n][j]; x2[4 * n + j] = acc[ai][1][m][n][j]; }
                    const float sc = pn == 7 ? 1.f : QSCALE;
#pragma unroll
                    for (int k2 = 0; k2 < 4; ++k2) { const f32x4 cs = tp[k2];
                        o1[2 * k2] = (x1[2 * k2] * cs[0] - x2[2 * k2] * cs[1]) * sc;         o2[2 * k2] = (x2[2 * k2] * cs[0] + x1[2 * k2] * cs[1]) * sc;
                        o1[2 * k2 + 1] = (x1[2 * k2 + 1] * cs[2] - x2[2 * k2 + 1] * cs[3]) * sc; o2[2 * k2 + 1] = (x2[2 * k2 + 1] * cs[2] + x1[2 * k2 + 1] * cs[3]) * sc; }
                    if (pn == 7) { const int hk = wc;
                        *(u32x4*)(PK + (size_t)row * 128 + hk * 64 + d8) = pack8(o1); *(u32x4*)(PK + (size_t)row * 128 + hk * 64 + 32 + d8) = pack8(o2);
                        float* dst = nullptr;
                        if (smp) dst = out + OFF_KS + (((size_t)(l * DB + b) * 128 + 124 + t) * 2 + hk) * 64 + d8;
                        else if (t >= SEQ - 128) dst = out + OFF_KP + (((size_t)(l * NB + b) * 128 + (t - (SEQ - 128))) * 2 + hk) * 64 + d8;
                        if (dst) { st8f(dst, o1); st8f(dst + 32, o2); }
                    } else { const int head = (pn - 5) * 4 + wc;
                        *(u32x4*)(PQ + (size_t)row * 512 + head * 64 + d8) = pack8(o1); *(u32x4*)(PQ + (size_t)row * 512 + head * 64 + 32 + d8) = pack8(o2); }
                }
            }
    }
};

struct EpiOutF {
    static constexpr bool AFTER_DRAIN = true;
    unsigned char* ws; int l; const float* ln_g; const float* ln_b;
    DI void operator()(f32x4 (&)[2][2][4][2], const pg8::Unit&, int, int, int, int, int) const {}
    DI void fused(f32x4 (&acc)[2][2][4][2], const pg8::Unit& u, int wr, int wc, int fr, int fq, LAS unsigned char* lds, int tid) const {
        LAS float* CV = (LAS float*)lds;
        LAS float* RS = (LAS float*)(lds + 8192);
        LAS float* PW = (LAS float*)(lds + 12288);
        u16* ZH = (u16*)(ws + WS_ZH); u16* ZP = (u16*)(ws + WS_H);
        const float* MOD = (const float*)(ws + WS_MOD); const int b = u.pm >> 4;
        const float* PSp = (const float*)(ws + WS_PS) + (size_t)((l + 1) & 1) * MP * 24; float* PSc = (float*)(ws + WS_PS) + (size_t)(l & 1) * MP * 24;
        if (tid < 256) { const int col = u.pn * 256 + tid;
            CV[tid] = l > 0 ? ln_g[(l - 1) * D + col] : 1.f; CV[256 + tid] = l > 0 ? ln_b[(l - 1) * D + col] : 0.f;
            CV[512 + tid] = MOD[((size_t)l * NMOD + b) * 3072 + 2048 + col]; CV[768 + tid] = ln_g[l * D + col]; CV[1024 + tid] = ln_b[l * D + col];
            CV[1280 + tid] = l < DEPTH - 1 ? MOD[((size_t)(l + 1) * NMOD + b) * 3072 + 1024 + col] : 0.f;
        } else { const int row = tid - 256; float mu = 0.f, rstd = 1.f;
            if (l > 0) { const float* ps = PSp + (size_t)(u.pm * 256 + row) * 24; const float s1 = (ps[0] + ps[6]) + (ps[12] + ps[18]), s2 = (ps[1] + ps[7]) + (ps[13] + ps[19]);
                mu = s1 * (1.f / D); rstd = 1.f / sqrtf(s2 * (1.f / D) - mu * mu + LN_EPS); }
            RS[2 * row] = mu; RS[2 * row + 1] = rstd; }
        __syncthreads();
#pragma unroll
        for (int am2 = 0; am2 < 4; ++am2) { const int ai = am2 >> 1;
        u32x4 zpv[2][2];
#pragma unroll
        for (int mm = 0; mm < 2; ++mm)
#pragma unroll
            for (int bj = 0; bj < 2; ++bj) zpv[mm][bj] = *(const u32x4*)(ZH + ((size_t)u.pm * 256 + ai * 128 + wr * 64 + ((am2 & 1) * 2 + mm) * 16 + fr) * D + u.pn * 256 + bj * 128 + wc * 32 + fq * 8);
#pragma unroll
        for (int mm = 0; mm < 2; ++mm) { const int m = (am2 & 1) * 2 + mm;
            const int rt = ai * 128 + wr * 64 + m * 16 + fr; const size_t row = (size_t)u.pm * 256 + rt;
            const float mu = RS[2 * rt], rstd = RS[2 * rt + 1];
            float s1 = 0.f, s2 = 0.f, s3 = 0.f, s4 = 0.f, s5 = 0.f, s6 = 0.f;
#pragma unroll
            for (int bj = 0; bj < 2; ++bj) { const int cl = bj * 128 + wc * 32 + fq * 8; const size_t off = row * D + u.pn * 256 + cl;
                float zp[8], zq[8], zo[8]; unpack8(zpv[mm][bj], zp);
#pragma unroll
                for (int hh = 0; hh < 2; ++hh) {
                    const f32x4 gp = *(const LAS f32x4*)(CV + cl + 4 * hh), bp = *(const LAS f32x4*)(CV + 256 + cl + 4 * hh), gt = *(const LAS f32x4*)(CV + 512 + cl + 4 * hh),
                                gg = *(const LAS f32x4*)(CV + 768 + cl + 4 * hh), bb = *(const LAS f32x4*)(CV + 1024 + cl + 4 * hh), sn = *(const LAS f32x4*)(CV + 1280 + cl + 4 * hh);
                    const f32x4 av = acc[ai][bj][m][hh];
#pragma unroll
                    for (int j = 0; j < 4; ++j) { const int k = 4 * hh + j;
                        const float x1 = l > 0 ? (zp[k] - mu) * rstd * gp[j] + bp[j] : zp[k];
                        const float z = ALPHA * x1 + (1.f + gt[j]) * av[j], uu = z * gg[j];
                        s1 += z; s2 += z * z; s3 += uu; s4 += uu * uu; s5 += uu * gg[j]; s6 += uu * bb[j];
                        zq[k] = z; zo[k] = uu * (1.f + sn[j]); } }
                *(u32x4*)(ZH + off) = pack8(zq);
                if (l < DEPTH - 1) *(u32x4*)(ZP + off) = pack8(zo); }
            s1 += __shfl_xor(s1, 16); s2 += __shfl_xor(s2, 16); s3 += __shfl_xor(s3, 16); s4 += __shfl_xor(s4, 16); s5 += __shfl_xor(s5, 16); s6 += __shfl_xor(s6, 16);
            s1 += __shfl_xor(s1, 32); s2 += __shfl_xor(s2, 32); s3 += __shfl_xor(s3, 32); s4 += __shfl_xor(s4, 32); s5 += __shfl_xor(s5, 32); s6 += __shfl_xor(s6, 32);
            if (fq == 0) { LAS float* pw = PW + (rt * 4 + wc) * 6; pw[0] = s1; pw[1] = s2; pw[2] = s3; pw[3] = s4; pw[4] = s5; pw[5] = s6; } }
        asm volatile("" ::: "memory"); }
        __syncthreads();
        if (tid < 256 && l < DEPTH - 1) { float* ps = PSc + (size_t)(u.pm * 256 + tid) * 24 + u.pn * 6; const LAS float* pw = PW + tid * 24;
#pragma unroll
            for (int k = 0; k < 6; ++k) ps[k] = (pw[k] + pw[6 + k]) + (pw[12 + k] + pw[18 + k]); }
    }
};

#define XB_TMO      128
#define XB_XCNT(j)  (256  + 64 * (j))
#define XB_XSUB(j)  (1280 + 64 * (j))
#define XB_XGEN(j)  (2304 + 64 * (j))
#define XB_TOP      3328
#define XB_TOPGEN   3392
#define XCD_BAR_WORDS 3456
#define XB_SPIN_CAP (1u << 18)
DI unsigned xb_ld(unsigned* p)              { return __hip_atomic_load(p, __ATOMIC_RELAXED, __HIP_MEMORY_SCOPE_AGENT); }
DI unsigned xb_add(unsigned* p, unsigned v) { return __hip_atomic_fetch_add(p, v, __ATOMIC_RELAXED, __HIP_MEMORY_SCOPE_AGENT); }
DI unsigned xb_xcc_id() { return (unsigned)__builtin_amdgcn_s_getreg((3 << 11) | 20) & 0xFu; }
#define XB_SPIN(cond, bar) do { unsigned _sp = 0; while (cond) { __builtin_amdgcn_s_sleep(1); \
    if ((++_sp & 255u) == 0u) { if (xb_ld(&(bar)[XB_TMO])) break; if (_sp > XB_SPIN_CAP) { atomicAdd(&(bar)[XB_TMO], 1u); break; } } } } while (0)
struct XcdBarrier { unsigned* bar; unsigned x; volatile LAS unsigned* st; };
DI XcdBarrier xcd_barrier_post(unsigned* bar, volatile LAS unsigned* st) {
    XcdBarrier b; b.bar = bar; b.x = xb_xcc_id(); b.st = st;
    if (threadIdx.x == 0) (void)xb_add(&bar[XB_XCNT(b.x)], 1u);
    return b;
}
DI void xcd_barrier_complete(unsigned* bar, unsigned x, unsigned& nloc, unsigned& nx) {
    const unsigned G = gridDim.x * gridDim.y * gridDim.z;
    unsigned sum, cnt, mine, sp = 0u;
    for (;;) {
        sum = 0u; cnt = 0u; mine = 0u;
#pragma unroll
        for (unsigned j = 0; j < 16; ++j) { const unsigned c = xb_ld(&bar[XB_XCNT(j)]); sum += c; cnt += (c > 0u) ? 1u : 0u; mine = (j == x) ? c : mine; }
        if (sum == G) break;
        __builtin_amdgcn_s_sleep(1);
        if ((++sp & 255u) == 0u) { if (xb_ld(&bar[XB_TMO])) break; if (sp > XB_SPIN_CAP) { atomicAdd(&bar[XB_TMO], 1u); break; } }
    }
    nloc = mine > 0u ? mine : 1u; nx = cnt > 0u ? cnt : 1u;
}
DI void xcd_barrier(const XcdBarrier& b) {
    asm volatile("s_waitcnt vmcnt(0)" ::: "memory");
    __syncthreads();
    if (threadIdx.x == 0) {
        unsigned* bar = b.bar;
        __builtin_amdgcn_s_waitcnt(0);
        unsigned nloc = b.st[0], nx = b.st[1];
        if (nloc == 0u) { xcd_barrier_complete(bar, b.x, nloc, nx); b.st[0] = nloc; b.st[1] = nx; }
        const unsigned old = xb_add(&bar[XB_XSUB(b.x)], 1u);
        const unsigned gen = old / nloc;
        if (old + 1u == (gen + 1u) * nloc) {
            __builtin_amdgcn_fence(__ATOMIC_RELEASE, "agent");
            asm volatile("s_waitcnt vmcnt(0)" ::: "memory");
            const unsigned og = xb_add(&bar[XB_TOP], 1u);
            const unsigned tg = og / nx;
            if (og + 1u == (tg + 1u) * nx) xb_add(&bar[XB_TOPGEN], 1u);
            else XB_SPIN(xb_ld(&bar[XB_TOPGEN]) == tg, bar);
            __builtin_amdgcn_fence(__ATOMIC_ACQUIRE, "agent");
            xb_add(&bar[XB_XGEN(b.x)], 1u);
            asm volatile("s_waitcnt vmcnt(0)" ::: "memory");
        } else {
            XB_SPIN(xb_ld(&bar[XB_XGEN(b.x)]) == gen, bar);
            __builtin_amdgcn_fence(__ATOMIC_ACQUIRE, "agent");
            asm volatile("s_waitcnt vmcnt(0)" ::: "memory");
        }
    }
    __syncthreads();
}

constexpr int NWAVES = 8, NTHR = 512;
constexpr int LDS_BYTES = 147456;
constexpr int RING_BYTES = 131072, MISC_OFF = RING_BYTES + 320;

DI void p0_transpose_item(const float* W, int K, int N, u16* WT, LAS float* scr, int item, int lane, bool isin) {
    const int nblk = N / 32, kb = item / nblk, nb = item % nblk, k0 = 64 * kb, n0 = 32 * nb;
#pragma unroll 8
    for (int i = 0; i < 32; ++i) { const int kk = 2 * i + (lane >> 5); scr[kk * 33 + (lane & 31)] = W[(size_t)(k0 + kk) * N + n0 + (lane & 31)]; }
    asm volatile("s_waitcnt lgkmcnt(0)" ::: "memory");
    const int c = lane & 7;
#pragma unroll
    for (int j = 0; j < 4; ++j) { const int n = (lane >> 3) + 8 * j; const LAS float* s = scr + (8 * c) * 33 + n;
        u32x4 o; o.x = pkh(s[0 * 33], s[1 * 33]); o.y = pkh(s[2 * 33], s[3 * 33]); o.z = pkh(s[4 * 33], s[5 * 33]); o.w = pkh(s[6 * 33], s[7 * 33]);
        const int dst = isin ? perm_in(n0 + n) : perm_out(n0 + n);
        *(u32x4*)(WT + (size_t)dst * K + k0 + 8 * c) = o; }
    asm volatile("s_waitcnt lgkmcnt(0)" ::: "memory");
}
DI void mod_unit(const Params& p, LAS unsigned char* lds, int unit, int tid, int lane, int wave) {
    const int l = unit >> 6, n0 = (unit & 63) * 48;
    const float* W = p.w_mod + (size_t)l * D * 3072;
    float* MOD = (float*)(p.ws + WS_MOD);
    const int fr = lane & 15, fq = lane >> 4;
    f32x4 acc[9][3];
#pragma unroll
    for (int rt = 0; rt < 9; ++rt)
#pragma unroll
        for (int ct = 0; ct < 3; ++ct) acc[rt][ct] = (f32x4){0.f, 0.f, 0.f, 0.f};
    for (int ks = 0; ks < 4; ++ks) {
        const int k0 = wave * 128 + ks * 32 + fq * 8;
        h8 bfr[3];
#pragma unroll
        for (int ct = 0; ct < 3; ++ct) { const float* wp = W + (size_t)k0 * 3072 + n0 + 16 * ct + fr;
#pragma unroll
            for (int j = 0; j < 8; ++j) bfr[ct][j] = (_Float16)wp[(size_t)j * 3072]; }
#pragma unroll
        for (int rt = 0; rt < 9; ++rt) { const int row = 16 * rt + fr; h8 a;
            if (row < NMOD) { const float* c = row < NB ? p.c_prompt + (size_t)row * D : p.c_sample + (size_t)(row - NB) * D;
                const f32x4 c0 = *(const f32x4*)(c + k0), c1 = *(const f32x4*)(c + k0 + 4);
#pragma unroll
                for (int j = 0; j < 4; ++j) { a[j] = (_Float16)silu(c0[j]); a[4 + j] = (_Float16)silu(c1[j]); } }
            else {
#pragma unroll
                for (int j = 0; j < 8; ++j) a[j] = (_Float16)0.f; }
#pragma unroll
            for (int ct = 0; ct < 3; ++ct) acc[rt][ct] = __builtin_amdgcn_mfma_f32_16x16x32_f16(a, bfr[ct], acc[rt][ct], 0, 0, 0); }
    }
    LAS float* part = (LAS float*)lds;
#pragma unroll
    for (int rg = 0; rg < 3; ++rg) {
        __syncthreads();
#pragma unroll
        for (int r3 = 0; r3 < 3; ++r3)
#pragma unroll
            for (int ct = 0; ct < 3; ++ct)
#pragma unroll
                for (int i = 0; i < 4; ++i) part[(wave * 48 + r3 * 16 + 4 * fq + i) * 48 + 16 * ct + fr] = acc[rg * 3 + r3][ct][i];
        __syncthreads();
        for (int o = tid; o < 48 * 48; o += NTHR) { const int r48 = o / 48, col = o % 48, row = 48 * rg + r48; float sacc = 0.f;
#pragma unroll
            for (int w = 0; w < 8; ++w) sacc += part[(w * 48 + r48) * 48 + col];
            if (row < NMOD) MOD[((size_t)l * NMOD + row) * 3072 + n0 + col] = sacc + p.b_mod[(size_t)l * 3072 + n0 + col]; }
    }
    __syncthreads();
}
DI void sincos_d(double a, float& c, float& s) {
    const double k = __builtin_rint(a * 0.63661977236758134308);
    const double r = __builtin_fma(-k, 1.2246467991473532e-16 * 0.5, __builtin_fma(-k, 1.5707963267948966, a));
    const double r2 = r * r;
    double sp = -1.0 / 6227020800.0; sp = sp * r2 + 1.0 / 39916800.0; sp = sp * r2 - 1.0 / 362880.0; sp = sp * r2 + 1.0 / 5040.0; sp = sp * r2 - 1.0 / 120.0; sp = sp * r2 + 1.0 / 6.0;
    const double sn = r - r * r2 * sp;
    double cp = 1.0 / 87178291200.0; cp = cp * r2 - 1.0 / 479001600.0; cp = cp * r2 + 1.0 / 3628800.0; cp = cp * r2 - 1.0 / 40320.0; cp = cp * r2 + 1.0 / 720.0; cp = cp * r2 - 1.0 / 24.0; cp = cp * r2 + 0.5;
    const double cn = 1.0 - r2 * cp;
    const long long q = (long long)k & 3;
    const double cc = (q == 0) ? cn : (q == 1) ? -sn : (q == 2) ? -cn : sn;
    const double ss = (q == 0) ? sn : (q == 1) ? cn : (q == 2) ? -sn : -cn;
    c = (float)cc; s = (float)ss;
}
DI void p0_prologue(const Params& p, const __attribute__((address_space(4))) float* invf, LAS unsigned char* lds, int vcu, int G, int tid, int lane, int wave) {
    for (int u = vcu; u < 256; u += G) mod_unit(p, lds, u, tid, lane, wave);
    LAS float* scr = (LAS float*)(lds + wave * 16384);
    const int gw = vcu * NWAVES + wave, NGW = G * NWAVES;
    constexpr int I_IN = (D / 64) * (DIN / 32), I_OUT = (D / 64) * (D / 32);
    for (int it = gw; it < DEPTH * (I_IN + I_OUT); it += NGW) {
        const int l = it / (I_IN + I_OUT), r = it % (I_IN + I_OUT);
        if (r < I_IN) p0_transpose_item(p.w_in + (size_t)l * D * DIN, D, DIN, (u16*)(p.ws + WS_WIN) + (size_t)l * DIN * D, scr, r, lane, true);
        else p0_transpose_item(p.w_out + (size_t)l * D * D, D, D, (u16*)(p.ws + WS_WOUT) + (size_t)l * D * D, scr, r - I_IN, lane, false);
    }
    if (vcu == 0 && wave < DEPTH) {
        float a = 0.f, b2 = 0.f, c2 = 0.f, d = 0.f, e = 0.f;
        for (int c = lane; c < D; c += 64) { const float g = p.ln_g[wave * D + c], bb = p.ln_b[wave * D + c]; a += g; b2 += g * g; c2 += g * bb; d += bb; e += bb * bb; }
        a = wave_sum(a); b2 = wave_sum(b2); c2 = wave_sum(c2); d = wave_sum(d); e = wave_sum(e);
        if (lane == 0) { float* o = (float*)(p.ws + WS_LNC) + wave * 8; o[0] = a; o[1] = b2; o[2] = c2; o[3] = d; o[4] = e; } }
    f32x2* tab = (f32x2*)(p.ws + WS_TAB);
    for (int e = vcu * NTHR + tid; e < (SEQ + DS) * 32; e += G * NTHR) {
        const int pi = e >> 5, i = e & 31; const int pos = pi < SEQ ? pi : PAST + (pi - SEQ);
        const float ang = (float)pos * invf[i];
        float c, s; sincos_d((double)ang, c, s);
        tab[e] = (f32x2){c, s};
    }
}

template <int R>
DI void ln_stats(float (&v)[R][16], float (&mean)[R], float (&rstd)[R]) {
    float s[R];
#pragma unroll
    for (int r = 0; r < R; ++r) { s[r] = 0.f;
#pragma unroll
        for (int k = 0; k < 16; ++k) s[r] += v[r][k]; }
#pragma unroll
    for (int o = 1; o < 64; o <<= 1)
#pragma unroll
        for (int r = 0; r < R; ++r) s[r] += __shfl_xor(s[r], o);
#pragma unroll
    for (int r = 0; r < R; ++r) { mean[r] = s[r] * (1.f / D); s[r] = 0.f;
#pragma unroll
        for (int k = 0; k < 16; ++k) { v[r][k] -= mean[r]; s[r] += v[r][k] * v[r][k]; } }
#pragma unroll
    for (int o = 1; o < 64; o <<= 1)
#pragma unroll
        for (int r = 0; r < R; ++r) s[r] += __shfl_xor(s[r], o);
#pragma unroll
    for (int r = 0; r < R; ++r) rstd[r] = 1.f / sqrtf(s[r] * (1.f / D) + LN_EPS);
}
constexpr int LNR = 3;
DI void pre_phase(const Params& p, int gw, int NGW, int lane) {
    const float* modl = (const float*)(p.ws + WS_MOD);
    u16* ZH = (u16*)(p.ws + WS_ZH); u16* XR = (u16*)(p.ws + WS_XR); u16* ZP = (u16*)(p.ws + WS_H); f32x4* RC0 = (f32x4*)(p.ws + WS_RC0);
    for (int row0 = gw; row0 < M; row0 += LNR * NGW) {
        float v[LNR][16]; bool ok[LNR]; float mean[LNR], rstd[LNR]; int rows[LNR];
#pragma unroll
        for (int r = 0; r < LNR; ++r) { rows[r] = row0 + r * NGW; ok[r] = rows[r] < M; if (!ok[r]) rows[r] = row0; }
#pragma unroll
        for (int r = 0; r < LNR; ++r) { const int row = rows[r]; const float* x = row < MP ? p.x_prompt + (size_t)row * D : p.x_sample + (size_t)(row - MP) * D;
#pragma unroll
            for (int j2 = 0; j2 < 2; ++j2) { const f32x4 a = *(const f32x4*)(x + 512 * j2 + 8 * lane), b = *(const f32x4*)(x + 512 * j2 + 8 * lane + 4);
#pragma unroll
                for (int k = 0; k < 4; ++k) { v[r][8 * j2 + k] = a[k]; v[r][8 * j2 + 4 + k] = b[k]; } } }
#pragma unroll
        for (int r = 0; r < LNR; ++r) if (ok[r]) { u16* dst = rows[r] < MP ? ZH : XR;
#pragma unroll
            for (int j2 = 0; j2 < 2; ++j2) *(u32x4*)(dst + (size_t)rows[r] * D + 512 * j2 + 8 * lane) = pack8(v[r] + 8 * j2); }
        ln_stats<LNR>(v, mean, rstd);
#pragma unroll
        for (int r = 0; r < LNR; ++r) if (ok[r]) { const int row = rows[r]; const bool smp = row >= MP; const int bidx = smp ? NB + ((row - MP) >> 2) : (row >> 12);
            const float* sh = modl + (size_t)bidx * 3072; const float* sc = sh + 1024;
            if (!smp && lane == 0) RC0[row] = (f32x4){rstd[r], 0.f, rstd[r], rstd[r] * mean[r]};
#pragma unroll
            for (int j2 = 0; j2 < 2; ++j2) { float o[8];
#pragma unroll
                for (int h = 0; h < 2; ++h) { const f32x4 a = *(const f32x4*)(sc + 512 * j2 + 8 * lane + 4 * h), bb = *(const f32x4*)(sh + 512 * j2 + 8 * lane + 4 * h);
#pragma unroll
                    for (int k = 0; k < 4; ++k) o[4 * h + k] = smp ? v[r][8 * j2 + 4 * h + k] * rstd[r] * (1.f + a[k]) + bb[k] : (v[r][8 * j2 + 4 * h + k] + mean[r]) * (1.f + a[k]); }
                *(u32x4*)(ZP + (size_t)row * D + 512 * j2 + 8 * lane) = pack8(o); } }
    }
}
DI void modv_unit(const Params& p, LAS unsigned char* lds, int unit, int tid, int lane, int wave) {
    const int l = unit / 40, cb = unit % 40, col = 64 * cb + lane;
    const float* W = p.w_in + (size_t)l * D * DIN + col; const float* modl = (const float*)(p.ws + WS_MOD) + (size_t)l * NMOD * 3072;
    LAS float* part = (LAS float*)lds;
    LAS float* cf = (LAS float*)(lds + 32768) + wave * 128 * 12;
    __syncthreads();
#pragma unroll
    for (int hlf = 0; hlf < 2; ++hlf) { const int ci = 64 * hlf + lane, c = wave * 128 + ci; LAS float* o = cf + ci * 12;
        o[0] = l > 0 ? p.ln_g[(l - 1) * D + c] : 1.f; o[1] = l > 0 ? p.ln_b[(l - 1) * D + c] : 0.f;
#pragma unroll
        for (int b = 0; b < 4; ++b) { o[2 + b] = 1.f + modl[b * 3072 + 1024 + c]; o[6 + b] = modl[b * 3072 + c]; } }
    asm volatile("s_waitcnt lgkmcnt(0)" ::: "memory");
    float acc[4][4];
#pragma unroll
    for (int b = 0; b < 4; ++b)
#pragma unroll
        for (int k = 0; k < 4; ++k) acc[b][k] = 0.f;
#pragma unroll 1
    for (int c0 = 0; c0 < 128; c0 += 32) { float wv[32];
#pragma unroll
        for (int i = 0; i < 32; ++i) wv[i] = W[(size_t)(wave * 128 + c0 + i) * DIN];
#pragma unroll
        for (int i = 0; i < 32; ++i) { const LAS f32x4* cp = (const LAS f32x4*)(cf + (c0 + i) * 12); const f32x4 q0 = cp[0], q1 = cp[1], q2 = cp[2];
            const float g = q0[0], bb = q0[1]; const float s1[4] = {q0[2], q0[3], q1[0], q1[1]}; const float sh[4] = {q1[2], q1[3], q2[0], q2[1]};
#pragma unroll
            for (int b = 0; b < 4; ++b) { const float sw = s1[b] * wv[i]; acc[b][0] += g * sw; acc[b][1] += bb * sw; acc[b][2] += sw; acc[b][3] += sh[b] * wv[i]; } } }
#pragma unroll
    for (int b = 0; b < 4; ++b)
#pragma unroll
        for (int k = 0; k < 4; ++k) part[(wave * 16 + b * 4 + k) * 64 + lane] = acc[b][k];
    __syncthreads();
    float* MODV = (float*)(p.ws + WS_MODV);
    for (int o = tid; o < 1024; o += NTHR) { const int idx = o >> 6, ln = o & 63; float sum = 0.f;
#pragma unroll
        for (int w = 0; w < 8; ++w) sum += part[(w * 16 + idx) * 64 + ln];
        MODV[((size_t)(l * NB + (idx >> 2)) * 4 + (idx & 3)) * DIN + perm_in(64 * cb + ln)] = sum; }
    __syncthreads();
}
DI void finalize_rc_in(const Params& p, int l, int pm, LAS float* dst, int tid) {
    if (tid < 256) { const size_t row = (size_t)pm * 256 + tid; f32x4 rc;
        if (l == 0) rc = ((const f32x4*)(p.ws + WS_RC0))[row];
        else { const float* ps = (const float*)(p.ws + WS_PS) + (size_t)((l - 1) & 1) * MP * 24 + row * 24; const float* lnc = (const float*)(p.ws + WS_LNC) + (l - 1) * 8;
            float S[6];
#pragma unroll
            for (int k = 0; k < 6; ++k) S[k] = (ps[k] + ps[6 + k]) + (ps[12 + k] + ps[18 + k]);
            const float N1 = 1.f / D, mu = S[0] * N1, rstd = 1.f / sqrtf(S[1] * N1 - mu * mu + LN_EPS);
            const float m2 = (rstd * (S[2] - mu * lnc[0]) + lnc[3]) * N1;
            const float e2 = (rstd * rstd * (S[3] - 2.f * mu * S[4] + mu * mu * lnc[1]) + 2.f * rstd * (S[5] - mu * lnc[2]) + lnc[4]) * N1;
            const float rstd2 = 1.f / sqrtf(e2 - m2 * m2 + LN_EPS);
            rc = (f32x4){rstd * rstd2, rstd * rstd2 * mu, rstd2, rstd2 * m2}; }
        *(LAS f32x4*)(dst + 4 * tid) = rc; }
}
DI void fin_phase(const Params& p, int gw, int NGW, int lane) {
    const u16* ZH = (const u16*)(p.ws + WS_ZH);
    const float* lg = p.ln_g + (size_t)(DEPTH - 1) * D; const float* lb = p.ln_b + (size_t)(DEPTH - 1) * D;
    for (int row0 = gw; row0 < MP; row0 += LNR * NGW) {
        float v[LNR][16]; bool ok[LNR]; float mean[LNR], rstd[LNR]; int rows[LNR];
#pragma unroll
        for (int r = 0; r < LNR; ++r) { rows[r] = row0 + r * NGW; ok[r] = rows[r] < MP; if (!ok[r]) rows[r] = row0; }
#pragma unroll
        for (int r = 0; r < LNR; ++r)
#pragma unroll
            for (int j2 = 0; j2 < 2; ++j2) unpack8(*(const u32x4*)(ZH + (size_t)rows[r] * D + 512 * j2 + 8 * lane), v[r] + 8 * j2);
        ln_stats<LNR>(v, mean, rstd);
#pragma unroll
        for (int j2 = 0; j2 < 2; ++j2)
#pragma unroll
            for (int h = 0; h < 2; ++h) { const f32x4 g = *(const f32x4*)(lg + 512 * j2 + 8 * lane + 4 * h), bb = *(const f32x4*)(lb + 512 * j2 + 8 * lane + 4 * h);
#pragma unroll
                for (int r = 0; r < LNR; ++r) if (ok[r]) { f32x4 o;
#pragma unroll
                    for (int k = 0; k < 4; ++k) o[k] = v[r][8 * j2 + 4 * h + k] * rstd[r] * g[k] + bb[k];
                    *(f32x4*)(p.out + (size_t)rows[r] * D + 512 * j2 + 8 * lane + 4 * h) = o; } }
    }
}

struct MixPtrs { const u16 *PA, *PSZC, *PPV, *PSZP, *PQ, *PSZA, *PK, *PV; u16* MIX; };
DI v4i16_t ds_tr(const LAS unsigned char* a) { return __builtin_amdgcn_ds_read_tr16_b64_v4i16((LAS v4i16_t*)a); }

DI void attn_prompt_unit(const Params& p, const MixPtrs& X, int l, int unit, LAS unsigned char* lds, int tid, int lane, int wave) {
    const int b = unit >> 6, hk = (unit >> 5) & 1, nb = unit & 31, q0 = nb * 128; const size_t rb = (size_t)b * SEQ;
    LAS unsigned char* Ks = lds; LAS unsigned char* Vs = lds + 36864;
#pragma unroll
    for (int i = 0; i < 4; ++i) { const int c = tid + 512 * i, key = c >> 3, ch = c & 7, tk = q0 - 128 + key;
        if (tk >= 0) { const u32x4 kv = *(const u32x4*)(X.PK + (rb + tk) * 128 + hk * 64 + ch * 8), vv = *(const u32x4*)(X.PV + (rb + tk) * 128 + hk * 64 + ch * 8);
            *(LAS u32x4*)(Ks + key * 144 + ch * 16) = kv; *(LAS u32x4*)(Vs + (ch >> 2) * 16384 + key * 64 + (ch & 3) * 16) = vv; } }
    __syncthreads();
    const int g = wave & 3, qh = wave >> 2, head = 4 * hk + g, r = lane & 31, h = lane >> 5;
    const float sink2 = p.sinks[l * 8 + head] * LOG2E;
    const int trq = (lane & 15) >> 2, trp = lane & 3, trg = (lane >> 4) & 1;
    const float NEG = -INFINITY;
#pragma unroll 1
    for (int e = 0; e < 2; ++e) {
        const int ql = 64 * qh + 32 * e; const size_t qrow = rb + q0 + ql + r;
        h8 qf[4];
#pragma unroll
        for (int s = 0; s < 4; ++s) qf[s] = *(const h8*)(X.PQ + qrow * 512 + head * 64 + 16 * s + 8 * h);
        f32x16 S[5];
#pragma unroll
        for (int i = 0; i < 5; ++i) { const int kl = ql + 32 * i; const bool valid = (nb > 0) || (kl >= 128);
#pragma unroll
            for (int x = 0; x < 16; ++x) S[i][x] = 0.f;
            if (valid) {
#pragma unroll
                for (int s = 0; s < 4; ++s) { const h8 kf = *(const LAS h8*)(Ks + (kl + r) * 144 + (16 * s + 8 * h) * 2); S[i] = __builtin_amdgcn_mfma_f32_32x32x16_f16(kf, qf[s], S[i], 0, 0, 0); }
            } else {
#pragma unroll
                for (int x = 0; x < 16; ++x) S[i][x] = NEG; }
            if (i == 0) {
#pragma unroll
                for (int x = 0; x < 16; ++x) if (!(crow(x, h) > r)) S[i][x] = NEG; }
            if (i == 4) {
#pragma unroll
                for (int x = 0; x < 16; ++x) if (!(crow(x, h) <= r)) S[i][x] = NEG; }
        }
        float mx = sink2;
#pragma unroll
        for (int i = 0; i < 5; ++i)
#pragma unroll
            for (int x = 0; x < 16; ++x) mx = fmaxf(mx, S[i][x]);
        mx = fmaxf(mx, __shfl_xor(mx, 32));
        float sum = 0.f;
#pragma unroll
        for (int i = 0; i < 5; ++i)
#pragma unroll
            for (int x = 0; x < 16; ++x) { S[i][x] = ex2(S[i][x] - mx); sum += S[i][x]; }
        sum += __shfl_xor(sum, 32);
        const float inv = 1.f / (sum + ex2(sink2 - mx));
        f32x16 O[2];
#pragma unroll
        for (int x = 0; x < 16; ++x) { O[0][x] = 0.f; O[1][x] = 0.f; }
#pragma unroll
        for (int i = 0; i < 5; ++i) { const int kl = ql + 32 * i; const bool valid = (nb > 0) || (kl >= 128);
            if (valid) {
#pragma unroll
                for (int s2 = 0; s2 < 2; ++s2) { float pv8[8];
#pragma unroll
                    for (int j = 0; j < 8; ++j) pv8[j] = S[i][8 * s2 + j] * inv;
                    const h8 pa = __builtin_bit_cast(h8, pack8(pv8));
#pragma unroll
                    for (int db = 0; db < 2; ++db) { const LAS unsigned char* va = Vs + db * 16384 + (kl + 16 * s2 + 4 * h + trq) * 64 + trg * 32 + trp * 8;
                        const v4i16_t lo = ds_tr(va), hi = ds_tr(va + 512);
                        const h8 vf = __builtin_bit_cast(h8, __builtin_shufflevector(lo, hi, 0, 1, 2, 3, 4, 5, 6, 7));
                        O[db] = __builtin_amdgcn_mfma_f32_32x32x16_f16(vf, pa, O[db], 0, 0, 0); } } } }
#pragma unroll
        for (int db = 0; db < 2; ++db)
#pragma unroll
            for (int xq = 0; xq < 4; ++xq) { const int col = head * 64 + 32 * db + 8 * xq + 4 * h;
                const h4 z = *(const h4*)(X.PSZA + qrow * 512 + col);
                u32x2 w; w.x = pkh(O[db][4 * xq] * (float)z[0], O[db][4 * xq + 1] * (float)z[1]); w.y = pkh(O[db][4 * xq + 2] * (float)z[2], O[db][4 * xq + 3] * (float)z[3]);
                *(u32x2*)(X.MIX + qrow * D + 512 + col) = w; }
    }
    __syncthreads();
}

DI void conv_prompt_unit(const Params& p, const MixPtrs& X, int l, int unit, LAS unsigned char* lds, int tid, int lane, int wave) {
    const int R0 = unit * 64, b = R0 >> 12, t0 = R0 & (SEQ - 1); const size_t rb = (size_t)b * SEQ;
    LAS unsigned char* WL = lds + 94 * 512;
    for (int c = tid; c < 94 * 32; c += NTHR) { const int row = c >> 5, ch = c & 31, tk = t0 - 30 + row; u32x4 v = (u32x4){0u, 0u, 0u, 0u};
        if (tk >= 0) v = *(const u32x4*)(X.PA + (rb + tk) * 256 + ch * 8);
        *(LAS u32x4*)(lds + row * 512 + ch * 16) = v; }
    for (int c = tid; c < 31 * 64; c += NTHR) *(LAS f32x4*)(WL + c * 16) = *(const f32x4*)(p.conv_w + (size_t)l * 31 * 256 + 4 * c);
    const f32x4 bias = *(const f32x4*)(p.conv_b + l * 256 + 4 * lane), cg = *(const f32x4*)(p.cnorm_g + l * 256 + 4 * lane), cb = *(const f32x4*)(p.cnorm_b + l * 256 + 4 * lane);
    __syncthreads();
    f32x4 acc[8], win[8];
#pragma unroll
    for (int tt = 0; tt < 8; ++tt) acc[tt] = bias;
    const LAS unsigned char* arow = lds + (8 * wave) * 512 + lane * 8;
#pragma unroll
    for (int k = 0; k < 7; ++k) win[k] = __builtin_convertvector(*(const LAS h4*)(arow + k * 512), f32x4);
#pragma unroll 1
    for (int jb = 0; jb < 4; ++jb) {
#pragma unroll
        for (int jj = 0; jj < 8; ++jj) { const int j = 8 * jb + jj;
            if (j < 31) {
                win[(jj + 7) & 7] = __builtin_convertvector(*(const LAS h4*)(arow + (j + 7) * 512), f32x4);
                const f32x4 w = *(const LAS f32x4*)(WL + j * 1024 + lane * 16);
#pragma unroll
                for (int tt = 0; tt < 8; ++tt) acc[tt] += w * win[(jj + tt) & 7]; } } }
#pragma unroll
    for (int tt = 0; tt < 8; ++tt) { const size_t row = (size_t)R0 + 8 * wave + tt;
        const float mean = wave_sum((acc[tt][0] + acc[tt][1]) + (acc[tt][2] + acc[tt][3])) * (1.f / 256.f);
        const f32x4 d = acc[tt] - mean;
        const float rstd = 1.f / sqrtf(wave_sum((d[0] * d[0] + d[1] * d[1]) + (d[2] * d[2] + d[3] * d[3])) * (1.f / 256.f) + LN_EPS);
        const h4 zc = *(const h4*)(X.PSZC + row * 256 + 4 * lane); float o[4];
#pragma unroll
        for (int k = 0; k < 4; ++k) o[k] = silu(d[k] * rstd * cg[k] + cb[k]) * (float)zc[k];
        u32x2 w; w.x = pkh(o[0], o[1]); w.y = pkh(o[2], o[3]);
        *(u32x2*)(X.MIX + row * D + 4 * lane) = w; }
    __syncthreads();
}

DI void pool_prompt_unit(const Params& p, const MixPtrs& X, int l, int unit, LAS unsigned char* lds, int tid, int lane, int wave) {
    const int R0 = unit * 64, b = R0 >> 12, t0 = R0 & (SEQ - 1); const size_t rb = (size_t)b * SEQ;
    LAS unsigned char* PL = lds + 79 * 512;
    for (int c = tid; c < 79 * 32; c += NTHR) { const int row = c >> 5, ch = c & 31, tk = t0 - 15 + row; u32x4 v = (u32x4){0u, 0u, 0u, 0u};
        if (tk >= 0) v = *(const u32x4*)(X.PPV + (rb + tk) * 256 + ch * 8);
        *(LAS u32x4*)(lds + row * 512 + ch * 16) = v; }
    __syncthreads();
    { const int wlen = 2 << (lane >> 4);
        const LAS unsigned char* prow = lds + (8 * wave + 15) * 512 + lane * 8;
        f32x4 sm[8];
#pragma unroll
        for (int tt = 0; tt < 8; ++tt) sm[tt] = (f32x4){0.f, 0.f, 0.f, 0.f};
#pragma unroll 1
        for (int i = 0; i < 16; ++i) { if (i < wlen) {
#pragma unroll
            for (int tt = 0; tt < 8; ++tt) sm[tt] += __builtin_convertvector(*(const LAS h4*)(prow + (tt - i) * 512), f32x4); } }
#pragma unroll
        for (int tt = 0; tt < 8; ++tt) {
            const int t = t0 + 8 * wave + tt; const float cnt = (float)(wlen < t + 1 ? wlen : t + 1);
            const f32x4 cur = __builtin_convertvector(*(const LAS h4*)(prow + tt * 512), f32x4);
            const f32x4 pl = sm[tt] * (1.f / cnt) - cur;
            u32x2 w; w.x = pkh(pl[0], pl[1]); w.y = pkh(pl[2], pl[3]);
            *(LAS u32x2*)(PL + (8 * wave + tt) * 528 + lane * 8) = w; } }
    __syncthreads();
    { const int g = wave & 3, th = wave >> 2, r = lane & 31, h = lane >> 5;
        const float* pw = p.pool_w + ((size_t)l * 4 + g) * 64 * 64 + r;
        f32x16 Dd[2];
#pragma unroll
        for (int x = 0; x < 16; ++x) { Dd[0][x] = 0.f; Dd[1][x] = 0.f; }
#pragma unroll 1
        for (int s = 0; s < 4; ++s) { const h8 bf = *(const LAS h8*)(PL + (32 * th + r) * 528 + (64 * g + 16 * s + 8 * h) * 2);
#pragma unroll
            for (int nb = 0; nb < 2; ++nb) { h8 af;
#pragma unroll
                for (int j = 0; j < 8; ++j) af[j] = (_Float16)pw[(size_t)(16 * s + 8 * h + j) * 64 + 32 * nb];
                Dd[nb] = __builtin_amdgcn_mfma_f32_32x32x16_f16(af, bf, Dd[nb], 0, 0, 0); } }
        const size_t row = (size_t)R0 + 32 * th + r;
#pragma unroll
        for (int nb = 0; nb < 2; ++nb)
#pragma unroll
            for (int xq = 0; xq < 4; ++xq) { const int col = 64 * g + 32 * nb + 8 * xq + 4 * h;
                const f32x4 ps = *(const f32x4*)(p.pool_scale + l * 256 + col); const h4 z = *(const h4*)(X.PSZP + row * 256 + col);
                u32x2 w; w.x = pkh(Dd[nb][4 * xq] * ps[0] * (float)z[0], Dd[nb][4 * xq + 1] * ps[1] * (float)z[1]); w.y = pkh(Dd[nb][4 * xq + 2] * ps[2] * (float)z[2], Dd[nb][4 * xq + 3] * ps[3] * (float)z[3]);
                *(u32x2*)(X.MIX + row * D + 256 + col) = w; } }
    __syncthreads();
}

DI void convpool_sample_unit(const Params& p, const MixPtrs& X, int l, int b, LAS unsigned char* lds, int tid, int lane, int wave) {
    LAS float* cv = (LAS float*)lds;
    LAS float* pl = cv + 1024;
    const int c = tid & 255, tp = tid >> 8; const size_t r0 = (size_t)MP + 4 * b;
    const float* cc = p.cache_conv + (size_t)(l * DB + b) * 30 * 256; const float* cp = p.cache_pool + (size_t)(l * DB + b) * 15 * 256;
    {
        auto xc = [&](int ri) -> float { return ri < 30 ? cc[(size_t)ri * 256 + c] : (float)(*(const _Float16*)(X.PA + (r0 + (ri - 30)) * 256 + c)); };
        float a0 = p.conv_b[l * 256 + c], a1 = a0, prev = xc(2 * tp);
#pragma unroll 2
        for (int j = 0; j < 31; ++j) { const float cur = xc(2 * tp + j + 1); const float w = p.conv_w[((size_t)l * 31 + j) * 256 + c]; a0 += w * prev; a1 += w * cur; prev = cur; }
        cv[(2 * tp) * 256 + c] = a0; cv[(2 * tp + 1) * 256 + c] = a1; }
    {
        auto xp = [&](int ri) -> float { return ri < 15 ? cp[(size_t)ri * 256 + c] : (float)(*(const _Float16*)(X.PPV + (r0 + (ri - 15)) * 256 + c)); };
        const int wlen = 2 << (c >> 6); float s0 = 0.f, s1 = 0.f;
#pragma unroll 2
        for (int i = 0; i < 16; ++i) if (i < wlen) { s0 += xp(15 + 2 * tp - i); s1 += xp(16 + 2 * tp - i); }
        const float iw = 1.f / (float)wlen;
        pl[(2 * tp) * 256 + c] = s0 * iw - xp(15 + 2 * tp); pl[(2 * tp + 1) * 256 + c] = s1 * iw - xp(16 + 2 * tp); }
    { float* oc = p.out + OFF_CONVS + (size_t)(l * DB + b) * 30 * 256; float* op = p.out + OFF_POOLS + (size_t)(l * DB + b) * 15 * 256;
        for (int e = tid; e < 26 * 64; e += NTHR) *(f32x4*)(oc + 4 * e) = *(const f32x4*)(cc + 4 * 256 + 4 * e);
        for (int e = tid; e < 11 * 64; e += NTHR) *(f32x4*)(op + 4 * e) = *(const f32x4*)(cp + 4 * 256 + 4 * e); }
    __syncthreads();
    if (wave < 4) { const int t = wave; const f32x4 v = *(const LAS f32x4*)(cv + t * 256 + 4 * lane);
        const float mean = wave_sum((v[0] + v[1]) + (v[2] + v[3])) * (1.f / 256.f); const f32x4 d = v - mean;
        const float rstd = 1.f / sqrtf(wave_sum((d[0] * d[0] + d[1] * d[1]) + (d[2] * d[2] + d[3] * d[3])) * (1.f / 256.f) + LN_EPS);
        const f32x4 cg = *(const f32x4*)(p.cnorm_g + l * 256 + 4 * lane), cb = *(const f32x4*)(p.cnorm_b + l * 256 + 4 * lane);
        const h4 zc = *(const h4*)(X.PSZC + (r0 + t) * 256 + 4 * lane); float o[4];
#pragma unroll
        for (int k = 0; k < 4; ++k) o[k] = silu(d[k] * rstd * cg[k] + cb[k]) * (float)zc[k];
        u32x2 w; w.x = pkh(o[0], o[1]); w.y = pkh(o[2], o[3]);
        *(u32x2*)(X.MIX + (r0 + t) * D + 4 * lane) = w; }
    { const int g = c >> 6, n = c & 63; const float* pw = p.pool_w + ((size_t)l * 4 + g) * 64 * 64 + n; float y0 = 0.f, y1 = 0.f;
#pragma unroll 4
        for (int k = 0; k < 64; ++k) { const float w = pw[(size_t)k * 64]; y0 += pl[(2 * tp) * 256 + 64 * g + k] * w; y1 += pl[(2 * tp + 1) * 256 + 64 * g + k] * w; }
        const float ps = p.pool_scale[l * 256 + c];
        const float z0 = (float)(*(const _Float16*)(X.PSZP + (r0 + 2 * tp) * 256 + c)), z1 = (float)(*(const _Float16*)(X.PSZP + (r0 + 2 * tp + 1) * 256 + c));
        *(_Float16*)(X.MIX + (r0 + 2 * tp) * D + 256 + c) = (_Float16)(y0 * ps * z0); *(_Float16*)(X.MIX + (r0 + 2 * tp + 1) * D + 256 + c) = (_Float16)(y1 * ps * z1); }
    __syncthreads();
}

DI void attn_sample_unit(const Params& p, const MixPtrs& X, int l, int unit, LAS unsigned char* lds, int tid, int lane, int wave) {
    const int b = unit >> 1, hk = unit & 1; const size_t r0 = (size_t)MP + 4 * b;
    LAS float* Ks = (LAS float*)lds;
    LAS float* Vs = Ks + 132 * 65;
    LAS float* Qs = Vs + 132 * 64;
    LAS float* Ss = Qs + 16 * 65;
    const float* ck = p.cache_k + ((size_t)(l * DB + b) * 128 * 2 + hk) * 64; const float* cvv = p.cache_v + ((size_t)(l * DB + b) * 128 * 2 + hk) * 64;
    float* ok = p.out + OFF_KS + ((size_t)(l * DB + b) * 128 * 2 + hk) * 64; float* ov = p.out + OFF_VS + ((size_t)(l * DB + b) * 128 * 2 + hk) * 64;
#pragma unroll
    for (int i = 0; i < 4; ++i) { const int e = tid + 512 * i, j = e >> 4, d4 = (e & 15) * 4;
        const f32x4 kv = *(const f32x4*)(ck + (size_t)j * 128 + d4), vv = *(const f32x4*)(cvv + (size_t)j * 128 + d4);
        Ks[j * 65 + d4] = kv[0]; Ks[j * 65 + d4 + 1] = kv[1]; Ks[j * 65 + d4 + 2] = kv[2]; Ks[j * 65 + d4 + 3] = kv[3];
        *(LAS f32x4*)(Vs + j * 64 + d4) = vv;
        if (j >= 4) { *(f32x4*)(ok + (size_t)(j - 4) * 128 + d4) = kv; *(f32x4*)(ov + (size_t)(j - 4) * 128 + d4) = vv; } }
    if (tid < 256) { const int t = tid >> 6, d = tid & 63;
        Ks[(128 + t) * 65 + d] = (float)(*(const _Float16*)(X.PK + (r0 + t) * 128 + hk * 64 + d));
        Vs[(128 + t) * 64 + d] = (float)(*(const _Float16*)(X.PV + (r0 + t) * 128 + hk * 64 + d)); }
#pragma unroll
    for (int i = 0; i < 2; ++i) { const int e = tid + 512 * i, qr = e >> 6, d = e & 63, t = qr >> 2, g = qr & 3;
        Qs[qr * 65 + d] = (float)(*(const _Float16*)(X.PQ + (r0 + t) * 512 + (4 * hk + g) * 64 + d)); }
    __syncthreads();
    { const int qr = tid & 15, kg = tid >> 4, t = qr >> 2;
        for (int kk = kg; kk < 132; kk += 32) { float s = 0.f;
#pragma unroll 16
            for (int d = 0; d < 64; ++d) s += Qs[qr * 65 + d] * Ks[kk * 65 + d];
            Ss[qr * 133 + kk] = (kk >= t + 1 && kk <= t + 128) ? s : -INFINITY; } }
    __syncthreads();
#pragma unroll
    for (int q2 = 0; q2 < 2; ++q2) { const int qr = 2 * wave + q2, g = qr & 3; const float sink2 = p.sinks[l * 8 + 4 * hk + g] * LOG2E;
        float s0 = Ss[qr * 133 + lane], s1 = Ss[qr * 133 + 64 + lane], s2 = lane < 4 ? Ss[qr * 133 + 128 + lane] : -INFINITY;
        const float mx = fmaxf(wave_max(fmaxf(fmaxf(s0, s1), s2)), sink2);
        s0 = ex2(s0 - mx); s1 = ex2(s1 - mx); s2 = ex2(s2 - mx);
        const float inv = 1.f / (wave_sum(s0 + s1 + s2) + ex2(sink2 - mx));
        Ss[qr * 133 + lane] = s0 * inv; Ss[qr * 133 + 64 + lane] = s1 * inv; if (lane < 4) Ss[qr * 133 + 128 + lane] = s2 * inv; }
    __syncthreads();
    { const int qr = tid & 15, dg = tid >> 4, t = qr >> 2, g = qr & 3; float o0 = 0.f, o1 = 0.f;
#pragma unroll 4
        for (int kk = 0; kk < 132; ++kk) { const float pr = Ss[qr * 133 + kk]; const f32x2 v = *(const LAS f32x2*)(Vs + kk * 64 + 2 * dg); o0 += pr * v[0]; o1 += pr * v[1]; }
        const int col = (4 * hk + g) * 64 + 2 * dg;
        const h2 z = *(const h2*)(X.PSZA + (r0 + t) * 512 + col);
        *(unsigned*)(X.MIX + (r0 + t) * D + 512 + col) = pkh(o0 * (float)z[0], o1 * (float)z[1]); }
    __syncthreads();
}


DI void sample_ln_rows(const Params& p, int l, int R0, int wave, int lane) {
    const u16* ZH = (const u16*)(p.ws + WS_ZH); u16* XR = (u16*)(p.ws + WS_XR); u16* ZP = (u16*)(p.ws + WS_H);
    const float* lg = p.ln_g + (size_t)l * D; const float* lb = p.ln_b + (size_t)l * D;
    const float* modn = (const float*)(p.ws + WS_MOD) + (size_t)(l + 1) * NMOD * 3072;
#pragma unroll 1
    for (int i0 = 0; i0 < 8; i0 += 4) {
        float v[4][16], mean[4], rstd[4];
#pragma unroll
        for (int r = 0; r < 4; ++r)
#pragma unroll
            for (int j2 = 0; j2 < 2; ++j2) unpack8(*(const u32x4*)(ZH + (size_t)(R0 + 8 * wave + i0 + r) * D + 512 * j2 + 8 * lane), v[r] + 8 * j2);
        ln_stats<4>(v, mean, rstd);
#pragma unroll
        for (int j2 = 0; j2 < 2; ++j2)
#pragma unroll
            for (int h = 0; h < 2; ++h) { const f32x4 g = *(const f32x4*)(lg + 512 * j2 + 8 * lane + 4 * h), bb = *(const f32x4*)(lb + 512 * j2 + 8 * lane + 4 * h);
#pragma unroll
                for (int r = 0; r < 4; ++r)
#pragma unroll
                    for (int k = 0; k < 4; ++k) v[r][8 * j2 + 4 * h + k] = v[r][8 * j2 + 4 * h + k] * rstd[r] * g[k] + bb[k]; }
        if (l == DEPTH - 1) {
#pragma unroll
            for (int r = 0; r < 4; ++r) { float* y = p.out + OFF_YS + (size_t)(R0 - MP + 8 * wave + i0 + r) * D;
#pragma unroll
                for (int j2 = 0; j2 < 2; ++j2)
#pragma unroll
                    for (int h = 0; h < 2; ++h) *(f32x4*)(y + 512 * j2 + 8 * lane + 4 * h) = (f32x4){v[r][8 * j2 + 4 * h], v[r][8 * j2 + 4 * h + 1], v[r][8 * j2 + 4 * h + 2], v[r][8 * j2 + 4 * h + 3]}; }
        } else {
#pragma unroll
            for (int r = 0; r < 4; ++r)
#pragma unroll
                for (int j2 = 0; j2 < 2; ++j2) *(u32x4*)(XR + (size_t)(R0 + 8 * wave + i0 + r) * D + 512 * j2 + 8 * lane) = pack8(v[r] + 8 * j2);
            ln_stats<4>(v, mean, rstd);
#pragma unroll
            for (int r = 0; r < 4; ++r) { const int row = R0 + 8 * wave + i0 + r; const float* sh = modn + (size_t)(NB + ((row - MP) >> 2)) * 3072; const float* sc = sh + 1024;
#pragma unroll
                for (int j2 = 0; j2 < 2; ++j2) { float o[8];
#pragma unroll
                    for (int h = 0; h < 2; ++h) { const f32x4 a = *(const f32x4*)(sc + 512 * j2 + 8 * lane + 4 * h), bb = *(const f32x4*)(sh + 512 * j2 + 8 * lane + 4 * h);
#pragma unroll
                        for (int k = 0; k < 4; ++k) o[4 * h + k] = v[r][8 * j2 + 4 * h + k] * rstd[r] * (1.f + a[k]) + bb[k]; }
                    *(u32x4*)(ZP + (size_t)row * D + 512 * j2 + 8 * lane) = pack8(o); } }
        }
    }
}
DI void outproj_sample_unit(const Params& p, int l, int unit, LAS unsigned char* lds, int tid, int lane, int wave) {
    const int rbk0 = unit >> 5, cb = unit & 31, R0 = MP + 64 * rbk0, n0 = 32 * cb, r = lane & 31, h = lane >> 5;
    const u16* MIX = (const u16*)(p.ws + WS_MIX); const u16* WT = (const u16*)(p.ws + WS_WOUT) + (size_t)l * D * D;
    const u16* bp = WT + (size_t)perm_out(n0 + r) * D + wave * 128 + 8 * h;
    const u16* ap = MIX + (size_t)(R0 + r) * D + wave * 128 + 8 * h;
    f32x16 acc[2];
#pragma unroll
    for (int x = 0; x < 16; ++x) { acc[0][x] = 0.f; acc[1][x] = 0.f; }
#pragma unroll
    for (int s = 0; s < 8; ++s) { const h8 bf = *(const h8*)(bp + 16 * s);
#pragma unroll
        for (int rb = 0; rb < 2; ++rb) { const h8 af = *(const h8*)(ap + (size_t)rb * 32 * D + 16 * s); acc[rb] = __builtin_amdgcn_mfma_f32_32x32x16_f16(af, bf, acc[rb], 0, 0, 0); } }
    LAS float* part = (LAS float*)lds;
    LAS unsigned* flag = (LAS unsigned*)(lds + 65536);
#pragma unroll
    for (int rb = 0; rb < 2; ++rb)
#pragma unroll
        for (int x = 0; x < 16; ++x) part[(wave * 64 + 32 * rb + crow(x, h)) * 32 + r] = acc[rb][x];
    __syncthreads();
    const float* modl = (const float*)(p.ws + WS_MOD) + (size_t)l * NMOD * 3072;
#pragma unroll
    for (int q = 0; q < 4; ++q) { const int o = tid + 512 * q, row = o >> 5, col = o & 31; float sum = 0.f;
#pragma unroll
        for (int w = 0; w < 8; ++w) sum += part[(w * 64 + row) * 32 + col];
        const int grow = R0 + row, bidx = NB + ((grow - MP) >> 2);
        const float xr = (float)(*(const _Float16*)((const u16*)(p.ws + WS_XR) + (size_t)grow * D + n0 + col));
        *(_Float16*)((u16*)(p.ws + WS_ZH) + (size_t)grow * D + n0 + col) = (_Float16)(ALPHA * xr + (1.f + modl[(size_t)bidx * 3072 + 2048 + n0 + col]) * sum); }
    asm volatile("s_waitcnt vmcnt(0)" ::: "memory");
    __syncthreads();
    if (tid == 0) {
        __builtin_amdgcn_fence(__ATOMIC_RELEASE, "agent"); asm volatile("s_waitcnt vmcnt(0)" ::: "memory");
        unsigned* cnt = (unsigned*)(p.ws + WS_CTL) + CW_SCNT + 64 * (l * 8 + rbk0);
        const unsigned old = __hip_atomic_fetch_add(cnt, 1u, __ATOMIC_RELAXED, __HIP_MEMORY_SCOPE_AGENT);
        const unsigned last = old == 31u ? 1u : 0u;
        if (last) { __builtin_amdgcn_fence(__ATOMIC_ACQUIRE, "agent"); asm volatile("s_waitcnt vmcnt(0)" ::: "memory"); }
        *flag = last; }
    __syncthreads();
    if (*flag != 0u) sample_ln_rows(p, l, R0, wave, lane);
    __syncthreads();
}

constexpr int N_PHASES = 3 + 3 * DEPTH;
typedef const __attribute__((address_space(4))) Params* KParams;
#define PHASE_BEGIN() int tid = threadIdx.x; asm volatile("" : "+v"(tid)); const int lane = tid & 63, wave = __builtin_amdgcn_readfirstlane(tid >> 6); \
    KParams kq = kp; asm volatile("" : "+s"(kq)); Params p; __builtin_memcpy(&p, (const void*)kq, __builtin_offsetof(Params, inv_freq)); const int gw = vcu * NWAVES + wave, NGW = G * NWAVES; (void)lane; (void)gw; (void)NGW
#define MIXPTRS() MixPtrs X; X.PA = (const u16*)(p.ws + WS_PA); X.PSZC = (const u16*)(p.ws + WS_PSZC); X.PPV = (const u16*)(p.ws + WS_PPV); X.PSZP = (const u16*)(p.ws + WS_PSZP); \
    X.PQ = (const u16*)(p.ws + WS_PQ); X.PSZA = (const u16*)(p.ws + WS_PSZA); X.PK = (const u16*)(p.ws + WS_PK); X.PV = (const u16*)(p.ws + WS_PV); X.MIX = (u16*)(p.ws + WS_MIX)
__global__ void __launch_bounds__(NTHR, 2) hymba_fwd(Params p_unused) {
#if defined(__HIP_DEVICE_COMPILE__)
    extern __shared__ __attribute__((aligned(16))) unsigned char lds_raw[];
    LAS unsigned char* lds = (LAS unsigned char*)lds_raw;
    volatile LAS unsigned* MISC = (volatile LAS unsigned*)(lds + MISC_OFF);
    const KParams kp = (KParams)__builtin_amdgcn_kernarg_segment_ptr();
    const int G = gridDim.x, bx = blockIdx.x, vcu = (G % 8 == 0) ? (bx % 8) * (G / 8) + bx / 8 : bx;
    for (int u = threadIdx.x; u < (LDS_BYTES - RING_BYTES) / 4; u += NTHR) ((LAS unsigned*)(lds + RING_BYTES))[u] = 0u;
    __syncthreads();
    unsigned* ctl = (unsigned*)(kp->ws + WS_CTL);
    XcdBarrier bar; bar.bar = ctl + CW_BAR; bar.x = 0; bar.st = nullptr;
    if (MK_N_LAUNCHES == 1) bar = xcd_barrier_post(ctl + CW_BAR, MISC + 8);
    const int lo = kp->ph_lo, hi = kp->ph_hi;
#define IN(k) (lo <= (k) && (k) < hi)
#define SEAM(k) do { if (MK_N_LAUNCHES == 1 && IN((k) + 1)) xcd_barrier(bar); } while (0)
    if (IN(0)) { { PHASE_BEGIN(); p0_prologue(p, (const __attribute__((address_space(4))) float*)((const __attribute__((address_space(4))) char*)kq + __builtin_offsetof(Params, inv_freq)), lds, vcu, G, tid, lane, wave); } SEAM(0); }
    if (IN(1)) { { PHASE_BEGIN(); for (int u = vcu; u < DEPTH * 40; u += G) modv_unit(p, lds, u, tid, lane, wave); pre_phase(p, gw, NGW, lane); } SEAM(1); }
#pragma unroll 1
    for (int l = 0; l < DEPTH; ++l) {
        const int ph = 2 + 3 * l;
        if (IN(ph)) {
            { PHASE_BEGIN();
            pg8::Gemm g{(const u16*)(p.ws + WS_H), (const u16*)(p.ws + WS_WIN) + (size_t)l * DIN * D, M, DIN, D};
            pg8::StaticOrder S; S.init(M, DIN, G, bx);
            LAS float* rcl = (LAS float*)(lds + RING_BYTES + 1024);
            for (int i = 0; i < 3; ++i) { pg8::Unit u; if (S.next(i, u) && u.pm < MP / 256) finalize_rc_in(p, l, u.pm, rcl + i * 1024, tid); }
            asm volatile("s_waitcnt lgkmcnt(0)" ::: "memory"); __syncthreads();
            EpiIn E{l, p.ws, p.out, rcl};
            pg8::gemm_phase<EpiIn, true>(lds, g, S, E, tid); }
            SEAM(ph);
        }
        if (IN(ph + 1)) {
            { PHASE_BEGIN(); MIXPTRS(); for (int u = vcu; u < 256; u += G) attn_prompt_unit(p, X, l, u, lds, tid, lane, wave); }
            { PHASE_BEGIN(); MIXPTRS(); for (int u = vcu; u < 256; u += G) conv_prompt_unit(p, X, l, u, lds, tid, lane, wave); }
            { PHASE_BEGIN(); MIXPTRS(); for (int u = vcu; u < 256; u += G) pool_prompt_unit(p, X, l, u, lds, tid, lane, wave); }
            { PHASE_BEGIN(); MIXPTRS(); for (int u = vcu; u < 256; u += G) attn_sample_unit(p, X, l, u, lds, tid, lane, wave); }
            { PHASE_BEGIN(); MIXPTRS(); for (int u = vcu; u < DB; u += G) convpool_sample_unit(p, X, l, u, lds, tid, lane, wave); }
            SEAM(ph + 1); }
        if (IN(ph + 2)) {
            { PHASE_BEGIN();
            pg8::Gemm g{(const u16*)(p.ws + WS_MIX), (const u16*)(p.ws + WS_WOUT) + (size_t)l * D * D, M, D, D};
            pg8::StaticOrder S; S.init(MP, D, G, bx);
            EpiOutF E{p.ws, l, p.ln_g, p.ln_b};
            pg8::gemm_phase<EpiOutF, false>(lds, g, S, E, tid);
            __syncthreads();
            for (int u = vcu; u < 256; u += G) outproj_sample_unit(p, l, u, lds, tid, lane, wave); }
            SEAM(ph + 2);
        }
    }
    if (IN(N_PHASES - 1)) { PHASE_BEGIN(); fin_phase(p, gw, NGW, lane); }
#undef IN
#undef SEAM
#endif
}


#ifdef DBG
constexpr int DBG_NS = 56;
constexpr size_t WS_DBGACC = 32 * 1024;
constexpr size_t WS_DBGZ = WS_END;
__constant__ int dbg_rows_tab[DBG_NS] = {0, 1, 2, 3, 14, 15, 16, 29, 30, 31, 32, 63, 64, 65, 127, 128, 129, 255, 256, 1000, 2047, 2048, 3967, 3968, 4065, 4066, 4080, 4081, 4094, 4095, 4096, 4097, 4127, 4224,
                            8191, 8192, 8320, 12288, 12415, 16382, 16383, 16384, 16385, 16386, 16387, 16388, 16391, 16639, 16640, 16892, 16893, 16894, 16895, 5000, 9999, 15000};
__device__ int dbg_row(int i) { return dbg_rows_tab[i]; }
__device__ void dbg_acc(float* accf, int id, float e, float r) {
    __shared__ float se[256], sr[256];
    const int t = threadIdx.x; se[t] = e; sr[t] = r; __syncthreads();
    for (int o = 128; o > 0; o >>= 1) { if (t < o) { se[t] += se[t + o]; sr[t] += sr[t + o]; } __syncthreads(); }
    if (t == 0) { atomicAdd(accf + 2 * id, se[0]); atomicAdd(accf + 2 * id + 1, sr[0]); }
    __syncthreads();
}
__device__ float dbg_h(const u16* p, size_t i) { return (float)(*(const _Float16*)(p + i)); }
__device__ float dbg_block_sum(float v) { __shared__ float sb[256]; const int t = threadIdx.x; sb[t] = v; __syncthreads(); for (int o = 128; o > 0; o >>= 1) { if (t < o) sb[t] += sb[t + o]; __syncthreads(); } const float r = sb[0]; __syncthreads(); return r; }
__device__ void dbg_ln4(float (&x)[4], float& rstd) { const float mean = dbg_block_sum(x[0] + x[1] + x[2] + x[3]) / D; float q = 0; for (int i = 0; i < 4; ++i) { x[i] -= mean; q += x[i] * x[i]; } rstd = 1.f / sqrtf(dbg_block_sum(q) / D + LN_EPS); }
#define DBG_E(fast, ref) do { const float f_ = (fast), r_ = (ref); e += (f_ - r_) * (f_ - r_); rr += r_ * r_; } while (0)
__global__ void __launch_bounds__(256) dbg_p0(Params p) {
    float* accf = (float*)(p.ws + WS_DBGACC); const int t = threadIdx.x, bid = blockIdx.x;
    { float e = 0, rr = 0; const int ri = (bid >> 2) % 9;
        const int l = bid & 3, row = ri < 6 ? ri : (ri == 6 ? 67 : 123 + ri);
        const float* c = row < NB ? p.c_prompt + (size_t)row * D : p.c_sample + (size_t)(row - NB) * D;
        for (int n = t * 12 + (bid % 12); n < 3072; n += 256 * 12) { float a = p.b_mod[l * 3072 + n];
            for (int k = 0; k < D; ++k) { const float x = c[k]; a += x / (1.f + expf(-x)) * p.w_mod[((size_t)l * D + k) * 3072 + n]; }
            DBG_E(((const float*)(p.ws + WS_MOD))[((size_t)l * NMOD + row) * 3072 + n], a); }
        dbg_acc(accf, 0, e, rr); }
    { float e = 0, rr = 0;
        for (int i = 0; i < 64; ++i) { const int l = bid & 3, col = (bid * 37 + i * 41 + t * 10) % DIN, k = (t * 4 + i * 16 + bid) % D;
            DBG_E(dbg_h((const u16*)(p.ws + WS_WIN), ((size_t)l * DIN + perm_in(col)) * D + k), p.w_in[((size_t)l * D + k) * DIN + col]); }
        dbg_acc(accf, 1, e, rr); }
    { float e = 0, rr = 0;
        for (int i = 0; i < 64; ++i) { const int l = bid & 3, col = (bid * 37 + i * 41 + t * 4) % D, k = (t * 4 + i * 16 + bid) % D;
            DBG_E(dbg_h((const u16*)(p.ws + WS_WOUT), ((size_t)l * D + perm_out(col)) * D + k), p.w_out[((size_t)l * D + k) * D + col]); }
        dbg_acc(accf, 2, e, rr); }
    { float e = 0, rr = 0;
        for (int i = 0; i < 16; ++i) { const int pi = (bid * 113 + i * 257 + t * 16) % (SEQ + DS), f = (t + i) & 31; const int pos = pi < SEQ ? pi : PAST + pi - SEQ;
            const float ang = (float)pos * p.inv_freq[f]; const f32x2 cs = ((const f32x2*)(p.ws + WS_TAB))[pi * 32 + f];
            DBG_E(cs[0], cosf(ang)); DBG_E(cs[1], sinf(ang)); }
        dbg_acc(accf, 3, e, rr); }
}
__global__ void __launch_bounds__(256) dbg_p0b(Params p) {
    float* accf = (float*)(p.ws + WS_DBGACC); const int t = threadIdx.x, bid = blockIdx.x;
    { float e = 0, rr = 0;
        const int l = bid & 3, b = (bid >> 2) & 3; const float* md = (const float*)(p.ws + WS_MOD) + ((size_t)l * NMOD + b) * 3072;
        const int col = (t * 10 + (bid >> 4) * 3 + 1) % DIN; float v1 = 0, v2 = 0, v3 = 0, v4 = 0;
        for (int c = 0; c < D; ++c) { const float w = p.w_in[((size_t)l * D + c) * DIN + col], g = l > 0 ? p.ln_g[(l - 1) * D + c] : 1.f, bb = l > 0 ? p.ln_b[(l - 1) * D + c] : 0.f, s1 = 1.f + md[1024 + c];
            v1 += g * s1 * w; v2 += bb * s1 * w; v3 += s1 * w; v4 += md[c] * w; }
        const float* mv = (const float*)(p.ws + WS_MODV) + (size_t)(l * NB + b) * 4 * DIN + perm_in(col);
        DBG_E(mv[0], v1); DBG_E(mv[2 * DIN], v3); DBG_E(mv[3 * DIN], v4); if (l > 0) DBG_E(mv[DIN], v2); else e += mv[DIN] * mv[DIN];
        dbg_acc(accf, 69, e, rr); }
    if (bid < DBG_NS) { const int row = dbg_row(bid); const bool smp = row >= MP; const int bidx = smp ? NB + ((row - MP) >> 2) : (row >> 12);
        const float* md = (const float*)(p.ws + WS_MOD) + (size_t)bidx * 3072;
        float x[4]; for (int i = 0; i < 4; ++i) { const int c = t + 256 * i; x[i] = smp ? p.x_sample[(size_t)(row - MP) * D + c] : p.x_prompt[(size_t)row * D + c]; }
        float e = 0, rr = 0; for (int i = 0; i < 4; ++i) DBG_E(dbg_h((const u16*)(p.ws + (smp ? WS_XR : WS_ZH)), (size_t)row * D + t + 256 * i), x[i]); dbg_acc(accf, 70, e, rr);
        e = 0; rr = 0;
        if (!smp) { for (int i = 0; i < 4; ++i) { const int c = t + 256 * i; DBG_E(dbg_h((const u16*)(p.ws + WS_H), (size_t)row * D + c), x[i] * (1.f + md[1024 + c])); } }
        else { float rstd; dbg_ln4(x, rstd); for (int i = 0; i < 4; ++i) { const int c = t + 256 * i; DBG_E(dbg_h((const u16*)(p.ws + WS_H), (size_t)row * D + c), x[i] * rstd * (1.f + md[1024 + c]) + md[c]); } }
        dbg_acc(accf, 71, e, rr); }
}
__global__ void __launch_bounds__(256) dbg_copyz(Params p) { const int row = dbg_row(blockIdx.x);
    for (int c = threadIdx.x; c < D; c += 256) { ((u16*)(p.ws + WS_DBGZ))[blockIdx.x * D + c] = ((const u16*)(p.ws + WS_ZH))[(size_t)row * D + c]; ((u16*)(p.ws + WS_DBGZ))[(DBG_NS + blockIdx.x) * D + c] = ((const u16*)(p.ws + WS_XR))[(size_t)row * D + c]; } }
__global__ void __launch_bounds__(256) dbg_in(Params p, int l) {
    __shared__ float pr[DIN]; __shared__ float hh[D];
    float* accf = (float*)(p.ws + WS_DBGACC); const int t = threadIdx.x, row = dbg_row(blockIdx.x), base = 4 + 16 * l;
    const bool smp = row >= MP; const int b = smp ? (row - MP) >> 2 : row >> 12, tt = smp ? (row - MP) & 3 : row & (SEQ - 1), pos = smp ? PAST + tt : tt;
    const int bidx = smp ? NB + b : b; const float* md = (const float*)(p.ws + WS_MOD) + ((size_t)l * NMOD + bidx) * 3072;
    float e, rr;
    { float x[4]; float rstd;
        for (int i = 0; i < 4; ++i) x[i] = dbg_h((const u16*)(p.ws + (smp ? WS_XR : WS_ZH)), (size_t)row * D + t + 256 * i);
        if (!smp && l > 0) { dbg_ln4(x, rstd); for (int i = 0; i < 4; ++i) { const int c = t + 256 * i; x[i] = x[i] * rstd * p.ln_g[(l - 1) * D + c] + p.ln_b[(l - 1) * D + c]; } }
        dbg_ln4(x, rstd);
        for (int i = 0; i < 4; ++i) { const int c = t + 256 * i; hh[c] = x[i] * rstd * (1.f + md[1024 + c]) + md[c]; }
        __syncthreads();
        if (smp) { e = 0; rr = 0; for (int i = 0; i < 4; ++i) { const int c = t + 256 * i; DBG_E(dbg_h((const u16*)(p.ws + WS_H), (size_t)row * D + c), hh[c]); } dbg_acc(accf, base + 1, e, rr); } }
    for (int i = 0; i < 10; ++i) { const int col = t + 256 * i; float a = 0; for (int k = 0; k < D; ++k) a += hh[k] * p.w_in[((size_t)l * D + k) * DIN + col]; pr[col] = a; }
    __syncthreads();
    const float av = pr[t] / (1.f + expf(-pr[256 + t]));
    e = 0; rr = 0; DBG_E(dbg_h((const u16*)(p.ws + WS_PA), (size_t)row * 256 + t), av); dbg_acc(accf, base + 2, e, rr);
    e = 0; rr = 0; { const float z = pr[512 + t]; DBG_E(dbg_h((const u16*)(p.ws + WS_PSZC), (size_t)row * 256 + t), z / (1.f + expf(-z))); } dbg_acc(accf, base + 3, e, rr);
    e = 0; rr = 0; DBG_E(dbg_h((const u16*)(p.ws + WS_PPV), (size_t)row * 256 + t), pr[768 + t]); dbg_acc(accf, base + 4, e, rr);
    e = 0; rr = 0; { const float z = pr[1024 + t]; DBG_E(dbg_h((const u16*)(p.ws + WS_PSZP), (size_t)row * 256 + t), z / (1.f + expf(-z))); } dbg_acc(accf, base + 5, e, rr);
    e = 0; rr = 0;
    for (int i = 0; i < 2; ++i) { const int c = t + 256 * i, hd = c >> 6, d = c & 63, f = d & 31; const float ang = (float)pos * p.inv_freq[f], cs = cosf(ang), sn = sinf(ang);
        const float x = pr[1280 + c], xo = d < 32 ? -pr[1280 + hd * 64 + d + 32] : pr[1280 + hd * 64 + d - 32];
        DBG_E(dbg_h((const u16*)(p.ws + WS_PQ), (size_t)row * 512 + c), (x * cs + xo * sn) * QSCALE); }
    dbg_acc(accf, base + 6, e, rr);
    e = 0; rr = 0; float kref = 0.f, vref = 0.f;
    if (t < 128) { const int hd = t >> 6, d = t & 63, f = d & 31; const float ang = (float)pos * p.inv_freq[f], cs = cosf(ang), sn = sinf(ang);
        const float x = pr[1792 + t], xo = d < 32 ? -pr[1792 + hd * 64 + d + 32] : pr[1792 + hd * 64 + d - 32]; kref = x * cs + xo * sn;
        DBG_E(dbg_h((const u16*)(p.ws + WS_PK), (size_t)row * 128 + t), kref); }
    dbg_acc(accf, base + 7, e, rr);
    e = 0; rr = 0; if (t < 128) { vref = pr[1920 + t]; DBG_E(dbg_h((const u16*)(p.ws + WS_PV), (size_t)row * 128 + t), vref); } dbg_acc(accf, base + 8, e, rr);
    e = 0; rr = 0; for (int i = 0; i < 2; ++i) { const float z = pr[2048 + t + 256 * i]; DBG_E(dbg_h((const u16*)(p.ws + WS_PSZA), (size_t)row * 512 + t + 256 * i), z / (1.f + expf(-z))); } dbg_acc(accf, base + 9, e, rr);
    e = 0; rr = 0;
    if (smp) { DBG_E(p.out[OFF_CONVS + ((size_t)(l * DB + b) * 30 + 26 + tt) * 256 + t], av); DBG_E(p.out[OFF_POOLS + ((size_t)(l * DB + b) * 15 + 11 + tt) * 256 + t], pr[768 + t]);
        if (t < 128) { DBG_E(p.out[OFF_KS + ((size_t)(l * DB + b) * 128 + 124 + tt) * 128 + t], kref); DBG_E(p.out[OFF_VS + ((size_t)(l * DB + b) * 128 + 124 + tt) * 128 + t], vref); } }
    else { if (tt >= SEQ - 30) DBG_E(p.out[OFF_CONVP + ((size_t)(l * NB + b) * 30 + tt - (SEQ - 30)) * 256 + t], av);
        if (tt >= SEQ - 15) DBG_E(p.out[OFF_POOLP + ((size_t)(l * NB + b) * 15 + tt - (SEQ - 15)) * 256 + t], pr[768 + t]);
        if (tt >= SEQ - 128 && t < 128) { DBG_E(p.out[OFF_KP + ((size_t)(l * NB + b) * 128 + tt - (SEQ - 128)) * 128 + t], kref); DBG_E(p.out[OFF_VP + ((size_t)(l * NB + b) * 128 + tt - (SEQ - 128)) * 128 + t], vref); } }
    dbg_acc(accf, base + 10, e, rr);
}
__global__ void __launch_bounds__(256) dbg_mix(Params p, int l) {
    __shared__ float sh[1024]; __shared__ float sc[136];
    float* accf = (float*)(p.ws + WS_DBGACC); const int t = threadIdx.x, row = dbg_row(blockIdx.x), base = 4 + 16 * l;
    const bool smp = row >= MP; const int b = smp ? (row - MP) >> 2 : row >> 12, tt = smp ? (row - MP) & 3 : row & (SEQ - 1);
    const u16 *PA = (const u16*)(p.ws + WS_PA), *PSZC = (const u16*)(p.ws + WS_PSZC), *PPV = (const u16*)(p.ws + WS_PPV), *PSZP = (const u16*)(p.ws + WS_PSZP), *PQ = (const u16*)(p.ws + WS_PQ),
              *PSZA = (const u16*)(p.ws + WS_PSZA), *PK = (const u16*)(p.ws + WS_PK), *PV = (const u16*)(p.ws + WS_PV), *MIX = (const u16*)(p.ws + WS_MIX);
    float e, rr;
    {
        float a = p.conv_b[l * 256 + t];
        for (int j = 0; j < 31; ++j) { float x;
            if (!smp) { const int ts = tt - 30 + j; x = ts >= 0 ? dbg_h(PA, ((size_t)b * SEQ + ts) * 256 + t) : 0.f; }
            else { const int ri = tt + j; x = ri < 30 ? p.cache_conv[((size_t)(l * DB + b) * 30 + ri) * 256 + t] : dbg_h(PA, ((size_t)MP + 4 * b + ri - 30) * 256 + t); }
            a += p.conv_w[((size_t)l * 31 + j) * 256 + t] * x; }
        const float mean = dbg_block_sum(a) / 256.f; const float d = a - mean; const float rstd = 1.f / sqrtf(dbg_block_sum(d * d) / 256.f + LN_EPS);
        const float y = d * rstd * p.cnorm_g[l * 256 + t] + p.cnorm_b[l * 256 + t];
        e = 0; rr = 0; DBG_E(dbg_h(MIX, (size_t)row * D + t), y / (1.f + expf(-y)) * dbg_h(PSZC, (size_t)row * 256 + t)); dbg_acc(accf, base + 11, e, rr); }
    {
        const int w = 2 << (t >> 6); float s = 0;
        for (int i = 0; i < w; ++i) { float x;
            if (!smp) { const int ts = tt - i; x = ts >= 0 ? dbg_h(PPV, ((size_t)b * SEQ + ts) * 256 + t) : 0.f; }
            else { const int ri = 15 + tt - i; x = ri < 15 ? p.cache_pool[((size_t)(l * DB + b) * 15 + ri) * 256 + t] : dbg_h(PPV, ((size_t)MP + 4 * b + ri - 15) * 256 + t); }
            s += x; }
        const float cnt = smp ? (float)w : (float)(w < tt + 1 ? w : tt + 1);
        sh[t] = s / cnt - dbg_h(PPV, (size_t)row * 256 + t); __syncthreads();
        const int g = t >> 6, n = t & 63; float y = 0; for (int c = 0; c < 64; ++c) y += sh[64 * g + c] * p.pool_w[(((size_t)l * 4 + g) * 64 + c) * 64 + n];
        e = 0; rr = 0; DBG_E(dbg_h(MIX, (size_t)row * D + 256 + t), y * p.pool_scale[l * 256 + t] * dbg_h(PSZP, (size_t)row * 256 + t)); dbg_acc(accf, base + 12, e, rr); __syncthreads(); }
    {
        e = 0; rr = 0;
        for (int hd = 0; hd < 8; ++hd) { const int hk = hd >> 2; __syncthreads();
            if (t < 64) sh[t] = dbg_h(PQ, (size_t)row * 512 + hd * 64 + t); __syncthreads();
            const float sink2 = p.sinks[l * 8 + hd] * LOG2E;
            if (t < 128) { float s = -INFINITY;
                if (!smp) { const int ts = tt - 127 + t; if (ts >= 0) { s = 0; for (int d = 0; d < 64; ++d) s += sh[d] * dbg_h(PK, ((size_t)b * SEQ + ts) * 128 + hk * 64 + d); } }
                else { const int ci = tt + 1 + t;
                    s = 0; for (int d = 0; d < 64; ++d) s += sh[d] * (ci < 128 ? p.cache_k[(((size_t)(l * DB + b) * 128 + ci) * 2 + hk) * 64 + d] : dbg_h(PK, ((size_t)MP + 4 * b + ci - 128) * 128 + hk * 64 + d)); }
                sc[t] = s; }
            __syncthreads();
            float mx = sink2; for (int k = 0; k < 128; ++k) mx = fmaxf(mx, sc[k]);
            float den = exp2f(sink2 - mx); for (int k = 0; k < 128; ++k) den += exp2f(sc[k] - mx);
            if (t < 64) { float o = 0;
                for (int k = 0; k < 128; ++k) { const float pk = exp2f(sc[k] - mx) / den; if (pk == 0.f) continue; float v;
                    if (!smp) { const int ts = tt - 127 + k; v = dbg_h(PV, ((size_t)b * SEQ + ts) * 128 + hk * 64 + t); }
                    else { const int ci = tt + 1 + k; v = ci < 128 ? p.cache_v[(((size_t)(l * DB + b) * 128 + ci) * 2 + hk) * 64 + t] : dbg_h(PV, ((size_t)MP + 4 * b + ci - 128) * 128 + hk * 64 + t); }
                    o += pk * v; }
                DBG_E(dbg_h(MIX, (size_t)row * D + 512 + hd * 64 + t), o * dbg_h(PSZA, (size_t)row * 512 + hd * 64 + t)); } }
        dbg_acc(accf, base + 13, e, rr); }
    if (smp) { e = 0; rr = 0;
        for (int i = 0; i < 26; ++i) DBG_E(p.out[OFF_CONVS + ((size_t)(l * DB + b) * 30 + i) * 256 + t], p.cache_conv[((size_t)(l * DB + b) * 30 + i + 4) * 256 + t]);
        for (int i = 0; i < 11; ++i) DBG_E(p.out[OFF_POOLS + ((size_t)(l * DB + b) * 15 + i) * 256 + t], p.cache_pool[((size_t)(l * DB + b) * 15 + i + 4) * 256 + t]);
        for (int i = 0; i < 124; ++i) if (t < 128) { DBG_E(p.out[OFF_KS + ((size_t)(l * DB + b) * 128 + i) * 128 + t], p.cache_k[((size_t)(l * DB + b) * 128 + i + 4) * 128 + t]);
            DBG_E(p.out[OFF_VS + ((size_t)(l * DB + b) * 128 + i) * 128 + t], p.cache_v[((size_t)(l * DB + b) * 128 + i + 4) * 128 + t]); }
        dbg_acc(accf, base + 15, e, rr); }
}
__global__ void __launch_bounds__(256) dbg_out(Params p, int l) {
    __shared__ float mm[D];
    float* accf = (float*)(p.ws + WS_DBGACC); const int t = threadIdx.x, row = dbg_row(blockIdx.x), base = 4 + 16 * l;
    const bool smp = row >= MP; const int bidx = smp ? NB + ((row - MP) >> 2) : (row >> 12);
    for (int c = t; c < D; c += 256) mm[c] = dbg_h((const u16*)(p.ws + WS_MIX), (size_t)row * D + c);
    __syncthreads();
    const float* md = (const float*)(p.ws + WS_MOD) + ((size_t)l * NMOD + bidx) * 3072 + 2048;
    const float* mdn = (const float*)(p.ws + WS_MOD) + ((size_t)(l + 1) * NMOD + bidx) * 3072;
    float x1[4], z[4], rstd;
    for (int i = 0; i < 4; ++i) x1[i] = dbg_h((const u16*)(p.ws + WS_DBGZ), (size_t)((smp ? DBG_NS : 0) + blockIdx.x) * D + t + 256 * i);
    if (!smp && l > 0) { dbg_ln4(x1, rstd); for (int i = 0; i < 4; ++i) { const int c = t + 256 * i; x1[i] = x1[i] * rstd * p.ln_g[(l - 1) * D + c] + p.ln_b[(l - 1) * D + c]; } }
    float e = 0, rr = 0;
    for (int i = 0; i < 4; ++i) { const int c = t + 256 * i; float a = 0; for (int k = 0; k < D; ++k) a += mm[k] * p.w_out[((size_t)l * D + k) * D + c];
        z[i] = ALPHA * x1[i] + (1.f + md[c]) * a; DBG_E(dbg_h((const u16*)(p.ws + WS_ZH), (size_t)row * D + c), z[i]); }
    dbg_acc(accf, base + 14, e, rr);
    e = 0; rr = 0;
    if (!smp) { if (l < DEPTH - 1) for (int i = 0; i < 4; ++i) { const int c = t + 256 * i; DBG_E(dbg_h((const u16*)(p.ws + WS_H), (size_t)row * D + c), z[i] * p.ln_g[l * D + c] * (1.f + mdn[1024 + c])); } }
    else { dbg_ln4(z, rstd); for (int i = 0; i < 4; ++i) { const int c = t + 256 * i; z[i] = z[i] * rstd * p.ln_g[l * D + c] + p.ln_b[l * D + c]; }
        if (l == DEPTH - 1) { for (int i = 0; i < 4; ++i) DBG_E(p.out[OFF_YS + (size_t)(row - MP) * D + t + 256 * i], z[i]); }
        else { for (int i = 0; i < 4; ++i) DBG_E(dbg_h((const u16*)(p.ws + WS_XR), (size_t)row * D + t + 256 * i), z[i]);
            dbg_ln4(z, rstd); for (int i = 0; i < 4; ++i) { const int c = t + 256 * i; DBG_E(dbg_h((const u16*)(p.ws + WS_H), (size_t)row * D + c), z[i] * rstd * (1.f + mdn[1024 + c]) + mdn[c]); } } }
    dbg_acc(accf, base + 0, e, rr);
    if (l == 0) { dbg_acc(accf, 100, smp ? 0.f : e, smp ? 0.f : rr); dbg_acc(accf, 101, smp ? e : 0.f, smp ? rr : 0.f); }
}
__global__ void __launch_bounds__(256) dbg_fin(Params p) {
    float* accf = (float*)(p.ws + WS_DBGACC); const int t = threadIdx.x, row = dbg_row(blockIdx.x);
    if (row >= MP) return;
    float x[4]; for (int i = 0; i < 4; ++i) x[i] = dbg_h((const u16*)(p.ws + WS_ZH), (size_t)row * D + t + 256 * i);
    float rstd; dbg_ln4(x, rstd); float e = 0, rr = 0;
    for (int i = 0; i < 4; ++i) { const int c = t + 256 * i; DBG_E(p.out[(size_t)row * D + c], x[i] * rstd * p.ln_g[3 * D + c] + p.ln_b[3 * D + c]); }
    dbg_acc(accf, 68, e, rr);
}
#ifndef DBG_REPORT_ID
#define DBG_REPORT_ID -1
#endif
__global__ void __launch_bounds__(256) dbg_report(Params p) {
    const float* accf = (const float*)(p.ws + WS_DBGACC);
    float code = 1000.f;
    if (DBG_REPORT_ID >= 0) { const float e = accf[2 * DBG_REPORT_ID], r = accf[2 * DBG_REPORT_ID + 1]; code = (r > 0.f ? e / r : 9.9f) * 1e12f; if (!(code > 100.f)) code = 100.f; }
    else for (int i = 0; i < 128; ++i) { const float e = accf[2 * i], r = accf[2 * i + 1]; const bool expected = i <= 71 && !(i >= 4 && i < 68 && ((i - 4) & 15) == 0 && (i - 4) / 16 == 99);
        if ((r > 0.f && !(e / r < 1e-3f)) || (r == 0.f && (e > 0.f || expected)) || e != e || r != r) { code = (float)(i + 1) * 1e4f; break; } }
    const float S = sqrtf(code);
    for (size_t i = (size_t)blockIdx.x * 256 + threadIdx.x; i < (size_t)MP * D; i += (size_t)gridDim.x * 256) p.out[i] = S;
}
#endif

extern "C" void kernel_launch(void* const* d_in, const int* in_sizes, int n_in, void* d_out, int out_size, void* d_ws, size_t ws_size, hipStream_t stream) {
    static int grid = 0;
    if (grid == 0) {
        if (n_in != 21 || (size_t)out_size != OUT_TOTAL || ws_size < WS_END) { fprintf(stderr, "kernel_launch: unexpected shapes (n_in %d, out %d, ws %zu)\n", n_in, out_size, ws_size); grid = -1; return; }
        int dev = 0, cus = 0;
        if (hipGetDevice(&dev) != hipSuccess || hipDeviceGetAttribute(&cus, hipDeviceAttributeMultiprocessorCount, dev) != hipSuccess) { grid = -1; return; }
        if (hipFuncSetAttribute((const void*)hymba_fwd, hipFuncAttributeMaxDynamicSharedMemorySize, LDS_BYTES) != hipSuccess) { fprintf(stderr, "kernel_launch: hipFuncSetAttribute failed\n"); grid = -1; return; }
        (void)hipGetLastError();
        grid = cus;
    }
    if (grid < 0) return;
    (void)hipMemsetAsync((char*)d_ws + WS_CTL, 0, CTL_ZERO_BYTES, stream);
    Params a{};
    a.x_prompt = (const float*)d_in[0]; a.x_sample = (const float*)d_in[1]; a.cache_conv = (const float*)d_in[2]; a.cache_pool = (const float*)d_in[3];
    a.cache_k = (const float*)d_in[4]; a.cache_v = (const float*)d_in[5]; a.c_prompt = (const float*)d_in[6]; a.c_sample = (const float*)d_in[7];
    a.w_in = (const float*)d_in[8]; a.w_out = (const float*)d_in[9]; a.conv_w = (const float*)d_in[10]; a.conv_b = (const float*)d_in[11];
    a.cnorm_g = (const float*)d_in[12]; a.cnorm_b = (const float*)d_in[13]; a.pool_w = (const float*)d_in[14]; a.pool_scale = (const float*)d_in[15];
    a.sinks = (const float*)d_in[16]; a.w_mod = (const float*)d_in[17]; a.b_mod = (const float*)d_in[18]; a.ln_g = (const float*)d_in[19]; a.ln_b = (const float*)d_in[20];
    a.out = (float*)d_out; a.ws = (unsigned char*)d_ws;
    for (int i = 0; i < 32; ++i) a.inv_freq[i] = (float)std::pow(10000.0, -(double)i * (2.0 / 64.0));
    if (MK_N_LAUNCHES == 1) { a.ph_lo = 0; a.ph_hi = N_PHASES; hipLaunchKernelGGL(hymba_fwd, dim3(grid), dim3(NTHR), LDS_BYTES, stream, a); }
    else for (int ph = 0; ph < N_PHASES; ++ph) {
#ifdef DBG
        if (ph >= 2 && ph < N_PHASES - 1 && (ph - 2) % 3 == 2) hipLaunchKernelGGL(dbg_copyz, dim3(DBG_NS), dim3(256), 0, stream, a);
#endif
        a.ph_lo = ph; a.ph_hi = ph + 1; hipLaunchKernelGGL(hymba_fwd, dim3(grid), dim3(NTHR), LDS_BYTES, stream, a);
#ifdef DBG
        if (ph == 0) hipLaunchKernelGGL(dbg_p0, dim3(144), dim3(256), 0, stream, a);
        else if (ph == 1) hipLaunchKernelGGL(dbg_p0b, dim3(144), dim3(256), 0, stream, a);
        else if (ph == N_PHASES - 1) { hipLaunchKernelGGL(dbg_fin, dim3(DBG_NS), dim3(256), 0, stream, a); hipLaunchKernelGGL(dbg_report, dim3(1024), dim3(256), 0, stream, a); }
        else { const int l = (ph - 2) / 3, k = (ph - 2) % 3;
            if (k == 0) hipLaunchKernelGGL(dbg_in, dim3(DBG_NS), dim3(256), 0, stream, a, l);
            if (k == 1) hipLaunchKernelGGL(dbg_mix, dim3(DBG_NS), dim3(256), 0, stream, a, l);
            if (k == 2) hipLaunchKernelGGL(dbg_out, dim3(DBG_NS), dim3(256), 0, stream, a, l); }
#endif
    }
}
```

```cpp
#include <hip/hip_runtime.h>
#include <cstdint>
#include <cstdio>
#include <cmath>

#define DBG_REPORT_ID -1
#ifndef MK_N_LAUNCHES
#define MK_N_LAUNCHES 1
#endif

#define DI __device__ __forceinline__
#define GAS __attribute__((address_space(1)))
#define LAS __attribute__((address_space(3)))
typedef unsigned short u16;
typedef _Float16 h8 __attribute__((ext_vector_type(8)));
typedef _Float16 h4 __attribute__((ext_vector_type(4)));
typedef _Float16 h2 __attribute__((ext_vector_type(2)));
typedef float f32x2 __attribute__((ext_vector_type(2)));
typedef float f32x4 __attribute__((ext_vector_type(4)));
typedef float f32x16 __attribute__((ext_vector_type(16)));
typedef unsigned u32x4 __attribute__((ext_vector_type(4)));
typedef unsigned u32x2 __attribute__((ext_vector_type(2)));
typedef short v4i16_t __attribute__((ext_vector_type(4)));

constexpr int D = 1024, DIN = 2560, NB = 4, SEQ = 4096, DEPTH = 4, DB = 128, DS = 4;
constexpr int MP = NB * SEQ, MS = DB * DS, M = MP + MS;
constexpr int NMOD = NB + DB;
constexpr int PAST = 8192;
constexpr float LN_EPS = 1e-5f;
constexpr float ALPHA = 1.681792830507429f;
constexpr float LOG2E = 1.4426950408889634f;
constexpr float QSCALE = 0.125f * LOG2E;
constexpr size_t OFF_YP = 0, OFF_YS = OFF_YP + (size_t)MP * D, OFF_CONVP = OFF_YS + (size_t)MS * D, OFF_POOLP = OFF_CONVP + (size_t)DEPTH * NB * 30 * 256,
                 OFF_KP = OFF_POOLP + (size_t)DEPTH * NB * 15 * 256, OFF_VP = OFF_KP + (size_t)DEPTH * NB * 128 * 128, OFF_CONVS = OFF_VP + (size_t)DEPTH * NB * 128 * 128,
                 OFF_POOLS = OFF_CONVS + (size_t)DEPTH * DB * 30 * 256, OFF_KS = OFF_POOLS + (size_t)DEPTH * DB * 15 * 256, OFF_VS = OFF_KS + (size_t)DEPTH * DB * 128 * 128,
                 OUT_TOTAL = OFF_VS + (size_t)DEPTH * DB * 128 * 128;
constexpr size_t MiB = 1u << 20;
constexpr size_t WS_CTL = 0, CTL_ZERO_BYTES = 64 * 1024;
constexpr size_t WS_WIN = 1 * MiB;
constexpr size_t WS_WOUT = 21 * MiB;
constexpr size_t WS_MOD = 29 * MiB;
constexpr size_t WS_TAB = 36 * MiB;
constexpr size_t WS_ZH = 38 * MiB;
constexpr size_t WS_XR = 71 * MiB;
constexpr size_t WS_MIX = 104 * MiB;
constexpr size_t WS_PA = 137 * MiB;
constexpr size_t WS_PSZC = WS_PA + (size_t)M * 256 * 2, WS_PPV = WS_PSZC + (size_t)M * 256 * 2, WS_PSZP = WS_PPV + (size_t)M * 256 * 2;
constexpr size_t WS_PQ = WS_PSZP + (size_t)M * 256 * 2;
constexpr size_t WS_PSZA = WS_PQ + (size_t)M * 512 * 2;
constexpr size_t WS_PK = WS_PSZA + (size_t)M * 512 * 2;
constexpr size_t WS_PV = WS_PK + (size_t)M * 128 * 2;
constexpr size_t WS_H = WS_PV + (size_t)M * 128 * 2;
constexpr size_t WS_PS = WS_H + (size_t)M * D * 2;
constexpr size_t WS_RC0 = WS_PS + 2 * (size_t)MP * 24 * 4;
constexpr size_t WS_MODV = WS_RC0 + (size_t)MP * 16;
constexpr size_t WS_LNC = WS_MODV + (size_t)DEPTH * NB * 4 * DIN * 4;
constexpr size_t WS_VT = WS_LNC + 256;
constexpr size_t WS_END = WS_VT + (size_t)NB * 2 * 64 * SEQ * 2;
static_assert(WS_END <= 256 * MiB, "d_ws map");
constexpr int CW_BAR = 1024;
constexpr int CW_SCNT = 12288;

DI unsigned pkh(float a, float b) { f32x2 v = {a, b}; h2 r = __builtin_convertvector(v, h2); return __builtin_bit_cast(unsigned, r); }
DI u32x4 pack8(const float* v) { u32x4 w; w.x = pkh(v[0], v[1]); w.y = pkh(v[2], v[3]); w.z = pkh(v[4], v[5]); w.w = pkh(v[6], v[7]); return w; }
DI void unpack8(u32x4 w, float* o) {
    const h8 v = __builtin_bit_cast(h8, w);
#pragma unroll
    for (int j = 0; j < 8; ++j) o[j] = (float)v[j];
}
DI float ex2(float x) { return __builtin_amdgcn_exp2f(x); }
DI float sigm(float x) { return __builtin_amdgcn_rcpf(1.f + ex2(-x * LOG2E)); }
DI float silu(float x) { return x * sigm(x); }
template <int O> DI float xor_lane(float v) {
    return __builtin_bit_cast(float, __builtin_amdgcn_ds_swizzle(__builtin_bit_cast(int, v), (O << 10) | 0x1f));
}
DI float sum_halves(float v) { float a = v, b = v; asm volatile("s_nop 1\n\tv_permlane32_swap_b32 %0, %1" : "+v"(a), "+v"(b)); return a + b; }
DI float max_halves(float v) { float a = v, b = v; asm volatile("s_nop 1\n\tv_permlane32_swap_b32 %0, %1" : "+v"(a), "+v"(b)); return fmaxf(a, b); }
DI float wave_sum(float v) { v += xor_lane<1>(v); v += xor_lane<2>(v); v += xor_lane<4>(v); v += xor_lane<8>(v); v += xor_lane<16>(v); return sum_halves(v); }
DI float wave_max(float v) { v = fmaxf(v, xor_lane<1>(v)); v = fmaxf(v, xor_lane<2>(v)); v = fmaxf(v, xor_lane<4>(v)); v = fmaxf(v, xor_lane<8>(v)); v = fmaxf(v, xor_lane<16>(v)); return max_halves(v); }
DI int lane_id() { int l_; asm volatile("v_mbcnt_lo_u32_b32 %0, -1, 0\n\tv_mbcnt_hi_u32_b32 %0, -1, %0" : "=v"(l_)); return l_; }
DI int crow(int r, int hi) { return (r & 3) + 8 * (r >> 2) + 4 * hi; }

__host__ __device__ __forceinline__ int pperm(int bj, int c7) { return 128 * bj + 32 * (c7 >> 5) + 16 * ((c7 >> 2) & 1) + 4 * ((c7 >> 3) & 3) + (c7 & 3); }
__host__ __device__ __forceinline__ int perm_in(int col) {
    if (col < 512) { const int bj = col >> 8, ch = col & 255; return 256 * (ch >> 7) + pperm(bj, ch & 127); }
    if (col < 1280) { const int base = col < 768 ? 512 : (col < 1024 ? 768 : 1024); const int x = col - base; return base + pperm(x >> 7, x & 127); }
    if (col < 1792) { const int x = col - 1280, head = x >> 6, d = x & 63; return 256 * (5 + (head >> 2)) + pperm(d >> 5, 32 * (head & 3) + (d & 31)); }
    if (col < 2048) { const int x = col - 1792, hh = x >> 6, d = x & 63; return 1792 + pperm(d >> 5, 32 * hh + (d & 31)); }
    { const int x = col - 2048; return 2048 + 256 * (x >> 8) + pperm((x >> 7) & 1, x & 127); }
}
__host__ __device__ __forceinline__ int perm_out(int col) { const int y = col & 255; return (col & ~255) + pperm(y >> 7, y & 127); }

namespace pg8 {
constexpr int BM = 256, BK = 64, HALF = 128, HTB = HALF * BK * 2, STAGE_BYTES = 8 * HTB, NXCD = 8, WGM = 8;
__host__ __device__ __forceinline__ int lds_byte(int r, int c) { const int st = (r >> 4) * 2 + (c >> 5), rr = r & 15, cc = c & 31, ob = rr * 64 + cc * 2; return st * 1024 + (ob ^ (((ob >> 9) & 1) << 5)); }
__host__ __device__ __forceinline__ void stage_rc(int b, int& R, int& C) { const int st = b / 1024, sb = b % 1024, swz = sb ^ (((sb >> 9) & 1) << 5); R = (st >> 1) * 16 + swz / 64; C = (st & 1) * 32 + (swz % 64) / 2; }
struct Unit { int pm, pn; };
struct Gemm { const u16* A; const u16* Bt; int M, N, K; };
struct StaticOrder {
    int nM, nN, nwg, G, c;
    __host__ __device__ void init(int M_, int N_, int G_, int c_) { nM = M_ / BM; nN = N_ / BM; nwg = nM * nN; G = G_; c = c_; }
    __host__ __device__ bool next(int i, Unit& u) const {
        const long L = (long)i * G + c; if (L >= nwg) return false;
        int wgid = (int)L; { const int q = nwg / NXCD, r = nwg % NXCD, xcd = wgid % NXCD, off = wgid / NXCD; wgid = (xcd < r ? xcd * (q + 1) : r * (q + 1) + (xcd - r) * q) + off; }
        const int nig = WGM * nN, gid = wgid / nig, fm = gid * WGM, gsz = (nM - fm) < WGM ? (nM - fm) : WGM;
        u.pm = fm + ((wgid % nig) % gsz); u.pn = (wgid % nig) / gsz; return true;
    }
};

template <class Epi, bool ALIGN_EPI>
DI void gemm_phase(LAS unsigned char* lds, const Gemm g, const StaticOrder& S, const Epi& E, const int tid) {
    const int wid = __builtin_amdgcn_readfirstlane(tid >> 6), lane = tid & 63, wr = wid >> 2, wc = wid & 3, fr = lane & 15, fq = lane >> 4;
    const int K = g.K, nt = K / BK;
    unsigned voffA[2];
#pragma unroll
    for (int i = 0; i < 2; ++i) { int R, C; stage_rc(tid * 16 + i * 8192, R, C); voffA[i] = (unsigned)(R * K + C) * 2u; }
    const size_t kstep = (size_t)(BK * 2);
    const size_t hstep = (size_t)HALF * K * 2;
    const size_t tstep = 2 * hstep;
    const unsigned ldsw = (unsigned)wid * 1024u;
    const int aoff = lds_byte(wr * 64 + fr, fq * 8), boff = lds_byte(wc * 32 + fr, fq * 8);
#define PG8_SA(b, h) (((b) * 2 + (h)) * HTB)
#define PG8_SB(b, h) ((4 + (b) * 2 + (h)) * HTB)
#define PG8_STAGE(bufoff, gbase) do { _Pragma("unroll") for (int _i = 0; _i < 2; ++_i) \
        __builtin_amdgcn_global_load_lds((const unsigned*)((const char*)(gbase) + voffA[_i]), (LAS unsigned*)(lds + (bufoff) + ldsw + _i * 8192), 16, 0, 0); } while (0)
#define PG8_LDA(dst, b, h) do { _Pragma("unroll") for (int m = 0; m < 4; ++m) _Pragma("unroll") for (int k = 0; k < 2; ++k) dst[m][k] = *(const LAS h8*)(lds + PG8_SA(b, h) + aoff + m * 2048 + k * 1024); } while (0)
#define PG8_LDB(dst, b, h) do { _Pragma("unroll") for (int n = 0; n < 2; ++n) _Pragma("unroll") for (int k = 0; k < 2; ++k) dst[n][k] = *(const LAS h8*)(lds + PG8_SB(b, h) + boff + n * 2048 + k * 1024); } while (0)
#define PG8_MMA(ai, bj, At, Bt) do { __builtin_amdgcn_s_setprio(1); _Pragma("unroll") for (int m = 0; m < 4; ++m) _Pragma("unroll") for (int n = 0; n < 2; ++n) _Pragma("unroll") for (int k = 0; k < 2; ++k) \
        acc[ai][bj][m][n] = __builtin_amdgcn_mfma_f32_16x16x32_f16(Bt[n][k], At[m][k], acc[ai][bj][m][n], 0, 0, 0); __builtin_amdgcn_s_setprio(0); } while (0)
#define PG8_WAIT_V(n) asm volatile("s_waitcnt vmcnt(" #n ")" ::: "memory")
#define PG8_WAIT_L(n) asm volatile("s_waitcnt lgkmcnt(" #n ")" ::: "memory")
#define PG8_BAR __builtin_amdgcn_s_barrier()
#define PG8_SCHED __builtin_amdgcn_sched_barrier(0)
    Unit cur, nxt; int ui = 0;
    if (!S.next(0, cur)) return;
    f32x4 acc[2][2][4][2];
#pragma unroll
    for (int a = 0; a < 2; ++a)
#pragma unroll
        for (int b = 0; b < 2; ++b)
#pragma unroll
            for (int m = 0; m < 4; ++m)
#pragma unroll
                for (int n = 0; n < 2; ++n) acc[a][b][m][n] = (f32x4){0.f, 0.f, 0.f, 0.f};
    h8 At[4][2], B0[2][2], B1[2][2];
    const char* cA = (const char*)g.A + (size_t)cur.pm * tstep; const char* cB = (const char*)g.Bt + (size_t)cur.pn * tstep;
    PG8_STAGE(PG8_SB(0, 0), cB); PG8_STAGE(PG8_SB(0, 1), cB + hstep); PG8_STAGE(PG8_SA(0, 0), cA); PG8_STAGE(PG8_SA(0, 1), cA + hstep);
    if (wr == 1) PG8_BAR;
    PG8_WAIT_V(2); PG8_BAR;
    PG8_STAGE(PG8_SB(1, 0), cB + kstep); PG8_STAGE(PG8_SA(1, 0), cA + kstep); PG8_STAGE(PG8_SB(1, 1), cB + hstep + kstep);
    PG8_WAIT_V(6); PG8_BAR;
    for (;;) {
        const bool has_next = S.next(ui + 1, nxt);
        const char* nA = has_next ? (const char*)g.A + (size_t)nxt.pm * tstep : cA; const char* nB = has_next ? (const char*)g.Bt + (size_t)nxt.pn * tstep : cB;
        for (int t = 0; t < nt; t += 2) {
            const bool last = (t == nt - 2);
            const char* a1 = cA + (size_t)(t + 1) * kstep;
            const char* a2 = last ? nA : cA + (size_t)(t + 2) * kstep; const char* b2 = last ? nB : cB + (size_t)(t + 2) * kstep;
            const char* a3 = a2 + kstep; const char* b3 = b2 + kstep;
            PG8_LDB(B0, 0, 0); PG8_LDB(B1, 0, 1); PG8_SCHED; PG8_LDA(At, 0, 0); PG8_STAGE(PG8_SA(1, 1), a1 + hstep);
            PG8_WAIT_V(8); PG8_WAIT_L(0); PG8_BAR; PG8_MMA(0, 0, At, B0); PG8_MMA(0, 1, At, B1); PG8_BAR; PG8_SCHED;
            PG8_LDA(At, 0, 1); PG8_STAGE(PG8_SB(0, 0), b2); PG8_STAGE(PG8_SB(0, 1), b2 + hstep); PG8_STAGE(PG8_SA(0, 0), a2);
            PG8_WAIT_V(8); PG8_WAIT_L(0); PG8_BAR; PG8_MMA(1, 0, At, B0); PG8_MMA(1, 1, At, B1); PG8_BAR; PG8_SCHED;
            PG8_LDB(B0, 1, 0); PG8_LDB(B1, 1, 1); PG8_SCHED; PG8_LDA(At, 1, 0); PG8_STAGE(PG8_SA(0, 1), a2 + hstep);
            PG8_WAIT_V(8); PG8_WAIT_L(0); PG8_BAR; PG8_MMA(0, 0, At, B0); PG8_MMA(0, 1, At, B1); PG8_BAR; PG8_SCHED;
            PG8_LDA(At, 1, 1); PG8_STAGE(PG8_SB(1, 0), b3); PG8_STAGE(PG8_SB(1, 1), b3 + hstep); PG8_STAGE(PG8_SA(1, 0), a3);
            PG8_WAIT_V(8); PG8_WAIT_L(0); PG8_BAR; PG8_MMA(1, 0, At, B0); PG8_MMA(1, 1, At, B1); PG8_BAR; PG8_SCHED;
        }
        if constexpr (ALIGN_EPI) { if (wr == 0) PG8_BAR; }
        if constexpr (!Epi::AFTER_DRAIN) E(acc, cur, ui, wr, wc, fr, fq);
        if (!has_next) break;
#pragma unroll
        for (int a = 0; a < 2; ++a)
#pragma unroll
            for (int b = 0; b < 2; ++b)
#pragma unroll
                for (int m = 0; m < 4; ++m)
#pragma unroll
                    for (int n = 0; n < 2; ++n) acc[a][b][m][n] = (f32x4){0.f, 0.f, 0.f, 0.f};
        cur = nxt; cA = nA; cB = nB; ++ui;
        if constexpr (ALIGN_EPI) { if (wr == 1) PG8_BAR; }
    }
    PG8_WAIT_V(0);
    if constexpr (!ALIGN_EPI) { if (wr == 0) PG8_BAR; }
    PG8_BAR;
    if constexpr (Epi::AFTER_DRAIN) E.fused(acc, cur, wr, wc, fr, fq, lds, tid);
#undef PG8_SA
#undef PG8_SB
#undef PG8_STAGE
#undef PG8_LDA
#undef PG8_LDB
#undef PG8_MMA
#undef PG8_WAIT_V
#undef PG8_WAIT_L
#undef PG8_BAR
#undef PG8_SCHED
}
}

struct Params {
    const float* x_prompt; const float* x_sample; const float* cache_conv; const float* cache_pool; const float* cache_k; const float* cache_v;
    const float* c_prompt; const float* c_sample; const float* w_in; const float* w_out; const float* conv_w; const float* conv_b; const float* cnorm_g; const float* cnorm_b;
    const float* pool_w; const float* pool_scale; const float* sinks; const float* w_mod; const float* b_mod; const float* ln_g; const float* ln_b;
    float* out; unsigned char* ws;
    int ph_lo, ph_hi;
    float inv_freq[32];
};
struct ParamsHead { const float* ptrs[21]; float* out; unsigned char* ws; int ph_lo, ph_hi; };
static_assert(sizeof(ParamsHead) == __builtin_offsetof(Params, inv_freq), "ParamsHead mirrors the head of Params");

DI void row_info(int row, bool& smp, int& b, int& t) { smp = row >= MP; if (!smp) { b = row >> 12; t = row & (SEQ - 1); } else { const int s = row - MP; b = s >> 2; t = s & 3; } }
DI void st8f(float* dst, const float* v) { *(f32x4*)dst = (f32x4){v[0], v[1], v[2], v[3]}; *(f32x4*)(dst + 4) = (f32x4){v[4], v[5], v[6], v[7]}; }

struct EpiIn {
    static constexpr bool AFTER_DRAIN = false;
    int l; unsigned char* ws; float* out; const LAS float* rcl;
    DI void operator()(f32x4 (&acc)[2][2][4][2], const pg8::Unit& u, int ui, int wr, int wc, int fr, int fq) const {
        asm volatile("" : "+v"(fr), "+v"(fq));
        const int pn = u.pn;
        if (u.pm < MP / 256) {
            const LAS f32x4* rc = (const LAS f32x4*)rcl + ui * 256 + wr * 64 + fr;
            const float* mv = (const float*)(ws + WS_MODV) + (size_t)(l * NB + (u.pm >> 4)) * 4 * DIN + pn * 256 + wc * 32 + 4 * fq;
#pragma unroll
            for (int bj = 0; bj < 2; ++bj)
#pragma unroll
                for (int n = 0; n < 2; ++n) { const float* mp = mv + 128 * bj + 16 * n;
                    const f32x4 v1 = *(const f32x4*)mp, v2 = *(const f32x4*)(mp + DIN), v3 = *(const f32x4*)(mp + 2 * DIN), v4 = *(const f32x4*)(mp + 3 * DIN);
#pragma unroll
                    for (int ai = 0; ai < 2; ++ai)
#pragma unroll
                        for (int m = 0; m < 4; ++m) { const f32x4 r = rc[ai * 128 + m * 16];
                            acc[ai][bj][m][n] = r[0] * acc[ai][bj][m][n] - r[1] * v1 + r[2] * v2 - r[3] * v3 + v4; } }
        }
        unsigned char* const W = ws; float* const O = out;
#define ST16(byteoff, vals) (*(u32x4*)(W + (size_t)(unsigned)(byteoff)) = pack8(vals))
#define STF8(fidx, vals) st8f(O + (size_t)(unsigned)(fidx), vals)
#pragma unroll
        for (int ai = 0; ai < 2; ++ai)
#pragma unroll
            for (int m = 0; m < 4; ++m) {
                const unsigned row = (unsigned)(u.pm * 256 + ai * 128 + wr * 64 + m * 16 + fr);
                const bool smp = row >= (unsigned)MP; const unsigned b = smp ? (row - MP) >> 2 : row >> 12, t = smp ? (row - MP) & 3u : row & (unsigned)(SEQ - 1);
                if (pn < 2) {
                    const unsigned c8 = pn * 128 + wc * 32 + fq * 8; float a[8];
#pragma unroll
                    for (int n = 0; n < 2; ++n)
#pragma unroll
                        for (int j = 0; j < 4; ++j) a[4 * n + j] = acc[ai][0][m][n][j] * sigm(acc[ai][1][m][n][j]);
                    ST16((unsigned)WS_PA + (row * 256 + c8) * 2, a);
                    if (smp) STF8((unsigned)OFF_CONVS + ((l * DB + b) * 30 + 26 + t) * 256 + c8, a);
                    else if (t >= SEQ - 30) STF8((unsigned)OFF_CONVP + ((l * NB + b) * 30 + (t - (SEQ - 30))) * 256 + c8, a);
                } else if (pn == 2 || pn == 4) {
                    const unsigned base = pn == 2 ? (unsigned)WS_PSZC : (unsigned)WS_PSZP;
#pragma unroll
                    for (int bj = 0; bj < 2; ++bj) { const unsigned c8 = bj * 128 + wc * 32 + fq * 8; float v[8];
#pragma unroll
                        for (int n = 0; n < 2; ++n)
#pragma unroll
                            for (int j = 0; j < 4; ++j) v[4 * n + j] = silu(acc[ai][bj][m][n][j]);
                        ST16(base + (row * 256 + c8) * 2, v); }
                } else if (pn == 3) {
#pragma unroll
                    for (int bj = 0; bj < 2; ++bj) { const unsigned c8 = bj * 128 + wc * 32 + fq * 8; float v[8];
#pragma unroll
                        for (int n = 0; n < 2; ++n)
#pragma unroll
                            for (int j = 0; j < 4; ++j) v[4 * n + j] = acc[ai][bj][m][n][j];
                        ST16((unsigned)WS_PPV + (row * 256 + c8) * 2, v);
                        if (smp) STF8((unsigned)OFF_POOLS + ((l * DB + b) * 15 + 11 + t) * 256 + c8, v);
                        else if (t >= SEQ - 15) STF8((unsigned)OFF_POOLP + ((l * NB + b) * 15 + (t - (SEQ - 15))) * 256 + c8, v); }
                } else if (pn >= 8) {
#pragma unroll
                    for (int bj = 0; bj < 2; ++bj) { const unsigned c8 = (pn - 8) * 256 + bj * 128 + wc * 32 + fq * 8; float v[8];
#pragma unroll
                        for (int n = 0; n < 2; ++n)
#pragma unroll
                            for (int j = 0; j < 4; ++j) v[4 * n + j] = silu(acc[ai][bj][m][n][j]);
                        ST16((unsigned)WS_PSZA + (row * 512 + c8) * 2, v); }
                } else if (pn == 7 && wc >= 2) {
                    const unsigned hv = wc - 2;
#pragma unroll
                    for (int bj = 0; bj < 2; ++bj) { const unsigned d8 = 32 * bj + 8 * fq; float v[8];
#pragma unroll
                        for (int n = 0; n < 2; ++n)
#pragma unroll
                            for (int j = 0; j < 4; ++j) v[4 * n + j] = acc[ai][bj][m][n][j];
                        ST16((unsigned)WS_PV + (row * 128 + hv * 64 + d8) * 2, v);
                        if (smp) STF8((unsigned)OFF_VS + (((l * DB + b) * 128 + 124 + t) * 2 + hv) * 64 + d8, v);
                        else if (t >= SEQ - 128) STF8((unsigned)OFF_VP + (((l * NB + b) * 128 + (t - (SEQ - 128))) * 2 + hv) * 64 + d8, v); }
                } else {
                    const unsigned d8 = 8 * fq; const unsigned pidx = smp ? SEQ + t : t;
                    const f32x4* tp = (const f32x4*)(W + (size_t)((unsigned)WS_TAB + (pidx * 32 + d8) * 8));
                    float x1[8], x2[8], o1[8], o2[8];
#pragma unroll
                    for (int n = 0; n < 2; ++n)
#pragma unroll
                        for (int j = 0; j < 4; ++j) { x1[4 * n + j] = acc[ai][0][m][n][j]; x2[4 * n + j] = acc[ai][1][m][n][j]; }
                    const float sc = pn == 7 ? 1.f : QSCALE;
#pragma unroll
                    for (int k2 = 0; k2 < 4; ++k2) { const f32x4 cs = tp[k2];
                        o1[2 * k2] = (x1[2 * k2] * cs[0] - x2[2 * k2] * cs[1]) * sc;         o2[2 * k2] = (x2[2 * k2] * cs[0] + x1[2 * k2] * cs[1]) * sc;
                        o1[2 * k2 + 1] = (x1[2 * k2 + 1] * cs[2] - x2[2 * k2 + 1] * cs[3]) * sc; o2[2 * k2 + 1] = (x2[2 * k2 + 1] * cs[2] + x1[2 * k2 + 1] * cs[3]) * sc; }
                    if (pn == 7) { const unsigned hk = wc;
                        ST16((unsigned)WS_PK + (row * 128 + hk * 64 + d8) * 2, o1); ST16((unsigned)WS_PK + (row * 128 + hk * 64 + 32 + d8) * 2, o2);
                        if (smp) { const unsigned di = (unsigned)OFF_KS + (((l * DB + b) * 128 + 124 + t) * 2 + hk) * 64 + d8; STF8(di, o1); STF8(di + 32, o2); }
                        else if (t >= SEQ - 128) { const unsigned di = (unsigned)OFF_KP + (((l * NB + b) * 128 + (t - (SEQ - 128))) * 2 + hk) * 64 + d8; STF8(di, o1); STF8(di + 32, o2); }
                    } else { const unsigned head = (pn - 5) * 4 + wc;
                        ST16((unsigned)WS_PQ + (row * 512 + head * 64 + d8) * 2, o1); ST16((unsigned)WS_PQ + (row * 512 + head * 64 + 32 + d8) * 2, o2); }
                }
            }
#undef ST16
#undef STF8
    }
};

struct EpiOutF {
    static constexpr bool AFTER_DRAIN = true;
    unsigned char* ws; int l; const float* ln_g; const float* ln_b;
    DI void operator()(f32x4 (&)[2][2][4][2], const pg8::Unit&, int, int, int, int, int) const {}
    DI void fused(f32x4 (&acc)[2][2][4][2], const pg8::Unit& u, int wr, int wc, int fr, int fq, LAS unsigned char* lds, int tid) const {
        LAS float* CV = (LAS float*)lds;
        LAS float* RS = (LAS float*)(lds + 8192);
        LAS float* PW = (LAS float*)(lds + 12288);
        u16* ZH = (u16*)(ws + WS_ZH); u16* ZP = (u16*)(ws + WS_H);
        const float* MOD = (const float*)(ws + WS_MOD); const int b = u.pm >> 4;
        const float* PSp = (const float*)(ws + WS_PS) + (size_t)((l + 1) & 1) * MP * 24; float* PSc = (float*)(ws + WS_PS) + (size_t)(l & 1) * MP * 24;
        if (tid < 256) { const int col = u.pn * 256 + tid;
            CV[tid] = l > 0 ? ln_g[(l - 1) * D + col] : 1.f; CV[256 + tid] = l > 0 ? ln_b[(l - 1) * D + col] : 0.f;
            CV[512 + tid] = MOD[((size_t)l * NMOD + b) * 3072 + 2048 + col]; CV[768 + tid] = ln_g[l * D + col]; CV[1024 + tid] = ln_b[l * D + col];
            CV[1280 + tid] = l < DEPTH - 1 ? MOD[((size_t)(l + 1) * NMOD + b) * 3072 + 1024 + col] : 0.f;
        } else { const int row = tid - 256; float mu = 0.f, rstd = 1.f;
            if (l > 0) { const float* ps = PSp + (size_t)(u.pm * 256 + row) * 24; const float s1 = (ps[0] + ps[6]) + (ps[12] + ps[18]), s2 = (ps[1] + ps[7]) + (ps[13] + ps[19]);
                mu = s1 * (1.f / D); rstd = 1.f / sqrtf(s2 * (1.f / D) - mu * mu + LN_EPS); }
            RS[2 * row] = mu; RS[2 * row + 1] = rstd; }
        __syncthreads();
#pragma unroll
        for (int am2 = 0; am2 < 4; ++am2) { const int ai = am2 >> 1;
        u32x4 zpv[2][2];
#pragma unroll
        for (int mm = 0; mm < 2; ++mm)
#pragma unroll
            for (int bj = 0; bj < 2; ++bj) zpv[mm][bj] = *(const u32x4*)(ZH + ((size_t)u.pm * 256 + ai * 128 + wr * 64 + ((am2 & 1) * 2 + mm) * 16 + fr) * D + u.pn * 256 + bj * 128 + wc * 32 + fq * 8);
#pragma unroll
        for (int mm = 0; mm < 2; ++mm) { const int m = (am2 & 1) * 2 + mm;
            const int rt = ai * 128 + wr * 64 + m * 16 + fr; const size_t row = (size_t)u.pm * 256 + rt;
            const float mu = RS[2 * rt], rstd = RS[2 * rt + 1];
            float s1 = 0.f, s2 = 0.f, s3 = 0.f, s4 = 0.f, s5 = 0.f, s6 = 0.f;
#pragma unroll
            for (int bj = 0; bj < 2; ++bj) { const int cl = bj * 128 + wc * 32 + fq * 8; const size_t off = row * D + u.pn * 256 + cl;
                float zp[8], zq[8], zo[8]; unpack8(zpv[mm][bj], zp);
#pragma unroll
                for (int hh = 0; hh < 2; ++hh) {
                    const f32x4 gp = *(const LAS f32x4*)(CV + cl + 4 * hh), bp = *(const LAS f32x4*)(CV + 256 + cl + 4 * hh), gt = *(const LAS f32x4*)(CV + 512 + cl + 4 * hh),
                                gg = *(const LAS f32x4*)(CV + 768 + cl + 4 * hh), bb = *(const LAS f32x4*)(CV + 1024 + cl + 4 * hh), sn = *(const LAS f32x4*)(CV + 1280 + cl + 4 * hh);
                    const f32x4 av = acc[ai][bj][m][hh];
#pragma unroll
                    for (int j = 0; j < 4; ++j) { const int k = 4 * hh + j;
                        const float x1 = l > 0 ? (zp[k] - mu) * rstd * gp[j] + bp[j] : zp[k];
                        const float z = ALPHA * x1 + (1.f + gt[j]) * av[j], uu = z * gg[j];
                        s1 += z; s2 += z * z; s3 += uu; s4 += uu * uu; s5 += uu * gg[j]; s6 += uu * bb[j];
                        zq[k] = z; zo[k] = uu * (1.f + sn[j]); } }
                *(u32x4*)(ZH + off) = pack8(zq);
                if (l < DEPTH - 1) *(u32x4*)(ZP + off) = pack8(zo); }
            s1 = sum_halves(s1 + xor_lane<16>(s1)); s2 = sum_halves(s2 + xor_lane<16>(s2)); s3 = sum_halves(s3 + xor_lane<16>(s3)); s4 = sum_halves(s4 + xor_lane<16>(s4)); s5 = sum_halves(s5 + xor_lane<16>(s5)); s6 = sum_halves(s6 + xor_lane<16>(s6));
            if (fq == 0) { LAS float* pw = PW + (rt * 4 + wc) * 6; pw[0] = s1; pw[1] = s2; pw[2] = s3; pw[3] = s4; pw[4] = s5; pw[5] = s6; } }
        asm volatile("" ::: "memory"); }
        __syncthreads();
        if (tid < 256 && l < DEPTH - 1) { float* ps = PSc + (size_t)(u.pm * 256 + tid) * 24 + u.pn * 6; const LAS float* pw = PW + tid * 24;
#pragma unroll
            for (int k = 0; k < 6; ++k) ps[k] = (pw[k] + pw[6 + k]) + (pw[12 + k] + pw[18 + k]); }
    }
};

#define XB_TMO      128
#define XB_XCNT(j)  (256  + 64 * (j))
#define XB_XSUB(j)  (1280 + 64 * (j))
#define XB_XGEN(j)  (2304 + 64 * (j))
#define XB_TOP      3328
#define XB_TOPGEN   3392
#define XCD_BAR_WORDS 3456
#define XB_SPIN_CAP (1u << 18)
DI unsigned xb_ld(unsigned* p)              { return __hip_atomic_load(p, __ATOMIC_RELAXED, __HIP_MEMORY_SCOPE_AGENT); }
DI unsigned xb_add(unsigned* p, unsigned v) { return __hip_atomic_fetch_add(p, v, __ATOMIC_RELAXED, __HIP_MEMORY_SCOPE_AGENT); }
DI unsigned xb_xcc_id() { return (unsigned)__builtin_amdgcn_s_getreg((3 << 11) | 20) & 0xFu; }
#define XB_SPIN(cond, bar) do { unsigned _sp = 0; while (cond) { __builtin_amdgcn_s_sleep(1); \
    if ((++_sp & 255u) == 0u) { if (xb_ld(&(bar)[XB_TMO])) break; if (_sp > XB_SPIN_CAP) { atomicAdd(&(bar)[XB_TMO], 1u); break; } } } } while (0)
struct XcdBarrier { unsigned* bar; unsigned x; volatile LAS unsigned* st; };
DI XcdBarrier xcd_barrier_post(unsigned* bar, volatile LAS unsigned* st) {
    XcdBarrier b; b.bar = bar; b.x = xb_xcc_id(); b.st = st;
    if (threadIdx.x == 0) (void)xb_add(&bar[XB_XCNT(b.x)], 1u);
    return b;
}
DI void xcd_barrier_complete(unsigned* bar, unsigned x, unsigned& nloc, unsigned& nx) {
    const unsigned G = gridDim.x * gridDim.y * gridDim.z;
    unsigned sum, cnt, mine, sp = 0u;
    for (;;) {
        sum = 0u; cnt = 0u; mine = 0u;
#pragma unroll
        for (unsigned j = 0; j < 16; ++j) { const unsigned c = xb_ld(&bar[XB_XCNT(j)]); sum += c; cnt += (c > 0u) ? 1u : 0u; mine = (j == x) ? c : mine; }
        if (sum == G) break;
        __builtin_amdgcn_s_sleep(1);
        if ((++sp & 255u) == 0u) { if (xb_ld(&bar[XB_TMO])) break; if (sp > XB_SPIN_CAP) { atomicAdd(&bar[XB_TMO], 1u); break; } }
    }
    nloc = mine > 0u ? mine : 1u; nx = cnt > 0u ? cnt : 1u;
}
DI void xcd_barrier(const XcdBarrier& b, const int wave_s) {
    asm volatile("s_waitcnt vmcnt(0)" ::: "memory");
    __syncthreads();
    if (wave_s == 0 && lane_id() == 0) {
        unsigned* bar = b.bar;
        __builtin_amdgcn_s_waitcnt(0);
        unsigned nloc = b.st[0], nx = b.st[1];
        if (nloc == 0u) { xcd_barrier_complete(bar, b.x, nloc, nx); b.st[0] = nloc; b.st[1] = nx; }
        const unsigned old = xb_add(&bar[XB_XSUB(b.x)], 1u);
        const unsigned gen = old / nloc;
        if (old + 1u == (gen + 1u) * nloc) {
            __builtin_amdgcn_fence(__ATOMIC_RELEASE, "agent");
            asm volatile("s_waitcnt vmcnt(0)" ::: "memory");
            const unsigned og = xb_add(&bar[XB_TOP], 1u);
            const unsigned tg = og / nx;
            if (og + 1u == (tg + 1u) * nx) xb_add(&bar[XB_TOPGEN], 1u);
            else XB_SPIN(xb_ld(&bar[XB_TOPGEN]) == tg, bar);
            __builtin_amdgcn_fence(__ATOMIC_ACQUIRE, "agent");
            xb_add(&bar[XB_XGEN(b.x)], 1u);
            asm volatile("s_waitcnt vmcnt(0)" ::: "memory");
        } else {
            XB_SPIN(xb_ld(&bar[XB_XGEN(b.x)]) == gen, bar);
            __builtin_amdgcn_fence(__ATOMIC_ACQUIRE, "agent");
            asm volatile("s_waitcnt vmcnt(0)" ::: "memory");
        }
    }
    __syncthreads();
}

constexpr int NWAVES = 8, NTHR = 512;
constexpr int LDS_BYTES = 147456;
constexpr int RING_BYTES = 131072, MISC_OFF = RING_BYTES + 320;

DI void p0_transpose_item(const float* W, int K, int N, u16* WT, LAS float* scr, int item, int lane, bool isin) {
    const int nblk = N / 32, kb = item / nblk, nb = item % nblk, k0 = 64 * kb, n0 = 32 * nb;
#pragma unroll 8
    for (int i = 0; i < 32; ++i) { const int kk = 2 * i + (lane >> 5); scr[kk * 33 + (lane & 31)] = W[(size_t)(k0 + kk) * N + n0 + (lane & 31)]; }
    asm volatile("s_waitcnt lgkmcnt(0)" ::: "memory");
    const int c = lane & 7;
#pragma unroll
    for (int j = 0; j < 4; ++j) { const int n = (lane >> 3) + 8 * j; const LAS float* s = scr + (8 * c) * 33 + n;
        u32x4 o; o.x = pkh(s[0 * 33], s[1 * 33]); o.y = pkh(s[2 * 33], s[3 * 33]); o.z = pkh(s[4 * 33], s[5 * 33]); o.w = pkh(s[6 * 33], s[7 * 33]);
        const int dst = isin ? perm_in(n0 + n) : perm_out(n0 + n);
        *(u32x4*)(WT + (size_t)dst * K + k0 + 8 * c) = o; }
    asm volatile("s_waitcnt lgkmcnt(0)" ::: "memory");
}
DI void mod_unit(const Params& p, LAS unsigned char* lds, int unit, int tid, int lane, int wave) {
    const int l = unit >> 6, n0 = (unit & 63) * 48;
    const float* W = p.w_mod + (size_t)l * D * 3072;
    float* MOD = (float*)(p.ws + WS_MOD);
    const int fr = lane & 15, fq = lane >> 4;
    f32x4 acc[9][3];
#pragma unroll
    for (int rt = 0; rt < 9; ++rt)
#pragma unroll
        for (int ct = 0; ct < 3; ++ct) acc[rt][ct] = (f32x4){0.f, 0.f, 0.f, 0.f};
    for (int ks = 0; ks < 4; ++ks) {
        const int k0 = wave * 128 + ks * 32 + fq * 8;
        h8 bfr[3];
#pragma unroll
        for (int ct = 0; ct < 3; ++ct) { const float* wp = W + (size_t)k0 * 3072 + n0 + 16 * ct + fr;
#pragma unroll
            for (int j = 0; j < 8; ++j) bfr[ct][j] = (_Float16)wp[(size_t)j * 3072]; }
#pragma unroll
        for (int rt = 0; rt < 9; ++rt) { const int row = 16 * rt + fr; h8 a;
            if (row < NMOD) { const float* c = row < NB ? p.c_prompt + (size_t)row * D : p.c_sample + (size_t)(row - NB) * D;
                const f32x4 c0 = *(const f32x4*)(c + k0), c1 = *(const f32x4*)(c + k0 + 4);
#pragma unroll
                for (int j = 0; j < 4; ++j) { a[j] = (_Float16)silu(c0[j]); a[4 + j] = (_Float16)silu(c1[j]); } }
            else {
#pragma unroll
                for (int j = 0; j < 8; ++j) a[j] = (_Float16)0.f; }
#pragma unroll
            for (int ct = 0; ct < 3; ++ct) acc[rt][ct] = __builtin_amdgcn_mfma_f32_16x16x32_f16(a, bfr[ct], acc[rt][ct], 0, 0, 0); }
    }
    LAS float* part = (LAS float*)lds;
#pragma unroll
    for (int rg = 0; rg < 3; ++rg) {
        __syncthreads();
#pragma unroll
        for (int r3 = 0; r3 < 3; ++r3)
#pragma unroll
            for (int ct = 0; ct < 3; ++ct)
#pragma unroll
                for (int i = 0; i < 4; ++i) part[(wave * 48 + r3 * 16 + 4 * fq + i) * 48 + 16 * ct + fr] = acc[rg * 3 + r3][ct][i];
        __syncthreads();
        for (int o = tid; o < 48 * 48; o += NTHR) { const int r48 = o / 48, col = o % 48, row = 48 * rg + r48; float sacc = 0.f;
#pragma unroll
            for (int w = 0; w < 8; ++w) sacc += part[(w * 48 + r48) * 48 + col];
            if (row < NMOD) MOD[((size_t)l * NMOD + row) * 3072 + n0 + col] = sacc + p.b_mod[(size_t)l * 3072 + n0 + col]; }
    }
    __syncthreads();
}
DI void sincos_d(double a, float& c, float& s) {
    const double k = __builtin_rint(a * 0.63661977236758134308);
    const double r = __builtin_fma(-k, 1.2246467991473532e-16 * 0.5, __builtin_fma(-k, 1.5707963267948966, a));
    const double r2 = r * r;
    double sp = -1.0 / 6227020800.0; sp = sp * r2 + 1.0 / 39916800.0; sp = sp * r2 - 1.0 / 362880.0; sp = sp * r2 + 1.0 / 5040.0; sp = sp * r2 - 1.0 / 120.0; sp = sp * r2 + 1.0 / 6.0;
    const double sn = r - r * r2 * sp;
    double cp = 1.0 / 87178291200.0; cp = cp * r2 - 1.0 / 479001600.0; cp = cp * r2 + 1.0 / 3628800.0; cp = cp * r2 - 1.0 / 40320.0; cp = cp * r2 + 1.0 / 720.0; cp = cp * r2 - 1.0 / 24.0; cp = cp * r2 + 0.5;
    const double cn = 1.0 - r2 * cp;
    const long long q = (long long)k & 3;
    const double cc = (q == 0) ? cn : (q == 1) ? -sn : (q == 2) ? -cn : sn;
    const double ss = (q == 0) ? sn : (q == 1) ? cn : (q == 2) ? -sn : -cn;
    c = (float)cc; s = (float)ss;
}
DI void p0_prologue(const Params& p, const __attribute__((address_space(4))) float* invf, LAS unsigned char* lds, int vcu, int G, int tid, int lane, int wave) {
    for (int u = vcu; u < 256; u += G) mod_unit(p, lds, u, tid, lane, wave);
    LAS float* scr = (LAS float*)(lds + wave * 16384);
    const int gw = vcu * NWAVES + wave, NGW = G * NWAVES;
    constexpr int I_IN = (D / 64) * (DIN / 32), I_OUT = (D / 64) * (D / 32);
    for (int it = gw; it < DEPTH * (I_IN + I_OUT); it += NGW) {
        const int l = it / (I_IN + I_OUT), r = it % (I_IN + I_OUT);
        if (r < I_IN) p0_transpose_item(p.w_in + (size_t)l * D * DIN, D, DIN, (u16*)(p.ws + WS_WIN) + (size_t)l * DIN * D, scr, r, lane, true);
        else p0_transpose_item(p.w_out + (size_t)l * D * D, D, D, (u16*)(p.ws + WS_WOUT) + (size_t)l * D * D, scr, r - I_IN, lane, false);
    }
    if (vcu == 0 && wave < DEPTH) {
        float a = 0.f, b2 = 0.f, c2 = 0.f, d = 0.f, e = 0.f;
        for (int c = lane; c < D; c += 64) { const float g = p.ln_g[wave * D + c], bb = p.ln_b[wave * D + c]; a += g; b2 += g * g; c2 += g * bb; d += bb; e += bb * bb; }
        a = wave_sum(a); b2 = wave_sum(b2); c2 = wave_sum(c2); d = wave_sum(d); e = wave_sum(e);
        if (lane == 0) { float* o = (float*)(p.ws + WS_LNC) + wave * 8; o[0] = a; o[1] = b2; o[2] = c2; o[3] = d; o[4] = e; } }
    f32x2* tab = (f32x2*)(p.ws + WS_TAB);
    for (int e = vcu * NTHR + tid; e < (SEQ + DS) * 32; e += G * NTHR) {
        const int pi = e >> 5, i = e & 31; const int pos = pi < SEQ ? pi : PAST + (pi - SEQ);
        const float ang = (float)pos * invf[i];
        float c, s; sincos_d((double)ang, c, s);
        tab[e] = (f32x2){c, s};
    }
}

template <int R>
DI void ln_stats(float (&v)[R][16], float (&mean)[R], float (&rstd)[R]) {
    float s[R];
#pragma unroll
    for (int r = 0; r < R; ++r) { s[r] = 0.f;
#pragma unroll
        for (int k = 0; k < 16; ++k) s[r] += v[r][k]; }
#pragma unroll
    for (int r = 0; r < R; ++r) s[r] = wave_sum(s[r]);
#pragma unroll
    for (int r = 0; r < R; ++r) { mean[r] = s[r] * (1.f / D); s[r] = 0.f;
#pragma unroll
        for (int k = 0; k < 16; ++k) { v[r][k] -= mean[r]; s[r] += v[r][k] * v[r][k]; } }
#pragma unroll
    for (int r = 0; r < R; ++r) s[r] = wave_sum(s[r]);
#pragma unroll
    for (int r = 0; r < R; ++r) rstd[r] = 1.f / sqrtf(s[r] * (1.f / D) + LN_EPS);
}
constexpr int LNR = 3;
DI void pre_phase(const Params& p, int gw, int NGW, int lane) {
    const float* modl = (const float*)(p.ws + WS_MOD);
    u16* ZH = (u16*)(p.ws + WS_ZH); u16* XR = (u16*)(p.ws + WS_XR); u16* ZP = (u16*)(p.ws + WS_H); f32x4* RC0 = (f32x4*)(p.ws + WS_RC0);
    for (int row0 = gw; row0 < M; row0 += LNR * NGW) {
        float v[LNR][16]; bool ok[LNR]; float mean[LNR], rstd[LNR]; int rows[LNR];
#pragma unroll
        for (int r = 0; r < LNR; ++r) { rows[r] = row0 + r * NGW; ok[r] = rows[r] < M; if (!ok[r]) rows[r] = row0; }
#pragma unroll
        for (int r = 0; r < LNR; ++r) { const int row = rows[r]; const float* x = row < MP ? p.x_prompt + (size_t)row * D : p.x_sample + (size_t)(row - MP) * D;
#pragma unroll
            for (int j2 = 0; j2 < 2; ++j2) { const f32x4 a = *(const f32x4*)(x + 512 * j2 + 8 * lane), b = *(const f32x4*)(x + 512 * j2 + 8 * lane + 4);
#pragma unroll
                for (int k = 0; k < 4; ++k) { v[r][8 * j2 + k] = a[k]; v[r][8 * j2 + 4 + k] = b[k]; } } }
#pragma unroll
        for (int r = 0; r < LNR; ++r) if (ok[r]) { u16* dst = rows[r] < MP ? ZH : XR;
#pragma unroll
            for (int j2 = 0; j2 < 2; ++j2) *(u32x4*)(dst + (size_t)rows[r] * D + 512 * j2 + 8 * lane) = pack8(v[r] + 8 * j2); }
        ln_stats<LNR>(v, mean, rstd);
#pragma unroll
        for (int r = 0; r < LNR; ++r) if (ok[r]) { const int row = rows[r]; const bool smp = row >= MP; const int bidx = smp ? NB + ((row - MP) >> 2) : (row >> 12);
            const float* sh = modl + (size_t)bidx * 3072; const float* sc = sh + 1024;
            if (!smp && lane == 0) RC0[row] = (f32x4){rstd[r], 0.f, rstd[r], rstd[r] * mean[r]};
#pragma unroll
            for (int j2 = 0; j2 < 2; ++j2) { float o[8];
#pragma unroll
                for (int h = 0; h < 2; ++h) { const f32x4 a = *(const f32x4*)(sc + 512 * j2 + 8 * lane + 4 * h), bb = *(const f32x4*)(sh + 512 * j2 + 8 * lane + 4 * h);
#pragma unroll
                    for (int k = 0; k < 4; ++k) o[4 * h + k] = smp ? v[r][8 * j2 + 4 * h + k] * rstd[r] * (1.f + a[k]) + bb[k] : (v[r][8 * j2 + 4 * h + k] + mean[r]) * (1.f + a[k]); }
                *(u32x4*)(ZP + (size_t)row * D + 512 * j2 + 8 * lane) = pack8(o); } }
    }
}
DI void modv_unit(const Params& p, LAS unsigned char* lds, int unit, int tid, int lane, int wave) {
    const int l = unit / 40, cb = unit % 40, col = 64 * cb + lane;
    const float* W = p.w_in + (size_t)l * D * DIN + col; const float* modl = (const float*)(p.ws + WS_MOD) + (size_t)l * NMOD * 3072;
    LAS float* part = (LAS float*)lds;
    LAS float* cf = (LAS float*)(lds + 32768) + wave * 128 * 12;
    __syncthreads();
#pragma unroll
    for (int hlf = 0; hlf < 2; ++hlf) { const int ci = 64 * hlf + lane, c = wave * 128 + ci; LAS float* o = cf + ci * 12;
        o[0] = l > 0 ? p.ln_g[(l - 1) * D + c] : 1.f; o[1] = l > 0 ? p.ln_b[(l - 1) * D + c] : 0.f;
#pragma unroll
        for (int b = 0; b < 4; ++b) { o[2 + b] = 1.f + modl[b * 3072 + 1024 + c]; o[6 + b] = modl[b * 3072 + c]; } }
    asm volatile("s_waitcnt lgkmcnt(0)" ::: "memory");
    float acc[4][4];
#pragma unroll
    for (int b = 0; b < 4; ++b)
#pragma unroll
        for (int k = 0; k < 4; ++k) acc[b][k] = 0.f;
#pragma unroll 1
    for (int c0 = 0; c0 < 128; c0 += 32) { float wv[32];
#pragma unroll
        for (int i = 0; i < 32; ++i) wv[i] = W[(size_t)(wave * 128 + c0 + i) * DIN];
#pragma unroll
        for (int i = 0; i < 32; ++i) { const LAS f32x4* cp = (const LAS f32x4*)(cf + (c0 + i) * 12); const f32x4 q0 = cp[0], q1 = cp[1], q2 = cp[2];
            const float g = q0[0], bb = q0[1]; const float s1[4] = {q0[2], q0[3], q1[0], q1[1]}; const float sh[4] = {q1[2], q1[3], q2[0], q2[1]};
#pragma unroll
            for (int b = 0; b < 4; ++b) { const float sw = s1[b] * wv[i]; acc[b][0] += g * sw; acc[b][1] += bb * sw; acc[b][2] += sw; acc[b][3] += sh[b] * wv[i]; } } }
#pragma unroll
    for (int b = 0; b < 4; ++b)
#pragma unroll
        for (int k = 0; k < 4; ++k) part[(wave * 16 + b * 4 + k) * 64 + lane] = acc[b][k];
    __syncthreads();
    float* MODV = (float*)(p.ws + WS_MODV);
    for (int o = tid; o < 1024; o += NTHR) { const int idx = o >> 6, ln = o & 63; float sum = 0.f;
#pragma unroll
        for (int w = 0; w < 8; ++w) sum += part[(w * 16 + idx) * 64 + ln];
        MODV[((size_t)(l * NB + (idx >> 2)) * 4 + (idx & 3)) * DIN + perm_in(64 * cb + ln)] = sum; }
    __syncthreads();
}
DI void finalize_rc_in(const Params& p, int l, int pm, LAS float* dst, int tid) {
    if (tid < 256) { const size_t row = (size_t)pm * 256 + tid; f32x4 rc;
        if (l == 0) rc = ((const f32x4*)(p.ws + WS_RC0))[row];
        else { const float* ps = (const float*)(p.ws + WS_PS) + (size_t)((l - 1) & 1) * MP * 24 + row * 24; const float* lnc = (const float*)(p.ws + WS_LNC) + (l - 1) * 8;
            float S[6];
#pragma unroll
            for (int k = 0; k < 6; ++k) S[k] = (ps[k] + ps[6 + k]) + (ps[12 + k] + ps[18 + k]);
            float N1 = 1.f / D, two = 2.f; asm volatile("" : "+v"(N1), "+v"(two));
            const float mu = S[0] * N1, rstd = 1.f / sqrtf(S[1] * N1 - mu * mu + LN_EPS);
            const float m2 = (rstd * (S[2] - mu * lnc[0]) + lnc[3]) * N1;
            const float e2 = (rstd * rstd * (S[3] - two * mu * S[4] + mu * mu * lnc[1]) + two * rstd * (S[5] - mu * lnc[2]) + lnc[4]) * N1;
            const float rstd2 = 1.f / sqrtf(e2 - m2 * m2 + LN_EPS);
            rc = (f32x4){rstd * rstd2, rstd * rstd2 * mu, rstd2, rstd2 * m2}; }
        *(LAS f32x4*)(dst + 4 * tid) = rc; }
}
DI void fin_phase(const Params& p, int gw, int NGW, int lane) {
    const u16* ZH = (const u16*)(p.ws + WS_ZH);
    const float* lg = p.ln_g + (size_t)(DEPTH - 1) * D; const float* lb = p.ln_b + (size_t)(DEPTH - 1) * D;
    for (int row0 = gw; row0 < MP; row0 += LNR * NGW) {
        float v[LNR][16]; bool ok[LNR]; float mean[LNR], rstd[LNR]; int rows[LNR];
#pragma unroll
        for (int r = 0; r < LNR; ++r) { rows[r] = row0 + r * NGW; ok[r] = rows[r] < MP; if (!ok[r]) rows[r] = row0; }
#pragma unroll
        for (int r = 0; r < LNR; ++r)
#pragma unroll
            for (int j2 = 0; j2 < 2; ++j2) unpack8(*(const u32x4*)(ZH + (size_t)rows[r] * D + 512 * j2 + 8 * lane), v[r] + 8 * j2);
        ln_stats<LNR>(v, mean, rstd);
#pragma unroll
        for (int j2 = 0; j2 < 2; ++j2)
#pragma unroll
            for (int h = 0; h < 2; ++h) { const f32x4 g = *(const f32x4*)(lg + 512 * j2 + 8 * lane + 4 * h), bb = *(const f32x4*)(lb + 512 * j2 + 8 * lane + 4 * h);
#pragma unroll
                for (int r = 0; r < LNR; ++r) if (ok[r]) { f32x4 o;
#pragma unroll
                    for (int k = 0; k < 4; ++k) o[k] = v[r][8 * j2 + 4 * h + k] * rstd[r] * g[k] + bb[k];
                    *(f32x4*)(p.out + (size_t)rows[r] * D + 512 * j2 + 8 * lane + 4 * h) = o; } }
    }
}

struct MixPtrs { const u16 *PA, *PSZC, *PPV, *PSZP, *PQ, *PSZA, *PK, *PV; u16* MIX; };
DI v4i16_t ds_tr(const LAS unsigned char* a) { return __builtin_amdgcn_ds_read_tr16_b64_v4i16((LAS v4i16_t*)a); }

DI void attn_prompt_unit(const Params& p, const MixPtrs& X, int l, int unit, LAS unsigned char* lds, int tid, int lane, int wave) {
    const int b = unit >> 6, hk = (unit >> 5) & 1, nb = unit & 31, q0 = nb * 128; const size_t rb = (size_t)b * SEQ;
    LAS unsigned char* Ks = lds; LAS unsigned char* Vs = lds + 36864;
#pragma unroll
    for (int i = 0; i < 4; ++i) { const int c = tid + 512 * i, key = c >> 3, ch = c & 7, tk = q0 - 128 + key;
        if (tk >= 0) { const u32x4 kv = *(const u32x4*)(X.PK + (rb + tk) * 128 + hk * 64 + ch * 8), vv = *(const u32x4*)(X.PV + (rb + tk) * 128 + hk * 64 + ch * 8);
            *(LAS u32x4*)(Ks + key * 144 + ch * 16) = kv; *(LAS u32x4*)(Vs + (ch >> 2) * 16384 + key * 64 + (ch & 3) * 16) = vv; } }
    __syncthreads();
    const int g = wave & 3, qh = wave >> 2, head = 4 * hk + g, r = lane & 31, h = lane >> 5;
    const float sink2 = p.sinks[l * 8 + head] * LOG2E;
    const int trq = (lane & 15) >> 2, trp = lane & 3, trg = (lane >> 4) & 1;
    const float NEG = -INFINITY;
#pragma unroll 1
    for (int e = 0; e < 2; ++e) {
        const int ql = 64 * qh + 32 * e; const size_t qrow = rb + q0 + ql + r;
        h8 qf[4];
#pragma unroll
        for (int s = 0; s < 4; ++s) qf[s] = *(const h8*)(X.PQ + qrow * 512 + head * 64 + 16 * s + 8 * h);
        f32x16 S[5];
#pragma unroll
        for (int i = 0; i < 5; ++i) { const int kl = ql + 32 * i; const bool valid = (nb > 0) || (kl >= 128);
#pragma unroll
            for (int x = 0; x < 16; ++x) S[i][x] = 0.f;
            if (valid) {
#pragma unroll
                for (int s = 0; s < 4; ++s) { const h8 kf = *(const LAS h8*)(Ks + (kl + r) * 144 + (16 * s + 8 * h) * 2); S[i] = __builtin_amdgcn_mfma_f32_32x32x16_f16(kf, qf[s], S[i], 0, 0, 0); }
            } else {
#pragma unroll
                for (int x = 0; x < 16; ++x) S[i][x] = NEG; }
            if (i == 0) {
#pragma unroll
                for (int x = 0; x < 16; ++x) if (!(crow(x, h) > r)) S[i][x] = NEG; }
            if (i == 4) {
#pragma unroll
                for (int x = 0; x < 16; ++x) if (!(crow(x, h) <= r)) S[i][x] = NEG; }
        }
        float mx = sink2;
#pragma unroll
        for (int i = 0; i < 5; ++i)
#pragma unroll
            for (int x = 0; x < 16; ++x) mx = fmaxf(mx, S[i][x]);
        mx = max_halves(mx);
        float sum = 0.f;
#pragma unroll
        for (int i = 0; i < 5; ++i)
#pragma unroll
            for (int x = 0; x < 16; ++x) { S[i][x] = ex2(S[i][x] - mx); sum += S[i][x]; }
        sum = sum_halves(sum);
        const float inv = 1.f / (sum + ex2(sink2 - mx));
        f32x16 O[2];
#pragma unroll
        for (int x = 0; x < 16; ++x) { O[0][x] = 0.f; O[1][x] = 0.f; }
#pragma unroll
        for (int i = 0; i < 5; ++i) { const int kl = ql + 32 * i; const bool valid = (nb > 0) || (kl >= 128);
            if (valid) {
#pragma unroll
                for (int s2 = 0; s2 < 2; ++s2) { float pv8[8];
#pragma unroll
                    for (int j = 0; j < 8; ++j) pv8[j] = S[i][8 * s2 + j] * inv;
                    const h8 pa = __builtin_bit_cast(h8, pack8(pv8));
#pragma unroll
                    for (int db = 0; db < 2; ++db) { const LAS unsigned char* va = Vs + db * 16384 + (kl + 16 * s2 + 4 * h + trq) * 64 + trg * 32 + trp * 8;
                        const v4i16_t lo = ds_tr(va), hi = ds_tr(va + 512);
                        const h8 vf = __builtin_bit_cast(h8, __builtin_shufflevector(lo, hi, 0, 1, 2, 3, 4, 5, 6, 7));
                        O[db] = __builtin_amdgcn_mfma_f32_32x32x16_f16(vf, pa, O[db], 0, 0, 0); } } } }
#pragma unroll
        for (int db = 0; db < 2; ++db)
#pragma unroll
            for (int xq = 0; xq < 4; ++xq) { const int col = head * 64 + 32 * db + 8 * xq + 4 * h;
                const h4 z = *(const h4*)(X.PSZA + qrow * 512 + col);
                u32x2 w; w.x = pkh(O[db][4 * xq] * (float)z[0], O[db][4 * xq + 1] * (float)z[1]); w.y = pkh(O[db][4 * xq + 2] * (float)z[2], O[db][4 * xq + 3] * (float)z[3]);
                *(u32x2*)(X.MIX + qrow * D + 512 + col) = w; }
    }
    __syncthreads();
}

DI void conv_prompt_unit(const Params& p, const MixPtrs& X, int l, int unit, LAS unsigned char* lds, int tid, int lane, int wave) {
    const int R0 = unit * 64, b = R0 >> 12, t0 = R0 & (SEQ - 1); const size_t rb = (size_t)b * SEQ;
    LAS unsigned char* WL = lds + 94 * 512;
    for (int c = tid; c < 94 * 32; c += NTHR) { const int row = c >> 5, ch = c & 31, tk = t0 - 30 + row; u32x4 v = (u32x4){0u, 0u, 0u, 0u};
        if (tk >= 0) v = *(const u32x4*)(X.PA + (rb + tk) * 256 + ch * 8);
        *(LAS u32x4*)(lds + row * 512 + ch * 16) = v; }
    for (int c = tid; c < 31 * 64; c += NTHR) *(LAS f32x4*)(WL + c * 16) = *(const f32x4*)(p.conv_w + (size_t)l * 31 * 256 + 4 * c);
    const f32x4 bias = *(const f32x4*)(p.conv_b + l * 256 + 4 * lane), cg = *(const f32x4*)(p.cnorm_g + l * 256 + 4 * lane), cb = *(const f32x4*)(p.cnorm_b + l * 256 + 4 * lane);
    __syncthreads();
    f32x4 acc[8], win[8];
#pragma unroll
    for (int tt = 0; tt < 8; ++tt) acc[tt] = bias;
    const LAS unsigned char* arow = lds + (8 * wave) * 512 + lane * 8;
#pragma unroll
    for (int k = 0; k < 7; ++k) win[k] = __builtin_convertvector(*(const LAS h4*)(arow + k * 512), f32x4);
#pragma unroll 1
    for (int jb = 0; jb < 4; ++jb) {
#pragma unroll
        for (int jj = 0; jj < 8; ++jj) { const int j = 8 * jb + jj;
            if (j < 31) {
                win[(jj + 7) & 7] = __builtin_convertvector(*(const LAS h4*)(arow + (j + 7) * 512), f32x4);
                const f32x4 w = *(const LAS f32x4*)(WL + j * 1024 + lane * 16);
#pragma unroll
                for (int tt = 0; tt < 8; ++tt) acc[tt] += w * win[(jj + tt) & 7]; } } }
#pragma unroll
    for (int tt = 0; tt < 8; ++tt) { const size_t row = (size_t)R0 + 8 * wave + tt;
        const float mean = wave_sum((acc[tt][0] + acc[tt][1]) + (acc[tt][2] + acc[tt][3])) * (1.f / 256.f);
        const f32x4 d = acc[tt] - mean;
        const float rstd = 1.f / sqrtf(wave_sum((d[0] * d[0] + d[1] * d[1]) + (d[2] * d[2] + d[3] * d[3])) * (1.f / 256.f) + LN_EPS);
        const h4 zc = *(const h4*)(X.PSZC + row * 256 + 4 * lane); float o[4];
#pragma unroll
        for (int k = 0; k < 4; ++k) o[k] = silu(d[k] * rstd * cg[k] + cb[k]) * (float)zc[k];
        u32x2 w; w.x = pkh(o[0], o[1]); w.y = pkh(o[2], o[3]);
        *(u32x2*)(X.MIX + row * D + 4 * lane) = w; }
    __syncthreads();
}

DI void pool_prompt_unit(const Params& p, const MixPtrs& X, int l, int unit, LAS unsigned char* lds, int tid, int lane, int wave) {
    const int R0 = unit * 64, b = R0 >> 12, t0 = R0 & (SEQ - 1); const size_t rb = (size_t)b * SEQ;
    LAS unsigned char* PL = lds + 79 * 512;
    for (int c = tid; c < 79 * 32; c += NTHR) { const int row = c >> 5, ch = c & 31, tk = t0 - 15 + row; u32x4 v = (u32x4){0u, 0u, 0u, 0u};
        if (tk >= 0) v = *(const u32x4*)(X.PPV + (rb + tk) * 256 + ch * 8);
        *(LAS u32x4*)(lds + row * 512 + ch * 16) = v; }
    __syncthreads();
    { const int wlen = 2 << (lane >> 4);
        const LAS unsigned char* prow = lds + (8 * wave + 15) * 512 + lane * 8;
        f32x4 sm[8];
#pragma unroll
        for (int tt = 0; tt < 8; ++tt) sm[tt] = (f32x4){0.f, 0.f, 0.f, 0.f};
#pragma unroll 1
        for (int i = 0; i < 16; ++i) { if (i < wlen) {
#pragma unroll
            for (int tt = 0; tt < 8; ++tt) sm[tt] += __builtin_convertvector(*(const LAS h4*)(prow + (tt - i) * 512), f32x4); } }
#pragma unroll
        for (int tt = 0; tt < 8; ++tt) {
            const int t = t0 + 8 * wave + tt; const float cnt = (float)(wlen < t + 1 ? wlen : t + 1);
            const f32x4 cur = __builtin_convertvector(*(const LAS h4*)(prow + tt * 512), f32x4);
            const f32x4 pl = sm[tt] * (1.f / cnt) - cur;
            u32x2 w; w.x = pkh(pl[0], pl[1]); w.y = pkh(pl[2], pl[3]);
            *(LAS u32x2*)(PL + (8 * wave + tt) * 528 + lane * 8) = w; } }
    __syncthreads();
    { const int g = wave & 3, th = wave >> 2, r = lane & 31, h = lane >> 5;
        const float* pw = p.pool_w + ((size_t)l * 4 + g) * 64 * 64 + r;
        f32x16 Dd[2];
#pragma unroll
        for (int x = 0; x < 16; ++x) { Dd[0][x] = 0.f; Dd[1][x] = 0.f; }
#pragma unroll 1
        for (int s = 0; s < 4; ++s) { const h8 bf = *(const LAS h8*)(PL + (32 * th + r) * 528 + (64 * g + 16 * s + 8 * h) * 2);
#pragma unroll
            for (int nb = 0; nb < 2; ++nb) { h8 af;
#pragma unroll
                for (int j = 0; j < 8; ++j) af[j] = (_Float16)pw[(size_t)(16 * s + 8 * h + j) * 64 + 32 * nb];
                Dd[nb] = __builtin_amdgcn_mfma_f32_32x32x16_f16(af, bf, Dd[nb], 0, 0, 0); } }
        const size_t row = (size_t)R0 + 32 * th + r;
#pragma unroll
        for (int nb = 0; nb < 2; ++nb)
#pragma unroll
            for (int xq = 0; xq < 4; ++xq) { const int col = 64 * g + 32 * nb + 8 * xq + 4 * h;
                const f32x4 ps = *(const f32x4*)(p.pool_scale + l * 256 + col); const h4 z = *(const h4*)(X.PSZP + row * 256 + col);
                u32x2 w; w.x = pkh(Dd[nb][4 * xq] * ps[0] * (float)z[0], Dd[nb][4 * xq + 1] * ps[1] * (float)z[1]); w.y = pkh(Dd[nb][4 * xq + 2] * ps[2] * (float)z[2], Dd[nb][4 * xq + 3] * ps[3] * (float)z[3]);
                *(u32x2*)(X.MIX + row * D + 256 + col) = w; } }
    __syncthreads();
}


constexpr int MX_WCV = 0;
constexpr int MX_WPT = 31744;
constexpr int MX_SCR = 68608, MX_SCR_W = 7168;
constexpr int MX_TQ = RING_BYTES + 640;
DI void mix_stage_weights(const Params& p, int l, LAS unsigned char* lds, int tid) {
    for (int c = tid; c < 31 * 64; c += NTHR) *(LAS f32x4*)(lds + MX_WCV + c * 16) = *(const f32x4*)(p.conv_w + (size_t)l * 31 * 256 + 4 * c);
    for (int e = tid; e < 4 * 64 * 64; e += NTHR) { const int g = e >> 12, c = (e >> 6) & 63, n = e & 63;
        *(LAS _Float16*)(lds + MX_WPT + ((g * 64 + n) * 72 + c) * 2) = (_Float16)p.pool_w[(size_t)l * 16384 + e]; }
    if (tid == 0) *(LAS unsigned*)(lds + MX_TQ) = 0u;
}
DI void task_attn(const Params& p, int l, int b, int hk, int g, int tq0, int lane) {
    const int head = 4 * hk + g, r = lane & 31, h = lane >> 5; const size_t rb = (size_t)b * SEQ; const size_t qrow = rb + tq0 + r;
    const float sink2 = p.sinks[l * 8 + head] * LOG2E; const float NEG = -INFINITY;
    const u16* PQ = (const u16*)(p.ws + WS_PQ); const u16* PK = (const u16*)(p.ws + WS_PK);
    f32x16 S[5];
    {   h8 qf[4];
#pragma unroll
        for (int s = 0; s < 4; ++s) qf[s] = *(const h8*)(PQ + qrow * 512 + head * 64 + 16 * s + 8 * h);
        h8 kf[5][4];
#pragma unroll
        for (int i = 0; i < 5; ++i) { const int tk = tq0 - 128 + 32 * i, tkc = tk < 0 ? 0 : tk;
#pragma unroll
            for (int s = 0; s < 4; ++s) kf[i][s] = *(const h8*)(PK + (rb + tkc + r) * 128 + hk * 64 + 16 * s + 8 * h); }
#pragma unroll
        for (int i = 0; i < 5; ++i) { const int tk = tq0 - 128 + 32 * i;
#pragma unroll
            for (int x = 0; x < 16; ++x) S[i][x] = 0.f;
#pragma unroll
            for (int s = 0; s < 4; ++s) S[i] = __builtin_amdgcn_mfma_f32_32x32x16_f16(kf[i][s], qf[s], S[i], 0, 0, 0);
#pragma unroll
            for (int x = 0; x < 16; ++x) S[i][x] = tk >= 0 ? S[i][x] : NEG; } }
#pragma unroll
    for (int x = 0; x < 16; ++x) { if (!(crow(x, h) > r)) S[0][x] = NEG; if (!(crow(x, h) <= r)) S[4][x] = NEG; }
    float mx = sink2;
#pragma unroll
    for (int i = 0; i < 5; ++i)
#pragma unroll
        for (int x = 0; x < 16; ++x) mx = fmaxf(mx, S[i][x]);
    mx = max_halves(mx);
    float sum = 0.f;
#pragma unroll
    for (int i = 0; i < 5; ++i)
#pragma unroll
        for (int x = 0; x < 16; ++x) { S[i][x] = ex2(S[i][x] - mx); sum += S[i][x]; }
    sum = sum_halves(sum);
    const float inv = 1.f / (sum + ex2(sink2 - mx));
    u32x4 pa[5][2];
#pragma unroll
    for (int i = 0; i < 5; ++i)
#pragma unroll
        for (int s2 = 0; s2 < 2; ++s2) { float pv8[8];
#pragma unroll
            for (int j = 0; j < 8; ++j) pv8[j] = S[i][8 * s2 + j] * inv;
            pa[i][s2] = pack8(pv8); }
    int voff = ((b * 2 + hk) * 64 + r) * SEQ + (tq0 - 128) + 4 * h;
    asm volatile("" : "+v"(voff) : "v"(pa[0][0]), "v"(pa[0][1]), "v"(pa[1][0]), "v"(pa[1][1]), "v"(pa[2][0]), "v"(pa[2][1]), "v"(pa[3][0]), "v"(pa[3][1]), "v"(pa[4][0]), "v"(pa[4][1]));
    const u16* vtb = (const u16*)(p.ws + WS_VT) + voff;
    u32x2 vlo[5][2][2], vhi[5][2][2];
#pragma unroll
    for (int i = 0; i < 5; ++i) { const int tk = tq0 - 128 + 32 * i; const int adj = tk < 0 ? -tk : 0;
#pragma unroll
        for (int s2 = 0; s2 < 2; ++s2)
#pragma unroll
            for (int db = 0; db < 2; ++db) { const u16* vp = vtb + (size_t)db * 32 * SEQ + 32 * i + 16 * s2 + adj; vlo[i][s2][db] = *(const u32x2*)vp; vhi[i][s2][db] = *(const u32x2*)(vp + 8); } }
    f32x16 O[2];
#pragma unroll
    for (int x = 0; x < 16; ++x) { O[0][x] = 0.f; O[1][x] = 0.f; }
#pragma unroll
    for (int i = 0; i < 5; ++i)
#pragma unroll
        for (int s2 = 0; s2 < 2; ++s2)
#pragma unroll
            for (int db = 0; db < 2; ++db) { const u32x4 vv = {vlo[i][s2][db][0], vlo[i][s2][db][1], vhi[i][s2][db][0], vhi[i][s2][db][1]};
                O[db] = __builtin_amdgcn_mfma_f32_32x32x16_f16(__builtin_bit_cast(h8, vv), __builtin_bit_cast(h8, pa[i][s2]), O[db], 0, 0, 0); }
    const u16* PSZA = (const u16*)(p.ws + WS_PSZA); u16* MIX = (u16*)(p.ws + WS_MIX);
    u32x2 zg[2][4];
#pragma unroll
    for (int db = 0; db < 2; ++db)
#pragma unroll
        for (int xq = 0; xq < 4; ++xq) zg[db][xq] = *(const u32x2*)(PSZA + qrow * 512 + head * 64 + 32 * db + 8 * xq + 4 * h);
#pragma unroll
    for (int db = 0; db < 2; ++db)
#pragma unroll
        for (int xq = 0; xq < 4; ++xq) { const int col = head * 64 + 32 * db + 8 * xq + 4 * h; const h4 z = __builtin_bit_cast(h4, zg[db][xq]);
            u32x2 w; w.x = pkh(O[db][4 * xq] * (float)z[0], O[db][4 * xq + 1] * (float)z[1]); w.y = pkh(O[db][4 * xq + 2] * (float)z[2], O[db][4 * xq + 3] * (float)z[3]);
            *(u32x2*)(MIX + qrow * D + 512 + col) = w; }
}
constexpr int MX_X = 68608;
DI void conv_tile_dma(const Params& p, int R0, LAS unsigned char* lds, int wave, int lane) {
    const int b = R0 >> 12, t0 = R0 & (SEQ - 1);
    const unsigned char* PA = p.ws + WS_PA;
#pragma unroll
    for (int i = 0; i < 6; ++i) { const int piece = wave + 8 * i;
        if (piece < 47) { const int row = 2 * piece + (lane >> 5); int tk = t0 - 30 + row; tk = tk < 0 ? 0 : tk;
            __builtin_amdgcn_global_load_lds((const unsigned*)(PA + ((size_t)b * SEQ + tk) * 512 + (lane & 31) * 16), (LAS unsigned*)(lds + MX_X + piece * 1024), 16, 0, 0); } }
}
DI void task_conv(const Params& p, int l, int R0, int sub, LAS unsigned char* lds, int lane) {
    const int t0 = (R0 & (SEQ - 1)) + 8 * sub; const size_t rowb = (size_t)R0 + 8 * sub;
    const f32x4 bias = *(const f32x4*)(p.conv_b + l * 256 + 4 * lane), cg = *(const f32x4*)(p.cnorm_g + l * 256 + 4 * lane), cb = *(const f32x4*)(p.cnorm_b + l * 256 + 4 * lane);
    const LAS unsigned char* arow = lds + MX_X + (8 * sub) * 512 + lane * 8;
    const LAS unsigned char* wl = lds + MX_WCV + lane * 16;
    f32x4 acc[8], win[8];
#pragma unroll
    for (int tt = 0; tt < 8; ++tt) acc[tt] = bias;
#pragma unroll
    for (int k = 0; k < 7; ++k) { const f32x4 v = __builtin_convertvector(*(const LAS h4*)(arow + k * 512), f32x4); win[k] = (t0 - 30 + k >= 0) ? v : (f32x4){0.f, 0.f, 0.f, 0.f}; }
#pragma unroll 1
    for (int jb = 0; jb < 4; ++jb) {
#pragma unroll
        for (int jj = 0; jj < 8; ++jj) { const int j = 8 * jb + jj;
            if (j < 31) {
                const f32x4 v = __builtin_convertvector(*(const LAS h4*)(arow + (j + 7) * 512), f32x4);
                win[(jj + 7) & 7] = (t0 - 30 + j + 7 >= 0) ? v : (f32x4){0.f, 0.f, 0.f, 0.f};
                const f32x4 w = *(const LAS f32x4*)(wl + j * 1024);
#pragma unroll
                for (int tt = 0; tt < 8; ++tt) acc[tt] += w * win[(jj + tt) & 7]; } } }
    const u16* PSZC = (const u16*)(p.ws + WS_PSZC); u16* MIX = (u16*)(p.ws + WS_MIX);
#pragma unroll
    for (int tt = 0; tt < 8; ++tt) { const size_t row = rowb + tt;
        const float mean = wave_sum((acc[tt][0] + acc[tt][1]) + (acc[tt][2] + acc[tt][3])) * (1.f / 256.f);
        const f32x4 d = acc[tt] - mean;
        const float rstd = 1.f / sqrtf(wave_sum((d[0] * d[0] + d[1] * d[1]) + (d[2] * d[2] + d[3] * d[3])) * (1.f / 256.f) + LN_EPS);
        const h4 z = *(const h4*)(PSZC + row * 256 + 4 * lane); float o[4];
#pragma unroll
        for (int k = 0; k < 4; ++k) o[k] = silu(d[k] * rstd * cg[k] + cb[k]) * (float)z[k];
        u32x2 w; w.x = pkh(o[0], o[1]); w.y = pkh(o[2], o[3]);
        *(u32x2*)(MIX + row * D + 4 * lane) = w; }
}
DI void task_pool(const Params& p, int l, int R0, int th, int g, LAS unsigned char* lds, int wave, int lane) {
    const u16* PPV = (const u16*)(p.ws + WS_PPV); const u16* PSZP = (const u16*)(p.ws + WS_PSZP); u16* MIX = (u16*)(p.ws + WS_MIX);
    const int b = R0 >> 12, T0 = (R0 & (SEQ - 1)) + 32 * th; const size_t rb = (size_t)b * SEQ;
    LAS unsigned char* scr = lds + MX_SCR + wave * MX_SCR_W;
    const int r = lane & 31, h = lane >> 5;
    u32x4 tl[6];
#pragma unroll
    for (int i = 0; i < 6; ++i) { const int row = (lane >> 3) + 8 * i, tk = T0 - 15 + row; const int tkc = tk < 0 ? 0 : (row < 47 ? tk : T0 + 31);
        const u32x4 v = *(const u32x4*)(PPV + (rb + tkc) * 256 + 64 * g + 8 * (lane & 7)); const unsigned msk = (unsigned)-(int)(tk >= 0); tl[i] = (u32x4){v[0] & msk, v[1] & msk, v[2] & msk, v[3] & msk}; }
    const size_t orow = rb + T0 + r;
    u32x2 zp[2][4]; f32x4 ps[2][4];
#pragma unroll
    for (int nb = 0; nb < 2; ++nb)
#pragma unroll
        for (int xq = 0; xq < 4; ++xq) { const int col = 64 * g + 32 * nb + 8 * xq + 4 * h; zp[nb][xq] = *(const u32x2*)(PSZP + orow * 256 + col); ps[nb][xq] = *(const f32x4*)(p.pool_scale + l * 256 + col); }
#pragma unroll
    for (int i = 0; i < 6; ++i) { const int row = (lane >> 3) + 8 * i; if (row < 47) *(LAS u32x4*)(scr + row * 144 + (lane & 7) * 16) = tl[i]; }
    asm volatile("s_waitcnt lgkmcnt(0)" ::: "memory");
    const int wlen = 2 << g; const int t = T0 + r; const float icnt = 1.f / (float)(wlen < t + 1 ? wlen : t + 1);
    h8 bf[4];
#pragma unroll
    for (int s = 0; s < 4; ++s) { const LAS unsigned char* base = scr + (15 + r) * 144 + (16 * s + 8 * h) * 2; float sm[8];
        const h8 cur = *(const LAS h8*)base;
#pragma unroll
        for (int k = 0; k < 8; ++k) sm[k] = (float)cur[k];
        for (int i = 1; i < wlen; ++i) { const h8 v = *(const LAS h8*)(base - i * 144);
#pragma unroll
            for (int k = 0; k < 8; ++k) sm[k] += (float)v[k]; }
        float pl[8];
#pragma unroll
        for (int k = 0; k < 8; ++k) pl[k] = sm[k] * icnt - (float)cur[k];
        bf[s] = __builtin_bit_cast(h8, pack8(pl)); }
    f32x16 Dd[2];
#pragma unroll
    for (int x = 0; x < 16; ++x) { Dd[0][x] = 0.f; Dd[1][x] = 0.f; }
#pragma unroll
    for (int s = 0; s < 4; ++s)
#pragma unroll
        for (int nb = 0; nb < 2; ++nb) { const h8 af = *(const LAS h8*)(lds + MX_WPT + ((g * 64 + 32 * nb + r) * 72 + 16 * s + 8 * h) * 2);
            Dd[nb] = __builtin_amdgcn_mfma_f32_32x32x16_f16(af, bf[s], Dd[nb], 0, 0, 0); }
#pragma unroll
    for (int nb = 0; nb < 2; ++nb)
#pragma unroll
        for (int xq = 0; xq < 4; ++xq) { const int col = 64 * g + 32 * nb + 8 * xq + 4 * h; const h4 z = __builtin_bit_cast(h4, zp[nb][xq]); const f32x4 sc = ps[nb][xq];
            u32x2 w; w.x = pkh(Dd[nb][4 * xq] * sc[0] * (float)z[0], Dd[nb][4 * xq + 1] * sc[1] * (float)z[1]); w.y = pkh(Dd[nb][4 * xq + 2] * sc[2] * (float)z[2], Dd[nb][4 * xq + 3] * sc[3] * (float)z[3]);
            *(u32x2*)(MIX + orow * D + 256 + col) = w; }
}
DI void mix_prompt_tasks(const Params& p, int l, int unit, LAS unsigned char* lds, int lane, int wave) {
    int one = 1; asm volatile("" : "+s"(one));
    if (one) task_attn(p, l, unit >> 6, (unit >> 5) & 1, wave & 3, (unit & 31) * 128 + 32 * (wave >> 2), lane_id());
    asm volatile("" : "+s"(one) :: "memory");
    if (one) task_attn(p, l, unit >> 6, (unit >> 5) & 1, wave & 3, (unit & 31) * 128 + 32 * (2 + (wave >> 2)), lane_id());
    asm volatile("s_waitcnt vmcnt(0) lgkmcnt(0)\n\ts_barrier" : "+s"(one) :: "memory");
    if (one) task_conv(p, l, unit * 64, wave, lds, lane_id());
    asm volatile("s_waitcnt lgkmcnt(0)\n\ts_barrier" : "+s"(one) :: "memory");
    if (one) task_pool(p, l, unit * 64, wave >> 2, wave & 3, lds, wave, lane_id());
    (void)lane;
}

DI void convpool_sample_unit(const Params& p, const MixPtrs& X, int l, int b, int part, LAS unsigned char* lds, int tid, int lane, int wave) {
    LAS float* cv = (LAS float*)lds;
    const int c = tid & 255, tp = tid >> 8; const size_t r0 = (size_t)MP + 4 * b;
    if (part == 0) {
        const float* cc = p.cache_conv + (size_t)(l * DB + b) * 30 * 256;
        float xa[34], wv[31];
        { const float* pc = cc + c;
#pragma unroll
          for (int ri = 0; ri < 30; ++ri) xa[ri] = pc[ri * 256];
          const u16* pn = X.PA + r0 * 256 + c;
#pragma unroll
          for (int ri = 0; ri < 4; ++ri) xa[30 + ri] = (float)(*(const _Float16*)(pn + ri * 256));
          const float* pw = p.conv_w + (size_t)l * 31 * 256 + c;
#pragma unroll
          for (int j = 0; j < 31; ++j) wv[j] = pw[j * 256]; }
        float a0 = p.conv_b[l * 256 + c], a1 = a0;
        if (tp == 0) {
#pragma unroll
            for (int j = 0; j < 31; ++j) { a0 += wv[j] * xa[j]; a1 += wv[j] * xa[j + 1]; }
        } else {
#pragma unroll
            for (int j = 0; j < 31; ++j) { a0 += wv[j] * xa[j + 2]; a1 += wv[j] * xa[j + 3]; } }
        cv[(2 * tp) * 256 + c] = a0; cv[(2 * tp + 1) * 256 + c] = a1;
        { float* oc = p.out + OFF_CONVS + (size_t)(l * DB + b) * 30 * 256; for (int e = tid; e < 26 * 64; e += NTHR) *(f32x4*)(oc + 4 * e) = *(const f32x4*)(cc + 4 * 256 + 4 * e); }
        __syncthreads();
        if (wave < 4) { const int t = wave; const f32x4 v = *(const LAS f32x4*)(cv + t * 256 + 4 * lane);
            const float mean = wave_sum((v[0] + v[1]) + (v[2] + v[3])) * (1.f / 256.f); const f32x4 d = v - mean;
            const float rstd = 1.f / sqrtf(wave_sum((d[0] * d[0] + d[1] * d[1]) + (d[2] * d[2] + d[3] * d[3])) * (1.f / 256.f) + LN_EPS);
            const f32x4 cg = *(const f32x4*)(p.cnorm_g + l * 256 + 4 * lane), cb = *(const f32x4*)(p.cnorm_b + l * 256 + 4 * lane);
            const h4 zc = *(const h4*)(X.PSZC + (r0 + t) * 256 + 4 * lane); float o[4];
#pragma unroll
            for (int k = 0; k < 4; ++k) o[k] = silu(d[k] * rstd * cg[k] + cb[k]) * (float)zc[k];
            u32x2 w; w.x = pkh(o[0], o[1]); w.y = pkh(o[2], o[3]);
            *(u32x2*)(X.MIX + (r0 + t) * D + 4 * lane) = w; }
    } else {
        const float* cp = p.cache_pool + (size_t)(l * DB + b) * 15 * 256;
        float xa[19];
        { const float* pc = cp + c;
#pragma unroll
          for (int ri = 0; ri < 15; ++ri) xa[ri] = pc[ri * 256];
          const u16* pn = X.PPV + r0 * 256 + c;
#pragma unroll
          for (int ri = 0; ri < 4; ++ri) xa[15 + ri] = (float)(*(const _Float16*)(pn + ri * 256)); }
        const int wlen = 2 << (c >> 6); float s0 = 0.f, s1 = 0.f, c0, c1;
        if (tp == 0) { c0 = xa[15]; c1 = xa[16];
#pragma unroll
            for (int i = 0; i < 16; ++i) if (i < wlen) { s0 += xa[15 - i]; s1 += xa[16 - i]; }
        } else { c0 = xa[17]; c1 = xa[18];
#pragma unroll
            for (int i = 0; i < 16; ++i) if (i < wlen) { s0 += xa[17 - i]; s1 += xa[18 - i]; } }
        const float iw = 1.f / (float)wlen;
        cv[(2 * tp) * 256 + c] = s0 * iw - c0; cv[(2 * tp + 1) * 256 + c] = s1 * iw - c1;
        { float* op = p.out + OFF_POOLS + (size_t)(l * DB + b) * 15 * 256; for (int e = tid; e < 11 * 64; e += NTHR) *(f32x4*)(op + 4 * e) = *(const f32x4*)(cp + 4 * 256 + 4 * e); }
        __syncthreads();
        const int g = c >> 6, n = c & 63; const float* pw = p.pool_w + ((size_t)l * 4 + g) * 64 * 64 + n; float y0 = 0.f, y1 = 0.f;
#pragma unroll 16
        for (int k = 0; k < 64; ++k) { const float w = pw[(size_t)k * 64]; y0 += cv[(2 * tp) * 256 + 64 * g + k] * w; y1 += cv[(2 * tp + 1) * 256 + 64 * g + k] * w; }
        const float ps = p.pool_scale[l * 256 + c];
        const float z0 = (float)(*(const _Float16*)(X.PSZP + (r0 + 2 * tp) * 256 + c)), z1 = (float)(*(const _Float16*)(X.PSZP + (r0 + 2 * tp + 1) * 256 + c));
        *(_Float16*)(X.MIX + (r0 + 2 * tp) * D + 256 + c) = (_Float16)(y0 * ps * z0); *(_Float16*)(X.MIX + (r0 + 2 * tp + 1) * D + 256 + c) = (_Float16)(y1 * ps * z1); }
    __syncthreads();
}

DI void attn_sample_unit(const Params& p, const MixPtrs& X, int l, int unit, LAS unsigned char* lds, int tid, int lane, int wave) {
    const int b = unit >> 1, hk = unit & 1; const size_t r0 = (size_t)MP + 4 * b;
    LAS float* Ks = (LAS float*)lds;
    LAS float* Vs = Ks + 132 * 65;
    LAS float* Qs = Vs + 132 * 64;
    LAS float* Ss = Qs + 16 * 65;
    const float* ck = p.cache_k + ((size_t)(l * DB + b) * 128 * 2 + hk) * 64; const float* cvv = p.cache_v + ((size_t)(l * DB + b) * 128 * 2 + hk) * 64;
    float* ok = p.out + OFF_KS + ((size_t)(l * DB + b) * 128 * 2 + hk) * 64; float* ov = p.out + OFF_VS + ((size_t)(l * DB + b) * 128 * 2 + hk) * 64;
#pragma unroll
    for (int i = 0; i < 4; ++i) { const int e = tid + 512 * i, j = e >> 4, d4 = (e & 15) * 4;
        const f32x4 kv = *(const f32x4*)(ck + (size_t)j * 128 + d4), vv = *(const f32x4*)(cvv + (size_t)j * 128 + d4);
        Ks[j * 65 + d4] = kv[0]; Ks[j * 65 + d4 + 1] = kv[1]; Ks[j * 65 + d4 + 2] = kv[2]; Ks[j * 65 + d4 + 3] = kv[3];
        *(LAS f32x4*)(Vs + j * 64 + d4) = vv;
        if (j >= 4) { *(f32x4*)(ok + (size_t)(j - 4) * 128 + d4) = kv; *(f32x4*)(ov + (size_t)(j - 4) * 128 + d4) = vv; } }
    if (tid < 256) { const int t = tid >> 6, d = tid & 63;
        Ks[(128 + t) * 65 + d] = (float)(*(const _Float16*)(X.PK + (r0 + t) * 128 + hk * 64 + d));
        Vs[(128 + t) * 64 + d] = (float)(*(const _Float16*)(X.PV + (r0 + t) * 128 + hk * 64 + d)); }
#pragma unroll
    for (int i = 0; i < 2; ++i) { const int e = tid + 512 * i, qr = e >> 6, d = e & 63, t = qr >> 2, g = qr & 3;
        Qs[qr * 65 + d] = (float)(*(const _Float16*)(X.PQ + (r0 + t) * 512 + (4 * hk + g) * 64 + d)); }
    __syncthreads();
    { const int qr = tid & 15, kg = tid >> 4, t = qr >> 2;
        for (int kk = kg; kk < 132; kk += 32) { float s = 0.f;
#pragma unroll 16
            for (int d = 0; d < 64; ++d) s += Qs[qr * 65 + d] * Ks[kk * 65 + d];
            Ss[qr * 133 + kk] = (kk >= t + 1 && kk <= t + 128) ? s : -INFINITY; } }
    __syncthreads();
#pragma unroll
    for (int q2 = 0; q2 < 2; ++q2) { const int qr = 2 * wave + q2, g = qr & 3; const float sink2 = p.sinks[l * 8 + 4 * hk + g] * LOG2E;
        float s0 = Ss[qr * 133 + lane], s1 = Ss[qr * 133 + 64 + lane], s2 = lane < 4 ? Ss[qr * 133 + 128 + lane] : -INFINITY;
        const float mx = fmaxf(wave_max(fmaxf(fmaxf(s0, s1), s2)), sink2);
        s0 = ex2(s0 - mx); s1 = ex2(s1 - mx); s2 = ex2(s2 - mx);
        const float inv = 1.f / (wave_sum(s0 + s1 + s2) + ex2(sink2 - mx));
        Ss[qr * 133 + lane] = s0 * inv; Ss[qr * 133 + 64 + lane] = s1 * inv; if (lane < 4) Ss[qr * 133 + 128 + lane] = s2 * inv; }
    __syncthreads();
    { const int qr = tid & 15, dg = tid >> 4, t = qr >> 2, g = qr & 3; float o0 = 0.f, o1 = 0.f;
#pragma unroll 4
        for (int kk = 0; kk < 132; ++kk) { const float pr = Ss[qr * 133 + kk]; const f32x2 v = *(const LAS f32x2*)(Vs + kk * 64 + 2 * dg); o0 += pr * v[0]; o1 += pr * v[1]; }
        const int col = (4 * hk + g) * 64 + 2 * dg;
        const h2 z = *(const h2*)(X.PSZA + (r0 + t) * 512 + col);
        *(unsigned*)(X.MIX + (r0 + t) * D + 512 + col) = pkh(o0 * (float)z[0], o1 * (float)z[1]); }
    __syncthreads();
}


DI void sample_ln_rows(const Params& p, int l, int R0, int wave, int lane) {
    const u16* ZH = (const u16*)(p.ws + WS_ZH); u16* XR = (u16*)(p.ws + WS_XR); u16* ZP = (u16*)(p.ws + WS_H);
    const float* lg = p.ln_g + (size_t)l * D; const float* lb = p.ln_b + (size_t)l * D;
    const float* modn = (const float*)(p.ws + WS_MOD) + (size_t)(l + 1) * NMOD * 3072;
#pragma unroll 1
    for (int i0 = 0; i0 < 8; i0 += 4) {
        float v[4][16], mean[4], rstd[4];
#pragma unroll
        for (int r = 0; r < 4; ++r)
#pragma unroll
            for (int j2 = 0; j2 < 2; ++j2) unpack8(*(const u32x4*)(ZH + (size_t)(R0 + 8 * wave + i0 + r) * D + 512 * j2 + 8 * lane), v[r] + 8 * j2);
        ln_stats<4>(v, mean, rstd);
#pragma unroll
        for (int j2 = 0; j2 < 2; ++j2)
#pragma unroll
            for (int h = 0; h < 2; ++h) { const f32x4 g = *(const f32x4*)(lg + 512 * j2 + 8 * lane + 4 * h), bb = *(const f32x4*)(lb + 512 * j2 + 8 * lane + 4 * h);
#pragma unroll
                for (int r = 0; r < 4; ++r)
#pragma unroll
                    for (int k = 0; k < 4; ++k) v[r][8 * j2 + 4 * h + k] = v[r][8 * j2 + 4 * h + k] * rstd[r] * g[k] + bb[k]; }
        if (l == DEPTH - 1) {
#pragma unroll
            for (int r = 0; r < 4; ++r) { float* y = p.out + OFF_YS + (size_t)(R0 - MP + 8 * wave + i0 + r) * D;
#pragma unroll
                for (int j2 = 0; j2 < 2; ++j2)
#pragma unroll
                    for (int h = 0; h < 2; ++h) *(f32x4*)(y + 512 * j2 + 8 * lane + 4 * h) = (f32x4){v[r][8 * j2 + 4 * h], v[r][8 * j2 + 4 * h + 1], v[r][8 * j2 + 4 * h + 2], v[r][8 * j2 + 4 * h + 3]}; }
        } else {
#pragma unroll
            for (int r = 0; r < 4; ++r)
#pragma unroll
                for (int j2 = 0; j2 < 2; ++j2) *(u32x4*)(XR + (size_t)(R0 + 8 * wave + i0 + r) * D + 512 * j2 + 8 * lane) = pack8(v[r] + 8 * j2);
            ln_stats<4>(v, mean, rstd);
#pragma unroll
            for (int r = 0; r < 4; ++r) { const int row = R0 + 8 * wave + i0 + r; const float* sh = modn + (size_t)(NB + ((row - MP) >> 2)) * 3072; const float* sc = sh + 1024;
#pragma unroll
                for (int j2 = 0; j2 < 2; ++j2) { float o[8];
#pragma unroll
                    for (int h = 0; h < 2; ++h) { const f32x4 a = *(const f32x4*)(sc + 512 * j2 + 8 * lane + 4 * h), bb = *(const f32x4*)(sh + 512 * j2 + 8 * lane + 4 * h);
#pragma unroll
                        for (int k = 0; k < 4; ++k) o[4 * h + k] = v[r][8 * j2 + 4 * h + k] * rstd[r] * (1.f + a[k]) + bb[k]; }
                    *(u32x4*)(ZP + (size_t)row * D + 512 * j2 + 8 * lane) = pack8(o); } }
        }
    }
}
DI void outproj_sample_unit(const Params& p, int l, int unit, LAS unsigned char* lds, int tid, int lane, int wave) {
    const int rbk0 = unit >> 5, cb = unit & 31, R0 = MP + 64 * rbk0, n0 = 32 * cb, r = lane & 31, h = lane >> 5;
    const u16* MIX = (const u16*)(p.ws + WS_MIX); const u16* WT = (const u16*)(p.ws + WS_WOUT) + (size_t)l * D * D;
    const u16* bp = WT + (size_t)perm_out(n0 + r) * D + wave * 128 + 8 * h;
    const u16* ap = MIX + (size_t)(R0 + r) * D + wave * 128 + 8 * h;
    f32x16 acc[2];
#pragma unroll
    for (int x = 0; x < 16; ++x) { acc[0][x] = 0.f; acc[1][x] = 0.f; }
#pragma unroll
    for (int s = 0; s < 8; ++s) { const h8 bf = *(const h8*)(bp + 16 * s);
#pragma unroll
        for (int rb = 0; rb < 2; ++rb) { const h8 af = *(const h8*)(ap + (size_t)rb * 32 * D + 16 * s); acc[rb] = __builtin_amdgcn_mfma_f32_32x32x16_f16(af, bf, acc[rb], 0, 0, 0); } }
    LAS float* part = (LAS float*)lds;
    LAS unsigned* flag = (LAS unsigned*)(lds + 65536);
#pragma unroll
    for (int rb = 0; rb < 2; ++rb)
#pragma unroll
        for (int x = 0; x < 16; ++x) part[(wave * 64 + 32 * rb + crow(x, h)) * 32 + r] = acc[rb][x];
    __syncthreads();
    const float* modl = (const float*)(p.ws + WS_MOD) + (size_t)l * NMOD * 3072;
#pragma unroll
    for (int q = 0; q < 4; ++q) { const int o = tid + 512 * q, row = o >> 5, col = o & 31; float sum = 0.f;
#pragma unroll
        for (int w = 0; w < 8; ++w) sum += part[(w * 64 + row) * 32 + col];
        const int grow = R0 + row, bidx = NB + ((grow - MP) >> 2);
        const float xr = (float)(*(const _Float16*)((const u16*)(p.ws + WS_XR) + (size_t)grow * D + n0 + col));
        *(_Float16*)((u16*)(p.ws + WS_ZH) + (size_t)grow * D + n0 + col) = (_Float16)(ALPHA * xr + (1.f + modl[(size_t)bidx * 3072 + 2048 + n0 + col]) * sum); }
    asm volatile("s_waitcnt vmcnt(0)" ::: "memory");
    __syncthreads();
    if (tid == 0) {
        __builtin_amdgcn_fence(__ATOMIC_RELEASE, "agent"); asm volatile("s_waitcnt vmcnt(0)" ::: "memory");
        unsigned* cnt = (unsigned*)(p.ws + WS_CTL) + CW_SCNT + 64 * (l * 8 + rbk0);
        const unsigned old = __hip_atomic_fetch_add(cnt, 1u, __ATOMIC_RELAXED, __HIP_MEMORY_SCOPE_AGENT);
        const unsigned last = old == 31u ? 1u : 0u;
        if (last) { __builtin_amdgcn_fence(__ATOMIC_ACQUIRE, "agent"); asm volatile("s_waitcnt vmcnt(0)" ::: "memory"); }
        *flag = last; }
    __syncthreads();
    if (*flag != 0u) sample_ln_rows(p, l, R0, wave, lane);
    __syncthreads();
}

constexpr int N_PHASES = 3 + 3 * DEPTH;
typedef const __attribute__((address_space(4))) Params* KParams;
#define PHASE_BEGIN() const int lane_ = lane_id(); const int lane = lane_, wave = wave_s, tid = wave_s * 64 + lane_; \
    KParams kq = kp; asm volatile("" : "+s"(kq)); Params p; { const ParamsHead hh_ = *(const __attribute__((address_space(4))) ParamsHead*)kq; __builtin_memcpy(&p, &hh_, sizeof(ParamsHead)); }     const int gw = vcu * NWAVES + wave, NGW = G * NWAVES; (void)lane; (void)gw; (void)NGW
#define MIXPTRS() MixPtrs X; X.PA = (const u16*)(p.ws + WS_PA); X.PSZC = (const u16*)(p.ws + WS_PSZC); X.PPV = (const u16*)(p.ws + WS_PPV); X.PSZP = (const u16*)(p.ws + WS_PSZP); \
    X.PQ = (const u16*)(p.ws + WS_PQ); X.PSZA = (const u16*)(p.ws + WS_PSZA); X.PK = (const u16*)(p.ws + WS_PK); X.PV = (const u16*)(p.ws + WS_PV); X.MIX = (u16*)(p.ws + WS_MIX)
__global__ void __launch_bounds__(NTHR, 2) hymba_fwd(Params p_unused) {
#if defined(__HIP_DEVICE_COMPILE__)
    extern __shared__ __attribute__((aligned(16))) unsigned char lds_raw[];
    LAS unsigned char* lds = (LAS unsigned char*)lds_raw;
    volatile LAS unsigned* MISC = (volatile LAS unsigned*)(lds + MISC_OFF);
    const KParams kp = (KParams)__builtin_amdgcn_kernarg_segment_ptr();
    const int G = gridDim.x, bx = blockIdx.x, vcu = (G % 8 == 0) ? (bx % 8) * (G / 8) + bx / 8 : bx;
    const int wave_s = __builtin_amdgcn_readfirstlane((int)threadIdx.x >> 6);
    for (int u = threadIdx.x; u < (LDS_BYTES - RING_BYTES) / 4; u += NTHR) ((LAS unsigned*)(lds + RING_BYTES))[u] = 0u;
    __syncthreads();
    unsigned* ctl = (unsigned*)(kp->ws + WS_CTL);
    XcdBarrier bar; bar.bar = ctl + CW_BAR; bar.x = 0; bar.st = nullptr;
    if (MK_N_LAUNCHES == 1) bar = xcd_barrier_post(ctl + CW_BAR, MISC + 8);
    const int lo = kp->ph_lo, hi = kp->ph_hi;
#ifndef ONLY
#define ONLY -1
#endif
#ifndef ONLYMASK
#define ONLYMASK 0x3f
#endif
#define EN(t) ((ONLY < 0 || ONLY == (t)) && ((ONLYMASK >> (t)) & 1))
#define IN(k) (lo <= (k) && (k) < hi)
#define SEAM(k) do { if (MK_N_LAUNCHES == 1 && IN((k) + 1)) xcd_barrier(bar, wave_s); } while (0)
    if (EN(0) && IN(0)) { { PHASE_BEGIN(); p0_prologue(p, (const __attribute__((address_space(4))) float*)((const __attribute__((address_space(4))) char*)kq + __builtin_offsetof(Params, inv_freq)), lds, vcu, G, tid, lane, wave); } SEAM(0); }
    if (EN(1) && IN(1)) { { PHASE_BEGIN(); for (int u = vcu; u < DEPTH * 40; u += G) modv_unit(p, lds, u, tid, lane, wave); pre_phase(p, gw, NGW, lane); } SEAM(1); }
#pragma unroll 1
    for (int l = 0; l < DEPTH; ++l) {
        const int ph = 2 + 3 * l;
        if (EN(2) && IN(ph)) {
            { PHASE_BEGIN();
            pg8::Gemm g{(const u16*)(p.ws + WS_H), (const u16*)(p.ws + WS_WIN) + (size_t)l * DIN * D, M, DIN, D};
            pg8::StaticOrder S; S.init(M, DIN, G, bx);
            LAS float* rcl = (LAS float*)(lds + RING_BYTES + 1024);
            for (int i = 0; i < 3; ++i) { pg8::Unit u; if (S.next(i, u) && u.pm < MP / 256) finalize_rc_in(p, l, u.pm, rcl + i * 1024, tid); }
            asm volatile("s_waitcnt lgkmcnt(0)" ::: "memory"); __syncthreads();
            EpiIn E{l, p.ws, p.out, rcl};
            pg8::gemm_phase<EpiIn, true>(lds, g, S, E, tid); }
            SEAM(ph);
        }
        if (EN(3) && IN(ph + 1)) {
            { PHASE_BEGIN(); MIXPTRS(); for (int u = vcu; u < 256; u += G) attn_prompt_unit(p, X, l, u, lds, tid, lane, wave); }
            { PHASE_BEGIN(); MIXPTRS(); for (int u = vcu; u < 256; u += G) conv_prompt_unit(p, X, l, u, lds, tid, lane, wave); }
            { PHASE_BEGIN(); MIXPTRS(); for (int u = vcu; u < 256; u += G) pool_prompt_unit(p, X, l, u, lds, tid, lane, wave); }
            { PHASE_BEGIN(); MIXPTRS(); for (int u = vcu; u < 256; u += G) attn_sample_unit(p, X, l, u, lds, tid, lane, wave); }
            { PHASE_BEGIN(); MIXPTRS(); for (int u = vcu; u < 2 * DB; u += G) convpool_sample_unit(p, X, l, u >> 1, u & 1, lds, tid, lane, wave); }
            SEAM(ph + 1); }
        if (EN(4) && IN(ph + 2)) {
            { PHASE_BEGIN();
            pg8::Gemm g{(const u16*)(p.ws + WS_MIX), (const u16*)(p.ws + WS_WOUT) + (size_t)l * D * D, M, D, D};
            pg8::StaticOrder S; S.init(MP, D, G, bx);
            EpiOutF E{p.ws, l, p.ln_g, p.ln_b};
            pg8::gemm_phase<EpiOutF, false>(lds, g, S, E, tid);
            __syncthreads();
            for (int u = vcu; u < 256; u += G) outproj_sample_unit(p, l, u, lds, tid, lane, wave); }
            SEAM(ph + 2);
        }
    }
    if (EN(5) && IN(N_PHASES - 1)) { PHASE_BEGIN(); fin_phase(p, gw, NGW, lane); }
#undef IN
#undef SEAM
#endif
}


#ifdef DBG
constexpr int DBG_NS = 56;
constexpr size_t WS_DBGACC = 32 * 1024;
constexpr size_t WS_DBGZ = WS_END;
__constant__ int dbg_rows_tab[DBG_NS] = {0, 1, 2, 3, 14, 15, 16, 29, 30, 31, 32, 63, 64, 65, 127, 128, 129, 255, 256, 1000, 2047, 2048, 3967, 3968, 4065, 4066, 4080, 4081, 4094, 4095, 4096, 4097, 4127, 4224,
                            8191, 8192, 8320, 12288, 12415, 16382, 16383, 16384, 16385, 16386, 16387, 16388, 16391, 16639, 16640, 16892, 16893, 16894, 16895, 5000, 9999, 15000};
__device__ int dbg_row(int i) { return dbg_rows_tab[i]; }
__device__ void dbg_acc(float* accf, int id, float e, float r) {
    __shared__ float se[256], sr[256];
    const int t = threadIdx.x; se[t] = e; sr[t] = r; __syncthreads();
    for (int o = 128; o > 0; o >>= 1) { if (t < o) { se[t] += se[t + o]; sr[t] += sr[t + o]; } __syncthreads(); }
    if (t == 0) { atomicAdd(accf + 2 * id, se[0]); atomicAdd(accf + 2 * id + 1, sr[0]); }
    __syncthreads();
}
__device__ float dbg_h(const u16* p, size_t i) { return (float)(*(const _Float16*)(p + i)); }
__device__ float dbg_block_sum(float v) { __shared__ float sb[256]; const int t = threadIdx.x; sb[t] = v; __syncthreads(); for (int o = 128; o > 0; o >>= 1) { if (t < o) sb[t] += sb[t + o]; __syncthreads(); } const float r = sb[0]; __syncthreads(); return r; }
__device__ void dbg_ln4(float (&x)[4], float& rstd) { const float mean = dbg_block_sum(x[0] + x[1] + x[2] + x[3]) / D; float q = 0; for (int i = 0; i < 4; ++i) { x[i] -= mean; q += x[i] * x[i]; } rstd = 1.f / sqrtf(dbg_block_sum(q) / D + LN_EPS); }
#define DBG_E(fast, ref) do { const float f_ = (fast), r_ = (ref); e += (f_ - r_) * (f_ - r_); rr += r_ * r_; } while (0)
__global__ void __launch_bounds__(256) dbg_p0(Params p) {
    float* accf = (float*)(p.ws + WS_DBGACC); const int t = threadIdx.x, bid = blockIdx.x;
    { float e = 0, rr = 0; const int ri = (bid >> 2) % 9;
        const int l = bid & 3, row = ri < 6 ? ri : (ri == 6 ? 67 : 123 + ri);
        const float* c = row < NB ? p.c_prompt + (size_t)row * D : p.c_sample + (size_t)(row - NB) * D;
        for (int n = t * 12 + (bid % 12); n < 3072; n += 256 * 12) { float a = p.b_mod[l * 3072 + n];
            for (int k = 0; k < D; ++k) { const float x = c[k]; a += x / (1.f + expf(-x)) * p.w_mod[((size_t)l * D + k) * 3072 + n]; }
            DBG_E(((const float*)(p.ws + WS_MOD))[((size_t)l * NMOD + row) * 3072 + n], a); }
        dbg_acc(accf, 0, e, rr); }
    { float e = 0, rr = 0;
        for (int i = 0; i < 64; ++i) { const int l = bid & 3, col = (bid * 37 + i * 41 + t * 10) % DIN, k = (t * 4 + i * 16 + bid) % D;
            DBG_E(dbg_h((const u16*)(p.ws + WS_WIN), ((size_t)l * DIN + perm_in(col)) * D + k), p.w_in[((size_t)l * D + k) * DIN + col]); }
        dbg_acc(accf, 1, e, rr); }
    { float e = 0, rr = 0;
        for (int i = 0; i < 64; ++i) { const int l = bid & 3, col = (bid * 37 + i * 41 + t * 4) % D, k = (t * 4 + i * 16 + bid) % D;
            DBG_E(dbg_h((const u16*)(p.ws + WS_WOUT), ((size_t)l * D + perm_out(col)) * D + k), p.w_out[((size_t)l * D + k) * D + col]); }
        dbg_acc(accf, 2, e, rr); }
    { float e = 0, rr = 0;
        for (int i = 0; i < 16; ++i) { const int pi = (bid * 113 + i * 257 + t * 16) % (SEQ + DS), f = (t + i) & 31; const int pos = pi < SEQ ? pi : PAST + pi - SEQ;
            const float ang = (float)pos * p.inv_freq[f]; const f32x2 cs = ((const f32x2*)(p.ws + WS_TAB))[pi * 32 + f];
            DBG_E(cs[0], cosf(ang)); DBG_E(cs[1], sinf(ang)); }
        dbg_acc(accf, 3, e, rr); }
}
__global__ void __launch_bounds__(256) dbg_p0b(Params p) {
    float* accf = (float*)(p.ws + WS_DBGACC); const int t = threadIdx.x, bid = blockIdx.x;
    { float e = 0, rr = 0;
        const int l = bid & 3, b = (bid >> 2) & 3; const float* md = (const float*)(p.ws + WS_MOD) + ((size_t)l * NMOD + b) * 3072;
        const int col = (t * 10 + (bid >> 4) * 3 + 1) % DIN; float v1 = 0, v2 = 0, v3 = 0, v4 = 0;
        for (int c = 0; c < D; ++c) { const float w = p.w_in[((size_t)l * D + c) * DIN + col], g = l > 0 ? p.ln_g[(l - 1) * D + c] : 1.f, bb = l > 0 ? p.ln_b[(l - 1) * D + c] : 0.f, s1 = 1.f + md[1024 + c];
            v1 += g * s1 * w; v2 += bb * s1 * w; v3 += s1 * w; v4 += md[c] * w; }
        const float* mv = (const float*)(p.ws + WS_MODV) + (size_t)(l * NB + b) * 4 * DIN + perm_in(col);
        DBG_E(mv[0], v1); DBG_E(mv[2 * DIN], v3); DBG_E(mv[3 * DIN], v4); if (l > 0) DBG_E(mv[DIN], v2); else e += mv[DIN] * mv[DIN];
        dbg_acc(accf, 69, e, rr); }
    if (bid < DBG_NS) { const int row = dbg_row(bid); const bool smp = row >= MP; const int bidx = smp ? NB + ((row - MP) >> 2) : (row >> 12);
        const float* md = (const float*)(p.ws + WS_MOD) + (size_t)bidx * 3072;
        float x[4]; for (int i = 0; i < 4; ++i) { const int c = t + 256 * i; x[i] = smp ? p.x_sample[(size_t)(row - MP) * D + c] : p.x_prompt[(size_t)row * D + c]; }
        float e = 0, rr = 0; for (int i = 0; i < 4; ++i) DBG_E(dbg_h((const u16*)(p.ws + (smp ? WS_XR : WS_ZH)), (size_t)row * D + t + 256 * i), x[i]); dbg_acc(accf, 70, e, rr);
        e = 0; rr = 0;
        if (!smp) { for (int i = 0; i < 4; ++i) { const int c = t + 256 * i; DBG_E(dbg_h((const u16*)(p.ws + WS_H), (size_t)row * D + c), x[i] * (1.f + md[1024 + c])); } }
        else { float rstd; dbg_ln4(x, rstd); for (int i = 0; i < 4; ++i) { const int c = t + 256 * i; DBG_E(dbg_h((const u16*)(p.ws + WS_H), (size_t)row * D + c), x[i] * rstd * (1.f + md[1024 + c]) + md[c]); } }
        dbg_acc(accf, 71, e, rr); }
}
__global__ void __launch_bounds__(256) dbg_copyz(Params p) { const int row = dbg_row(blockIdx.x);
    for (int c = threadIdx.x; c < D; c += 256) { ((u16*)(p.ws + WS_DBGZ))[blockIdx.x * D + c] = ((const u16*)(p.ws + WS_ZH))[(size_t)row * D + c]; ((u16*)(p.ws + WS_DBGZ))[(DBG_NS + blockIdx.x) * D + c] = ((const u16*)(p.ws + WS_XR))[(size_t)row * D + c]; } }
__global__ void __launch_bounds__(256) dbg_in(Params p, int l) {
    __shared__ float pr[DIN]; __shared__ float hh[D];
    float* accf = (float*)(p.ws + WS_DBGACC); const int t = threadIdx.x, row = dbg_row(blockIdx.x), base = 4 + 16 * l;
    const bool smp = row >= MP; const int b = smp ? (row - MP) >> 2 : row >> 12, tt = smp ? (row - MP) & 3 : row & (SEQ - 1), pos = smp ? PAST + tt : tt;
    const int bidx = smp ? NB + b : b; const float* md = (const float*)(p.ws + WS_MOD) + ((size_t)l * NMOD + bidx) * 3072;
    float e, rr;
    { float x[4]; float rstd;
        for (int i = 0; i < 4; ++i) x[i] = dbg_h((const u16*)(p.ws + (smp ? WS_XR : WS_ZH)), (size_t)row * D + t + 256 * i);
        if (!smp && l > 0) { dbg_ln4(x, rstd); for (int i = 0; i < 4; ++i) { const int c = t + 256 * i; x[i] = x[i] * rstd * p.ln_g[(l - 1) * D + c] + p.ln_b[(l - 1) * D + c]; } }
        dbg_ln4(x, rstd);
        for (int i = 0; i < 4; ++i) { const int c = t + 256 * i; hh[c] = x[i] * rstd * (1.f + md[1024 + c]) + md[c]; }
        __syncthreads();
        if (smp) { e = 0; rr = 0; for (int i = 0; i < 4; ++i) { const int c = t + 256 * i; DBG_E(dbg_h((const u16*)(p.ws + WS_H), (size_t)row * D + c), hh[c]); } dbg_acc(accf, base + 1, e, rr); } }
    for (int i = 0; i < 10; ++i) { const int col = t + 256 * i; float a = 0; for (int k = 0; k < D; ++k) a += hh[k] * p.w_in[((size_t)l * D + k) * DIN + col]; pr[col] = a; }
    __syncthreads();
    const float av = pr[t] / (1.f + expf(-pr[256 + t]));
    e = 0; rr = 0; DBG_E(dbg_h((const u16*)(p.ws + WS_PA), (size_t)row * 256 + t), av); dbg_acc(accf, base + 2, e, rr);
    e = 0; rr = 0; { const float z = pr[512 + t]; DBG_E(dbg_h((const u16*)(p.ws + WS_PSZC), (size_t)row * 256 + t), z / (1.f + expf(-z))); } dbg_acc(accf, base + 3, e, rr);
    e = 0; rr = 0; DBG_E(dbg_h((const u16*)(p.ws + WS_PPV), (size_t)row * 256 + t), pr[768 + t]); dbg_acc(accf, base + 4, e, rr);
    e = 0; rr = 0; { const float z = pr[1024 + t]; DBG_E(dbg_h((const u16*)(p.ws + WS_PSZP), (size_t)row * 256 + t), z / (1.f + expf(-z))); } dbg_acc(accf, base + 5, e, rr);
    e = 0; rr = 0;
    for (int i = 0; i < 2; ++i) { const int c = t + 256 * i, hd = c >> 6, d = c & 63, f = d & 31; const float ang = (float)pos * p.inv_freq[f], cs = cosf(ang), sn = sinf(ang);
        const float x = pr[1280 + c], xo = d < 32 ? -pr[1280 + hd * 64 + d + 32] : pr[1280 + hd * 64 + d - 32];
        DBG_E(dbg_h((const u16*)(p.ws + WS_PQ), (size_t)row * 512 + c), (x * cs + xo * sn) * QSCALE); }
    dbg_acc(accf, base + 6, e, rr);
    e = 0; rr = 0; float kref = 0.f, vref = 0.f;
    if (t < 128) { const int hd = t >> 6, d = t & 63, f = d & 31; const float ang = (float)pos * p.inv_freq[f], cs = cosf(ang), sn = sinf(ang);
        const float x = pr[1792 + t], xo = d < 32 ? -pr[1792 + hd * 64 + d + 32] : pr[1792 + hd * 64 + d - 32]; kref = x * cs + xo * sn;
        DBG_E(dbg_h((const u16*)(p.ws + WS_PK), (size_t)row * 128 + t), kref); }
    dbg_acc(accf, base + 7, e, rr);
    e = 0; rr = 0; if (t < 128) { vref = pr[1920 + t]; DBG_E(dbg_h((const u16*)(p.ws + WS_PV), (size_t)row * 128 + t), vref); } dbg_acc(accf, base + 8, e, rr);
    e = 0; rr = 0; for (int i = 0; i < 2; ++i) { const float z = pr[2048 + t + 256 * i]; DBG_E(dbg_h((const u16*)(p.ws + WS_PSZA), (size_t)row * 512 + t + 256 * i), z / (1.f + expf(-z))); } dbg_acc(accf, base + 9, e, rr);
    e = 0; rr = 0;
    if (smp) { DBG_E(p.out[OFF_CONVS + ((size_t)(l * DB + b) * 30 + 26 + tt) * 256 + t], av); DBG_E(p.out[OFF_POOLS + ((size_t)(l * DB + b) * 15 + 11 + tt) * 256 + t], pr[768 + t]);
        if (t < 128) { DBG_E(p.out[OFF_KS + ((size_t)(l * DB + b) * 128 + 124 + tt) * 128 + t], kref); DBG_E(p.out[OFF_VS + ((size_t)(l * DB + b) * 128 + 124 + tt) * 128 + t], vref); } }
    else { if (tt >= SEQ - 30) DBG_E(p.out[OFF_CONVP + ((size_t)(l * NB + b) * 30 + tt - (SEQ - 30)) * 256 + t], av);
        if (tt >= SEQ - 15) DBG_E(p.out[OFF_POOLP + ((size_t)(l * NB + b) * 15 + tt - (SEQ - 15)) * 256 + t], pr[768 + t]);
        if (tt >= SEQ - 128 && t < 128) { DBG_E(p.out[OFF_KP + ((size_t)(l * NB + b) * 128 + tt - (SEQ - 128)) * 128 + t], kref); DBG_E(p.out[OFF_VP + ((size_t)(l * NB + b) * 128 + tt - (SEQ - 128)) * 128 + t], vref); } }
    dbg_acc(accf, base + 10, e, rr);
}
__global__ void __launch_bounds__(256) dbg_mix(Params p, int l) {
    __shared__ float sh[1024]; __shared__ float sc[136];
    float* accf = (float*)(p.ws + WS_DBGACC); const int t = threadIdx.x, row = dbg_row(blockIdx.x), base = 4 + 16 * l;
    const bool smp = row >= MP; const int b = smp ? (row - MP) >> 2 : row >> 12, tt = smp ? (row - MP) & 3 : row & (SEQ - 1);
    const u16 *PA = (const u16*)(p.ws + WS_PA), *PSZC = (const u16*)(p.ws + WS_PSZC), *PPV = (const u16*)(p.ws + WS_PPV), *PSZP = (const u16*)(p.ws + WS_PSZP), *PQ = (const u16*)(p.ws + WS_PQ),
              *PSZA = (const u16*)(p.ws + WS_PSZA), *PK = (const u16*)(p.ws + WS_PK), *PV = (const u16*)(p.ws + WS_PV), *MIX = (const u16*)(p.ws + WS_MIX);
    float e, rr;
    {
        float a = p.conv_b[l * 256 + t];
        for (int j = 0; j < 31; ++j) { float x;
            if (!smp) { const int ts = tt - 30 + j; x = ts >= 0 ? dbg_h(PA, ((size_t)b * SEQ + ts) * 256 + t) : 0.f; }
            else { const int ri = tt + j; x = ri < 30 ? p.cache_conv[((size_t)(l * DB + b) * 30 + ri) * 256 + t] : dbg_h(PA, ((size_t)MP + 4 * b + ri - 30) * 256 + t); }
            a += p.conv_w[((size_t)l * 31 + j) * 256 + t] * x; }
        const float mean = dbg_block_sum(a) / 256.f; const float d = a - mean; const float rstd = 1.f / sqrtf(dbg_block_sum(d * d) / 256.f + LN_EPS);
        const float y = d * rstd * p.cnorm_g[l * 256 + t] + p.cnorm_b[l * 256 + t];
        e = 0; rr = 0; DBG_E(dbg_h(MIX, (size_t)row * D + t), y / (1.f + expf(-y)) * dbg_h(PSZC, (size_t)row * 256 + t)); dbg_acc(accf, base + 11, e, rr); }
    {
        const int w = 2 << (t >> 6); float s = 0;
        for (int i = 0; i < w; ++i) { float x;
            if (!smp) { const int ts = tt - i; x = ts >= 0 ? dbg_h(PPV, ((size_t)b * SEQ + ts) * 256 + t) : 0.f; }
            else { const int ri = 15 + tt - i; x = ri < 15 ? p.cache_pool[((size_t)(l * DB + b) * 15 + ri) * 256 + t] : dbg_h(PPV, ((size_t)MP + 4 * b + ri - 15) * 256 + t); }
            s += x; }
        const float cnt = smp ? (float)w : (float)(w < tt + 1 ? w : tt + 1);
        sh[t] = s / cnt - dbg_h(PPV, (size_t)row * 256 + t); __syncthreads();
        const int g = t >> 6, n = t & 63; float y = 0; for (int c = 0; c < 64; ++c) y += sh[64 * g + c] * p.pool_w[(((size_t)l * 4 + g) * 64 + c) * 64 + n];
        e = 0; rr = 0; DBG_E(dbg_h(MIX, (size_t)row * D + 256 + t), y * p.pool_scale[l * 256 + t] * dbg_h(PSZP, (size_t)row * 256 + t)); dbg_acc(accf, base + 12, e, rr); __syncthreads(); }
    {
        e = 0; rr = 0;
        for (int hd = 0; hd < 8; ++hd) { const int hk = hd >> 2; __syncthreads();
            if (t < 64) sh[t] = dbg_h(PQ, (size_t)row * 512 + hd * 64 + t); __syncthreads();
            const float sink2 = p.sinks[l * 8 + hd] * LOG2E;
            if (t < 128) { float s = -INFINITY;
                if (!smp) { const int ts = tt - 127 + t; if (ts >= 0) { s = 0; for (int d = 0; d < 64; ++d) s += sh[d] * dbg_h(PK, ((size_t)b * SEQ + ts) * 128 + hk * 64 + d); } }
                else { const int ci = tt + 1 + t;
                    s = 0; for (int d = 0; d < 64; ++d) s += sh[d] * (ci < 128 ? p.cache_k[(((size_t)(l * DB + b) * 128 + ci) * 2 + hk) * 64 + d] : dbg_h(PK, ((size_t)MP + 4 * b + ci - 128) * 128 + hk * 64 + d)); }
                sc[t] = s; }
            __syncthreads();
            float mx = sink2; for (int k = 0; k < 128; ++k) mx = fmaxf(mx, sc[k]);
            float den = exp2f(sink2 - mx); for (int k = 0; k < 128; ++k) den += exp2f(sc[k] - mx);
            if (t < 64) { float o = 0;
                for (int k = 0; k < 128; ++k) { const float pk = exp2f(sc[k] - mx) / den; if (pk == 0.f) continue; float v;
                    if (!smp) { const int ts = tt - 127 + k; v = dbg_h(PV, ((size_t)b * SEQ + ts) * 128 + hk * 64 + t); }
                    else { const int ci = tt + 1 + k; v = ci < 128 ? p.cache_v[(((size_t)(l * DB + b) * 128 + ci) * 2 + hk) * 64 + t] : dbg_h(PV, ((size_t)MP + 4 * b + ci - 128) * 128 + hk * 64 + t); }
                    o += pk * v; }
                DBG_E(dbg_h(MIX, (size_t)row * D + 512 + hd * 64 + t), o * dbg_h(PSZA, (size_t)row * 512 + hd * 64 + t)); } }
        dbg_acc(accf, base + 13, e, rr); }
    if (smp) { e = 0; rr = 0;
        for (int i = 0; i < 26; ++i) DBG_E(p.out[OFF_CONVS + ((size_t)(l * DB + b) * 30 + i) * 256 + t], p.cache_conv[((size_t)(l * DB + b) * 30 + i + 4) * 256 + t]);
        for (int i = 0; i < 11; ++i) DBG_E(p.out[OFF_POOLS + ((size_t)(l * DB + b) * 15 + i) * 256 + t], p.cache_pool[((size_t)(l * DB + b) * 15 + i + 4) * 256 + t]);
        for (int i = 0; i < 124; ++i) if (t < 128) { DBG_E(p.out[OFF_KS + ((size_t)(l * DB + b) * 128 + i) * 128 + t], p.cache_k[((size_t)(l * DB + b) * 128 + i + 4) * 128 + t]);
            DBG_E(p.out[OFF_VS + ((size_t)(l * DB + b) * 128 + i) * 128 + t], p.cache_v[((size_t)(l * DB + b) * 128 + i + 4) * 128 + t]); }
        dbg_acc(accf, base + 15, e, rr); }
}
__global__ void __launch_bounds__(256) dbg_out(Params p, int l) {
    __shared__ float mm[D];
    float* accf = (float*)(p.ws + WS_DBGACC); const int t = threadIdx.x, row = dbg_row(blockIdx.x), base = 4 + 16 * l;
    const bool smp = row >= MP; const int bidx = smp ? NB + ((row - MP) >> 2) : (row >> 12);
    for (int c = t; c < D; c += 256) mm[c] = dbg_h((const u16*)(p.ws + WS_MIX), (size_t)row * D + c);
    __syncthreads();
    const float* md = (const float*)(p.ws + WS_MOD) + ((size_t)l * NMOD + bidx) * 3072 + 2048;
    const float* mdn = (const float*)(p.ws + WS_MOD) + ((size_t)(l + 1) * NMOD + bidx) * 3072;
    float x1[4], z[4], rstd;
    for (int i = 0; i < 4; ++i) x1[i] = dbg_h((const u16*)(p.ws + WS_DBGZ), (size_t)((smp ? DBG_NS : 0) + blockIdx.x) * D + t + 256 * i);
    if (!smp && l > 0) { dbg_ln4(x1, rstd); for (int i = 0; i < 4; ++i) { const int c = t + 256 * i; x1[i] = x1[i] * rstd * p.ln_g[(l - 1) * D + c] + p.ln_b[(l - 1) * D + c]; } }
    float e = 0, rr = 0;
    for (int i = 0; i < 4; ++i) { const int c = t + 256 * i; float a = 0; for (int k = 0; k < D; ++k) a += mm[k] * p.w_out[((size_t)l * D + k) * D + c];
        z[i] = ALPHA * x1[i] + (1.f + md[c]) * a; DBG_E(dbg_h((const u16*)(p.ws + WS_ZH), (size_t)row * D + c), z[i]); }
    dbg_acc(accf, base + 14, e, rr);
    e = 0; rr = 0;
    if (!smp) { if (l < DEPTH - 1) for (int i = 0; i < 4; ++i) { const int c = t + 256 * i; DBG_E(dbg_h((const u16*)(p.ws + WS_H), (size_t)row * D + c), z[i] * p.ln_g[l * D + c] * (1.f + mdn[1024 + c])); } }
    else { dbg_ln4(z, rstd); for (int i = 0; i < 4; ++i) { const int c = t + 256 * i; z[i] = z[i] * rstd * p.ln_g[l * D + c] + p.ln_b[l * D + c]; }
        if (l == DEPTH - 1) { for (int i = 0; i < 4; ++i) DBG_E(p.out[OFF_YS + (size_t)(row - MP) * D + t + 256 * i], z[i]); }
        else { for (int i = 0; i < 4; ++i) DBG_E(dbg_h((const u16*)(p.ws + WS_XR), (size_t)row * D + t + 256 * i), z[i]);
            dbg_ln4(z, rstd); for (int i = 0; i < 4; ++i) { const int c = t + 256 * i; DBG_E(dbg_h((const u16*)(p.ws + WS_H), (size_t)row * D + c), z[i] * rstd * (1.f + mdn[1024 + c]) + mdn[c]); } } }
    dbg_acc(accf, base + 0, e, rr);
    if (l == 0) { dbg_acc(accf, 100, smp ? 0.f : e, smp ? 0.f : rr); dbg_acc(accf, 101, smp ? e : 0.f, smp ? rr : 0.f); }
}
__global__ void __launch_bounds__(256) dbg_fin(Params p) {
    float* accf = (float*)(p.ws + WS_DBGACC); const int t = threadIdx.x, row = dbg_row(blockIdx.x);
    if (row >= MP) return;
    float x[4]; for (int i = 0; i < 4; ++i) x[i] = dbg_h((const u16*)(p.ws + WS_ZH), (size_t)row * D + t + 256 * i);
    float rstd; dbg_ln4(x, rstd); float e = 0, rr = 0;
    for (int i = 0; i < 4; ++i) { const int c = t + 256 * i; DBG_E(p.out[(size_t)row * D + c], x[i] * rstd * p.ln_g[3 * D + c] + p.ln_b[3 * D + c]); }
    dbg_acc(accf, 68, e, rr);
}
#ifndef DBG_REPORT_ID
#define DBG_REPORT_ID -1
#endif
__global__ void __launch_bounds__(256) dbg_report(Params p) {
    const float* accf = (const float*)(p.ws + WS_DBGACC);
    float code = 1000.f;
    if (DBG_REPORT_ID >= 0) { const float e = accf[2 * DBG_REPORT_ID], r = accf[2 * DBG_REPORT_ID + 1]; code = (r > 0.f ? e / r : 9.9f) * 1e12f; if (!(code > 100.f)) code = 100.f; }
    else for (int i = 0; i < 128; ++i) { const float e = accf[2 * i], r = accf[2 * i + 1]; const bool expected = i <= 71 && !(i >= 4 && i < 68 && ((i - 4) & 15) == 0 && (i - 4) / 16 == 99);
        if ((r > 0.f && !(e / r < 1e-3f)) || (r == 0.f && (e > 0.f || expected)) || e != e || r != r) { code = (float)(i + 1) * 1e4f; break; } }
    const float S = sqrtf(code);
    for (size_t i = (size_t)blockIdx.x * 256 + threadIdx.x; i < (size_t)MP * D; i += (size_t)gridDim.x * 256) p.out[i] = S;
}
#endif

extern "C" void kernel_launch(void* const* d_in, const int* in_sizes, int n_in, void* d_out, int out_size, void* d_ws, size_t ws_size, hipStream_t stream) {
    static int grid = 0;
    if (grid == 0) {
        if (n_in != 21 || (size_t)out_size != OUT_TOTAL || ws_size < WS_END) { fprintf(stderr, "kernel_launch: unexpected shapes (n_in %d, out %d, ws %zu)\n", n_in, out_size, ws_size); grid = -1; return; }
        int dev = 0, cus = 0;
        if (hipGetDevice(&dev) != hipSuccess || hipDeviceGetAttribute(&cus, hipDeviceAttributeMultiprocessorCount, dev) != hipSuccess) { grid = -1; return; }
        if (hipFuncSetAttribute((const void*)hymba_fwd, hipFuncAttributeMaxDynamicSharedMemorySize, LDS_BYTES) != hipSuccess) { fprintf(stderr, "kernel_launch: hipFuncSetAttribute failed\n"); grid = -1; return; }
        (void)hipGetLastError();
        grid = cus;
    }
    if (grid < 0) return;
    (void)hipMemsetAsync((char*)d_ws + WS_CTL, 0, CTL_ZERO_BYTES, stream);
    Params a{};
    a.x_prompt = (const float*)d_in[0]; a.x_sample = (const float*)d_in[1]; a.cache_conv = (const float*)d_in[2]; a.cache_pool = (const float*)d_in[3];
    a.cache_k = (const float*)d_in[4]; a.cache_v = (const float*)d_in[5]; a.c_prompt = (const float*)d_in[6]; a.c_sample = (const float*)d_in[7];
    a.w_in = (const float*)d_in[8]; a.w_out = (const float*)d_in[9]; a.conv_w = (const float*)d_in[10]; a.conv_b = (const float*)d_in[11];
    a.cnorm_g = (const float*)d_in[12]; a.cnorm_b = (const float*)d_in[13]; a.pool_w = (const float*)d_in[14]; a.pool_scale = (const float*)d_in[15];
    a.sinks = (const float*)d_in[16]; a.w_mod = (const float*)d_in[17]; a.b_mod = (const float*)d_in[18]; a.ln_g = (const float*)d_in[19]; a.ln_b = (const float*)d_in[20];
    a.out = (float*)d_out; a.ws = (unsigned char*)d_ws;
    for (int i = 0; i < 32; ++i) a.inv_freq[i] = (float)std::pow(10000.0, -(double)i * (2.0 / 64.0));
    if (MK_N_LAUNCHES == 1) { a.ph_lo = 0; a.ph_hi = N_PHASES; hipLaunchKernelGGL(hymba_fwd, dim3(grid), dim3(NTHR), LDS_BYTES, stream, a); }
    else for (int ph = 0; ph < N_PHASES; ++ph) {
#ifdef DBG
        if (ph >= 2 && ph < N_PHASES - 1 && (ph - 2) % 3 == 2) hipLaunchKernelGGL(dbg_copyz, dim3(DBG_NS), dim3(256), 0, stream, a);
#endif
        a.ph_lo = ph; a.ph_hi = ph + 1; hipLaunchKernelGGL(hymba_fwd, dim3(grid), dim3(NTHR), LDS_BYTES, stream, a);
#ifdef DBG
        if (ph == 0) hipLaunchKernelGGL(dbg_p0, dim3(144), dim3(256), 0, stream, a);
        else if (ph == 1) hipLaunchKernelGGL(dbg_p0b, dim3(144), dim3(256), 0, stream, a);
        else if (ph == N_PHASES - 1) { hipLaunchKernelGGL(dbg_fin, dim3(DBG_NS), dim3(256), 0, stream, a); hipLaunchKernelGGL(dbg_report, dim3(1024), dim3(256), 0, stream, a); }
        else { const int l = (ph - 2) / 3, k = (ph - 2) % 3;
            if (k == 0) hipLaunchKernelGGL(dbg_in, dim3(DBG_NS), dim3(256), 0, stream, a, l);
            if (k == 1) hipLaunchKernelGGL(dbg_mix, dim3(DBG_NS), dim3(256), 0, stream, a, l);
            if (k == 2) hipLaunchKernelGGL(dbg_out, dim3(DBG_NS), dim3(256), 0, stream, a, l); }
#endif
    }
}
```

```cpp
#include <hip/hip_runtime.h>
#include <cstdint>
#include <cstdio>
#include <cmath>

#define DBG_REPORT_ID -1
#ifndef MK_N_LAUNCHES
#define MK_N_LAUNCHES 1
#endif

#define DI __device__ __forceinline__
#define GAS __attribute__((address_space(1)))
#define LAS __attribute__((address_space(3)))
typedef unsigned short u16;
typedef _Float16 h8 __attribute__((ext_vector_type(8)));
typedef _Float16 h4 __attribute__((ext_vector_type(4)));
typedef _Float16 h2 __attribute__((ext_vector_type(2)));
typedef float f32x2 __attribute__((ext_vector_type(2)));
typedef float f32x4 __attribute__((ext_vector_type(4)));
typedef float f32x16 __attribute__((ext_vector_type(16)));
typedef unsigned u32x4 __attribute__((ext_vector_type(4)));
typedef unsigned u32x2 __attribute__((ext_vector_type(2)));
typedef short v4i16_t __attribute__((ext_vector_type(4)));

constexpr int D = 1024, DIN = 2560, NB = 4, SEQ = 4096, DEPTH = 4, DB = 128, DS = 4;
constexpr int MP = NB * SEQ, MS = DB * DS, M = MP + MS;
constexpr int NMOD = NB + DB;
constexpr int PAST = 8192;
constexpr float LN_EPS = 1e-5f;
constexpr float ALPHA = 1.681792830507429f;
constexpr float LOG2E = 1.4426950408889634f;
constexpr float QSCALE = 0.125f * LOG2E;
constexpr size_t OFF_YP = 0, OFF_YS = OFF_YP + (size_t)MP * D, OFF_CONVP = OFF_YS + (size_t)MS * D, OFF_POOLP = OFF_CONVP + (size_t)DEPTH * NB * 30 * 256,
                 OFF_KP = OFF_POOLP + (size_t)DEPTH * NB * 15 * 256, OFF_VP = OFF_KP + (size_t)DEPTH * NB * 128 * 128, OFF_CONVS = OFF_VP + (size_t)DEPTH * NB * 128 * 128,
                 OFF_POOLS = OFF_CONVS + (size_t)DEPTH * DB * 30 * 256, OFF_KS = OFF_POOLS + (size_t)DEPTH * DB * 15 * 256, OFF_VS = OFF_KS + (size_t)DEPTH * DB * 128 * 128,
                 OUT_TOTAL = OFF_VS + (size_t)DEPTH * DB * 128 * 128;
constexpr size_t MiB = 1u << 20;
constexpr size_t WS_CTL = 0, CTL_ZERO_BYTES = 64 * 1024;
constexpr size_t WS_WIN = 1 * MiB;
constexpr size_t WS_WOUT = 21 * MiB;
constexpr size_t WS_MOD = 29 * MiB;
constexpr size_t WS_TAB = 36 * MiB;
constexpr size_t WS_ZH = 38 * MiB;
constexpr size_t WS_XR = 71 * MiB;
constexpr size_t WS_MIX = 104 * MiB;
constexpr size_t WS_PA = 137 * MiB;
constexpr size_t WS_PSZC = WS_PA + (size_t)M * 256 * 2, WS_PPV = WS_PSZC + (size_t)M * 256 * 2, WS_PSZP = WS_PPV + (size_t)M * 256 * 2;
constexpr size_t WS_PQ = WS_PSZP + (size_t)M * 256 * 2;
constexpr size_t WS_PSZA = WS_PQ + (size_t)M * 512 * 2;
constexpr size_t WS_PK = WS_PSZA + (size_t)M * 512 * 2;
constexpr size_t WS_PV = WS_PK + (size_t)M * 128 * 2;
constexpr size_t WS_H = WS_PV + (size_t)M * 128 * 2;
constexpr size_t WS_PS = WS_H + (size_t)M * D * 2;
constexpr size_t WS_RC0 = WS_PS + 2 * (size_t)MP * 24 * 4;
constexpr size_t WS_MODV = WS_RC0 + (size_t)MP * 16;
constexpr size_t WS_LNC = WS_MODV + (size_t)DEPTH * NB * 4 * DIN * 4;
constexpr size_t WS_VT = WS_LNC + 256;
constexpr size_t WS_END = WS_VT + (size_t)NB * 2 * 64 * SEQ * 2;
static_assert(WS_END <= 256 * MiB, "d_ws map");
constexpr int CW_BAR = 1024;
constexpr int CW_SCNT = 12288;

DI unsigned pkh(float a, float b) { f32x2 v = {a, b}; h2 r = __builtin_convertvector(v, h2); return __builtin_bit_cast(unsigned, r); }
DI u32x4 pack8(const float* v) { u32x4 w; w.x = pkh(v[0], v[1]); w.y = pkh(v[2], v[3]); w.z = pkh(v[4], v[5]); w.w = pkh(v[6], v[7]); return w; }
DI void unpack8(u32x4 w, float* o) {
    const h8 v = __builtin_bit_cast(h8, w);
#pragma unroll
    for (int j = 0; j < 8; ++j) o[j] = (float)v[j];
}
DI float ex2(float x) { return __builtin_amdgcn_exp2f(x); }
DI float sigm(float x) { return __builtin_amdgcn_rcpf(1.f + ex2(-x * LOG2E)); }
DI float silu(float x) { return x * sigm(x); }
template <int O> DI float xor_lane(float v) {
    return __builtin_bit_cast(float, __builtin_amdgcn_ds_swizzle(__builtin_bit_cast(int, v), (O << 10) | 0x1f));
}
DI float sum_halves(float v) { float a = v, b = v; asm volatile("s_nop 1\n\tv_permlane32_swap_b32 %0, %1" : "+v"(a), "+v"(b)); return a + b; }
DI float max_halves(float v) { float a = v, b = v; asm volatile("s_nop 1\n\tv_permlane32_swap_b32 %0, %1" : "+v"(a), "+v"(b)); return fmaxf(a, b); }
DI float wave_sum(float v) { v += xor_lane<1>(v); v += xor_lane<2>(v); v += xor_lane<4>(v); v += xor_lane<8>(v); v += xor_lane<16>(v); return sum_halves(v); }
DI float wave_max(float v) { v = fmaxf(v, xor_lane<1>(v)); v = fmaxf(v, xor_lane<2>(v)); v = fmaxf(v, xor_lane<4>(v)); v = fmaxf(v, xor_lane<8>(v)); v = fmaxf(v, xor_lane<16>(v)); return max_halves(v); }
DI int lane_id() { int l_; asm volatile("v_mbcnt_lo_u32_b32 %0, -1, 0\n\tv_mbcnt_hi_u32_b32 %0, -1, %0" : "=v"(l_)); return l_; }
DI int crow(int r, int hi) { return (r & 3) + 8 * (r >> 2) + 4 * hi; }

__host__ __device__ __forceinline__ int pperm(int bj, int c7) { return 128 * bj + 32 * (c7 >> 5) + 16 * ((c7 >> 2) & 1) + 4 * ((c7 >> 3) & 3) + (c7 & 3); }
__host__ __device__ __forceinline__ int perm_in(int col) {
    if (col < 512) { const int bj = col >> 8, ch = col & 255; return 256 * (ch >> 7) + pperm(bj, ch & 127); }
    if (col < 1280) { const int base = col < 768 ? 512 : (col < 1024 ? 768 : 1024); const int x = col - base; return base + pperm(x >> 7, x & 127); }
    if (col < 1792) { const int x = col - 1280, head = x >> 6, d = x & 63; return 256 * (5 + (head >> 2)) + pperm(d >> 5, 32 * (head & 3) + (d & 31)); }
    if (col < 2048) { const int x = col - 1792, hh = x >> 6, d = x & 63; return 1792 + pperm(d >> 5, 32 * hh + (d & 31)); }
    { const int x = col - 2048; return 2048 + 256 * (x >> 8) + pperm((x >> 7) & 1, x & 127); }
}
__host__ __device__ __forceinline__ int perm_out(int col) { const int y = col & 255; return (col & ~255) + pperm(y >> 7, y & 127); }

namespace pg8 {
constexpr int BM = 256, BK = 64, HALF = 128, HTB = HALF * BK * 2, STAGE_BYTES = 8 * HTB, NXCD = 8, WGM = 8;
__host__ __device__ __forceinline__ int lds_byte(int r, int c) { const int st = (r >> 4) * 2 + (c >> 5), rr = r & 15, cc = c & 31, ob = rr * 64 + cc * 2; return st * 1024 + (ob ^ (((ob >> 9) & 1) << 5)); }
__host__ __device__ __forceinline__ void stage_rc(int b, int& R, int& C) { const int st = b / 1024, sb = b % 1024, swz = sb ^ (((sb >> 9) & 1) << 5); R = (st >> 1) * 16 + swz / 64; C = (st & 1) * 32 + (swz % 64) / 2; }
struct Unit { int pm, pn; };
struct Gemm { const u16* A; const u16* Bt; int M, N, K; };
struct StaticOrder {
    int nM, nN, nwg, G, c;
    __host__ __device__ void init(int M_, int N_, int G_, int c_) { nM = M_ / BM; nN = N_ / BM; nwg = nM * nN; G = G_; c = c_; }
    __host__ __device__ bool next(int i, Unit& u) const {
        const long L = (long)i * G + c; if (L >= nwg) return false;
        int wgid = (int)L; { const int q = nwg / NXCD, r = nwg % NXCD, xcd = wgid % NXCD, off = wgid / NXCD; wgid = (xcd < r ? xcd * (q + 1) : r * (q + 1) + (xcd - r) * q) + off; }
        const int nig = WGM * nN, gid = wgid / nig, fm = gid * WGM, gsz = (nM - fm) < WGM ? (nM - fm) : WGM;
        u.pm = fm + ((wgid % nig) % gsz); u.pn = (wgid % nig) / gsz; return true;
    }
};

template <class Epi, bool ALIGN_EPI>
DI void gemm_phase(LAS unsigned char* lds, const Gemm g, const StaticOrder& S, const Epi& E, const int tid) {
    const int wid = __builtin_amdgcn_readfirstlane(tid >> 6), lane = tid & 63, wr = wid >> 2, wc = wid & 3, fr = lane & 15, fq = lane >> 4;
    const int K = g.K, nt = K / BK;
    unsigned voffA[2];
#pragma unroll
    for (int i = 0; i < 2; ++i) { int R, C; stage_rc(tid * 16 + i * 8192, R, C); voffA[i] = (unsigned)(R * K + C) * 2u; }
    const size_t kstep = (size_t)(BK * 2);
    const size_t hstep = (size_t)HALF * K * 2;
    const size_t tstep = 2 * hstep;
    const unsigned ldsw = (unsigned)wid * 1024u;
    const int aoff = lds_byte(wr * 64 + fr, fq * 8), boff = lds_byte(wc * 32 + fr, fq * 8);
#define PG8_SA(b, h) (((b) * 2 + (h)) * HTB)
#define PG8_SB(b, h) ((4 + (b) * 2 + (h)) * HTB)
#define PG8_STAGE(bufoff, gbase) do { _Pragma("unroll") for (int _i = 0; _i < 2; ++_i) \
        __builtin_amdgcn_global_load_lds((const unsigned*)((const char*)(gbase) + voffA[_i]), (LAS unsigned*)(lds + (bufoff) + ldsw + _i * 8192), 16, 0, 0); } while (0)
#define PG8_LDA(dst, b, h) do { _Pragma("unroll") for (int m = 0; m < 4; ++m) _Pragma("unroll") for (int k = 0; k < 2; ++k) dst[m][k] = *(const LAS h8*)(lds + PG8_SA(b, h) + aoff + m * 2048 + k * 1024); } while (0)
#define PG8_LDB(dst, b, h) do { _Pragma("unroll") for (int n = 0; n < 2; ++n) _Pragma("unroll") for (int k = 0; k < 2; ++k) dst[n][k] = *(const LAS h8*)(lds + PG8_SB(b, h) + boff + n * 2048 + k * 1024); } while (0)
#define PG8_MMA(ai, bj, At, Bt) do { __builtin_amdgcn_s_setprio(1); _Pragma("unroll") for (int m = 0; m < 4; ++m) _Pragma("unroll") for (int n = 0; n < 2; ++n) _Pragma("unroll") for (int k = 0; k < 2; ++k) \
        acc[ai][bj][m][n] = __builtin_amdgcn_mfma_f32_16x16x32_f16(Bt[n][k], At[m][k], acc[ai][bj][m][n], 0, 0, 0); __builtin_amdgcn_s_setprio(0); } while (0)
#define PG8_WAIT_V(n) asm volatile("s_waitcnt vmcnt(" #n ")" ::: "memory")
#define PG8_WAIT_L(n) asm volatile("s_waitcnt lgkmcnt(" #n ")" ::: "memory")
#define PG8_BAR __builtin_amdgcn_s_barrier()
#define PG8_SCHED __builtin_amdgcn_sched_barrier(0)
    Unit cur, nxt; int ui = 0;
    if (!S.next(0, cur)) return;
    f32x4 acc[2][2][4][2];
#pragma unroll
    for (int a = 0; a < 2; ++a)
#pragma unroll
        for (int b = 0; b < 2; ++b)
#pragma unroll
            for (int m = 0; m < 4; ++m)
#pragma unroll
                for (int n = 0; n < 2; ++n) acc[a][b][m][n] = (f32x4){0.f, 0.f, 0.f, 0.f};
    h8 At[4][2], B0[2][2], B1[2][2];
    const char* cA = (const char*)g.A + (size_t)cur.pm * tstep; const char* cB = (const char*)g.Bt + (size_t)cur.pn * tstep;
    PG8_STAGE(PG8_SB(0, 0), cB); PG8_STAGE(PG8_SB(0, 1), cB + hstep); PG8_STAGE(PG8_SA(0, 0), cA); PG8_STAGE(PG8_SA(0, 1), cA + hstep);
    if (wr == 1) PG8_BAR;
    PG8_WAIT_V(2); PG8_BAR;
    PG8_STAGE(PG8_SB(1, 0), cB + kstep); PG8_STAGE(PG8_SA(1, 0), cA + kstep); PG8_STAGE(PG8_SB(1, 1), cB + hstep + kstep);
    PG8_WAIT_V(6); PG8_BAR;
    for (;;) {
        const bool has_next = S.next(ui + 1, nxt);
        const char* nA = has_next ? (const char*)g.A + (size_t)nxt.pm * tstep : cA; const char* nB = has_next ? (const char*)g.Bt + (size_t)nxt.pn * tstep : cB;
        for (int t = 0; t < nt; t += 2) {
            const bool last = (t == nt - 2);
            const char* a1 = cA + (size_t)(t + 1) * kstep;
            const char* a2 = last ? nA : cA + (size_t)(t + 2) * kstep; const char* b2 = last ? nB : cB + (size_t)(t + 2) * kstep;
            const char* a3 = a2 + kstep; const char* b3 = b2 + kstep;
            PG8_LDB(B0, 0, 0); PG8_LDB(B1, 0, 1); PG8_SCHED; PG8_LDA(At, 0, 0); PG8_STAGE(PG8_SA(1, 1), a1 + hstep);
            PG8_WAIT_V(8); PG8_WAIT_L(0); PG8_BAR; PG8_MMA(0, 0, At, B0); PG8_MMA(0, 1, At, B1); PG8_BAR; PG8_SCHED;
            PG8_LDA(At, 0, 1); PG8_STAGE(PG8_SB(0, 0), b2); PG8_STAGE(PG8_SB(0, 1), b2 + hstep); PG8_STAGE(PG8_SA(0, 0), a2);
            PG8_WAIT_V(8); PG8_WAIT_L(0); PG8_BAR; PG8_MMA(1, 0, At, B0); PG8_MMA(1, 1, At, B1); PG8_BAR; PG8_SCHED;
            PG8_LDB(B0, 1, 0); PG8_LDB(B1, 1, 1); PG8_SCHED; PG8_LDA(At, 1, 0); PG8_STAGE(PG8_SA(0, 1), a2 + hstep);
            PG8_WAIT_V(8); PG8_WAIT_L(0); PG8_BAR; PG8_MMA(0, 0, At, B0); PG8_MMA(0, 1, At, B1); PG8_BAR; PG8_SCHED;
            PG8_LDA(At, 1, 1); PG8_STAGE(PG8_SB(1, 0), b3); PG8_STAGE(PG8_SB(1, 1), b3 + hstep); PG8_STAGE(PG8_SA(1, 0), a3);
            PG8_WAIT_V(8); PG8_WAIT_L(0); PG8_BAR; PG8_MMA(1, 0, At, B0); PG8_MMA(1, 1, At, B1); PG8_BAR; PG8_SCHED;
        }
        if constexpr (ALIGN_EPI) { if (wr == 0) PG8_BAR; }
        if constexpr (!Epi::AFTER_DRAIN) E(acc, cur, ui, wr, wc, fr, fq);
        if (!has_next) break;
#pragma unroll
        for (int a = 0; a < 2; ++a)
#pragma unroll
            for (int b = 0; b < 2; ++b)
#pragma unroll
                for (int m = 0; m < 4; ++m)
#pragma unroll
                    for (int n = 0; n < 2; ++n) acc[a][b][m][n] = (f32x4){0.f, 0.f, 0.f, 0.f};
        cur = nxt; cA = nA; cB = nB; ++ui;
        if constexpr (ALIGN_EPI) { if (wr == 1) PG8_BAR; }
    }
    PG8_WAIT_V(0);
    if constexpr (!ALIGN_EPI) { if (wr == 0) PG8_BAR; }
    PG8_BAR;
    if constexpr (Epi::AFTER_DRAIN) E.fused(acc, cur, wr, wc, fr, fq, lds, tid);
#undef PG8_SA
#undef PG8_SB
#undef PG8_STAGE
#undef PG8_LDA
#undef PG8_LDB
#undef PG8_MMA
#undef PG8_WAIT_V
#undef PG8_WAIT_L
#undef PG8_BAR
#undef PG8_SCHED
}
}

struct Params {
    const float* x_prompt; const float* x_sample; const float* cache_conv; const float* cache_pool; const float* cache_k; const float* cache_v;
    const float* c_prompt; const float* c_sample; const float* w_in; const float* w_out; const float* conv_w; const float* conv_b; const float* cnorm_g; const float* cnorm_b;
    const float* pool_w; const float* pool_scale; const float* sinks; const float* w_mod; const float* b_mod; const float* ln_g; const float* ln_b;
    float* out; unsigned char* ws;
    int ph_lo, ph_hi;
    float inv_freq[32];
};
struct ParamsHead { const float* ptrs[21]; float* out; unsigned char* ws; int ph_lo, ph_hi; };
static_assert(sizeof(ParamsHead) == __builtin_offsetof(Params, inv_freq), "ParamsHead mirrors the head of Params");

DI void row_info(int row, bool& smp, int& b, int& t) { smp = row >= MP; if (!smp) { b = row >> 12; t = row & (SEQ - 1); } else { const int s = row - MP; b = s >> 2; t = s & 3; } }
DI void st8f(float* dst, const float* v) { *(f32x4*)dst = (f32x4){v[0], v[1], v[2], v[3]}; *(f32x4*)(dst + 4) = (f32x4){v[4], v[5], v[6], v[7]}; }

struct EpiIn {
    static constexpr bool AFTER_DRAIN = false;
    int l; unsigned char* ws; float* out; const LAS float* rcl;
    DI void operator()(f32x4 (&acc)[2][2][4][2], const pg8::Unit& u, int ui, int wr, int wc, int fr, int fq) const {
        asm volatile("" : "+v"(fr), "+v"(fq));
        const int pn = u.pn;
        if (u.pm < MP / 256) {
            const LAS f32x4* rc = (const LAS f32x4*)rcl + ui * 256 + wr * 64 + fr;
            const float* mv = (const float*)(ws + WS_MODV) + (size_t)(l * NB + (u.pm >> 4)) * 4 * DIN + pn * 256 + wc * 32 + 4 * fq;
#pragma unroll
            for (int bj = 0; bj < 2; ++bj)
#pragma unroll
                for (int n = 0; n < 2; ++n) { const float* mp = mv + 128 * bj + 16 * n;
                    const f32x4 v1 = *(const f32x4*)mp, v2 = *(const f32x4*)(mp + DIN), v3 = *(const f32x4*)(mp + 2 * DIN), v4 = *(const f32x4*)(mp + 3 * DIN);
#pragma unroll
                    for (int ai = 0; ai < 2; ++ai)
#pragma unroll
                        for (int m = 0; m < 4; ++m) { const f32x4 r = rc[ai * 128 + m * 16];
                            acc[ai][bj][m][n] = r[0] * acc[ai][bj][m][n] - r[1] * v1 + r[2] * v2 - r[3] * v3 + v4; } }
        }
        unsigned char* const W = ws; float* const O = out;
#define ST16(byteoff, vals) (*(u32x4*)(W + (size_t)(unsigned)(byteoff)) = pack8(vals))
#define STF8(fidx, vals) st8f(O + (size_t)(unsigned)(fidx), vals)
#pragma unroll
        for (int ai = 0; ai < 2; ++ai)
#pragma unroll
            for (int m = 0; m < 4; ++m) {
                const unsigned row = (unsigned)(u.pm * 256 + ai * 128 + wr * 64 + m * 16 + fr);
                const bool smp = row >= (unsigned)MP; const unsigned b = smp ? (row - MP) >> 2 : row >> 12, t = smp ? (row - MP) & 3u : row & (unsigned)(SEQ - 1);
                if (pn < 2) {
                    const unsigned c8 = pn * 128 + wc * 32 + fq * 8; float a[8];
#pragma unroll
                    for (int n = 0; n < 2; ++n)
#pragma unroll
                        for (int j = 0; j < 4; ++j) a[4 * n + j] = acc[ai][0][m][n][j] * sigm(acc[ai][1][m][n][j]);
                    ST16((unsigned)WS_PA + (row * 256 + c8) * 2, a);
                    if (smp) STF8((unsigned)OFF_CONVS + ((l * DB + b) * 30 + 26 + t) * 256 + c8, a);
                    else if (t >= SEQ - 30) STF8((unsigned)OFF_CONVP + ((l * NB + b) * 30 + (t - (SEQ - 30))) * 256 + c8, a);
                } else if (pn == 2 || pn == 4) {
                    const unsigned base = pn == 2 ? (unsigned)WS_PSZC : (unsigned)WS_PSZP;
#pragma unroll
                    for (int bj = 0; bj < 2; ++bj) { const unsigned c8 = bj * 128 + wc * 32 + fq * 8; float v[8];
#pragma unroll
                        for (int n = 0; n < 2; ++n)
#pragma unroll
                            for (int j = 0; j < 4; ++j) v[4 * n + j] = silu(acc[ai][bj][m][n][j]);
                        ST16(base + (row * 256 + c8) * 2, v); }
                } else if (pn == 3) {
#pragma unroll
                    for (int bj = 0; bj < 2; ++bj) { const unsigned c8 = bj * 128 + wc * 32 + fq * 8; float v[8];
#pragma unroll
                        for (int n = 0; n < 2; ++n)
#pragma unroll
                            for (int j = 0; j < 4; ++j) v[4 * n + j] = acc[ai][bj][m][n][j];
                        ST16((unsigned)WS_PPV + (row * 256 + c8) * 2, v);
                        if (smp) STF8((unsigned)OFF_POOLS + ((l * DB + b) * 15 + 11 + t) * 256 + c8, v);
                        else if (t >= SEQ - 15) STF8((unsigned)OFF_POOLP + ((l * NB + b) * 15 + (t - (SEQ - 15))) * 256 + c8, v); }
                } else if (pn >= 8) {
#pragma unroll
                    for (int bj = 0; bj < 2; ++bj) { const unsigned c8 = (pn - 8) * 256 + bj * 128 + wc * 32 + fq * 8; float v[8];
#pragma unroll
                        for (int n = 0; n < 2; ++n)
#pragma unroll
                            for (int j = 0; j < 4; ++j) v[4 * n + j] = silu(acc[ai][bj][m][n][j]);
                        ST16((unsigned)WS_PSZA + (row * 512 + c8) * 2, v); }
                } else if (pn == 7 && wc >= 2) {
                    const unsigned hv = wc - 2;
#pragma unroll
                    for (int bj = 0; bj < 2; ++bj) { const unsigned d8 = 32 * bj + 8 * fq; float v[8];
#pragma unroll
                        for (int n = 0; n < 2; ++n)
#pragma unroll
                            for (int j = 0; j < 4; ++j) v[4 * n + j] = acc[ai][bj][m][n][j];
                        ST16((unsigned)WS_PV + (row * 128 + hv * 64 + d8) * 2, v);
                        if (smp) STF8((unsigned)OFF_VS + (((l * DB + b) * 128 + 124 + t) * 2 + hv) * 64 + d8, v);
                        else if (t >= SEQ - 128) STF8((unsigned)OFF_VP + (((l * NB + b) * 128 + (t - (SEQ - 128))) * 2 + hv) * 64 + d8, v); }
                } else {
                    const unsigned d8 = 8 * fq; const unsigned pidx = smp ? SEQ + t : t;
                    const f32x4* tp = (const f32x4*)(W + (size_t)((unsigned)WS_TAB + (pidx * 32 + d8) * 8));
                    float x1[8], x2[8], o1[8], o2[8];
#pragma unroll
                    for (int n = 0; n < 2; ++n)
#pragma unroll
                        for (int j = 0; j < 4; ++j) { x1[4 * n + j] = acc[ai][0][m][n][j]; x2[4 * n + j] = acc[ai][1][m][n][j]; }
                    const float sc = pn == 7 ? 1.f : QSCALE;
#pragma unroll
                    for (int k2 = 0; k2 < 4; ++k2) { const f32x4 cs = tp[k2];
                        o1[2 * k2] = (x1[2 * k2] * cs[0] - x2[2 * k2] * cs[1]) * sc;         o2[2 * k2] = (x2[2 * k2] * cs[0] + x1[2 * k2] * cs[1]) * sc;
                        o1[2 * k2 + 1] = (x1[2 * k2 + 1] * cs[2] - x2[2 * k2 + 1] * cs[3]) * sc; o2[2 * k2 + 1] = (x2[2 * k2 + 1] * cs[2] + x1[2 * k2 + 1] * cs[3]) * sc; }
                    if (pn == 7) { const unsigned hk = wc;
                        ST16((unsigned)WS_PK + (row * 128 + hk * 64 + d8) * 2, o1); ST16((unsigned)WS_PK + (row * 128 + hk * 64 + 32 + d8) * 2, o2);
                        if (smp) { const unsigned di = (unsigned)OFF_KS + (((l * DB + b) * 128 + 124 + t) * 2 + hk) * 64 + d8; STF8(di, o1); STF8(di + 32, o2); }
                        else if (t >= SEQ - 128) { const unsigned di = (unsigned)OFF_KP + (((l * NB + b) * 128 + (t - (SEQ - 128))) * 2 + hk) * 64 + d8; STF8(di, o1); STF8(di + 32, o2); }
                    } else { const unsigned head = (pn - 5) * 4 + wc;
                        ST16((unsigned)WS_PQ + (row * 512 + head * 64 + d8) * 2, o1); ST16((unsigned)WS_PQ + (row * 512 + head * 64 + 32 + d8) * 2, o2); }
                }
            }
#undef ST16
#undef STF8
    }
};

struct EpiOutF {
    static constexpr bool AFTER_DRAIN = true;
    unsigned char* ws; int l; const float* ln_g; const float* ln_b;
    DI void operator()(f32x4 (&)[2][2][4][2], const pg8::Unit&, int, int, int, int, int) const {}
    DI void fused(f32x4 (&acc)[2][2][4][2], const pg8::Unit& u, int wr, int wc, int fr, int fq, LAS unsigned char* lds, int tid) const {
        LAS float* CV = (LAS float*)lds;
        LAS float* RS = (LAS float*)(lds + 8192);
        LAS float* PW = (LAS float*)(lds + 12288);
        u16* ZH = (u16*)(ws + WS_ZH); u16* ZP = (u16*)(ws + WS_H);
        const float* MOD = (const float*)(ws + WS_MOD); const int b = u.pm >> 4;
        const float* PSp = (const float*)(ws + WS_PS) + (size_t)((l + 1) & 1) * MP * 24; float* PSc = (float*)(ws + WS_PS) + (size_t)(l & 1) * MP * 24;
        if (tid < 256) { const int col = u.pn * 256 + tid;
            CV[tid] = l > 0 ? ln_g[(l - 1) * D + col] : 1.f; CV[256 + tid] = l > 0 ? ln_b[(l - 1) * D + col] : 0.f;
            CV[512 + tid] = MOD[((size_t)l * NMOD + b) * 3072 + 2048 + col]; CV[768 + tid] = ln_g[l * D + col]; CV[1024 + tid] = ln_b[l * D + col];
            CV[1280 + tid] = l < DEPTH - 1 ? MOD[((size_t)(l + 1) * NMOD + b) * 3072 + 1024 + col] : 0.f;
        } else { const int row = tid - 256; float mu = 0.f, rstd = 1.f;
            if (l > 0) { const float* ps = PSp + (size_t)(u.pm * 256 + row) * 24; const float s1 = (ps[0] + ps[6]) + (ps[12] + ps[18]), s2 = (ps[1] + ps[7]) + (ps[13] + ps[19]);
                mu = s1 * (1.f / D); rstd = 1.f / sqrtf(s2 * (1.f / D) - mu * mu + LN_EPS); }
            RS[2 * row] = mu; RS[2 * row + 1] = rstd; }
        __syncthreads();
#pragma unroll
        for (int ai = 0; ai < 2; ++ai) {
        u32x4 zpv[4][2];
#pragma unroll
        for (int mm = 0; mm < 4; ++mm)
#pragma unroll
            for (int bj = 0; bj < 2; ++bj) zpv[mm][bj] = *(const u32x4*)(ZH + ((size_t)u.pm * 256 + ai * 128 + wr * 64 + mm * 16 + fr) * D + u.pn * 256 + bj * 128 + wc * 32 + fq * 8);
#pragma unroll
        for (int mm = 0; mm < 4; ++mm) { const int m = mm;
            const int rt = ai * 128 + wr * 64 + m * 16 + fr; const size_t row = (size_t)u.pm * 256 + rt;
            const float mu = RS[2 * rt], rstd = RS[2 * rt + 1];
            float s1 = 0.f, s2 = 0.f, s3 = 0.f, s4 = 0.f, s5 = 0.f, s6 = 0.f;
#pragma unroll
            for (int bj = 0; bj < 2; ++bj) { const int cl = bj * 128 + wc * 32 + fq * 8; const size_t off = row * D + u.pn * 256 + cl;
                float zp[8], zq[8], zo[8]; unpack8(zpv[mm][bj], zp);
#pragma unroll
                for (int hh = 0; hh < 2; ++hh) {
                    const f32x4 gp = *(const LAS f32x4*)(CV + cl + 4 * hh), bp = *(const LAS f32x4*)(CV + 256 + cl + 4 * hh), gt = *(const LAS f32x4*)(CV + 512 + cl + 4 * hh),
                                gg = *(const LAS f32x4*)(CV + 768 + cl + 4 * hh), bb = *(const LAS f32x4*)(CV + 1024 + cl + 4 * hh), sn = *(const LAS f32x4*)(CV + 1280 + cl + 4 * hh);
                    const f32x4 av = acc[ai][bj][m][hh];
#pragma unroll
                    for (int j = 0; j < 4; ++j) { const int k = 4 * hh + j;
                        const float x1 = l > 0 ? (zp[k] - mu) * rstd * gp[j] + bp[j] : zp[k];
                        const float z = ALPHA * x1 + (1.f + gt[j]) * av[j], uu = z * gg[j];
                        s1 += z; s2 += z * z; s3 += uu; s4 += uu * uu; s5 += uu * gg[j]; s6 += uu * bb[j];
                        zq[k] = z; zo[k] = uu * (1.f + sn[j]); } }
                *(u32x4*)(ZH + off) = pack8(zq);
                if (l < DEPTH - 1) *(u32x4*)(ZP + off) = pack8(zo); }
            s1 = sum_halves(s1 + xor_lane<16>(s1)); s2 = sum_halves(s2 + xor_lane<16>(s2)); s3 = sum_halves(s3 + xor_lane<16>(s3)); s4 = sum_halves(s4 + xor_lane<16>(s4)); s5 = sum_halves(s5 + xor_lane<16>(s5)); s6 = sum_halves(s6 + xor_lane<16>(s6));
            if (fq == 0) { LAS float* pw = PW + (rt * 4 + wc) * 6; pw[0] = s1; pw[1] = s2; pw[2] = s3; pw[3] = s4; pw[4] = s5; pw[5] = s6; } }
        asm volatile("" ::: "memory"); }
        __syncthreads();
        if (tid < 256 && l < DEPTH - 1) { float* ps = PSc + (size_t)(u.pm * 256 + tid) * 24 + u.pn * 6; const LAS float* pw = PW + tid * 24;
#pragma unroll
            for (int k = 0; k < 6; ++k) ps[k] = (pw[k] + pw[6 + k]) + (pw[12 + k] + pw[18 + k]); }
    }
};

#define XB_TMO      128
#define XB_XCNT(j)  (256  + 64 * (j))
#define XB_XSUB(j)  (1280 + 64 * (j))
#define XB_XGEN(j)  (2304 + 64 * (j))
#define XB_TOP      3328
#define XB_TOPGEN   3392
#define XCD_BAR_WORDS 3456
#define XB_SPIN_CAP (1u << 18)
DI unsigned xb_ld(unsigned* p)              { return __hip_atomic_load(p, __ATOMIC_RELAXED, __HIP_MEMORY_SCOPE_AGENT); }
DI unsigned xb_add(unsigned* p, unsigned v) { return __hip_atomic_fetch_add(p, v, __ATOMIC_RELAXED, __HIP_MEMORY_SCOPE_AGENT); }
DI unsigned xb_xcc_id() { return (unsigned)__builtin_amdgcn_s_getreg((3 << 11) | 20) & 0xFu; }
#define XB_SPIN(cond, bar) do { unsigned _sp = 0; while (cond) { __builtin_amdgcn_s_sleep(1); \
    if ((++_sp & 255u) == 0u) { if (xb_ld(&(bar)[XB_TMO])) break; if (_sp > XB_SPIN_CAP) { atomicAdd(&(bar)[XB_TMO], 1u); break; } } } } while (0)
struct XcdBarrier { unsigned* bar; unsigned x; volatile LAS unsigned* st; };
DI XcdBarrier xcd_barrier_post(unsigned* bar, volatile LAS unsigned* st) {
    XcdBarrier b; b.bar = bar; b.x = xb_xcc_id(); b.st = st;
    if (threadIdx.x == 0) (void)xb_add(&bar[XB_XCNT(b.x)], 1u);
    return b;
}
DI void xcd_barrier_complete(unsigned* bar, unsigned x, unsigned& nloc, unsigned& nx) {
    const unsigned G = gridDim.x * gridDim.y * gridDim.z;
    unsigned sum, cnt, mine, sp = 0u;
    for (;;) {
        sum = 0u; cnt = 0u; mine = 0u;
#pragma unroll
        for (unsigned j = 0; j < 16; ++j) { const unsigned c = xb_ld(&bar[XB_XCNT(j)]); sum += c; cnt += (c > 0u) ? 1u : 0u; mine = (j == x) ? c : mine; }
        if (sum == G) break;
        __builtin_amdgcn_s_sleep(1);
        if ((++sp & 255u) == 0u) { if (xb_ld(&bar[XB_TMO])) break; if (sp > XB_SPIN_CAP) { atomicAdd(&bar[XB_TMO], 1u); break; } }
    }
    nloc = mine > 0u ? mine : 1u; nx = cnt > 0u ? cnt : 1u;
}
DI void xcd_barrier(const XcdBarrier& b, const int wave_s) {
    asm volatile("s_waitcnt vmcnt(0)" ::: "memory");
    __syncthreads();
    if (wave_s == 0 && lane_id() == 0) {
        unsigned* bar = b.bar;
        __builtin_amdgcn_s_waitcnt(0);
        unsigned nloc = b.st[0], nx = b.st[1];
        if (nloc == 0u) { xcd_barrier_complete(bar, b.x, nloc, nx); b.st[0] = nloc; b.st[1] = nx; }
        const unsigned old = xb_add(&bar[XB_XSUB(b.x)], 1u);
        const unsigned gen = old / nloc;
        if (old + 1u == (gen + 1u) * nloc) {
            __builtin_amdgcn_fence(__ATOMIC_RELEASE, "agent");
            asm volatile("s_waitcnt vmcnt(0)" ::: "memory");
            const unsigned og = xb_add(&bar[XB_TOP], 1u);
            const unsigned tg = og / nx;
            if (og + 1u == (tg + 1u) * nx) xb_add(&bar[XB_TOPGEN], 1u);
            else XB_SPIN(xb_ld(&bar[XB_TOPGEN]) == tg, bar);
            __builtin_amdgcn_fence(__ATOMIC_ACQUIRE, "agent");
            xb_add(&bar[XB_XGEN(b.x)], 1u);
            asm volatile("s_waitcnt vmcnt(0)" ::: "memory");
        } else {
            XB_SPIN(xb_ld(&bar[XB_XGEN(b.x)]) == gen, bar);
            __builtin_amdgcn_fence(__ATOMIC_ACQUIRE, "agent");
            asm volatile("s_waitcnt vmcnt(0)" ::: "memory");
        }
    }
    __syncthreads();
}

constexpr int NWAVES = 8, NTHR = 512;
constexpr int LDS_BYTES = 147456;
constexpr int RING_BYTES = 131072, MISC_OFF = RING_BYTES + 320;

DI void p0_transpose_item(const float* W, int K, int N, u16* WT, LAS float* scr, int item, int lane, bool isin) {
    const int nblk = N / 32, kb = item / nblk, nb = item % nblk, k0 = 64 * kb, n0 = 32 * nb;
#pragma unroll 8
    for (int i = 0; i < 32; ++i) { const int kk = 2 * i + (lane >> 5); scr[kk * 33 + (lane & 31)] = W[(size_t)(k0 + kk) * N + n0 + (lane & 31)]; }
    asm volatile("s_waitcnt lgkmcnt(0)" ::: "memory");
    const int c = lane & 7;
#pragma unroll
    for (int j = 0; j < 4; ++j) { const int n = (lane >> 3) + 8 * j; const LAS float* s = scr + (8 * c) * 33 + n;
        u32x4 o; o.x = pkh(s[0 * 33], s[1 * 33]); o.y = pkh(s[2 * 33], s[3 * 33]); o.z = pkh(s[4 * 33], s[5 * 33]); o.w = pkh(s[6 * 33], s[7 * 33]);
        const int dst = isin ? perm_in(n0 + n) : perm_out(n0 + n);
        *(u32x4*)(WT + (size_t)dst * K + k0 + 8 * c) = o; }
    asm volatile("s_waitcnt lgkmcnt(0)" ::: "memory");
}
DI void mod_unit(const Params& p, LAS unsigned char* lds, int unit, int tid, int lane, int wave) {
    const int l = unit >> 6, n0 = (unit & 63) * 48;
    const float* W = p.w_mod + (size_t)l * D * 3072;
    float* MOD = (float*)(p.ws + WS_MOD);
    const int fr = lane & 15, fq = lane >> 4;
    f32x4 acc[9][3];
#pragma unroll
    for (int rt = 0; rt < 9; ++rt)
#pragma unroll
        for (int ct = 0; ct < 3; ++ct) acc[rt][ct] = (f32x4){0.f, 0.f, 0.f, 0.f};
    for (int ks = 0; ks < 4; ++ks) {
        const int k0 = wave * 128 + ks * 32 + fq * 8;
        h8 bfr[3];
#pragma unroll
        for (int ct = 0; ct < 3; ++ct) { const float* wp = W + (size_t)k0 * 3072 + n0 + 16 * ct + fr;
#pragma unroll
            for (int j = 0; j < 8; ++j) bfr[ct][j] = (_Float16)wp[(size_t)j * 3072]; }
#pragma unroll
        for (int rt = 0; rt < 9; ++rt) { const int row = 16 * rt + fr; h8 a;
            if (row < NMOD) { const float* c = row < NB ? p.c_prompt + (size_t)row * D : p.c_sample + (size_t)(row - NB) * D;
                const f32x4 c0 = *(const f32x4*)(c + k0), c1 = *(const f32x4*)(c + k0 + 4);
#pragma unroll
                for (int j = 0; j < 4; ++j) { a[j] = (_Float16)silu(c0[j]); a[4 + j] = (_Float16)silu(c1[j]); } }
            else {
#pragma unroll
                for (int j = 0; j < 8; ++j) a[j] = (_Float16)0.f; }
#pragma unroll
            for (int ct = 0; ct < 3; ++ct) acc[rt][ct] = __builtin_amdgcn_mfma_f32_16x16x32_f16(a, bfr[ct], acc[rt][ct], 0, 0, 0); }
    }
    LAS float* part = (LAS float*)lds;
#pragma unroll
    for (int rg = 0; rg < 3; ++rg) {
        __syncthreads();
#pragma unroll
        for (int r3 = 0; r3 < 3; ++r3)
#pragma unroll
            for (int ct = 0; ct < 3; ++ct)
#pragma unroll
                for (int i = 0; i < 4; ++i) part[(wave * 48 + r3 * 16 + 4 * fq + i) * 48 + 16 * ct + fr] = acc[rg * 3 + r3][ct][i];
        __syncthreads();
        for (int o = tid; o < 48 * 48; o += NTHR) { const int r48 = o / 48, col = o % 48, row = 48 * rg + r48; float sacc = 0.f;
#pragma unroll
            for (int w = 0; w < 8; ++w) sacc += part[(w * 48 + r48) * 48 + col];
            if (row < NMOD) MOD[((size_t)l * NMOD + row) * 3072 + n0 + col] = sacc + p.b_mod[(size_t)l * 3072 + n0 + col]; }
    }
    __syncthreads();
}
DI void sincos_d(double a, float& c, float& s) {
    const double k = __builtin_rint(a * 0.63661977236758134308);
    const double r = __builtin_fma(-k, 1.2246467991473532e-16 * 0.5, __builtin_fma(-k, 1.5707963267948966, a));
    const double r2 = r * r;
    double sp = -1.0 / 6227020800.0; sp = sp * r2 + 1.0 / 39916800.0; sp = sp * r2 - 1.0 / 362880.0; sp = sp * r2 + 1.0 / 5040.0; sp = sp * r2 - 1.0 / 120.0; sp = sp * r2 + 1.0 / 6.0;
    const double sn = r - r * r2 * sp;
    double cp = 1.0 / 87178291200.0; cp = cp * r2 - 1.0 / 479001600.0; cp = cp * r2 + 1.0 / 3628800.0; cp = cp * r2 - 1.0 / 40320.0; cp = cp * r2 + 1.0 / 720.0; cp = cp * r2 - 1.0 / 24.0; cp = cp * r2 + 0.5;
    const double cn = 1.0 - r2 * cp;
    const long long q = (long long)k & 3;
    const double cc = (q == 0) ? cn : (q == 1) ? -sn : (q == 2) ? -cn : sn;
    const double ss = (q == 0) ? sn : (q == 1) ? cn : (q == 2) ? -sn : -cn;
    c = (float)cc; s = (float)ss;
}
DI void p0_prologue(const Params& p, const __attribute__((address_space(4))) float* invf, LAS unsigned char* lds, int vcu, int G, int tid, int lane, int wave) {
    for (int u = vcu; u < 256; u += G) mod_unit(p, lds, u, tid, lane, wave);
    LAS float* scr = (LAS float*)(lds + wave * 16384);
    const int gw = vcu * NWAVES + wave, NGW = G * NWAVES;
    constexpr int I_IN = (D / 64) * (DIN / 32), I_OUT = (D / 64) * (D / 32);
    for (int it = gw; it < DEPTH * (I_IN + I_OUT); it += NGW) {
        const int l = it / (I_IN + I_OUT), r = it % (I_IN + I_OUT);
        if (r < I_IN) p0_transpose_item(p.w_in + (size_t)l * D * DIN, D, DIN, (u16*)(p.ws + WS_WIN) + (size_t)l * DIN * D, scr, r, lane, true);
        else p0_transpose_item(p.w_out + (size_t)l * D * D, D, D, (u16*)(p.ws + WS_WOUT) + (size_t)l * D * D, scr, r - I_IN, lane, false);
    }
    if (vcu == 0 && wave < DEPTH) {
        float a = 0.f, b2 = 0.f, c2 = 0.f, d = 0.f, e = 0.f;
        for (int c = lane; c < D; c += 64) { const float g = p.ln_g[wave * D + c], bb = p.ln_b[wave * D + c]; a += g; b2 += g * g; c2 += g * bb; d += bb; e += bb * bb; }
        a = wave_sum(a); b2 = wave_sum(b2); c2 = wave_sum(c2); d = wave_sum(d); e = wave_sum(e);
        if (lane == 0) { float* o = (float*)(p.ws + WS_LNC) + wave * 8; o[0] = a; o[1] = b2; o[2] = c2; o[3] = d; o[4] = e; } }
    f32x2* tab = (f32x2*)(p.ws + WS_TAB);
    for (int e = vcu * NTHR + tid; e < (SEQ + DS) * 32; e += G * NTHR) {
        const int pi = e >> 5, i = e & 31; const int pos = pi < SEQ ? pi : PAST + (pi - SEQ);
        const float ang = (float)pos * invf[i];
        float c, s; sincos_d((double)ang, c, s);
        tab[e] = (f32x2){c, s};
    }
}

template <int R>
DI void ln_stats(float (&v)[R][16], float (&mean)[R], float (&rstd)[R]) {
    float s[R];
#pragma unroll
    for (int r = 0; r < R; ++r) { s[r] = 0.f;
#pragma unroll
        for (int k = 0; k < 16; ++k) s[r] += v[r][k]; }
#pragma unroll
    for (int r = 0; r < R; ++r) s[r] = wave_sum(s[r]);
#pragma unroll
    for (int r = 0; r < R; ++r) { mean[r] = s[r] * (1.f / D); s[r] = 0.f;
#pragma unroll
        for (int k = 0; k < 16; ++k) { v[r][k] -= mean[r]; s[r] += v[r][k] * v[r][k]; } }
#pragma unroll
    for (int r = 0; r < R; ++r) s[r] = wave_sum(s[r]);
#pragma unroll
    for (int r = 0; r < R; ++r) rstd[r] = 1.f / sqrtf(s[r] * (1.f / D) + LN_EPS);
}
constexpr int LNR = 3;
DI void pre_phase(const Params& p, int gw, int NGW, int lane) {
    const float* modl = (const float*)(p.ws + WS_MOD);
    u16* ZH = (u16*)(p.ws + WS_ZH); u16* XR = (u16*)(p.ws + WS_XR); u16* ZP = (u16*)(p.ws + WS_H); f32x4* RC0 = (f32x4*)(p.ws + WS_RC0);
    for (int row0 = gw; row0 < M; row0 += LNR * NGW) {
        float v[LNR][16]; bool ok[LNR]; float mean[LNR], rstd[LNR]; int rows[LNR];
#pragma unroll
        for (int r = 0; r < LNR; ++r) { rows[r] = row0 + r * NGW; ok[r] = rows[r] < M; if (!ok[r]) rows[r] = row0; }
#pragma unroll
        for (int r = 0; r < LNR; ++r) { const int row = rows[r]; const float* x = row < MP ? p.x_prompt + (size_t)row * D : p.x_sample + (size_t)(row - MP) * D;
#pragma unroll
            for (int j2 = 0; j2 < 2; ++j2) { const f32x4 a = *(const f32x4*)(x + 512 * j2 + 8 * lane), b = *(const f32x4*)(x + 512 * j2 + 8 * lane + 4);
#pragma unroll
                for (int k = 0; k < 4; ++k) { v[r][8 * j2 + k] = a[k]; v[r][8 * j2 + 4 + k] = b[k]; } } }
#pragma unroll
        for (int r = 0; r < LNR; ++r) if (ok[r]) { u16* dst = rows[r] < MP ? ZH : XR;
#pragma unroll
            for (int j2 = 0; j2 < 2; ++j2) *(u32x4*)(dst + (size_t)rows[r] * D + 512 * j2 + 8 * lane) = pack8(v[r] + 8 * j2); }
        ln_stats<LNR>(v, mean, rstd);
#pragma unroll
        for (int r = 0; r < LNR; ++r) if (ok[r]) { const int row = rows[r]; const bool smp = row >= MP; const int bidx = smp ? NB + ((row - MP) >> 2) : (row >> 12);
            const float* sh = modl + (size_t)bidx * 3072; const float* sc = sh + 1024;
            if (!smp && lane == 0) RC0[row] = (f32x4){rstd[r], 0.f, rstd[r], rstd[r] * mean[r]};
#pragma unroll
            for (int j2 = 0; j2 < 2; ++j2) { float o[8];
#pragma unroll
                for (int h = 0; h < 2; ++h) { const f32x4 a = *(const f32x4*)(sc + 512 * j2 + 8 * lane + 4 * h), bb = *(const f32x4*)(sh + 512 * j2 + 8 * lane + 4 * h);
#pragma unroll
                    for (int k = 0; k < 4; ++k) o[4 * h + k] = smp ? v[r][8 * j2 + 4 * h + k] * rstd[r] * (1.f + a[k]) + bb[k] : (v[r][8 * j2 + 4 * h + k] + mean[r]) * (1.f + a[k]); }
                *(u32x4*)(ZP + (size_t)row * D + 512 * j2 + 8 * lane) = pack8(o); } }
    }
}
DI void modv_unit(const Params& p, LAS unsigned char* lds, int unit, int tid, int lane, int wave) {
    const int l = unit / 40, cb = unit % 40, col = 64 * cb + lane;
    const float* W = p.w_in + (size_t)l * D * DIN + col; const float* modl = (const float*)(p.ws + WS_MOD) + (size_t)l * NMOD * 3072;
    LAS float* part = (LAS float*)lds;
    LAS float* cf = (LAS float*)(lds + 32768) + wave * 128 * 12;
    __syncthreads();
#pragma unroll
    for (int hlf = 0; hlf < 2; ++hlf) { const int ci = 64 * hlf + lane, c = wave * 128 + ci; LAS float* o = cf + ci * 12;
        o[0] = l > 0 ? p.ln_g[(l - 1) * D + c] : 1.f; o[1] = l > 0 ? p.ln_b[(l - 1) * D + c] : 0.f;
#pragma unroll
        for (int b = 0; b < 4; ++b) { o[2 + b] = 1.f + modl[b * 3072 + 1024 + c]; o[6 + b] = modl[b * 3072 + c]; } }
    asm volatile("s_waitcnt lgkmcnt(0)" ::: "memory");
    float acc[4][4];
#pragma unroll
    for (int b = 0; b < 4; ++b)
#pragma unroll
        for (int k = 0; k < 4; ++k) acc[b][k] = 0.f;
#pragma unroll 1
    for (int c0 = 0; c0 < 128; c0 += 32) { float wv[32];
#pragma unroll
        for (int i = 0; i < 32; ++i) wv[i] = W[(size_t)(wave * 128 + c0 + i) * DIN];
#pragma unroll
        for (int i = 0; i < 32; ++i) { const LAS f32x4* cp = (const LAS f32x4*)(cf + (c0 + i) * 12); const f32x4 q0 = cp[0], q1 = cp[1], q2 = cp[2];
            const float g = q0[0], bb = q0[1]; const float s1[4] = {q0[2], q0[3], q1[0], q1[1]}; const float sh[4] = {q1[2], q1[3], q2[0], q2[1]};
#pragma unroll
            for (int b = 0; b < 4; ++b) { const float sw = s1[b] * wv[i]; acc[b][0] += g * sw; acc[b][1] += bb * sw; acc[b][2] += sw; acc[b][3] += sh[b] * wv[i]; } } }
#pragma unroll
    for (int b = 0; b < 4; ++b)
#pragma unroll
        for (int k = 0; k < 4; ++k) part[(wave * 16 + b * 4 + k) * 64 + lane] = acc[b][k];
    __syncthreads();
    float* MODV = (float*)(p.ws + WS_MODV);
    for (int o = tid; o < 1024; o += NTHR) { const int idx = o >> 6, ln = o & 63; float sum = 0.f;
#pragma unroll
        for (int w = 0; w < 8; ++w) sum += part[(w * 16 + idx) * 64 + ln];
        MODV[((size_t)(l * NB + (idx >> 2)) * 4 + (idx & 3)) * DIN + perm_in(64 * cb + ln)] = sum; }
    __syncthreads();
}
DI void finalize_rc_in(const Params& p, int l, int pm, LAS float* dst, int tid) {
    if (tid < 256) { const size_t row = (size_t)pm * 256 + tid; f32x4 rc;
        if (l == 0) rc = ((const f32x4*)(p.ws + WS_RC0))[row];
        else { const float* ps = (const float*)(p.ws + WS_PS) + (size_t)((l - 1) & 1) * MP * 24 + row * 24; const float* lnc = (const float*)(p.ws + WS_LNC) + (l - 1) * 8;
            float S[6];
#pragma unroll
            for (int k = 0; k < 6; ++k) S[k] = (ps[k] + ps[6 + k]) + (ps[12 + k] + ps[18 + k]);
            float N1 = 1.f / D, two = 2.f; asm volatile("" : "+v"(N1), "+v"(two));
            const float mu = S[0] * N1, rstd = 1.f / sqrtf(S[1] * N1 - mu * mu + LN_EPS);
            const float m2 = (rstd * (S[2] - mu * lnc[0]) + lnc[3]) * N1;
            const float e2 = (rstd * rstd * (S[3] - two * mu * S[4] + mu * mu * lnc[1]) + two * rstd * (S[5] - mu * lnc[2]) + lnc[4]) * N1;
            const float rstd2 = 1.f / sqrtf(e2 - m2 * m2 + LN_EPS);
            rc = (f32x4){rstd * rstd2, rstd * rstd2 * mu, rstd2, rstd2 * m2}; }
        *(LAS f32x4*)(dst + 4 * tid) = rc; }
}
DI void fin_phase(const Params& p, int gw, int NGW, int lane) {
    const u16* ZH = (const u16*)(p.ws + WS_ZH);
    const float* lg = p.ln_g + (size_t)(DEPTH - 1) * D; const float* lb = p.ln_b + (size_t)(DEPTH - 1) * D;
    for (int row0 = gw; row0 < MP; row0 += LNR * NGW) {
        float v[LNR][16]; bool ok[LNR]; float mean[LNR], rstd[LNR]; int rows[LNR];
#pragma unroll
        for (int r = 0; r < LNR; ++r) { rows[r] = row0 + r * NGW; ok[r] = rows[r] < MP; if (!ok[r]) rows[r] = row0; }
#pragma unroll
        for (int r = 0; r < LNR; ++r)
#pragma unroll
            for (int j2 = 0; j2 < 2; ++j2) unpack8(*(const u32x4*)(ZH + (size_t)rows[r] * D + 512 * j2 + 8 * lane), v[r] + 8 * j2);
        ln_stats<LNR>(v, mean, rstd);
#pragma unroll
        for (int j2 = 0; j2 < 2; ++j2)
#pragma unroll
            for (int h = 0; h < 2; ++h) { const f32x4 g = *(const f32x4*)(lg + 512 * j2 + 8 * lane + 4 * h), bb = *(const f32x4*)(lb + 512 * j2 + 8 * lane + 4 * h);
#pragma unroll
                for (int r = 0; r < LNR; ++r) if (ok[r]) { f32x4 o;
#pragma unroll
                    for (int k = 0; k < 4; ++k) o[k] = v[r][8 * j2 + 4 * h + k] * rstd[r] * g[k] + bb[k];
                    *(f32x4*)(p.out + (size_t)rows[r] * D + 512 * j2 + 8 * lane + 4 * h) = o; } }
    }
}

struct MixPtrs { const u16 *PA, *PSZC, *PPV, *PSZP, *PQ, *PSZA, *PK, *PV; u16* MIX; };
DI v4i16_t ds_tr(const LAS unsigned char* a) { return __builtin_amdgcn_ds_read_tr16_b64_v4i16((LAS v4i16_t*)a); }

DI void attn_prompt_unit(const Params& p, const MixPtrs& X, int l, int unit, LAS unsigned char* lds, int tid, int lane, int wave) {
    const int b = unit >> 6, hk = (unit >> 5) & 1, nb = unit & 31, q0 = nb * 128; const size_t rb = (size_t)b * SEQ;
    LAS unsigned char* Ks = lds; LAS unsigned char* Vs = lds + 36864;
#pragma unroll
    for (int i = 0; i < 4; ++i) { const int c = tid + 512 * i, key = c >> 3, ch = c & 7, tk = q0 - 128 + key;
        if (tk >= 0) { const u32x4 kv = *(const u32x4*)(X.PK + (rb + tk) * 128 + hk * 64 + ch * 8), vv = *(const u32x4*)(X.PV + (rb + tk) * 128 + hk * 64 + ch * 8);
            *(LAS u32x4*)(Ks + key * 144 + ch * 16) = kv; *(LAS u32x4*)(Vs + (ch >> 2) * 16384 + key * 64 + (ch & 3) * 16) = vv; } }
    __syncthreads();
    const int g = wave & 3, qh = wave >> 2, head = 4 * hk + g, r = lane & 31, h = lane >> 5;
    const float sink2 = p.sinks[l * 8 + head] * LOG2E;
    const int trq = (lane & 15) >> 2, trp = lane & 3, trg = (lane >> 4) & 1;
    const float NEG = -INFINITY;
#pragma unroll 1
    for (int e = 0; e < 2; ++e) {
        const int ql = 64 * qh + 32 * e; const size_t qrow = rb + q0 + ql + r;
        h8 qf[4];
#pragma unroll
        for (int s = 0; s < 4; ++s) qf[s] = *(const h8*)(X.PQ + qrow * 512 + head * 64 + 16 * s + 8 * h);
        f32x16 S[5];
#pragma unroll
        for (int i = 0; i < 5; ++i) { const int kl = ql + 32 * i; const bool valid = (nb > 0) || (kl >= 128);
#pragma unroll
            for (int x = 0; x < 16; ++x) S[i][x] = 0.f;
            if (valid) {
#pragma unroll
                for (int s = 0; s < 4; ++s) { const h8 kf = *(const LAS h8*)(Ks + (kl + r) * 144 + (16 * s + 8 * h) * 2); S[i] = __builtin_amdgcn_mfma_f32_32x32x16_f16(kf, qf[s], S[i], 0, 0, 0); }
            } else {
#pragma unroll
                for (int x = 0; x < 16; ++x) S[i][x] = NEG; }
            if (i == 0) {
#pragma unroll
                for (int x = 0; x < 16; ++x) if (!(crow(x, h) > r)) S[i][x] = NEG; }
            if (i == 4) {
#pragma unroll
                for (int x = 0; x < 16; ++x) if (!(crow(x, h) <= r)) S[i][x] = NEG; }
        }
        float mx = sink2;
#pragma unroll
        for (int i = 0; i < 5; ++i)
#pragma unroll
            for (int x = 0; x < 16; ++x) mx = fmaxf(mx, S[i][x]);
        mx = max_halves(mx);
        float sum = 0.f;
#pragma unroll
        for (int i = 0; i < 5; ++i)
#pragma unroll
            for (int x = 0; x < 16; ++x) { S[i][x] = ex2(S[i][x] - mx); sum += S[i][x]; }
        sum = sum_halves(sum);
        const float inv = 1.f / (sum + ex2(sink2 - mx));
        f32x16 O[2];
#pragma unroll
        for (int x = 0; x < 16; ++x) { O[0][x] = 0.f; O[1][x] = 0.f; }
#pragma unroll
        for (int i = 0; i < 5; ++i) { const int kl = ql + 32 * i; const bool valid = (nb > 0) || (kl >= 128);
            if (valid) {
#pragma unroll
                for (int s2 = 0; s2 < 2; ++s2) { float pv8[8];
#pragma unroll
                    for (int j = 0; j < 8; ++j) pv8[j] = S[i][8 * s2 + j] * inv;
                    const h8 pa = __builtin_bit_cast(h8, pack8(pv8));
#pragma unroll
                    for (int db = 0; db < 2; ++db) { const LAS unsigned char* va = Vs + db * 16384 + (kl + 16 * s2 + 4 * h + trq) * 64 + trg * 32 + trp * 8;
                        const v4i16_t lo = ds_tr(va), hi = ds_tr(va + 512);
                        const h8 vf = __builtin_bit_cast(h8, __builtin_shufflevector(lo, hi, 0, 1, 2, 3, 4, 5, 6, 7));
                        O[db] = __builtin_amdgcn_mfma_f32_32x32x16_f16(vf, pa, O[db], 0, 0, 0); } } } }
#pragma unroll
        for (int db = 0; db < 2; ++db)
#pragma unroll
            for (int xq = 0; xq < 4; ++xq) { const int col = head * 64 + 32 * db + 8 * xq + 4 * h;
                const h4 z = *(const h4*)(X.PSZA + qrow * 512 + col);
                u32x2 w; w.x = pkh(O[db][4 * xq] * (float)z[0], O[db][4 * xq + 1] * (float)z[1]); w.y = pkh(O[db][4 * xq + 2] * (float)z[2], O[db][4 * xq + 3] * (float)z[3]);
                *(u32x2*)(X.MIX + qrow * D + 512 + col) = w; }
    }
    __syncthreads();
}

DI void conv_prompt_unit(const Params& p, const MixPtrs& X, int l, int unit, LAS unsigned char* lds, int tid, int lane, int wave) {
    const int R0 = unit * 64, b = R0 >> 12, t0 = R0 & (SEQ - 1); const size_t rb = (size_t)b * SEQ;
    LAS unsigned char* WL = lds + 94 * 512;
    for (int c = tid; c < 94 * 32; c += NTHR) { const int row = c >> 5, ch = c & 31, tk = t0 - 30 + row; u32x4 v = (u32x4){0u, 0u, 0u, 0u};
        if (tk >= 0) v = *(const u32x4*)(X.PA + (rb + tk) * 256 + ch * 8);
        *(LAS u32x4*)(lds + row * 512 + ch * 16) = v; }
    for (int c = tid; c < 31 * 64; c += NTHR) *(LAS f32x4*)(WL + c * 16) = *(const f32x4*)(p.conv_w + (size_t)l * 31 * 256 + 4 * c);
    const f32x4 bias = *(const f32x4*)(p.conv_b + l * 256 + 4 * lane), cg = *(const f32x4*)(p.cnorm_g + l * 256 + 4 * lane), cb = *(const f32x4*)(p.cnorm_b + l * 256 + 4 * lane);
    __syncthreads();
    f32x4 acc[8], win[8];
#pragma unroll
    for (int tt = 0; tt < 8; ++tt) acc[tt] = bias;
    const LAS unsigned char* arow = lds + (8 * wave) * 512 + lane * 8;
#pragma unroll
    for (int k = 0; k < 7; ++k) win[k] = __builtin_convertvector(*(const LAS h4*)(arow + k * 512), f32x4);
#pragma unroll 1
    for (int jb = 0; jb < 4; ++jb) {
#pragma unroll
        for (int jj = 0; jj < 8; ++jj) { const int j = 8 * jb + jj;
            if (j < 31) {
                win[(jj + 7) & 7] = __builtin_convertvector(*(const LAS h4*)(arow + (j + 7) * 512), f32x4);
                const f32x4 w = *(const LAS f32x4*)(WL + j * 1024 + lane * 16);
#pragma unroll
                for (int tt = 0; tt < 8; ++tt) acc[tt] += w * win[(jj + tt) & 7]; } } }
#pragma unroll
    for (int tt = 0; tt < 8; ++tt) { const size_t row = (size_t)R0 + 8 * wave + tt;
        const float mean = wave_sum((acc[tt][0] + acc[tt][1]) + (acc[tt][2] + acc[tt][3])) * (1.f / 256.f);
        const f32x4 d = acc[tt] - mean;
        const float rstd = 1.f / sqrtf(wave_sum((d[0] * d[0] + d[1] * d[1]) + (d[2] * d[2] + d[3] * d[3])) * (1.f / 256.f) + LN_EPS);
        const h4 zc = *(const h4*)(X.PSZC + row * 256 + 4 * lane); float o[4];
#pragma unroll
        for (int k = 0; k < 4; ++k) o[k] = silu(d[k] * rstd * cg[k] + cb[k]) * (float)zc[k];
        u32x2 w; w.x = pkh(o[0], o[1]); w.y = pkh(o[2], o[3]);
        *(u32x2*)(X.MIX + row * D + 4 * lane) = w; }
    __syncthreads();
}

DI void pool_prompt_unit(const Params& p, const MixPtrs& X, int l, int unit, LAS unsigned char* lds, int tid, int lane, int wave) {
    const int R0 = unit * 64, b = R0 >> 12, t0 = R0 & (SEQ - 1); const size_t rb = (size_t)b * SEQ;
    LAS unsigned char* PL = lds + 79 * 512;
    for (int c = tid; c < 79 * 32; c += NTHR) { const int row = c >> 5, ch = c & 31, tk = t0 - 15 + row; u32x4 v = (u32x4){0u, 0u, 0u, 0u};
        if (tk >= 0) v = *(const u32x4*)(X.PPV + (rb + tk) * 256 + ch * 8);
        *(LAS u32x4*)(lds + row * 512 + ch * 16) = v; }
    __syncthreads();
    { const int wlen = 2 << (lane >> 4);
        const LAS unsigned char* prow = lds + (8 * wave + 15) * 512 + lane * 8;
        f32x4 sm[8];
#pragma unroll
        for (int tt = 0; tt < 8; ++tt) sm[tt] = (f32x4){0.f, 0.f, 0.f, 0.f};
#pragma unroll 1
        for (int i = 0; i < 16; ++i) { if (i < wlen) {
#pragma unroll
            for (int tt = 0; tt < 8; ++tt) sm[tt] += __builtin_convertvector(*(const LAS h4*)(prow + (tt - i) * 512), f32x4); } }
#pragma unroll
        for (int tt = 0; tt < 8; ++tt) {
            const int t = t0 + 8 * wave + tt; const float cnt = (float)(wlen < t + 1 ? wlen : t + 1);
            const f32x4 cur = __builtin_convertvector(*(const LAS h4*)(prow + tt * 512), f32x4);
            const f32x4 pl = sm[tt] * (1.f / cnt) - cur;
            u32x2 w; w.x = pkh(pl[0], pl[1]); w.y = pkh(pl[2], pl[3]);
            *(LAS u32x2*)(PL + (8 * wave + tt) * 528 + lane * 8) = w; } }
    __syncthreads();
    { const int g = wave & 3, th = wave >> 2, r = lane & 31, h = lane >> 5;
        const float* pw = p.pool_w + ((size_t)l * 4 + g) * 64 * 64 + r;
        f32x16 Dd[2];
#pragma unroll
        for (int x = 0; x < 16; ++x) { Dd[0][x] = 0.f; Dd[1][x] = 0.f; }
#pragma unroll 1
        for (int s = 0; s < 4; ++s) { const h8 bf = *(const LAS h8*)(PL + (32 * th + r) * 528 + (64 * g + 16 * s + 8 * h) * 2);
#pragma unroll
            for (int nb = 0; nb < 2; ++nb) { h8 af;
#pragma unroll
                for (int j = 0; j < 8; ++j) af[j] = (_Float16)pw[(size_t)(16 * s + 8 * h + j) * 64 + 32 * nb];
                Dd[nb] = __builtin_amdgcn_mfma_f32_32x32x16_f16(af, bf, Dd[nb], 0, 0, 0); } }
        const size_t row = (size_t)R0 + 32 * th + r;
#pragma unroll
        for (int nb = 0; nb < 2; ++nb)
#pragma unroll
            for (int xq = 0; xq < 4; ++xq) { const int col = 64 * g + 32 * nb + 8 * xq + 4 * h;
                const f32x4 ps = *(const f32x4*)(p.pool_scale + l * 256 + col); const h4 z = *(const h4*)(X.PSZP + row * 256 + col);
                u32x2 w; w.x = pkh(Dd[nb][4 * xq] * ps[0] * (float)z[0], Dd[nb][4 * xq + 1] * ps[1] * (float)z[1]); w.y = pkh(Dd[nb][4 * xq + 2] * ps[2] * (float)z[2], Dd[nb][4 * xq + 3] * ps[3] * (float)z[3]);
                *(u32x2*)(X.MIX + row * D + 256 + col) = w; } }
    __syncthreads();
}


constexpr int MX_WCV = 0;
constexpr int MX_WPT = 81920;
constexpr int MX_SCR = 0, MX_SCR_W = 7168;
constexpr int MX_TQ = RING_BYTES + 640;
DI void mix_stage_weights(const Params& p, int l, LAS unsigned char* lds, int tid) {
    for (int c = tid; c < 31 * 64; c += NTHR) *(LAS f32x4*)(lds + MX_WCV + c * 16) = *(const f32x4*)(p.conv_w + (size_t)l * 31 * 256 + 4 * c);
    for (int e = tid; e < 4 * 64 * 64; e += NTHR) { const int g = e >> 12, c = (e >> 6) & 63, n = e & 63;
        *(LAS _Float16*)(lds + MX_WPT + ((g * 64 + n) * 72 + c) * 2) = (_Float16)p.pool_w[(size_t)l * 16384 + e]; }
    if (tid == 0) *(LAS unsigned*)(lds + MX_TQ) = 0u;
}
DI void task_attn(const Params& p, int l, int b, int hk, int g, int tq0, int lane) {
    const int head = 4 * hk + g, r = lane & 31, h = lane >> 5; const size_t rb = (size_t)b * SEQ; const size_t qrow = rb + tq0 + r;
    const float sink2 = p.sinks[l * 8 + head] * LOG2E; const float NEG = -INFINITY;
    const u16* PQ = (const u16*)(p.ws + WS_PQ); const u16* PK = (const u16*)(p.ws + WS_PK);
    f32x16 S[5];
    {   h8 qf[4];
#pragma unroll
        for (int s = 0; s < 4; ++s) qf[s] = *(const h8*)(PQ + qrow * 512 + head * 64 + 16 * s + 8 * h);
        h8 kf[5][4];
#pragma unroll
        for (int i = 0; i < 5; ++i) { const int tk = tq0 - 128 + 32 * i, tkc = tk < 0 ? 0 : tk;
#pragma unroll
            for (int s = 0; s < 4; ++s) kf[i][s] = *(const h8*)(PK + (rb + tkc + r) * 128 + hk * 64 + 16 * s + 8 * h); }
#pragma unroll
        for (int i = 0; i < 5; ++i) { const int tk = tq0 - 128 + 32 * i;
#pragma unroll
            for (int x = 0; x < 16; ++x) S[i][x] = 0.f;
#pragma unroll
            for (int s = 0; s < 4; ++s) S[i] = __builtin_amdgcn_mfma_f32_32x32x16_f16(kf[i][s], qf[s], S[i], 0, 0, 0);
#pragma unroll
            for (int x = 0; x < 16; ++x) S[i][x] = tk >= 0 ? S[i][x] : NEG; } }
#pragma unroll
    for (int x = 0; x < 16; ++x) { if (!(crow(x, h) > r)) S[0][x] = NEG; if (!(crow(x, h) <= r)) S[4][x] = NEG; }
    float mx = sink2;
#pragma unroll
    for (int i = 0; i < 5; ++i)
#pragma unroll
        for (int x = 0; x < 16; ++x) mx = fmaxf(mx, S[i][x]);
    mx = max_halves(mx);
    float sum = 0.f;
#pragma unroll
    for (int i = 0; i < 5; ++i)
#pragma unroll
        for (int x = 0; x < 16; ++x) { S[i][x] = ex2(S[i][x] - mx); sum += S[i][x]; }
    sum = sum_halves(sum);
    const float inv = 1.f / (sum + ex2(sink2 - mx));
    u32x4 pa[5][2];
#pragma unroll
    for (int i = 0; i < 5; ++i)
#pragma unroll
        for (int s2 = 0; s2 < 2; ++s2) { float pv8[8];
#pragma unroll
            for (int j = 0; j < 8; ++j) pv8[j] = S[i][8 * s2 + j] * inv;
            pa[i][s2] = pack8(pv8); }
    int voff = ((b * 2 + hk) * 64 + r) * SEQ + (tq0 - 128) + 4 * h;
    asm volatile("" : "+v"(voff) : "v"(pa[0][0]), "v"(pa[0][1]), "v"(pa[1][0]), "v"(pa[1][1]), "v"(pa[2][0]), "v"(pa[2][1]), "v"(pa[3][0]), "v"(pa[3][1]), "v"(pa[4][0]), "v"(pa[4][1]));
    const u16* vtb = (const u16*)(p.ws + WS_VT) + voff;
    u32x2 vlo[5][2][2], vhi[5][2][2];
#pragma unroll
    for (int i = 0; i < 5; ++i) { const int tk = tq0 - 128 + 32 * i; const int adj = tk < 0 ? -tk : 0;
#pragma unroll
        for (int s2 = 0; s2 < 2; ++s2)
#pragma unroll
            for (int db = 0; db < 2; ++db) { const u16* vp = vtb + (size_t)db * 32 * SEQ + 32 * i + 16 * s2 + adj; vlo[i][s2][db] = *(const u32x2*)vp; vhi[i][s2][db] = *(const u32x2*)(vp + 8); } }
    f32x16 O[2];
#pragma unroll
    for (int x = 0; x < 16; ++x) { O[0][x] = 0.f; O[1][x] = 0.f; }
#pragma unroll
    for (int i = 0; i < 5; ++i)
#pragma unroll
        for (int s2 = 0; s2 < 2; ++s2)
#pragma unroll
            for (int db = 0; db < 2; ++db) { const u32x4 vv = {vlo[i][s2][db][0], vlo[i][s2][db][1], vhi[i][s2][db][0], vhi[i][s2][db][1]};
                O[db] = __builtin_amdgcn_mfma_f32_32x32x16_f16(__builtin_bit_cast(h8, vv), __builtin_bit_cast(h8, pa[i][s2]), O[db], 0, 0, 0); }
    const u16* PSZA = (const u16*)(p.ws + WS_PSZA); u16* MIX = (u16*)(p.ws + WS_MIX);
    u32x2 zg[2][4];
#pragma unroll
    for (int db = 0; db < 2; ++db)
#pragma unroll
        for (int xq = 0; xq < 4; ++xq) zg[db][xq] = *(const u32x2*)(PSZA + qrow * 512 + head * 64 + 32 * db + 8 * xq + 4 * h);
#pragma unroll
    for (int db = 0; db < 2; ++db)
#pragma unroll
        for (int xq = 0; xq < 4; ++xq) { const int col = head * 64 + 32 * db + 8 * xq + 4 * h; const h4 z = __builtin_bit_cast(h4, zg[db][xq]);
            u32x2 w; w.x = pkh(O[db][4 * xq] * (float)z[0], O[db][4 * xq + 1] * (float)z[1]); w.y = pkh(O[db][4 * xq + 2] * (float)z[2], O[db][4 * xq + 3] * (float)z[3]);
            *(u32x2*)(MIX + qrow * D + 512 + col) = w; }
}
constexpr int MX_X = 68608;
DI void conv_tile_dma(const Params& p, int R0, LAS unsigned char* lds, int wave, int lane) {
    const int b = R0 >> 12, t0 = R0 & (SEQ - 1);
    const unsigned char* PA = p.ws + WS_PA;
#pragma unroll
    for (int i = 0; i < 6; ++i) { const int piece = wave + 8 * i;
        if (piece < 47) { const int row = 2 * piece + (lane >> 5); int tk = t0 - 30 + row; tk = tk < 0 ? 0 : tk;
            __builtin_amdgcn_global_load_lds((const unsigned*)(PA + ((size_t)b * SEQ + tk) * 512 + (lane & 31) * 16), (LAS unsigned*)(lds + MX_X + piece * 1024), 16, 0, 0); } }
}
DI void task_conv(const Params& p, int l, int R0, int sub, LAS unsigned char* lds, int lane) {
    const int t0 = (R0 & (SEQ - 1)) + 8 * sub; const size_t rowb = (size_t)R0 + 8 * sub;
    const f32x4 bias = *(const f32x4*)(p.conv_b + l * 256 + 4 * lane), cg = *(const f32x4*)(p.cnorm_g + l * 256 + 4 * lane), cb = *(const f32x4*)(p.cnorm_b + l * 256 + 4 * lane);
    const LAS unsigned char* arow = lds + MX_X + (8 * sub) * 512 + lane * 8;
    const LAS unsigned char* wl = lds + MX_WCV + lane * 16;
    f32x4 acc[8], win[8];
#pragma unroll
    for (int tt = 0; tt < 8; ++tt) acc[tt] = bias;
#pragma unroll
    for (int k = 0; k < 7; ++k) { const f32x4 v = __builtin_convertvector(*(const LAS h4*)(arow + k * 512), f32x4); win[k] = (t0 - 30 + k >= 0) ? v : (f32x4){0.f, 0.f, 0.f, 0.f}; }
#pragma unroll 1
    for (int jb = 0; jb < 4; ++jb) {
#pragma unroll
        for (int jj = 0; jj < 8; ++jj) { const int j = 8 * jb + jj;
            if (j < 31) {
                const f32x4 v = __builtin_convertvector(*(const LAS h4*)(arow + (j + 7) * 512), f32x4);
                win[(jj + 7) & 7] = (t0 - 30 + j + 7 >= 0) ? v : (f32x4){0.f, 0.f, 0.f, 0.f};
                const f32x4 w = *(const LAS f32x4*)(wl + j * 1024);
#pragma unroll
                for (int tt = 0; tt < 8; ++tt) acc[tt] += w * win[(jj + tt) & 7]; } } }
    const u16* PSZC = (const u16*)(p.ws + WS_PSZC); u16* MIX = (u16*)(p.ws + WS_MIX);
#pragma unroll
    for (int tt = 0; tt < 8; ++tt) { const size_t row = rowb + tt;
        const float mean = wave_sum((acc[tt][0] + acc[tt][1]) + (acc[tt][2] + acc[tt][3])) * (1.f / 256.f);
        const f32x4 d = acc[tt] - mean;
        const float rstd = 1.f / sqrtf(wave_sum((d[0] * d[0] + d[1] * d[1]) + (d[2] * d[2] + d[3] * d[3])) * (1.f / 256.f) + LN_EPS);
        const h4 z = *(const h4*)(PSZC + row * 256 + 4 * lane); float o[4];
#pragma unroll
        for (int k = 0; k < 4; ++k) o[k] = silu(d[k] * rstd * cg[k] + cb[k]) * (float)z[k];
        u32x2 w; w.x = pkh(o[0], o[1]); w.y = pkh(o[2], o[3]);
        *(u32x2*)(MIX + row * D + 4 * lane) = w; }
}
DI void task_pool(const Params& p, int l, int R0, int th, int g, LAS unsigned char* lds, int wave, int lane) {
    const u16* PPV = (const u16*)(p.ws + WS_PPV); const u16* PSZP = (const u16*)(p.ws + WS_PSZP); u16* MIX = (u16*)(p.ws + WS_MIX);
    const int b = R0 >> 12, T0 = (R0 & (SEQ - 1)) + 32 * th; const size_t rb = (size_t)b * SEQ;
    LAS unsigned char* scr = lds + MX_SCR + wave * MX_SCR_W;
    const int r = lane & 31, h = lane >> 5;
    u32x4 tl[6];
#pragma unroll
    for (int i = 0; i < 6; ++i) { const int row = (lane >> 3) + 8 * i, tk = T0 - 15 + row; const int tkc = tk < 0 ? 0 : (row < 47 ? tk : T0 + 31);
        const u32x4 v = *(const u32x4*)(PPV + (rb + tkc) * 256 + 64 * g + 8 * (lane & 7)); const unsigned msk = (unsigned)-(int)(tk >= 0); tl[i] = (u32x4){v[0] & msk, v[1] & msk, v[2] & msk, v[3] & msk}; }
    const size_t orow = rb + T0 + r;
    u32x2 zp[2][4]; f32x4 ps[2][4];
#pragma unroll
    for (int nb = 0; nb < 2; ++nb)
#pragma unroll
        for (int xq = 0; xq < 4; ++xq) { const int col = 64 * g + 32 * nb + 8 * xq + 4 * h; zp[nb][xq] = *(const u32x2*)(PSZP + orow * 256 + col); ps[nb][xq] = *(const f32x4*)(p.pool_scale + l * 256 + col); }
#pragma unroll
    for (int i = 0; i < 6; ++i) { const int row = (lane >> 3) + 8 * i; if (row < 47) *(LAS u32x4*)(scr + row * 144 + (lane & 7) * 16) = tl[i]; }
    asm volatile("s_waitcnt lgkmcnt(0)" ::: "memory");
    const int wlen = 2 << g; const int t = T0 + r; const float icnt = 1.f / (float)(wlen < t + 1 ? wlen : t + 1);
    h8 bf[4];
#pragma unroll
    for (int s = 0; s < 4; ++s) { const LAS unsigned char* base = scr + (15 + r) * 144 + (16 * s + 8 * h) * 2; float sm[8];
        const h8 cur = *(const LAS h8*)base;
#pragma unroll
        for (int k = 0; k < 8; ++k) sm[k] = (float)cur[k];
        for (int i = 1; i < wlen; ++i) { const h8 v = *(const LAS h8*)(base - i * 144);
#pragma unroll
            for (int k = 0; k < 8; ++k) sm[k] += (float)v[k]; }
        float pl[8];
#pragma unroll
        for (int k = 0; k < 8; ++k) pl[k] = sm[k] * icnt - (float)cur[k];
        bf[s] = __builtin_bit_cast(h8, pack8(pl)); }
    f32x16 Dd[2];
#pragma unroll
    for (int x = 0; x < 16; ++x) { Dd[0][x] = 0.f; Dd[1][x] = 0.f; }
#pragma unroll
    for (int s = 0; s < 4; ++s)
#pragma unroll
        for (int nb = 0; nb < 2; ++nb) { const h8 af = *(const LAS h8*)(lds + MX_WPT + ((g * 64 + 32 * nb + r) * 72 + 16 * s + 8 * h) * 2);
            Dd[nb] = __builtin_amdgcn_mfma_f32_32x32x16_f16(af, bf[s], Dd[nb], 0, 0, 0); }
#pragma unroll
    for (int nb = 0; nb < 2; ++nb)
#pragma unroll
        for (int xq = 0; xq < 4; ++xq) { const int col = 64 * g + 32 * nb + 8 * xq + 4 * h; const h4 z = __builtin_bit_cast(h4, zp[nb][xq]); const f32x4 sc = ps[nb][xq];
            u32x2 w; w.x = pkh(Dd[nb][4 * xq] * sc[0] * (float)z[0], Dd[nb][4 * xq + 1] * sc[1] * (float)z[1]); w.y = pkh(Dd[nb][4 * xq + 2] * sc[2] * (float)z[2], Dd[nb][4 * xq + 3] * sc[3] * (float)z[3]);
            *(u32x2*)(MIX + orow * D + 256 + col) = w; }
}
DI void mix_prompt_tasks(const Params& p, int l, int unit, LAS unsigned char* lds, int lane, int wave) {
    int one = 1; asm volatile("" : "+s"(one));
    if (one) task_attn(p, l, unit >> 6, (unit >> 5) & 1, wave & 3, (unit & 31) * 128 + 32 * (wave >> 2), lane_id());
    asm volatile("" : "+s"(one) :: "memory");
    if (one) task_attn(p, l, unit >> 6, (unit >> 5) & 1, wave & 3, (unit & 31) * 128 + 32 * (2 + (wave >> 2)), lane_id());
    asm volatile("s_waitcnt vmcnt(0) lgkmcnt(0)\n\ts_barrier" : "+s"(one) :: "memory");
    if (one) task_conv(p, l, unit * 64, wave, lds, lane_id());
    asm volatile("s_waitcnt lgkmcnt(0)\n\ts_barrier" : "+s"(one) :: "memory");
    if (one) task_pool(p, l, unit * 64, wave >> 2, wave & 3, lds, wave, lane_id());
    (void)lane;
}

DI void convpool_sample_unit(const Params& p, const MixPtrs& X, int l, int b, int part, LAS unsigned char* lds, int tid, int lane, int wave) {
    LAS float* cv = (LAS float*)lds;
    const int c = tid & 255, tp = tid >> 8; const size_t r0 = (size_t)MP + 4 * b;
    if (part == 0) {
        const float* cc = p.cache_conv + (size_t)(l * DB + b) * 30 * 256;
        float xa[34], wv[31];
        { const float* pc = cc + c;
#pragma unroll
          for (int ri = 0; ri < 30; ++ri) xa[ri] = pc[ri * 256];
          const u16* pn = X.PA + r0 * 256 + c;
#pragma unroll
          for (int ri = 0; ri < 4; ++ri) xa[30 + ri] = (float)(*(const _Float16*)(pn + ri * 256));
          const float* pw = p.conv_w + (size_t)l * 31 * 256 + c;
#pragma unroll
          for (int j = 0; j < 31; ++j) wv[j] = pw[j * 256]; }
        float a0 = p.conv_b[l * 256 + c], a1 = a0;
        if (tp == 0) {
#pragma unroll
            for (int j = 0; j < 31; ++j) { a0 += wv[j] * xa[j]; a1 += wv[j] * xa[j + 1]; }
        } else {
#pragma unroll
            for (int j = 0; j < 31; ++j) { a0 += wv[j] * xa[j + 2]; a1 += wv[j] * xa[j + 3]; } }
        cv[(2 * tp) * 256 + c] = a0; cv[(2 * tp + 1) * 256 + c] = a1;
        { float* oc = p.out + OFF_CONVS + (size_t)(l * DB + b) * 30 * 256; for (int e = tid; e < 26 * 64; e += NTHR) *(f32x4*)(oc + 4 * e) = *(const f32x4*)(cc + 4 * 256 + 4 * e); }
        __syncthreads();
        if (wave < 4) { const int t = wave; const f32x4 v = *(const LAS f32x4*)(cv + t * 256 + 4 * lane);
            const float mean = wave_sum((v[0] + v[1]) + (v[2] + v[3])) * (1.f / 256.f); const f32x4 d = v - mean;
            const float rstd = 1.f / sqrtf(wave_sum((d[0] * d[0] + d[1] * d[1]) + (d[2] * d[2] + d[3] * d[3])) * (1.f / 256.f) + LN_EPS);
            const f32x4 cg = *(const f32x4*)(p.cnorm_g + l * 256 + 4 * lane), cb = *(const f32x4*)(p.cnorm_b + l * 256 + 4 * lane);
            const h4 zc = *(const h4*)(X.PSZC + (r0 + t) * 256 + 4 * lane); float o[4];
#pragma unroll
            for (int k = 0; k < 4; ++k) o[k] = silu(d[k] * rstd * cg[k] + cb[k]) * (float)zc[k];
            u32x2 w; w.x = pkh(o[0], o[1]); w.y = pkh(o[2], o[3]);
            *(u32x2*)(X.MIX + (r0 + t) * D + 4 * lane) = w; }
    } else {
        const float* cp = p.cache_pool + (size_t)(l * DB + b) * 15 * 256;
        float xa[19];
        { const float* pc = cp + c;
#pragma unroll
          for (int ri = 0; ri < 15; ++ri) xa[ri] = pc[ri * 256];
          const u16* pn = X.PPV + r0 * 256 + c;
#pragma unroll
          for (int ri = 0; ri < 4; ++ri) xa[15 + ri] = (float)(*(const _Float16*)(pn + ri * 256)); }
        const int wlen = 2 << (c >> 6); float s0 = 0.f, s1 = 0.f, c0, c1;
        if (tp == 0) { c0 = xa[15]; c1 = xa[16];
#pragma unroll
            for (int i = 0; i < 16; ++i) if (i < wlen) { s0 += xa[15 - i]; s1 += xa[16 - i]; }
        } else { c0 = xa[17]; c1 = xa[18];
#pragma unroll
            for (int i = 0; i < 16; ++i) if (i < wlen) { s0 += xa[17 - i]; s1 += xa[18 - i]; } }
        const float iw = 1.f / (float)wlen;
        cv[(2 * tp) * 256 + c] = s0 * iw - c0; cv[(2 * tp + 1) * 256 + c] = s1 * iw - c1;
        { float* op = p.out + OFF_POOLS + (size_t)(l * DB + b) * 15 * 256; for (int e = tid; e < 11 * 64; e += NTHR) *(f32x4*)(op + 4 * e) = *(const f32x4*)(cp + 4 * 256 + 4 * e); }
        __syncthreads();
        const int g = c >> 6, n = c & 63; const float* pw = p.pool_w + ((size_t)l * 4 + g) * 64 * 64 + n; float y0 = 0.f, y1 = 0.f;
#pragma unroll 16
        for (int k = 0; k < 64; ++k) { const float w = pw[(size_t)k * 64]; y0 += cv[(2 * tp) * 256 + 64 * g + k] * w; y1 += cv[(2 * tp + 1) * 256 + 64 * g + k] * w; }
        const float ps = p.pool_scale[l * 256 + c];
        const float z0 = (float)(*(const _Float16*)(X.PSZP + (r0 + 2 * tp) * 256 + c)), z1 = (float)(*(const _Float16*)(X.PSZP + (r0 + 2 * tp + 1) * 256 + c));
        *(_Float16*)(X.MIX + (r0 + 2 * tp) * D + 256 + c) = (_Float16)(y0 * ps * z0); *(_Float16*)(X.MIX + (r0 + 2 * tp + 1) * D + 256 + c) = (_Float16)(y1 * ps * z1); }
    __syncthreads();
}

DI void attn_sample_unit(const Params& p, const MixPtrs& X, int l, int unit, LAS unsigned char* lds, int tid, int lane, int wave) {
    const int b = unit >> 1, hk = unit & 1; const size_t r0 = (size_t)MP + 4 * b;
    LAS float* Ks = (LAS float*)lds;
    LAS float* Vs = Ks + 132 * 65;
    LAS float* Qs = Vs + 132 * 64;
    LAS float* Ss = Qs + 16 * 65;
    const float* ck = p.cache_k + ((size_t)(l * DB + b) * 128 * 2 + hk) * 64; const float* cvv = p.cache_v + ((size_t)(l * DB + b) * 128 * 2 + hk) * 64;
    float* ok = p.out + OFF_KS + ((size_t)(l * DB + b) * 128 * 2 + hk) * 64; float* ov = p.out + OFF_VS + ((size_t)(l * DB + b) * 128 * 2 + hk) * 64;
#pragma unroll
    for (int i = 0; i < 4; ++i) { const int e = tid + 512 * i, j = e >> 4, d4 = (e & 15) * 4;
        const f32x4 kv = *(const f32x4*)(ck + (size_t)j * 128 + d4), vv = *(const f32x4*)(cvv + (size_t)j * 128 + d4);
        Ks[j * 65 + d4] = kv[0]; Ks[j * 65 + d4 + 1] = kv[1]; Ks[j * 65 + d4 + 2] = kv[2]; Ks[j * 65 + d4 + 3] = kv[3];
        *(LAS f32x4*)(Vs + j * 64 + d4) = vv;
        if (j >= 4) { *(f32x4*)(ok + (size_t)(j - 4) * 128 + d4) = kv; *(f32x4*)(ov + (size_t)(j - 4) * 128 + d4) = vv; } }
    if (tid < 256) { const int t = tid >> 6, d = tid & 63;
        Ks[(128 + t) * 65 + d] = (float)(*(const _Float16*)(X.PK + (r0 + t) * 128 + hk * 64 + d));
        Vs[(128 + t) * 64 + d] = (float)(*(const _Float16*)(X.PV + (r0 + t) * 128 + hk * 64 + d)); }
#pragma unroll
    for (int i = 0; i < 2; ++i) { const int e = tid + 512 * i, qr = e >> 6, d = e & 63, t = qr >> 2, g = qr & 3;
        Qs[qr * 65 + d] = (float)(*(const _Float16*)(X.PQ + (r0 + t) * 512 + (4 * hk + g) * 64 + d)); }
    __syncthreads();
    { const int qr = tid & 15, kg = tid >> 4, t = qr >> 2;
        for (int kk = kg; kk < 132; kk += 32) { float s = 0.f;
#pragma unroll 16
            for (int d = 0; d < 64; ++d) s += Qs[qr * 65 + d] * Ks[kk * 65 + d];
            Ss[qr * 133 + kk] = (kk >= t + 1 && kk <= t + 128) ? s : -INFINITY; } }
    __syncthreads();
#pragma unroll
    for (int q2 = 0; q2 < 2; ++q2) { const int qr = 2 * wave + q2, g = qr & 3; const float sink2 = p.sinks[l * 8 + 4 * hk + g] * LOG2E;
        float s0 = Ss[qr * 133 + lane], s1 = Ss[qr * 133 + 64 + lane], s2 = lane < 4 ? Ss[qr * 133 + 128 + lane] : -INFINITY;
        const float mx = fmaxf(wave_max(fmaxf(fmaxf(s0, s1), s2)), sink2);
        s0 = ex2(s0 - mx); s1 = ex2(s1 - mx); s2 = ex2(s2 - mx);
        const float inv = 1.f / (wave_sum(s0 + s1 + s2) + ex2(sink2 - mx));
        Ss[qr * 133 + lane] = s0 * inv; Ss[qr * 133 + 64 + lane] = s1 * inv; if (lane < 4) Ss[qr * 133 + 128 + lane] = s2 * inv; }
    __syncthreads();
    { const int qr = tid & 15, dg = tid >> 4, t = qr >> 2, g = qr & 3; float o0 = 0.f, o1 = 0.f;
#pragma unroll 4
        for (int kk = 0; kk < 132; ++kk) { const float pr = Ss[qr * 133 + kk]; const f32x2 v = *(const LAS f32x2*)(Vs + kk * 64 + 2 * dg); o0 += pr * v[0]; o1 += pr * v[1]; }
        const int col = (4 * hk + g) * 64 + 2 * dg;
        const h2 z = *(const h2*)(X.PSZA + (r0 + t) * 512 + col);
        *(unsigned*)(X.MIX + (r0 + t) * D + 512 + col) = pkh(o0 * (float)z[0], o1 * (float)z[1]); }
    __syncthreads();
}


template <int R>
DI void sample_ln_rows(const Params& p, int l, int row0, int lane) {
    const u16* ZH = (const u16*)(p.ws + WS_ZH); u16* XR = (u16*)(p.ws + WS_XR); u16* ZP = (u16*)(p.ws + WS_H);
    const float* lg = p.ln_g + (size_t)l * D; const float* lb = p.ln_b + (size_t)l * D;
    const float* modn = (const float*)(p.ws + WS_MOD) + (size_t)(l + 1) * NMOD * 3072;
    float v[R][16], mean[R], rstd[R];
#pragma unroll
    for (int r = 0; r < R; ++r)
#pragma unroll
        for (int j2 = 0; j2 < 2; ++j2) unpack8(*(const u32x4*)(ZH + (size_t)(row0 + r) * D + 512 * j2 + 8 * lane), v[r] + 8 * j2);
    ln_stats<R>(v, mean, rstd);
#pragma unroll
    for (int j2 = 0; j2 < 2; ++j2)
#pragma unroll
        for (int h = 0; h < 2; ++h) { const f32x4 g = *(const f32x4*)(lg + 512 * j2 + 8 * lane + 4 * h), bb = *(const f32x4*)(lb + 512 * j2 + 8 * lane + 4 * h);
#pragma unroll
            for (int r = 0; r < R; ++r)
#pragma unroll
                for (int k = 0; k < 4; ++k) v[r][8 * j2 + 4 * h + k] = v[r][8 * j2 + 4 * h + k] * rstd[r] * g[k] + bb[k]; }
    if (l == DEPTH - 1) {
#pragma unroll
        for (int r = 0; r < R; ++r) { float* y = p.out + OFF_YS + (size_t)(row0 - MP + r) * D;
#pragma unroll
            for (int j2 = 0; j2 < 2; ++j2)
#pragma unroll
                for (int h = 0; h < 2; ++h) *(f32x4*)(y + 512 * j2 + 8 * lane + 4 * h) = (f32x4){v[r][8 * j2 + 4 * h], v[r][8 * j2 + 4 * h + 1], v[r][8 * j2 + 4 * h + 2], v[r][8 * j2 + 4 * h + 3]}; }
    } else {
#pragma unroll
        for (int r = 0; r < R; ++r)
#pragma unroll
            for (int j2 = 0; j2 < 2; ++j2) *(u32x4*)(XR + (size_t)(row0 + r) * D + 512 * j2 + 8 * lane) = pack8(v[r] + 8 * j2);
        ln_stats<R>(v, mean, rstd);
#pragma unroll
        for (int r = 0; r < R; ++r) { const int row = row0 + r; const float* sh = modn + (size_t)(NB + ((row - MP) >> 2)) * 3072; const float* sc = sh + 1024;
#pragma unroll
            for (int j2 = 0; j2 < 2; ++j2) { float o[8];
#pragma unroll
                for (int h = 0; h < 2; ++h) { const f32x4 a = *(const f32x4*)(sc + 512 * j2 + 8 * lane + 4 * h), bb = *(const f32x4*)(sh + 512 * j2 + 8 * lane + 4 * h);
#pragma unroll
                    for (int k = 0; k < 4; ++k) o[4 * h + k] = v[r][8 * j2 + 4 * h + k] * rstd[r] * (1.f + a[k]) + bb[k]; }
                *(u32x4*)(ZP + (size_t)row * D + 512 * j2 + 8 * lane) = pack8(o); } }
    }
}
DI void outproj_sample_unit(const Params& p, int l, int unit, LAS unsigned char* lds, int tid, int lane, int wave) {
    const int rbk0 = unit >> 5, cb = unit & 31, R0 = MP + 64 * rbk0, n0 = 32 * cb, r = lane & 31, h = lane >> 5;
    const u16* MIX = (const u16*)(p.ws + WS_MIX); const u16* WT = (const u16*)(p.ws + WS_WOUT) + (size_t)l * D * D;
    const u16* bp = WT + (size_t)perm_out(n0 + r) * D + wave * 128 + 8 * h;
    const u16* ap = MIX + (size_t)(R0 + r) * D + wave * 128 + 8 * h;
    f32x16 acc[2];
#pragma unroll
    for (int x = 0; x < 16; ++x) { acc[0][x] = 0.f; acc[1][x] = 0.f; }
#pragma unroll
    for (int s = 0; s < 8; ++s) { const h8 bf = *(const h8*)(bp + 16 * s);
#pragma unroll
        for (int rb = 0; rb < 2; ++rb) { const h8 af = *(const h8*)(ap + (size_t)rb * 32 * D + 16 * s); acc[rb] = __builtin_amdgcn_mfma_f32_32x32x16_f16(af, bf, acc[rb], 0, 0, 0); } }
    LAS float* part = (LAS float*)lds;
#pragma unroll
    for (int rb = 0; rb < 2; ++rb)
#pragma unroll
        for (int x = 0; x < 16; ++x) part[(wave * 64 + 32 * rb + crow(x, h)) * 32 + r] = acc[rb][x];
    __syncthreads();
    const float* modl = (const float*)(p.ws + WS_MOD) + (size_t)l * NMOD * 3072;
#pragma unroll
    for (int q = 0; q < 4; ++q) { const int o = tid + 512 * q, row = o >> 5, col = o & 31; float sum = 0.f;
#pragma unroll
        for (int w = 0; w < 8; ++w) sum += part[(w * 64 + row) * 32 + col];
        const int grow = R0 + row, bidx = NB + ((grow - MP) >> 2);
        const float xr = (float)(*(const _Float16*)((const u16*)(p.ws + WS_XR) + (size_t)grow * D + n0 + col));
        *(_Float16*)((u16*)(p.ws + WS_ZH) + (size_t)grow * D + n0 + col) = (_Float16)(ALPHA * xr + (1.f + modl[(size_t)bidx * 3072 + 2048 + n0 + col]) * sum); }
    asm volatile("s_waitcnt vmcnt(0)" ::: "memory");
    __syncthreads();
    if (wave == 0 && lane == 0) {
        __builtin_amdgcn_fence(__ATOMIC_RELEASE, "agent"); asm volatile("s_waitcnt vmcnt(0)" ::: "memory");
        (void)__hip_atomic_fetch_add((unsigned*)(p.ws + WS_CTL) + CW_SCNT + 64 * (l * 8 + rbk0), 1u, __ATOMIC_RELAXED, __HIP_MEMORY_SCOPE_AGENT); }
}
DI void outproj_sample_finish(const Params& p, int l, int unit, int lane, int wave) {
    if (wave != 0) return;
    unsigned* cnt = (unsigned*)(p.ws + WS_CTL) + CW_SCNT + 64 * (l * 8 + (unit >> 5));
    for (unsigned sp = 0; sp < (1u << 20); ++sp) { if (__hip_atomic_load(cnt, __ATOMIC_RELAXED, __HIP_MEMORY_SCOPE_AGENT) >= 32u) break; __builtin_amdgcn_s_sleep(2); }
    __builtin_amdgcn_fence(__ATOMIC_ACQUIRE, "agent"); asm volatile("s_waitcnt vmcnt(0)" ::: "memory");
    sample_ln_rows<2>(p, l, MP + 64 * (unit >> 5) + 2 * (unit & 31), lane);
}

constexpr int N_PHASES = 3 + 3 * DEPTH;
typedef const __attribute__((address_space(4))) Params* KParams;
#define PHASE_BEGIN() const int lane_ = lane_id(); const int lane = lane_, wave = wave_s, tid = wave_s * 64 + lane_; \
    KParams kq = kp; asm volatile("" : "+s"(kq)); Params p; { const ParamsHead hh_ = *(const __attribute__((address_space(4))) ParamsHead*)kq; __builtin_memcpy(&p, &hh_, sizeof(ParamsHead)); }     const int gw = vcu * NWAVES + wave, NGW = G * NWAVES; (void)lane; (void)gw; (void)NGW
#define MIXPTRS() MixPtrs X; X.PA = (const u16*)(p.ws + WS_PA); X.PSZC = (const u16*)(p.ws + WS_PSZC); X.PPV = (const u16*)(p.ws + WS_PPV); X.PSZP = (const u16*)(p.ws + WS_PSZP); \
    X.PQ = (const u16*)(p.ws + WS_PQ); X.PSZA = (const u16*)(p.ws + WS_PSZA); X.PK = (const u16*)(p.ws + WS_PK); X.PV = (const u16*)(p.ws + WS_PV); X.MIX = (u16*)(p.ws + WS_MIX)
__global__ void __launch_bounds__(NTHR, 2) hymba_fwd(Params p_unused) {
#if defined(__HIP_DEVICE_COMPILE__)
    extern __shared__ __attribute__((aligned(16))) unsigned char lds_raw[];
    LAS unsigned char* lds = (LAS unsigned char*)lds_raw;
    volatile LAS unsigned* MISC = (volatile LAS unsigned*)(lds + MISC_OFF);
    const KParams kp = (KParams)__builtin_amdgcn_kernarg_segment_ptr();
    const int G = gridDim.x, bx = blockIdx.x, vcu = (G % 8 == 0) ? (bx % 8) * (G / 8) + bx / 8 : bx;
    const int wave_s = __builtin_amdgcn_readfirstlane((int)threadIdx.x >> 6);
    for (int u = threadIdx.x; u < (LDS_BYTES - RING_BYTES) / 4; u += NTHR) ((LAS unsigned*)(lds + RING_BYTES))[u] = 0u;
    __syncthreads();
    unsigned* ctl = (unsigned*)(kp->ws + WS_CTL);
    XcdBarrier bar; bar.bar = ctl + CW_BAR; bar.x = 0; bar.st = nullptr;
    if (MK_N_LAUNCHES == 1) bar = xcd_barrier_post(ctl + CW_BAR, MISC + 8);
    const int lo = kp->ph_lo, hi = kp->ph_hi;
#ifndef ONLY
#define ONLY -1
#endif
#ifndef ONLYMASK
#define ONLYMASK 0x3f
#endif
#define EN(t) ((ONLY < 0 || ONLY == (t)) && ((ONLYMASK >> (t)) & 1))
#define IN(k) (lo <= (k) && (k) < hi)
#define SEAM(k) do { if (MK_N_LAUNCHES == 1 && IN((k) + 1)) xcd_barrier(bar, wave_s); } while (0)
    if (EN(0) && IN(0)) { { PHASE_BEGIN(); p0_prologue(p, (const __attribute__((address_space(4))) float*)((const __attribute__((address_space(4))) char*)kq + __builtin_offsetof(Params, inv_freq)), lds, vcu, G, tid, lane, wave); } SEAM(0); }
    if (EN(1) && IN(1)) { { PHASE_BEGIN(); for (int u = vcu; u < DEPTH * 40; u += G) modv_unit(p, lds, u, tid, lane, wave); pre_phase(p, gw, NGW, lane); } SEAM(1); }
#pragma unroll 1
    for (int l = 0; l < DEPTH; ++l) {
        const int ph = 2 + 3 * l;
        if (EN(2) && IN(ph)) {
            { PHASE_BEGIN();
            pg8::Gemm g{(const u16*)(p.ws + WS_H), (const u16*)(p.ws + WS_WIN) + (size_t)l * DIN * D, M, DIN, D};
            pg8::StaticOrder S; S.init(M, DIN, G, bx);
            LAS float* rcl = (LAS float*)(lds + RING_BYTES + 1024);
            for (int i = 0; i < 3; ++i) { pg8::Unit u; if (S.next(i, u) && u.pm < MP / 256) finalize_rc_in(p, l, u.pm, rcl + i * 1024, tid); }
            asm volatile("s_waitcnt lgkmcnt(0)" ::: "memory"); __syncthreads();
            EpiIn E{l, p.ws, p.out, rcl};
            pg8::gemm_phase<EpiIn, true>(lds, g, S, E, tid); }
            SEAM(ph);
        }
        if (EN(3) && IN(ph + 1)) {
            { PHASE_BEGIN(); for (int e = tid; e < 4 * 64 * 64; e += NTHR) { const int g = e >> 12, c = (e >> 6) & 63, n = e & 63;
                  *(LAS _Float16*)(lds + MX_WPT + ((g * 64 + n) * 72 + c) * 2) = (_Float16)p.pool_w[(size_t)l * 16384 + e]; } }
            { PHASE_BEGIN(); MIXPTRS(); for (int u = vcu; u < 256; u += G) attn_prompt_unit(p, X, l, u, lds, tid, lane, wave); }
            { PHASE_BEGIN(); MIXPTRS(); for (int u = vcu; u < 256; u += G) conv_prompt_unit(p, X, l, u, lds, tid, lane, wave); }
            { PHASE_BEGIN(); for (int u = vcu; u < 256; u += G) { task_pool(p, l, u * 64, wave >> 2, wave & 3, lds, wave, lane); __syncthreads(); } }
            { PHASE_BEGIN(); MIXPTRS(); for (int u = vcu; u < 256; u += G) attn_sample_unit(p, X, l, u, lds, tid, lane, wave); }
            { PHASE_BEGIN(); MIXPTRS(); for (int u = vcu; u < 2 * DB; u += G) convpool_sample_unit(p, X, l, u >> 1, u & 1, lds, tid, lane, wave); }
            SEAM(ph + 1); }
        if (EN(4) && IN(ph + 2)) {
            { PHASE_BEGIN();
            pg8::Gemm g{(const u16*)(p.ws + WS_MIX), (const u16*)(p.ws + WS_WOUT) + (size_t)l * D * D, M, D, D};
            for (int u = vcu; u < 256; u += G) outproj_sample_unit(p, l, u, lds, tid, lane, wave);
            __syncthreads();
            pg8::StaticOrder S; S.init(MP, D, G, bx);
            EpiOutF E{p.ws, l, p.ln_g, p.ln_b};
            pg8::gemm_phase<EpiOutF, false>(lds, g, S, E, tid);
            for (int u = vcu; u < 256; u += G) outproj_sample_finish(p, l, u, lane, wave); }
            SEAM(ph + 2);
        }
    }
    if (EN(5) && IN(N_PHASES - 1)) { PHASE_BEGIN(); fin_phase(p, gw, NGW, lane); }
#undef IN
#undef SEAM
#endif
}


#ifdef DBG
constexpr int DBG_NS = 56;
constexpr size_t WS_DBGACC = 32 * 1024;
constexpr size_t WS_DBGZ = WS_END;
__constant__ int dbg_rows_tab[DBG_NS] = {0, 1, 2, 3, 14, 15, 16, 29, 30, 31, 32, 63, 64, 65, 127, 128, 129, 255, 256, 1000, 2047, 2048, 3967, 3968, 4065, 4066, 4080, 4081, 4094, 4095, 4096, 4097, 4127, 4224,
                            8191, 8192, 8320, 12288, 12415, 16382, 16383, 16384, 16385, 16386, 16387, 16388, 16391, 16639, 16640, 16892, 16893, 16894, 16895, 5000, 9999, 15000};
__device__ int dbg_row(int i) { return dbg_rows_tab[i]; }
__device__ void dbg_acc(float* accf, int id, float e, float r) {
    __shared__ float se[256], sr[256];
    const int t = threadIdx.x; se[t] = e; sr[t] = r; __syncthreads();
    for (int o = 128; o > 0; o >>= 1) { if (t < o) { se[t] += se[t + o]; sr[t] += sr[t + o]; } __syncthreads(); }
    if (t == 0) { atomicAdd(accf + 2 * id, se[0]); atomicAdd(accf + 2 * id + 1, sr[0]); }
    __syncthreads();
}
__device__ float dbg_h(const u16* p, size_t i) { return (float)(*(const _Float16*)(p + i)); }
__device__ float dbg_block_sum(float v) { __shared__ float sb[256]; const int t = threadIdx.x; sb[t] = v; __syncthreads(); for (int o = 128; o > 0; o >>= 1) { if (t < o) sb[t] += sb[t + o]; __syncthreads(); } const float r = sb[0]; __syncthreads(); return r; }
__device__ void dbg_ln4(float (&x)[4], float& rstd) { const float mean = dbg_block_sum(x[0] + x[1] + x[2] + x[3]) / D; float q = 0; for (int i = 0; i < 4; ++i) { x[i] -= mean; q += x[i] * x[i]; } rstd = 1.f / sqrtf(dbg_block_sum(q) / D + LN_EPS); }
#define DBG_E(fast, ref) do { const float f_ = (fast), r_ = (ref); e += (f_ - r_) * (f_ - r_); rr += r_ * r_; } while (0)
__global__ void __launch_bounds__(256) dbg_p0(Params p) {
    float* accf = (float*)(p.ws + WS_DBGACC); const int t = threadIdx.x, bid = blockIdx.x;
    { float e = 0, rr = 0; const int ri = (bid >> 2) % 9;
        const int l = bid & 3, row = ri < 6 ? ri : (ri == 6 ? 67 : 123 + ri);
        const float* c = row < NB ? p.c_prompt + (size_t)row * D : p.c_sample + (size_t)(row - NB) * D;
        for (int n = t * 12 + (bid % 12); n < 3072; n += 256 * 12) { float a = p.b_mod[l * 3072 + n];
            for (int k = 0; k < D; ++k) { const float x = c[k]; a += x / (1.f + expf(-x)) * p.w_mod[((size_t)l * D + k) * 3072 + n]; }
            DBG_E(((const float*)(p.ws + WS_MOD))[((size_t)l * NMOD + row) * 3072 + n], a); }
        dbg_acc(accf, 0, e, rr); }
    { float e = 0, rr = 0;
        for (int i = 0; i < 64; ++i) { const int l = bid & 3, col = (bid * 37 + i * 41 + t * 10) % DIN, k = (t * 4 + i * 16 + bid) % D;
            DBG_E(dbg_h((const u16*)(p.ws + WS_WIN), ((size_t)l * DIN + perm_in(col)) * D + k), p.w_in[((size_t)l * D + k) * DIN + col]); }
        dbg_acc(accf, 1, e, rr); }
    { float e = 0, rr = 0;
        for (int i = 0; i < 64; ++i) { const int l = bid & 3, col = (bid * 37 + i * 41 + t * 4) % D, k = (t * 4 + i * 16 + bid) % D;
            DBG_E(dbg_h((const u16*)(p.ws + WS_WOUT), ((size_t)l * D + perm_out(col)) * D + k), p.w_out[((size_t)l * D + k) * D + col]); }
        dbg_acc(accf, 2, e, rr); }
    { float e = 0, rr = 0;
        for (int i = 0; i < 16; ++i) { const int pi = (bid * 113 + i * 257 + t * 16) % (SEQ + DS), f = (t + i) & 31; const int pos = pi < SEQ ? pi : PAST + pi - SEQ;
            const float ang = (float)pos * p.inv_freq[f]; const f32x2 cs = ((const f32x2*)(p.ws + WS_TAB))[pi * 32 + f];
            DBG_E(cs[0], cosf(ang)); DBG_E(cs[1], sinf(ang)); }
        dbg_acc(accf, 3, e, rr); }
}
__global__ void __launch_bounds__(256) dbg_p0b(Params p) {
    float* accf = (float*)(p.ws + WS_DBGACC); const int t = threadIdx.x, bid = blockIdx.x;
    { float e = 0, rr = 0;
        const int l = bid & 3, b = (bid >> 2) & 3; const float* md = (const float*)(p.ws + WS_MOD) + ((size_t)l * NMOD + b) * 3072;
        const int col = (t * 10 + (bid >> 4) * 3 + 1) % DIN; float v1 = 0, v2 = 0, v3 = 0, v4 = 0;
        for (int c = 0; c < D; ++c) { const float w = p.w_in[((size_t)l * D + c) * DIN + col], g = l > 0 ? p.ln_g[(l - 1) * D + c] : 1.f, bb = l > 0 ? p.ln_b[(l - 1) * D + c] : 0.f, s1 = 1.f + md[1024 + c];
            v1 += g * s1 * w; v2 += bb * s1 * w; v3 += s1 * w; v4 += md[c] * w; }
        const float* mv = (const float*)(p.ws + WS_MODV) + (size_t)(l * NB + b) * 4 * DIN + perm_in(col);
        DBG_E(mv[0], v1); DBG_E(mv[2 * DIN], v3); DBG_E(mv[3 * DIN], v4); if (l > 0) DBG_E(mv[DIN], v2); else e += mv[DIN] * mv[DIN];
        dbg_acc(accf, 69, e, rr); }
    if (bid < DBG_NS) { const int row = dbg_row(bid); const bool smp = row >= MP; const int bidx = smp ? NB + ((row - MP) >> 2) : (row >> 12);
        const float* md = (const float*)(p.ws + WS_MOD) + (size_t)bidx * 3072;
        float x[4]; for (int i = 0; i < 4; ++i) { const int c = t + 256 * i; x[i] = smp ? p.x_sample[(size_t)(row - MP) * D + c] : p.x_prompt[(size_t)row * D + c]; }
        float e = 0, rr = 0; for (int i = 0; i < 4; ++i) DBG_E(dbg_h((const u16*)(p.ws + (smp ? WS_XR : WS_ZH)), (size_t)row * D + t + 256 * i), x[i]); dbg_acc(accf, 70, e, rr);
        e = 0; rr = 0;
        if (!smp) { for (int i = 0; i < 4; ++i) { const int c = t + 256 * i; DBG_E(dbg_h((const u16*)(p.ws + WS_H), (size_t)row * D + c), x[i] * (1.f + md[1024 + c])); } }
        else { float rstd; dbg_ln4(x, rstd); for (int i = 0; i < 4; ++i) { const int c = t + 256 * i; DBG_E(dbg_h((const u16*)(p.ws + WS_H), (size_t)row * D + c), x[i] * rstd * (1.f + md[1024 + c]) + md[c]); } }
        dbg_acc(accf, 71, e, rr); }
}
__global__ void __launch_bounds__(256) dbg_copyz(Params p) { const int row = dbg_row(blockIdx.x);
    for (int c = threadIdx.x; c < D; c += 256) { ((u16*)(p.ws + WS_DBGZ))[blockIdx.x * D + c] = ((const u16*)(p.ws + WS_ZH))[(size_t)row * D + c]; ((u16*)(p.ws + WS_DBGZ))[(DBG_NS + blockIdx.x) * D + c] = ((const u16*)(p.ws + WS_XR))[(size_t)row * D + c]; } }
__global__ void __launch_bounds__(256) dbg_in(Params p, int l) {
    __shared__ float pr[DIN]; __shared__ float hh[D];
    float* accf = (float*)(p.ws + WS_DBGACC); const int t = threadIdx.x, row = dbg_row(blockIdx.x), base = 4 + 16 * l;
    const bool smp = row >= MP; const int b = smp ? (row - MP) >> 2 : row >> 12, tt = smp ? (row - MP) & 3 : row & (SEQ - 1), pos = smp ? PAST + tt : tt;
    const int bidx = smp ? NB + b : b; const float* md = (const float*)(p.ws + WS_MOD) + ((size_t)l * NMOD + bidx) * 3072;
    float e, rr;
    { float x[4]; float rstd;
        for (int i = 0; i < 4; ++i) x[i] = dbg_h((const u16*)(p.ws + (smp ? WS_XR : WS_ZH)), (size_t)row * D + t + 256 * i);
        if (!smp && l > 0) { dbg_ln4(x, rstd); for (int i = 0; i < 4; ++i) { const int c = t + 256 * i; x[i] = x[i] * rstd * p.ln_g[(l - 1) * D + c] + p.ln_b[(l - 1) * D + c]; } }
        dbg_ln4(x, rstd);
        for (int i = 0; i < 4; ++i) { const int c = t + 256 * i; hh[c] = x[i] * rstd * (1.f + md[1024 + c]) + md[c]; }
        __syncthreads();
        if (smp) { e = 0; rr = 0; for (int i = 0; i < 4; ++i) { const int c = t + 256 * i; DBG_E(dbg_h((const u16*)(p.ws + WS_H), (size_t)row * D + c), hh[c]); } dbg_acc(accf, base + 1, e, rr); } }
    for (int i = 0; i < 10; ++i) { const int col = t + 256 * i; float a = 0; for (int k = 0; k < D; ++k) a += hh[k] * p.w_in[((size_t)l * D + k) * DIN + col]; pr[col] = a; }
    __syncthreads();
    const float av = pr[t] / (1.f + expf(-pr[256 + t]));
    e = 0; rr = 0; DBG_E(dbg_h((const u16*)(p.ws + WS_PA), (size_t)row * 256 + t), av); dbg_acc(accf, base + 2, e, rr);
    e = 0; rr = 0; { const float z = pr[512 + t]; DBG_E(dbg_h((const u16*)(p.ws + WS_PSZC), (size_t)row * 256 + t), z / (1.f + expf(-z))); } dbg_acc(accf, base + 3, e, rr);
    e = 0; rr = 0; DBG_E(dbg_h((const u16*)(p.ws + WS_PPV), (size_t)row * 256 + t), pr[768 + t]); dbg_acc(accf, base + 4, e, rr);
    e = 0; rr = 0; { const float z = pr[1024 + t]; DBG_E(dbg_h((const u16*)(p.ws + WS_PSZP), (size_t)row * 256 + t), z / (1.f + expf(-z))); } dbg_acc(accf, base + 5, e, rr);
    e = 0; rr = 0;
    for (int i = 0; i < 2; ++i) { const int c = t + 256 * i, hd = c >> 6, d = c & 63, f = d & 31; const float ang = (float)pos * p.inv_freq[f], cs = cosf(ang), sn = sinf(ang);
        const float x = pr[1280 + c], xo = d < 32 ? -pr[1280 + hd * 64 + d + 32] : pr[1280 + hd * 64 + d - 32];
        DBG_E(dbg_h((const u16*)(p.ws + WS_PQ), (size_t)row * 512 + c), (x * cs + xo * sn) * QSCALE); }
    dbg_acc(accf, base + 6, e, rr);
    e = 0; rr = 0; float kref = 0.f, vref = 0.f;
    if (t < 128) { const int hd = t >> 6, d = t & 63, f = d & 31; const float ang = (float)pos * p.inv_freq[f], cs = cosf(ang), sn = sinf(ang);
        const float x = pr[1792 + t], xo = d < 32 ? -pr[1792 + hd * 64 + d + 32] : pr[1792 + hd * 64 + d - 32]; kref = x * cs + xo * sn;
        DBG_E(dbg_h((const u16*)(p.ws + WS_PK), (size_t)row * 128 + t), kref); }
    dbg_acc(accf, base + 7, e, rr);
    e = 0; rr = 0; if (t < 128) { vref = pr[1920 + t]; DBG_E(dbg_h((const u16*)(p.ws + WS_PV), (size_t)row * 128 + t), vref); } dbg_acc(accf, base + 8, e, rr);
    e = 0; rr = 0; for (int i = 0; i < 2; ++i) { const float z = pr[2048 + t + 256 * i]; DBG_E(dbg_h((const u16*)(p.ws + WS_PSZA), (size_t)row * 512 + t + 256 * i), z / (1.f + expf(-z))); } dbg_acc(accf, base + 9, e, rr);
    e = 0; rr = 0;
    if (smp) { DBG_E(p.out[OFF_CONVS + ((size_t)(l * DB + b) * 30 + 26 + tt) * 256 + t], av); DBG_E(p.out[OFF_POOLS + ((size_t)(l * DB + b) * 15 + 11 + tt) * 256 + t], pr[768 + t]);
        if (t < 128) { DBG_E(p.out[OFF_KS + ((size_t)(l * DB + b) * 128 + 124 + tt) * 128 + t], kref); DBG_E(p.out[OFF_VS + ((size_t)(l * DB + b) * 128 + 124 + tt) * 128 + t], vref); } }
    else { if (tt >= SEQ - 30) DBG_E(p.out[OFF_CONVP + ((size_t)(l * NB + b) * 30 + tt - (SEQ - 30)) * 256 + t], av);
        if (tt >= SEQ - 15) DBG_E(p.out[OFF_POOLP + ((size_t)(l * NB + b) * 15 + tt - (SEQ - 15)) * 256 + t], pr[768 + t]);
        if (tt >= SEQ - 128 && t < 128) { DBG_E(p.out[OFF_KP + ((size_t)(l * NB + b) * 128 + tt - (SEQ - 128)) * 128 + t], kref); DBG_E(p.out[OFF_VP + ((size_t)(l * NB + b) * 128 + tt - (SEQ - 128)) * 128 + t], vref); } }
    dbg_acc(accf, base + 10, e, rr);
}
__global__ void __launch_bounds__(256) dbg_mix(Params p, int l) {
    __shared__ float sh[1024]; __shared__ float sc[136];
    float* accf = (float*)(p.ws + WS_DBGACC); const int t = threadIdx.x, row = dbg_row(blockIdx.x), base = 4 + 16 * l;
    const bool smp = row >= MP; const int b = smp ? (row - MP) >> 2 : row >> 12, tt = smp ? (row - MP) & 3 : row & (SEQ - 1);
    const u16 *PA = (const u16*)(p.ws + WS_PA), *PSZC = (const u16*)(p.ws + WS_PSZC), *PPV = (const u16*)(p.ws + WS_PPV), *PSZP = (const u16*)(p.ws + WS_PSZP), *PQ = (const u16*)(p.ws + WS_PQ),
              *PSZA = (const u16*)(p.ws + WS_PSZA), *PK = (const u16*)(p.ws + WS_PK), *PV = (const u16*)(p.ws + WS_PV), *MIX = (const u16*)(p.ws + WS_MIX);
    float e, rr;
    {
        float a = p.conv_b[l * 256 + t];
        for (int j = 0; j < 31; ++j) { float x;
            if (!smp) { const int ts = tt - 30 + j; x = ts >= 0 ? dbg_h(PA, ((size_t)b * SEQ + ts) * 256 + t) : 0.f; }
            else { const int ri = tt + j; x = ri < 30 ? p.cache_conv[((size_t)(l * DB + b) * 30 + ri) * 256 + t] : dbg_h(PA, ((size_t)MP + 4 * b + ri - 30) * 256 + t); }
            a += p.conv_w[((size_t)l * 31 + j) * 256 + t] * x; }
        const float mean = dbg_block_sum(a) / 256.f; const float d = a - mean; const float rstd = 1.f / sqrtf(dbg_block_sum(d * d) / 256.f + LN_EPS);
        const float y = d * rstd * p.cnorm_g[l * 256 + t] + p.cnorm_b[l * 256 + t];
        e = 0; rr = 0; DBG_E(dbg_h(MIX, (size_t)row * D + t), y / (1.f + expf(-y)) * dbg_h(PSZC, (size_t)row * 256 + t)); dbg_acc(accf, base + 11, e, rr); }
    {
        const int w = 2 << (t >> 6); float s = 0;
        for (int i = 0; i < w; ++i) { float x;
            if (!smp) { const int ts = tt - i; x = ts >= 0 ? dbg_h(PPV, ((size_t)b * SEQ + ts) * 256 + t) : 0.f; }
            else { const int ri = 15 + tt - i; x = ri < 15 ? p.cache_pool[((size_t)(l * DB + b) * 15 + ri) * 256 + t] : dbg_h(PPV, ((size_t)MP + 4 * b + ri - 15) * 256 + t); }
            s += x; }
        const float cnt = smp ? (float)w : (float)(w < tt + 1 ? w : tt + 1);
        sh[t] = s / cnt - dbg_h(PPV, (size_t)row * 256 + t); __syncthreads();
        const int g = t >> 6, n = t & 63; float y = 0; for (int c = 0; c < 64; ++c) y += sh[64 * g + c] * p.pool_w[(((size_t)l * 4 + g) * 64 + c) * 64 + n];
        e = 0; rr = 0; DBG_E(dbg_h(MIX, (size_t)row * D + 256 + t), y * p.pool_scale[l * 256 + t] * dbg_h(PSZP, (size_t)row * 256 + t)); dbg_acc(accf, base + 12, e, rr); __syncthreads(); }
    {
        e = 0; rr = 0;
        for (int hd = 0; hd < 8; ++hd) { const int hk = hd >> 2; __syncthreads();
            if (t < 64) sh[t] = dbg_h(PQ, (size_t)row * 512 + hd * 64 + t); __syncthreads();
            const float sink2 = p.sinks[l * 8 + hd] * LOG2E;
            if (t < 128) { float s = -INFINITY;
                if (!smp) { const int ts = tt - 127 + t; if (ts >= 0) { s = 0; for (int d = 0; d < 64; ++d) s += sh[d] * dbg_h(PK, ((size_t)b * SEQ + ts) * 128 + hk * 64 + d); } }
                else { const int ci = tt + 1 + t;
                    s = 0; for (int d = 0; d < 64; ++d) s += sh[d] * (ci < 128 ? p.cache_k[(((size_t)(l * DB + b) * 128 + ci) * 2 + hk) * 64 + d] : dbg_h(PK, ((size_t)MP + 4 * b + ci - 128) * 128 + hk * 64 + d)); }
                sc[t] = s; }
            __syncthreads();
            float mx = sink2; for (int k = 0; k < 128; ++k) mx = fmaxf(mx, sc[k]);
            float den = exp2f(sink2 - mx); for (int k = 0; k < 128; ++k) den += exp2f(sc[k] - mx);
            if (t < 64) { float o = 0;
                for (int k = 0; k < 128; ++k) { const float pk = exp2f(sc[k] - mx) / den; if (pk == 0.f) continue; float v;
                    if (!smp) { const int ts = tt - 127 + k; v = dbg_h(PV, ((size_t)b * SEQ + ts) * 128 + hk * 64 + t); }
                    else { const int ci = tt + 1 + k; v = ci < 128 ? p.cache_v[(((size_t)(l * DB + b) * 128 + ci) * 2 + hk) * 64 + t] : dbg_h(PV, ((size_t)MP + 4 * b + ci - 128) * 128 + hk * 64 + t); }
                    o += pk * v; }
                DBG_E(dbg_h(MIX, (size_t)row * D + 512 + hd * 64 + t), o * dbg_h(PSZA, (size_t)row * 512 + hd * 64 + t)); } }
        dbg_acc(accf, base + 13, e, rr); }
    if (smp) { e = 0; rr = 0;
        for (int i = 0; i < 26; ++i) DBG_E(p.out[OFF_CONVS + ((size_t)(l * DB + b) * 30 + i) * 256 + t], p.cache_conv[((size_t)(l * DB + b) * 30 + i + 4) * 256 + t]);
        for (int i = 0; i < 11; ++i) DBG_E(p.out[OFF_POOLS + ((size_t)(l * DB + b) * 15 + i) * 256 + t], p.cache_pool[((size_t)(l * DB + b) * 15 + i + 4) * 256 + t]);
        for (int i = 0; i < 124; ++i) if (t < 128) { DBG_E(p.out[OFF_KS + ((size_t)(l * DB + b) * 128 + i) * 128 + t], p.cache_k[((size_t)(l * DB + b) * 128 + i + 4) * 128 + t]);
            DBG_E(p.out[OFF_VS + ((size_t)(l * DB + b) * 128 + i) * 128 + t], p.cache_v[((size_t)(l * DB + b) * 128 + i + 4) * 128 + t]); }
        dbg_acc(accf, base + 15, e, rr); }
}
__global__ void __launch_bounds__(256) dbg_out(Params p, int l) {
    __shared__ float mm[D];
    float* accf = (float*)(p.ws + WS_DBGACC); const int t = threadIdx.x, row = dbg_row(blockIdx.x), base = 4 + 16 * l;
    const bool smp = row >= MP; const int bidx = smp ? NB + ((row - MP) >> 2) : (row >> 12);
    for (int c = t; c < D; c += 256) mm[c] = dbg_h((const u16*)(p.ws + WS_MIX), (size_t)row * D + c);
    __syncthreads();
    const float* md = (const float*)(p.ws + WS_MOD) + ((size_t)l * NMOD + bidx) * 3072 + 2048;
    const float* mdn = (const float*)(p.ws + WS_MOD) + ((size_t)(l + 1) * NMOD + bidx) * 3072;
    float x1[4], z[4], rstd;
    for (int i = 0; i < 4; ++i) x1[i] = dbg_h((const u16*)(p.ws + WS_DBGZ), (size_t)((smp ? DBG_NS : 0) + blockIdx.x) * D + t + 256 * i);
    if (!smp && l > 0) { dbg_ln4(x1, rstd); for (int i = 0; i < 4; ++i) { const int c = t + 256 * i; x1[i] = x1[i] * rstd * p.ln_g[(l - 1) * D + c] + p.ln_b[(l - 1) * D + c]; } }
    float e = 0, rr = 0;
    for (int i = 0; i < 4; ++i) { const int c = t + 256 * i; float a = 0; for (int k = 0; k < D; ++k) a += mm[k] * p.w_out[((size_t)l * D + k) * D + c];
        z[i] = ALPHA * x1[i] + (1.f + md[c]) * a; DBG_E(dbg_h((const u16*)(p.ws + WS_ZH), (size_t)row * D + c), z[i]); }
    dbg_acc(accf, base + 14, e, rr);
    e = 0; rr = 0;
    if (!smp) { if (l < DEPTH - 1) for (int i = 0; i < 4; ++i) { const int c = t + 256 * i; DBG_E(dbg_h((const u16*)(p.ws + WS_H), (size_t)row * D + c), z[i] * p.ln_g[l * D + c] * (1.f + mdn[1024 + c])); } }
    else { dbg_ln4(z, rstd); for (int i = 0; i < 4; ++i) { const int c = t + 256 * i; z[i] = z[i] * rstd * p.ln_g[l * D + c] + p.ln_b[l * D + c]; }
        if (l == DEPTH - 1) { for (int i = 0; i < 4; ++i) DBG_E(p.out[OFF_YS + (size_t)(row - MP) * D + t + 256 * i], z[i]); }
        else { for (int i = 0; i < 4; ++i) DBG_E(dbg_h((const u16*)(p.ws + WS_XR), (size_t)row * D + t + 256 * i), z[i]);
            dbg_ln4(z, rstd); for (int i = 0; i < 4; ++i) { const int c = t + 256 * i; DBG_E(dbg_h((const u16*)(p.ws + WS_H), (size_t)row * D + c), z[i] * rstd * (1.f + mdn[1024 + c]) + mdn[c]); } } }
    dbg_acc(accf, base + 0, e, rr);
    if (l == 0) { dbg_acc(accf, 100, smp ? 0.f : e, smp ? 0.f : rr); dbg_acc(accf, 101, smp ? e : 0.f, smp ? rr : 0.f); }
}
__global__ void __launch_bounds__(256) dbg_fin(Params p) {
    float* accf = (float*)(p.ws + WS_DBGACC); const int t = threadIdx.x, row = dbg_row(blockIdx.x);
    if (row >= MP) return;
    float x[4]; for (int i = 0; i < 4; ++i) x[i] = dbg_h((const u16*)(p.ws + WS_ZH), (size_t)row * D + t + 256 * i);
    float rstd; dbg_ln4(x, rstd); float e = 0, rr = 0;
    for (int i = 0; i < 4; ++i) { const int c = t + 256 * i; DBG_E(p.out[(size_t)row * D + c], x[i] * rstd * p.ln_g[3 * D + c] + p.ln_b[3 * D + c]); }
    dbg_acc(accf, 68, e, rr);
}
#ifndef DBG_REPORT_ID
#define DBG_REPORT_ID -1
#endif
__global__ void __launch_bounds__(256) dbg_report(Params p) {
    const float* accf = (const float*)(p.ws + WS_DBGACC);
    float code = 1000.f;
    if (DBG_REPORT_ID >= 0) { const float e = accf[2 * DBG_REPORT_ID], r = accf[2 * DBG_REPORT_ID + 1]; code = (r > 0.f ? e / r : 9.9f) * 1e12f; if (!(code > 100.f)) code = 100.f; }
    else for (int i = 0; i < 128; ++i) { const float e = accf[2 * i], r = accf[2 * i + 1]; const bool expected = i <= 71 && !(i >= 4 && i < 68 && ((i - 4) & 15) == 0 && (i - 4) / 16 == 99);
        if ((r > 0.f && !(e / r < 1e-3f)) || (r == 0.f && (e > 0.f || expected)) || e != e || r != r) { code = (float)(i + 1) * 1e4f; break; } }
    const float S = sqrtf(code);
    for (size_t i = (size_t)blockIdx.x * 256 + threadIdx.x; i < (size_t)MP * D; i += (size_t)gridDim.x * 256) p.out[i] = S;
}
#endif

extern "C" void kernel_launch(void* const* d_in, const int* in_sizes, int n_in, void* d_out, int out_size, void* d_ws, size_t ws_size, hipStream_t stream) {
    static int grid = 0;
    if (grid == 0) {
        if (n_in != 21 || (size_t)out_size != OUT_TOTAL || ws_size < WS_END) { fprintf(stderr, "kernel_launch: unexpected shapes (n_in %d, out %d, ws %zu)\n", n_in, out_size, ws_size); grid = -1; return; }
        int dev = 0, cus = 0;
        if (hipGetDevice(&dev) != hipSuccess || hipDeviceGetAttribute(&cus, hipDeviceAttributeMultiprocessorCount, dev) != hipSuccess) { grid = -1; return; }
        if (hipFuncSetAttribute((const void*)hymba_fwd, hipFuncAttributeMaxDynamicSharedMemorySize, LDS_BYTES) != hipSuccess) { fprintf(stderr, "kernel_launch: hipFuncSetAttribute failed\n"); grid = -1; return; }
        (void)hipGetLastError();
        grid = cus;
    }
    if (grid < 0) return;
    (void)hipMemsetAsync((char*)d_ws + WS_CTL, 0, CTL_ZERO_BYTES, stream);
    Params a{};
    a.x_prompt = (const float*)d_in[0]; a.x_sample = (const float*)d_in[1]; a.cache_conv = (const float*)d_in[2]; a.cache_pool = (const float*)d_in[3];
    a.cache_k = (const float*)d_in[4]; a.cache_v = (const float*)d_in[5]; a.c_prompt = (const float*)d_in[6]; a.c_sample = (const float*)d_in[7];
    a.w_in = (const float*)d_in[8]; a.w_out = (const float*)d_in[9]; a.conv_w = (const float*)d_in[10]; a.conv_b = (const float*)d_in[11];
    a.cnorm_g = (const float*)d_in[12]; a.cnorm_b = (const float*)d_in[13]; a.pool_w = (const float*)d_in[14]; a.pool_scale = (const float*)d_in[15];
    a.sinks = (const float*)d_in[16]; a.w_mod = (const float*)d_in[17]; a.b_mod = (const float*)d_in[18]; a.ln_g = (const float*)d_in[19]; a.ln_b = (const float*)d_in[20];
    a.out = (float*)d_out; a.ws = (unsigned char*)d_ws;
    for (int i = 0; i < 32; ++i) a.inv_freq[i] = (float)std::pow(10000.0, -(double)i * (2.0 / 64.0));
    if (MK_N_LAUNCHES == 1) { a.ph_lo = 0; a.ph_hi = N_PHASES; hipLaunchKernelGGL(hymba_fwd, dim3(grid), dim3(NTHR), LDS_BYTES, stream, a); }
    else for (int ph = 0; ph < N_PHASES; ++ph) {
#ifdef DBG
        if (ph >= 2 && ph < N_PHASES - 1 && (ph - 2) % 3 == 2) hipLaunchKernelGGL(dbg_copyz, dim3(DBG_NS), dim3(256), 0, stream, a);
#endif
        a.ph_lo = ph; a.ph_hi = ph + 1; hipLaunchKernelGGL(hymba_fwd, dim3(grid), dim3(NTHR), LDS_BYTES, stream, a);
#ifdef DBG
        if (ph == 0) hipLaunchKernelGGL(dbg_p0, dim3(144), dim3(256), 0, stream, a);
        else if (ph == 1) hipLaunchKernelGGL(dbg_p0b, dim3(144), dim3(256), 0, stream, a);
        else if (ph == N_PHASES - 1) { hipLaunchKernelGGL(dbg_fin, dim3(DBG_NS), dim3(256), 0, stream, a); hipLaunchKernelGGL(dbg_report, dim3(1024), dim3(256), 0, stream, a); }
        else { const int l = (ph - 2) / 3, k = (ph - 2) % 3;
            if (k == 0) hipLaunchKernelGGL(dbg_in, dim3(DBG_NS), dim3(256), 0, stream, a, l);
            if (k == 1) hipLaunchKernelGGL(dbg_mix, dim3(DBG_NS), dim3(256), 0, stream, a, l);
            if (k == 2) hipLaunchKernelGGL(dbg_out, dim3(DBG_NS), dim3(256), 0, stream, a, l); }
#endif
    }
}
```

```cpp
#include <hip/hip_runtime.h>
#include <cstdint>
#include <cstdio>
#include <cmath>

#define DBG_REPORT_ID -1
#ifndef MK_N_LAUNCHES
#define MK_N_LAUNCHES 1
#endif

#define DI __device__ __forceinline__
#define GAS __attribute__((address_space(1)))
#define LAS __attribute__((address_space(3)))
typedef unsigned short u16;
typedef _Float16 h8 __attribute__((ext_vector_type(8)));
typedef _Float16 h4 __attribute__((ext_vector_type(4)));
typedef _Float16 h2 __attribute__((ext_vector_type(2)));
typedef float f32x2 __attribute__((ext_vector_type(2)));
typedef float f32x4 __attribute__((ext_vector_type(4)));
typedef float f32x16 __attribute__((ext_vector_type(16)));
typedef unsigned u32x4 __attribute__((ext_vector_type(4)));
typedef unsigned u32x2 __attribute__((ext_vector_type(2)));
typedef short v4i16_t __attribute__((ext_vector_type(4)));

constexpr int D = 1024, DIN = 2560, NB = 4, SEQ = 4096, DEPTH = 4, DB = 128, DS = 4;
constexpr int MP = NB * SEQ, MS = DB * DS, M = MP + MS;
constexpr int NMOD = NB + DB;
constexpr int PAST = 8192;
constexpr float LN_EPS = 1e-5f;
constexpr float ALPHA = 1.681792830507429f;
constexpr float LOG2E = 1.4426950408889634f;
constexpr float QSCALE = 0.125f * LOG2E;
constexpr size_t OFF_YP = 0, OFF_YS = OFF_YP + (size_t)MP * D, OFF_CONVP = OFF_YS + (size_t)MS * D, OFF_POOLP = OFF_CONVP + (size_t)DEPTH * NB * 30 * 256,
                 OFF_KP = OFF_POOLP + (size_t)DEPTH * NB * 15 * 256, OFF_VP = OFF_KP + (size_t)DEPTH * NB * 128 * 128, OFF_CONVS = OFF_VP + (size_t)DEPTH * NB * 128 * 128,
                 OFF_POOLS = OFF_CONVS + (size_t)DEPTH * DB * 30 * 256, OFF_KS = OFF_POOLS + (size_t)DEPTH * DB * 15 * 256, OFF_VS = OFF_KS + (size_t)DEPTH * DB * 128 * 128,
                 OUT_TOTAL = OFF_VS + (size_t)DEPTH * DB * 128 * 128;
constexpr size_t MiB = 1u << 20;
constexpr size_t WS_CTL = 0, CTL_ZERO_BYTES = 64 * 1024;
constexpr size_t WS_WIN = 1 * MiB;
constexpr size_t WS_WOUT = 21 * MiB;
constexpr size_t WS_MOD = 29 * MiB;
constexpr size_t WS_TAB = 36 * MiB;
constexpr size_t WS_ZH = 38 * MiB;
constexpr size_t WS_XR = 71 * MiB;
constexpr size_t WS_MIX = 104 * MiB;
constexpr size_t WS_PA = 137 * MiB;
constexpr size_t WS_PSZC = WS_PA + (size_t)M * 256 * 2, WS_PPV = WS_PSZC + (size_t)M * 256 * 2, WS_PSZP = WS_PPV + (size_t)M * 256 * 2;
constexpr size_t WS_PQ = WS_PSZP + (size_t)M * 256 * 2;
constexpr size_t WS_PSZA = WS_PQ + (size_t)M * 512 * 2;
constexpr size_t WS_PK = WS_PSZA + (size_t)M * 512 * 2;
constexpr size_t WS_PV = WS_PK + (size_t)M * 128 * 2;
constexpr size_t WS_H = WS_PV + (size_t)M * 128 * 2;
constexpr size_t WS_PS = WS_H + (size_t)M * D * 2;
constexpr size_t WS_RC0 = WS_PS + 2 * (size_t)MP * 24 * 4;
constexpr size_t WS_MODV = WS_RC0 + (size_t)MP * 16;
constexpr size_t WS_LNC = WS_MODV + (size_t)DEPTH * NB * 4 * DIN * 4;
constexpr size_t WS_VT = WS_LNC + 256;
constexpr size_t WS_END = WS_VT + (size_t)NB * 2 * 64 * SEQ * 2;
static_assert(WS_END <= 256 * MiB, "d_ws map");
constexpr int CW_BAR = 1024;
constexpr int CW_SCNT = 12288;

DI unsigned pkh(float a, float b) { f32x2 v = {a, b}; h2 r = __builtin_convertvector(v, h2); return __builtin_bit_cast(unsigned, r); }
DI u32x4 pack8(const float* v) { u32x4 w; w.x = pkh(v[0], v[1]); w.y = pkh(v[2], v[3]); w.z = pkh(v[4], v[5]); w.w = pkh(v[6], v[7]); return w; }
DI void unpack8(u32x4 w, float* o) {
    const h8 v = __builtin_bit_cast(h8, w);
#pragma unroll
    for (int j = 0; j < 8; ++j) o[j] = (float)v[j];
}
DI float ex2(float x) { return __builtin_amdgcn_exp2f(x); }
DI float sigm(float x) { return __builtin_amdgcn_rcpf(1.f + ex2(-x * LOG2E)); }
DI float silu(float x) { return x * sigm(x); }
template <int O> DI float xor_lane(float v) {
    return __builtin_bit_cast(float, __builtin_amdgcn_ds_swizzle(__builtin_bit_cast(int, v), (O << 10) | 0x1f));
}
DI float sum_halves(float v) { float a = v, b = v; asm volatile("s_nop 1\n\tv_permlane32_swap_b32 %0, %1" : "+v"(a), "+v"(b)); return a + b; }
DI float max_halves(float v) { float a = v, b = v; asm volatile("s_nop 1\n\tv_permlane32_swap_b32 %0, %1" : "+v"(a), "+v"(b)); return fmaxf(a, b); }
DI float wave_sum(float v) { v += xor_lane<1>(v); v += xor_lane<2>(v); v += xor_lane<4>(v); v += xor_lane<8>(v); v += xor_lane<16>(v); return sum_halves(v); }
DI float wave_max(float v) { v = fmaxf(v, xor_lane<1>(v)); v = fmaxf(v, xor_lane<2>(v)); v = fmaxf(v, xor_lane<4>(v)); v = fmaxf(v, xor_lane<8>(v)); v = fmaxf(v, xor_lane<16>(v)); return max_halves(v); }
DI int lane_id() { int l_; asm volatile("v_mbcnt_lo_u32_b32 %0, -1, 0\n\tv_mbcnt_hi_u32_b32 %0, -1, %0" : "=v"(l_)); return l_; }
DI int crow(int r, int hi) { return (r & 3) + 8 * (r >> 2) + 4 * hi; }

__host__ __device__ __forceinline__ int pperm(int bj, int c7) { return 128 * bj + 32 * (c7 >> 5) + 16 * ((c7 >> 2) & 1) + 4 * ((c7 >> 3) & 3) + (c7 & 3); }
__host__ __device__ __forceinline__ int perm_in(int col) {
    if (col < 512) { const int bj = col >> 8, ch = col & 255; return 256 * (ch >> 7) + pperm(bj, ch & 127); }
    if (col < 1280) { const int base = col < 768 ? 512 : (col < 1024 ? 768 : 1024); const int x = col - base; return base + pperm(x >> 7, x & 127); }
    if (col < 1792) { const int x = col - 1280, head = x >> 6, d = x & 63; return 256 * (5 + (head >> 2)) + pperm(d >> 5, 32 * (head & 3) + (d & 31)); }
    if (col < 2048) { const int x = col - 1792, hh = x >> 6, d = x & 63; return 1792 + pperm(d >> 5, 32 * hh + (d & 31)); }
    { const int x = col - 2048; return 2048 + 256 * (x >> 8) + pperm((x >> 7) & 1, x & 127); }
}
__host__ __device__ __forceinline__ int perm_out(int col) { const int y = col & 255; return (col & ~255) + pperm(y >> 7, y & 127); }

namespace pg8 {
constexpr int BM = 256, BK = 64, HALF = 128, HTB = HALF * BK * 2, STAGE_BYTES = 8 * HTB, NXCD = 8, WGM = 8;
__host__ __device__ __forceinline__ int lds_byte(int r, int c) { const int st = (r >> 4) * 2 + (c >> 5), rr = r & 15, cc = c & 31, ob = rr * 64 + cc * 2; return st * 1024 + (ob ^ (((ob >> 9) & 1) << 5)); }
__host__ __device__ __forceinline__ void stage_rc(int b, int& R, int& C) { const int st = b / 1024, sb = b % 1024, swz = sb ^ (((sb >> 9) & 1) << 5); R = (st >> 1) * 16 + swz / 64; C = (st & 1) * 32 + (swz % 64) / 2; }
struct Unit { int pm, pn; };
struct Gemm { const u16* A; const u16* Bt; int M, N, K; };
struct StaticOrder {
    int nM, nN, nwg, G, c;
    __host__ __device__ void init(int M_, int N_, int G_, int c_) { nM = M_ / BM; nN = N_ / BM; nwg = nM * nN; G = G_; c = c_; }
    __host__ __device__ bool next(int i, Unit& u) const {
        const long L = (long)i * G + c; if (L >= nwg) return false;
        int wgid = (int)L; { const int q = nwg / NXCD, r = nwg % NXCD, xcd = wgid % NXCD, off = wgid / NXCD; wgid = (xcd < r ? xcd * (q + 1) : r * (q + 1) + (xcd - r) * q) + off; }
        const int nig = WGM * nN, gid = wgid / nig, fm = gid * WGM, gsz = (nM - fm) < WGM ? (nM - fm) : WGM;
        u.pm = fm + ((wgid % nig) % gsz); u.pn = (wgid % nig) / gsz; return true;
    }
};

template <class Epi, bool ALIGN_EPI>
DI void gemm_phase(LAS unsigned char* lds, const Gemm g, const StaticOrder& S, const Epi& E, const int tid) {
    const int wid = __builtin_amdgcn_readfirstlane(tid >> 6), lane = tid & 63, wr = wid >> 2, wc = wid & 3, fr = lane & 15, fq = lane >> 4;
    const int K = g.K, nt = K / BK;
    unsigned voffA[2];
#pragma unroll
    for (int i = 0; i < 2; ++i) { int R, C; stage_rc(tid * 16 + i * 8192, R, C); voffA[i] = (unsigned)(R * K + C) * 2u; }
    const size_t kstep = (size_t)(BK * 2);
    const size_t hstep = (size_t)HALF * K * 2;
    const size_t tstep = 2 * hstep;
    const unsigned ldsw = (unsigned)wid * 1024u;
    const int aoff = lds_byte(wr * 64 + fr, fq * 8), boff = lds_byte(wc * 32 + fr, fq * 8);
#define PG8_SA(b, h) (((b) * 2 + (h)) * HTB)
#define PG8_SB(b, h) ((4 + (b) * 2 + (h)) * HTB)
#define PG8_STAGE(bufoff, gbase) do { _Pragma("unroll") for (int _i = 0; _i < 2; ++_i) \
        __builtin_amdgcn_global_load_lds((const unsigned*)((const char*)(gbase) + voffA[_i]), (LAS unsigned*)(lds + (bufoff) + ldsw + _i * 8192), 16, 0, 0); } while (0)
#define PG8_LDA(dst, b, h) do { _Pragma("unroll") for (int m = 0; m < 4; ++m) _Pragma("unroll") for (int k = 0; k < 2; ++k) dst[m][k] = *(const LAS h8*)(lds + PG8_SA(b, h) + aoff + m * 2048 + k * 1024); } while (0)
#define PG8_LDB(dst, b, h) do { _Pragma("unroll") for (int n = 0; n < 2; ++n) _Pragma("unroll") for (int k = 0; k < 2; ++k) dst[n][k] = *(const LAS h8*)(lds + PG8_SB(b, h) + boff + n * 2048 + k * 1024); } while (0)
#define PG8_MMA(ai, bj, At, Bt) do { __builtin_amdgcn_s_setprio(1); _Pragma("unroll") for (int m = 0; m < 4; ++m) _Pragma("unroll") for (int n = 0; n < 2; ++n) _Pragma("unroll") for (int k = 0; k < 2; ++k) \
        acc[ai][bj][m][n] = __builtin_amdgcn_mfma_f32_16x16x32_f16(Bt[n][k], At[m][k], acc[ai][bj][m][n], 0, 0, 0); __builtin_amdgcn_s_setprio(0); } while (0)
#define PG8_WAIT_V(n) asm volatile("s_waitcnt vmcnt(" #n ")" ::: "memory")
#define PG8_WAIT_L(n) asm volatile("s_waitcnt lgkmcnt(" #n ")" ::: "memory")
#define PG8_BAR __builtin_amdgcn_s_barrier()
#define PG8_SCHED __builtin_amdgcn_sched_barrier(0)
    Unit cur, nxt; int ui = 0;
    if (!S.next(0, cur)) return;
    f32x4 acc[2][2][4][2];
#pragma unroll
    for (int a = 0; a < 2; ++a)
#pragma unroll
        for (int b = 0; b < 2; ++b)
#pragma unroll
            for (int m = 0; m < 4; ++m)
#pragma unroll
                for (int n = 0; n < 2; ++n) acc[a][b][m][n] = (f32x4){0.f, 0.f, 0.f, 0.f};
    h8 At[4][2], B0[2][2], B1[2][2];
    const char* cA = (const char*)g.A + (size_t)cur.pm * tstep; const char* cB = (const char*)g.Bt + (size_t)cur.pn * tstep;
    PG8_STAGE(PG8_SB(0, 0), cB); PG8_STAGE(PG8_SB(0, 1), cB + hstep); PG8_STAGE(PG8_SA(0, 0), cA); PG8_STAGE(PG8_SA(0, 1), cA + hstep);
    if (wr == 1) PG8_BAR;
    PG8_WAIT_V(2); PG8_BAR;
    PG8_STAGE(PG8_SB(1, 0), cB + kstep); PG8_STAGE(PG8_SA(1, 0), cA + kstep); PG8_STAGE(PG8_SB(1, 1), cB + hstep + kstep);
    PG8_WAIT_V(6); PG8_BAR;
    for (;;) {
        const bool has_next = S.next(ui + 1, nxt);
        const char* nA = has_next ? (const char*)g.A + (size_t)nxt.pm * tstep : cA; const char* nB = has_next ? (const char*)g.Bt + (size_t)nxt.pn * tstep : cB;
        for (int t = 0; t < nt; t += 2) {
            const bool last = (t == nt - 2);
            const char* a1 = cA + (size_t)(t + 1) * kstep;
            const char* a2 = last ? nA : cA + (size_t)(t + 2) * kstep; const char* b2 = last ? nB : cB + (size_t)(t + 2) * kstep;
            const char* a3 = a2 + kstep; const char* b3 = b2 + kstep;
            PG8_LDB(B0, 0, 0); PG8_LDB(B1, 0, 1); PG8_SCHED; PG8_LDA(At, 0, 0); PG8_STAGE(PG8_SA(1, 1), a1 + hstep);
            PG8_WAIT_V(8); PG8_WAIT_L(0); PG8_BAR; PG8_MMA(0, 0, At, B0); PG8_MMA(0, 1, At, B1); PG8_BAR; PG8_SCHED;
            PG8_LDA(At, 0, 1); PG8_STAGE(PG8_SB(0, 0), b2); PG8_STAGE(PG8_SB(0, 1), b2 + hstep); PG8_STAGE(PG8_SA(0, 0), a2);
            PG8_WAIT_V(8); PG8_WAIT_L(0); PG8_BAR; PG8_MMA(1, 0, At, B0); PG8_MMA(1, 1, At, B1); PG8_BAR; PG8_SCHED;
            PG8_LDB(B0, 1, 0); PG8_LDB(B1, 1, 1); PG8_SCHED; PG8_LDA(At, 1, 0); PG8_STAGE(PG8_SA(0, 1), a2 + hstep);
            PG8_WAIT_V(8); PG8_WAIT_L(0); PG8_BAR; PG8_MMA(0, 0, At, B0); PG8_MMA(0, 1, At, B1); PG8_BAR; PG8_SCHED;
            PG8_LDA(At, 1, 1); PG8_STAGE(PG8_SB(1, 0), b3); PG8_STAGE(PG8_SB(1, 1), b3 + hstep); PG8_STAGE(PG8_SA(1, 0), a3);
            PG8_WAIT_V(8); PG8_WAIT_L(0); PG8_BAR; PG8_MMA(1, 0, At, B0); PG8_MMA(1, 1, At, B1); PG8_BAR; PG8_SCHED;
        }
        if constexpr (ALIGN_EPI) { if (wr == 0) PG8_BAR; }
        if constexpr (!Epi::AFTER_DRAIN) E(acc, cur, ui, wr, wc, fr, fq);
        if (!has_next) break;
#pragma unroll
        for (int a = 0; a < 2; ++a)
#pragma unroll
            for (int b = 0; b < 2; ++b)
#pragma unroll
                for (int m = 0; m < 4; ++m)
#pragma unroll
                    for (int n = 0; n < 2; ++n) acc[a][b][m][n] = (f32x4){0.f, 0.f, 0.f, 0.f};
        cur = nxt; cA = nA; cB = nB; ++ui;
        if constexpr (ALIGN_EPI) { if (wr == 1) PG8_BAR; }
    }
    PG8_WAIT_V(0);
    if constexpr (!ALIGN_EPI) { if (wr == 0) PG8_BAR; }
    PG8_BAR;
    if constexpr (Epi::AFTER_DRAIN) E.fused(acc, cur, wr, wc, fr, fq, lds, tid);
#undef PG8_SA
#undef PG8_SB
#undef PG8_STAGE
#undef PG8_LDA
#undef PG8_LDB
#undef PG8_MMA
#undef PG8_WAIT_V
#undef PG8_WAIT_L
#undef PG8_BAR
#undef PG8_SCHED
}
}

struct Params {
    const float* x_prompt; const float* x_sample; const float* cache_conv; const float* cache_pool; const float* cache_k; const float* cache_v;
    const float* c_prompt; const float* c_sample; const float* w_in; const float* w_out; const float* conv_w; const float* conv_b; const float* cnorm_g; const float* cnorm_b;
    const float* pool_w; const float* pool_scale; const float* sinks; const float* w_mod; const float* b_mod; const float* ln_g; const float* ln_b;
    float* out; unsigned char* ws;
    int ph_lo, ph_hi;
    float inv_freq[32];
};
struct ParamsHead { const float* ptrs[21]; float* out; unsigned char* ws; int ph_lo, ph_hi; };
static_assert(sizeof(ParamsHead) == __builtin_offsetof(Params, inv_freq), "ParamsHead mirrors the head of Params");

DI void row_info(int row, bool& smp, int& b, int& t) { smp = row >= MP; if (!smp) { b = row >> 12; t = row & (SEQ - 1); } else { const int s = row - MP; b = s >> 2; t = s & 3; } }
DI void st8f(float* dst, const float* v) { *(f32x4*)dst = (f32x4){v[0], v[1], v[2], v[3]}; *(f32x4*)(dst + 4) = (f32x4){v[4], v[5], v[6], v[7]}; }

struct EpiIn {
    static constexpr bool AFTER_DRAIN = false;
    int l; unsigned char* ws; float* out; const LAS float* rcl;
    DI void operator()(f32x4 (&acc)[2][2][4][2], const pg8::Unit& u, int ui, int wr, int wc, int fr, int fq) const {
        asm volatile("" : "+v"(fr), "+v"(fq));
        const int pn = u.pn;
        if (u.pm < MP / 256) {
            const LAS f32x4* rc = (const LAS f32x4*)rcl + ui * 256 + wr * 64 + fr;
            const float* mv = (const float*)(ws + WS_MODV) + (size_t)(l * NB + (u.pm >> 4)) * 4 * DIN + pn * 256 + wc * 32 + 4 * fq;
#pragma unroll
            for (int bj = 0; bj < 2; ++bj)
#pragma unroll
                for (int n = 0; n < 2; ++n) { const float* mp = mv + 128 * bj + 16 * n;
                    const f32x4 v1 = *(const f32x4*)mp, v2 = *(const f32x4*)(mp + DIN), v3 = *(const f32x4*)(mp + 2 * DIN), v4 = *(const f32x4*)(mp + 3 * DIN);
#pragma unroll
                    for (int ai = 0; ai < 2; ++ai)
#pragma unroll
                        for (int m = 0; m < 4; ++m) { const f32x4 r = rc[ai * 128 + m * 16];
                            acc[ai][bj][m][n] = r[0] * acc[ai][bj][m][n] - r[1] * v1 + r[2] * v2 - r[3] * v3 + v4; } }
        }
        unsigned char* const W = ws; float* const O = out;
#define ST16(byteoff, vals) (*(u32x4*)(W + (size_t)(unsigned)(byteoff)) = pack8(vals))
#define STF8(fidx, vals) st8f(O + (size_t)(unsigned)(fidx), vals)
#pragma unroll
        for (int ai = 0; ai < 2; ++ai)
#pragma unroll
            for (int m = 0; m < 4; ++m) {
                const unsigned row = (unsigned)(u.pm * 256 + ai * 128 + wr * 64 + m * 16 + fr);
                const bool smp = row >= (unsigned)MP; const unsigned b = smp ? (row - MP) >> 2 : row >> 12, t = smp ? (row - MP) & 3u : row & (unsigned)(SEQ - 1);
                if (pn < 2) {
                    const unsigned c8 = pn * 128 + wc * 32 + fq * 8; float a[8];
#pragma unroll
                    for (int n = 0; n < 2; ++n)
#pragma unroll
                        for (int j = 0; j < 4; ++j) a[4 * n + j] = acc[ai][0][m][n][j] * sigm(acc[ai][1][m][n][j]);
                    ST16((unsigned)WS_PA + (row * 256 + c8) * 2, a);
                    if (smp) STF8((unsigned)OFF_CONVS + ((l * DB + b) * 30 + 26 + t) * 256 + c8, a);
                    else if (t >= SEQ - 30) STF8((unsigned)OFF_CONVP + ((l * NB + b) * 30 + (t - (SEQ - 30))) * 256 + c8, a);
                } else if (pn == 2 || pn == 4) {
                    const unsigned base = pn == 2 ? (unsigned)WS_PSZC : (unsigned)WS_PSZP;
#pragma unroll
                    for (int bj = 0; bj < 2; ++bj) { const unsigned c8 = bj * 128 + wc * 32 + fq * 8; float v[8];
#pragma unroll
                        for (int n = 0; n < 2; ++n)
#pragma unroll
                            for (int j = 0; j < 4; ++j) v[4 * n + j] = silu(acc[ai][bj][m][n][j]);
                        ST16(base + (row * 256 + c8) * 2, v); }
                } else if (pn == 3) {
#pragma unroll
                    for (int bj = 0; bj < 2; ++bj) { const unsigned c8 = bj * 128 + wc * 32 + fq * 8; float v[8];
#pragma unroll
                        for (int n = 0; n < 2; ++n)
#pragma unroll
                            for (int j = 0; j < 4; ++j) v[4 * n + j] = acc[ai][bj][m][n][j];
                        ST16((unsigned)WS_PPV + (row * 256 + c8) * 2, v);
                        if (smp) STF8((unsigned)OFF_POOLS + ((l * DB + b) * 15 + 11 + t) * 256 + c8, v);
                        else if (t >= SEQ - 15) STF8((unsigned)OFF_POOLP + ((l * NB + b) * 15 + (t - (SEQ - 15))) * 256 + c8, v); }
                } else if (pn >= 8) {
#pragma unroll
                    for (int bj = 0; bj < 2; ++bj) { const unsigned c8 = (pn - 8) * 256 + bj * 128 + wc * 32 + fq * 8; float v[8];
#pragma unroll
                        for (int n = 0; n < 2; ++n)
#pragma unroll
                            for (int j = 0; j < 4; ++j) v[4 * n + j] = silu(acc[ai][bj][m][n][j]);
                        ST16((unsigned)WS_PSZA + (row * 512 + c8) * 2, v); }
                } else if (pn == 7 && wc >= 2) {
                    const unsigned hv = wc - 2;
#pragma unroll
                    for (int bj = 0; bj < 2; ++bj) { const unsigned d8 = 32 * bj + 8 * fq; float v[8];
#pragma unroll
                        for (int n = 0; n < 2; ++n)
#pragma unroll
                            for (int j = 0; j < 4; ++j) v[4 * n + j] = acc[ai][bj][m][n][j];
                        ST16((unsigned)WS_PV + (row * 128 + hv * 64 + d8) * 2, v);
                        if (smp) STF8((unsigned)OFF_VS + (((l * DB + b) * 128 + 124 + t) * 2 + hv) * 64 + d8, v);
                        else if (t >= SEQ - 128) STF8((unsigned)OFF_VP + (((l * NB + b) * 128 + (t - (SEQ - 128))) * 2 + hv) * 64 + d8, v); }
                } else {
                    const unsigned d8 = 8 * fq; const unsigned pidx = smp ? SEQ + t : t;
                    const f32x4* tp = (const f32x4*)(W + (size_t)((unsigned)WS_TAB + (pidx * 32 + d8) * 8));
                    float x1[8], x2[8], o1[8], o2[8];
#pragma unroll
                    for (int n = 0; n < 2; ++n)
#pragma unroll
                        for (int j = 0; j < 4; ++j) { x1[4 * n + j] = acc[ai][0][m][n][j]; x2[4 * n + j] = acc[ai][1][m][n][j]; }
                    const float sc = pn == 7 ? 1.f : QSCALE;
#pragma unroll
                    for (int k2 = 0; k2 < 4; ++k2) { const f32x4 cs = tp[k2];
                        o1[2 * k2] = (x1[2 * k2] * cs[0] - x2[2 * k2] * cs[1]) * sc;         o2[2 * k2] = (x2[2 * k2] * cs[0] + x1[2 * k2] * cs[1]) * sc;
                        o1[2 * k2 + 1] = (x1[2 * k2 + 1] * cs[2] - x2[2 * k2 + 1] * cs[3]) * sc; o2[2 * k2 + 1] = (x2[2 * k2 + 1] * cs[2] + x1[2 * k2 + 1] * cs[3]) * sc; }
                    if (pn == 7) { const unsigned hk = wc;
                        ST16((unsigned)WS_PK + (row * 128 + hk * 64 + d8) * 2, o1); ST16((unsigned)WS_PK + (row * 128 + hk * 64 + 32 + d8) * 2, o2);
                        if (smp) { const unsigned di = (unsigned)OFF_KS + (((l * DB + b) * 128 + 124 + t) * 2 + hk) * 64 + d8; STF8(di, o1); STF8(di + 32, o2); }
                        else if (t >= SEQ - 128) { const unsigned di = (unsigned)OFF_KP + (((l * NB + b) * 128 + (t - (SEQ - 128))) * 2 + hk) * 64 + d8; STF8(di, o1); STF8(di + 32, o2); }
                    } else { const unsigned head = (pn - 5) * 4 + wc;
                        ST16((unsigned)WS_PQ + (row * 512 + head * 64 + d8) * 2, o1); ST16((unsigned)WS_PQ + (row * 512 + head * 64 + 32 + d8) * 2, o2); }
                }
            }
#undef ST16
#undef STF8
    }
};

struct EpiOutF {
    static constexpr bool AFTER_DRAIN = true;
    unsigned char* ws; int l; const float* ln_g; const float* ln_b;
    DI void operator()(f32x4 (&)[2][2][4][2], const pg8::Unit&, int, int, int, int, int) const {}
    DI void fused(f32x4 (&acc)[2][2][4][2], const pg8::Unit& u, int wr, int wc, int fr, int fq, LAS unsigned char* lds, int tid) const {
        LAS float* CV = (LAS float*)lds;
        LAS float* RS = (LAS float*)(lds + 8192);
        LAS float* PW = (LAS float*)(lds + 12288);
        u16* ZH = (u16*)(ws + WS_ZH); u16* ZP = (u16*)(ws + WS_H);
        const float* MOD = (const float*)(ws + WS_MOD); const int b = u.pm >> 4;
        const float* PSp = (const float*)(ws + WS_PS) + (size_t)((l + 1) & 1) * MP * 24; float* PSc = (float*)(ws + WS_PS) + (size_t)(l & 1) * MP * 24;
        if (tid < 256) { const int col = u.pn * 256 + tid;
            CV[tid] = l > 0 ? ln_g[(l - 1) * D + col] : 1.f; CV[256 + tid] = l > 0 ? ln_b[(l - 1) * D + col] : 0.f;
            CV[512 + tid] = MOD[((size_t)l * NMOD + b) * 3072 + 2048 + col]; CV[768 + tid] = ln_g[l * D + col]; CV[1024 + tid] = ln_b[l * D + col];
            CV[1280 + tid] = l < DEPTH - 1 ? MOD[((size_t)(l + 1) * NMOD + b) * 3072 + 1024 + col] : 0.f;
        } else { const int row = tid - 256; float mu = 0.f, rstd = 1.f;
            if (l > 0) { const float* ps = PSp + (size_t)(u.pm * 256 + row) * 24; const float s1 = (ps[0] + ps[6]) + (ps[12] + ps[18]), s2 = (ps[1] + ps[7]) + (ps[13] + ps[19]);
                mu = s1 * (1.f / D); rstd = 1.f / sqrtf(s2 * (1.f / D) - mu * mu + LN_EPS); }
            RS[2 * row] = mu; RS[2 * row + 1] = rstd; }
        __syncthreads();
#pragma unroll
        for (int ai = 0; ai < 2; ++ai) {
        u32x4 zpv[4][2];
#pragma unroll
        for (int mm = 0; mm < 4; ++mm)
#pragma unroll
            for (int bj = 0; bj < 2; ++bj) zpv[mm][bj] = *(const u32x4*)(ZH + ((size_t)u.pm * 256 + ai * 128 + wr * 64 + mm * 16 + fr) * D + u.pn * 256 + bj * 128 + wc * 32 + fq * 8);
#pragma unroll
        for (int mm = 0; mm < 4; ++mm) { const int m = mm;
            const int rt = ai * 128 + wr * 64 + m * 16 + fr; const size_t row = (size_t)u.pm * 256 + rt;
            const float mu = RS[2 * rt], rstd = RS[2 * rt + 1];
            float s1 = 0.f, s2 = 0.f, s3 = 0.f, s4 = 0.f, s5 = 0.f, s6 = 0.f;
#pragma unroll
            for (int bj = 0; bj < 2; ++bj) { const int cl = bj * 128 + wc * 32 + fq * 8; const size_t off = row * D + u.pn * 256 + cl;
                float zp[8], zq[8], zo[8]; unpack8(zpv[mm][bj], zp);
#pragma unroll
                for (int hh = 0; hh < 2; ++hh) {
                    const f32x4 gp = *(const LAS f32x4*)(CV + cl + 4 * hh), bp = *(const LAS f32x4*)(CV + 256 + cl + 4 * hh), gt = *(const LAS f32x4*)(CV + 512 + cl + 4 * hh),
                                gg = *(const LAS f32x4*)(CV + 768 + cl + 4 * hh), bb = *(const LAS f32x4*)(CV + 1024 + cl + 4 * hh), sn = *(const LAS f32x4*)(CV + 1280 + cl + 4 * hh);
                    const f32x4 av = acc[ai][bj][m][hh];
#pragma unroll
                    for (int j = 0; j < 4; ++j) { const int k = 4 * hh + j;
                        const float x1 = l > 0 ? (zp[k] - mu) * rstd * gp[j] + bp[j] : zp[k];
                        const float z = ALPHA * x1 + (1.f + gt[j]) * av[j], uu = z * gg[j];
                        s1 += z; s2 += z * z; s3 += uu; s4 += uu * uu; s5 += uu * gg[j]; s6 += uu * bb[j];
                        zq[k] = z; zo[k] = uu * (1.f + sn[j]); } }
                *(u32x4*)(ZH + off) = pack8(zq);
                if (l < DEPTH - 1) *(u32x4*)(ZP + off) = pack8(zo); }
            s1 = sum_halves(s1 + xor_lane<16>(s1)); s2 = sum_halves(s2 + xor_lane<16>(s2)); s3 = sum_halves(s3 + xor_lane<16>(s3)); s4 = sum_halves(s4 + xor_lane<16>(s4)); s5 = sum_halves(s5 + xor_lane<16>(s5)); s6 = sum_halves(s6 + xor_lane<16>(s6));
            if (fq == 0) { LAS float* pw = PW + (rt * 4 + wc) * 6; pw[0] = s1; pw[1] = s2; pw[2] = s3; pw[3] = s4; pw[4] = s5; pw[5] = s6; } }
        asm volatile("" ::: "memory"); }
        __syncthreads();
        if (tid < 256 && l < DEPTH - 1) { float* ps = PSc + (size_t)(u.pm * 256 + tid) * 24 + u.pn * 6; const LAS float* pw = PW + tid * 24;
#pragma unroll
            for (int k = 0; k < 6; ++k) ps[k] = (pw[k] + pw[6 + k]) + (pw[12 + k] + pw[18 + k]); }
    }
};

#define XB_TMO      128
#define XB_XCNT(j)  (256  + 64 * (j))
#define XB_XSUB(j)  (1280 + 64 * (j))
#define XB_XGEN(j)  (2304 + 64 * (j))
#define XB_TOP      3328
#define XB_TOPGEN   3392
#define XCD_BAR_WORDS 3456
#define XB_SPIN_CAP (1u << 18)
DI unsigned xb_ld(unsigned* p)              { return __hip_atomic_load(p, __ATOMIC_RELAXED, __HIP_MEMORY_SCOPE_AGENT); }
DI unsigned xb_add(unsigned* p, unsigned v) { return __hip_atomic_fetch_add(p, v, __ATOMIC_RELAXED, __HIP_MEMORY_SCOPE_AGENT); }
DI unsigned xb_xcc_id() { return (unsigned)__builtin_amdgcn_s_getreg((3 << 11) | 20) & 0xFu; }
#define XB_SPIN(cond, bar) do { unsigned _sp = 0; while (cond) { __builtin_amdgcn_s_sleep(1); \
    if ((++_sp & 255u) == 0u) { if (xb_ld(&(bar)[XB_TMO])) break; if (_sp > XB_SPIN_CAP) { atomicAdd(&(bar)[XB_TMO], 1u); break; } } } } while (0)
struct XcdBarrier { unsigned* bar; unsigned x; volatile LAS unsigned* st; };
DI XcdBarrier xcd_barrier_post(unsigned* bar, volatile LAS unsigned* st) {
    XcdBarrier b; b.bar = bar; b.x = xb_xcc_id(); b.st = st;
    if (threadIdx.x == 0) (void)xb_add(&bar[XB_XCNT(b.x)], 1u);
    return b;
}
DI void xcd_barrier_complete(unsigned* bar, unsigned x, unsigned& nloc, unsigned& nx) {
    const unsigned G = gridDim.x * gridDim.y * gridDim.z;
    unsigned sum, cnt, mine, sp = 0u;
    for (;;) {
        sum = 0u; cnt = 0u; mine = 0u;
#pragma unroll
        for (unsigned j = 0; j < 16; ++j) { const unsigned c = xb_ld(&bar[XB_XCNT(j)]); sum += c; cnt += (c > 0u) ? 1u : 0u; mine = (j == x) ? c : mine; }
        if (sum == G) break;
        __builtin_amdgcn_s_sleep(1);
        if ((++sp & 255u) == 0u) { if (xb_ld(&bar[XB_TMO])) break; if (sp > XB_SPIN_CAP) { atomicAdd(&bar[XB_TMO], 1u); break; } }
    }
    nloc = mine > 0u ? mine : 1u; nx = cnt > 0u ? cnt : 1u;
}
DI void xcd_barrier(const XcdBarrier& b, const int wave_s) {
    asm volatile("s_waitcnt vmcnt(0)" ::: "memory");
    __syncthreads();
    if (wave_s == 0 && lane_id() == 0) {
        unsigned* bar = b.bar;
        __builtin_amdgcn_s_waitcnt(0);
        unsigned nloc = b.st[0], nx = b.st[1];
        if (nloc == 0u) { xcd_barrier_complete(bar, b.x, nloc, nx); b.st[0] = nloc; b.st[1] = nx; }
        const unsigned old = xb_add(&bar[XB_XSUB(b.x)], 1u);
        const unsigned gen = old / nloc;
        if (old + 1u == (gen + 1u) * nloc) {
            __builtin_amdgcn_fence(__ATOMIC_RELEASE, "agent");
            asm volatile("s_waitcnt vmcnt(0)" ::: "memory");
            const unsigned og = xb_add(&bar[XB_TOP], 1u);
            const unsigned tg = og / nx;
            if (og + 1u == (tg + 1u) * nx) xb_add(&bar[XB_TOPGEN], 1u);
            else XB_SPIN(xb_ld(&bar[XB_TOPGEN]) == tg, bar);
            __builtin_amdgcn_fence(__ATOMIC_ACQUIRE, "agent");
            xb_add(&bar[XB_XGEN(b.x)], 1u);
            asm volatile("s_waitcnt vmcnt(0)" ::: "memory");
        } else {
            XB_SPIN(xb_ld(&bar[XB_XGEN(b.x)]) == gen, bar);
            __builtin_amdgcn_fence(__ATOMIC_ACQUIRE, "agent");
            asm volatile("s_waitcnt vmcnt(0)" ::: "memory");
        }
    }
    __syncthreads();
}

constexpr int NWAVES = 8, NTHR = 512;
constexpr int LDS_BYTES = 147456;
constexpr int RING_BYTES = 131072, MISC_OFF = RING_BYTES + 320;

DI void p0_transpose_item(const float* W, int K, int N, u16* WT, LAS float* scr, int item, int lane, bool isin) {
    const int nblk = N / 32, kb = item / nblk, nb = item % nblk, k0 = 64 * kb, n0 = 32 * nb;
#pragma unroll 8
    for (int i = 0; i < 32; ++i) { const int kk = 2 * i + (lane >> 5); scr[kk * 33 + (lane & 31)] = W[(size_t)(k0 + kk) * N + n0 + (lane & 31)]; }
    asm volatile("s_waitcnt lgkmcnt(0)" ::: "memory");
    const int c = lane & 7;
#pragma unroll
    for (int j = 0; j < 4; ++j) { const int n = (lane >> 3) + 8 * j; const LAS float* s = scr + (8 * c) * 33 + n;
        u32x4 o; o.x = pkh(s[0 * 33], s[1 * 33]); o.y = pkh(s[2 * 33], s[3 * 33]); o.z = pkh(s[4 * 33], s[5 * 33]); o.w = pkh(s[6 * 33], s[7 * 33]);
        const int dst = isin ? perm_in(n0 + n) : perm_out(n0 + n);
        *(u32x4*)(WT + (size_t)dst * K + k0 + 8 * c) = o; }
    asm volatile("s_waitcnt lgkmcnt(0)" ::: "memory");
}
DI void mod_unit(const Params& p, LAS unsigned char* lds, int unit, int tid, int lane, int wave) {
    const int l = unit >> 6, n0 = (unit & 63) * 48;
    const float* W = p.w_mod + (size_t)l * D * 3072;
    float* MOD = (float*)(p.ws + WS_MOD);
    const int fr = lane & 15, fq = lane >> 4;
    f32x4 acc[9][3];
#pragma unroll
    for (int rt = 0; rt < 9; ++rt)
#pragma unroll
        for (int ct = 0; ct < 3; ++ct) acc[rt][ct] = (f32x4){0.f, 0.f, 0.f, 0.f};
    for (int ks = 0; ks < 4; ++ks) {
        const int k0 = wave * 128 + ks * 32 + fq * 8;
        h8 bfr[3];
#pragma unroll
        for (int ct = 0; ct < 3; ++ct) { const float* wp = W + (size_t)k0 * 3072 + n0 + 16 * ct + fr;
#pragma unroll
            for (int j = 0; j < 8; ++j) bfr[ct][j] = (_Float16)wp[(size_t)j * 3072]; }
#pragma unroll
        for (int rt = 0; rt < 9; ++rt) { const int row = 16 * rt + fr; h8 a;
            if (row < NMOD) { const float* c = row < NB ? p.c_prompt + (size_t)row * D : p.c_sample + (size_t)(row - NB) * D;
                const f32x4 c0 = *(const f32x4*)(c + k0), c1 = *(const f32x4*)(c + k0 + 4);
#pragma unroll
                for (int j = 0; j < 4; ++j) { a[j] = (_Float16)silu(c0[j]); a[4 + j] = (_Float16)silu(c1[j]); } }
            else {
#pragma unroll
                for (int j = 0; j < 8; ++j) a[j] = (_Float16)0.f; }
#pragma unroll
            for (int ct = 0; ct < 3; ++ct) acc[rt][ct] = __builtin_amdgcn_mfma_f32_16x16x32_f16(a, bfr[ct], acc[rt][ct], 0, 0, 0); }
    }
    LAS float* part = (LAS float*)lds;
#pragma unroll
    for (int rg = 0; rg < 3; ++rg) {
        __syncthreads();
#pragma unroll
        for (int r3 = 0; r3 < 3; ++r3)
#pragma unroll
            for (int ct = 0; ct < 3; ++ct)
#pragma unroll
                for (int i = 0; i < 4; ++i) part[(wave * 48 + r3 * 16 + 4 * fq + i) * 48 + 16 * ct + fr] = acc[rg * 3 + r3][ct][i];
        __syncthreads();
        for (int o = tid; o < 48 * 48; o += NTHR) { const int r48 = o / 48, col = o % 48, row = 48 * rg + r48; float sacc = 0.f;
#pragma unroll
            for (int w = 0; w < 8; ++w) sacc += part[(w * 48 + r48) * 48 + col];
            if (row < NMOD) MOD[((size_t)l * NMOD + row) * 3072 + n0 + col] = sacc + p.b_mod[(size_t)l * 3072 + n0 + col]; }
    }
    __syncthreads();
}
DI void sincos_d(double a, float& c, float& s) {
    const double k = __builtin_rint(a * 0.63661977236758134308);
    const double r = __builtin_fma(-k, 1.2246467991473532e-16 * 0.5, __builtin_fma(-k, 1.5707963267948966, a));
    const double r2 = r * r;
    double sp = -1.0 / 6227020800.0; sp = sp * r2 + 1.0 / 39916800.0; sp = sp * r2 - 1.0 / 362880.0; sp = sp * r2 + 1.0 / 5040.0; sp = sp * r2 - 1.0 / 120.0; sp = sp * r2 + 1.0 / 6.0;
    const double sn = r - r * r2 * sp;
    double cp = 1.0 / 87178291200.0; cp = cp * r2 - 1.0 / 479001600.0; cp = cp * r2 + 1.0 / 3628800.0; cp = cp * r2 - 1.0 / 40320.0; cp = cp * r2 + 1.0 / 720.0; cp = cp * r2 - 1.0 / 24.0; cp = cp * r2 + 0.5;
    const double cn = 1.0 - r2 * cp;
    const long long q = (long long)k & 3;
    const double cc = (q == 0) ? cn : (q == 1) ? -sn : (q == 2) ? -cn : sn;
    const double ss = (q == 0) ? sn : (q == 1) ? cn : (q == 2) ? -sn : -cn;
    c = (float)cc; s = (float)ss;
}
DI void p0_prologue(const Params& p, const __attribute__((address_space(4))) float* invf, LAS unsigned char* lds, int vcu, int G, int tid, int lane, int wave) {
    for (int u = vcu; u < 256; u += G) mod_unit(p, lds, u, tid, lane, wave);
    LAS float* scr = (LAS float*)(lds + wave * 16384);
    const int gw = vcu * NWAVES + wave, NGW = G * NWAVES;
    constexpr int I_IN = (D / 64) * (DIN / 32), I_OUT = (D / 64) * (D / 32);
    for (int it = gw; it < DEPTH * (I_IN + I_OUT); it += NGW) {
        const int l = it / (I_IN + I_OUT), r = it % (I_IN + I_OUT);
        if (r < I_IN) p0_transpose_item(p.w_in + (size_t)l * D * DIN, D, DIN, (u16*)(p.ws + WS_WIN) + (size_t)l * DIN * D, scr, r, lane, true);
        else p0_transpose_item(p.w_out + (size_t)l * D * D, D, D, (u16*)(p.ws + WS_WOUT) + (size_t)l * D * D, scr, r - I_IN, lane, false);
    }
    if (vcu == 0 && wave < DEPTH) {
        float a = 0.f, b2 = 0.f, c2 = 0.f, d = 0.f, e = 0.f;
        for (int c = lane; c < D; c += 64) { const float g = p.ln_g[wave * D + c], bb = p.ln_b[wave * D + c]; a += g; b2 += g * g; c2 += g * bb; d += bb; e += bb * bb; }
        a = wave_sum(a); b2 = wave_sum(b2); c2 = wave_sum(c2); d = wave_sum(d); e = wave_sum(e);
        if (lane == 0) { float* o = (float*)(p.ws + WS_LNC) + wave * 8; o[0] = a; o[1] = b2; o[2] = c2; o[3] = d; o[4] = e; } }
    f32x2* tab = (f32x2*)(p.ws + WS_TAB);
    for (int e = vcu * NTHR + tid; e < (SEQ + DS) * 32; e += G * NTHR) {
        const int pi = e >> 5, i = e & 31; const int pos = pi < SEQ ? pi : PAST + (pi - SEQ);
        const float ang = (float)pos * invf[i];
        float c, s; sincos_d((double)ang, c, s);
        tab[e] = (f32x2){c, s};
    }
}

template <int R>
DI void ln_stats(float (&v)[R][16], float (&mean)[R], float (&rstd)[R]) {
    float s[R];
#pragma unroll
    for (int r = 0; r < R; ++r) { s[r] = 0.f;
#pragma unroll
        for (int k = 0; k < 16; ++k) s[r] += v[r][k]; }
#pragma unroll
    for (int r = 0; r < R; ++r) s[r] = wave_sum(s[r]);
#pragma unroll
    for (int r = 0; r < R; ++r) { mean[r] = s[r] * (1.f / D); s[r] = 0.f;
#pragma unroll
        for (int k = 0; k < 16; ++k) { v[r][k] -= mean[r]; s[r] += v[r][k] * v[r][k]; } }
#pragma unroll
    for (int r = 0; r < R; ++r) s[r] = wave_sum(s[r]);
#pragma unroll
    for (int r = 0; r < R; ++r) rstd[r] = 1.f / sqrtf(s[r] * (1.f / D) + LN_EPS);
}
constexpr int LNR = 3;
DI void pre_phase(const Params& p, int gw, int NGW, int lane) {
    const float* modl = (const float*)(p.ws + WS_MOD);
    u16* ZH = (u16*)(p.ws + WS_ZH); u16* XR = (u16*)(p.ws + WS_XR); u16* ZP = (u16*)(p.ws + WS_H); f32x4* RC0 = (f32x4*)(p.ws + WS_RC0);
    for (int row0 = gw; row0 < M; row0 += LNR * NGW) {
        float v[LNR][16]; bool ok[LNR]; float mean[LNR], rstd[LNR]; int rows[LNR];
#pragma unroll
        for (int r = 0; r < LNR; ++r) { rows[r] = row0 + r * NGW; ok[r] = rows[r] < M; if (!ok[r]) rows[r] = row0; }
#pragma unroll
        for (int r = 0; r < LNR; ++r) { const int row = rows[r]; const float* x = row < MP ? p.x_prompt + (size_t)row * D : p.x_sample + (size_t)(row - MP) * D;
#pragma unroll
            for (int j2 = 0; j2 < 2; ++j2) { const f32x4 a = *(const f32x4*)(x + 512 * j2 + 8 * lane), b = *(const f32x4*)(x + 512 * j2 + 8 * lane + 4);
#pragma unroll
                for (int k = 0; k < 4; ++k) { v[r][8 * j2 + k] = a[k]; v[r][8 * j2 + 4 + k] = b[k]; } } }
#pragma unroll
        for (int r = 0; r < LNR; ++r) if (ok[r]) { u16* dst = rows[r] < MP ? ZH : XR;
#pragma unroll
            for (int j2 = 0; j2 < 2; ++j2) *(u32x4*)(dst + (size_t)rows[r] * D + 512 * j2 + 8 * lane) = pack8(v[r] + 8 * j2); }
        ln_stats<LNR>(v, mean, rstd);
#pragma unroll
        for (int r = 0; r < LNR; ++r) if (ok[r]) { const int row = rows[r]; const bool smp = row >= MP; const int bidx = smp ? NB + ((row - MP) >> 2) : (row >> 12);
            const float* sh = modl + (size_t)bidx * 3072; const float* sc = sh + 1024;
            if (!smp && lane == 0) RC0[row] = (f32x4){rstd[r], 0.f, rstd[r], rstd[r] * mean[r]};
#pragma unroll
            for (int j2 = 0; j2 < 2; ++j2) { float o[8];
#pragma unroll
                for (int h = 0; h < 2; ++h) { const f32x4 a = *(const f32x4*)(sc + 512 * j2 + 8 * lane + 4 * h), bb = *(const f32x4*)(sh + 512 * j2 + 8 * lane + 4 * h);
#pragma unroll
                    for (int k = 0; k < 4; ++k) o[4 * h + k] = smp ? v[r][8 * j2 + 4 * h + k] * rstd[r] * (1.f + a[k]) + bb[k] : (v[r][8 * j2 + 4 * h + k] + mean[r]) * (1.f + a[k]); }
                *(u32x4*)(ZP + (size_t)row * D + 512 * j2 + 8 * lane) = pack8(o); } }
    }
}
DI void modv_unit(const Params& p, LAS unsigned char* lds, int unit, int tid, int lane, int wave) {
    const int l = unit / 40, cb = unit % 40, col = 64 * cb + lane;
    const float* W = p.w_in + (size_t)l * D * DIN + col; const float* modl = (const float*)(p.ws + WS_MOD) + (size_t)l * NMOD * 3072;
    LAS float* part = (LAS float*)lds;
    LAS float* cf = (LAS float*)(lds + 32768) + wave * 128 * 12;
    __syncthreads();
#pragma unroll
    for (int hlf = 0; hlf < 2; ++hlf) { const int ci = 64 * hlf + lane, c = wave * 128 + ci; LAS float* o = cf + ci * 12;
        o[0] = l > 0 ? p.ln_g[(l - 1) * D + c] : 1.f; o[1] = l > 0 ? p.ln_b[(l - 1) * D + c] : 0.f;
#pragma unroll
        for (int b = 0; b < 4; ++b) { o[2 + b] = 1.f + modl[b * 3072 + 1024 + c]; o[6 + b] = modl[b * 3072 + c]; } }
    asm volatile("s_waitcnt lgkmcnt(0)" ::: "memory");
    float acc[4][4];
#pragma unroll
    for (int b = 0; b < 4; ++b)
#pragma unroll
        for (int k = 0; k < 4; ++k) acc[b][k] = 0.f;
#pragma unroll 1
    for (int c0 = 0; c0 < 128; c0 += 32) { float wv[32];
#pragma unroll
        for (int i = 0; i < 32; ++i) wv[i] = W[(size_t)(wave * 128 + c0 + i) * DIN];
#pragma unroll
        for (int i = 0; i < 32; ++i) { const LAS f32x4* cp = (const LAS f32x4*)(cf + (c0 + i) * 12); const f32x4 q0 = cp[0], q1 = cp[1], q2 = cp[2];
            const float g = q0[0], bb = q0[1]; const float s1[4] = {q0[2], q0[3], q1[0], q1[1]}; const float sh[4] = {q1[2], q1[3], q2[0], q2[1]};
#pragma unroll
            for (int b = 0; b < 4; ++b) { const float sw = s1[b] * wv[i]; acc[b][0] += g * sw; acc[b][1] += bb * sw; acc[b][2] += sw; acc[b][3] += sh[b] * wv[i]; } } }
#pragma unroll
    for (int b = 0; b < 4; ++b)
#pragma unroll
        for (int k = 0; k < 4; ++k) part[(wave * 16 + b * 4 + k) * 64 + lane] = acc[b][k];
    __syncthreads();
    float* MODV = (float*)(p.ws + WS_MODV);
    for (int o = tid; o < 1024; o += NTHR) { const int idx = o >> 6, ln = o & 63; float sum = 0.f;
#pragma unroll
        for (int w = 0; w < 8; ++w) sum += part[(w * 16 + idx) * 64 + ln];
        MODV[((size_t)(l * NB + (idx >> 2)) * 4 + (idx & 3)) * DIN + perm_in(64 * cb + ln)] = sum; }
    __syncthreads();
}
DI void finalize_rc_in(const Params& p, int l, int pm, LAS float* dst, int tid) {
    if (tid < 256) { const size_t row = (size_t)pm * 256 + tid; f32x4 rc;
        if (l == 0) rc = ((const f32x4*)(p.ws + WS_RC0))[row];
        else { const float* ps = (const float*)(p.ws + WS_PS) + (size_t)((l - 1) & 1) * MP * 24 + row * 24; const float* lnc = (const float*)(p.ws + WS_LNC) + (l - 1) * 8;
            float S[6];
#pragma unroll
            for (int k = 0; k < 6; ++k) S[k] = (ps[k] + ps[6 + k]) + (ps[12 + k] + ps[18 + k]);
            float N1 = 1.f / D, two = 2.f; asm volatile("" : "+v"(N1), "+v"(two));
            const float mu = S[0] * N1, rstd = 1.f / sqrtf(S[1] * N1 - mu * mu + LN_EPS);
            const float m2 = (rstd * (S[2] - mu * lnc[0]) + lnc[3]) * N1;
            const float e2 = (rstd * rstd * (S[3] - two * mu * S[4] + mu * mu * lnc[1]) + two * rstd * (S[5] - mu * lnc[2]) + lnc[4]) * N1;
            const float rstd2 = 1.f / sqrtf(e2 - m2 * m2 + LN_EPS);
            rc = (f32x4){rstd * rstd2, rstd * rstd2 * mu, rstd2, rstd2 * m2}; }
        *(LAS f32x4*)(dst + 4 * tid) = rc; }
}
DI void fin_phase(const Params& p, int gw, int NGW, int lane) {
    const u16* ZH = (const u16*)(p.ws + WS_ZH);
    const float* lg = p.ln_g + (size_t)(DEPTH - 1) * D; const float* lb = p.ln_b + (size_t)(DEPTH - 1) * D;
    for (int row0 = gw; row0 < MP; row0 += LNR * NGW) {
        float v[LNR][16]; bool ok[LNR]; float mean[LNR], rstd[LNR]; int rows[LNR];
#pragma unroll
        for (int r = 0; r < LNR; ++r) { rows[r] = row0 + r * NGW; ok[r] = rows[r] < MP; if (!ok[r]) rows[r] = row0; }
#pragma unroll
        for (int r = 0; r < LNR; ++r)
#pragma unroll
            for (int j2 = 0; j2 < 2; ++j2) unpack8(*(const u32x4*)(ZH + (size_t)rows[r] * D + 512 * j2 + 8 * lane), v[r] + 8 * j2);
        ln_stats<LNR>(v, mean, rstd);
#pragma unroll
        for (int j2 = 0; j2 < 2; ++j2)
#pragma unroll
            for (int h = 0; h < 2; ++h) { const f32x4 g = *(const f32x4*)(lg + 512 * j2 + 8 * lane + 4 * h), bb = *(const f32x4*)(lb + 512 * j2 + 8 * lane + 4 * h);
#pragma unroll
                for (int r = 0; r < LNR; ++r) if (ok[r]) { f32x4 o;
#pragma unroll
                    for (int k = 0; k < 4; ++k) o[k] = v[r][8 * j2 + 4 * h + k] * rstd[r] * g[k] + bb[k];
                    *(f32x4*)(p.out + (size_t)rows[r] * D + 512 * j2 + 8 * lane + 4 * h) = o; } }
    }
}

struct MixPtrs { const u16 *PA, *PSZC, *PPV, *PSZP, *PQ, *PSZA, *PK, *PV; u16* MIX; };
DI v4i16_t ds_tr(const LAS unsigned char* a) { return __builtin_amdgcn_ds_read_tr16_b64_v4i16((LAS v4i16_t*)a); }

DI void attn_prompt_unit(const Params& p, const MixPtrs& X, int l, int unit, LAS unsigned char* lds, int tid, int lane, int wave) {
    const int xg = unit >> 5, b = xg >> 1, hk = (unit >> 4) & 1, nb = (xg & 1) * 16 + (unit & 15), q0 = nb * 128; const size_t rb = (size_t)b * SEQ;
    LAS unsigned char* Ks = lds; LAS unsigned char* Vs = lds + 36864;
    const int g = wave & 3, qh = wave >> 2, head = 4 * hk + g, r = lane & 31, h = lane >> 5;
    h8 qfA[4], qfB[4]; u32x2 zgA[2][4], zgB[2][4];
    { const size_t qr0 = rb + q0 + 64 * qh + r, qr1 = qr0 + 32;
#pragma unroll
      for (int s = 0; s < 4; ++s) { qfA[s] = *(const h8*)(X.PQ + qr0 * 512 + head * 64 + 16 * s + 8 * h); qfB[s] = *(const h8*)(X.PQ + qr1 * 512 + head * 64 + 16 * s + 8 * h); }
#pragma unroll
      for (int db = 0; db < 2; ++db)
#pragma unroll
          for (int xq = 0; xq < 4; ++xq) { const int col = head * 64 + 32 * db + 8 * xq + 4 * h; zgA[db][xq] = *(const u32x2*)(X.PSZA + qr0 * 512 + col); zgB[db][xq] = *(const u32x2*)(X.PSZA + qr1 * 512 + col); } }
#pragma unroll
    for (int i = 0; i < 4; ++i) { const int c = tid + 512 * i, key = c >> 3, ch = c & 7, tk = q0 - 128 + key;
        if (tk >= 0) { const u32x4 kv = *(const u32x4*)(X.PK + (rb + tk) * 128 + hk * 64 + ch * 8), vv = *(const u32x4*)(X.PV + (rb + tk) * 128 + hk * 64 + ch * 8);
            *(LAS u32x4*)(Ks + key * 144 + ch * 16) = kv; *(LAS u32x4*)(Vs + (ch >> 2) * 16384 + key * 64 + (ch & 3) * 16) = vv; } }
    __syncthreads();
    const float sink2 = p.sinks[l * 8 + head] * LOG2E;
    const int trq = (lane & 15) >> 2, trp = lane & 3, trg = (lane >> 4) & 1;
    const float NEG = -INFINITY;
    auto half = [&](const h8 (&qf)[4], const u32x2 (&zg)[2][4], const int e) {
        const int ql = 64 * qh + 32 * e; const size_t qrow = rb + q0 + ql + r;
        f32x16 S[5];
#pragma unroll
        for (int i = 0; i < 5; ++i) { const int kl = ql + 32 * i; const bool valid = (nb > 0) || (kl >= 128);
#pragma unroll
            for (int x = 0; x < 16; ++x) S[i][x] = 0.f;
            if (valid) {
#pragma unroll
                for (int s = 0; s < 4; ++s) { const h8 kf = *(const LAS h8*)(Ks + (kl + r) * 144 + (16 * s + 8 * h) * 2); S[i] = __builtin_amdgcn_mfma_f32_32x32x16_f16(kf, qf[s], S[i], 0, 0, 0); }
            } else {
#pragma unroll
                for (int x = 0; x < 16; ++x) S[i][x] = NEG; }
            if (i == 0) {
#pragma unroll
                for (int x = 0; x < 16; ++x) if (!(crow(x, h) > r)) S[i][x] = NEG; }
            if (i == 4) {
#pragma unroll
                for (int x = 0; x < 16; ++x) if (!(crow(x, h) <= r)) S[i][x] = NEG; }
        }
        float mx = sink2;
#pragma unroll
        for (int i = 0; i < 5; ++i)
#pragma unroll
            for (int x = 0; x < 16; ++x) mx = fmaxf(mx, S[i][x]);
        mx = max_halves(mx);
        float sum = 0.f;
#pragma unroll
        for (int i = 0; i < 5; ++i)
#pragma unroll
            for (int x = 0; x < 16; ++x) { S[i][x] = ex2(S[i][x] - mx); sum += S[i][x]; }
        sum = sum_halves(sum);
        const float inv = 1.f / (sum + ex2(sink2 - mx));
        f32x16 O[2];
#pragma unroll
        for (int x = 0; x < 16; ++x) { O[0][x] = 0.f; O[1][x] = 0.f; }
#pragma unroll
        for (int i = 0; i < 5; ++i) { const int kl = ql + 32 * i; const bool valid = (nb > 0) || (kl >= 128);
            if (valid) {
#pragma unroll
                for (int s2 = 0; s2 < 2; ++s2) { float pv8[8];
#pragma unroll
                    for (int j = 0; j < 8; ++j) pv8[j] = S[i][8 * s2 + j] * inv;
                    const h8 pa = __builtin_bit_cast(h8, pack8(pv8));
#pragma unroll
                    for (int db = 0; db < 2; ++db) { const LAS unsigned char* va = Vs + db * 16384 + (kl + 16 * s2 + 4 * h + trq) * 64 + trg * 32 + trp * 8;
                        const v4i16_t lo = ds_tr(va), hi = ds_tr(va + 512);
                        const h8 vf = __builtin_bit_cast(h8, __builtin_shufflevector(lo, hi, 0, 1, 2, 3, 4, 5, 6, 7));
                        O[db] = __builtin_amdgcn_mfma_f32_32x32x16_f16(vf, pa, O[db], 0, 0, 0); } } } }
#pragma unroll
        for (int db = 0; db < 2; ++db)
#pragma unroll
            for (int xq = 0; xq < 4; ++xq) { const int col = head * 64 + 32 * db + 8 * xq + 4 * h; const h4 z = __builtin_bit_cast(h4, zg[db][xq]);
                u32x2 w; w.x = pkh(O[db][4 * xq] * (float)z[0], O[db][4 * xq + 1] * (float)z[1]); w.y = pkh(O[db][4 * xq + 2] * (float)z[2], O[db][4 * xq + 3] * (float)z[3]);
                *(u32x2*)(X.MIX + qrow * D + 512 + col) = w; }
    };
    half(qfA, zgA, 0);
    half(qfB, zgB, 1);
    __syncthreads();
}

DI void conv_prompt_unit(const Params& p, const MixPtrs& X, int l, int unit, LAS unsigned char* lds, int tid, int lane, int wave) {
    const int R0 = unit * 64, b = R0 >> 12, t0 = R0 & (SEQ - 1); const size_t rb = (size_t)b * SEQ;
    LAS unsigned char* WL = lds + 94 * 512;
    for (int c = tid; c < 94 * 32; c += NTHR) { const int row = c >> 5, ch = c & 31, tk = t0 - 30 + row; u32x4 v = (u32x4){0u, 0u, 0u, 0u};
        if (tk >= 0) v = *(const u32x4*)(X.PA + (rb + tk) * 256 + ch * 8);
        *(LAS u32x4*)(lds + row * 512 + ch * 16) = v; }
    for (int c = tid; c < 31 * 64; c += NTHR) *(LAS f32x4*)(WL + c * 16) = *(const f32x4*)(p.conv_w + (size_t)l * 31 * 256 + 4 * c);
    const f32x4 bias = *(const f32x4*)(p.conv_b + l * 256 + 4 * lane), cg = *(const f32x4*)(p.cnorm_g + l * 256 + 4 * lane), cb = *(const f32x4*)(p.cnorm_b + l * 256 + 4 * lane);
    u32x2 zcv[8];
#pragma unroll
    for (int tt = 0; tt < 8; ++tt) zcv[tt] = *(const u32x2*)(X.PSZC + ((size_t)R0 + 8 * wave + tt) * 256 + 4 * lane);
    __syncthreads();
    f32x4 acc[8], win[8];
#pragma unroll
    for (int tt = 0; tt < 8; ++tt) acc[tt] = bias;
    const LAS unsigned char* arow = lds + (8 * wave) * 512 + lane * 8;
#pragma unroll
    for (int k = 0; k < 7; ++k) win[k] = __builtin_convertvector(*(const LAS h4*)(arow + k * 512), f32x4);
#pragma unroll 1
    for (int jb = 0; jb < 4; ++jb) {
#pragma unroll
        for (int jj = 0; jj < 8; ++jj) { const int j = 8 * jb + jj;
            if (j < 31) {
                win[(jj + 7) & 7] = __builtin_convertvector(*(const LAS h4*)(arow + (j + 7) * 512), f32x4);
                const f32x4 w = *(const LAS f32x4*)(WL + j * 1024 + lane * 16);
#pragma unroll
                for (int tt = 0; tt < 8; ++tt) acc[tt] += w * win[(jj + tt) & 7]; } } }
#pragma unroll
    for (int tt = 0; tt < 8; ++tt) { const size_t row = (size_t)R0 + 8 * wave + tt;
        const float mean = wave_sum((acc[tt][0] + acc[tt][1]) + (acc[tt][2] + acc[tt][3])) * (1.f / 256.f);
        const f32x4 d = acc[tt] - mean;
        const float rstd = 1.f / sqrtf(wave_sum((d[0] * d[0] + d[1] * d[1]) + (d[2] * d[2] + d[3] * d[3])) * (1.f / 256.f) + LN_EPS);
        const h4 zc = __builtin_bit_cast(h4, zcv[tt]); float o[4];
#pragma unroll
        for (int k = 0; k < 4; ++k) o[k] = silu(d[k] * rstd * cg[k] + cb[k]) * (float)zc[k];
        u32x2 w; w.x = pkh(o[0], o[1]); w.y = pkh(o[2], o[3]);
        *(u32x2*)(X.MIX + row * D + 4 * lane) = w; }
    __syncthreads();
}

DI void pool_prompt_unit(const Params& p, const MixPtrs& X, int l, int unit, LAS unsigned char* lds, int tid, int lane, int wave) {
    const int R0 = unit * 64, b = R0 >> 12, t0 = R0 & (SEQ - 1); const size_t rb = (size_t)b * SEQ;
    LAS unsigned char* PL = lds + 79 * 512;
    for (int c = tid; c < 79 * 32; c += NTHR) { const int row = c >> 5, ch = c & 31, tk = t0 - 15 + row; u32x4 v = (u32x4){0u, 0u, 0u, 0u};
        if (tk >= 0) v = *(const u32x4*)(X.PPV + (rb + tk) * 256 + ch * 8);
        *(LAS u32x4*)(lds + row * 512 + ch * 16) = v; }
    __syncthreads();
    { const int wlen = 2 << (lane >> 4);
        const LAS unsigned char* prow = lds + (8 * wave + 15) * 512 + lane * 8;
        f32x4 sm[8];
#pragma unroll
        for (int tt = 0; tt < 8; ++tt) sm[tt] = (f32x4){0.f, 0.f, 0.f, 0.f};
#pragma unroll 1
        for (int i = 0; i < 16; ++i) { if (i < wlen) {
#pragma unroll
            for (int tt = 0; tt < 8; ++tt) sm[tt] += __builtin_convertvector(*(const LAS h4*)(prow + (tt - i) * 512), f32x4); } }
#pragma unroll
        for (int tt = 0; tt < 8; ++tt) {
            const int t = t0 + 8 * wave + tt; const float cnt = (float)(wlen < t + 1 ? wlen : t + 1);
            const f32x4 cur = __builtin_convertvector(*(const LAS h4*)(prow + tt * 512), f32x4);
            const f32x4 pl = sm[tt] * (1.f / cnt) - cur;
            u32x2 w; w.x = pkh(pl[0], pl[1]); w.y = pkh(pl[2], pl[3]);
            *(LAS u32x2*)(PL + (8 * wave + tt) * 528 + lane * 8) = w; } }
    __syncthreads();
    { const int g = wave & 3, th = wave >> 2, r = lane & 31, h = lane >> 5;
        const float* pw = p.pool_w + ((size_t)l * 4 + g) * 64 * 64 + r;
        f32x16 Dd[2];
#pragma unroll
        for (int x = 0; x < 16; ++x) { Dd[0][x] = 0.f; Dd[1][x] = 0.f; }
#pragma unroll 1
        for (int s = 0; s < 4; ++s) { const h8 bf = *(const LAS h8*)(PL + (32 * th + r) * 528 + (64 * g + 16 * s + 8 * h) * 2);
#pragma unroll
            for (int nb = 0; nb < 2; ++nb) { h8 af;
#pragma unroll
                for (int j = 0; j < 8; ++j) af[j] = (_Float16)pw[(size_t)(16 * s + 8 * h + j) * 64 + 32 * nb];
                Dd[nb] = __builtin_amdgcn_mfma_f32_32x32x16_f16(af, bf, Dd[nb], 0, 0, 0); } }
        const size_t row = (size_t)R0 + 32 * th + r;
#pragma unroll
        for (int nb = 0; nb < 2; ++nb)
#pragma unroll
            for (int xq = 0; xq < 4; ++xq) { const int col = 64 * g + 32 * nb + 8 * xq + 4 * h;
                const f32x4 ps = *(const f32x4*)(p.pool_scale + l * 256 + col); const h4 z = *(const h4*)(X.PSZP + row * 256 + col);
                u32x2 w; w.x = pkh(Dd[nb][4 * xq] * ps[0] * (float)z[0], Dd[nb][4 * xq + 1] * ps[1] * (float)z[1]); w.y = pkh(Dd[nb][4 * xq + 2] * ps[2] * (float)z[2], Dd[nb][4 * xq + 3] * ps[3] * (float)z[3]);
                *(u32x2*)(X.MIX + row * D + 256 + col) = w; } }
    __syncthreads();
}


constexpr int MX_WCV = 0;
constexpr int MX_WPT = 81920;
constexpr int MX_SCR = 0, MX_SCR_W = 7168;
constexpr int MX_TQ = RING_BYTES + 640;
DI void mix_stage_weights(const Params& p, int l, LAS unsigned char* lds, int tid) {
    for (int c = tid; c < 31 * 64; c += NTHR) *(LAS f32x4*)(lds + MX_WCV + c * 16) = *(const f32x4*)(p.conv_w + (size_t)l * 31 * 256 + 4 * c);
    for (int e = tid; e < 4 * 64 * 64; e += NTHR) { const int g = e >> 12, c = (e >> 6) & 63, n = e & 63;
        *(LAS _Float16*)(lds + MX_WPT + ((g * 64 + n) * 72 + c) * 2) = (_Float16)p.pool_w[(size_t)l * 16384 + e]; }
    if (tid == 0) *(LAS unsigned*)(lds + MX_TQ) = 0u;
}
DI void task_attn(const Params& p, int l, int b, int hk, int g, int tq0, int lane) {
    const int head = 4 * hk + g, r = lane & 31, h = lane >> 5; const size_t rb = (size_t)b * SEQ; const size_t qrow = rb + tq0 + r;
    const float sink2 = p.sinks[l * 8 + head] * LOG2E; const float NEG = -INFINITY;
    const u16* PQ = (const u16*)(p.ws + WS_PQ); const u16* PK = (const u16*)(p.ws + WS_PK);
    f32x16 S[5];
    {   h8 qf[4];
#pragma unroll
        for (int s = 0; s < 4; ++s) qf[s] = *(const h8*)(PQ + qrow * 512 + head * 64 + 16 * s + 8 * h);
        h8 kf[5][4];
#pragma unroll
        for (int i = 0; i < 5; ++i) { const int tk = tq0 - 128 + 32 * i, tkc = tk < 0 ? 0 : tk;
#pragma unroll
            for (int s = 0; s < 4; ++s) kf[i][s] = *(const h8*)(PK + (rb + tkc + r) * 128 + hk * 64 + 16 * s + 8 * h); }
#pragma unroll
        for (int i = 0; i < 5; ++i) { const int tk = tq0 - 128 + 32 * i;
#pragma unroll
            for (int x = 0; x < 16; ++x) S[i][x] = 0.f;
#pragma unroll
            for (int s = 0; s < 4; ++s) S[i] = __builtin_amdgcn_mfma_f32_32x32x16_f16(kf[i][s], qf[s], S[i], 0, 0, 0);
#pragma unroll
            for (int x = 0; x < 16; ++x) S[i][x] = tk >= 0 ? S[i][x] : NEG; } }
#pragma unroll
    for (int x = 0; x < 16; ++x) { if (!(crow(x, h) > r)) S[0][x] = NEG; if (!(crow(x, h) <= r)) S[4][x] = NEG; }
    float mx = sink2;
#pragma unroll
    for (int i = 0; i < 5; ++i)
#pragma unroll
        for (int x = 0; x < 16; ++x) mx = fmaxf(mx, S[i][x]);
    mx = max_halves(mx);
    float sum = 0.f;
#pragma unroll
    for (int i = 0; i < 5; ++i)
#pragma unroll
        for (int x = 0; x < 16; ++x) { S[i][x] = ex2(S[i][x] - mx); sum += S[i][x]; }
    sum = sum_halves(sum);
    const float inv = 1.f / (sum + ex2(sink2 - mx));
    u32x4 pa[5][2];
#pragma unroll
    for (int i = 0; i < 5; ++i)
#pragma unroll
        for (int s2 = 0; s2 < 2; ++s2) { float pv8[8];
#pragma unroll
            for (int j = 0; j < 8; ++j) pv8[j] = S[i][8 * s2 + j] * inv;
            pa[i][s2] = pack8(pv8); }
    int voff = ((b * 2 + hk) * 64 + r) * SEQ + (tq0 - 128) + 4 * h;
    asm volatile("" : "+v"(voff) : "v"(pa[0][0]), "v"(pa[0][1]), "v"(pa[1][0]), "v"(pa[1][1]), "v"(pa[2][0]), "v"(pa[2][1]), "v"(pa[3][0]), "v"(pa[3][1]), "v"(pa[4][0]), "v"(pa[4][1]));
    const u16* vtb = (const u16*)(p.ws + WS_VT) + voff;
    u32x2 vlo[5][2][2], vhi[5][2][2];
#pragma unroll
    for (int i = 0; i < 5; ++i) { const int tk = tq0 - 128 + 32 * i; const int adj = tk < 0 ? -tk : 0;
#pragma unroll
        for (int s2 = 0; s2 < 2; ++s2)
#pragma unroll
            for (int db = 0; db < 2; ++db) { const u16* vp = vtb + (size_t)db * 32 * SEQ + 32 * i + 16 * s2 + adj; vlo[i][s2][db] = *(const u32x2*)vp; vhi[i][s2][db] = *(const u32x2*)(vp + 8); } }
    f32x16 O[2];
#pragma unroll
    for (int x = 0; x < 16; ++x) { O[0][x] = 0.f; O[1][x] = 0.f; }
#pragma unroll
    for (int i = 0; i < 5; ++i)
#pragma unroll
        for (int s2 = 0; s2 < 2; ++s2)
#pragma unroll
            for (int db = 0; db < 2; ++db) { const u32x4 vv = {vlo[i][s2][db][0], vlo[i][s2][db][1], vhi[i][s2][db][0], vhi[i][s2][db][1]};
                O[db] = __builtin_amdgcn_mfma_f32_32x32x16_f16(__builtin_bit_cast(h8, vv), __builtin_bit_cast(h8, pa[i][s2]), O[db], 0, 0, 0); }
    const u16* PSZA = (const u16*)(p.ws + WS_PSZA); u16* MIX = (u16*)(p.ws + WS_MIX);
    u32x2 zg[2][4];
#pragma unroll
    for (int db = 0; db < 2; ++db)
#pragma unroll
        for (int xq = 0; xq < 4; ++xq) zg[db][xq] = *(const u32x2*)(PSZA + qrow * 512 + head * 64 + 32 * db + 8 * xq + 4 * h);
#pragma unroll
    for (int db = 0; db < 2; ++db)
#pragma unroll
        for (int xq = 0; xq < 4; ++xq) { const int col = head * 64 + 32 * db + 8 * xq + 4 * h; const h4 z = __builtin_bit_cast(h4, zg[db][xq]);
            u32x2 w; w.x = pkh(O[db][4 * xq] * (float)z[0], O[db][4 * xq + 1] * (float)z[1]); w.y = pkh(O[db][4 * xq + 2] * (float)z[2], O[db][4 * xq + 3] * (float)z[3]);
            *(u32x2*)(MIX + qrow * D + 512 + col) = w; }
}
constexpr int MX_X = 68608;
DI void conv_tile_dma(const Params& p, int R0, LAS unsigned char* lds, int wave, int lane) {
    const int b = R0 >> 12, t0 = R0 & (SEQ - 1);
    const unsigned char* PA = p.ws + WS_PA;
#pragma unroll
    for (int i = 0; i < 6; ++i) { const int piece = wave + 8 * i;
        if (piece < 47) { const int row = 2 * piece + (lane >> 5); int tk = t0 - 30 + row; tk = tk < 0 ? 0 : tk;
            __builtin_amdgcn_global_load_lds((const unsigned*)(PA + ((size_t)b * SEQ + tk) * 512 + (lane & 31) * 16), (LAS unsigned*)(lds + MX_X + piece * 1024), 16, 0, 0); } }
}
DI void task_conv(const Params& p, int l, int R0, int sub, LAS unsigned char* lds, int lane) {
    const int t0 = (R0 & (SEQ - 1)) + 8 * sub; const size_t rowb = (size_t)R0 + 8 * sub;
    const f32x4 bias = *(const f32x4*)(p.conv_b + l * 256 + 4 * lane), cg = *(const f32x4*)(p.cnorm_g + l * 256 + 4 * lane), cb = *(const f32x4*)(p.cnorm_b + l * 256 + 4 * lane);
    const LAS unsigned char* arow = lds + MX_X + (8 * sub) * 512 + lane * 8;
    const LAS unsigned char* wl = lds + MX_WCV + lane * 16;
    f32x4 acc[8], win[8];
#pragma unroll
    for (int tt = 0; tt < 8; ++tt) acc[tt] = bias;
#pragma unroll
    for (int k = 0; k < 7; ++k) { const f32x4 v = __builtin_convertvector(*(const LAS h4*)(arow + k * 512), f32x4); win[k] = (t0 - 30 + k >= 0) ? v : (f32x4){0.f, 0.f, 0.f, 0.f}; }
#pragma unroll 1
    for (int jb = 0; jb < 4; ++jb) {
#pragma unroll
        for (int jj = 0; jj < 8; ++jj) { const int j = 8 * jb + jj;
            if (j < 31) {
                const f32x4 v = __builtin_convertvector(*(const LAS h4*)(arow + (j + 7) * 512), f32x4);
                win[(jj + 7) & 7] = (t0 - 30 + j + 7 >= 0) ? v : (f32x4){0.f, 0.f, 0.f, 0.f};
                const f32x4 w = *(const LAS f32x4*)(wl + j * 1024);
#pragma unroll
                for (int tt = 0; tt < 8; ++tt) acc[tt] += w * win[(jj + tt) & 7]; } } }
    const u16* PSZC = (const u16*)(p.ws + WS_PSZC); u16* MIX = (u16*)(p.ws + WS_MIX);
#pragma unroll
    for (int tt = 0; tt < 8; ++tt) { const size_t row = rowb + tt;
        const float mean = wave_sum((acc[tt][0] + acc[tt][1]) + (acc[tt][2] + acc[tt][3])) * (1.f / 256.f);
        const f32x4 d = acc[tt] - mean;
        const float rstd = 1.f / sqrtf(wave_sum((d[0] * d[0] + d[1] * d[1]) + (d[2] * d[2] + d[3] * d[3])) * (1.f / 256.f) + LN_EPS);
        const h4 z = *(const h4*)(PSZC + row * 256 + 4 * lane); float o[4];
#pragma unroll
        for (int k = 0; k < 4; ++k) o[k] = silu(d[k] * rstd * cg[k] + cb[k]) * (float)z[k];
        u32x2 w; w.x = pkh(o[0], o[1]); w.y = pkh(o[2], o[3]);
        *(u32x2*)(MIX + row * D + 4 * lane) = w; }
}
DI void task_pool(const Params& p, int l, int R0, int th, int g, LAS unsigned char* lds, int wave, int lane) {
    const u16* PPV = (const u16*)(p.ws + WS_PPV); const u16* PSZP = (const u16*)(p.ws + WS_PSZP); u16* MIX = (u16*)(p.ws + WS_MIX);
    const int b = R0 >> 12, T0 = (R0 & (SEQ - 1)) + 32 * th; const size_t rb = (size_t)b * SEQ;
    LAS unsigned char* scr = lds + MX_SCR + wave * MX_SCR_W;
    const int r = lane & 31, h = lane >> 5;
    u32x4 tl[6];
#pragma unroll
    for (int i = 0; i < 6; ++i) { const int row = (lane >> 3) + 8 * i, tk = T0 - 15 + row; const int tkc = tk < 0 ? 0 : (row < 47 ? tk : T0 + 31);
        const u32x4 v = *(const u32x4*)(PPV + (rb + tkc) * 256 + 64 * g + 8 * (lane & 7)); const unsigned msk = (unsigned)-(int)(tk >= 0); tl[i] = (u32x4){v[0] & msk, v[1] & msk, v[2] & msk, v[3] & msk}; }
    const size_t orow = rb + T0 + r;
    u32x2 zp[2][4]; f32x4 ps[2][4];
#pragma unroll
    for (int nb = 0; nb < 2; ++nb)
#pragma unroll
        for (int xq = 0; xq < 4; ++xq) { const int col = 64 * g + 32 * nb + 8 * xq + 4 * h; zp[nb][xq] = *(const u32x2*)(PSZP + orow * 256 + col); ps[nb][xq] = *(const f32x4*)(p.pool_scale + l * 256 + col); }
#pragma unroll
    for (int i = 0; i < 6; ++i) { const int row = (lane >> 3) + 8 * i; if (row < 47) *(LAS u32x4*)(scr + row * 144 + (lane & 7) * 16) = tl[i]; }
    asm volatile("s_waitcnt lgkmcnt(0)" ::: "memory");
    const int wlen = 2 << g; const int t = T0 + r; const float icnt = 1.f / (float)(wlen < t + 1 ? wlen : t + 1);
    h8 bf[4];
#pragma unroll
    for (int s = 0; s < 4; ++s) { const LAS unsigned char* base = scr + (15 + r) * 144 + (16 * s + 8 * h) * 2; float sm[8];
        const h8 cur = *(const LAS h8*)base;
#pragma unroll
        for (int k = 0; k < 8; ++k) sm[k] = (float)cur[k];
        for (int i = 1; i < wlen; ++i) { const h8 v = *(const LAS h8*)(base - i * 144);
#pragma unroll
            for (int k = 0; k < 8; ++k) sm[k] += (float)v[k]; }
        float pl[8];
#pragma unroll
        for (int k = 0; k < 8; ++k) pl[k] = sm[k] * icnt - (float)cur[k];
        bf[s] = __builtin_bit_cast(h8, pack8(pl)); }
    f32x16 Dd[2];
#pragma unroll
    for (int x = 0; x < 16; ++x) { Dd[0][x] = 0.f; Dd[1][x] = 0.f; }
#pragma unroll
    for (int s = 0; s < 4; ++s)
#pragma unroll
        for (int nb = 0; nb < 2; ++nb) { const h8 af = *(const LAS h8*)(lds + MX_WPT + ((g * 64 + 32 * nb + r) * 72 + 16 * s + 8 * h) * 2);
            Dd[nb] = __builtin_amdgcn_mfma_f32_32x32x16_f16(af, bf[s], Dd[nb], 0, 0, 0); }
#pragma unroll
    for (int nb = 0; nb < 2; ++nb)
#pragma unroll
        for (int xq = 0; xq < 4; ++xq) { const int col = 64 * g + 32 * nb + 8 * xq + 4 * h; const h4 z = __builtin_bit_cast(h4, zp[nb][xq]); const f32x4 sc = ps[nb][xq];
            u32x2 w; w.x = pkh(Dd[nb][4 * xq] * sc[0] * (float)z[0], Dd[nb][4 * xq + 1] * sc[1] * (float)z[1]); w.y = pkh(Dd[nb][4 * xq + 2] * sc[2] * (float)z[2], Dd[nb][4 * xq + 3] * sc[3] * (float)z[3]);
            *(u32x2*)(MIX + orow * D + 256 + col) = w; }
}
DI void mix_prompt_tasks(const Params& p, int l, int unit, LAS unsigned char* lds, int lane, int wave) {
    int one = 1; asm volatile("" : "+s"(one));
    if (one) task_attn(p, l, unit >> 6, (unit >> 5) & 1, wave & 3, (unit & 31) * 128 + 32 * (wave >> 2), lane_id());
    asm volatile("" : "+s"(one) :: "memory");
    if (one) task_attn(p, l, unit >> 6, (unit >> 5) & 1, wave & 3, (unit & 31) * 128 + 32 * (2 + (wave >> 2)), lane_id());
    asm volatile("s_waitcnt vmcnt(0) lgkmcnt(0)\n\ts_barrier" : "+s"(one) :: "memory");
    if (one) task_conv(p, l, unit * 64, wave, lds, lane_id());
    asm volatile("s_waitcnt lgkmcnt(0)\n\ts_barrier" : "+s"(one) :: "memory");
    if (one) task_pool(p, l, unit * 64, wave >> 2, wave & 3, lds, wave, lane_id());
    (void)lane;
}

DI void convpool_sample_unit(const Params& p, const MixPtrs& X, int l, int b, int part, LAS unsigned char* lds, int tid, int lane, int wave) {
    LAS float* cv = (LAS float*)lds;
    const int c = tid & 255, tp = tid >> 8; const size_t r0 = (size_t)MP + 4 * b;
    if (part == 0) {
        const float* cc = p.cache_conv + (size_t)(l * DB + b) * 30 * 256;
        float xa[34], wv[31];
        { const float* pc = cc + c;
#pragma unroll
          for (int ri = 0; ri < 30; ++ri) xa[ri] = pc[ri * 256];
          const u16* pn = X.PA + r0 * 256 + c;
#pragma unroll
          for (int ri = 0; ri < 4; ++ri) xa[30 + ri] = (float)(*(const _Float16*)(pn + ri * 256));
          const float* pw = p.conv_w + (size_t)l * 31 * 256 + c;
#pragma unroll
          for (int j = 0; j < 31; ++j) wv[j] = pw[j * 256]; }
        float a0 = p.conv_b[l * 256 + c], a1 = a0;
        if (tp == 0) {
#pragma unroll
            for (int j = 0; j < 31; ++j) { a0 += wv[j] * xa[j]; a1 += wv[j] * xa[j + 1]; }
        } else {
#pragma unroll
            for (int j = 0; j < 31; ++j) { a0 += wv[j] * xa[j + 2]; a1 += wv[j] * xa[j + 3]; } }
        cv[(2 * tp) * 256 + c] = a0; cv[(2 * tp + 1) * 256 + c] = a1;
        { float* oc = p.out + OFF_CONVS + (size_t)(l * DB + b) * 30 * 256; for (int e = tid; e < 26 * 64; e += NTHR) *(f32x4*)(oc + 4 * e) = *(const f32x4*)(cc + 4 * 256 + 4 * e); }
        __syncthreads();
        if (wave < 4) { const int t = wave; const f32x4 v = *(const LAS f32x4*)(cv + t * 256 + 4 * lane);
            const float mean = wave_sum((v[0] + v[1]) + (v[2] + v[3])) * (1.f / 256.f); const f32x4 d = v - mean;
            const float rstd = 1.f / sqrtf(wave_sum((d[0] * d[0] + d[1] * d[1]) + (d[2] * d[2] + d[3] * d[3])) * (1.f / 256.f) + LN_EPS);
            const f32x4 cg = *(const f32x4*)(p.cnorm_g + l * 256 + 4 * lane), cb = *(const f32x4*)(p.cnorm_b + l * 256 + 4 * lane);
            const h4 zc = *(const h4*)(X.PSZC + (r0 + t) * 256 + 4 * lane); float o[4];
#pragma unroll
            for (int k = 0; k < 4; ++k) o[k] = silu(d[k] * rstd * cg[k] + cb[k]) * (float)zc[k];
            u32x2 w; w.x = pkh(o[0], o[1]); w.y = pkh(o[2], o[3]);
            *(u32x2*)(X.MIX + (r0 + t) * D + 4 * lane) = w; }
    } else {
        const float* cp = p.cache_pool + (size_t)(l * DB + b) * 15 * 256;
        float xa[19];
        { const float* pc = cp + c;
#pragma unroll
          for (int ri = 0; ri < 15; ++ri) xa[ri] = pc[ri * 256];
          const u16* pn = X.PPV + r0 * 256 + c;
#pragma unroll
          for (int ri = 0; ri < 4; ++ri) xa[15 + ri] = (float)(*(const _Float16*)(pn + ri * 256)); }
        const int wlen = 2 << (c >> 6); float s0 = 0.f, s1 = 0.f, c0, c1;
        if (tp == 0) { c0 = xa[15]; c1 = xa[16];
#pragma unroll
            for (int i = 0; i < 16; ++i) if (i < wlen) { s0 += xa[15 - i]; s1 += xa[16 - i]; }
        } else { c0 = xa[17]; c1 = xa[18];
#pragma unroll
            for (int i = 0; i < 16; ++i) if (i < wlen) { s0 += xa[17 - i]; s1 += xa[18 - i]; } }
        const float iw = 1.f / (float)wlen;
        cv[(2 * tp) * 256 + c] = s0 * iw - c0; cv[(2 * tp + 1) * 256 + c] = s1 * iw - c1;
        { float* op = p.out + OFF_POOLS + (size_t)(l * DB + b) * 15 * 256; for (int e = tid; e < 11 * 64; e += NTHR) *(f32x4*)(op + 4 * e) = *(const f32x4*)(cp + 4 * 256 + 4 * e); }
        __syncthreads();
        const int g = c >> 6, n = c & 63; const float* pw = p.pool_w + ((size_t)l * 4 + g) * 64 * 64 + n; float y0 = 0.f, y1 = 0.f;
#pragma unroll 16
        for (int k = 0; k < 64; ++k) { const float w = pw[(size_t)k * 64]; y0 += cv[(2 * tp) * 256 + 64 * g + k] * w; y1 += cv[(2 * tp + 1) * 256 + 64 * g + k] * w; }
        const float ps = p.pool_scale[l * 256 + c];
        const float z0 = (float)(*(const _Float16*)(X.PSZP + (r0 + 2 * tp) * 256 + c)), z1 = (float)(*(const _Float16*)(X.PSZP + (r0 + 2 * tp + 1) * 256 + c));
        *(_Float16*)(X.MIX + (r0 + 2 * tp) * D + 256 + c) = (_Float16)(y0 * ps * z0); *(_Float16*)(X.MIX + (r0 + 2 * tp + 1) * D + 256 + c) = (_Float16)(y1 * ps * z1); }
    __syncthreads();
}

DI void attn_sample_unit(const Params& p, const MixPtrs& X, int l, int unit, LAS unsigned char* lds, int tid, int lane, int wave) {
    const int b = unit >> 1, hk = unit & 1; const size_t r0 = (size_t)MP + 4 * b;
    LAS float* Ks = (LAS float*)lds;
    LAS float* Vs = Ks + 132 * 65;
    LAS float* Qs = Vs + 132 * 64;
    LAS float* Ss = Qs + 16 * 65;
    const float* ck = p.cache_k + ((size_t)(l * DB + b) * 128 * 2 + hk) * 64; const float* cvv = p.cache_v + ((size_t)(l * DB + b) * 128 * 2 + hk) * 64;
    float* ok = p.out + OFF_KS + ((size_t)(l * DB + b) * 128 * 2 + hk) * 64; float* ov = p.out + OFF_VS + ((size_t)(l * DB + b) * 128 * 2 + hk) * 64;
#pragma unroll
    for (int i = 0; i < 4; ++i) { const int e = tid + 512 * i, j = e >> 4, d4 = (e & 15) * 4;
        const f32x4 kv = *(const f32x4*)(ck + (size_t)j * 128 + d4), vv = *(const f32x4*)(cvv + (size_t)j * 128 + d4);
        Ks[j * 65 + d4] = kv[0]; Ks[j * 65 + d4 + 1] = kv[1]; Ks[j * 65 + d4 + 2] = kv[2]; Ks[j * 65 + d4 + 3] = kv[3];
        *(LAS f32x4*)(Vs + j * 64 + d4) = vv;
        if (j >= 4) { *(f32x4*)(ok + (size_t)(j - 4) * 128 + d4) = kv; *(f32x4*)(ov + (size_t)(j - 4) * 128 + d4) = vv; } }
    if (tid < 256) { const int t = tid >> 6, d = tid & 63;
        Ks[(128 + t) * 65 + d] = (float)(*(const _Float16*)(X.PK + (r0 + t) * 128 + hk * 64 + d));
        Vs[(128 + t) * 64 + d] = (float)(*(const _Float16*)(X.PV + (r0 + t) * 128 + hk * 64 + d)); }
#pragma unroll
    for (int i = 0; i < 2; ++i) { const int e = tid + 512 * i, qr = e >> 6, d = e & 63, t = qr >> 2, g = qr & 3;
        Qs[qr * 65 + d] = (float)(*(const _Float16*)(X.PQ + (r0 + t) * 512 + (4 * hk + g) * 64 + d)); }
    __syncthreads();
    { const int qr = tid & 15, kg = tid >> 4, t = qr >> 2;
        for (int kk = kg; kk < 132; kk += 32) { float s = 0.f;
#pragma unroll 16
            for (int d = 0; d < 64; ++d) s += Qs[qr * 65 + d] * Ks[kk * 65 + d];
            Ss[qr * 133 + kk] = (kk >= t + 1 && kk <= t + 128) ? s : -INFINITY; } }
    __syncthreads();
#pragma unroll
    for (int q2 = 0; q2 < 2; ++q2) { const int qr = 2 * wave + q2, g = qr & 3; const float sink2 = p.sinks[l * 8 + 4 * hk + g] * LOG2E;
        float s0 = Ss[qr * 133 + lane], s1 = Ss[qr * 133 + 64 + lane], s2 = lane < 4 ? Ss[qr * 133 + 128 + lane] : -INFINITY;
        const float mx = fmaxf(wave_max(fmaxf(fmaxf(s0, s1), s2)), sink2);
        s0 = ex2(s0 - mx); s1 = ex2(s1 - mx); s2 = ex2(s2 - mx);
        const float inv = 1.f / (wave_sum(s0 + s1 + s2) + ex2(sink2 - mx));
        Ss[qr * 133 + lane] = s0 * inv; Ss[qr * 133 + 64 + lane] = s1 * inv; if (lane < 4) Ss[qr * 133 + 128 + lane] = s2 * inv; }
    __syncthreads();
    { const int qr = tid & 15, dg = tid >> 4, t = qr >> 2, g = qr & 3; float o0 = 0.f, o1 = 0.f;
#pragma unroll 4
        for (int kk = 0; kk < 132; ++kk) { const float pr = Ss[qr * 133 + kk]; const f32x2 v = *(const LAS f32x2*)(Vs + kk * 64 + 2 * dg); o0 += pr * v[0]; o1 += pr * v[1]; }
        const int col = (4 * hk + g) * 64 + 2 * dg;
        const h2 z = *(const h2*)(X.PSZA + (r0 + t) * 512 + col);
        *(unsigned*)(X.MIX + (r0 + t) * D + 512 + col) = pkh(o0 * (float)z[0], o1 * (float)z[1]); }
    __syncthreads();
}


template <int R>
DI void sample_ln_rows(const Params& p, int l, int row0, int lane) {
    const u16* ZH = (const u16*)(p.ws + WS_ZH); u16* XR = (u16*)(p.ws + WS_XR); u16* ZP = (u16*)(p.ws + WS_H);
    const float* lg = p.ln_g + (size_t)l * D; const float* lb = p.ln_b + (size_t)l * D;
    const float* modn = (const float*)(p.ws + WS_MOD) + (size_t)(l + 1) * NMOD * 3072;
    float v[R][16], mean[R], rstd[R];
#pragma unroll
    for (int r = 0; r < R; ++r)
#pragma unroll
        for (int j2 = 0; j2 < 2; ++j2) unpack8(*(const u32x4*)(ZH + (size_t)(row0 + r) * D + 512 * j2 + 8 * lane), v[r] + 8 * j2);
    ln_stats<R>(v, mean, rstd);
#pragma unroll
    for (int j2 = 0; j2 < 2; ++j2)
#pragma unroll
        for (int h = 0; h < 2; ++h) { const f32x4 g = *(const f32x4*)(lg + 512 * j2 + 8 * lane + 4 * h), bb = *(const f32x4*)(lb + 512 * j2 + 8 * lane + 4 * h);
#pragma unroll
            for (int r = 0; r < R; ++r)
#pragma unroll
                for (int k = 0; k < 4; ++k) v[r][8 * j2 + 4 * h + k] = v[r][8 * j2 + 4 * h + k] * rstd[r] * g[k] + bb[k]; }
    if (l == DEPTH - 1) {
#pragma unroll
        for (int r = 0; r < R; ++r) { float* y = p.out + OFF_YS + (size_t)(row0 - MP + r) * D;
#pragma unroll
            for (int j2 = 0; j2 < 2; ++j2)
#pragma unroll
                for (int h = 0; h < 2; ++h) *(f32x4*)(y + 512 * j2 + 8 * lane + 4 * h) = (f32x4){v[r][8 * j2 + 4 * h], v[r][8 * j2 + 4 * h + 1], v[r][8 * j2 + 4 * h + 2], v[r][8 * j2 + 4 * h + 3]}; }
    } else {
#pragma unroll
        for (int r = 0; r < R; ++r)
#pragma unroll
            for (int j2 = 0; j2 < 2; ++j2) *(u32x4*)(XR + (size_t)(row0 + r) * D + 512 * j2 + 8 * lane) = pack8(v[r] + 8 * j2);
        ln_stats<R>(v, mean, rstd);
#pragma unroll
        for (int r = 0; r < R; ++r) { const int row = row0 + r; const float* sh = modn + (size_t)(NB + ((row - MP) >> 2)) * 3072; const float* sc = sh + 1024;
#pragma unroll
            for (int j2 = 0; j2 < 2; ++j2) { float o[8];
#pragma unroll
                for (int h = 0; h < 2; ++h) { const f32x4 a = *(const f32x4*)(sc + 512 * j2 + 8 * lane + 4 * h), bb = *(const f32x4*)(sh + 512 * j2 + 8 * lane + 4 * h);
#pragma unroll
                    for (int k = 0; k < 4; ++k) o[4 * h + k] = v[r][8 * j2 + 4 * h + k] * rstd[r] * (1.f + a[k]) + bb[k]; }
                *(u32x4*)(ZP + (size_t)row * D + 512 * j2 + 8 * lane) = pack8(o); } }
    }
}
DI void outproj_sample_unit(const Params& p, int l, int unit, LAS unsigned char* lds, int tid, int lane, int wave) {
    const int rbk0 = unit >> 5, cb = unit & 31, R0 = MP + 64 * rbk0, n0 = 32 * cb, r = lane & 31, h = lane >> 5;
    const u16* MIX = (const u16*)(p.ws + WS_MIX); const u16* WT = (const u16*)(p.ws + WS_WOUT) + (size_t)l * D * D;
    const u16* bp = WT + (size_t)perm_out(n0 + r) * D + wave * 128 + 8 * h;
    const u16* ap = MIX + (size_t)(R0 + r) * D + wave * 128 + 8 * h;
    f32x16 acc[2];
#pragma unroll
    for (int x = 0; x < 16; ++x) { acc[0][x] = 0.f; acc[1][x] = 0.f; }
#pragma unroll
    for (int s = 0; s < 8; ++s) { const h8 bf = *(const h8*)(bp + 16 * s);
#pragma unroll
        for (int rb = 0; rb < 2; ++rb) { const h8 af = *(const h8*)(ap + (size_t)rb * 32 * D + 16 * s); acc[rb] = __builtin_amdgcn_mfma_f32_32x32x16_f16(af, bf, acc[rb], 0, 0, 0); } }
    LAS float* part = (LAS float*)lds;
#pragma unroll
    for (int rb = 0; rb < 2; ++rb)
#pragma unroll
        for (int x = 0; x < 16; ++x) part[(wave * 64 + 32 * rb + crow(x, h)) * 32 + r] = acc[rb][x];
    __syncthreads();
    const float* modl = (const float*)(p.ws + WS_MOD) + (size_t)l * NMOD * 3072;
#pragma unroll
    for (int q = 0; q < 4; ++q) { const int o = tid + 512 * q, row = o >> 5, col = o & 31; float sum = 0.f;
#pragma unroll
        for (int w = 0; w < 8; ++w) sum += part[(w * 64 + row) * 32 + col];
        const int grow = R0 + row, bidx = NB + ((grow - MP) >> 2);
        const float xr = (float)(*(const _Float16*)((const u16*)(p.ws + WS_XR) + (size_t)grow * D + n0 + col));
        *(_Float16*)((u16*)(p.ws + WS_ZH) + (size_t)grow * D + n0 + col) = (_Float16)(ALPHA * xr + (1.f + modl[(size_t)bidx * 3072 + 2048 + n0 + col]) * sum); }
    asm volatile("s_waitcnt vmcnt(0)" ::: "memory");
    __syncthreads();
    if (wave == 0 && lane == 0) {
        __builtin_amdgcn_fence(__ATOMIC_RELEASE, "agent"); asm volatile("s_waitcnt vmcnt(0)" ::: "memory");
        (void)__hip_atomic_fetch_add((unsigned*)(p.ws + WS_CTL) + CW_SCNT + 64 * (l * 8 + rbk0), 1u, __ATOMIC_RELAXED, __HIP_MEMORY_SCOPE_AGENT); }
}
DI void outproj_sample_finish(const Params& p, int l, int unit, int lane, int wave) {
    if (wave != 0) return;
    unsigned* cnt = (unsigned*)(p.ws + WS_CTL) + CW_SCNT + 64 * (l * 8 + (unit >> 5));
    for (unsigned sp = 0; sp < (1u << 20); ++sp) { if (__hip_atomic_load(cnt, __ATOMIC_RELAXED, __HIP_MEMORY_SCOPE_AGENT) >= 32u) break; __builtin_amdgcn_s_sleep(2); }
    __builtin_amdgcn_fence(__ATOMIC_ACQUIRE, "agent"); asm volatile("s_waitcnt vmcnt(0)" ::: "memory");
    sample_ln_rows<2>(p, l, MP + 64 * (unit >> 5) + 2 * (unit & 31), lane);
}

constexpr int N_PHASES = 3 + 3 * DEPTH;
typedef const __attribute__((address_space(4))) Params* KParams;
#define PHASE_BEGIN() const int lane_ = lane_id(); const int lane = lane_, wave = wave_s, tid = wave_s * 64 + lane_; \
    KParams kq = kp; asm volatile("" : "+s"(kq)); Params p; { const ParamsHead hh_ = *(const __attribute__((address_space(4))) ParamsHead*)kq; __builtin_memcpy(&p, &hh_, sizeof(ParamsHead)); }     const int gw = vcu * NWAVES + wave, NGW = G * NWAVES; (void)lane; (void)gw; (void)NGW
#define MIXPTRS() MixPtrs X; X.PA = (const u16*)(p.ws + WS_PA); X.PSZC = (const u16*)(p.ws + WS_PSZC); X.PPV = (const u16*)(p.ws + WS_PPV); X.PSZP = (const u16*)(p.ws + WS_PSZP); \
    X.PQ = (const u16*)(p.ws + WS_PQ); X.PSZA = (const u16*)(p.ws + WS_PSZA); X.PK = (const u16*)(p.ws + WS_PK); X.PV = (const u16*)(p.ws + WS_PV); X.MIX = (u16*)(p.ws + WS_MIX)
__global__ void __launch_bounds__(NTHR, 2) hymba_fwd(Params p_unused) {
#if defined(__HIP_DEVICE_COMPILE__)
    extern __shared__ __attribute__((aligned(16))) unsigned char lds_raw[];
    LAS unsigned char* lds = (LAS unsigned char*)lds_raw;
    volatile LAS unsigned* MISC = (volatile LAS unsigned*)(lds + MISC_OFF);
    const KParams kp = (KParams)__builtin_amdgcn_kernarg_segment_ptr();
    const int G = gridDim.x, bx = blockIdx.x, vcu = (G % 8 == 0) ? (bx % 8) * (G / 8) + bx / 8 : bx;
    const int wave_s = __builtin_amdgcn_readfirstlane((int)threadIdx.x >> 6);
    for (int u = threadIdx.x; u < (LDS_BYTES - RING_BYTES) / 4; u += NTHR) ((LAS unsigned*)(lds + RING_BYTES))[u] = 0u;
    __syncthreads();
    unsigned* ctl = (unsigned*)(kp->ws + WS_CTL);
    XcdBarrier bar; bar.bar = ctl + CW_BAR; bar.x = 0; bar.st = nullptr;
    if (MK_N_LAUNCHES == 1) bar = xcd_barrier_post(ctl + CW_BAR, MISC + 8);
    const int lo = kp->ph_lo, hi = kp->ph_hi;
#ifndef ONLY
#define ONLY -1
#endif
#ifndef ONLYMASK
#define ONLYMASK 0x3f
#endif
#define EN(t) ((ONLY < 0 || ONLY == (t)) && ((ONLYMASK >> (t)) & 1))
#define IN(k) (lo <= (k) && (k) < hi)
#define SEAM(k) do { if (MK_N_LAUNCHES == 1 && IN((k) + 1)) xcd_barrier(bar, wave_s); } while (0)
    if (EN(0) && IN(0)) { { PHASE_BEGIN(); p0_prologue(p, (const __attribute__((address_space(4))) float*)((const __attribute__((address_space(4))) char*)kq + __builtin_offsetof(Params, inv_freq)), lds, vcu, G, tid, lane, wave); } SEAM(0); }
    if (EN(1) && IN(1)) { { PHASE_BEGIN(); for (int u = vcu; u < DEPTH * 40; u += G) modv_unit(p, lds, u, tid, lane, wave); pre_phase(p, gw, NGW, lane); } SEAM(1); }
#pragma unroll 1
    for (int l = 0; l < DEPTH; ++l) {
        const int ph = 2 + 3 * l;
        if (EN(2) && IN(ph)) {
            { PHASE_BEGIN();
            pg8::Gemm g{(const u16*)(p.ws + WS_H), (const u16*)(p.ws + WS_WIN) + (size_t)l * DIN * D, M, DIN, D};
            pg8::StaticOrder S; S.init(M, DIN, G, bx);
            LAS float* rcl = (LAS float*)(lds + RING_BYTES + 1024);
            for (int i = 0; i < 3; ++i) { pg8::Unit u; if (S.next(i, u) && u.pm < MP / 256) finalize_rc_in(p, l, u.pm, rcl + i * 1024, tid); }
            asm volatile("s_waitcnt lgkmcnt(0)" ::: "memory"); __syncthreads();
            EpiIn E{l, p.ws, p.out, rcl};
            pg8::gemm_phase<EpiIn, true>(lds, g, S, E, tid); }
            SEAM(ph);
        }
        if (EN(3) && IN(ph + 1)) {
            { PHASE_BEGIN(); for (int e = tid; e < 4 * 64 * 64; e += NTHR) { const int g = e >> 12, c = (e >> 6) & 63, n = e & 63;
                  *(LAS _Float16*)(lds + MX_WPT + ((g * 64 + n) * 72 + c) * 2) = (_Float16)p.pool_w[(size_t)l * 16384 + e]; } }
            { PHASE_BEGIN(); MIXPTRS(); for (int u = vcu; u < 256; u += G) attn_prompt_unit(p, X, l, u, lds, tid, lane, wave); }
            { PHASE_BEGIN(); MIXPTRS(); for (int u = vcu; u < 256; u += G) conv_prompt_unit(p, X, l, u, lds, tid, lane, wave); }
            { PHASE_BEGIN(); for (int u = vcu; u < 256; u += G) { task_pool(p, l, u * 64, wave >> 2, wave & 3, lds, wave, lane); __syncthreads(); } }
            { PHASE_BEGIN(); MIXPTRS(); for (int u = vcu; u < 256; u += G) attn_sample_unit(p, X, l, u, lds, tid, lane, wave); }
            { PHASE_BEGIN(); MIXPTRS(); for (int u = vcu; u < 2 * DB; u += G) convpool_sample_unit(p, X, l, u >> 1, u & 1, lds, tid, lane, wave); }
            SEAM(ph + 1); }
        if (EN(4) && IN(ph + 2)) {
            { PHASE_BEGIN();
            pg8::Gemm g{(const u16*)(p.ws + WS_MIX), (const u16*)(p.ws + WS_WOUT) + (size_t)l * D * D, M, D, D};
            for (int u = vcu; u < 256; u += G) outproj_sample_unit(p, l, u, lds, tid, lane, wave);
            __syncthreads();
            pg8::StaticOrder S; S.init(MP, D, G, bx);
            EpiOutF E{p.ws, l, p.ln_g, p.ln_b};
            pg8::gemm_phase<EpiOutF, false>(lds, g, S, E, tid);
            for (int u = vcu; u < 256; u += G) outproj_sample_finish(p, l, u, lane, wave); }
            SEAM(ph + 2);
        }
    }
    if (EN(5) && IN(N_PHASES - 1)) { PHASE_BEGIN(); fin_phase(p, gw, NGW, lane); }
#undef IN
#undef SEAM
#endif
}


#ifdef DBG
constexpr int DBG_NS = 56;
constexpr size_t WS_DBGACC = 32 * 1024;
constexpr size_t WS_DBGZ = WS_END;
__constant__ int dbg_rows_tab[DBG_NS] = {0, 1, 2, 3, 14, 15, 16, 29, 30, 31, 32, 63, 64, 65, 127, 128, 129, 255, 256, 1000, 2047, 2048, 3967, 3968, 4065, 4066, 4080, 4081, 4094, 4095, 4096, 4097, 4127, 4224,
                            8191, 8192, 8320, 12288, 12415, 16382, 16383, 16384, 16385, 16386, 16387, 16388, 16391, 16639, 16640, 16892, 16893, 16894, 16895, 5000, 9999, 15000};
__device__ int dbg_row(int i) { return dbg_rows_tab[i]; }
__device__ void dbg_acc(float* accf, int id, float e, float r) {
    __shared__ float se[256], sr[256];
    const int t = threadIdx.x; se[t] = e; sr[t] = r; __syncthreads();
    for (int o = 128; o > 0; o >>= 1) { if (t < o) { se[t] += se[t + o]; sr[t] += sr[t + o]; } __syncthreads(); }
    if (t == 0) { atomicAdd(accf + 2 * id, se[0]); atomicAdd(accf + 2 * id + 1, sr[0]); }
    __syncthreads();
}
__device__ float dbg_h(const u16* p, size_t i) { return (float)(*(const _Float16*)(p + i)); }
__device__ float dbg_block_sum(float v) { __shared__ float sb[256]; const int t = threadIdx.x; sb[t] = v; __syncthreads(); for (int o = 128; o > 0; o >>= 1) { if (t < o) sb[t] += sb[t + o]; __syncthreads(); } const float r = sb[0]; __syncthreads(); return r; }
__device__ void dbg_ln4(float (&x)[4], float& rstd) { const float mean = dbg_block_sum(x[0] + x[1] + x[2] + x[3]) / D; float q = 0; for (int i = 0; i < 4; ++i) { x[i] -= mean; q += x[i] * x[i]; } rstd = 1.f / sqrtf(dbg_block_sum(q) / D + LN_EPS); }
#define DBG_E(fast, ref) do { const float f_ = (fast), r_ = (ref); e += (f_ - r_) * (f_ - r_); rr += r_ * r_; } while (0)
__global__ void __launch_bounds__(256) dbg_p0(Params p) {
    float* accf = (float*)(p.ws + WS_DBGACC); const int t = threadIdx.x, bid = blockIdx.x;
    { float e = 0, rr = 0; const int ri = (bid >> 2) % 9;
        const int l = bid & 3, row = ri < 6 ? ri : (ri == 6 ? 67 : 123 + ri);
        const float* c = row < NB ? p.c_prompt + (size_t)row * D : p.c_sample + (size_t)(row - NB) * D;
        for (int n = t * 12 + (bid % 12); n < 3072; n += 256 * 12) { float a = p.b_mod[l * 3072 + n];
            for (int k = 0; k < D; ++k) { const float x = c[k]; a += x / (1.f + expf(-x)) * p.w_mod[((size_t)l * D + k) * 3072 + n]; }
            DBG_E(((const float*)(p.ws + WS_MOD))[((size_t)l * NMOD + row) * 3072 + n], a); }
        dbg_acc(accf, 0, e, rr); }
    { float e = 0, rr = 0;
        for (int i = 0; i < 64; ++i) { const int l = bid & 3, col = (bid * 37 + i * 41 + t * 10) % DIN, k = (t * 4 + i * 16 + bid) % D;
            DBG_E(dbg_h((const u16*)(p.ws + WS_WIN), ((size_t)l * DIN + perm_in(col)) * D + k), p.w_in[((size_t)l * D + k) * DIN + col]); }
        dbg_acc(accf, 1, e, rr); }
    { float e = 0, rr = 0;
        for (int i = 0; i < 64; ++i) { const int l = bid & 3, col = (bid * 37 + i * 41 + t * 4) % D, k = (t * 4 + i * 16 + bid) % D;
            DBG_E(dbg_h((const u16*)(p.ws + WS_WOUT), ((size_t)l * D + perm_out(col)) * D + k), p.w_out[((size_t)l * D + k) * D + col]); }
        dbg_acc(accf, 2, e, rr); }
    { float e = 0, rr = 0;
        for (int i = 0; i < 16; ++i) { const int pi = (bid * 113 + i * 257 + t * 16) % (SEQ + DS), f = (t + i) & 31; const int pos = pi < SEQ ? pi : PAST + pi - SEQ;
            const float ang = (float)pos * p.inv_freq[f]; const f32x2 cs = ((const f32x2*)(p.ws + WS_TAB))[pi * 32 + f];
            DBG_E(cs[0], cosf(ang)); DBG_E(cs[1], sinf(ang)); }
        dbg_acc(accf, 3, e, rr); }
}
__global__ void __launch_bounds__(256) dbg_p0b(Params p) {
    float* accf = (float*)(p.ws + WS_DBGACC); const int t = threadIdx.x, bid = blockIdx.x;
    { float e = 0, rr = 0;
        const int l = bid & 3, b = (bid >> 2) & 3; const float* md = (const float*)(p.ws + WS_MOD) + ((size_t)l * NMOD + b) * 3072;
        const int col = (t * 10 + (bid >> 4) * 3 + 1) % DIN; float v1 = 0, v2 = 0, v3 = 0, v4 = 0;
        for (int c = 0; c < D; ++c) { const float w = p.w_in[((size_t)l * D + c) * DIN + col], g = l > 0 ? p.ln_g[(l - 1) * D + c] : 1.f, bb = l > 0 ? p.ln_b[(l - 1) * D + c] : 0.f, s1 = 1.f + md[1024 + c];
            v1 += g * s1 * w; v2 += bb * s1 * w; v3 += s1 * w; v4 += md[c] * w; }
        const float* mv = (const float*)(p.ws + WS_MODV) + (size_t)(l * NB + b) * 4 * DIN + perm_in(col);
        DBG_E(mv[0], v1); DBG_E(mv[2 * DIN], v3); DBG_E(mv[3 * DIN], v4); if (l > 0) DBG_E(mv[DIN], v2); else e += mv[DIN] * mv[DIN];
        dbg_acc(accf, 69, e, rr); }
    if (bid < DBG_NS) { const int row = dbg_row(bid); const bool smp = row >= MP; const int bidx = smp ? NB + ((row - MP) >> 2) : (row >> 12);
        const float* md = (const float*)(p.ws + WS_MOD) + (size_t)bidx * 3072;
        float x[4]; for (int i = 0; i < 4; ++i) { const int c = t + 256 * i; x[i] = smp ? p.x_sample[(size_t)(row - MP) * D + c] : p.x_prompt[(size_t)row * D + c]; }
        float e = 0, rr = 0; for (int i = 0; i < 4; ++i) DBG_E(dbg_h((const u16*)(p.ws + (smp ? WS_XR : WS_ZH)), (size_t)row * D + t + 256 * i), x[i]); dbg_acc(accf, 70, e, rr);
        e = 0; rr = 0;
        if (!smp) { for (int i = 0; i < 4; ++i) { const int c = t + 256 * i; DBG_E(dbg_h((const u16*)(p.ws + WS_H), (size_t)row * D + c), x[i] * (1.f + md[1024 + c])); } }
        else { float rstd; dbg_ln4(x, rstd); for (int i = 0; i < 4; ++i) { const int c = t + 256 * i; DBG_E(dbg_h((const u16*)(p.ws + WS_H), (size_t)row * D + c), x[i] * rstd * (1.f + md[1024 + c]) + md[c]); } }
        dbg_acc(accf, 71, e, rr); }
}
__global__ void __launch_bounds__(256) dbg_copyz(Params p) { const int row = dbg_row(blockIdx.x);
    for (int c = threadIdx.x; c < D; c += 256) { ((u16*)(p.ws + WS_DBGZ))[blockIdx.x * D + c] = ((const u16*)(p.ws + WS_ZH))[(size_t)row * D + c]; ((u16*)(p.ws + WS_DBGZ))[(DBG_NS + blockIdx.x) * D + c] = ((const u16*)(p.ws + WS_XR))[(size_t)row * D + c]; } }
__global__ void __launch_bounds__(256) dbg_in(Params p, int l) {
    __shared__ float pr[DIN]; __shared__ float hh[D];
    float* accf = (float*)(p.ws + WS_DBGACC); const int t = threadIdx.x, row = dbg_row(blockIdx.x), base = 4 + 16 * l;
    const bool smp = row >= MP; const int b = smp ? (row - MP) >> 2 : row >> 12, tt = smp ? (row - MP) & 3 : row & (SEQ - 1), pos = smp ? PAST + tt : tt;
    const int bidx = smp ? NB + b : b; const float* md = (const float*)(p.ws + WS_MOD) + ((size_t)l * NMOD + bidx) * 3072;
    float e, rr;
    { float x[4]; float rstd;
        for (int i = 0; i < 4; ++i) x[i] = dbg_h((const u16*)(p.ws + (smp ? WS_XR : WS_ZH)), (size_t)row * D + t + 256 * i);
        if (!smp && l > 0) { dbg_ln4(x, rstd); for (int i = 0; i < 4; ++i) { const int c = t + 256 * i; x[i] = x[i] * rstd * p.ln_g[(l - 1) * D + c] + p.ln_b[(l - 1) * D + c]; } }
        dbg_ln4(x, rstd);
        for (int i = 0; i < 4; ++i) { const int c = t + 256 * i; hh[c] = x[i] * rstd * (1.f + md[1024 + c]) + md[c]; }
        __syncthreads();
        if (smp) { e = 0; rr = 0; for (int i = 0; i < 4; ++i) { const int c = t + 256 * i; DBG_E(dbg_h((const u16*)(p.ws + WS_H), (size_t)row * D + c), hh[c]); } dbg_acc(accf, base + 1, e, rr); } }
    for (int i = 0; i < 10; ++i) { const int col = t + 256 * i; float a = 0; for (int k = 0; k < D; ++k) a += hh[k] * p.w_in[((size_t)l * D + k) * DIN + col]; pr[col] = a; }
    __syncthreads();
    const float av = pr[t] / (1.f + expf(-pr[256 + t]));
    e = 0; rr = 0; DBG_E(dbg_h((const u16*)(p.ws + WS_PA), (size_t)row * 256 + t), av); dbg_acc(accf, base + 2, e, rr);
    e = 0; rr = 0; { const float z = pr[512 + t]; DBG_E(dbg_h((const u16*)(p.ws + WS_PSZC), (size_t)row * 256 + t), z / (1.f + expf(-z))); } dbg_acc(accf, base + 3, e, rr);
    e = 0; rr = 0; DBG_E(dbg_h((const u16*)(p.ws + WS_PPV), (size_t)row * 256 + t), pr[768 + t]); dbg_acc(accf, base + 4, e, rr);
    e = 0; rr = 0; { const float z = pr[1024 + t]; DBG_E(dbg_h((const u16*)(p.ws + WS_PSZP), (size_t)row * 256 + t), z / (1.f + expf(-z))); } dbg_acc(accf, base + 5, e, rr);
    e = 0; rr = 0;
    for (int i = 0; i < 2; ++i) { const int c = t + 256 * i, hd = c >> 6, d = c & 63, f = d & 31; const float ang = (float)pos * p.inv_freq[f], cs = cosf(ang), sn = sinf(ang);
        const float x = pr[1280 + c], xo = d < 32 ? -pr[1280 + hd * 64 + d + 32] : pr[1280 + hd * 64 + d - 32];
        DBG_E(dbg_h((const u16*)(p.ws + WS_PQ), (size_t)row * 512 + c), (x * cs + xo * sn) * QSCALE); }
    dbg_acc(accf, base + 6, e, rr);
    e = 0; rr = 0; float kref = 0.f, vref = 0.f;
    if (t < 128) { const int hd = t >> 6, d = t & 63, f = d & 31; const float ang = (float)pos * p.inv_freq[f], cs = cosf(ang), sn = sinf(ang);
        const float x = pr[1792 + t], xo = d < 32 ? -pr[1792 + hd * 64 + d + 32] : pr[1792 + hd * 64 + d - 32]; kref = x * cs + xo * sn;
        DBG_E(dbg_h((const u16*)(p.ws + WS_PK), (size_t)row * 128 + t), kref); }
    dbg_acc(accf, base + 7, e, rr);
    e = 0; rr = 0; if (t < 128) { vref = pr[1920 + t]; DBG_E(dbg_h((const u16*)(p.ws + WS_PV), (size_t)row * 128 + t), vref); } dbg_acc(accf, base + 8, e, rr);
    e = 0; rr = 0; for (int i = 0; i < 2; ++i) { const float z = pr[2048 + t + 256 * i]; DBG_E(dbg_h((const u16*)(p.ws + WS_PSZA), (size_t)row * 512 + t + 256 * i), z / (1.f + expf(-z))); } dbg_acc(accf, base + 9, e, rr);
    e = 0; rr = 0;
    if (smp) { DBG_E(p.out[OFF_CONVS + ((size_t)(l * DB + b) * 30 + 26 + tt) * 256 + t], av); DBG_E(p.out[OFF_POOLS + ((size_t)(l * DB + b) * 15 + 11 + tt) * 256 + t], pr[768 + t]);
        if (t < 128) { DBG_E(p.out[OFF_KS + ((size_t)(l * DB + b) * 128 + 124 + tt) * 128 + t], kref); DBG_E(p.out[OFF_VS + ((size_t)(l * DB + b) * 128 + 124 + tt) * 128 + t], vref); } }
    else { if (tt >= SEQ - 30) DBG_E(p.out[OFF_CONVP + ((size_t)(l * NB + b) * 30 + tt - (SEQ - 30)) * 256 + t], av);
        if (tt >= SEQ - 15) DBG_E(p.out[OFF_POOLP + ((size_t)(l * NB + b) * 15 + tt - (SEQ - 15)) * 256 + t], pr[768 + t]);
        if (tt >= SEQ - 128 && t < 128) { DBG_E(p.out[OFF_KP + ((size_t)(l * NB + b) * 128 + tt - (SEQ - 128)) * 128 + t], kref); DBG_E(p.out[OFF_VP + ((size_t)(l * NB + b) * 128 + tt - (SEQ - 128)) * 128 + t], vref); } }
    dbg_acc(accf, base + 10, e, rr);
}
__global__ void __launch_bounds__(256) dbg_mix(Params p, int l) {
    __shared__ float sh[1024]; __shared__ float sc[136];
    float* accf = (float*)(p.ws + WS_DBGACC); const int t = threadIdx.x, row = dbg_row(blockIdx.x), base = 4 + 16 * l;
    const bool smp = row >= MP; const int b = smp ? (row - MP) >> 2 : row >> 12, tt = smp ? (row - MP) & 3 : row & (SEQ - 1);
    const u16 *PA = (const u16*)(p.ws + WS_PA), *PSZC = (const u16*)(p.ws + WS_PSZC), *PPV = (const u16*)(p.ws + WS_PPV), *PSZP = (const u16*)(p.ws + WS_PSZP), *PQ = (const u16*)(p.ws + WS_PQ),
              *PSZA = (const u16*)(p.ws + WS_PSZA), *PK = (const u16*)(p.ws + WS_PK), *PV = (const u16*)(p.ws + WS_PV), *MIX = (const u16*)(p.ws + WS_MIX);
    float e, rr;
    {
        float a = p.conv_b[l * 256 + t];
        for (int j = 0; j < 31; ++j) { float x;
            if (!smp) { const int ts = tt - 30 + j; x = ts >= 0 ? dbg_h(PA, ((size_t)b * SEQ + ts) * 256 + t) : 0.f; }
            else { const int ri = tt + j; x = ri < 30 ? p.cache_conv[((size_t)(l * DB + b) * 30 + ri) * 256 + t] : dbg_h(PA, ((size_t)MP + 4 * b + ri - 30) * 256 + t); }
            a += p.conv_w[((size_t)l * 31 + j) * 256 + t] * x; }
        const float mean = dbg_block_sum(a) / 256.f; const float d = a - mean; const float rstd = 1.f / sqrtf(dbg_block_sum(d * d) / 256.f + LN_EPS);
        const float y = d * rstd * p.cnorm_g[l * 256 + t] + p.cnorm_b[l * 256 + t];
        e = 0; rr = 0; DBG_E(dbg_h(MIX, (size_t)row * D + t), y / (1.f + expf(-y)) * dbg_h(PSZC, (size_t)row * 256 + t)); dbg_acc(accf, base + 11, e, rr); }
    {
        const int w = 2 << (t >> 6); float s = 0;
        for (int i = 0; i < w; ++i) { float x;
            if (!smp) { const int ts = tt - i; x = ts >= 0 ? dbg_h(PPV, ((size_t)b * SEQ + ts) * 256 + t) : 0.f; }
            else { const int ri = 15 + tt - i; x = ri < 15 ? p.cache_pool[((size_t)(l * DB + b) * 15 + ri) * 256 + t] : dbg_h(PPV, ((size_t)MP + 4 * b + ri - 15) * 256 + t); }
            s += x; }
        const float cnt = smp ? (float)w : (float)(w < tt + 1 ? w : tt + 1);
        sh[t] = s / cnt - dbg_h(PPV, (size_t)row * 256 + t); __syncthreads();
        const int g = t >> 6, n = t & 63; float y = 0; for (int c = 0; c < 64; ++c) y += sh[64 * g + c] * p.pool_w[(((size_t)l * 4 + g) * 64 + c) * 64 + n];
        e = 0; rr = 0; DBG_E(dbg_h(MIX, (size_t)row * D + 256 + t), y * p.pool_scale[l * 256 + t] * dbg_h(PSZP, (size_t)row * 256 + t)); dbg_acc(accf, base + 12, e, rr); __syncthreads(); }
    {
        e = 0; rr = 0;
        for (int hd = 0; hd < 8; ++hd) { const int hk = hd >> 2; __syncthreads();
            if (t < 64) sh[t] = dbg_h(PQ, (size_t)row * 512 + hd * 64 + t); __syncthreads();
            const float sink2 = p.sinks[l * 8 + hd] * LOG2E;
            if (t < 128) { float s = -INFINITY;
                if (!smp) { const int ts = tt - 127 + t; if (ts >= 0) { s = 0; for (int d = 0; d < 64; ++d) s += sh[d] * dbg_h(PK, ((size_t)b * SEQ + ts) * 128 + hk * 64 + d); } }
                else { const int ci = tt + 1 + t;
                    s = 0; for (int d = 0; d < 64; ++d) s += sh[d] * (ci < 128 ? p.cache_k[(((size_t)(l * DB + b) * 128 + ci) * 2 + hk) * 64 + d] : dbg_h(PK, ((size_t)MP + 4 * b + ci - 128) * 128 + hk * 64 + d)); }
                sc[t] = s; }
            __syncthreads();
            float mx = sink2; for (int k = 0; k < 128; ++k) mx = fmaxf(mx, sc[k]);
            float den = exp2f(sink2 - mx); for (int k = 0; k < 128; ++k) den += exp2f(sc[k] - mx);
            if (t < 64) { float o = 0;
                for (int k = 0; k < 128; ++k) { const float pk = exp2f(sc[k] - mx) / den; if (pk == 0.f) continue; float v;
                    if (!smp) { const int ts = tt - 127 + k; v = dbg_h(PV, ((size_t)b * SEQ + ts) * 128 + hk * 64 + t); }
                    else { const int ci = tt + 1 + k; v = ci < 128 ? p.cache_v[(((size_t)(l * DB + b) * 128 + ci) * 2 + hk) * 64 + t] : dbg_h(PV, ((size_t)MP + 4 * b + ci - 128) * 128 + hk * 64 + t); }
                    o += pk * v; }
                DBG_E(dbg_h(MIX, (size_t)row * D + 512 + hd * 64 + t), o * dbg_h(PSZA, (size_t)row * 512 + hd * 64 + t)); } }
        dbg_acc(accf, base + 13, e, rr); }
    if (smp) { e = 0; rr = 0;
        for (int i = 0; i < 26; ++i) DBG_E(p.out[OFF_CONVS + ((size_t)(l * DB + b) * 30 + i) * 256 + t], p.cache_conv[((size_t)(l * DB + b) * 30 + i + 4) * 256 + t]);
        for (int i = 0; i < 11; ++i) DBG_E(p.out[OFF_POOLS + ((size_t)(l * DB + b) * 15 + i) * 256 + t], p.cache_pool[((size_t)(l * DB + b) * 15 + i + 4) * 256 + t]);
        for (int i = 0; i < 124; ++i) if (t < 128) { DBG_E(p.out[OFF_KS + ((size_t)(l * DB + b) * 128 + i) * 128 + t], p.cache_k[((size_t)(l * DB + b) * 128 + i + 4) * 128 + t]);
            DBG_E(p.out[OFF_VS + ((size_t)(l * DB + b) * 128 + i) * 128 + t], p.cache_v[((size_t)(l * DB + b) * 128 + i + 4) * 128 + t]); }
        dbg_acc(accf, base + 15, e, rr); }
}
__global__ void __launch_bounds__(256) dbg_out(Params p, int l) {
    __shared__ float mm[D];
    float* accf = (float*)(p.ws + WS_DBGACC); const int t = threadIdx.x, row = dbg_row(blockIdx.x), base = 4 + 16 * l;
    const bool smp = row >= MP; const int bidx = smp ? NB + ((row - MP) >> 2) : (row >> 12);
    for (int c = t; c < D; c += 256) mm[c] = dbg_h((const u16*)(p.ws + WS_MIX), (size_t)row * D + c);
    __syncthreads();
    const float* md = (const float*)(p.ws + WS_MOD) + ((size_t)l * NMOD + bidx) * 3072 + 2048;
    const float* mdn = (const float*)(p.ws + WS_MOD) + ((size_t)(l + 1) * NMOD + bidx) * 3072;
    float x1[4], z[4], rstd;
    for (int i = 0; i < 4; ++i) x1[i] = dbg_h((const u16*)(p.ws + WS_DBGZ), (size_t)((smp ? DBG_NS : 0) + blockIdx.x) * D + t + 256 * i);
    if (!smp && l > 0) { dbg_ln4(x1, rstd); for (int i = 0; i < 4; ++i) { const int c = t + 256 * i; x1[i] = x1[i] * rstd * p.ln_g[(l - 1) * D + c] + p.ln_b[(l - 1) * D + c]; } }
    float e = 0, rr = 0;
    for (int i = 0; i < 4; ++i) { const int c = t + 256 * i; float a = 0; for (int k = 0; k < D; ++k) a += mm[k] * p.w_out[((size_t)l * D + k) * D + c];
        z[i] = ALPHA * x1[i] + (1.f + md[c]) * a; DBG_E(dbg_h((const u16*)(p.ws + WS_ZH), (size_t)row * D + c), z[i]); }
    dbg_acc(accf, base + 14, e, rr);
    e = 0; rr = 0;
    if (!smp) { if (l < DEPTH - 1) for (int i = 0; i < 4; ++i) { const int c = t + 256 * i; DBG_E(dbg_h((const u16*)(p.ws + WS_H), (size_t)row * D + c), z[i] * p.ln_g[l * D + c] * (1.f + mdn[1024 + c])); } }
    else { dbg_ln4(z, rstd); for (int i = 0; i < 4; ++i) { const int c = t + 256 * i; z[i] = z[i] * rstd * p.ln_g[l * D + c] + p.ln_b[l * D + c]; }
        if (l == DEPTH - 1) { for (int i = 0; i < 4; ++i) DBG_E(p.out[OFF_YS + (size_t)(row - MP) * D + t + 256 * i], z[i]); }
        else { for (int i = 0; i < 4; ++i) DBG_E(dbg_h((const u16*)(p.ws + WS_XR), (size_t)row * D + t + 256 * i), z[i]);
            dbg_ln4(z, rstd); for (int i = 0; i < 4; ++i) { const int c = t + 256 * i; DBG_E(dbg_h((const u16*)(p.ws + WS_H), (size_t)row * D + c), z[i] * rstd * (1.f + mdn[1024 + c]) + mdn[c]); } } }
    dbg_acc(accf, base + 0, e, rr);
    if (l == 0) { dbg_acc(accf, 100, smp ? 0.f : e, smp ? 0.f : rr); dbg_acc(accf, 101, smp ? e : 0.f, smp ? rr : 0.f); }
}
__global__ void __launch_bounds__(256) dbg_fin(Params p) {
    float* accf = (float*)(p.ws + WS_DBGACC); const int t = threadIdx.x, row = dbg_row(blockIdx.x);
    if (row >= MP) return;
    float x[4]; for (int i = 0; i < 4; ++i) x[i] = dbg_h((const u16*)(p.ws + WS_ZH), (size_t)row * D + t + 256 * i);
    float rstd; dbg_ln4(x, rstd); float e = 0, rr = 0;
    for (int i = 0; i < 4; ++i) { const int c = t + 256 * i; DBG_E(p.out[(size_t)row * D + c], x[i] * rstd * p.ln_g[3 * D + c] + p.ln_b[3 * D + c]); }
    dbg_acc(accf, 68, e, rr);
}
#ifndef DBG_REPORT_ID
#define DBG_REPORT_ID -1
#endif
__global__ void __launch_bounds__(256) dbg_report(Params p) {
    const float* accf = (const float*)(p.ws + WS_DBGACC);
    float code = 1000.f;
    if (DBG_REPORT_ID >= 0) { const float e = accf[2 * DBG_REPORT_ID], r = accf[2 * DBG_REPORT_ID + 1]; code = (r > 0.f ? e / r : 9.9f) * 1e12f; if (!(code > 100.f)) code = 100.f; }
    else for (int i = 0; i < 128; ++i) { const float e = accf[2 * i], r = accf[2 * i + 1]; const bool expected = i <= 71 && !(i >= 4 && i < 68 && ((i - 4) & 15) == 0 && (i - 4) / 16 == 99);
        if ((r > 0.f && !(e / r < 1e-3f)) || (r == 0.f && (e > 0.f || expected)) || e != e || r != r) { code = (float)(i + 1) * 1e4f; break; } }
    const float S = sqrtf(code);
    for (size_t i = (size_t)blockIdx.x * 256 + threadIdx.x; i < (size_t)MP * D; i += (size_t)gridDim.x * 256) p.out[i] = S;
}
#endif

extern "C" void kernel_launch(void* const* d_in, const int* in_sizes, int n_in, void* d_out, int out_size, void* d_ws, size_t ws_size, hipStream_t stream) {
    static int grid = 0;
    if (grid == 0) {
        if (n_in != 21 || (size_t)out_size != OUT_TOTAL || ws_size < WS_END) { fprintf(stderr, "kernel_launch: unexpected shapes (n_in %d, out %d, ws %zu)\n", n_in, out_size, ws_size); grid = -1; return; }
        int dev = 0, cus = 0;
        if (hipGetDevice(&dev) != hipSuccess || hipDeviceGetAttribute(&cus, hipDeviceAttributeMultiprocessorCount, dev) != hipSuccess) { grid = -1; return; }
        if (hipFuncSetAttribute((const void*)hymba_fwd, hipFuncAttributeMaxDynamicSharedMemorySize, LDS_BYTES) != hipSuccess) { fprintf(stderr, "kernel_launch: hipFuncSetAttribute failed\n"); grid = -1; return; }
        (void)hipGetLastError();
        grid = cus;
    }
    if (grid < 0) return;
    (void)hipMemsetAsync((char*)d_ws + WS_CTL, 0, CTL_ZERO_BYTES, stream);
    Params a{};
    a.x_prompt = (const float*)d_in[0]; a.x_sample = (const float*)d_in[1]; a.cache_conv = (const float*)d_in[2]; a.cache_pool = (const float*)d_in[3];
    a.cache_k = (const float*)d_in[4]; a.cache_v = (const float*)d_in[5]; a.c_prompt = (const float*)d_in[6]; a.c_sample = (const float*)d_in[7];
    a.w_in = (const float*)d_in[8]; a.w_out = (const float*)d_in[9]; a.conv_w = (const float*)d_in[10]; a.conv_b = (const float*)d_in[11];
    a.cnorm_g = (const float*)d_in[12]; a.cnorm_b = (const float*)d_in[13]; a.pool_w = (const float*)d_in[14]; a.pool_scale = (const float*)d_in[15];
    a.sinks = (const float*)d_in[16]; a.w_mod = (const float*)d_in[17]; a.b_mod = (const float*)d_in[18]; a.ln_g = (const float*)d_in[19]; a.ln_b = (const float*)d_in[20];
    a.out = (float*)d_out; a.ws = (unsigned char*)d_ws;
    for (int i = 0; i < 32; ++i) a.inv_freq[i] = (float)std::pow(10000.0, -(double)i * (2.0 / 64.0));
    if (MK_N_LAUNCHES == 1) { a.ph_lo = 0; a.ph_hi = N_PHASES; hipLaunchKernelGGL(hymba_fwd, dim3(grid), dim3(NTHR), LDS_BYTES, stream, a); }
    else for (int ph = 0; ph < N_PHASES; ++ph) {
#ifdef DBG
        if (ph >= 2 && ph < N_PHASES - 1 && (ph - 2) % 3 == 2) hipLaunchKernelGGL(dbg_copyz, dim3(DBG_NS), dim3(256), 0, stream, a);
#endif
        a.ph_lo = ph; a.ph_hi = ph + 1; hipLaunchKernelGGL(hymba_fwd, dim3(grid), dim3(NTHR), LDS_BYTES, stream, a);
#ifdef DBG
        if (ph == 0) hipLaunchKernelGGL(dbg_p0, dim3(144), dim3(256), 0, stream, a);
        else if (ph == 1) hipLaunchKernelGGL(dbg_p0b, dim3(144), dim3(256), 0, stream, a);
        else if (ph == N_PHASES - 1) { hipLaunchKernelGGL(dbg_fin, dim3(DBG_NS), dim3(256), 0, stream, a); hipLaunchKernelGGL(dbg_report, dim3(1024), dim3(256), 0, stream, a); }
        else { const int l = (ph - 2) / 3, k = (ph - 2) % 3;
            if (k == 0) hipLaunchKernelGGL(dbg_in, dim3(DBG_NS), dim3(256), 0, stream, a, l);
            if (k == 1) hipLaunchKernelGGL(dbg_mix, dim3(DBG_NS), dim3(256), 0, stream, a, l);
            if (k == 2) hipLaunchKernelGGL(dbg_out, dim3(DBG_NS), dim3(256), 0, stream, a, l); }
#endif
    }
}
```

```cpp
#include <hip/hip_runtime.h>
#include <cstdint>
#include <cstdio>
#include <cmath>

#define DBG_REPORT_ID -1
#ifndef MK_N_LAUNCHES
#define MK_N_LAUNCHES 1
#endif

#define DI __device__ __forceinline__
#define GAS __attribute__((address_space(1)))
#define LAS __attribute__((address_space(3)))
typedef unsigned short u16;
typedef _Float16 h8 __attribute__((ext_vector_type(8)));
typedef _Float16 h4 __attribute__((ext_vector_type(4)));
typedef _Float16 h2 __attribute__((ext_vector_type(2)));
typedef float f32x2 __attribute__((ext_vector_type(2)));
typedef float f32x4 __attribute__((ext_vector_type(4)));
typedef float f32x16 __attribute__((ext_vector_type(16)));
typedef unsigned u32x4 __attribute__((ext_vector_type(4)));
typedef unsigned u32x2 __attribute__((ext_vector_type(2)));
typedef short v4i16_t __attribute__((ext_vector_type(4)));

constexpr int D = 1024, DIN = 2560, NB = 4, SEQ = 4096, DEPTH = 4, DB = 128, DS = 4;
constexpr int MP = NB * SEQ, MS = DB * DS, M = MP + MS;
constexpr int NMOD = NB + DB;
constexpr int PAST = 8192;
constexpr float LN_EPS = 1e-5f;
constexpr float ALPHA = 1.681792830507429f;
constexpr float LOG2E = 1.4426950408889634f;
constexpr float QSCALE = 0.125f * LOG2E;
constexpr size_t OFF_YP = 0, OFF_YS = OFF_YP + (size_t)MP * D, OFF_CONVP = OFF_YS + (size_t)MS * D, OFF_POOLP = OFF_CONVP + (size_t)DEPTH * NB * 30 * 256,
                 OFF_KP = OFF_POOLP + (size_t)DEPTH * NB * 15 * 256, OFF_VP = OFF_KP + (size_t)DEPTH * NB * 128 * 128, OFF_CONVS = OFF_VP + (size_t)DEPTH * NB * 128 * 128,
                 OFF_POOLS = OFF_CONVS + (size_t)DEPTH * DB * 30 * 256, OFF_KS = OFF_POOLS + (size_t)DEPTH * DB * 15 * 256, OFF_VS = OFF_KS + (size_t)DEPTH * DB * 128 * 128,
                 OUT_TOTAL = OFF_VS + (size_t)DEPTH * DB * 128 * 128;
constexpr size_t MiB = 1u << 20;
constexpr size_t WS_CTL = 0, CTL_ZERO_BYTES = 64 * 1024;
constexpr size_t WS_WIN = 1 * MiB;
constexpr size_t WS_WOUT = 21 * MiB;
constexpr size_t WS_MOD = 29 * MiB;
constexpr size_t WS_TAB = 36 * MiB;
constexpr size_t WS_ZH = 38 * MiB;
constexpr size_t WS_XR = 71 * MiB;
constexpr size_t WS_MIX = 104 * MiB;
constexpr size_t WS_PA = 137 * MiB;
constexpr size_t WS_PSZC = WS_PA + (size_t)M * 256 * 2, WS_PPV = WS_PSZC + (size_t)M * 256 * 2, WS_PSZP = WS_PPV + (size_t)M * 256 * 2;
constexpr size_t WS_PQ = WS_PSZP + (size_t)M * 256 * 2;
constexpr size_t WS_PSZA = WS_PQ + (size_t)M * 512 * 2;
constexpr size_t WS_PK = WS_PSZA + (size_t)M * 512 * 2;
constexpr size_t WS_PV = WS_PK + (size_t)M * 128 * 2;
constexpr size_t WS_H = WS_PV + (size_t)M * 128 * 2;
constexpr size_t WS_PS = WS_H + (size_t)M * D * 2;
constexpr size_t WS_RC0 = WS_PS + 2 * (size_t)MP * 24 * 4;
constexpr size_t WS_MODV = WS_RC0 + (size_t)MP * 16;
constexpr size_t WS_LNC = WS_MODV + (size_t)DEPTH * NB * 4 * DIN * 4;
constexpr size_t WS_VT = WS_LNC + 256;
constexpr size_t WS_END = WS_VT + (size_t)NB * 2 * 64 * SEQ * 2;
static_assert(WS_END <= 256 * MiB, "d_ws map");
constexpr int CW_BAR = 1024;
constexpr int CW_SCNT = 12288;

DI unsigned pkh(float a, float b) { f32x2 v = {a, b}; h2 r = __builtin_convertvector(v, h2); return __builtin_bit_cast(unsigned, r); }
DI u32x4 pack8(const float* v) { u32x4 w; w.x = pkh(v[0], v[1]); w.y = pkh(v[2], v[3]); w.z = pkh(v[4], v[5]); w.w = pkh(v[6], v[7]); return w; }
DI void unpack8(u32x4 w, float* o) {
    const h8 v = __builtin_bit_cast(h8, w);
#pragma unroll
    for (int j = 0; j < 8; ++j) o[j] = (float)v[j];
}
DI float ex2(float x) { return __builtin_amdgcn_exp2f(x); }
DI float sigm(float x) { return __builtin_amdgcn_rcpf(1.f + ex2(-x * LOG2E)); }
DI float silu(float x) { return x * sigm(x); }
template <int O> DI float xor_lane(float v) {
    return __builtin_bit_cast(float, __builtin_amdgcn_ds_swizzle(__builtin_bit_cast(int, v), (O << 10) | 0x1f));
}
DI float sum_halves(float v) { float a = v, b = v; asm volatile("s_nop 1\n\tv_permlane32_swap_b32 %0, %1" : "+v"(a), "+v"(b)); return a + b; }
DI float max_halves(float v) { float a = v, b = v; asm volatile("s_nop 1\n\tv_permlane32_swap_b32 %0, %1" : "+v"(a), "+v"(b)); return fmaxf(a, b); }
DI float wave_sum(float v) { v += xor_lane<1>(v); v += xor_lane<2>(v); v += xor_lane<4>(v); v += xor_lane<8>(v); v += xor_lane<16>(v); return sum_halves(v); }
DI float wave_max(float v) { v = fmaxf(v, xor_lane<1>(v)); v = fmaxf(v, xor_lane<2>(v)); v = fmaxf(v, xor_lane<4>(v)); v = fmaxf(v, xor_lane<8>(v)); v = fmaxf(v, xor_lane<16>(v)); return max_halves(v); }
DI int lane_id() { int l_; asm volatile("v_mbcnt_lo_u32_b32 %0, -1, 0\n\tv_mbcnt_hi_u32_b32 %0, -1, %0" : "=v"(l_)); return l_; }
DI int crow(int r, int hi) { return (r & 3) + 8 * (r >> 2) + 4 * hi; }

__host__ __device__ __forceinline__ int pperm(int bj, int c7) { return 128 * bj + 32 * (c7 >> 5) + 16 * ((c7 >> 2) & 1) + 4 * ((c7 >> 3) & 3) + (c7 & 3); }
__host__ __device__ __forceinline__ int perm_in(int col) {
    if (col < 512) { const int bj = col >> 8, ch = col & 255; return 256 * (ch >> 7) + pperm(bj, ch & 127); }
    if (col < 1280) { const int base = col < 768 ? 512 : (col < 1024 ? 768 : 1024); const int x = col - base; return base + pperm(x >> 7, x & 127); }
    if (col < 1792) { const int x = col - 1280, head = x >> 6, d = x & 63; return 256 * (5 + (head >> 2)) + pperm(d >> 5, 32 * (head & 3) + (d & 31)); }
    if (col < 2048) { const int x = col - 1792, hh = x >> 6, d = x & 63; return 1792 + pperm(d >> 5, 32 * hh + (d & 31)); }
    { const int x = col - 2048; return 2048 + 256 * (x >> 8) + pperm((x >> 7) & 1, x & 127); }
}
__host__ __device__ __forceinline__ int perm_out(int col) { const int y = col & 255; return (col & ~255) + pperm(y >> 7, y & 127); }

namespace pg8 {
constexpr int BM = 256, BK = 64, HALF = 128, HTB = HALF * BK * 2, STAGE_BYTES = 8 * HTB, NXCD = 8, WGM = 8;
__host__ __device__ __forceinline__ int lds_byte(int r, int c) { const int st = (r >> 4) * 2 + (c >> 5), rr = r & 15, cc = c & 31, ob = rr * 64 + cc * 2; return st * 1024 + (ob ^ (((ob >> 9) & 1) << 5)); }
__host__ __device__ __forceinline__ void stage_rc(int b, int& R, int& C) { const int st = b / 1024, sb = b % 1024, swz = sb ^ (((sb >> 9) & 1) << 5); R = (st >> 1) * 16 + swz / 64; C = (st & 1) * 32 + (swz % 64) / 2; }
struct Unit { int pm, pn; };
struct Gemm { const u16* A; const u16* Bt; int M, N, K; };
struct StaticOrder {
    int nM, nN, nwg, G, c;
    __host__ __device__ void init(int M_, int N_, int G_, int c_) { nM = M_ / BM; nN = N_ / BM; nwg = nM * nN; G = G_; c = c_; }
    __host__ __device__ bool next(int i, Unit& u) const {
        const long L = (long)i * G + c; if (L >= nwg) return false;
        int wgid = (int)L; { const int q = nwg / NXCD, r = nwg % NXCD, xcd = wgid % NXCD, off = wgid / NXCD; wgid = (xcd < r ? xcd * (q + 1) : r * (q + 1) + (xcd - r) * q) + off; }
        const int nig = WGM * nN, gid = wgid / nig, fm = gid * WGM, gsz = (nM - fm) < WGM ? (nM - fm) : WGM;
        u.pm = fm + ((wgid % nig) % gsz); u.pn = (wgid % nig) / gsz; return true;
    }
};

template <class Epi, bool ALIGN_EPI>
DI void gemm_phase(LAS unsigned char* lds, const Gemm g, const StaticOrder& S, const Epi& E, const int tid) {
    const int wid = __builtin_amdgcn_readfirstlane(tid >> 6), lane = tid & 63, wr = wid >> 2, wc = wid & 3, fr = lane & 15, fq = lane >> 4;
    const int K = g.K, nt = K / BK;
    unsigned voffA[2];
#pragma unroll
    for (int i = 0; i < 2; ++i) { int R, C; stage_rc(tid * 16 + i * 8192, R, C); voffA[i] = (unsigned)(R * K + C) * 2u; }
    const size_t kstep = (size_t)(BK * 2);
    const size_t hstep = (size_t)HALF * K * 2;
    const size_t tstep = 2 * hstep;
    const unsigned ldsw = (unsigned)wid * 1024u;
    const int aoff = lds_byte(wr * 64 + fr, fq * 8), boff = lds_byte(wc * 32 + fr, fq * 8);
#define PG8_SA(b, h) (((b) * 2 + (h)) * HTB)
#define PG8_SB(b, h) ((4 + (b) * 2 + (h)) * HTB)
#define PG8_STAGE(bufoff, gbase) do { _Pragma("unroll") for (int _i = 0; _i < 2; ++_i) \
        __builtin_amdgcn_global_load_lds((const unsigned*)((const char*)(gbase) + voffA[_i]), (LAS unsigned*)(lds + (bufoff) + ldsw + _i * 8192), 16, 0, 0); } while (0)
#define PG8_LDA(dst, b, h) do { _Pragma("unroll") for (int m = 0; m < 4; ++m) _Pragma("unroll") for (int k = 0; k < 2; ++k) dst[m][k] = *(const LAS h8*)(lds + PG8_SA(b, h) + aoff + m * 2048 + k * 1024); } while (0)
#define PG8_LDB(dst, b, h) do { _Pragma("unroll") for (int n = 0; n < 2; ++n) _Pragma("unroll") for (int k = 0; k < 2; ++k) dst[n][k] = *(const LAS h8*)(lds + PG8_SB(b, h) + boff + n * 2048 + k * 1024); } while (0)
#define PG8_MMA(ai, bj, At, Bt) do { __builtin_amdgcn_s_setprio(1); _Pragma("unroll") for (int m = 0; m < 4; ++m) _Pragma("unroll") for (int n = 0; n < 2; ++n) _Pragma("unroll") for (int k = 0; k < 2; ++k) \
        acc[ai][bj][m][n] = __builtin_amdgcn_mfma_f32_16x16x32_f16(Bt[n][k], At[m][k], acc[ai][bj][m][n], 0, 0, 0); __builtin_amdgcn_s_setprio(0); } while (0)
#define PG8_WAIT_V(n) asm volatile("s_waitcnt vmcnt(" #n ")" ::: "memory")
#define PG8_WAIT_L(n) asm volatile("s_waitcnt lgkmcnt(" #n ")" ::: "memory")
#define PG8_BAR __builtin_amdgcn_s_barrier()
#define PG8_SCHED __builtin_amdgcn_sched_barrier(0)
    Unit cur, nxt; int ui = 0;
    if (!S.next(0, cur)) return;
    f32x4 acc[2][2][4][2];
#pragma unroll
    for (int a = 0; a < 2; ++a)
#pragma unroll
        for (int b = 0; b < 2; ++b)
#pragma unroll
            for (int m = 0; m < 4; ++m)
#pragma unroll
                for (int n = 0; n < 2; ++n) acc[a][b][m][n] = (f32x4){0.f, 0.f, 0.f, 0.f};
    h8 At[4][2], B0[2][2], B1[2][2];
    const char* cA = (const char*)g.A + (size_t)cur.pm * tstep; const char* cB = (const char*)g.Bt + (size_t)cur.pn * tstep;
    PG8_STAGE(PG8_SB(0, 0), cB); PG8_STAGE(PG8_SB(0, 1), cB + hstep); PG8_STAGE(PG8_SA(0, 0), cA); PG8_STAGE(PG8_SA(0, 1), cA + hstep);
    if (wr == 1) PG8_BAR;
    PG8_WAIT_V(2); PG8_BAR;
    PG8_STAGE(PG8_SB(1, 0), cB + kstep); PG8_STAGE(PG8_SA(1, 0), cA + kstep); PG8_STAGE(PG8_SB(1, 1), cB + hstep + kstep);
    PG8_WAIT_V(6); PG8_BAR;
    for (;;) {
        const bool has_next = S.next(ui + 1, nxt);
        const char* nA = has_next ? (const char*)g.A + (size_t)nxt.pm * tstep : cA; const char* nB = has_next ? (const char*)g.Bt + (size_t)nxt.pn * tstep : cB;
        for (int t = 0; t < nt; t += 2) {
            const bool last = (t == nt - 2);
            const char* a1 = cA + (size_t)(t + 1) * kstep;
            const char* a2 = last ? nA : cA + (size_t)(t + 2) * kstep; const char* b2 = last ? nB : cB + (size_t)(t + 2) * kstep;
            const char* a3 = a2 + kstep; const char* b3 = b2 + kstep;
            PG8_LDB(B0, 0, 0); PG8_LDB(B1, 0, 1); PG8_SCHED; PG8_LDA(At, 0, 0); PG8_STAGE(PG8_SA(1, 1), a1 + hstep);
            PG8_WAIT_V(8); PG8_WAIT_L(0); PG8_BAR; PG8_MMA(0, 0, At, B0); PG8_MMA(0, 1, At, B1); PG8_BAR; PG8_SCHED;
            PG8_LDA(At, 0, 1); PG8_STAGE(PG8_SB(0, 0), b2); PG8_STAGE(PG8_SB(0, 1), b2 + hstep); PG8_STAGE(PG8_SA(0, 0), a2);
            PG8_WAIT_V(8); PG8_WAIT_L(0); PG8_BAR; PG8_MMA(1, 0, At, B0); PG8_MMA(1, 1, At, B1); PG8_BAR; PG8_SCHED;
            PG8_LDB(B0, 1, 0); PG8_LDB(B1, 1, 1); PG8_SCHED; PG8_LDA(At, 1, 0); PG8_STAGE(PG8_SA(0, 1), a2 + hstep);
            PG8_WAIT_V(8); PG8_WAIT_L(0); PG8_BAR; PG8_MMA(0, 0, At, B0); PG8_MMA(0, 1, At, B1); PG8_BAR; PG8_SCHED;
            PG8_LDA(At, 1, 1); PG8_STAGE(PG8_SB(1, 0), b3); PG8_STAGE(PG8_SB(1, 1), b3 + hstep); PG8_STAGE(PG8_SA(1, 0), a3);
            PG8_WAIT_V(8); PG8_WAIT_L(0); PG8_BAR; PG8_MMA(1, 0, At, B0); PG8_MMA(1, 1, At, B1); PG8_BAR; PG8_SCHED;
        }
        if constexpr (ALIGN_EPI) { if (wr == 0) PG8_BAR; }
        if constexpr (!Epi::AFTER_DRAIN) E(acc, cur, ui, wr, wc, fr, fq);
        if (!has_next) break;
#pragma unroll
        for (int a = 0; a < 2; ++a)
#pragma unroll
            for (int b = 0; b < 2; ++b)
#pragma unroll
                for (int m = 0; m < 4; ++m)
#pragma unroll
                    for (int n = 0; n < 2; ++n) acc[a][b][m][n] = (f32x4){0.f, 0.f, 0.f, 0.f};
        cur = nxt; cA = nA; cB = nB; ++ui;
        if constexpr (ALIGN_EPI) { if (wr == 1) PG8_BAR; }
    }
    PG8_WAIT_V(0);
    if constexpr (!ALIGN_EPI) { if (wr == 0) PG8_BAR; }
    PG8_BAR;
    if constexpr (Epi::AFTER_DRAIN) E.fused(acc, cur, wr, wc, fr, fq, lds, tid);
#undef PG8_SA
#undef PG8_SB
#undef PG8_STAGE
#undef PG8_LDA
#undef PG8_LDB
#undef PG8_MMA
#undef PG8_WAIT_V
#undef PG8_WAIT_L
#undef PG8_BAR
#undef PG8_SCHED
}
}

struct Params {
    const float* x_prompt; const float* x_sample; const float* cache_conv; const float* cache_pool; const float* cache_k; const float* cache_v;
    const float* c_prompt; const float* c_sample; const float* w_in; const float* w_out; const float* conv_w; const float* conv_b; const float* cnorm_g; const float* cnorm_b;
    const float* pool_w; const float* pool_scale; const float* sinks; const float* w_mod; const float* b_mod; const float* ln_g; const float* ln_b;
    float* out; unsigned char* ws;
    int ph_lo, ph_hi;
    float inv_freq[32];
};
struct ParamsHead { const float* ptrs[21]; float* out; unsigned char* ws; int ph_lo, ph_hi; };
static_assert(sizeof(ParamsHead) == __builtin_offsetof(Params, inv_freq), "ParamsHead mirrors the head of Params");

DI void row_info(int row, bool& smp, int& b, int& t) { smp = row >= MP; if (!smp) { b = row >> 12; t = row & (SEQ - 1); } else { const int s = row - MP; b = s >> 2; t = s & 3; } }
DI void st8f(float* dst, const float* v) { *(f32x4*)dst = (f32x4){v[0], v[1], v[2], v[3]}; *(f32x4*)(dst + 4) = (f32x4){v[4], v[5], v[6], v[7]}; }

struct EpiIn {
    static constexpr bool AFTER_DRAIN = false;
    int l; unsigned char* ws; float* out; const LAS float* rcl;
    DI void operator()(f32x4 (&acc)[2][2][4][2], const pg8::Unit& u, int ui, int wr, int wc, int fr, int fq) const {
        asm volatile("" : "+v"(fr), "+v"(fq));
        const int pn = u.pn;
        if (u.pm < MP / 256) {
            const LAS f32x4* rc = (const LAS f32x4*)rcl + ui * 256 + wr * 64 + fr;
            const float* mv = (const float*)(ws + WS_MODV) + (size_t)(l * NB + (u.pm >> 4)) * 4 * DIN + pn * 256 + wc * 32 + 4 * fq;
#pragma unroll
            for (int bj = 0; bj < 2; ++bj)
#pragma unroll
                for (int n = 0; n < 2; ++n) { const float* mp = mv + 128 * bj + 16 * n;
                    const f32x4 v1 = *(const f32x4*)mp, v2 = *(const f32x4*)(mp + DIN), v3 = *(const f32x4*)(mp + 2 * DIN), v4 = *(const f32x4*)(mp + 3 * DIN);
#pragma unroll
                    for (int ai = 0; ai < 2; ++ai)
#pragma unroll
                        for (int m = 0; m < 4; ++m) { const f32x4 r = rc[ai * 128 + m * 16];
                            acc[ai][bj][m][n] = r[0] * acc[ai][bj][m][n] - r[1] * v1 + r[2] * v2 - r[3] * v3 + v4; } }
        }
        unsigned char* const W = ws; float* const O = out;
#define ST16(byteoff, vals) (*(u32x4*)(W + (size_t)(unsigned)(byteoff)) = pack8(vals))
#define STF8(fidx, vals) st8f(O + (size_t)(unsigned)(fidx), vals)
#pragma unroll
        for (int ai = 0; ai < 2; ++ai)
#pragma unroll
            for (int m = 0; m < 4; ++m) {
                const unsigned row = (unsigned)(u.pm * 256 + ai * 128 + wr * 64 + m * 16 + fr);
                const bool smp = row >= (unsigned)MP; const unsigned b = smp ? (row - MP) >> 2 : row >> 12, t = smp ? (row - MP) & 3u : row & (unsigned)(SEQ - 1);
                if (pn < 2) {
                    const unsigned c8 = pn * 128 + wc * 32 + fq * 8; float a[8];
#pragma unroll
                    for (int n = 0; n < 2; ++n)
#pragma unroll
                        for (int j = 0; j < 4; ++j) a[4 * n + j] = acc[ai][0][m][n][j] * sigm(acc[ai][1][m][n][j]);
                    ST16((unsigned)WS_PA + (row * 256 + c8) * 2, a);
                    if (smp) STF8((unsigned)OFF_CONVS + ((l * DB + b) * 30 + 26 + t) * 256 + c8, a);
                    else if (t >= SEQ - 30) STF8((unsigned)OFF_CONVP + ((l * NB + b) * 30 + (t - (SEQ - 30))) * 256 + c8, a);
                } else if (pn == 2 || pn == 4) {
                    const unsigned base = pn == 2 ? (unsigned)WS_PSZC : (unsigned)WS_PSZP;
#pragma unroll
                    for (int bj = 0; bj < 2; ++bj) { const unsigned c8 = bj * 128 + wc * 32 + fq * 8; float v[8];
#pragma unroll
                        for (int n = 0; n < 2; ++n)
#pragma unroll
                            for (int j = 0; j < 4; ++j) v[4 * n + j] = silu(acc[ai][bj][m][n][j]);
                        ST16(base + (row * 256 + c8) * 2, v); }
                } else if (pn == 3) {
#pragma unroll
                    for (int bj = 0; bj < 2; ++bj) { const unsigned c8 = bj * 128 + wc * 32 + fq * 8; float v[8];
#pragma unroll
                        for (int n = 0; n < 2; ++n)
#pragma unroll
                            for (int j = 0; j < 4; ++j) v[4 * n + j] = acc[ai][bj][m][n][j];
                        ST16((unsigned)WS_PPV + (row * 256 + c8) * 2, v);
                        if (smp) STF8((unsigned)OFF_POOLS + ((l * DB + b) * 15 + 11 + t) * 256 + c8, v);
                        else if (t >= SEQ - 15) STF8((unsigned)OFF_POOLP + ((l * NB + b) * 15 + (t - (SEQ - 15))) * 256 + c8, v); }
                } else if (pn >= 8) {
#pragma unroll
                    for (int bj = 0; bj < 2; ++bj) { const unsigned c8 = (pn - 8) * 256 + bj * 128 + wc * 32 + fq * 8; float v[8];
#pragma unroll
                        for (int n = 0; n < 2; ++n)
#pragma unroll
                            for (int j = 0; j < 4; ++j) v[4 * n + j] = silu(acc[ai][bj][m][n][j]);
                        ST16((unsigned)WS_PSZA + (row * 512 + c8) * 2, v); }
                } else if (pn == 7 && wc >= 2) {
                    const unsigned hv = wc - 2;
#pragma unroll
                    for (int bj = 0; bj < 2; ++bj) { const unsigned d8 = 32 * bj + 8 * fq; float v[8];
#pragma unroll
                        for (int n = 0; n < 2; ++n)
#pragma unroll
                            for (int j = 0; j < 4; ++j) v[4 * n + j] = acc[ai][bj][m][n][j];
                        ST16((unsigned)WS_PV + (row * 128 + hv * 64 + d8) * 2, v);
                        if (smp) STF8((unsigned)OFF_VS + (((l * DB + b) * 128 + 124 + t) * 2 + hv) * 64 + d8, v);
                        else if (t >= SEQ - 128) STF8((unsigned)OFF_VP + (((l * NB + b) * 128 + (t - (SEQ - 128))) * 2 + hv) * 64 + d8, v); }
                } else {
                    const unsigned d8 = 8 * fq; const unsigned pidx = smp ? SEQ + t : t;
                    const f32x4* tp = (const f32x4*)(W + (size_t)((unsigned)WS_TAB + (pidx * 32 + d8) * 8));
                    float x1[8], x2[8], o1[8], o2[8];
#pragma unroll
                    for (int n = 0; n < 2; ++n)
#pragma unroll
                        for (int j = 0; j < 4; ++j) { x1[4 * n + j] = acc[ai][0][m][n][j]; x2[4 * n + j] = acc[ai][1][m][n][j]; }
                    const float sc = pn == 7 ? 1.f : QSCALE;
#pragma unroll
                    for (int k2 = 0; k2 < 4; ++k2) { const f32x4 cs = tp[k2];
                        o1[2 * k2] = (x1[2 * k2] * cs[0] - x2[2 * k2] * cs[1]) * sc;         o2[2 * k2] = (x2[2 * k2] * cs[0] + x1[2 * k2] * cs[1]) * sc;
                        o1[2 * k2 + 1] = (x1[2 * k2 + 1] * cs[2] - x2[2 * k2 + 1] * cs[3]) * sc; o2[2 * k2 + 1] = (x2[2 * k2 + 1] * cs[2] + x1[2 * k2 + 1] * cs[3]) * sc; }
                    if (pn == 7) { const unsigned hk = wc;
                        ST16((unsigned)WS_PK + (row * 128 + hk * 64 + d8) * 2, o1); ST16((unsigned)WS_PK + (row * 128 + hk * 64 + 32 + d8) * 2, o2);
                        if (smp) { const unsigned di = (unsigned)OFF_KS + (((l * DB + b) * 128 + 124 + t) * 2 + hk) * 64 + d8; STF8(di, o1); STF8(di + 32, o2); }
                        else if (t >= SEQ - 128) { const unsigned di = (unsigned)OFF_KP + (((l * NB + b) * 128 + (t - (SEQ - 128))) * 2 + hk) * 64 + d8; STF8(di, o1); STF8(di + 32, o2); }
                    } else { const unsigned head = (pn - 5) * 4 + wc;
                        ST16((unsigned)WS_PQ + (row * 512 + head * 64 + d8) * 2, o1); ST16((unsigned)WS_PQ + (row * 512 + head * 64 + 32 + d8) * 2, o2); }
                }
            }
#undef ST16
#undef STF8
    }
};

struct EpiOutF {
    static constexpr bool AFTER_DRAIN = true;
    unsigned char* ws; int l; const float* ln_g; const float* ln_b;
    DI void operator()(f32x4 (&)[2][2][4][2], const pg8::Unit&, int, int, int, int, int) const {}
    DI void fused(f32x4 (&acc)[2][2][4][2], const pg8::Unit& u, int wr, int wc, int fr, int fq, LAS unsigned char* lds, int tid) const {
        LAS float* CV = (LAS float*)lds;
        LAS float* RS = (LAS float*)(lds + 8192);
        LAS float* PW = (LAS float*)(lds + 12288);
        u16* ZH = (u16*)(ws + WS_ZH); u16* ZP = (u16*)(ws + WS_H);
        const float* MOD = (const float*)(ws + WS_MOD); const int b = u.pm >> 4;
        const float* PSp = (const float*)(ws + WS_PS) + (size_t)((l + 1) & 1) * MP * 24; float* PSc = (float*)(ws + WS_PS) + (size_t)(l & 1) * MP * 24;
        if (tid < 256) { const int col = u.pn * 256 + tid;
            CV[tid] = l > 0 ? ln_g[(l - 1) * D + col] : 1.f; CV[256 + tid] = l > 0 ? ln_b[(l - 1) * D + col] : 0.f;
            CV[512 + tid] = MOD[((size_t)l * NMOD + b) * 3072 + 2048 + col]; CV[768 + tid] = ln_g[l * D + col]; CV[1024 + tid] = ln_b[l * D + col];
            CV[1280 + tid] = l < DEPTH - 1 ? MOD[((size_t)(l + 1) * NMOD + b) * 3072 + 1024 + col] : 0.f;
        } else { const int row = tid - 256; float mu = 0.f, rstd = 1.f;
            if (l > 0) { const float* ps = PSp + (size_t)(u.pm * 256 + row) * 24; const float s1 = (ps[0] + ps[6]) + (ps[12] + ps[18]), s2 = (ps[1] + ps[7]) + (ps[13] + ps[19]);
                mu = s1 * (1.f / D); rstd = 1.f / sqrtf(s2 * (1.f / D) - mu * mu + LN_EPS); }
            RS[2 * row] = mu; RS[2 * row + 1] = rstd; }
        __syncthreads();
#pragma unroll
        for (int ai = 0; ai < 2; ++ai) {
        u32x4 zpv[4][2];
#pragma unroll
        for (int mm = 0; mm < 4; ++mm)
#pragma unroll
            for (int bj = 0; bj < 2; ++bj) zpv[mm][bj] = *(const u32x4*)(ZH + ((size_t)u.pm * 256 + ai * 128 + wr * 64 + mm * 16 + fr) * D + u.pn * 256 + bj * 128 + wc * 32 + fq * 8);
#pragma unroll
        for (int mm = 0; mm < 4; ++mm) { const int m = mm;
            const int rt = ai * 128 + wr * 64 + m * 16 + fr; const size_t row = (size_t)u.pm * 256 + rt;
            const float mu = RS[2 * rt], rstd = RS[2 * rt + 1];
            float s1 = 0.f, s2 = 0.f, s3 = 0.f, s4 = 0.f, s5 = 0.f, s6 = 0.f;
#pragma unroll
            for (int bj = 0; bj < 2; ++bj) { const int cl = bj * 128 + wc * 32 + fq * 8; const size_t off = row * D + u.pn * 256 + cl;
                float zp[8], zq[8], zo[8]; unpack8(zpv[mm][bj], zp);
#pragma unroll
                for (int hh = 0; hh < 2; ++hh) {
                    const f32x4 gp = *(const LAS f32x4*)(CV + cl + 4 * hh), bp = *(const LAS f32x4*)(CV + 256 + cl + 4 * hh), gt = *(const LAS f32x4*)(CV + 512 + cl + 4 * hh),
                                gg = *(const LAS f32x4*)(CV + 768 + cl + 4 * hh), bb = *(const LAS f32x4*)(CV + 1024 + cl + 4 * hh), sn = *(const LAS f32x4*)(CV + 1280 + cl + 4 * hh);
                    const f32x4 av = acc[ai][bj][m][hh];
#pragma unroll
                    for (int j = 0; j < 4; ++j) { const int k = 4 * hh + j;
                        const float x1 = l > 0 ? (zp[k] - mu) * rstd * gp[j] + bp[j] : zp[k];
                        const float z = ALPHA * x1 + (1.f + gt[j]) * av[j], uu = z * gg[j];
                        s1 += z; s2 += z * z; s3 += uu; s4 += uu * uu; s5 += uu * gg[j]; s6 += uu * bb[j];
                        zq[k] = z; zo[k] = uu * (1.f + sn[j]); } }
                *(u32x4*)(ZH + off) = pack8(zq);
                if (l < DEPTH - 1) *(u32x4*)(ZP + off) = pack8(zo); }
            s1 = sum_halves(s1 + xor_lane<16>(s1)); s2 = sum_halves(s2 + xor_lane<16>(s2)); s3 = sum_halves(s3 + xor_lane<16>(s3)); s4 = sum_halves(s4 + xor_lane<16>(s4)); s5 = sum_halves(s5 + xor_lane<16>(s5)); s6 = sum_halves(s6 + xor_lane<16>(s6));
            if (fq == 0) { LAS float* pw = PW + (rt * 4 + wc) * 6; pw[0] = s1; pw[1] = s2; pw[2] = s3; pw[3] = s4; pw[4] = s5; pw[5] = s6; } }
        asm volatile("" ::: "memory"); }
        __syncthreads();
        if (tid < 256 && l < DEPTH - 1) { float* ps = PSc + (size_t)(u.pm * 256 + tid) * 24 + u.pn * 6; const LAS float* pw = PW + tid * 24;
#pragma unroll
            for (int k = 0; k < 6; ++k) ps[k] = (pw[k] + pw[6 + k]) + (pw[12 + k] + pw[18 + k]); }
    }
};

#define XB_TMO      128
#define XB_XCNT(j)  (256  + 64 * (j))
#define XB_XSUB(j)  (1280 + 64 * (j))
#define XB_XGEN(j)  (2304 + 64 * (j))
#define XB_TOP      3328
#define XB_TOPGEN   3392
#define XCD_BAR_WORDS 3456
#define XB_SPIN_CAP (1u << 18)
DI unsigned xb_ld(unsigned* p)              { return __hip_atomic_load(p, __ATOMIC_RELAXED, __HIP_MEMORY_SCOPE_AGENT); }
DI unsigned xb_add(unsigned* p, unsigned v) { return __hip_atomic_fetch_add(p, v, __ATOMIC_RELAXED, __HIP_MEMORY_SCOPE_AGENT); }
DI unsigned xb_xcc_id() { return (unsigned)__builtin_amdgcn_s_getreg((3 << 11) | 20) & 0xFu; }
#define XB_SPIN(cond, bar) do { unsigned _sp = 0; while (cond) { __builtin_amdgcn_s_sleep(1); \
    if ((++_sp & 255u) == 0u) { if (xb_ld(&(bar)[XB_TMO])) break; if (_sp > XB_SPIN_CAP) { atomicAdd(&(bar)[XB_TMO], 1u); break; } } } } while (0)
struct XcdBarrier { unsigned* bar; unsigned x; volatile LAS unsigned* st; };
DI XcdBarrier xcd_barrier_post(unsigned* bar, volatile LAS unsigned* st) {
    XcdBarrier b; b.bar = bar; b.x = xb_xcc_id(); b.st = st;
    if (threadIdx.x == 0) (void)xb_add(&bar[XB_XCNT(b.x)], 1u);
    return b;
}
DI void xcd_barrier_complete(unsigned* bar, unsigned x, unsigned& nloc, unsigned& nx) {
    const unsigned G = gridDim.x * gridDim.y * gridDim.z;
    unsigned sum, cnt, mine, sp = 0u;
    for (;;) {
        sum = 0u; cnt = 0u; mine = 0u;
#pragma unroll
        for (unsigned j = 0; j < 16; ++j) { const unsigned c = xb_ld(&bar[XB_XCNT(j)]); sum += c; cnt += (c > 0u) ? 1u : 0u; mine = (j == x) ? c : mine; }
        if (sum == G) break;
        __builtin_amdgcn_s_sleep(1);
        if ((++sp & 255u) == 0u) { if (xb_ld(&bar[XB_TMO])) break; if (sp > XB_SPIN_CAP) { atomicAdd(&bar[XB_TMO], 1u); break; } }
    }
    nloc = mine > 0u ? mine : 1u; nx = cnt > 0u ? cnt : 1u;
}
DI void xcd_barrier(const XcdBarrier& b, const int wave_s) {
    asm volatile("s_waitcnt vmcnt(0)" ::: "memory");
    __syncthreads();
    if (wave_s == 0 && lane_id() == 0) {
        unsigned* bar = b.bar;
        __builtin_amdgcn_s_waitcnt(0);
        unsigned nloc = b.st[0], nx = b.st[1];
        if (nloc == 0u) { xcd_barrier_complete(bar, b.x, nloc, nx); b.st[0] = nloc; b.st[1] = nx; }
        const unsigned old = xb_add(&bar[XB_XSUB(b.x)], 1u);
        const unsigned gen = old / nloc;
        if (old + 1u == (gen + 1u) * nloc) {
            __builtin_amdgcn_fence(__ATOMIC_RELEASE, "agent");
            asm volatile("s_waitcnt vmcnt(0)" ::: "memory");
            const unsigned og = xb_add(&bar[XB_TOP], 1u);
            const unsigned tg = og / nx;
            if (og + 1u == (tg + 1u) * nx) xb_add(&bar[XB_TOPGEN], 1u);
            else XB_SPIN(xb_ld(&bar[XB_TOPGEN]) == tg, bar);
            __builtin_amdgcn_fence(__ATOMIC_ACQUIRE, "agent");
            xb_add(&bar[XB_XGEN(b.x)], 1u);
            asm volatile("s_waitcnt vmcnt(0)" ::: "memory");
        } else {
            XB_SPIN(xb_ld(&bar[XB_XGEN(b.x)]) == gen, bar);
            __builtin_amdgcn_fence(__ATOMIC_ACQUIRE, "agent");
            asm volatile("s_waitcnt vmcnt(0)" ::: "memory");
        }
    }
    __syncthreads();
}

constexpr int NWAVES = 8, NTHR = 512;
constexpr int LDS_BYTES = 147456;
constexpr int RING_BYTES = 131072, MISC_OFF = RING_BYTES + 320;

DI void p0_transpose_item(const float* W, int K, int N, u16* WT, LAS float* scr, int item, int lane, bool isin) {
    const int nblk = N / 32, kb = item / nblk, nb = item % nblk, k0 = 64 * kb, n0 = 32 * nb;
#pragma unroll 8
    for (int i = 0; i < 32; ++i) { const int kk = 2 * i + (lane >> 5); scr[kk * 33 + (lane & 31)] = W[(size_t)(k0 + kk) * N + n0 + (lane & 31)]; }
    asm volatile("s_waitcnt lgkmcnt(0)" ::: "memory");
    const int c = lane & 7;
#pragma unroll
    for (int j = 0; j < 4; ++j) { const int n = (lane >> 3) + 8 * j; const LAS float* s = scr + (8 * c) * 33 + n;
        u32x4 o; o.x = pkh(s[0 * 33], s[1 * 33]); o.y = pkh(s[2 * 33], s[3 * 33]); o.z = pkh(s[4 * 33], s[5 * 33]); o.w = pkh(s[6 * 33], s[7 * 33]);
        const int dst = isin ? perm_in(n0 + n) : perm_out(n0 + n);
        *(u32x4*)(WT + (size_t)dst * K + k0 + 8 * c) = o; }
    asm volatile("s_waitcnt lgkmcnt(0)" ::: "memory");
}
DI void mod_unit(const Params& p, LAS unsigned char* lds, int unit, int tid, int lane, int wave) {
    const int l = unit >> 6, n0 = (unit & 63) * 48;
    const float* W = p.w_mod + (size_t)l * D * 3072;
    float* MOD = (float*)(p.ws + WS_MOD);
    const int fr = lane & 15, fq = lane >> 4;
    f32x4 acc[9][3];
#pragma unroll
    for (int rt = 0; rt < 9; ++rt)
#pragma unroll
        for (int ct = 0; ct < 3; ++ct) acc[rt][ct] = (f32x4){0.f, 0.f, 0.f, 0.f};
    for (int ks = 0; ks < 4; ++ks) {
        const int k0 = wave * 128 + ks * 32 + fq * 8;
        h8 bfr[3];
#pragma unroll
        for (int ct = 0; ct < 3; ++ct) { const float* wp = W + (size_t)k0 * 3072 + n0 + 16 * ct + fr;
#pragma unroll
            for (int j = 0; j < 8; ++j) bfr[ct][j] = (_Float16)wp[(size_t)j * 3072]; }
#pragma unroll
        for (int rt = 0; rt < 9; ++rt) { const int row = 16 * rt + fr; h8 a;
            if (row < NMOD) { const float* c = row < NB ? p.c_prompt + (size_t)row * D : p.c_sample + (size_t)(row - NB) * D;
                const f32x4 c0 = *(const f32x4*)(c + k0), c1 = *(const f32x4*)(c + k0 + 4);
#pragma unroll
                for (int j = 0; j < 4; ++j) { a[j] = (_Float16)silu(c0[j]); a[4 + j] = (_Float16)silu(c1[j]); } }
            else {
#pragma unroll
                for (int j = 0; j < 8; ++j) a[j] = (_Float16)0.f; }
#pragma unroll
            for (int ct = 0; ct < 3; ++ct) acc[rt][ct] = __builtin_amdgcn_mfma_f32_16x16x32_f16(a, bfr[ct], acc[rt][ct], 0, 0, 0); }
    }
    LAS float* part = (LAS float*)lds;
#pragma unroll
    for (int rg = 0; rg < 3; ++rg) {
        __syncthreads();
#pragma unroll
        for (int r3 = 0; r3 < 3; ++r3)
#pragma unroll
            for (int ct = 0; ct < 3; ++ct)
#pragma unroll
                for (int i = 0; i < 4; ++i) part[(wave * 48 + r3 * 16 + 4 * fq + i) * 48 + 16 * ct + fr] = acc[rg * 3 + r3][ct][i];
        __syncthreads();
        for (int o = tid; o < 48 * 48; o += NTHR) { const int r48 = o / 48, col = o % 48, row = 48 * rg + r48; float sacc = 0.f;
#pragma unroll
            for (int w = 0; w < 8; ++w) sacc += part[(w * 48 + r48) * 48 + col];
            if (row < NMOD) MOD[((size_t)l * NMOD + row) * 3072 + n0 + col] = sacc + p.b_mod[(size_t)l * 3072 + n0 + col]; }
    }
    __syncthreads();
}
DI void sincos_d(double a, float& c, float& s) {
    const double k = __builtin_rint(a * 0.63661977236758134308);
    const double r = __builtin_fma(-k, 1.2246467991473532e-16 * 0.5, __builtin_fma(-k, 1.5707963267948966, a));
    const double r2 = r * r;
    double sp = -1.0 / 6227020800.0; sp = sp * r2 + 1.0 / 39916800.0; sp = sp * r2 - 1.0 / 362880.0; sp = sp * r2 + 1.0 / 5040.0; sp = sp * r2 - 1.0 / 120.0; sp = sp * r2 + 1.0 / 6.0;
    const double sn = r - r * r2 * sp;
    double cp = 1.0 / 87178291200.0; cp = cp * r2 - 1.0 / 479001600.0; cp = cp * r2 + 1.0 / 3628800.0; cp = cp * r2 - 1.0 / 40320.0; cp = cp * r2 + 1.0 / 720.0; cp = cp * r2 - 1.0 / 24.0; cp = cp * r2 + 0.5;
    const double cn = 1.0 - r2 * cp;
    const long long q = (long long)k & 3;
    const double cc = (q == 0) ? cn : (q == 1) ? -sn : (q == 2) ? -cn : sn;
    const double ss = (q == 0) ? sn : (q == 1) ? cn : (q == 2) ? -sn : -cn;
    c = (float)cc; s = (float)ss;
}
DI void p0_prologue(const Params& p, const __attribute__((address_space(4))) float* invf, LAS unsigned char* lds, int vcu, int G, int tid, int lane, int wave) {
    for (int u = vcu; u < 256; u += G) mod_unit(p, lds, u, tid, lane, wave);
    LAS float* scr = (LAS float*)(lds + wave * 16384);
    const int gw = vcu * NWAVES + wave, NGW = G * NWAVES;
    constexpr int I_IN = (D / 64) * (DIN / 32), I_OUT = (D / 64) * (D / 32);
    for (int it = gw; it < DEPTH * (I_IN + I_OUT); it += NGW) {
        const int l = it / (I_IN + I_OUT), r = it % (I_IN + I_OUT);
        if (r < I_IN) p0_transpose_item(p.w_in + (size_t)l * D * DIN, D, DIN, (u16*)(p.ws + WS_WIN) + (size_t)l * DIN * D, scr, r, lane, true);
        else p0_transpose_item(p.w_out + (size_t)l * D * D, D, D, (u16*)(p.ws + WS_WOUT) + (size_t)l * D * D, scr, r - I_IN, lane, false);
    }
    if (vcu == 0 && wave < DEPTH) {
        float a = 0.f, b2 = 0.f, c2 = 0.f, d = 0.f, e = 0.f;
        for (int c = lane; c < D; c += 64) { const float g = p.ln_g[wave * D + c], bb = p.ln_b[wave * D + c]; a += g; b2 += g * g; c2 += g * bb; d += bb; e += bb * bb; }
        a = wave_sum(a); b2 = wave_sum(b2); c2 = wave_sum(c2); d = wave_sum(d); e = wave_sum(e);
        if (lane == 0) { float* o = (float*)(p.ws + WS_LNC) + wave * 8; o[0] = a; o[1] = b2; o[2] = c2; o[3] = d; o[4] = e; } }
    f32x2* tab = (f32x2*)(p.ws + WS_TAB);
    for (int e = vcu * NTHR + tid; e < (SEQ + DS) * 32; e += G * NTHR) {
        const int pi = e >> 5, i = e & 31; const int pos = pi < SEQ ? pi : PAST + (pi - SEQ);
        const float ang = (float)pos * invf[i];
        float c, s; sincos_d((double)ang, c, s);
        tab[e] = (f32x2){c, s};
    }
}

template <int R>
DI void ln_stats(float (&v)[R][16], float (&mean)[R], float (&rstd)[R]) {
    float s[R];
#pragma unroll
    for (int r = 0; r < R; ++r) { s[r] = 0.f;
#pragma unroll
        for (int k = 0; k < 16; ++k) s[r] += v[r][k]; }
#pragma unroll
    for (int r = 0; r < R; ++r) s[r] = wave_sum(s[r]);
#pragma unroll
    for (int r = 0; r < R; ++r) { mean[r] = s[r] * (1.f / D); s[r] = 0.f;
#pragma unroll
        for (int k = 0; k < 16; ++k) { v[r][k] -= mean[r]; s[r] += v[r][k] * v[r][k]; } }
#pragma unroll
    for (int r = 0; r < R; ++r) s[r] = wave_sum(s[r]);
#pragma unroll
    for (int r = 0; r < R; ++r) rstd[r] = 1.f / sqrtf(s[r] * (1.f / D) + LN_EPS);
}
constexpr int LNR = 3;
DI void pre_phase(const Params& p, int gw, int NGW, int lane) {
    const float* modl = (const float*)(p.ws + WS_MOD);
    u16* ZH = (u16*)(p.ws + WS_ZH); u16* XR = (u16*)(p.ws + WS_XR); u16* ZP = (u16*)(p.ws + WS_H); f32x4* RC0 = (f32x4*)(p.ws + WS_RC0);
    for (int row0 = gw; row0 < M; row0 += LNR * NGW) {
        float v[LNR][16]; bool ok[LNR]; float mean[LNR], rstd[LNR]; int rows[LNR];
#pragma unroll
        for (int r = 0; r < LNR; ++r) { rows[r] = row0 + r * NGW; ok[r] = rows[r] < M; if (!ok[r]) rows[r] = row0; }
#pragma unroll
        for (int r = 0; r < LNR; ++r) { const int row = rows[r]; const float* x = row < MP ? p.x_prompt + (size_t)row * D : p.x_sample + (size_t)(row - MP) * D;
#pragma unroll
            for (int j2 = 0; j2 < 2; ++j2) { const f32x4 a = *(const f32x4*)(x + 512 * j2 + 8 * lane), b = *(const f32x4*)(x + 512 * j2 + 8 * lane + 4);
#pragma unroll
                for (int k = 0; k < 4; ++k) { v[r][8 * j2 + k] = a[k]; v[r][8 * j2 + 4 + k] = b[k]; } } }
#pragma unroll
        for (int r = 0; r < LNR; ++r) if (ok[r]) { u16* dst = rows[r] < MP ? ZH : XR;
#pragma unroll
            for (int j2 = 0; j2 < 2; ++j2) *(u32x4*)(dst + (size_t)rows[r] * D + 512 * j2 + 8 * lane) = pack8(v[r] + 8 * j2); }
        ln_stats<LNR>(v, mean, rstd);
#pragma unroll
        for (int r = 0; r < LNR; ++r) if (ok[r]) { const int row = rows[r]; const bool smp = row >= MP; const int bidx = smp ? NB + ((row - MP) >> 2) : (row >> 12);
            const float* sh = modl + (size_t)bidx * 3072; const float* sc = sh + 1024;
            if (!smp && lane == 0) RC0[row] = (f32x4){rstd[r], 0.f, rstd[r], rstd[r] * mean[r]};
#pragma unroll
            for (int j2 = 0; j2 < 2; ++j2) { float o[8];
#pragma unroll
                for (int h = 0; h < 2; ++h) { const f32x4 a = *(const f32x4*)(sc + 512 * j2 + 8 * lane + 4 * h), bb = *(const f32x4*)(sh + 512 * j2 + 8 * lane + 4 * h);
#pragma unroll
                    for (int k = 0; k < 4; ++k) o[4 * h + k] = smp ? v[r][8 * j2 + 4 * h + k] * rstd[r] * (1.f + a[k]) + bb[k] : (v[r][8 * j2 + 4 * h + k] + mean[r]) * (1.f + a[k]); }
                *(u32x4*)(ZP + (size_t)row * D + 512 * j2 + 8 * lane) = pack8(o); } }
    }
}
DI void modv_unit(const Params& p, LAS unsigned char* lds, int unit, int tid, int lane, int wave) {
    const int l = unit / 40, cb = unit % 40, col = 64 * cb + lane;
    const float* W = p.w_in + (size_t)l * D * DIN + col; const float* modl = (const float*)(p.ws + WS_MOD) + (size_t)l * NMOD * 3072;
    LAS float* part = (LAS float*)lds;
    LAS float* cf = (LAS float*)(lds + 32768) + wave * 128 * 12;
    __syncthreads();
#pragma unroll
    for (int hlf = 0; hlf < 2; ++hlf) { const int ci = 64 * hlf + lane, c = wave * 128 + ci; LAS float* o = cf + ci * 12;
        o[0] = l > 0 ? p.ln_g[(l - 1) * D + c] : 1.f; o[1] = l > 0 ? p.ln_b[(l - 1) * D + c] : 0.f;
#pragma unroll
        for (int b = 0; b < 4; ++b) { o[2 + b] = 1.f + modl[b * 3072 + 1024 + c]; o[6 + b] = modl[b * 3072 + c]; } }
    asm volatile("s_waitcnt lgkmcnt(0)" ::: "memory");
    float acc[4][4];
#pragma unroll
    for (int b = 0; b < 4; ++b)
#pragma unroll
        for (int k = 0; k < 4; ++k) acc[b][k] = 0.f;
#pragma unroll 1
    for (int c0 = 0; c0 < 128; c0 += 32) { float wv[32];
#pragma unroll
        for (int i = 0; i < 32; ++i) wv[i] = W[(size_t)(wave * 128 + c0 + i) * DIN];
#pragma unroll
        for (int i = 0; i < 32; ++i) { const LAS f32x4* cp = (const LAS f32x4*)(cf + (c0 + i) * 12); const f32x4 q0 = cp[0], q1 = cp[1], q2 = cp[2];
            const float g = q0[0], bb = q0[1]; const float s1[4] = {q0[2], q0[3], q1[0], q1[1]}; const float sh[4] = {q1[2], q1[3], q2[0], q2[1]};
#pragma unroll
            for (int b = 0; b < 4; ++b) { const float sw = s1[b] * wv[i]; acc[b][0] += g * sw; acc[b][1] += bb * sw; acc[b][2] += sw; acc[b][3] += sh[b] * wv[i]; } } }
#pragma unroll
    for (int b = 0; b < 4; ++b)
#pragma unroll
        for (int k = 0; k < 4; ++k) part[(wave * 16 + b * 4 + k) * 64 + lane] = acc[b][k];
    __syncthreads();
    float* MODV = (float*)(p.ws + WS_MODV);
    for (int o = tid; o < 1024; o += NTHR) { const int idx = o >> 6, ln = o & 63; float sum = 0.f;
#pragma unroll
        for (int w = 0; w < 8; ++w) sum += part[(w * 16 + idx) * 64 + ln];
        MODV[((size_t)(l * NB + (idx >> 2)) * 4 + (idx & 3)) * DIN + perm_in(64 * cb + ln)] = sum; }
    __syncthreads();
}
DI void finalize_rc_in(const Params& p, int l, int pm, LAS float* dst, int tid) {
    if (tid < 256) { const size_t row = (size_t)pm * 256 + tid; f32x4 rc;
        if (l == 0) rc = ((const f32x4*)(p.ws + WS_RC0))[row];
        else { const float* ps = (const float*)(p.ws + WS_PS) + (size_t)((l - 1) & 1) * MP * 24 + row * 24; const float* lnc = (const float*)(p.ws + WS_LNC) + (l - 1) * 8;
            float S[6];
#pragma unroll
            for (int k = 0; k < 6; ++k) S[k] = (ps[k] + ps[6 + k]) + (ps[12 + k] + ps[18 + k]);
            float N1 = 1.f / D, two = 2.f; asm volatile("" : "+v"(N1), "+v"(two));
            const float mu = S[0] * N1, rstd = 1.f / sqrtf(S[1] * N1 - mu * mu + LN_EPS);
            const float m2 = (rstd * (S[2] - mu * lnc[0]) + lnc[3]) * N1;
            const float e2 = (rstd * rstd * (S[3] - two * mu * S[4] + mu * mu * lnc[1]) + two * rstd * (S[5] - mu * lnc[2]) + lnc[4]) * N1;
            const float rstd2 = 1.f / sqrtf(e2 - m2 * m2 + LN_EPS);
            rc = (f32x4){rstd * rstd2, rstd * rstd2 * mu, rstd2, rstd2 * m2}; }
        *(LAS f32x4*)(dst + 4 * tid) = rc; }
}
DI void fin_phase(const Params& p, int gw, int NGW, int lane) {
    const u16* ZH = (const u16*)(p.ws + WS_ZH);
    const float* lg = p.ln_g + (size_t)(DEPTH - 1) * D; const float* lb = p.ln_b + (size_t)(DEPTH - 1) * D;
    for (int row0 = gw; row0 < MP; row0 += LNR * NGW) {
        float v[LNR][16]; bool ok[LNR]; float mean[LNR], rstd[LNR]; int rows[LNR];
#pragma unroll
        for (int r = 0; r < LNR; ++r) { rows[r] = row0 + r * NGW; ok[r] = rows[r] < MP; if (!ok[r]) rows[r] = row0; }
#pragma unroll
        for (int r = 0; r < LNR; ++r)
#pragma unroll
            for (int j2 = 0; j2 < 2; ++j2) unpack8(*(const u32x4*)(ZH + (size_t)rows[r] * D + 512 * j2 + 8 * lane), v[r] + 8 * j2);
        ln_stats<LNR>(v, mean, rstd);
#pragma unroll
        for (int j2 = 0; j2 < 2; ++j2)
#pragma unroll
            for (int h = 0; h < 2; ++h) { const f32x4 g = *(const f32x4*)(lg + 512 * j2 + 8 * lane + 4 * h), bb = *(const f32x4*)(lb + 512 * j2 + 8 * lane + 4 * h);
#pragma unroll
                for (int r = 0; r < LNR; ++r) if (ok[r]) { f32x4 o;
#pragma unroll
                    for (int k = 0; k < 4; ++k) o[k] = v[r][8 * j2 + 4 * h + k] * rstd[r] * g[k] + bb[k];
                    *(f32x4*)(p.out + (size_t)rows[r] * D + 512 * j2 + 8 * lane + 4 * h) = o; } }
    }
}

struct MixPtrs { const u16 *PA, *PSZC, *PPV, *PSZP, *PQ, *PSZA, *PK, *PV; u16* MIX; };
DI v4i16_t ds_tr(const LAS unsigned char* a) { return __builtin_amdgcn_ds_read_tr16_b64_v4i16((LAS v4i16_t*)a); }

DI void attn_prompt_unit(const Params& p, const MixPtrs& X, int l, int unit, LAS unsigned char* lds, int tid, int lane, int wave) {
    const int xg = unit >> 5, b = xg >> 1, hk = (unit >> 4) & 1, nb = (xg & 1) * 16 + (unit & 15), q0 = nb * 128; const size_t rb = (size_t)b * SEQ;
    LAS unsigned char* Ks = lds; LAS unsigned char* Vs = lds + 36864;
    const int g = wave & 3, qh = wave >> 2, head = 4 * hk + g, r = lane & 31, h = lane >> 5;
    h8 qfA[4], qfB[4]; u32x2 zgA[2][4], zgB[2][4];
    { const size_t qr0 = rb + q0 + 64 * qh + r, qr1 = qr0 + 32;
#pragma unroll
      for (int s = 0; s < 4; ++s) { qfA[s] = *(const h8*)(X.PQ + qr0 * 512 + head * 64 + 16 * s + 8 * h); qfB[s] = *(const h8*)(X.PQ + qr1 * 512 + head * 64 + 16 * s + 8 * h); }
#pragma unroll
      for (int db = 0; db < 2; ++db)
#pragma unroll
          for (int xq = 0; xq < 4; ++xq) { const int col = head * 64 + 32 * db + 8 * xq + 4 * h; zgA[db][xq] = *(const u32x2*)(X.PSZA + qr0 * 512 + col); zgB[db][xq] = *(const u32x2*)(X.PSZA + qr1 * 512 + col); } }
#pragma unroll
    for (int i = 0; i < 4; ++i) { const int c = tid + 512 * i, key = c >> 3, ch = c & 7, tk = q0 - 128 + key;
        if (tk >= 0) { const u32x4 kv = *(const u32x4*)(X.PK + (rb + tk) * 128 + hk * 64 + ch * 8), vv = *(const u32x4*)(X.PV + (rb + tk) * 128 + hk * 64 + ch * 8);
            *(LAS u32x4*)(Ks + key * 144 + ch * 16) = kv; *(LAS u32x4*)(Vs + (ch >> 2) * 16384 + key * 64 + (ch & 3) * 16) = vv; } }
    __syncthreads();
    const float sink2 = p.sinks[l * 8 + head] * LOG2E;
    const int trq = (lane & 15) >> 2, trp = lane & 3, trg = (lane >> 4) & 1;
    const float NEG = -INFINITY;
    auto half = [&](const h8 (&qf)[4], const u32x2 (&zg)[2][4], const int e) {
        const int ql = 64 * qh + 32 * e; const size_t qrow = rb + q0 + ql + r;
        f32x16 S[5];
#pragma unroll
        for (int i = 0; i < 5; ++i) { const int kl = ql + 32 * i; const bool valid = (nb > 0) || (kl >= 128);
#pragma unroll
            for (int x = 0; x < 16; ++x) S[i][x] = 0.f;
            if (valid) {
#pragma unroll
                for (int s = 0; s < 4; ++s) { const h8 kf = *(const LAS h8*)(Ks + (kl + r) * 144 + (16 * s + 8 * h) * 2); S[i] = __builtin_amdgcn_mfma_f32_32x32x16_f16(kf, qf[s], S[i], 0, 0, 0); }
            } else {
#pragma unroll
                for (int x = 0; x < 16; ++x) S[i][x] = NEG; }
            if (i == 0) {
#pragma unroll
                for (int x = 0; x < 16; ++x) if (!(crow(x, h) > r)) S[i][x] = NEG; }
            if (i == 4) {
#pragma unroll
                for (int x = 0; x < 16; ++x) if (!(crow(x, h) <= r)) S[i][x] = NEG; }
        }
        float mx = sink2;
#pragma unroll
        for (int i = 0; i < 5; ++i)
#pragma unroll
            for (int x = 0; x < 16; ++x) mx = fmaxf(mx, S[i][x]);
        mx = max_halves(mx);
        float sum = 0.f;
#pragma unroll
        for (int i = 0; i < 5; ++i)
#pragma unroll
            for (int x = 0; x < 16; ++x) { S[i][x] = ex2(S[i][x] - mx); sum += S[i][x]; }
        sum = sum_halves(sum);
        const float inv = 1.f / (sum + ex2(sink2 - mx));
        f32x16 O[2];
#pragma unroll
        for (int x = 0; x < 16; ++x) { O[0][x] = 0.f; O[1][x] = 0.f; }
#pragma unroll
        for (int i = 0; i < 5; ++i) { const int kl = ql + 32 * i; const bool valid = (nb > 0) || (kl >= 128);
            if (valid) {
#pragma unroll
                for (int s2 = 0; s2 < 2; ++s2) { float pv8[8];
#pragma unroll
                    for (int j = 0; j < 8; ++j) pv8[j] = S[i][8 * s2 + j] * inv;
                    const h8 pa = __builtin_bit_cast(h8, pack8(pv8));
#pragma unroll
                    for (int db = 0; db < 2; ++db) { const LAS unsigned char* va = Vs + db * 16384 + (kl + 16 * s2 + 4 * h + trq) * 64 + trg * 32 + trp * 8;
                        const v4i16_t lo = ds_tr(va), hi = ds_tr(va + 512);
                        const h8 vf = __builtin_bit_cast(h8, __builtin_shufflevector(lo, hi, 0, 1, 2, 3, 4, 5, 6, 7));
                        O[db] = __builtin_amdgcn_mfma_f32_32x32x16_f16(vf, pa, O[db], 0, 0, 0); } } } }
#pragma unroll
        for (int db = 0; db < 2; ++db)
#pragma unroll
            for (int xq = 0; xq < 4; ++xq) { const int col = head * 64 + 32 * db + 8 * xq + 4 * h; const h4 z = __builtin_bit_cast(h4, zg[db][xq]);
                u32x2 w; w.x = pkh(O[db][4 * xq] * (float)z[0], O[db][4 * xq + 1] * (float)z[1]); w.y = pkh(O[db][4 * xq + 2] * (float)z[2], O[db][4 * xq + 3] * (float)z[3]);
                *(u32x2*)(X.MIX + qrow * D + 512 + col) = w; }
    };
    half(qfA, zgA, 0);
    half(qfB, zgB, 1);
    __syncthreads();
}

DI void conv_prompt_unit(const Params& p, const MixPtrs& X, int l, int unit, LAS unsigned char* lds, int tid, int lane, int wave) {
    const int R0 = unit * 64, b = R0 >> 12, t0 = R0 & (SEQ - 1); const size_t rb = (size_t)b * SEQ;
    LAS unsigned char* WL = lds + 94 * 512;
    for (int c = tid; c < 94 * 32; c += NTHR) { const int row = c >> 5, ch = c & 31, tk = t0 - 30 + row; u32x4 v = (u32x4){0u, 0u, 0u, 0u};
        if (tk >= 0) v = *(const u32x4*)(X.PA + (rb + tk) * 256 + ch * 8);
        *(LAS u32x4*)(lds + row * 512 + ch * 16) = v; }
    for (int c = tid; c < 31 * 64; c += NTHR) *(LAS f32x4*)(WL + c * 16) = *(const f32x4*)(p.conv_w + (size_t)l * 31 * 256 + 4 * c);
    const f32x4 bias = *(const f32x4*)(p.conv_b + l * 256 + 4 * lane), cg = *(const f32x4*)(p.cnorm_g + l * 256 + 4 * lane), cb = *(const f32x4*)(p.cnorm_b + l * 256 + 4 * lane);
    u32x2 zcv[8];
#pragma unroll
    for (int tt = 0; tt < 8; ++tt) zcv[tt] = *(const u32x2*)(X.PSZC + ((size_t)R0 + 8 * wave + tt) * 256 + 4 * lane);
    __syncthreads();
    f32x4 acc[8], win[8];
#pragma unroll
    for (int tt = 0; tt < 8; ++tt) acc[tt] = bias;
    const LAS unsigned char* arow = lds + (8 * wave) * 512 + lane * 8;
#pragma unroll
    for (int k = 0; k < 7; ++k) win[k] = __builtin_convertvector(*(const LAS h4*)(arow + k * 512), f32x4);
#pragma unroll 1
    for (int jb = 0; jb < 4; ++jb) {
#pragma unroll
        for (int jj = 0; jj < 8; ++jj) { const int j = 8 * jb + jj;
            if (j < 31) {
                win[(jj + 7) & 7] = __builtin_convertvector(*(const LAS h4*)(arow + (j + 7) * 512), f32x4);
                const f32x4 w = *(const LAS f32x4*)(WL + j * 1024 + lane * 16);
#pragma unroll
                for (int tt = 0; tt < 8; ++tt) acc[tt] += w * win[(jj + tt) & 7]; } } }
#pragma unroll
    for (int tt = 0; tt < 8; ++tt) { const size_t row = (size_t)R0 + 8 * wave + tt;
        const float mean = wave_sum((acc[tt][0] + acc[tt][1]) + (acc[tt][2] + acc[tt][3])) * (1.f / 256.f);
        const f32x4 d = acc[tt] - mean;
        const float rstd = 1.f / sqrtf(wave_sum((d[0] * d[0] + d[1] * d[1]) + (d[2] * d[2] + d[3] * d[3])) * (1.f / 256.f) + LN_EPS);
        const h4 zc = __builtin_bit_cast(h4, zcv[tt]); float o[4];
#pragma unroll
        for (int k = 0; k < 4; ++k) o[k] = silu(d[k] * rstd * cg[k] + cb[k]) * (float)zc[k];
        u32x2 w; w.x = pkh(o[0], o[1]); w.y = pkh(o[2], o[3]);
        *(u32x2*)(X.MIX + row * D + 4 * lane) = w; }
    __syncthreads();
}

DI void pool_prompt_unit(const Params& p, const MixPtrs& X, int l, int unit, LAS unsigned char* lds, int tid, int lane, int wave) {
    const int R0 = unit * 64, b = R0 >> 12, t0 = R0 & (SEQ - 1); const size_t rb = (size_t)b * SEQ;
    LAS unsigned char* PL = lds + 79 * 512;
    for (int c = tid; c < 79 * 32; c += NTHR) { const int row = c >> 5, ch = c & 31, tk = t0 - 15 + row; u32x4 v = (u32x4){0u, 0u, 0u, 0u};
        if (tk >= 0) v = *(const u32x4*)(X.PPV + (rb + tk) * 256 + ch * 8);
        *(LAS u32x4*)(lds + row * 512 + ch * 16) = v; }
    __syncthreads();
    { const int wlen = 2 << (lane >> 4);
        const LAS unsigned char* prow = lds + (8 * wave + 15) * 512 + lane * 8;
        f32x4 sm[8];
#pragma unroll
        for (int tt = 0; tt < 8; ++tt) sm[tt] = (f32x4){0.f, 0.f, 0.f, 0.f};
#pragma unroll 1
        for (int i = 0; i < 16; ++i) { if (i < wlen) {
#pragma unroll
            for (int tt = 0; tt < 8; ++tt) sm[tt] += __builtin_convertvector(*(const LAS h4*)(prow + (tt - i) * 512), f32x4); } }
#pragma unroll
        for (int tt = 0; tt < 8; ++tt) {
            const int t = t0 + 8 * wave + tt; const float cnt = (float)(wlen < t + 1 ? wlen : t + 1);
            const f32x4 cur = __builtin_convertvector(*(const LAS h4*)(prow + tt * 512), f32x4);
            const f32x4 pl = sm[tt] * (1.f / cnt) - cur;
            u32x2 w; w.x = pkh(pl[0], pl[1]); w.y = pkh(pl[2], pl[3]);
            *(LAS u32x2*)(PL + (8 * wave + tt) * 528 + lane * 8) = w; } }
    __syncthreads();
    { const int g = wave & 3, th = wave >> 2, r = lane & 31, h = lane >> 5;
        const float* pw = p.pool_w + ((size_t)l * 4 + g) * 64 * 64 + r;
        f32x16 Dd[2];
#pragma unroll
        for (int x = 0; x < 16; ++x) { Dd[0][x] = 0.f; Dd[1][x] = 0.f; }
#pragma unroll 1
        for (int s = 0; s < 4; ++s) { const h8 bf = *(const LAS h8*)(PL + (32 * th + r) * 528 + (64 * g + 16 * s + 8 * h) * 2);
#pragma unroll
            for (int nb = 0; nb < 2; ++nb) { h8 af;
#pragma unroll
                for (int j = 0; j < 8; ++j) af[j] = (_Float16)pw[(size_t)(16 * s + 8 * h + j) * 64 + 32 * nb];
                Dd[nb] = __builtin_amdgcn_mfma_f32_32x32x16_f16(af, bf, Dd[nb], 0, 0, 0); } }
        const size_t row = (size_t)R0 + 32 * th + r;
#pragma unroll
        for (int nb = 0; nb < 2; ++nb)
#pragma unroll
            for (int xq = 0; xq < 4; ++xq) { const int col = 64 * g + 32 * nb + 8 * xq + 4 * h;
                const f32x4 ps = *(const f32x4*)(p.pool_scale + l * 256 + col); const h4 z = *(const h4*)(X.PSZP + row * 256 + col);
                u32x2 w; w.x = pkh(Dd[nb][4 * xq] * ps[0] * (float)z[0], Dd[nb][4 * xq + 1] * ps[1] * (float)z[1]); w.y = pkh(Dd[nb][4 * xq + 2] * ps[2] * (float)z[2], Dd[nb][4 * xq + 3] * ps[3] * (float)z[3]);
                *(u32x2*)(X.MIX + row * D + 256 + col) = w; } }
    __syncthreads();
}


constexpr int MX_WCV = 0;
constexpr int MX_WPT = 81920;
constexpr int MX_SCR = 0, MX_SCR_W = 7168;
constexpr int MX_TQ = RING_BYTES + 640;
DI void mix_stage_weights(const Params& p, int l, LAS unsigned char* lds, int tid) {
    for (int c = tid; c < 31 * 64; c += NTHR) *(LAS f32x4*)(lds + MX_WCV + c * 16) = *(const f32x4*)(p.conv_w + (size_t)l * 31 * 256 + 4 * c);
    for (int e = tid; e < 4 * 64 * 64; e += NTHR) { const int g = e >> 12, c = (e >> 6) & 63, n = e & 63;
        *(LAS _Float16*)(lds + MX_WPT + ((g * 64 + n) * 72 + c) * 2) = (_Float16)p.pool_w[(size_t)l * 16384 + e]; }
    if (tid == 0) *(LAS unsigned*)(lds + MX_TQ) = 0u;
}
DI void task_attn(const Params& p, int l, int b, int hk, int g, int tq0, int lane) {
    const int head = 4 * hk + g, r = lane & 31, h = lane >> 5; const size_t rb = (size_t)b * SEQ; const size_t qrow = rb + tq0 + r;
    const float sink2 = p.sinks[l * 8 + head] * LOG2E; const float NEG = -INFINITY;
    const u16* PQ = (const u16*)(p.ws + WS_PQ); const u16* PK = (const u16*)(p.ws + WS_PK);
    f32x16 S[5];
    {   h8 qf[4];
#pragma unroll
        for (int s = 0; s < 4; ++s) qf[s] = *(const h8*)(PQ + qrow * 512 + head * 64 + 16 * s + 8 * h);
        h8 kf[5][4];
#pragma unroll
        for (int i = 0; i < 5; ++i) { const int tk = tq0 - 128 + 32 * i, tkc = tk < 0 ? 0 : tk;
#pragma unroll
            for (int s = 0; s < 4; ++s) kf[i][s] = *(const h8*)(PK + (rb + tkc + r) * 128 + hk * 64 + 16 * s + 8 * h); }
#pragma unroll
        for (int i = 0; i < 5; ++i) { const int tk = tq0 - 128 + 32 * i;
#pragma unroll
            for (int x = 0; x < 16; ++x) S[i][x] = 0.f;
#pragma unroll
            for (int s = 0; s < 4; ++s) S[i] = __builtin_amdgcn_mfma_f32_32x32x16_f16(kf[i][s], qf[s], S[i], 0, 0, 0);
#pragma unroll
            for (int x = 0; x < 16; ++x) S[i][x] = tk >= 0 ? S[i][x] : NEG; } }
#pragma unroll
    for (int x = 0; x < 16; ++x) { if (!(crow(x, h) > r)) S[0][x] = NEG; if (!(crow(x, h) <= r)) S[4][x] = NEG; }
    float mx = sink2;
#pragma unroll
    for (int i = 0; i < 5; ++i)
#pragma unroll
        for (int x = 0; x < 16; ++x) mx = fmaxf(mx, S[i][x]);
    mx = max_halves(mx);
    float sum = 0.f;
#pragma unroll
    for (int i = 0; i < 5; ++i)
#pragma unroll
        for (int x = 0; x < 16; ++x) { S[i][x] = ex2(S[i][x] - mx); sum += S[i][x]; }
    sum = sum_halves(sum);
    const float inv = 1.f / (sum + ex2(sink2 - mx));
    u32x4 pa[5][2];
#pragma unroll
    for (int i = 0; i < 5; ++i)
#pragma unroll
        for (int s2 = 0; s2 < 2; ++s2) { float pv8[8];
#pragma unroll
            for (int j = 0; j < 8; ++j) pv8[j] = S[i][8 * s2 + j] * inv;
            pa[i][s2] = pack8(pv8); }
    int voff = ((b * 2 + hk) * 64 + r) * SEQ + (tq0 - 128) + 4 * h;
    asm volatile("" : "+v"(voff) : "v"(pa[0][0]), "v"(pa[0][1]), "v"(pa[1][0]), "v"(pa[1][1]), "v"(pa[2][0]), "v"(pa[2][1]), "v"(pa[3][0]), "v"(pa[3][1]), "v"(pa[4][0]), "v"(pa[4][1]));
    const u16* vtb = (const u16*)(p.ws + WS_VT) + voff;
    u32x2 vlo[5][2][2], vhi[5][2][2];
#pragma unroll
    for (int i = 0; i < 5; ++i) { const int tk = tq0 - 128 + 32 * i; const int adj = tk < 0 ? -tk : 0;
#pragma unroll
        for (int s2 = 0; s2 < 2; ++s2)
#pragma unroll
            for (int db = 0; db < 2; ++db) { const u16* vp = vtb + (size_t)db * 32 * SEQ + 32 * i + 16 * s2 + adj; vlo[i][s2][db] = *(const u32x2*)vp; vhi[i][s2][db] = *(const u32x2*)(vp + 8); } }
    f32x16 O[2];
#pragma unroll
    for (int x = 0; x < 16; ++x) { O[0][x] = 0.f; O[1][x] = 0.f; }
#pragma unroll
    for (int i = 0; i < 5; ++i)
#pragma unroll
        for (int s2 = 0; s2 < 2; ++s2)
#pragma unroll
            for (int db = 0; db < 2; ++db) { const u32x4 vv = {vlo[i][s2][db][0], vlo[i][s2][db][1], vhi[i][s2][db][0], vhi[i][s2][db][1]};
                O[db] = __builtin_amdgcn_mfma_f32_32x32x16_f16(__builtin_bit_cast(h8, vv), __builtin_bit_cast(h8, pa[i][s2]), O[db], 0, 0, 0); }
    const u16* PSZA = (const u16*)(p.ws + WS_PSZA); u16* MIX = (u16*)(p.ws + WS_MIX);
    u32x2 zg[2][4];
#pragma unroll
    for (int db = 0; db < 2; ++db)
#pragma unroll
        for (int xq = 0; xq < 4; ++xq) zg[db][xq] = *(const u32x2*)(PSZA + qrow * 512 + head * 64 + 32 * db + 8 * xq + 4 * h);
#pragma unroll
    for (int db = 0; db < 2; ++db)
#pragma unroll
        for (int xq = 0; xq < 4; ++xq) { const int col = head * 64 + 32 * db + 8 * xq + 4 * h; const h4 z = __builtin_bit_cast(h4, zg[db][xq]);
            u32x2 w; w.x = pkh(O[db][4 * xq] * (float)z[0], O[db][4 * xq + 1] * (float)z[1]); w.y = pkh(O[db][4 * xq + 2] * (float)z[2], O[db][4 * xq + 3] * (float)z[3]);
            *(u32x2*)(MIX + qrow * D + 512 + col) = w; }
}
constexpr int MX_X = 68608;
DI void conv_tile_dma(const Params& p, int R0, LAS unsigned char* lds, int wave, int lane) {
    const int b = R0 >> 12, t0 = R0 & (SEQ - 1);
    const unsigned char* PA = p.ws + WS_PA;
#pragma unroll
    for (int i = 0; i < 6; ++i) { const int piece = wave + 8 * i;
        if (piece < 47) { const int row = 2 * piece + (lane >> 5); int tk = t0 - 30 + row; tk = tk < 0 ? 0 : tk;
            __builtin_amdgcn_global_load_lds((const unsigned*)(PA + ((size_t)b * SEQ + tk) * 512 + (lane & 31) * 16), (LAS unsigned*)(lds + MX_X + piece * 1024), 16, 0, 0); } }
}
DI void task_conv(const Params& p, int l, int R0, int sub, LAS unsigned char* lds, int lane) {
    const int t0 = (R0 & (SEQ - 1)) + 8 * sub; const size_t rowb = (size_t)R0 + 8 * sub;
    const f32x4 bias = *(const f32x4*)(p.conv_b + l * 256 + 4 * lane), cg = *(const f32x4*)(p.cnorm_g + l * 256 + 4 * lane), cb = *(const f32x4*)(p.cnorm_b + l * 256 + 4 * lane);
    const LAS unsigned char* arow = lds + MX_X + (8 * sub) * 512 + lane * 8;
    const LAS unsigned char* wl = lds + MX_WCV + lane * 16;
    f32x4 acc[8], win[8];
#pragma unroll
    for (int tt = 0; tt < 8; ++tt) acc[tt] = bias;
#pragma unroll
    for (int k = 0; k < 7; ++k) { const f32x4 v = __builtin_convertvector(*(const LAS h4*)(arow + k * 512), f32x4); win[k] = (t0 - 30 + k >= 0) ? v : (f32x4){0.f, 0.f, 0.f, 0.f}; }
#pragma unroll 1
    for (int jb = 0; jb < 4; ++jb) {
#pragma unroll
        for (int jj = 0; jj < 8; ++jj) { const int j = 8 * jb + jj;
            if (j < 31) {
                const f32x4 v = __builtin_convertvector(*(const LAS h4*)(arow + (j + 7) * 512), f32x4);
                win[(jj + 7) & 7] = (t0 - 30 + j + 7 >= 0) ? v : (f32x4){0.f, 0.f, 0.f, 0.f};
                const f32x4 w = *(const LAS f32x4*)(wl + j * 1024);
#pragma unroll
                for (int tt = 0; tt < 8; ++tt) acc[tt] += w * win[(jj + tt) & 7]; } } }
    const u16* PSZC = (const u16*)(p.ws + WS_PSZC); u16* MIX = (u16*)(p.ws + WS_MIX);
#pragma unroll
    for (int tt = 0; tt < 8; ++tt) { const size_t row = rowb + tt;
        const float mean = wave_sum((acc[tt][0] + acc[tt][1]) + (acc[tt][2] + acc[tt][3])) * (1.f / 256.f);
        const f32x4 d = acc[tt] - mean;
        const float rstd = 1.f / sqrtf(wave_sum((d[0] * d[0] + d[1] * d[1]) + (d[2] * d[2] + d[3] * d[3])) * (1.f / 256.f) + LN_EPS);
        const h4 z = *(const h4*)(PSZC + row * 256 + 4 * lane); float o[4];
#pragma unroll
        for (int k = 0; k < 4; ++k) o[k] = silu(d[k] * rstd * cg[k] + cb[k]) * (float)z[k];
        u32x2 w; w.x = pkh(o[0], o[1]); w.y = pkh(o[2], o[3]);
        *(u32x2*)(MIX + row * D + 4 * lane) = w; }
}
DI void task_pool(const Params& p, int l, int R0, int th, int g, LAS unsigned char* lds, int wave, int lane) {
    const u16* PPV = (const u16*)(p.ws + WS_PPV); const u16* PSZP = (const u16*)(p.ws + WS_PSZP); u16* MIX = (u16*)(p.ws + WS_MIX);
    const int b = R0 >> 12, T0 = (R0 & (SEQ - 1)) + 32 * th; const size_t rb = (size_t)b * SEQ;
    LAS unsigned char* scr = lds + MX_SCR + wave * MX_SCR_W;
    const int r = lane & 31, h = lane >> 5;
    u32x4 tl[6];
#pragma unroll
    for (int i = 0; i < 6; ++i) { const int row = (lane >> 3) + 8 * i, tk = T0 - 15 + row; const int tkc = tk < 0 ? 0 : (row < 47 ? tk : T0 + 31);
        const u32x4 v = *(const u32x4*)(PPV + (rb + tkc) * 256 + 64 * g + 8 * (lane & 7)); const unsigned msk = (unsigned)-(int)(tk >= 0); tl[i] = (u32x4){v[0] & msk, v[1] & msk, v[2] & msk, v[3] & msk}; }
    const size_t orow = rb + T0 + r;
    u32x2 zp[2][4]; f32x4 ps[2][4];
#pragma unroll
    for (int nb = 0; nb < 2; ++nb)
#pragma unroll
        for (int xq = 0; xq < 4; ++xq) { const int col = 64 * g + 32 * nb + 8 * xq + 4 * h; zp[nb][xq] = *(const u32x2*)(PSZP + orow * 256 + col); ps[nb][xq] = *(const f32x4*)(p.pool_scale + l * 256 + col); }
#pragma unroll
    for (int i = 0; i < 6; ++i) { const int row = (lane >> 3) + 8 * i; if (row < 47) *(LAS u32x4*)(scr + row * 144 + (lane & 7) * 16) = tl[i]; }
    asm volatile("s_waitcnt lgkmcnt(0)" ::: "memory");
    const int wlen = 2 << g; const int t = T0 + r; const float icnt = 1.f / (float)(wlen < t + 1 ? wlen : t + 1);
    h8 bf[4];
#pragma unroll
    for (int s = 0; s < 4; ++s) { const LAS unsigned char* base = scr + (15 + r) * 144 + (16 * s + 8 * h) * 2; float sm[8];
        const h8 cur = *(const LAS h8*)base;
#pragma unroll
        for (int k = 0; k < 8; ++k) sm[k] = (float)cur[k];
        for (int i = 1; i < wlen; ++i) { const h8 v = *(const LAS h8*)(base - i * 144);
#pragma unroll
            for (int k = 0; k < 8; ++k) sm[k] += (float)v[k]; }
        float pl[8];
#pragma unroll
        for (int k = 0; k < 8; ++k) pl[k] = sm[k] * icnt - (float)cur[k];
        bf[s] = __builtin_bit_cast(h8, pack8(pl)); }
    f32x16 Dd[2];
#pragma unroll
    for (int x = 0; x < 16; ++x) { Dd[0][x] = 0.f; Dd[1][x] = 0.f; }
#pragma unroll
    for (int s = 0; s < 4; ++s)
#pragma unroll
        for (int nb = 0; nb < 2; ++nb) { const h8 af = *(const LAS h8*)(lds + MX_WPT + ((g * 64 + 32 * nb + r) * 72 + 16 * s + 8 * h) * 2);
            Dd[nb] = __builtin_amdgcn_mfma_f32_32x32x16_f16(af, bf[s], Dd[nb], 0, 0, 0); }
#pragma unroll
    for (int nb = 0; nb < 2; ++nb)
#pragma unroll
        for (int xq = 0; xq < 4; ++xq) { const int col = 64 * g + 32 * nb + 8 * xq + 4 * h; const h4 z = __builtin_bit_cast(h4, zp[nb][xq]); const f32x4 sc = ps[nb][xq];
            u32x2 w; w.x = pkh(Dd[nb][4 * xq] * sc[0] * (float)z[0], Dd[nb][4 * xq + 1] * sc[1] * (float)z[1]); w.y = pkh(Dd[nb][4 * xq + 2] * sc[2] * (float)z[2], Dd[nb][4 * xq + 3] * sc[3] * (float)z[3]);
            *(u32x2*)(MIX + orow * D + 256 + col) = w; }
}
DI void mix_prompt_tasks(const Params& p, int l, int unit, LAS unsigned char* lds, int lane, int wave) {
    int one = 1; asm volatile("" : "+s"(one));
    if (one) task_attn(p, l, unit >> 6, (unit >> 5) & 1, wave & 3, (unit & 31) * 128 + 32 * (wave >> 2), lane_id());
    asm volatile("" : "+s"(one) :: "memory");
    if (one) task_attn(p, l, unit >> 6, (unit >> 5) & 1, wave & 3, (unit & 31) * 128 + 32 * (2 + (wave >> 2)), lane_id());
    asm volatile("s_waitcnt vmcnt(0) lgkmcnt(0)\n\ts_barrier" : "+s"(one) :: "memory");
    if (one) task_conv(p, l, unit * 64, wave, lds, lane_id());
    asm volatile("s_waitcnt lgkmcnt(0)\n\ts_barrier" : "+s"(one) :: "memory");
    if (one) task_pool(p, l, unit * 64, wave >> 2, wave & 3, lds, wave, lane_id());
    (void)lane;
}

DI void convpool_sample_unit(const Params& p, const MixPtrs& X, int l, int b, int part, LAS unsigned char* lds, int tid, int lane, int wave) {
    LAS float* cv = (LAS float*)lds;
    const int c = tid & 255, tp = tid >> 8; const size_t r0 = (size_t)MP + 4 * b;
    if (part == 0) {
        const float* cc = p.cache_conv + (size_t)(l * DB + b) * 30 * 256;
        float xa[34], wv[31];
        { const float* pc = cc + c;
#pragma unroll
          for (int ri = 0; ri < 30; ++ri) xa[ri] = pc[ri * 256];
          const u16* pn = X.PA + r0 * 256 + c;
#pragma unroll
          for (int ri = 0; ri < 4; ++ri) xa[30 + ri] = (float)(*(const _Float16*)(pn + ri * 256));
          const float* pw = p.conv_w + (size_t)l * 31 * 256 + c;
#pragma unroll
          for (int j = 0; j < 31; ++j) wv[j] = pw[j * 256]; }
        float a0 = p.conv_b[l * 256 + c], a1 = a0;
        if (tp == 0) {
#pragma unroll
            for (int j = 0; j < 31; ++j) { a0 += wv[j] * xa[j]; a1 += wv[j] * xa[j + 1]; }
        } else {
#pragma unroll
            for (int j = 0; j < 31; ++j) { a0 += wv[j] * xa[j + 2]; a1 += wv[j] * xa[j + 3]; } }
        cv[(2 * tp) * 256 + c] = a0; cv[(2 * tp + 1) * 256 + c] = a1;
        { float* oc = p.out + OFF_CONVS + (size_t)(l * DB + b) * 30 * 256; for (int e = tid; e < 26 * 64; e += NTHR) *(f32x4*)(oc + 4 * e) = *(const f32x4*)(cc + 4 * 256 + 4 * e); }
        __syncthreads();
        if (wave < 4) { const int t = wave; const f32x4 v = *(const LAS f32x4*)(cv + t * 256 + 4 * lane);
            const float mean = wave_sum((v[0] + v[1]) + (v[2] + v[3])) * (1.f / 256.f); const f32x4 d = v - mean;
            const float rstd = 1.f / sqrtf(wave_sum((d[0] * d[0] + d[1] * d[1]) + (d[2] * d[2] + d[3] * d[3])) * (1.f / 256.f) + LN_EPS);
            const f32x4 cg = *(const f32x4*)(p.cnorm_g + l * 256 + 4 * lane), cb = *(const f32x4*)(p.cnorm_b + l * 256 + 4 * lane);
            const h4 zc = *(const h4*)(X.PSZC + (r0 + t) * 256 + 4 * lane); float o[4];
#pragma unroll
            for (int k = 0; k < 4; ++k) o[k] = silu(d[k] * rstd * cg[k] + cb[k]) * (float)zc[k];
            u32x2 w; w.x = pkh(o[0], o[1]); w.y = pkh(o[2], o[3]);
            *(u32x2*)(X.MIX + (r0 + t) * D + 4 * lane) = w; }
    } else {
        const float* cp = p.cache_pool + (size_t)(l * DB + b) * 15 * 256;
        float xa[19];
        { const float* pc = cp + c;
#pragma unroll
          for (int ri = 0; ri < 15; ++ri) xa[ri] = pc[ri * 256];
          const u16* pn = X.PPV + r0 * 256 + c;
#pragma unroll
          for (int ri = 0; ri < 4; ++ri) xa[15 + ri] = (float)(*(const _Float16*)(pn + ri * 256)); }
        const int wlen = 2 << (c >> 6); float s0 = 0.f, s1 = 0.f, c0, c1;
        if (tp == 0) { c0 = xa[15]; c1 = xa[16];
#pragma unroll
            for (int i = 0; i < 16; ++i) if (i < wlen) { s0 += xa[15 - i]; s1 += xa[16 - i]; }
        } else { c0 = xa[17]; c1 = xa[18];
#pragma unroll
            for (int i = 0; i < 16; ++i) if (i < wlen) { s0 += xa[17 - i]; s1 += xa[18 - i]; } }
        const float iw = 1.f / (float)wlen;
        cv[(2 * tp) * 256 + c] = s0 * iw - c0; cv[(2 * tp + 1) * 256 + c] = s1 * iw - c1;
        { float* op = p.out + OFF_POOLS + (size_t)(l * DB + b) * 15 * 256; for (int e = tid; e < 11 * 64; e += NTHR) *(f32x4*)(op + 4 * e) = *(const f32x4*)(cp + 4 * 256 + 4 * e); }
        __syncthreads();
        const int g = c >> 6, n = c & 63; const float* pw = p.pool_w + ((size_t)l * 4 + g) * 64 * 64 + n; float y0 = 0.f, y1 = 0.f;
#pragma unroll 16
        for (int k = 0; k < 64; ++k) { const float w = pw[(size_t)k * 64]; y0 += cv[(2 * tp) * 256 + 64 * g + k] * w; y1 += cv[(2 * tp + 1) * 256 + 64 * g + k] * w; }
        const float ps = p.pool_scale[l * 256 + c];
        const float z0 = (float)(*(const _Float16*)(X.PSZP + (r0 + 2 * tp) * 256 + c)), z1 = (float)(*(const _Float16*)(X.PSZP + (r0 + 2 * tp + 1) * 256 + c));
        *(_Float16*)(X.MIX + (r0 + 2 * tp) * D + 256 + c) = (_Float16)(y0 * ps * z0); *(_Float16*)(X.MIX + (r0 + 2 * tp + 1) * D + 256 + c) = (_Float16)(y1 * ps * z1); }
    __syncthreads();
}

DI void attn_sample_unit(const Params& p, const MixPtrs& X, int l, int unit, LAS unsigned char* lds, int tid, int lane, int wave) {
    const int b = unit >> 1, hk = unit & 1; const size_t r0 = (size_t)MP + 4 * b;
    LAS float* EX = (LAS float*)lds;
    LAS float* OP = EX + 256;
    const float* ck = p.cache_k + ((size_t)(l * DB + b) * 128 * 2 + hk) * 64; const float* cvv = p.cache_v + ((size_t)(l * DB + b) * 128 * 2 + hk) * 64;
    float* ok = p.out + OFF_KS + ((size_t)(l * DB + b) * 128 * 2 + hk) * 64; float* ov = p.out + OFF_VS + ((size_t)(l * DB + b) * 128 * 2 + hk) * 64;
    f32x4 ckv[4], cvw[4];
#pragma unroll
    for (int i = 0; i < 4; ++i) { const int e = tid + 512 * i, j = e >> 4, d4 = (e & 15) * 4; ckv[i] = *(const f32x4*)(ck + (size_t)j * 128 + d4); cvw[i] = *(const f32x4*)(cvv + (size_t)j * 128 + d4); }
    const int fr = lane & 15, fq = lane >> 4;
    f32x4 O[4]; f32x4 Sa = {0.f, 0.f, 0.f, 0.f}, Sb = {0.f, 0.f, 0.f, 0.f};
    float vg[4][8];
    const int kA = 32 * wave + fr, kB = kA + 16;
    if (wave < 5) {
        h8 ka[2], kb[2], qf[2];
#pragma unroll
        for (int ks = 0; ks < 2; ++ks) { const int d0 = 32 * ks + 8 * fq;
            qf[ks] = *(const h8*)(X.PQ + (r0 + (fr >> 2)) * 512 + (4 * hk + (fr & 3)) * 64 + d0);
            if (wave < 4) { const f32x4 a0 = *(const f32x4*)(ck + (size_t)kA * 128 + d0), a1 = *(const f32x4*)(ck + (size_t)kA * 128 + d0 + 4), b0 = *(const f32x4*)(ck + (size_t)kB * 128 + d0), b1 = *(const f32x4*)(ck + (size_t)kB * 128 + d0 + 4);
                float t8[8] = {a0[0], a0[1], a0[2], a0[3], a1[0], a1[1], a1[2], a1[3]}; ka[ks] = __builtin_bit_cast(h8, pack8(t8));
                float u8[8] = {b0[0], b0[1], b0[2], b0[3], b1[0], b1[1], b1[2], b1[3]}; kb[ks] = __builtin_bit_cast(h8, pack8(u8));
            } else { const int rr = fr < 4 ? fr : 0; const u32x4 raw = *(const u32x4*)(X.PK + (r0 + rr) * 128 + hk * 64 + d0); ka[ks] = __builtin_bit_cast(h8, fr < 4 ? raw : (u32x4){0u, 0u, 0u, 0u}); kb[ks] = __builtin_bit_cast(h8, (u32x4){0u, 0u, 0u, 0u}); } }
#pragma unroll
        for (int dt = 0; dt < 4; ++dt)
#pragma unroll
            for (int j = 0; j < 8; ++j) { const int key = 32 * wave + (j < 4 ? 0 : 16) + 4 * fq + (j & 3); const int d = 16 * dt + fr;
                if (wave < 4) vg[dt][j] = cvv[(size_t)key * 128 + d];
                else vg[dt][j] = key < 132 ? (float)(*(const _Float16*)(X.PV + (r0 + (key - 128)) * 128 + hk * 64 + d)) : 0.f; }
#pragma unroll
        for (int ks = 0; ks < 2; ++ks) { Sa = __builtin_amdgcn_mfma_f32_16x16x32_f16(ka[ks], qf[ks], Sa, 0, 0, 0); Sb = __builtin_amdgcn_mfma_f32_16x16x32_f16(kb[ks], qf[ks], Sb, 0, 0, 0); }
        const int t = fr >> 2; float mx = -INFINITY;
#pragma unroll
        for (int i = 0; i < 4; ++i) { const int k0 = 32 * wave + 4 * fq + i, k1 = k0 + 16;
            Sa[i] = (k0 >= t + 1 && k0 <= t + 128) ? Sa[i] : -INFINITY; Sb[i] = (k1 >= t + 1 && k1 <= t + 128) ? Sb[i] : -INFINITY; mx = fmaxf(mx, fmaxf(Sa[i], Sb[i])); }
        mx = fmaxf(mx, xor_lane<16>(mx)); mx = max_halves(mx);
        if (fq == 0) EX[wave * 16 + fr] = mx;
    }
#pragma unroll
    for (int i = 0; i < 4; ++i) { const int e = tid + 512 * i, j = e >> 4, d4 = (e & 15) * 4; if (j >= 4) { *(f32x4*)(ok + (size_t)(j - 4) * 128 + d4) = ckv[i]; *(f32x4*)(ov + (size_t)(j - 4) * 128 + d4) = cvw[i]; } }
    __syncthreads();
    if (wave < 5) {
        const float sink2 = p.sinks[l * 8 + 4 * hk + (fr & 3)] * LOG2E;
        float m = sink2;
#pragma unroll
        for (int w = 0; w < 5; ++w) m = fmaxf(m, EX[w * 16 + fr]);
        float sum = 0.f;
#pragma unroll
        for (int i = 0; i < 4; ++i) { Sa[i] = ex2(Sa[i] - m); Sb[i] = ex2(Sb[i] - m); sum += Sa[i] + Sb[i]; }
        sum += xor_lane<16>(sum); sum = sum_halves(sum);
        if (fq == 0) EX[128 + wave * 16 + fr] = sum;
        float p8[8] = {Sa[0], Sa[1], Sa[2], Sa[3], Sb[0], Sb[1], Sb[2], Sb[3]}; const h8 pb = __builtin_bit_cast(h8, pack8(p8));
#pragma unroll
        for (int dt = 0; dt < 4; ++dt) { const h8 va = __builtin_bit_cast(h8, pack8(vg[dt])); O[dt] = __builtin_amdgcn_mfma_f32_16x16x32_f16(va, pb, (f32x4){0.f, 0.f, 0.f, 0.f}, 0, 0, 0);
#pragma unroll
            for (int i = 0; i < 4; ++i) OP[(wave * 64 + 16 * dt + 4 * fq + i) * 16 + fr] = O[dt][i]; }
    }
    __syncthreads();
    { const int qr = tid & 15, dg = tid >> 4, t = qr >> 2, g = qr & 3;
        const float sink2 = p.sinks[l * 8 + 4 * hk + g] * LOG2E; float m = sink2, den = 0.f, o0 = 0.f, o1 = 0.f;
#pragma unroll
        for (int w = 0; w < 5; ++w) { m = fmaxf(m, EX[w * 16 + qr]); den += EX[128 + w * 16 + qr]; o0 += OP[(w * 64 + 2 * dg) * 16 + qr]; o1 += OP[(w * 64 + 2 * dg + 1) * 16 + qr]; }
        const float inv = 1.f / (den + ex2(sink2 - m));
        const int col = (4 * hk + g) * 64 + 2 * dg;
        const h2 z = *(const h2*)(X.PSZA + (r0 + t) * 512 + col);
        *(unsigned*)(X.MIX + (r0 + t) * D + 512 + col) = pkh(o0 * inv * (float)z[0], o1 * inv * (float)z[1]); }
    __syncthreads();
}

template <int R>
DI void sample_ln_rows(const Params& p, int l, int row0, int lane) {
    const u16* ZH = (const u16*)(p.ws + WS_ZH); u16* XR = (u16*)(p.ws + WS_XR); u16* ZP = (u16*)(p.ws + WS_H);
    const float* lg = p.ln_g + (size_t)l * D; const float* lb = p.ln_b + (size_t)l * D;
    const float* modn = (const float*)(p.ws + WS_MOD) + (size_t)(l + 1) * NMOD * 3072;
    float v[R][16], mean[R], rstd[R];
#pragma unroll
    for (int r = 0; r < R; ++r)
#pragma unroll
        for (int j2 = 0; j2 < 2; ++j2) unpack8(*(const u32x4*)(ZH + (size_t)(row0 + r) * D + 512 * j2 + 8 * lane), v[r] + 8 * j2);
    ln_stats<R>(v, mean, rstd);
#pragma unroll
    for (int j2 = 0; j2 < 2; ++j2)
#pragma unroll
        for (int h = 0; h < 2; ++h) { const f32x4 g = *(const f32x4*)(lg + 512 * j2 + 8 * lane + 4 * h), bb = *(const f32x4*)(lb + 512 * j2 + 8 * lane + 4 * h);
#pragma unroll
            for (int r = 0; r < R; ++r)
#pragma unroll
                for (int k = 0; k < 4; ++k) v[r][8 * j2 + 4 * h + k] = v[r][8 * j2 + 4 * h + k] * rstd[r] * g[k] + bb[k]; }
    if (l == DEPTH - 1) {
#pragma unroll
        for (int r = 0; r < R; ++r) { float* y = p.out + OFF_YS + (size_t)(row0 - MP + r) * D;
#pragma unroll
            for (int j2 = 0; j2 < 2; ++j2)
#pragma unroll
                for (int h = 0; h < 2; ++h) *(f32x4*)(y + 512 * j2 + 8 * lane + 4 * h) = (f32x4){v[r][8 * j2 + 4 * h], v[r][8 * j2 + 4 * h + 1], v[r][8 * j2 + 4 * h + 2], v[r][8 * j2 + 4 * h + 3]}; }
    } else {
#pragma unroll
        for (int r = 0; r < R; ++r)
#pragma unroll
            for (int j2 = 0; j2 < 2; ++j2) *(u32x4*)(XR + (size_t)(row0 + r) * D + 512 * j2 + 8 * lane) = pack8(v[r] + 8 * j2);
        ln_stats<R>(v, mean, rstd);
#pragma unroll
        for (int r = 0; r < R; ++r) { const int row = row0 + r; const float* sh = modn + (size_t)(NB + ((row - MP) >> 2)) * 3072; const float* sc = sh + 1024;
#pragma unroll
            for (int j2 = 0; j2 < 2; ++j2) { float o[8];
#pragma unroll
                for (int h = 0; h < 2; ++h) { const f32x4 a = *(const f32x4*)(sc + 512 * j2 + 8 * lane + 4 * h), bb = *(const f32x4*)(sh + 512 * j2 + 8 * lane + 4 * h);
#pragma unroll
                    for (int k = 0; k < 4; ++k) o[4 * h + k] = v[r][8 * j2 + 4 * h + k] * rstd[r] * (1.f + a[k]) + bb[k]; }
                *(u32x4*)(ZP + (size_t)row * D + 512 * j2 + 8 * lane) = pack8(o); } }
    }
}
DI void outproj_sample_unit(const Params& p, int l, int unit, LAS unsigned char* lds, int tid, int lane, int wave) {
    const int rbk0 = unit >> 5, cb = unit & 31, R0 = MP + 64 * rbk0, n0 = 32 * cb, r = lane & 31, h = lane >> 5;
    const u16* MIX = (const u16*)(p.ws + WS_MIX); const u16* WT = (const u16*)(p.ws + WS_WOUT) + (size_t)l * D * D;
    const u16* bp = WT + (size_t)perm_out(n0 + r) * D + wave * 128 + 8 * h;
    const u16* ap = MIX + (size_t)(R0 + r) * D + wave * 128 + 8 * h;
    f32x16 acc[2];
#pragma unroll
    for (int x = 0; x < 16; ++x) { acc[0][x] = 0.f; acc[1][x] = 0.f; }
#pragma unroll
    for (int s = 0; s < 8; ++s) { const h8 bf = *(const h8*)(bp + 16 * s);
#pragma unroll
        for (int rb = 0; rb < 2; ++rb) { const h8 af = *(const h8*)(ap + (size_t)rb * 32 * D + 16 * s); acc[rb] = __builtin_amdgcn_mfma_f32_32x32x16_f16(af, bf, acc[rb], 0, 0, 0); } }
    LAS float* part = (LAS float*)lds;
#pragma unroll
    for (int rb = 0; rb < 2; ++rb)
#pragma unroll
        for (int x = 0; x < 16; ++x) part[(wave * 64 + 32 * rb + crow(x, h)) * 32 + r] = acc[rb][x];
    __syncthreads();
    const float* modl = (const float*)(p.ws + WS_MOD) + (size_t)l * NMOD * 3072;
#pragma unroll
    for (int q = 0; q < 4; ++q) { const int o = tid + 512 * q, row = o >> 5, col = o & 31; float sum = 0.f;
#pragma unroll
        for (int w = 0; w < 8; ++w) sum += part[(w * 64 + row) * 32 + col];
        const int grow = R0 + row, bidx = NB + ((grow - MP) >> 2);
        const float xr = (float)(*(const _Float16*)((const u16*)(p.ws + WS_XR) + (size_t)grow * D + n0 + col));
        *(_Float16*)((u16*)(p.ws + WS_ZH) + (size_t)grow * D + n0 + col) = (_Float16)(ALPHA * xr + (1.f + modl[(size_t)bidx * 3072 + 2048 + n0 + col]) * sum); }
    asm volatile("s_waitcnt vmcnt(0)" ::: "memory");
    __syncthreads();
    if (wave == 0 && lane == 0) {
        __builtin_amdgcn_fence(__ATOMIC_RELEASE, "agent"); asm volatile("s_waitcnt vmcnt(0)" ::: "memory");
        (void)__hip_atomic_fetch_add((unsigned*)(p.ws + WS_CTL) + CW_SCNT + 64 * (l * 8 + rbk0), 1u, __ATOMIC_RELAXED, __HIP_MEMORY_SCOPE_AGENT); }
}
DI void outproj_sample_finish(const Params& p, int l, int unit, int lane, int wave) {
    if (wave != 0) return;
    unsigned* cnt = (unsigned*)(p.ws + WS_CTL) + CW_SCNT + 64 * (l * 8 + (unit >> 5));
    for (unsigned sp = 0; sp < (1u << 20); ++sp) { if (__hip_atomic_load(cnt, __ATOMIC_RELAXED, __HIP_MEMORY_SCOPE_AGENT) >= 32u) break; __builtin_amdgcn_s_sleep(2); }
    __builtin_amdgcn_fence(__ATOMIC_ACQUIRE, "agent"); asm volatile("s_waitcnt vmcnt(0)" ::: "memory");
    sample_ln_rows<2>(p, l, MP + 64 * (unit >> 5) + 2 * (unit & 31), lane);
}

constexpr int N_PHASES = 3 + 3 * DEPTH;
typedef const __attribute__((address_space(4))) Params* KParams;
#define PHASE_BEGIN() const int lane_ = lane_id(); const int lane = lane_, wave = wave_s, tid = wave_s * 64 + lane_; \
    KParams kq = kp; asm volatile("" : "+s"(kq)); Params p; { const ParamsHead hh_ = *(const __attribute__((address_space(4))) ParamsHead*)kq; __builtin_memcpy(&p, &hh_, sizeof(ParamsHead)); }     const int gw = vcu * NWAVES + wave, NGW = G * NWAVES; (void)lane; (void)gw; (void)NGW
#define MIXPTRS() MixPtrs X; X.PA = (const u16*)(p.ws + WS_PA); X.PSZC = (const u16*)(p.ws + WS_PSZC); X.PPV = (const u16*)(p.ws + WS_PPV); X.PSZP = (const u16*)(p.ws + WS_PSZP); \
    X.PQ = (const u16*)(p.ws + WS_PQ); X.PSZA = (const u16*)(p.ws + WS_PSZA); X.PK = (const u16*)(p.ws + WS_PK); X.PV = (const u16*)(p.ws + WS_PV); X.MIX = (u16*)(p.ws + WS_MIX)
__global__ void __launch_bounds__(NTHR, 2) hymba_fwd(Params p_unused) {
#if defined(__HIP_DEVICE_COMPILE__)
    extern __shared__ __attribute__((aligned(16))) unsigned char lds_raw[];
    LAS unsigned char* lds = (LAS unsigned char*)lds_raw;
    volatile LAS unsigned* MISC = (volatile LAS unsigned*)(lds + MISC_OFF);
    const KParams kp = (KParams)__builtin_amdgcn_kernarg_segment_ptr();
    const int G = gridDim.x, bx = blockIdx.x, vcu = (G % 8 == 0) ? (bx % 8) * (G / 8) + bx / 8 : bx;
    const int wave_s = __builtin_amdgcn_readfirstlane((int)threadIdx.x >> 6);
    for (int u = threadIdx.x; u < (LDS_BYTES - RING_BYTES) / 4; u += NTHR) ((LAS unsigned*)(lds + RING_BYTES))[u] = 0u;
    __syncthreads();
    unsigned* ctl = (unsigned*)(kp->ws + WS_CTL);
    XcdBarrier bar; bar.bar = ctl + CW_BAR; bar.x = 0; bar.st = nullptr;
    if (MK_N_LAUNCHES == 1) bar = xcd_barrier_post(ctl + CW_BAR, MISC + 8);
    const int lo = kp->ph_lo, hi = kp->ph_hi;
#ifndef ONLY
#define ONLY -1
#endif
#ifndef ONLYMASK
#define ONLYMASK 0x3f
#endif
#define EN(t) ((ONLY < 0 || ONLY == (t)) && ((ONLYMASK >> (t)) & 1))
#define IN(k) (lo <= (k) && (k) < hi)
#define SEAM(k) do { if (MK_N_LAUNCHES == 1 && IN((k) + 1)) xcd_barrier(bar, wave_s); } while (0)
    if (EN(0) && IN(0)) { { PHASE_BEGIN(); p0_prologue(p, (const __attribute__((address_space(4))) float*)((const __attribute__((address_space(4))) char*)kq + __builtin_offsetof(Params, inv_freq)), lds, vcu, G, tid, lane, wave); } SEAM(0); }
    if (EN(1) && IN(1)) { { PHASE_BEGIN(); for (int u = vcu; u < DEPTH * 40; u += G) modv_unit(p, lds, u, tid, lane, wave); pre_phase(p, gw, NGW, lane); } SEAM(1); }
#pragma unroll 1
    for (int l = 0; l < DEPTH; ++l) {
        const int ph = 2 + 3 * l;
        if (EN(2) && IN(ph)) {
            { PHASE_BEGIN();
            pg8::Gemm g{(const u16*)(p.ws + WS_H), (const u16*)(p.ws + WS_WIN) + (size_t)l * DIN * D, M, DIN, D};
            pg8::StaticOrder S; S.init(M, DIN, G, bx);
            LAS float* rcl = (LAS float*)(lds + RING_BYTES + 1024);
            for (int i = 0; i < 3; ++i) { pg8::Unit u; if (S.next(i, u) && u.pm < MP / 256) finalize_rc_in(p, l, u.pm, rcl + i * 1024, tid); }
            asm volatile("s_waitcnt lgkmcnt(0)" ::: "memory"); __syncthreads();
            EpiIn E{l, p.ws, p.out, rcl};
            pg8::gemm_phase<EpiIn, true>(lds, g, S, E, tid); }
            SEAM(ph);
        }
        if (EN(3) && IN(ph + 1)) {
            { PHASE_BEGIN(); for (int e = tid; e < 4 * 64 * 64; e += NTHR) { const int g = e >> 12, c = (e >> 6) & 63, n = e & 63;
                  *(LAS _Float16*)(lds + MX_WPT + ((g * 64 + n) * 72 + c) * 2) = (_Float16)p.pool_w[(size_t)l * 16384 + e]; } }
            { PHASE_BEGIN(); MIXPTRS(); for (int u = vcu; u < 256; u += G) attn_prompt_unit(p, X, l, u, lds, tid, lane, wave); }
            { PHASE_BEGIN(); MIXPTRS(); for (int u = vcu; u < 256; u += G) conv_prompt_unit(p, X, l, u, lds, tid, lane, wave); }
            { PHASE_BEGIN(); for (int u = vcu; u < 256; u += G) { task_pool(p, l, u * 64, wave >> 2, wave & 3, lds, wave, lane); __syncthreads(); } }
            { PHASE_BEGIN(); MIXPTRS(); for (int u = vcu; u < 256; u += G) attn_sample_unit(p, X, l, u, lds, tid, lane, wave); }
            { PHASE_BEGIN(); MIXPTRS(); for (int u = vcu; u < 2 * DB; u += G) convpool_sample_unit(p, X, l, u >> 1, u & 1, lds, tid, lane, wave); }
            SEAM(ph + 1); }
        if (EN(4) && IN(ph + 2)) {
            { PHASE_BEGIN();
            pg8::Gemm g{(const u16*)(p.ws + WS_MIX), (const u16*)(p.ws + WS_WOUT) + (size_t)l * D * D, M, D, D};
            for (int u = vcu; u < 256; u += G) outproj_sample_unit(p, l, u, lds, tid, lane, wave);
            __syncthreads();
            pg8::StaticOrder S; S.init(MP, D, G, bx);
            EpiOutF E{p.ws, l, p.ln_g, p.ln_b};
            pg8::gemm_phase<EpiOutF, false>(lds, g, S, E, tid);
            for (int u = vcu; u < 256; u += G) outproj_sample_finish(p, l, u, lane, wave); }
            SEAM(ph + 2);
        }
    }
    if (EN(5) && IN(N_PHASES - 1)) { PHASE_BEGIN(); fin_phase(p, gw, NGW, lane); }
#undef IN
#undef SEAM
#endif
}


#ifdef DBG
constexpr int DBG_NS = 56;
constexpr size_t WS_DBGACC = 32 * 1024;
constexpr size_t WS_DBGZ = WS_END;
__constant__ int dbg_rows_tab[DBG_NS] = {0, 1, 2, 3, 14, 15, 16, 29, 30, 31, 32, 63, 64, 65, 127, 128, 129, 255, 256, 1000, 2047, 2048, 3967, 3968, 4065, 4066, 4080, 4081, 4094, 4095, 4096, 4097, 4127, 4224,
                            8191, 8192, 8320, 12288, 12415, 16382, 16383, 16384, 16385, 16386, 16387, 16388, 16391, 16639, 16640, 16892, 16893, 16894, 16895, 5000, 9999, 15000};
__device__ int dbg_row(int i) { return dbg_rows_tab[i]; }
__device__ void dbg_acc(float* accf, int id, float e, float r) {
    __shared__ float se[256], sr[256];
    const int t = threadIdx.x; se[t] = e; sr[t] = r; __syncthreads();
    for (int o = 128; o > 0; o >>= 1) { if (t < o) { se[t] += se[t + o]; sr[t] += sr[t + o]; } __syncthreads(); }
    if (t == 0) { atomicAdd(accf + 2 * id, se[0]); atomicAdd(accf + 2 * id + 1, sr[0]); }
    __syncthreads();
}
__device__ float dbg_h(const u16* p, size_t i) { return (float)(*(const _Float16*)(p + i)); }
__device__ float dbg_block_sum(float v) { __shared__ float sb[256]; const int t = threadIdx.x; sb[t] = v; __syncthreads(); for (int o = 128; o > 0; o >>= 1) { if (t < o) sb[t] += sb[t + o]; __syncthreads(); } const float r = sb[0]; __syncthreads(); return r; }
__device__ void dbg_ln4(float (&x)[4], float& rstd) { const float mean = dbg_block_sum(x[0] + x[1] + x[2] + x[3]) / D; float q = 0; for (int i = 0; i < 4; ++i) { x[i] -= mean; q += x[i] * x[i]; } rstd = 1.f / sqrtf(dbg_block_sum(q) / D + LN_EPS); }
#define DBG_E(fast, ref) do { const float f_ = (fast), r_ = (ref); e += (f_ - r_) * (f_ - r_); rr += r_ * r_; } while (0)
__global__ void __launch_bounds__(256) dbg_p0(Params p) {
    float* accf = (float*)(p.ws + WS_DBGACC); const int t = threadIdx.x, bid = blockIdx.x;
    { float e = 0, rr = 0; const int ri = (bid >> 2) % 9;
        const int l = bid & 3, row = ri < 6 ? ri : (ri == 6 ? 67 : 123 + ri);
        const float* c = row < NB ? p.c_prompt + (size_t)row * D : p.c_sample + (size_t)(row - NB) * D;
        for (int n = t * 12 + (bid % 12); n < 3072; n += 256 * 12) { float a = p.b_mod[l * 3072 + n];
            for (int k = 0; k < D; ++k) { const float x = c[k]; a += x / (1.f + expf(-x)) * p.w_mod[((size_t)l * D + k) * 3072 + n]; }
            DBG_E(((const float*)(p.ws + WS_MOD))[((size_t)l * NMOD + row) * 3072 + n], a); }
        dbg_acc(accf, 0, e, rr); }
    { float e = 0, rr = 0;
        for (int i = 0; i < 64; ++i) { const int l = bid & 3, col = (bid * 37 + i * 41 + t * 10) % DIN, k = (t * 4 + i * 16 + bid) % D;
            DBG_E(dbg_h((const u16*)(p.ws + WS_WIN), ((size_t)l * DIN + perm_in(col)) * D + k), p.w_in[((size_t)l * D + k) * DIN + col]); }
        dbg_acc(accf, 1, e, rr); }
    { float e = 0, rr = 0;
        for (int i = 0; i < 64; ++i) { const int l = bid & 3, col = (bid * 37 + i * 41 + t * 4) % D, k = (t * 4 + i * 16 + bid) % D;
            DBG_E(dbg_h((const u16*)(p.ws + WS_WOUT), ((size_t)l * D + perm_out(col)) * D + k), p.w_out[((size_t)l * D + k) * D + col]); }
        dbg_acc(accf, 2, e, rr); }
    { float e = 0, rr = 0;
        for (int i = 0; i < 16; ++i) { const int pi = (bid * 113 + i * 257 + t * 16) % (SEQ + DS), f = (t + i) & 31; const int pos = pi < SEQ ? pi : PAST + pi - SEQ;
            const float ang = (float)pos * p.inv_freq[f]; const f32x2 cs = ((const f32x2*)(p.ws + WS_TAB))[pi * 32 + f];
            DBG_E(cs[0], cosf(ang)); DBG_E(cs[1], sinf(ang)); }
        dbg_acc(accf, 3, e, rr); }
}
__global__ void __launch_bounds__(256) dbg_p0b(Params p) {
    float* accf = (float*)(p.ws + WS_DBGACC); const int t = threadIdx.x, bid = blockIdx.x;
    { float e = 0, rr = 0;
        const int l = bid & 3, b = (bid >> 2) & 3; const float* md = (const float*)(p.ws + WS_MOD) + ((size_t)l * NMOD + b) * 3072;
        const int col = (t * 10 + (bid >> 4) * 3 + 1) % DIN; float v1 = 0, v2 = 0, v3 = 0, v4 = 0;
        for (int c = 0; c < D; ++c) { const float w = p.w_in[((size_t)l * D + c) * DIN + col], g = l > 0 ? p.ln_g[(l - 1) * D + c] : 1.f, bb = l > 0 ? p.ln_b[(l - 1) * D + c] : 0.f, s1 = 1.f + md[1024 + c];
            v1 += g * s1 * w; v2 += bb * s1 * w; v3 += s1 * w; v4 += md[c] * w; }
        const float* mv = (const float*)(p.ws + WS_MODV) + (size_t)(l * NB + b) * 4 * DIN + perm_in(col);
        DBG_E(mv[0], v1); DBG_E(mv[2 * DIN], v3); DBG_E(mv[3 * DIN], v4); if (l > 0) DBG_E(mv[DIN], v2); else e += mv[DIN] * mv[DIN];
        dbg_acc(accf, 69, e, rr); }
    if (bid < DBG_NS) { const int row = dbg_row(bid); const bool smp = row >= MP; const int bidx = smp ? NB + ((row - MP) >> 2) : (row >> 12);
        const float* md = (const float*)(p.ws + WS_MOD) + (size_t)bidx * 3072;
        float x[4]; for (int i = 0; i < 4; ++i) { const int c = t + 256 * i; x[i] = smp ? p.x_sample[(size_t)(row - MP) * D + c] : p.x_prompt[(size_t)row * D + c]; }
        float e = 0, rr = 0; for (int i = 0; i < 4; ++i) DBG_E(dbg_h((const u16*)(p.ws + (smp ? WS_XR : WS_ZH)), (size_t)row * D + t + 256 * i), x[i]); dbg_acc(accf, 70, e, rr);
        e = 0; rr = 0;
        if (!smp) { for (int i = 0; i < 4; ++i) { const int c = t + 256 * i; DBG_E(dbg_h((const u16*)(p.ws + WS_H), (size_t)row * D + c), x[i] * (1.f + md[1024 + c])); } }
        else { float rstd; dbg_ln4(x, rstd); for (int i = 0; i < 4; ++i) { const int c = t + 256 * i; DBG_E(dbg_h((const u16*)(p.ws + WS_H), (size_t)row * D + c), x[i] * rstd * (1.f + md[1024 + c]) + md[c]); } }
        dbg_acc(accf, 71, e, rr); }
}
__global__ void __launch_bounds__(256) dbg_copyz(Params p) { const int row = dbg_row(blockIdx.x);
    for (int c = threadIdx.x; c < D; c += 256) { ((u16*)(p.ws + WS_DBGZ))[blockIdx.x * D + c] = ((const u16*)(p.ws + WS_ZH))[(size_t)row * D + c]; ((u16*)(p.ws + WS_DBGZ))[(DBG_NS + blockIdx.x) * D + c] = ((const u16*)(p.ws + WS_XR))[(size_t)row * D + c]; } }
__global__ void __launch_bounds__(256) dbg_in(Params p, int l) {
    __shared__ float pr[DIN]; __shared__ float hh[D];
    float* accf = (float*)(p.ws + WS_DBGACC); const int t = threadIdx.x, row = dbg_row(blockIdx.x), base = 4 + 16 * l;
    const bool smp = row >= MP; const int b = smp ? (row - MP) >> 2 : row >> 12, tt = smp ? (row - MP) & 3 : row & (SEQ - 1), pos = smp ? PAST + tt : tt;
    const int bidx = smp ? NB + b : b; const float* md = (const float*)(p.ws + WS_MOD) + ((size_t)l * NMOD + bidx) * 3072;
    float e, rr;
    { float x[4]; float rstd;
        for (int i = 0; i < 4; ++i) x[i] = dbg_h((const u16*)(p.ws + (smp ? WS_XR : WS_ZH)), (size_t)row * D + t + 256 * i);
        if (!smp && l > 0) { dbg_ln4(x, rstd); for (int i = 0; i < 4; ++i) { const int c = t + 256 * i; x[i] = x[i] * rstd * p.ln_g[(l - 1) * D + c] + p.ln_b[(l - 1) * D + c]; } }
        dbg_ln4(x, rstd);
        for (int i = 0; i < 4; ++i) { const int c = t + 256 * i; hh[c] = x[i] * rstd * (1.f + md[1024 + c]) + md[c]; }
        __syncthreads();
        if (smp) { e = 0; rr = 0; for (int i = 0; i < 4; ++i) { const int c = t + 256 * i; DBG_E(dbg_h((const u16*)(p.ws + WS_H), (size_t)row * D + c), hh[c]); } dbg_acc(accf, base + 1, e, rr); } }
    for (int i = 0; i < 10; ++i) { const int col = t + 256 * i; float a = 0; for (int k = 0; k < D; ++k) a += hh[k] * p.w_in[((size_t)l * D + k) * DIN + col]; pr[col] = a; }
    __syncthreads();
    const float av = pr[t] / (1.f + expf(-pr[256 + t]));
    e = 0; rr = 0; DBG_E(dbg_h((const u16*)(p.ws + WS_PA), (size_t)row * 256 + t), av); dbg_acc(accf, base + 2, e, rr);
    e = 0; rr = 0; { const float z = pr[512 + t]; DBG_E(dbg_h((const u16*)(p.ws + WS_PSZC), (size_t)row * 256 + t), z / (1.f + expf(-z))); } dbg_acc(accf, base + 3, e, rr);
    e = 0; rr = 0; DBG_E(dbg_h((const u16*)(p.ws + WS_PPV), (size_t)row * 256 + t), pr[768 + t]); dbg_acc(accf, base + 4, e, rr);
    e = 0; rr = 0; { const float z = pr[1024 + t]; DBG_E(dbg_h((const u16*)(p.ws + WS_PSZP), (size_t)row * 256 + t), z / (1.f + expf(-z))); } dbg_acc(accf, base + 5, e, rr);
    e = 0; rr = 0;
    for (int i = 0; i < 2; ++i) { const int c = t + 256 * i, hd = c >> 6, d = c & 63, f = d & 31; const float ang = (float)pos * p.inv_freq[f], cs = cosf(ang), sn = sinf(ang);
        const float x = pr[1280 + c], xo = d < 32 ? -pr[1280 + hd * 64 + d + 32] : pr[1280 + hd * 64 + d - 32];
        DBG_E(dbg_h((const u16*)(p.ws + WS_PQ), (size_t)row * 512 + c), (x * cs + xo * sn) * QSCALE); }
    dbg_acc(accf, base + 6, e, rr);
    e = 0; rr = 0; float kref = 0.f, vref = 0.f;
    if (t < 128) { const int hd = t >> 6, d = t & 63, f = d & 31; const float ang = (float)pos * p.inv_freq[f], cs = cosf(ang), sn = sinf(ang);
        const float x = pr[1792 + t], xo = d < 32 ? -pr[1792 + hd * 64 + d + 32] : pr[1792 + hd * 64 + d - 32]; kref = x * cs + xo * sn;
        DBG_E(dbg_h((const u16*)(p.ws + WS_PK), (size_t)row * 128 + t), kref); }
    dbg_acc(accf, base + 7, e, rr);
    e = 0; rr = 0; if (t < 128) { vref = pr[1920 + t]; DBG_E(dbg_h((const u16*)(p.ws + WS_PV), (size_t)row * 128 + t), vref); } dbg_acc(accf, base + 8, e, rr);
    e = 0; rr = 0; for (int i = 0; i < 2; ++i) { const float z = pr[2048 + t + 256 * i]; DBG_E(dbg_h((const u16*)(p.ws + WS_PSZA), (size_t)row * 512 + t + 256 * i), z / (1.f + expf(-z))); } dbg_acc(accf, base + 9, e, rr);
    e = 0; rr = 0;
    if (smp) { DBG_E(p.out[OFF_CONVS + ((size_t)(l * DB + b) * 30 + 26 + tt) * 256 + t], av); DBG_E(p.out[OFF_POOLS + ((size_t)(l * DB + b) * 15 + 11 + tt) * 256 + t], pr[768 + t]);
        if (t < 128) { DBG_E(p.out[OFF_KS + ((size_t)(l * DB + b) * 128 + 124 + tt) * 128 + t], kref); DBG_E(p.out[OFF_VS + ((size_t)(l * DB + b) * 128 + 124 + tt) * 128 + t], vref); } }
    else { if (tt >= SEQ - 30) DBG_E(p.out[OFF_CONVP + ((size_t)(l * NB + b) * 30 + tt - (SEQ - 30)) * 256 + t], av);
        if (tt >= SEQ - 15) DBG_E(p.out[OFF_POOLP + ((size_t)(l * NB + b) * 15 + tt - (SEQ - 15)) * 256 + t], pr[768 + t]);
        if (tt >= SEQ - 128 && t < 128) { DBG_E(p.out[OFF_KP + ((size_t)(l * NB + b) * 128 + tt - (SEQ - 128)) * 128 + t], kref); DBG_E(p.out[OFF_VP + ((size_t)(l * NB + b) * 128 + tt - (SEQ - 128)) * 128 + t], vref); } }
    dbg_acc(accf, base + 10, e, rr);
}
__global__ void __launch_bounds__(256) dbg_mix(Params p, int l) {
    __shared__ float sh[1024]; __shared__ float sc[136];
    float* accf = (float*)(p.ws + WS_DBGACC); const int t = threadIdx.x, row = dbg_row(blockIdx.x), base = 4 + 16 * l;
    const bool smp = row >= MP; const int b = smp ? (row - MP) >> 2 : row >> 12, tt = smp ? (row - MP) & 3 : row & (SEQ - 1);
    const u16 *PA = (const u16*)(p.ws + WS_PA), *PSZC = (const u16*)(p.ws + WS_PSZC), *PPV = (const u16*)(p.ws + WS_PPV), *PSZP = (const u16*)(p.ws + WS_PSZP), *PQ = (const u16*)(p.ws + WS_PQ),
              *PSZA = (const u16*)(p.ws + WS_PSZA), *PK = (const u16*)(p.ws + WS_PK), *PV = (const u16*)(p.ws + WS_PV), *MIX = (const u16*)(p.ws + WS_MIX);
    float e, rr;
    {
        float a = p.conv_b[l * 256 + t];
        for (int j = 0; j < 31; ++j) { float x;
            if (!smp) { const int ts = tt - 30 + j; x = ts >= 0 ? dbg_h(PA, ((size_t)b * SEQ + ts) * 256 + t) : 0.f; }
            else { const int ri = tt + j; x = ri < 30 ? p.cache_conv[((size_t)(l * DB + b) * 30 + ri) * 256 + t] : dbg_h(PA, ((size_t)MP + 4 * b + ri - 30) * 256 + t); }
            a += p.conv_w[((size_t)l * 31 + j) * 256 + t] * x; }
        const float mean = dbg_block_sum(a) / 256.f; const float d = a - mean; const float rstd = 1.f / sqrtf(dbg_block_sum(d * d) / 256.f + LN_EPS);
        const float y = d * rstd * p.cnorm_g[l * 256 + t] + p.cnorm_b[l * 256 + t];
        e = 0; rr = 0; DBG_E(dbg_h(MIX, (size_t)row * D + t), y / (1.f + expf(-y)) * dbg_h(PSZC, (size_t)row * 256 + t)); dbg_acc(accf, base + 11, e, rr); }
    {
        const int w = 2 << (t >> 6); float s = 0;
        for (int i = 0; i < w; ++i) { float x;
            if (!smp) { const int ts = tt - i; x = ts >= 0 ? dbg_h(PPV, ((size_t)b * SEQ + ts) * 256 + t) : 0.f; }
            else { const int ri = 15 + tt - i; x = ri < 15 ? p.cache_pool[((size_t)(l * DB + b) * 15 + ri) * 256 + t] : dbg_h(PPV, ((size_t)MP + 4 * b + ri - 15) * 256 + t); }
            s += x; }
        const float cnt = smp ? (float)w : (float)(w < tt + 1 ? w : tt + 1);
        sh[t] = s / cnt - dbg_h(PPV, (size_t)row * 256 + t); __syncthreads();
        const int g = t >> 6, n = t & 63; float y = 0; for (int c = 0; c < 64; ++c) y += sh[64 * g + c] * p.pool_w[(((size_t)l * 4 + g) * 64 + c) * 64 + n];
        e = 0; rr = 0; DBG_E(dbg_h(MIX, (size_t)row * D + 256 + t), y * p.pool_scale[l * 256 + t] * dbg_h(PSZP, (size_t)row * 256 + t)); dbg_acc(accf, base + 12, e, rr); __syncthreads(); }
    {
        e = 0; rr = 0;
        for (int hd = 0; hd < 8; ++hd) { const int hk = hd >> 2; __syncthreads();
            if (t < 64) sh[t] = dbg_h(PQ, (size_t)row * 512 + hd * 64 + t); __syncthreads();
            const float sink2 = p.sinks[l * 8 + hd] * LOG2E;
            if (t < 128) { float s = -INFINITY;
                if (!smp) { const int ts = tt - 127 + t; if (ts >= 0) { s = 0; for (int d = 0; d < 64; ++d) s += sh[d] * dbg_h(PK, ((size_t)b * SEQ + ts) * 128 + hk * 64 + d); } }
                else { const int ci = tt + 1 + t;
                    s = 0; for (int d = 0; d < 64; ++d) s += sh[d] * (ci < 128 ? p.cache_k[(((size_t)(l * DB + b) * 128 + ci) * 2 + hk) * 64 + d] : dbg_h(PK, ((size_t)MP + 4 * b + ci - 128) * 128 + hk * 64 + d)); }
                sc[t] = s; }
            __syncthreads();
            float mx = sink2; for (int k = 0; k < 128; ++k) mx = fmaxf(mx, sc[k]);
            float den = exp2f(sink2 - mx); for (int k = 0; k < 128; ++k) den += exp2f(sc[k] - mx);
            if (t < 64) { float o = 0;
                for (int k = 0; k < 128; ++k) { const float pk = exp2f(sc[k] - mx) / den; if (pk == 0.f) continue; float v;
                    if (!smp) { const int ts = tt - 127 + k; v = dbg_h(PV, ((size_t)b * SEQ + ts) * 128 + hk * 64 + t); }
                    else { const int ci = tt + 1 + k; v = ci < 128 ? p.cache_v[(((size_t)(l * DB + b) * 128 + ci) * 2 + hk) * 64 + t] : dbg_h(PV, ((size_t)MP + 4 * b + ci - 128) * 128 + hk * 64 + t); }
                    o += pk * v; }
                DBG_E(dbg_h(MIX, (size_t)row * D + 512 + hd * 64 + t), o * dbg_h(PSZA, (size_t)row * 512 + hd * 64 + t)); } }
        dbg_acc(accf, base + 13, e, rr); }
    if (smp) { e = 0; rr = 0;
        for (int i = 0; i < 26; ++i) DBG_E(p.out[OFF_CONVS + ((size_t)(l * DB + b) * 30 + i) * 256 + t], p.cache_conv[((size_t)(l * DB + b) * 30 + i + 4) * 256 + t]);
        for (int i = 0; i < 11; ++i) DBG_E(p.out[OFF_POOLS + ((size_t)(l * DB + b) * 15 + i) * 256 + t], p.cache_pool[((size_t)(l * DB + b) * 15 + i + 4) * 256 + t]);
        for (int i = 0; i < 124; ++i) if (t < 128) { DBG_E(p.out[OFF_KS + ((size_t)(l * DB + b) * 128 + i) * 128 + t], p.cache_k[((size_t)(l * DB + b) * 128 + i + 4) * 128 + t]);
            DBG_E(p.out[OFF_VS + ((size_t)(l * DB + b) * 128 + i) * 128 + t], p.cache_v[((size_t)(l * DB + b) * 128 + i + 4) * 128 + t]); }
        dbg_acc(accf, base + 15, e, rr); }
}
__global__ void __launch_bounds__(256) dbg_out(Params p, int l) {
    __shared__ float mm[D];
    float* accf = (float*)(p.ws + WS_DBGACC); const int t = threadIdx.x, row = dbg_row(blockIdx.x), base = 4 + 16 * l;
    const bool smp = row >= MP; const int bidx = smp ? NB + ((row - MP) >> 2) : (row >> 12);
    for (int c = t; c < D; c += 256) mm[c] = dbg_h((const u16*)(p.ws + WS_MIX), (size_t)row * D + c);
    __syncthreads();
    const float* md = (const float*)(p.ws + WS_MOD) + ((size_t)l * NMOD + bidx) * 3072 + 2048;
    const float* mdn = (const float*)(p.ws + WS_MOD) + ((size_t)(l + 1) * NMOD + bidx) * 3072;
    float x1[4], z[4], rstd;
    for (int i = 0; i < 4; ++i) x1[i] = dbg_h((const u16*)(p.ws + WS_DBGZ), (size_t)((smp ? DBG_NS : 0) + blockIdx.x) * D + t + 256 * i);
    if (!smp && l > 0) { dbg_ln4(x1, rstd); for (int i = 0; i < 4; ++i) { const int c = t + 256 * i; x1[i] = x1[i] * rstd * p.ln_g[(l - 1) * D + c] + p.ln_b[(l - 1) * D + c]; } }
    float e = 0, rr = 0;
    for (int i = 0; i < 4; ++i) { const int c = t + 256 * i; float a = 0; for (int k = 0; k < D; ++k) a += mm[k] * p.w_out[((size_t)l * D + k) * D + c];
        z[i] = ALPHA * x1[i] + (1.f + md[c]) * a; DBG_E(dbg_h((const u16*)(p.ws + WS_ZH), (size_t)row * D + c), z[i]); }
    dbg_acc(accf, base + 14, e, rr);
    e = 0; rr = 0;
    if (!smp) { if (l < DEPTH - 1) for (int i = 0; i < 4; ++i) { const int c = t + 256 * i; DBG_E(dbg_h((const u16*)(p.ws + WS_H), (size_t)row * D + c), z[i] * p.ln_g[l * D + c] * (1.f + mdn[1024 + c])); } }
    else { dbg_ln4(z, rstd); for (int i = 0; i < 4; ++i) { const int c = t + 256 * i; z[i] = z[i] * rstd * p.ln_g[l * D + c] + p.ln_b[l * D + c]; }
        if (l == DEPTH - 1) { for (int i = 0; i < 4; ++i) DBG_E(p.out[OFF_YS + (size_t)(row - MP) * D + t + 256 * i], z[i]); }
        else { for (int i = 0; i < 4; ++i) DBG_E(dbg_h((const u16*)(p.ws + WS_XR), (size_t)row * D + t + 256 * i), z[i]);
            dbg_ln4(z, rstd); for (int i = 0; i < 4; ++i) { const int c = t + 256 * i; DBG_E(dbg_h((const u16*)(p.ws + WS_H), (size_t)row * D + c), z[i] * rstd * (1.f + mdn[1024 + c]) + mdn[c]); } } }
    dbg_acc(accf, base + 0, e, rr);
    if (l == 0) { dbg_acc(accf, 100, smp ? 0.f : e, smp ? 0.f : rr); dbg_acc(accf, 101, smp ? e : 0.f, smp ? rr : 0.f); }
}
__global__ void __launch_bounds__(256) dbg_fin(Params p) {
    float* accf = (float*)(p.ws + WS_DBGACC); const int t = threadIdx.x, row = dbg_row(blockIdx.x);
    if (row >= MP) return;
    float x[4]; for (int i = 0; i < 4; ++i) x[i] = dbg_h((const u16*)(p.ws + WS_ZH), (size_t)row * D + t + 256 * i);
    float rstd; dbg_ln4(x, rstd); float e = 0, rr = 0;
    for (int i = 0; i < 4; ++i) { const int c = t + 256 * i; DBG_E(p.out[(size_t)row * D + c], x[i] * rstd * p.ln_g[3 * D + c] + p.ln_b[3 * D + c]); }
    dbg_acc(accf, 68, e, rr);
}
#ifndef DBG_REPORT_ID
#define DBG_REPORT_ID -1
#endif
__global__ void __launch_bounds__(256) dbg_report(Params p) {
    const float* accf = (const float*)(p.ws + WS_DBGACC);
    float code = 1000.f;
    if (DBG_REPORT_ID >= 0) { const float e = accf[2 * DBG_REPORT_ID], r = accf[2 * DBG_REPORT_ID + 1]; code = (r > 0.f ? e / r : 9.9f) * 1e12f; if (!(code > 100.f)) code = 100.f; }
    else for (int i = 0; i < 128; ++i) { const float e = accf[2 * i], r = accf[2 * i + 1]; const bool expected = i <= 71 && !(i >= 4 && i < 68 && ((i - 4) & 15) == 0 && (i - 4) / 16 == 99);
        if ((r > 0.f && !(e / r < 1e-3f)) || (r == 0.f && (e > 0.f || expected)) || e != e || r != r) { code = (float)(i + 1) * 1e4f; break; } }
    const float S = sqrtf(code);
    for (size_t i = (size_t)blockIdx.x * 256 + threadIdx.x; i < (size_t)MP * D; i += (size_t)gridDim.x * 256) p.out[i] = S;
}
#endif

extern "C" void kernel_launch(void* const* d_in, const int* in_sizes, int n_in, void* d_out, int out_size, void* d_ws, size_t ws_size, hipStream_t stream) {
    static int grid = 0;
    if (grid == 0) {
        if (n_in != 21 || (size_t)out_size != OUT_TOTAL || ws_size < WS_END) { fprintf(stderr, "kernel_launch: unexpected shapes (n_in %d, out %d, ws %zu)\n", n_in, out_size, ws_size); grid = -1; return; }
        int dev = 0, cus = 0;
        if (hipGetDevice(&dev) != hipSuccess || hipDeviceGetAttribute(&cus, hipDeviceAttributeMultiprocessorCount, dev) != hipSuccess) { grid = -1; return; }
        if (hipFuncSetAttribute((const void*)hymba_fwd, hipFuncAttributeMaxDynamicSharedMemorySize, LDS_BYTES) != hipSuccess) { fprintf(stderr, "kernel_launch: hipFuncSetAttribute failed\n"); grid = -1; return; }
        (void)hipGetLastError();
        grid = cus;
    }
    if (grid < 0) return;
    (void)hipMemsetAsync((char*)d_ws + WS_CTL, 0, CTL_ZERO_BYTES, stream);
    Params a{};
    a.x_prompt = (const float*)d_in[0]; a.x_sample = (const float*)d_in[1]; a.cache_conv = (const float*)d_in[2]; a.cache_pool = (const float*)d_in[3];
    a.cache_k = (const float*)d_in[4]; a.cache_v = (const float*)d_in[5]; a.c_prompt = (const float*)d_in[6]; a.c_sample = (const float*)d_in[7];
    a.w_in = (const float*)d_in[8]; a.w_out = (const float*)d_in[9]; a.conv_w = (const float*)d_in[10]; a.conv_b = (const float*)d_in[11];
    a.cnorm_g = (const float*)d_in[12]; a.cnorm_b = (const float*)d_in[13]; a.pool_w = (const float*)d_in[14]; a.pool_scale = (const float*)d_in[15];
    a.sinks = (const float*)d_in[16]; a.w_mod = (const float*)d_in[17]; a.b_mod = (const float*)d_in[18]; a.ln_g = (const float*)d_in[19]; a.ln_b = (const float*)d_in[20];
    a.out = (float*)d_out; a.ws = (unsigned char*)d_ws;
    for (int i = 0; i < 32; ++i) a.inv_freq[i] = (float)std::pow(10000.0, -(double)i * (2.0 / 64.0));
    if (MK_N_LAUNCHES == 1) { a.ph_lo = 0; a.ph_hi = N_PHASES; hipLaunchKernelGGL(hymba_fwd, dim3(grid), dim3(NTHR), LDS_BYTES, stream, a); }
    else for (int ph = 0; ph < N_PHASES; ++ph) {
#ifdef DBG
        if (ph >= 2 && ph < N_PHASES - 1 && (ph - 2) % 3 == 2) hipLaunchKernelGGL(dbg_copyz, dim3(DBG_NS), dim3(256), 0, stream, a);
#endif
        a.ph_lo = ph; a.ph_hi = ph + 1; hipLaunchKernelGGL(hymba_fwd, dim3(grid), dim3(NTHR), LDS_BYTES, stream, a);
#ifdef DBG
        if (ph == 0) hipLaunchKernelGGL(dbg_p0, dim3(144), dim3(256), 0, stream, a);
        else if (ph == 1) hipLaunchKernelGGL(dbg_p0b, dim3(144), dim3(256), 0, stream, a);
        else if (ph == N_PHASES - 1) { hipLaunchKernelGGL(dbg_fin, dim3(DBG_NS), dim3(256), 0, stream, a); hipLaunchKernelGGL(dbg_report, dim3(1024), dim3(256), 0, stream, a); }
        else { const int l = (ph - 2) / 3, k = (ph - 2) % 3;
            if (k == 0) hipLaunchKernelGGL(dbg_in, dim3(DBG_NS), dim3(256), 0, stream, a, l);
            if (k == 1) hipLaunchKernelGGL(dbg_mix, dim3(DBG_NS), dim3(256), 0, stream, a, l);
            if (k == 2) hipLaunchKernelGGL(dbg_out, dim3(DBG_NS), dim3(256), 0, stream, a, l); }
#endif
    }
}
```

```cpp
#include <hip/hip_runtime.h>
#include <cstdint>
#include <cstdio>
#include <cmath>

#define DBG_REPORT_ID -1
#ifndef MK_N_LAUNCHES
#define MK_N_LAUNCHES 1
#endif

#define DI __device__ __forceinline__
#define GAS __attribute__((address_space(1)))
#define LAS __attribute__((address_space(3)))
typedef unsigned short u16;
typedef _Float16 h8 __attribute__((ext_vector_type(8)));
typedef _Float16 h4 __attribute__((ext_vector_type(4)));
typedef _Float16 h2 __attribute__((ext_vector_type(2)));
typedef float f32x2 __attribute__((ext_vector_type(2)));
typedef float f32x4 __attribute__((ext_vector_type(4)));
typedef float f32x16 __attribute__((ext_vector_type(16)));
typedef unsigned u32x4 __attribute__((ext_vector_type(4)));
typedef unsigned u32x2 __attribute__((ext_vector_type(2)));
typedef short v4i16_t __attribute__((ext_vector_type(4)));

constexpr int D = 1024, DIN = 2560, NB = 4, SEQ = 4096, DEPTH = 4, DB = 128, DS = 4;
constexpr int MP = NB * SEQ, MS = DB * DS, M = MP + MS;
constexpr int NMOD = NB + DB;
constexpr int PAST = 8192;
constexpr float LN_EPS = 1e-5f;
constexpr float ALPHA = 1.681792830507429f;
constexpr float LOG2E = 1.4426950408889634f;
constexpr float QSCALE = 0.125f * LOG2E;
constexpr size_t OFF_YP = 0, OFF_YS = OFF_YP + (size_t)MP * D, OFF_CONVP = OFF_YS + (size_t)MS * D, OFF_POOLP = OFF_CONVP + (size_t)DEPTH * NB * 30 * 256,
                 OFF_KP = OFF_POOLP + (size_t)DEPTH * NB * 15 * 256, OFF_VP = OFF_KP + (size_t)DEPTH * NB * 128 * 128, OFF_CONVS = OFF_VP + (size_t)DEPTH * NB * 128 * 128,
                 OFF_POOLS = OFF_CONVS + (size_t)DEPTH * DB * 30 * 256, OFF_KS = OFF_POOLS + (size_t)DEPTH * DB * 15 * 256, OFF_VS = OFF_KS + (size_t)DEPTH * DB * 128 * 128,
                 OUT_TOTAL = OFF_VS + (size_t)DEPTH * DB * 128 * 128;
constexpr size_t MiB = 1u << 20;
constexpr size_t WS_CTL = 0, CTL_ZERO_BYTES = 64 * 1024;
constexpr size_t WS_WIN = 1 * MiB;
constexpr size_t WS_WOUT = 21 * MiB;
constexpr size_t WS_MOD = 29 * MiB;
constexpr size_t WS_TAB = 36 * MiB;
constexpr size_t WS_ZH = 38 * MiB;
constexpr size_t WS_XR = 71 * MiB;
constexpr size_t WS_MIX = 104 * MiB;
constexpr size_t WS_PA = 137 * MiB;
constexpr size_t WS_PSZC = WS_PA + (size_t)M * 256 * 2, WS_PPV = WS_PSZC + (size_t)M * 256 * 2, WS_PSZP = WS_PPV + (size_t)M * 256 * 2;
constexpr size_t WS_PQ = WS_PSZP + (size_t)M * 256 * 2;
constexpr size_t WS_PSZA = WS_PQ + (size_t)M * 512 * 2;
constexpr size_t WS_PK = WS_PSZA + (size_t)M * 512 * 2;
constexpr size_t WS_PV = WS_PK + (size_t)M * 128 * 2;
constexpr size_t WS_H = WS_PV + (size_t)M * 128 * 2;
constexpr size_t WS_PS = WS_H + (size_t)M * D * 2;
constexpr size_t WS_RC0 = WS_PS + 2 * (size_t)MP * 24 * 4;
constexpr size_t WS_MODV = WS_RC0 + (size_t)MP * 16;
constexpr size_t WS_LNC = WS_MODV + (size_t)DEPTH * NB * 4 * DIN * 4;
constexpr size_t WS_VT = WS_LNC + 256;
constexpr size_t WS_END = WS_VT + (size_t)NB * 2 * 64 * SEQ * 2;
static_assert(WS_END <= 256 * MiB, "d_ws map");
constexpr int CW_BAR = 1024;
constexpr int CW_SCNT = 12288;

DI unsigned pkh(float a, float b) { f32x2 v = {a, b}; h2 r = __builtin_convertvector(v, h2); return __builtin_bit_cast(unsigned, r); }
DI u32x4 pack8(const float* v) { u32x4 w; w.x = pkh(v[0], v[1]); w.y = pkh(v[2], v[3]); w.z = pkh(v[4], v[5]); w.w = pkh(v[6], v[7]); return w; }
DI void unpack8(u32x4 w, float* o) {
    const h8 v = __builtin_bit_cast(h8, w);
#pragma unroll
    for (int j = 0; j < 8; ++j) o[j] = (float)v[j];
}
DI float ex2(float x) { return __builtin_amdgcn_exp2f(x); }
DI float sigm(float x) { return __builtin_amdgcn_rcpf(1.f + ex2(-x * LOG2E)); }
DI float silu(float x) { return x * sigm(x); }
template <int O> DI float xor_lane(float v) {
    return __builtin_bit_cast(float, __builtin_amdgcn_ds_swizzle(__builtin_bit_cast(int, v), (O << 10) | 0x1f));
}
DI float sum_halves(float v) { float a = v, b = v; asm volatile("s_nop 1\n\tv_permlane32_swap_b32 %0, %1" : "+v"(a), "+v"(b)); return a + b; }
DI float max_halves(float v) { float a = v, b = v; asm volatile("s_nop 1\n\tv_permlane32_swap_b32 %0, %1" : "+v"(a), "+v"(b)); return fmaxf(a, b); }
template <int CTRL, int ROWMASK> DI float dpp_f(float v, float ident) { return __builtin_bit_cast(float, __builtin_amdgcn_update_dpp(__builtin_bit_cast(int, ident), __builtin_bit_cast(int, v), CTRL, ROWMASK, 0xf, false)); }
DI float wave_sum(float v) {
    v += dpp_f<0xB1, 0xf>(v, 0.f); v += dpp_f<0x4E, 0xf>(v, 0.f); v += dpp_f<0x141, 0xf>(v, 0.f); v += dpp_f<0x140, 0xf>(v, 0.f);
    v += dpp_f<0x142, 0xa>(v, 0.f); v += dpp_f<0x143, 0xc>(v, 0.f);
    return __builtin_bit_cast(float, __builtin_amdgcn_readlane(__builtin_bit_cast(int, v), 63));
}
DI float wave_max(float v) {
    const float NI = -INFINITY;
    v = fmaxf(v, dpp_f<0xB1, 0xf>(v, NI)); v = fmaxf(v, dpp_f<0x4E, 0xf>(v, NI)); v = fmaxf(v, dpp_f<0x141, 0xf>(v, NI)); v = fmaxf(v, dpp_f<0x140, 0xf>(v, NI));
    v = fmaxf(v, dpp_f<0x142, 0xa>(v, NI)); v = fmaxf(v, dpp_f<0x143, 0xc>(v, NI));
    return __builtin_bit_cast(float, __builtin_amdgcn_readlane(__builtin_bit_cast(int, v), 63));
}
DI int lane_id() { int l_; asm volatile("v_mbcnt_lo_u32_b32 %0, -1, 0\n\tv_mbcnt_hi_u32_b32 %0, -1, %0" : "=v"(l_)); return l_; }
DI int crow(int r, int hi) { return (r & 3) + 8 * (r >> 2) + 4 * hi; }

__host__ __device__ __forceinline__ int pperm(int bj, int c7) { return 128 * bj + 32 * (c7 >> 5) + 16 * ((c7 >> 2) & 1) + 4 * ((c7 >> 3) & 3) + (c7 & 3); }
__host__ __device__ __forceinline__ int perm_in(int col) {
    if (col < 512) { const int bj = col >> 8, ch = col & 255; return 256 * (ch >> 7) + pperm(bj, ch & 127); }
    if (col < 1280) { const int base = col < 768 ? 512 : (col < 1024 ? 768 : 1024); const int x = col - base; return base + pperm(x >> 7, x & 127); }
    if (col < 1792) { const int x = col - 1280, head = x >> 6, d = x & 63; return 256 * (5 + (head >> 2)) + pperm(d >> 5, 32 * (head & 3) + (d & 31)); }
    if (col < 2048) { const int x = col - 1792, hh = x >> 6, d = x & 63; return 1792 + pperm(d >> 5, 32 * hh + (d & 31)); }
    { const int x = col - 2048; return 2048 + 256 * (x >> 8) + pperm((x >> 7) & 1, x & 127); }
}
__host__ __device__ __forceinline__ int perm_out(int col) { const int y = col & 255; return (col & ~255) + pperm(y >> 7, y & 127); }

namespace pg8 {
constexpr int BM = 256, BK = 64, HALF = 128, HTB = HALF * BK * 2, STAGE_BYTES = 8 * HTB, NXCD = 8, WGM = 8;
__host__ __device__ __forceinline__ int lds_byte(int r, int c) { const int st = (r >> 4) * 2 + (c >> 5), rr = r & 15, cc = c & 31, ob = rr * 64 + cc * 2; return st * 1024 + (ob ^ (((ob >> 9) & 1) << 5)); }
__host__ __device__ __forceinline__ void stage_rc(int b, int& R, int& C) { const int st = b / 1024, sb = b % 1024, swz = sb ^ (((sb >> 9) & 1) << 5); R = (st >> 1) * 16 + swz / 64; C = (st & 1) * 32 + (swz % 64) / 2; }
struct Unit { int pm, pn; };
struct Gemm { const u16* A; const u16* Bt; int M, N, K; };
struct StaticOrder {
    int nM, nN, nwg, G, c;
    __host__ __device__ void init(int M_, int N_, int G_, int c_) { nM = M_ / BM; nN = N_ / BM; nwg = nM * nN; G = G_; c = c_; }
    __host__ __device__ bool next(int i, Unit& u) const {
        const long L = (long)i * G + c; if (L >= nwg) return false;
        int wgid = (int)L; { const int q = nwg / NXCD, r = nwg % NXCD, xcd = wgid % NXCD, off = wgid / NXCD; wgid = (xcd < r ? xcd * (q + 1) : r * (q + 1) + (xcd - r) * q) + off; }
        const int nig = WGM * nN, gid = wgid / nig, fm = gid * WGM, gsz = (nM - fm) < WGM ? (nM - fm) : WGM;
        u.pm = fm + ((wgid % nig) % gsz); u.pn = (wgid % nig) / gsz; return true;
    }
};

template <class Epi, bool ALIGN_EPI>
DI void gemm_phase(LAS unsigned char* lds, const Gemm g, const StaticOrder& S, const Epi& E, const int tid) {
    const int wid = __builtin_amdgcn_readfirstlane(tid >> 6), lane = tid & 63, wr = wid >> 2, wc = wid & 3, fr = lane & 15, fq = lane >> 4;
    const int K = g.K, nt = K / BK;
    unsigned voffA[2];
#pragma unroll
    for (int i = 0; i < 2; ++i) { int R, C; stage_rc(tid * 16 + i * 8192, R, C); voffA[i] = (unsigned)(R * K + C) * 2u; }
    const size_t kstep = (size_t)(BK * 2);
    const size_t hstep = (size_t)HALF * K * 2;
    const size_t tstep = 2 * hstep;
    const unsigned ldsw = (unsigned)wid * 1024u;
    const int aoff = lds_byte(wr * 64 + fr, fq * 8), boff = lds_byte(wc * 32 + fr, fq * 8);
#define PG8_SA(b, h) (((b) * 2 + (h)) * HTB)
#define PG8_SB(b, h) ((4 + (b) * 2 + (h)) * HTB)
#define PG8_STAGE(bufoff, gbase) do { _Pragma("unroll") for (int _i = 0; _i < 2; ++_i) \
        __builtin_amdgcn_global_load_lds((const unsigned*)((const char*)(gbase) + voffA[_i]), (LAS unsigned*)(lds + (bufoff) + ldsw + _i * 8192), 16, 0, 0); } while (0)
#define PG8_LDA(dst, b, h) do { _Pragma("unroll") for (int m = 0; m < 4; ++m) _Pragma("unroll") for (int k = 0; k < 2; ++k) dst[m][k] = *(const LAS h8*)(lds + PG8_SA(b, h) + aoff + m * 2048 + k * 1024); } while (0)
#define PG8_LDB(dst, b, h) do { _Pragma("unroll") for (int n = 0; n < 2; ++n) _Pragma("unroll") for (int k = 0; k < 2; ++k) dst[n][k] = *(const LAS h8*)(lds + PG8_SB(b, h) + boff + n * 2048 + k * 1024); } while (0)
#define PG8_MMA(ai, bj, At, Bt) do { __builtin_amdgcn_s_setprio(1); _Pragma("unroll") for (int m = 0; m < 4; ++m) _Pragma("unroll") for (int n = 0; n < 2; ++n) _Pragma("unroll") for (int k = 0; k < 2; ++k) \
        acc[ai][bj][m][n] = __builtin_amdgcn_mfma_f32_16x16x32_f16(Bt[n][k], At[m][k], acc[ai][bj][m][n], 0, 0, 0); __builtin_amdgcn_s_setprio(0); } while (0)
#define PG8_WAIT_V(n) asm volatile("s_waitcnt vmcnt(" #n ")" ::: "memory")
#define PG8_WAIT_L(n) asm volatile("s_waitcnt lgkmcnt(" #n ")" ::: "memory")
#define PG8_BAR __builtin_amdgcn_s_barrier()
#define PG8_SCHED __builtin_amdgcn_sched_barrier(0)
    Unit cur, nxt; int ui = 0;
    if (!S.next(0, cur)) return;
    f32x4 acc[2][2][4][2];
#pragma unroll
    for (int a = 0; a < 2; ++a)
#pragma unroll
        for (int b = 0; b < 2; ++b)
#pragma unroll
            for (int m = 0; m < 4; ++m)
#pragma unroll
                for (int n = 0; n < 2; ++n) acc[a][b][m][n] = (f32x4){0.f, 0.f, 0.f, 0.f};
    h8 At[4][2], B0[2][2], B1[2][2];
    const char* cA = (const char*)g.A + (size_t)cur.pm * tstep; const char* cB = (const char*)g.Bt + (size_t)cur.pn * tstep;
    PG8_STAGE(PG8_SB(0, 0), cB); PG8_STAGE(PG8_SB(0, 1), cB + hstep); PG8_STAGE(PG8_SA(0, 0), cA); PG8_STAGE(PG8_SA(0, 1), cA + hstep);
    if (wr == 1) PG8_BAR;
    PG8_WAIT_V(2); PG8_BAR;
    PG8_STAGE(PG8_SB(1, 0), cB + kstep); PG8_STAGE(PG8_SA(1, 0), cA + kstep); PG8_STAGE(PG8_SB(1, 1), cB + hstep + kstep);
    PG8_WAIT_V(6); PG8_BAR;
    for (;;) {
        const bool has_next = S.next(ui + 1, nxt);
        const char* nA = has_next ? (const char*)g.A + (size_t)nxt.pm * tstep : cA; const char* nB = has_next ? (const char*)g.Bt + (size_t)nxt.pn * tstep : cB;
        for (int t = 0; t < nt; t += 2) {
            const bool last = (t == nt - 2);
            const char* a1 = cA + (size_t)(t + 1) * kstep;
            const char* a2 = last ? nA : cA + (size_t)(t + 2) * kstep; const char* b2 = last ? nB : cB + (size_t)(t + 2) * kstep;
            const char* a3 = a2 + kstep; const char* b3 = b2 + kstep;
            PG8_LDB(B0, 0, 0); PG8_LDB(B1, 0, 1); PG8_SCHED; PG8_LDA(At, 0, 0); PG8_STAGE(PG8_SA(1, 1), a1 + hstep);
            PG8_WAIT_V(8); PG8_WAIT_L(0); PG8_BAR; PG8_MMA(0, 0, At, B0); PG8_MMA(0, 1, At, B1); PG8_BAR; PG8_SCHED;
            PG8_LDA(At, 0, 1); PG8_STAGE(PG8_SB(0, 0), b2); PG8_STAGE(PG8_SB(0, 1), b2 + hstep); PG8_STAGE(PG8_SA(0, 0), a2);
            PG8_WAIT_V(8); PG8_WAIT_L(0); PG8_BAR; PG8_MMA(1, 0, At, B0); PG8_MMA(1, 1, At, B1); PG8_BAR; PG8_SCHED;
            PG8_LDB(B0, 1, 0); PG8_LDB(B1, 1, 1); PG8_SCHED; PG8_LDA(At, 1, 0); PG8_STAGE(PG8_SA(0, 1), a2 + hstep);
            PG8_WAIT_V(8); PG8_WAIT_L(0); PG8_BAR; PG8_MMA(0, 0, At, B0); PG8_MMA(0, 1, At, B1); PG8_BAR; PG8_SCHED;
            PG8_LDA(At, 1, 1); PG8_STAGE(PG8_SB(1, 0), b3); PG8_STAGE(PG8_SB(1, 1), b3 + hstep); PG8_STAGE(PG8_SA(1, 0), a3);
            PG8_WAIT_V(8); PG8_WAIT_L(0); PG8_BAR; PG8_MMA(1, 0, At, B0); PG8_MMA(1, 1, At, B1); PG8_BAR; PG8_SCHED;
        }
        if constexpr (ALIGN_EPI) { if (wr == 0) PG8_BAR; }
        if constexpr (!Epi::AFTER_DRAIN) E(acc, cur, ui, wr, wc, fr, fq);
        if (!has_next) break;
#pragma unroll
        for (int a = 0; a < 2; ++a)
#pragma unroll
            for (int b = 0; b < 2; ++b)
#pragma unroll
                for (int m = 0; m < 4; ++m)
#pragma unroll
                    for (int n = 0; n < 2; ++n) acc[a][b][m][n] = (f32x4){0.f, 0.f, 0.f, 0.f};
        cur = nxt; cA = nA; cB = nB; ++ui;
        if constexpr (ALIGN_EPI) { if (wr == 1) PG8_BAR; }
    }
    PG8_WAIT_V(0);
    if constexpr (!ALIGN_EPI) { if (wr == 0) PG8_BAR; }
    PG8_BAR;
    if constexpr (Epi::AFTER_DRAIN) E.fused(acc, cur, wr, wc, fr, fq, lds, tid);
#undef PG8_SA
#undef PG8_SB
#undef PG8_STAGE
#undef PG8_LDA
#undef PG8_LDB
#undef PG8_MMA
#undef PG8_WAIT_V
#undef PG8_WAIT_L
#undef PG8_BAR
#undef PG8_SCHED
}
}

struct Params {
    const float* x_prompt; const float* x_sample; const float* cache_conv; const float* cache_pool; const float* cache_k; const float* cache_v;
    const float* c_prompt; const float* c_sample; const float* w_in; const float* w_out; const float* conv_w; const float* conv_b; const float* cnorm_g; const float* cnorm_b;
    const float* pool_w; const float* pool_scale; const float* sinks; const float* w_mod; const float* b_mod; const float* ln_g; const float* ln_b;
    float* out; unsigned char* ws;
    int ph_lo, ph_hi;
    float inv_freq[32];
};
struct ParamsHead { const float* ptrs[21]; float* out; unsigned char* ws; int ph_lo, ph_hi; };
static_assert(sizeof(ParamsHead) == __builtin_offsetof(Params, inv_freq), "ParamsHead mirrors the head of Params");

DI void row_info(int row, bool& smp, int& b, int& t) { smp = row >= MP; if (!smp) { b = row >> 12; t = row & (SEQ - 1); } else { const int s = row - MP; b = s >> 2; t = s & 3; } }
DI void st8f(float* dst, const float* v) { *(f32x4*)dst = (f32x4){v[0], v[1], v[2], v[3]}; *(f32x4*)(dst + 4) = (f32x4){v[4], v[5], v[6], v[7]}; }

struct EpiIn {
    static constexpr bool AFTER_DRAIN = false;
    int l; unsigned char* ws; float* out; const LAS float* rcl;
    DI void operator()(f32x4 (&acc)[2][2][4][2], const pg8::Unit& u, int ui, int wr, int wc, int fr, int fq) const {
        asm volatile("" : "+v"(fr), "+v"(fq));
        const int pn = u.pn;
        if (u.pm < MP / 256) {
            const LAS f32x4* rc = (const LAS f32x4*)rcl + ui * 256 + wr * 64 + fr;
            const float* mv = (const float*)(ws + WS_MODV) + (size_t)(l * NB + (u.pm >> 4)) * 4 * DIN + pn * 256 + wc * 32 + 4 * fq;
#pragma unroll
            for (int bj = 0; bj < 2; ++bj)
#pragma unroll
                for (int n = 0; n < 2; ++n) { const float* mp = mv + 128 * bj + 16 * n;
                    const f32x4 v1 = *(const f32x4*)mp, v2 = *(const f32x4*)(mp + DIN), v3 = *(const f32x4*)(mp + 2 * DIN), v4 = *(const f32x4*)(mp + 3 * DIN);
#pragma unroll
                    for (int ai = 0; ai < 2; ++ai)
#pragma unroll
                        for (int m = 0; m < 4; ++m) { const f32x4 r = rc[ai * 128 + m * 16];
                            acc[ai][bj][m][n] = r[0] * acc[ai][bj][m][n] - r[1] * v1 + r[2] * v2 - r[3] * v3 + v4; } }
        }
        unsigned char* const W = ws; float* const O = out;
#define ST16(byteoff, vals) (*(u32x4*)(W + (size_t)(unsigned)(byteoff)) = pack8(vals))
#define STF8(fidx, vals) st8f(O + (size_t)(unsigned)(fidx), vals)
#pragma unroll
        for (int ai = 0; ai < 2; ++ai)
#pragma unroll
            for (int m = 0; m < 4; ++m) {
                const unsigned row = (unsigned)(u.pm * 256 + ai * 128 + wr * 64 + m * 16 + fr);
                const bool smp = row >= (unsigned)MP; const unsigned b = smp ? (row - MP) >> 2 : row >> 12, t = smp ? (row - MP) & 3u : row & (unsigned)(SEQ - 1);
                if (pn < 2) {
                    const unsigned c8 = pn * 128 + wc * 32 + fq * 8; float a[8];
#pragma unroll
                    for (int n = 0; n < 2; ++n)
#pragma unroll
                        for (int j = 0; j < 4; ++j) a[4 * n + j] = acc[ai][0][m][n][j] * sigm(acc[ai][1][m][n][j]);
                    ST16((unsigned)WS_PA + (row * 256 + c8) * 2, a);
                    if (smp) STF8((unsigned)OFF_CONVS + ((l * DB + b) * 30 + 26 + t) * 256 + c8, a);
                    else if (t >= SEQ - 30) STF8((unsigned)OFF_CONVP + ((l * NB + b) * 30 + (t - (SEQ - 30))) * 256 + c8, a);
                } else if (pn == 2 || pn == 4) {
                    const unsigned base = pn == 2 ? (unsigned)WS_PSZC : (unsigned)WS_PSZP;
#pragma unroll
                    for (int bj = 0; bj < 2; ++bj) { const unsigned c8 = bj * 128 + wc * 32 + fq * 8; float v[8];
#pragma unroll
                        for (int n = 0; n < 2; ++n)
#pragma unroll
                            for (int j = 0; j < 4; ++j) v[4 * n + j] = silu(acc[ai][bj][m][n][j]);
                        ST16(base + (row * 256 + c8) * 2, v); }
                } else if (pn == 3) {
#pragma unroll
                    for (int bj = 0; bj < 2; ++bj) { const unsigned c8 = bj * 128 + wc * 32 + fq * 8; float v[8];
#pragma unroll
                        for (int n = 0; n < 2; ++n)
#pragma unroll
                            for (int j = 0; j < 4; ++j) v[4 * n + j] = acc[ai][bj][m][n][j];
                        ST16((unsigned)WS_PPV + (row * 256 + c8) * 2, v);
                        if (smp) STF8((unsigned)OFF_POOLS + ((l * DB + b) * 15 + 11 + t) * 256 + c8, v);
                        else if (t >= SEQ - 15) STF8((unsigned)OFF_POOLP + ((l * NB + b) * 15 + (t - (SEQ - 15))) * 256 + c8, v); }
                } else if (pn >= 8) {
#pragma unroll
                    for (int bj = 0; bj < 2; ++bj) { const unsigned c8 = (pn - 8) * 256 + bj * 128 + wc * 32 + fq * 8; float v[8];
#pragma unroll
                        for (int n = 0; n < 2; ++n)
#pragma unroll
                            for (int j = 0; j < 4; ++j) v[4 * n + j] = silu(acc[ai][bj][m][n][j]);
                        ST16((unsigned)WS_PSZA + (row * 512 + c8) * 2, v); }
                } else if (pn == 7 && wc >= 2) {
                    const unsigned hv = wc - 2;
#pragma unroll
                    for (int bj = 0; bj < 2; ++bj) { const unsigned d8 = 32 * bj + 8 * fq; float v[8];
#pragma unroll
                        for (int n = 0; n < 2; ++n)
#pragma unroll
                            for (int j = 0; j < 4; ++j) v[4 * n + j] = acc[ai][bj][m][n][j];
                        ST16((unsigned)WS_PV + (row * 128 + hv * 64 + d8) * 2, v);
                        if (smp) STF8((unsigned)OFF_VS + (((l * DB + b) * 128 + 124 + t) * 2 + hv) * 64 + d8, v);
                        else if (t >= SEQ - 128) STF8((unsigned)OFF_VP + (((l * NB + b) * 128 + (t - (SEQ - 128))) * 2 + hv) * 64 + d8, v); }
                } else {
                    const unsigned d8 = 8 * fq; const unsigned pidx = smp ? SEQ + t : t;
                    const f32x4* tp = (const f32x4*)(W + (size_t)((unsigned)WS_TAB + (pidx * 32 + d8) * 8));
                    float x1[8], x2[8], o1[8], o2[8];
#pragma unroll
                    for (int n = 0; n < 2; ++n)
#pragma unroll
                        for (int j = 0; j < 4; ++j) { x1[4 * n + j] = acc[ai][0][m][n][j]; x2[4 * n + j] = acc[ai][1][m][n][j]; }
                    const float sc = pn == 7 ? 1.f : QSCALE;
#pragma unroll
                    for (int k2 = 0; k2 < 4; ++k2) { const f32x4 cs = tp[k2];
                        o1[2 * k2] = (x1[2 * k2] * cs[0] - x2[2 * k2] * cs[1]) * sc;         o2[2 * k2] = (x2[2 * k2] * cs[0] + x1[2 * k2] * cs[1]) * sc;
                        o1[2 * k2 + 1] = (x1[2 * k2 + 1] * cs[2] - x2[2 * k2 + 1] * cs[3]) * sc; o2[2 * k2 + 1] = (x2[2 * k2 + 1] * cs[2] + x1[2 * k2 + 1] * cs[3]) * sc; }
                    if (pn == 7) { const unsigned hk = wc;
                        ST16((unsigned)WS_PK + (row * 128 + hk * 64 + d8) * 2, o1); ST16((unsigned)WS_PK + (row * 128 + hk * 64 + 32 + d8) * 2, o2);
                        if (smp) { const unsigned di = (unsigned)OFF_KS + (((l * DB + b) * 128 + 124 + t) * 2 + hk) * 64 + d8; STF8(di, o1); STF8(di + 32, o2); }
                        else if (t >= SEQ - 128) { const unsigned di = (unsigned)OFF_KP + (((l * NB + b) * 128 + (t - (SEQ - 128))) * 2 + hk) * 64 + d8; STF8(di, o1); STF8(di + 32, o2); }
                    } else { const unsigned head = (pn - 5) * 4 + wc;
                        ST16((unsigned)WS_PQ + (row * 512 + head * 64 + d8) * 2, o1); ST16((unsigned)WS_PQ + (row * 512 + head * 64 + 32 + d8) * 2, o2); }
                }
            }
#undef ST16
#undef STF8
    }
};

struct EpiOutF {
    static constexpr bool AFTER_DRAIN = true;
    unsigned char* ws; int l; const float* ln_g; const float* ln_b;
    DI void operator()(f32x4 (&)[2][2][4][2], const pg8::Unit&, int, int, int, int, int) const {}
    DI void fused(f32x4 (&acc)[2][2][4][2], const pg8::Unit& u, int wr, int wc, int fr, int fq, LAS unsigned char* lds, int tid) const {
        LAS float* CV = (LAS float*)lds;
        LAS float* RS = (LAS float*)(lds + 8192);
        LAS float* PW = (LAS float*)(lds + 12288);
        u16* ZH = (u16*)(ws + WS_ZH); u16* ZP = (u16*)(ws + WS_H);
        const float* MOD = (const float*)(ws + WS_MOD); const int b = u.pm >> 4;
        const float* PSp = (const float*)(ws + WS_PS) + (size_t)((l + 1) & 1) * MP * 24; float* PSc = (float*)(ws + WS_PS) + (size_t)(l & 1) * MP * 24;
        if (tid < 256) { const int col = u.pn * 256 + tid;
            CV[tid] = l > 0 ? ln_g[(l - 1) * D + col] : 1.f; CV[256 + tid] = l > 0 ? ln_b[(l - 1) * D + col] : 0.f;
            CV[512 + tid] = MOD[((size_t)l * NMOD + b) * 3072 + 2048 + col]; CV[768 + tid] = ln_g[l * D + col]; CV[1024 + tid] = ln_b[l * D + col];
            CV[1280 + tid] = l < DEPTH - 1 ? MOD[((size_t)(l + 1) * NMOD + b) * 3072 + 1024 + col] : 0.f;
        } else { const int row = tid - 256; float mu = 0.f, rstd = 1.f;
            if (l > 0) { const float* ps = PSp + (size_t)(u.pm * 256 + row) * 24; const float s1 = (ps[0] + ps[6]) + (ps[12] + ps[18]), s2 = (ps[1] + ps[7]) + (ps[13] + ps[19]);
                mu = s1 * (1.f / D); rstd = 1.f / sqrtf(s2 * (1.f / D) - mu * mu + LN_EPS); }
            RS[2 * row] = mu; RS[2 * row + 1] = rstd; }
        __syncthreads();
#pragma unroll
        for (int ai = 0; ai < 2; ++ai) {
        u32x4 zpv[4][2];
#pragma unroll
        for (int mm = 0; mm < 4; ++mm)
#pragma unroll
            for (int bj = 0; bj < 2; ++bj) zpv[mm][bj] = *(const u32x4*)(ZH + ((size_t)u.pm * 256 + ai * 128 + wr * 64 + mm * 16 + fr) * D + u.pn * 256 + bj * 128 + wc * 32 + fq * 8);
#pragma unroll
        for (int mm = 0; mm < 4; ++mm) { const int m = mm;
            const int rt = ai * 128 + wr * 64 + m * 16 + fr; const size_t row = (size_t)u.pm * 256 + rt;
            const float mu = RS[2 * rt], rstd = RS[2 * rt + 1];
            float s1 = 0.f, s2 = 0.f, s3 = 0.f, s4 = 0.f, s5 = 0.f, s6 = 0.f;
#pragma unroll
            for (int bj = 0; bj < 2; ++bj) { const int cl = bj * 128 + wc * 32 + fq * 8; const size_t off = row * D + u.pn * 256 + cl;
                float zp[8], zq[8], zo[8]; unpack8(zpv[mm][bj], zp);
#pragma unroll
                for (int hh = 0; hh < 2; ++hh) {
                    const f32x4 gp = *(const LAS f32x4*)(CV + cl + 4 * hh), bp = *(const LAS f32x4*)(CV + 256 + cl + 4 * hh), gt = *(const LAS f32x4*)(CV + 512 + cl + 4 * hh),
                                gg = *(const LAS f32x4*)(CV + 768 + cl + 4 * hh), bb = *(const LAS f32x4*)(CV + 1024 + cl + 4 * hh), sn = *(const LAS f32x4*)(CV + 1280 + cl + 4 * hh);
                    const f32x4 av = acc[ai][bj][m][hh];
#pragma unroll
                    for (int j = 0; j < 4; ++j) { const int k = 4 * hh + j;
                        const float x1 = l > 0 ? (zp[k] - mu) * rstd * gp[j] + bp[j] : zp[k];
                        const float z = ALPHA * x1 + (1.f + gt[j]) * av[j], uu = z * gg[j];
                        s1 += z; s2 += z * z; s3 += uu; s4 += uu * uu; s5 += uu * gg[j]; s6 += uu * bb[j];
                        zq[k] = z; zo[k] = uu * (1.f + sn[j]); } }
                *(u32x4*)(ZH + off) = pack8(zq);
                if (l < DEPTH - 1) *(u32x4*)(ZP + off) = pack8(zo); }
            s1 = sum_halves(s1 + xor_lane<16>(s1)); s2 = sum_halves(s2 + xor_lane<16>(s2)); s3 = sum_halves(s3 + xor_lane<16>(s3)); s4 = sum_halves(s4 + xor_lane<16>(s4)); s5 = sum_halves(s5 + xor_lane<16>(s5)); s6 = sum_halves(s6 + xor_lane<16>(s6));
            if (fq == 0) { LAS float* pw = PW + (rt * 4 + wc) * 6; pw[0] = s1; pw[1] = s2; pw[2] = s3; pw[3] = s4; pw[4] = s5; pw[5] = s6; } }
        asm volatile("" ::: "memory"); }
        __syncthreads();
        if (tid < 256 && l < DEPTH - 1) { float* ps = PSc + (size_t)(u.pm * 256 + tid) * 24 + u.pn * 6; const LAS float* pw = PW + tid * 24;
#pragma unroll
            for (int k = 0; k < 6; ++k) ps[k] = (pw[k] + pw[6 + k]) + (pw[12 + k] + pw[18 + k]); }
    }
};

#define XB_TMO      128
#define XB_XCNT(j)  (256  + 64 * (j))
#define XB_XSUB(j)  (1280 + 64 * (j))
#define XB_XGEN(j)  (2304 + 64 * (j))
#define XB_TOP      3328
#define XB_TOPGEN   3392
#define XCD_BAR_WORDS 3456
#define XB_SPIN_CAP (1u << 18)
DI unsigned xb_ld(unsigned* p)              { return __hip_atomic_load(p, __ATOMIC_RELAXED, __HIP_MEMORY_SCOPE_AGENT); }
DI unsigned xb_add(unsigned* p, unsigned v) { return __hip_atomic_fetch_add(p, v, __ATOMIC_RELAXED, __HIP_MEMORY_SCOPE_AGENT); }
DI unsigned xb_xcc_id() { return (unsigned)__builtin_amdgcn_s_getreg((3 << 11) | 20) & 0xFu; }
#define XB_SPIN(cond, bar) do { unsigned _sp = 0; while (cond) { __builtin_amdgcn_s_sleep(1); \
    if ((++_sp & 255u) == 0u) { if (xb_ld(&(bar)[XB_TMO])) break; if (_sp > XB_SPIN_CAP) { atomicAdd(&(bar)[XB_TMO], 1u); break; } } } } while (0)
struct XcdBarrier { unsigned* bar; unsigned x; volatile LAS unsigned* st; };
DI XcdBarrier xcd_barrier_post(unsigned* bar, volatile LAS unsigned* st) {
    XcdBarrier b; b.bar = bar; b.x = xb_xcc_id(); b.st = st;
    if (threadIdx.x == 0) (void)xb_add(&bar[XB_XCNT(b.x)], 1u);
    return b;
}
DI void xcd_barrier_complete(unsigned* bar, unsigned x, unsigned& nloc, unsigned& nx) {
    const unsigned G = gridDim.x * gridDim.y * gridDim.z;
    unsigned sum, cnt, mine, sp = 0u;
    for (;;) {
        sum = 0u; cnt = 0u; mine = 0u;
#pragma unroll
        for (unsigned j = 0; j < 16; ++j) { const unsigned c = xb_ld(&bar[XB_XCNT(j)]); sum += c; cnt += (c > 0u) ? 1u : 0u; mine = (j == x) ? c : mine; }
        if (sum == G) break;
        __builtin_amdgcn_s_sleep(1);
        if ((++sp & 255u) == 0u) { if (xb_ld(&bar[XB_TMO])) break; if (sp > XB_SPIN_CAP) { atomicAdd(&bar[XB_TMO], 1u); break; } }
    }
    nloc = mine > 0u ? mine : 1u; nx = cnt > 0u ? cnt : 1u;
}
DI void xcd_barrier(const XcdBarrier& b, const int wave_s) {
    asm volatile("s_waitcnt vmcnt(0)" ::: "memory");
    __syncthreads();
    if (wave_s == 0 && lane_id() == 0) {
        unsigned* bar = b.bar;
        __builtin_amdgcn_s_waitcnt(0);
        unsigned nloc = b.st[0], nx = b.st[1];
        if (nloc == 0u) { xcd_barrier_complete(bar, b.x, nloc, nx); b.st[0] = nloc; b.st[1] = nx; }
        const unsigned old = xb_add(&bar[XB_XSUB(b.x)], 1u);
        const unsigned gen = old / nloc;
        if (old + 1u == (gen + 1u) * nloc) {
            __builtin_amdgcn_fence(__ATOMIC_RELEASE, "agent");
            asm volatile("s_waitcnt vmcnt(0)" ::: "memory");
            const unsigned og = xb_add(&bar[XB_TOP], 1u);
            const unsigned tg = og / nx;
            if (og + 1u == (tg + 1u) * nx) xb_add(&bar[XB_TOPGEN], 1u);
            else XB_SPIN(xb_ld(&bar[XB_TOPGEN]) == tg, bar);
            __builtin_amdgcn_fence(__ATOMIC_ACQUIRE, "agent");
            xb_add(&bar[XB_XGEN(b.x)], 1u);
            asm volatile("s_waitcnt vmcnt(0)" ::: "memory");
        } else {
            XB_SPIN(xb_ld(&bar[XB_XGEN(b.x)]) == gen, bar);
            __builtin_amdgcn_fence(__ATOMIC_ACQUIRE, "agent");
            asm volatile("s_waitcnt vmcnt(0)" ::: "memory");
        }
    }
    __syncthreads();
}

constexpr int NWAVES = 8, NTHR = 512;
constexpr int LDS_BYTES = 147456;
constexpr int RING_BYTES = 131072, MISC_OFF = RING_BYTES + 320;

DI void p0_transpose_item(const float* W, int K, int N, u16* WT, LAS float* scr, int item, int lane, bool isin) {
    const int nblk = N / 32, kb = item / nblk, nb = item % nblk, k0 = 64 * kb, n0 = 32 * nb;
#pragma unroll 8
    for (int i = 0; i < 32; ++i) { const int kk = 2 * i + (lane >> 5); scr[kk * 33 + (lane & 31)] = W[(size_t)(k0 + kk) * N + n0 + (lane & 31)]; }
    asm volatile("s_waitcnt lgkmcnt(0)" ::: "memory");
    const int c = lane & 7;
#pragma unroll
    for (int j = 0; j < 4; ++j) { const int n = (lane >> 3) + 8 * j; const LAS float* s = scr + (8 * c) * 33 + n;
        u32x4 o; o.x = pkh(s[0 * 33], s[1 * 33]); o.y = pkh(s[2 * 33], s[3 * 33]); o.z = pkh(s[4 * 33], s[5 * 33]); o.w = pkh(s[6 * 33], s[7 * 33]);
        const int dst = isin ? perm_in(n0 + n) : perm_out(n0 + n);
        *(u32x4*)(WT + (size_t)dst * K + k0 + 8 * c) = o; }
    asm volatile("s_waitcnt lgkmcnt(0)" ::: "memory");
}
DI void mod_unit(const Params& p, LAS unsigned char* lds, int unit, int tid, int lane, int wave) {
    const int l = unit >> 6, n0 = (unit & 63) * 48;
    const float* W = p.w_mod + (size_t)l * D * 3072;
    float* MOD = (float*)(p.ws + WS_MOD);
    const int fr = lane & 15, fq = lane >> 4;
    f32x4 acc[9][3];
#pragma unroll
    for (int rt = 0; rt < 9; ++rt)
#pragma unroll
        for (int ct = 0; ct < 3; ++ct) acc[rt][ct] = (f32x4){0.f, 0.f, 0.f, 0.f};
    for (int ks = 0; ks < 4; ++ks) {
        const int k0 = wave * 128 + ks * 32 + fq * 8;
        h8 bfr[3];
#pragma unroll
        for (int ct = 0; ct < 3; ++ct) { const float* wp = W + (size_t)k0 * 3072 + n0 + 16 * ct + fr;
#pragma unroll
            for (int j = 0; j < 8; ++j) bfr[ct][j] = (_Float16)wp[(size_t)j * 3072]; }
#pragma unroll
        for (int rt = 0; rt < 9; ++rt) { const int row = 16 * rt + fr; h8 a;
            if (row < NMOD) { const float* c = row < NB ? p.c_prompt + (size_t)row * D : p.c_sample + (size_t)(row - NB) * D;
                const f32x4 c0 = *(const f32x4*)(c + k0), c1 = *(const f32x4*)(c + k0 + 4);
#pragma unroll
                for (int j = 0; j < 4; ++j) { a[j] = (_Float16)silu(c0[j]); a[4 + j] = (_Float16)silu(c1[j]); } }
            else {
#pragma unroll
                for (int j = 0; j < 8; ++j) a[j] = (_Float16)0.f; }
#pragma unroll
            for (int ct = 0; ct < 3; ++ct) acc[rt][ct] = __builtin_amdgcn_mfma_f32_16x16x32_f16(a, bfr[ct], acc[rt][ct], 0, 0, 0); }
    }
    LAS float* part = (LAS float*)lds;
#pragma unroll
    for (int rg = 0; rg < 3; ++rg) {
        __syncthreads();
#pragma unroll
        for (int r3 = 0; r3 < 3; ++r3)
#pragma unroll
            for (int ct = 0; ct < 3; ++ct)
#pragma unroll
                for (int i = 0; i < 4; ++i) part[(wave * 48 + r3 * 16 + 4 * fq + i) * 48 + 16 * ct + fr] = acc[rg * 3 + r3][ct][i];
        __syncthreads();
        for (int o = tid; o < 48 * 48; o += NTHR) { const int r48 = o / 48, col = o % 48, row = 48 * rg + r48; float sacc = 0.f;
#pragma unroll
            for (int w = 0; w < 8; ++w) sacc += part[(w * 48 + r48) * 48 + col];
            if (row < NMOD) MOD[((size_t)l * NMOD + row) * 3072 + n0 + col] = sacc + p.b_mod[(size_t)l * 3072 + n0 + col]; }
    }
    __syncthreads();
}
DI void sincos_d(double a, float& c, float& s) {
    const double k = __builtin_rint(a * 0.63661977236758134308);
    const double r = __builtin_fma(-k, 1.2246467991473532e-16 * 0.5, __builtin_fma(-k, 1.5707963267948966, a));
    const double r2 = r * r;
    double sp = -1.0 / 6227020800.0; sp = sp * r2 + 1.0 / 39916800.0; sp = sp * r2 - 1.0 / 362880.0; sp = sp * r2 + 1.0 / 5040.0; sp = sp * r2 - 1.0 / 120.0; sp = sp * r2 + 1.0 / 6.0;
    const double sn = r - r * r2 * sp;
    double cp = 1.0 / 87178291200.0; cp = cp * r2 - 1.0 / 479001600.0; cp = cp * r2 + 1.0 / 3628800.0; cp = cp * r2 - 1.0 / 40320.0; cp = cp * r2 + 1.0 / 720.0; cp = cp * r2 - 1.0 / 24.0; cp = cp * r2 + 0.5;
    const double cn = 1.0 - r2 * cp;
    const long long q = (long long)k & 3;
    const double cc = (q == 0) ? cn : (q == 1) ? -sn : (q == 2) ? -cn : sn;
    const double ss = (q == 0) ? sn : (q == 1) ? cn : (q == 2) ? -sn : -cn;
    c = (float)cc; s = (float)ss;
}
DI void p0_prologue(const Params& p, const __attribute__((address_space(4))) float* invf, LAS unsigned char* lds, int vcu, int G, int tid, int lane, int wave) {
    for (int u = vcu; u < 256; u += G) mod_unit(p, lds, u, tid, lane, wave);
    LAS float* scr = (LAS float*)(lds + wave * 16384);
    const int gw = vcu * NWAVES + wave, NGW = G * NWAVES;
    constexpr int I_IN = (D / 64) * (DIN / 32), I_OUT = (D / 64) * (D / 32);
    for (int it = gw; it < DEPTH * (I_IN + I_OUT); it += NGW) {
        const int l = it / (I_IN + I_OUT), r = it % (I_IN + I_OUT);
        if (r < I_IN) p0_transpose_item(p.w_in + (size_t)l * D * DIN, D, DIN, (u16*)(p.ws + WS_WIN) + (size_t)l * DIN * D, scr, r, lane, true);
        else p0_transpose_item(p.w_out + (size_t)l * D * D, D, D, (u16*)(p.ws + WS_WOUT) + (size_t)l * D * D, scr, r - I_IN, lane, false);
    }
    if (vcu == 0 && wave < DEPTH) {
        float a = 0.f, b2 = 0.f, c2 = 0.f, d = 0.f, e = 0.f;
        for (int c = lane; c < D; c += 64) { const float g = p.ln_g[wave * D + c], bb = p.ln_b[wave * D + c]; a += g; b2 += g * g; c2 += g * bb; d += bb; e += bb * bb; }
        a = wave_sum(a); b2 = wave_sum(b2); c2 = wave_sum(c2); d = wave_sum(d); e = wave_sum(e);
        if (lane == 0) { float* o = (float*)(p.ws + WS_LNC) + wave * 8; o[0] = a; o[1] = b2; o[2] = c2; o[3] = d; o[4] = e; } }
    f32x2* tab = (f32x2*)(p.ws + WS_TAB);
    for (int e = vcu * NTHR + tid; e < (SEQ + DS) * 32; e += G * NTHR) {
        const int pi = e >> 5, i = e & 31; const int pos = pi < SEQ ? pi : PAST + (pi - SEQ);
        const float ang = (float)pos * invf[i];
        float c, s; sincos_d((double)ang, c, s);
        tab[e] = (f32x2){c, s};
    }
}

template <int R>
DI void ln_stats(float (&v)[R][16], float (&mean)[R], float (&rstd)[R]) {
    float s[R];
#pragma unroll
    for (int r = 0; r < R; ++r) { s[r] = 0.f;
#pragma unroll
        for (int k = 0; k < 16; ++k) s[r] += v[r][k]; }
#pragma unroll
    for (int r = 0; r < R; ++r) s[r] = wave_sum(s[r]);
#pragma unroll
    for (int r = 0; r < R; ++r) { mean[r] = s[r] * (1.f / D); s[r] = 0.f;
#pragma unroll
        for (int k = 0; k < 16; ++k) { v[r][k] -= mean[r]; s[r] += v[r][k] * v[r][k]; } }
#pragma unroll
    for (int r = 0; r < R; ++r) s[r] = wave_sum(s[r]);
#pragma unroll
    for (int r = 0; r < R; ++r) rstd[r] = 1.f / sqrtf(s[r] * (1.f / D) + LN_EPS);
}
constexpr int LNR = 3;
DI void pre_phase(const Params& p, int gw, int NGW, int lane) {
    const float* modl = (const float*)(p.ws + WS_MOD);
    u16* ZH = (u16*)(p.ws + WS_ZH); u16* XR = (u16*)(p.ws + WS_XR); u16* ZP = (u16*)(p.ws + WS_H); f32x4* RC0 = (f32x4*)(p.ws + WS_RC0);
    for (int row0 = gw; row0 < M; row0 += LNR * NGW) {
        float v[LNR][16]; bool ok[LNR]; float mean[LNR], rstd[LNR]; int rows[LNR];
#pragma unroll
        for (int r = 0; r < LNR; ++r) { rows[r] = row0 + r * NGW; ok[r] = rows[r] < M; if (!ok[r]) rows[r] = row0; }
#pragma unroll
        for (int r = 0; r < LNR; ++r) { const int row = rows[r]; const float* x = row < MP ? p.x_prompt + (size_t)row * D : p.x_sample + (size_t)(row - MP) * D;
#pragma unroll
            for (int j2 = 0; j2 < 2; ++j2) { const f32x4 a = *(const f32x4*)(x + 512 * j2 + 8 * lane), b = *(const f32x4*)(x + 512 * j2 + 8 * lane + 4);
#pragma unroll
                for (int k = 0; k < 4; ++k) { v[r][8 * j2 + k] = a[k]; v[r][8 * j2 + 4 + k] = b[k]; } } }
#pragma unroll
        for (int r = 0; r < LNR; ++r) if (ok[r]) { u16* dst = rows[r] < MP ? ZH : XR;
#pragma unroll
            for (int j2 = 0; j2 < 2; ++j2) *(u32x4*)(dst + (size_t)rows[r] * D + 512 * j2 + 8 * lane) = pack8(v[r] + 8 * j2); }
        ln_stats<LNR>(v, mean, rstd);
#pragma unroll
        for (int r = 0; r < LNR; ++r) if (ok[r]) { const int row = rows[r]; const bool smp = row >= MP; const int bidx = smp ? NB + ((row - MP) >> 2) : (row >> 12);
            const float* sh = modl + (size_t)bidx * 3072; const float* sc = sh + 1024;
            if (!smp && lane == 0) RC0[row] = (f32x4){rstd[r], 0.f, rstd[r], rstd[r] * mean[r]};
#pragma unroll
            for (int j2 = 0; j2 < 2; ++j2) { float o[8];
#pragma unroll
                for (int h = 0; h < 2; ++h) { const f32x4 a = *(const f32x4*)(sc + 512 * j2 + 8 * lane + 4 * h), bb = *(const f32x4*)(sh + 512 * j2 + 8 * lane + 4 * h);
#pragma unroll
                    for (int k = 0; k < 4; ++k) o[4 * h + k] = smp ? v[r][8 * j2 + 4 * h + k] * rstd[r] * (1.f + a[k]) + bb[k] : (v[r][8 * j2 + 4 * h + k] + mean[r]) * (1.f + a[k]); }
                *(u32x4*)(ZP + (size_t)row * D + 512 * j2 + 8 * lane) = pack8(o); } }
    }
}
DI void modv_unit(const Params& p, LAS unsigned char* lds, int unit, int tid, int lane, int wave) {
    const int l = unit / 40, cb = unit % 40, col = 64 * cb + lane;
    const float* W = p.w_in + (size_t)l * D * DIN + col; const float* modl = (const float*)(p.ws + WS_MOD) + (size_t)l * NMOD * 3072;
    LAS float* part = (LAS float*)lds;
    LAS float* cf = (LAS float*)(lds + 32768) + wave * 128 * 12;
    __syncthreads();
#pragma unroll
    for (int hlf = 0; hlf < 2; ++hlf) { const int ci = 64 * hlf + lane, c = wave * 128 + ci; LAS float* o = cf + ci * 12;
        o[0] = l > 0 ? p.ln_g[(l - 1) * D + c] : 1.f; o[1] = l > 0 ? p.ln_b[(l - 1) * D + c] : 0.f;
#pragma unroll
        for (int b = 0; b < 4; ++b) { o[2 + b] = 1.f + modl[b * 3072 + 1024 + c]; o[6 + b] = modl[b * 3072 + c]; } }
    asm volatile("s_waitcnt lgkmcnt(0)" ::: "memory");
    float acc[4][4];
#pragma unroll
    for (int b = 0; b < 4; ++b)
#pragma unroll
        for (int k = 0; k < 4; ++k) acc[b][k] = 0.f;
#pragma unroll 1
    for (int c0 = 0; c0 < 128; c0 += 32) { float wv[32];
#pragma unroll
        for (int i = 0; i < 32; ++i) wv[i] = W[(size_t)(wave * 128 + c0 + i) * DIN];
#pragma unroll
        for (int i = 0; i < 32; ++i) { const LAS f32x4* cp = (const LAS f32x4*)(cf + (c0 + i) * 12); const f32x4 q0 = cp[0], q1 = cp[1], q2 = cp[2];
            const float g = q0[0], bb = q0[1]; const float s1[4] = {q0[2], q0[3], q1[0], q1[1]}; const float sh[4] = {q1[2], q1[3], q2[0], q2[1]};
#pragma unroll
            for (int b = 0; b < 4; ++b) { const float sw = s1[b] * wv[i]; acc[b][0] += g * sw; acc[b][1] += bb * sw; acc[b][2] += sw; acc[b][3] += sh[b] * wv[i]; } } }
#pragma unroll
    for (int b = 0; b < 4; ++b)
#pragma unroll
        for (int k = 0; k < 4; ++k) part[(wave * 16 + b * 4 + k) * 64 + lane] = acc[b][k];
    __syncthreads();
    float* MODV = (float*)(p.ws + WS_MODV);
    for (int o = tid; o < 1024; o += NTHR) { const int idx = o >> 6, ln = o & 63; float sum = 0.f;
#pragma unroll
        for (int w = 0; w < 8; ++w) sum += part[(w * 16 + idx) * 64 + ln];
        MODV[((size_t)(l * NB + (idx >> 2)) * 4 + (idx & 3)) * DIN + perm_in(64 * cb + ln)] = sum; }
    __syncthreads();
}
DI void finalize_rc_in(const Params& p, int l, const int (&pms)[3], LAS float* rcl, int tid) {
    const int row = tid & 255;
    const int ua = tid >> 8, ub = 2;
    const bool hasA = pms[ua] >= 0 && pms[ua] < MP / 256, hasB = tid < 256 && pms[2] >= 0 && pms[2] < MP / 256;
    f32x4 ldA[6], ldB[6];
    const size_t rA = (size_t)(hasA ? pms[ua] : 0) * 256 + row, rB = (size_t)(hasB ? pms[2] : 0) * 256 + row;
    if (l == 0) { ldA[0] = ((const f32x4*)(p.ws + WS_RC0))[rA]; ldB[0] = ((const f32x4*)(p.ws + WS_RC0))[rB]; }
    else { const f32x4* psA = (const f32x4*)((const float*)(p.ws + WS_PS) + (size_t)((l - 1) & 1) * MP * 24 + rA * 24); const f32x4* psB = (const f32x4*)((const float*)(p.ws + WS_PS) + (size_t)((l - 1) & 1) * MP * 24 + rB * 24);
#pragma unroll
        for (int k = 0; k < 6; ++k) { ldA[k] = psA[k]; ldB[k] = psB[k]; } }
    auto fin = [&](const f32x4 (&ld)[6]) -> f32x4 {
        if (l == 0) return ld[0];
        const float* lnc = (const float*)(p.ws + WS_LNC) + (l - 1) * 8;
        float f[24];
#pragma unroll
        for (int k = 0; k < 6; ++k) { f[4 * k] = ld[k][0]; f[4 * k + 1] = ld[k][1]; f[4 * k + 2] = ld[k][2]; f[4 * k + 3] = ld[k][3]; }
        float S[6];
#pragma unroll
        for (int k = 0; k < 6; ++k) S[k] = (f[k] + f[6 + k]) + (f[12 + k] + f[18 + k]);
        float N1 = 1.f / D, two = 2.f; asm volatile("" : "+v"(N1), "+v"(two));
        const float mu = S[0] * N1, rstd = 1.f / sqrtf(S[1] * N1 - mu * mu + LN_EPS);
        const float m2 = (rstd * (S[2] - mu * lnc[0]) + lnc[3]) * N1;
        const float e2 = (rstd * rstd * (S[3] - two * mu * S[4] + mu * mu * lnc[1]) + two * rstd * (S[5] - mu * lnc[2]) + lnc[4]) * N1;
        const float rstd2 = 1.f / sqrtf(e2 - m2 * m2 + LN_EPS);
        return (f32x4){rstd * rstd2, rstd * rstd2 * mu, rstd2, rstd2 * m2}; };
    if (hasA) *(LAS f32x4*)(rcl + ua * 1024 + 4 * row) = fin(ldA);
    if (hasB) *(LAS f32x4*)(rcl + ub * 1024 + 4 * row) = fin(ldB);
}
DI void fin_phase(const Params& p, int gw, int NGW, int lane) {
    const u16* ZH = (const u16*)(p.ws + WS_ZH);
    const float* lg = p.ln_g + (size_t)(DEPTH - 1) * D; const float* lb = p.ln_b + (size_t)(DEPTH - 1) * D;
    for (int row0 = gw; row0 < MP; row0 += LNR * NGW) {
        float v[LNR][16]; bool ok[LNR]; float mean[LNR], rstd[LNR]; int rows[LNR];
#pragma unroll
        for (int r = 0; r < LNR; ++r) { rows[r] = row0 + r * NGW; ok[r] = rows[r] < MP; if (!ok[r]) rows[r] = row0; }
#pragma unroll
        for (int r = 0; r < LNR; ++r)
#pragma unroll
            for (int j2 = 0; j2 < 2; ++j2) unpack8(*(const u32x4*)(ZH + (size_t)rows[r] * D + 512 * j2 + 8 * lane), v[r] + 8 * j2);
        ln_stats<LNR>(v, mean, rstd);
#pragma unroll
        for (int j2 = 0; j2 < 2; ++j2)
#pragma unroll
            for (int h = 0; h < 2; ++h) { const f32x4 g = *(const f32x4*)(lg + 512 * j2 + 8 * lane + 4 * h), bb = *(const f32x4*)(lb + 512 * j2 + 8 * lane + 4 * h);
#pragma unroll
                for (int r = 0; r < LNR; ++r) if (ok[r]) { f32x4 o;
#pragma unroll
                    for (int k = 0; k < 4; ++k) o[k] = v[r][8 * j2 + 4 * h + k] * rstd[r] * g[k] + bb[k];
                    *(f32x4*)(p.out + (size_t)rows[r] * D + 512 * j2 + 8 * lane + 4 * h) = o; } }
    }
}

struct MixPtrs { const u16 *PA, *PSZC, *PPV, *PSZP, *PQ, *PSZA, *PK, *PV; u16* MIX; };
DI v4i16_t ds_tr(const LAS unsigned char* a) { return __builtin_amdgcn_ds_read_tr16_b64_v4i16((LAS v4i16_t*)a); }

DI void attn_prompt_unit(const Params& p, const MixPtrs& X, int l, int unit, LAS unsigned char* lds, int tid, int lane, int wave) {
    const int xg = unit >> 5, b = xg >> 1, hk = (unit >> 4) & 1, nb = (xg & 1) * 16 + (unit & 15), q0 = nb * 128; const size_t rb = (size_t)b * SEQ;
    LAS unsigned char* Ks = lds; LAS unsigned char* Vs = lds + 36864;
    const int g = wave & 3, qh = wave >> 2, head = 4 * hk + g, r = lane & 31, h = lane >> 5;
    h8 qfA[4], qfB[4]; u32x2 zgA[2][4], zgB[2][4];
    { const size_t qr0 = rb + q0 + 64 * qh + r, qr1 = qr0 + 32;
#pragma unroll
      for (int s = 0; s < 4; ++s) { qfA[s] = *(const h8*)(X.PQ + qr0 * 512 + head * 64 + 16 * s + 8 * h); qfB[s] = *(const h8*)(X.PQ + qr1 * 512 + head * 64 + 16 * s + 8 * h); }
#pragma unroll
      for (int db = 0; db < 2; ++db)
#pragma unroll
          for (int xq = 0; xq < 4; ++xq) { const int col = head * 64 + 32 * db + 8 * xq + 4 * h; zgA[db][xq] = *(const u32x2*)(X.PSZA + qr0 * 512 + col); zgB[db][xq] = *(const u32x2*)(X.PSZA + qr1 * 512 + col); } }
#pragma unroll
    for (int i = 0; i < 4; ++i) { const int c = tid + 512 * i, key = c >> 3, ch = c & 7, tk = q0 - 128 + key;
        if (tk >= 0) { const u32x4 kv = *(const u32x4*)(X.PK + (rb + tk) * 128 + hk * 64 + ch * 8), vv = *(const u32x4*)(X.PV + (rb + tk) * 128 + hk * 64 + ch * 8);
            *(LAS u32x4*)(Ks + key * 144 + ch * 16) = kv; *(LAS u32x4*)(Vs + (ch >> 2) * 16384 + key * 64 + (ch & 3) * 16) = vv; } }
    __syncthreads();
    const float sink2 = p.sinks[l * 8 + head] * LOG2E;
    const int trq = (lane & 15) >> 2, trp = lane & 3, trg = (lane >> 4) & 1;
    const float NEG = -INFINITY;
    auto half = [&](const h8 (&qf)[4], const u32x2 (&zg)[2][4], const int e) {
        const int ql = 64 * qh + 32 * e; const size_t qrow = rb + q0 + ql + r;
        f32x16 S[5];
#pragma unroll
        for (int i = 0; i < 5; ++i) { const int kl = ql + 32 * i; const bool valid = (nb > 0) || (kl >= 128);
#pragma unroll
            for (int x = 0; x < 16; ++x) S[i][x] = 0.f;
            if (valid) {
#pragma unroll
                for (int s = 0; s < 4; ++s) { const h8 kf = *(const LAS h8*)(Ks + (kl + r) * 144 + (16 * s + 8 * h) * 2); S[i] = __builtin_amdgcn_mfma_f32_32x32x16_f16(kf, qf[s], S[i], 0, 0, 0); }
            } else {
#pragma unroll
                for (int x = 0; x < 16; ++x) S[i][x] = NEG; }
            if (i == 0) {
#pragma unroll
                for (int x = 0; x < 16; ++x) if (!(crow(x, h) > r)) S[i][x] = NEG; }
            if (i == 4) {
#pragma unroll
                for (int x = 0; x < 16; ++x) if (!(crow(x, h) <= r)) S[i][x] = NEG; }
        }
        float mx = sink2;
#pragma unroll
        for (int i = 0; i < 5; ++i)
#pragma unroll
            for (int x = 0; x < 16; ++x) mx = fmaxf(mx, S[i][x]);
        mx = max_halves(mx);
        float sum = 0.f;
#pragma unroll
        for (int i = 0; i < 5; ++i)
#pragma unroll
            for (int x = 0; x < 16; ++x) { S[i][x] = ex2(S[i][x] - mx); sum += S[i][x]; }
        sum = sum_halves(sum);
        const float inv = 1.f / (sum + ex2(sink2 - mx));
        f32x16 O[2];
#pragma unroll
        for (int x = 0; x < 16; ++x) { O[0][x] = 0.f; O[1][x] = 0.f; }
#pragma unroll
        for (int i = 0; i < 5; ++i) { const int kl = ql + 32 * i; const bool valid = (nb > 0) || (kl >= 128);
            if (valid) {
#pragma unroll
                for (int s2 = 0; s2 < 2; ++s2) { float pv8[8];
#pragma unroll
                    for (int j = 0; j < 8; ++j) pv8[j] = S[i][8 * s2 + j] * inv;
                    const h8 pa = __builtin_bit_cast(h8, pack8(pv8));
#pragma unroll
                    for (int db = 0; db < 2; ++db) { const LAS unsigned char* va = Vs + db * 16384 + (kl + 16 * s2 + 4 * h + trq) * 64 + trg * 32 + trp * 8;
                        const v4i16_t lo = ds_tr(va), hi = ds_tr(va + 512);
                        const h8 vf = __builtin_bit_cast(h8, __builtin_shufflevector(lo, hi, 0, 1, 2, 3, 4, 5, 6, 7));
                        O[db] = __builtin_amdgcn_mfma_f32_32x32x16_f16(vf, pa, O[db], 0, 0, 0); } } } }
#pragma unroll
        for (int db = 0; db < 2; ++db)
#pragma unroll
            for (int xq = 0; xq < 4; ++xq) { const int col = head * 64 + 32 * db + 8 * xq + 4 * h; const h4 z = __builtin_bit_cast(h4, zg[db][xq]);
                u32x2 w; w.x = pkh(O[db][4 * xq] * (float)z[0], O[db][4 * xq + 1] * (float)z[1]); w.y = pkh(O[db][4 * xq + 2] * (float)z[2], O[db][4 * xq + 3] * (float)z[3]);
                *(u32x2*)(X.MIX + qrow * D + 512 + col) = w; }
    };
    half(qfA, zgA, 0);
    half(qfB, zgB, 1);
    __syncthreads();
}

DI void conv_prompt_unit(const Params& p, const MixPtrs& X, int l, int unit, LAS unsigned char* lds, int tid, int lane, int wave) {
    const int R0 = unit * 64, b = R0 >> 12, t0 = R0 & (SEQ - 1); const size_t rb = (size_t)b * SEQ;
    LAS unsigned char* WL = lds + 94 * 512;
    for (int c = tid; c < 94 * 32; c += NTHR) { const int row = c >> 5, ch = c & 31, tk = t0 - 30 + row; u32x4 v = (u32x4){0u, 0u, 0u, 0u};
        if (tk >= 0) v = *(const u32x4*)(X.PA + (rb + tk) * 256 + ch * 8);
        *(LAS u32x4*)(lds + row * 512 + ch * 16) = v; }
    for (int c = tid; c < 31 * 64; c += NTHR) *(LAS f32x4*)(WL + c * 16) = *(const f32x4*)(p.conv_w + (size_t)l * 31 * 256 + 4 * c);
    const f32x4 bias = *(const f32x4*)(p.conv_b + l * 256 + 4 * lane), cg = *(const f32x4*)(p.cnorm_g + l * 256 + 4 * lane), cb = *(const f32x4*)(p.cnorm_b + l * 256 + 4 * lane);
    u32x2 zcv[8];
#pragma unroll
    for (int tt = 0; tt < 8; ++tt) zcv[tt] = *(const u32x2*)(X.PSZC + ((size_t)R0 + 8 * wave + tt) * 256 + 4 * lane);
    __syncthreads();
    f32x4 acc[8], win[8];
#pragma unroll
    for (int tt = 0; tt < 8; ++tt) acc[tt] = bias;
    const LAS unsigned char* arow = lds + (8 * wave) * 512 + lane * 8;
#pragma unroll
    for (int k = 0; k < 7; ++k) win[k] = __builtin_convertvector(*(const LAS h4*)(arow + k * 512), f32x4);
#pragma unroll 1
    for (int jb = 0; jb < 4; ++jb) {
#pragma unroll
        for (int jj = 0; jj < 8; ++jj) { const int j = 8 * jb + jj;
            if (j < 31) {
                win[(jj + 7) & 7] = __builtin_convertvector(*(const LAS h4*)(arow + (j + 7) * 512), f32x4);
                const f32x4 w = *(const LAS f32x4*)(WL + j * 1024 + lane * 16);
#pragma unroll
                for (int tt = 0; tt < 8; ++tt) acc[tt] += w * win[(jj + tt) & 7]; } } }
#pragma unroll
    for (int tt = 0; tt < 8; ++tt) { const size_t row = (size_t)R0 + 8 * wave + tt;
        const float mean = wave_sum((acc[tt][0] + acc[tt][1]) + (acc[tt][2] + acc[tt][3])) * (1.f / 256.f);
        const f32x4 d = acc[tt] - mean;
        const float rstd = 1.f / sqrtf(wave_sum((d[0] * d[0] + d[1] * d[1]) + (d[2] * d[2] + d[3] * d[3])) * (1.f / 256.f) + LN_EPS);
        const h4 zc = __builtin_bit_cast(h4, zcv[tt]); float o[4];
#pragma unroll
        for (int k = 0; k < 4; ++k) o[k] = silu(d[k] * rstd * cg[k] + cb[k]) * (float)zc[k];
        u32x2 w; w.x = pkh(o[0], o[1]); w.y = pkh(o[2], o[3]);
        *(u32x2*)(X.MIX + row * D + 4 * lane) = w; }
    __syncthreads();
}

DI void pool_prompt_unit(const Params& p, const MixPtrs& X, int l, int unit, LAS unsigned char* lds, int tid, int lane, int wave) {
    const int R0 = unit * 64, b = R0 >> 12, t0 = R0 & (SEQ - 1); const size_t rb = (size_t)b * SEQ;
    LAS unsigned char* PL = lds + 79 * 512;
    for (int c = tid; c < 79 * 32; c += NTHR) { const int row = c >> 5, ch = c & 31, tk = t0 - 15 + row; u32x4 v = (u32x4){0u, 0u, 0u, 0u};
        if (tk >= 0) v = *(const u32x4*)(X.PPV + (rb + tk) * 256 + ch * 8);
        *(LAS u32x4*)(lds + row * 512 + ch * 16) = v; }
    __syncthreads();
    { const int wlen = 2 << (lane >> 4);
        const LAS unsigned char* prow = lds + (8 * wave + 15) * 512 + lane * 8;
        f32x4 sm[8];
#pragma unroll
        for (int tt = 0; tt < 8; ++tt) sm[tt] = (f32x4){0.f, 0.f, 0.f, 0.f};
#pragma unroll 1
        for (int i = 0; i < 16; ++i) { if (i < wlen) {
#pragma unroll
            for (int tt = 0; tt < 8; ++tt) sm[tt] += __builtin_convertvector(*(const LAS h4*)(prow + (tt - i) * 512), f32x4); } }
#pragma unroll
        for (int tt = 0; tt < 8; ++tt) {
            const int t = t0 + 8 * wave + tt; const float cnt = (float)(wlen < t + 1 ? wlen : t + 1);
            const f32x4 cur = __builtin_convertvector(*(const LAS h4*)(prow + tt * 512), f32x4);
            const f32x4 pl = sm[tt] * (1.f / cnt) - cur;
            u32x2 w; w.x = pkh(pl[0], pl[1]); w.y = pkh(pl[2], pl[3]);
            *(LAS u32x2*)(PL + (8 * wave + tt) * 528 + lane * 8) = w; } }
    __syncthreads();
    { const int g = wave & 3, th = wave >> 2, r = lane & 31, h = lane >> 5;
        const float* pw = p.pool_w + ((size_t)l * 4 + g) * 64 * 64 + r;
        f32x16 Dd[2];
#pragma unroll
        for (int x = 0; x < 16; ++x) { Dd[0][x] = 0.f; Dd[1][x] = 0.f; }
#pragma unroll 1
        for (int s = 0; s < 4; ++s) { const h8 bf = *(const LAS h8*)(PL + (32 * th + r) * 528 + (64 * g + 16 * s + 8 * h) * 2);
#pragma unroll
            for (int nb = 0; nb < 2; ++nb) { h8 af;
#pragma unroll
                for (int j = 0; j < 8; ++j) af[j] = (_Float16)pw[(size_t)(16 * s + 8 * h + j) * 64 + 32 * nb];
                Dd[nb] = __builtin_amdgcn_mfma_f32_32x32x16_f16(af, bf, Dd[nb], 0, 0, 0); } }
        const size_t row = (size_t)R0 + 32 * th + r;
#pragma unroll
        for (int nb = 0; nb < 2; ++nb)
#pragma unroll
            for (int xq = 0; xq < 4; ++xq) { const int col = 64 * g + 32 * nb + 8 * xq + 4 * h;
                const f32x4 ps = *(const f32x4*)(p.pool_scale + l * 256 + col); const h4 z = *(const h4*)(X.PSZP + row * 256 + col);
                u32x2 w; w.x = pkh(Dd[nb][4 * xq] * ps[0] * (float)z[0], Dd[nb][4 * xq + 1] * ps[1] * (float)z[1]); w.y = pkh(Dd[nb][4 * xq + 2] * ps[2] * (float)z[2], Dd[nb][4 * xq + 3] * ps[3] * (float)z[3]);
                *(u32x2*)(X.MIX + row * D + 256 + col) = w; } }
    __syncthreads();
}


constexpr int MX_WCV = 0;
constexpr int MX_WPT = 81920;
constexpr int MX_SCR = 0, MX_SCR_W = 7168;
constexpr int MX_TQ = RING_BYTES + 640;
DI void mix_stage_weights(const Params& p, int l, LAS unsigned char* lds, int tid) {
    for (int c = tid; c < 31 * 64; c += NTHR) *(LAS f32x4*)(lds + MX_WCV + c * 16) = *(const f32x4*)(p.conv_w + (size_t)l * 31 * 256 + 4 * c);
    for (int e = tid; e < 4 * 64 * 64; e += NTHR) { const int g = e >> 12, c = (e >> 6) & 63, n = e & 63;
        *(LAS _Float16*)(lds + MX_WPT + ((g * 64 + n) * 72 + c) * 2) = (_Float16)p.pool_w[(size_t)l * 16384 + e]; }
    if (tid == 0) *(LAS unsigned*)(lds + MX_TQ) = 0u;
}
DI void task_attn(const Params& p, int l, int b, int hk, int g, int tq0, int lane) {
    const int head = 4 * hk + g, r = lane & 31, h = lane >> 5; const size_t rb = (size_t)b * SEQ; const size_t qrow = rb + tq0 + r;
    const float sink2 = p.sinks[l * 8 + head] * LOG2E; const float NEG = -INFINITY;
    const u16* PQ = (const u16*)(p.ws + WS_PQ); const u16* PK = (const u16*)(p.ws + WS_PK);
    f32x16 S[5];
    {   h8 qf[4];
#pragma unroll
        for (int s = 0; s < 4; ++s) qf[s] = *(const h8*)(PQ + qrow * 512 + head * 64 + 16 * s + 8 * h);
        h8 kf[5][4];
#pragma unroll
        for (int i = 0; i < 5; ++i) { const int tk = tq0 - 128 + 32 * i, tkc = tk < 0 ? 0 : tk;
#pragma unroll
            for (int s = 0; s < 4; ++s) kf[i][s] = *(const h8*)(PK + (rb + tkc + r) * 128 + hk * 64 + 16 * s + 8 * h); }
#pragma unroll
        for (int i = 0; i < 5; ++i) { const int tk = tq0 - 128 + 32 * i;
#pragma unroll
            for (int x = 0; x < 16; ++x) S[i][x] = 0.f;
#pragma unroll
            for (int s = 0; s < 4; ++s) S[i] = __builtin_amdgcn_mfma_f32_32x32x16_f16(kf[i][s], qf[s], S[i], 0, 0, 0);
#pragma unroll
            for (int x = 0; x < 16; ++x) S[i][x] = tk >= 0 ? S[i][x] : NEG; } }
#pragma unroll
    for (int x = 0; x < 16; ++x) { if (!(crow(x, h) > r)) S[0][x] = NEG; if (!(crow(x, h) <= r)) S[4][x] = NEG; }
    float mx = sink2;
#pragma unroll
    for (int i = 0; i < 5; ++i)
#pragma unroll
        for (int x = 0; x < 16; ++x) mx = fmaxf(mx, S[i][x]);
    mx = max_halves(mx);
    float sum = 0.f;
#pragma unroll
    for (int i = 0; i < 5; ++i)
#pragma unroll
        for (int x = 0; x < 16; ++x) { S[i][x] = ex2(S[i][x] - mx); sum += S[i][x]; }
    sum = sum_halves(sum);
    const float inv = 1.f / (sum + ex2(sink2 - mx));
    u32x4 pa[5][2];
#pragma unroll
    for (int i = 0; i < 5; ++i)
#pragma unroll
        for (int s2 = 0; s2 < 2; ++s2) { float pv8[8];
#pragma unroll
            for (int j = 0; j < 8; ++j) pv8[j] = S[i][8 * s2 + j] * inv;
            pa[i][s2] = pack8(pv8); }
    int voff = ((b * 2 + hk) * 64 + r) * SEQ + (tq0 - 128) + 4 * h;
    asm volatile("" : "+v"(voff) : "v"(pa[0][0]), "v"(pa[0][1]), "v"(pa[1][0]), "v"(pa[1][1]), "v"(pa[2][0]), "v"(pa[2][1]), "v"(pa[3][0]), "v"(pa[3][1]), "v"(pa[4][0]), "v"(pa[4][1]));
    const u16* vtb = (const u16*)(p.ws + WS_VT) + voff;
    u32x2 vlo[5][2][2], vhi[5][2][2];
#pragma unroll
    for (int i = 0; i < 5; ++i) { const int tk = tq0 - 128 + 32 * i; const int adj = tk < 0 ? -tk : 0;
#pragma unroll
        for (int s2 = 0; s2 < 2; ++s2)
#pragma unroll
            for (int db = 0; db < 2; ++db) { const u16* vp = vtb + (size_t)db * 32 * SEQ + 32 * i + 16 * s2 + adj; vlo[i][s2][db] = *(const u32x2*)vp; vhi[i][s2][db] = *(const u32x2*)(vp + 8); } }
    f32x16 O[2];
#pragma unroll
    for (int x = 0; x < 16; ++x) { O[0][x] = 0.f; O[1][x] = 0.f; }
#pragma unroll
    for (int i = 0; i < 5; ++i)
#pragma unroll
        for (int s2 = 0; s2 < 2; ++s2)
#pragma unroll
            for (int db = 0; db < 2; ++db) { const u32x4 vv = {vlo[i][s2][db][0], vlo[i][s2][db][1], vhi[i][s2][db][0], vhi[i][s2][db][1]};
                O[db] = __builtin_amdgcn_mfma_f32_32x32x16_f16(__builtin_bit_cast(h8, vv), __builtin_bit_cast(h8, pa[i][s2]), O[db], 0, 0, 0); }
    const u16* PSZA = (const u16*)(p.ws + WS_PSZA); u16* MIX = (u16*)(p.ws + WS_MIX);
    u32x2 zg[2][4];
#pragma unroll
    for (int db = 0; db < 2; ++db)
#pragma unroll
        for (int xq = 0; xq < 4; ++xq) zg[db][xq] = *(const u32x2*)(PSZA + qrow * 512 + head * 64 + 32 * db + 8 * xq + 4 * h);
#pragma unroll
    for (int db = 0; db < 2; ++db)
#pragma unroll
        for (int xq = 0; xq < 4; ++xq) { const int col = head * 64 + 32 * db + 8 * xq + 4 * h; const h4 z = __builtin_bit_cast(h4, zg[db][xq]);
            u32x2 w; w.x = pkh(O[db][4 * xq] * (float)z[0], O[db][4 * xq + 1] * (float)z[1]); w.y = pkh(O[db][4 * xq + 2] * (float)z[2], O[db][4 * xq + 3] * (float)z[3]);
            *(u32x2*)(MIX + qrow * D + 512 + col) = w; }
}
constexpr int MX_X = 68608;
DI void conv_tile_dma(const Params& p, int R0, LAS unsigned char* lds, int wave, int lane) {
    const int b = R0 >> 12, t0 = R0 & (SEQ - 1);
    const unsigned char* PA = p.ws + WS_PA;
#pragma unroll
    for (int i = 0; i < 6; ++i) { const int piece = wave + 8 * i;
        if (piece < 47) { const int row = 2 * piece + (lane >> 5); int tk = t0 - 30 + row; tk = tk < 0 ? 0 : tk;
            __builtin_amdgcn_global_load_lds((const unsigned*)(PA + ((size_t)b * SEQ + tk) * 512 + (lane & 31) * 16), (LAS unsigned*)(lds + MX_X + piece * 1024), 16, 0, 0); } }
}
DI void task_conv(const Params& p, int l, int R0, int sub, LAS unsigned char* lds, int lane) {
    const int t0 = (R0 & (SEQ - 1)) + 8 * sub; const size_t rowb = (size_t)R0 + 8 * sub;
    const f32x4 bias = *(const f32x4*)(p.conv_b + l * 256 + 4 * lane), cg = *(const f32x4*)(p.cnorm_g + l * 256 + 4 * lane), cb = *(const f32x4*)(p.cnorm_b + l * 256 + 4 * lane);
    const LAS unsigned char* arow = lds + MX_X + (8 * sub) * 512 + lane * 8;
    const LAS unsigned char* wl = lds + MX_WCV + lane * 16;
    f32x4 acc[8], win[8];
#pragma unroll
    for (int tt = 0; tt < 8; ++tt) acc[tt] = bias;
#pragma unroll
    for (int k = 0; k < 7; ++k) { const f32x4 v = __builtin_convertvector(*(const LAS h4*)(arow + k * 512), f32x4); win[k] = (t0 - 30 + k >= 0) ? v : (f32x4){0.f, 0.f, 0.f, 0.f}; }
#pragma unroll 1
    for (int jb = 0; jb < 4; ++jb) {
#pragma unroll
        for (int jj = 0; jj < 8; ++jj) { const int j = 8 * jb + jj;
            if (j < 31) {
                const f32x4 v = __builtin_convertvector(*(const LAS h4*)(arow + (j + 7) * 512), f32x4);
                win[(jj + 7) & 7] = (t0 - 30 + j + 7 >= 0) ? v : (f32x4){0.f, 0.f, 0.f, 0.f};
                const f32x4 w = *(const LAS f32x4*)(wl + j * 1024);
#pragma unroll
                for (int tt = 0; tt < 8; ++tt) acc[tt] += w * win[(jj + tt) & 7]; } } }
    const u16* PSZC = (const u16*)(p.ws + WS_PSZC); u16* MIX = (u16*)(p.ws + WS_MIX);
#pragma unroll
    for (int tt = 0; tt < 8; ++tt) { const size_t row = rowb + tt;
        const float mean = wave_sum((acc[tt][0] + acc[tt][1]) + (acc[tt][2] + acc[tt][3])) * (1.f / 256.f);
        const f32x4 d = acc[tt] - mean;
        const float rstd = 1.f / sqrtf(wave_sum((d[0] * d[0] + d[1] * d[1]) + (d[2] * d[2] + d[3] * d[3])) * (1.f / 256.f) + LN_EPS);
        const h4 z = *(const h4*)(PSZC + row * 256 + 4 * lane); float o[4];
#pragma unroll
        for (int k = 0; k < 4; ++k) o[k] = silu(d[k] * rstd * cg[k] + cb[k]) * (float)z[k];
        u32x2 w; w.x = pkh(o[0], o[1]); w.y = pkh(o[2], o[3]);
        *(u32x2*)(MIX + row * D + 4 * lane) = w; }
}
DI void task_pool(const Params& p, int l, int R0, int th, int g, LAS unsigned char* lds, int wave, int lane) {
    const u16* PPV = (const u16*)(p.ws + WS_PPV); const u16* PSZP = (const u16*)(p.ws + WS_PSZP); u16* MIX = (u16*)(p.ws + WS_MIX);
    const int b = R0 >> 12, T0 = (R0 & (SEQ - 1)) + 32 * th; const size_t rb = (size_t)b * SEQ;
    LAS unsigned char* scr = lds + MX_SCR + wave * MX_SCR_W;
    const int r = lane & 31, h = lane >> 5;
    u32x4 tl[6];
#pragma unroll
    for (int i = 0; i < 6; ++i) { const int row = (lane >> 3) + 8 * i, tk = T0 - 15 + row; const int tkc = tk < 0 ? 0 : (row < 47 ? tk : T0 + 31);
        const u32x4 v = *(const u32x4*)(PPV + (rb + tkc) * 256 + 64 * g + 8 * (lane & 7)); const unsigned msk = (unsigned)-(int)(tk >= 0); tl[i] = (u32x4){v[0] & msk, v[1] & msk, v[2] & msk, v[3] & msk}; }
    const size_t orow = rb + T0 + r;
    u32x2 zp[2][4]; f32x4 ps[2][4];
#pragma unroll
    for (int nb = 0; nb < 2; ++nb)
#pragma unroll
        for (int xq = 0; xq < 4; ++xq) { const int col = 64 * g + 32 * nb + 8 * xq + 4 * h; zp[nb][xq] = *(const u32x2*)(PSZP + orow * 256 + col); ps[nb][xq] = *(const f32x4*)(p.pool_scale + l * 256 + col); }
#pragma unroll
    for (int i = 0; i < 6; ++i) { const int row = (lane >> 3) + 8 * i; if (row < 47) *(LAS u32x4*)(scr + row * 144 + (lane & 7) * 16) = tl[i]; }
    asm volatile("s_waitcnt lgkmcnt(0)" ::: "memory");
    const int wlen = 2 << g; const int t = T0 + r; const float icnt = 1.f / (float)(wlen < t + 1 ? wlen : t + 1);
    h8 bf[4];
#pragma unroll
    for (int s = 0; s < 4; ++s) { const LAS unsigned char* base = scr + (15 + r) * 144 + (16 * s + 8 * h) * 2; float sm[8];
        const h8 cur = *(const LAS h8*)base;
#pragma unroll
        for (int k = 0; k < 8; ++k) sm[k] = (float)cur[k];
        for (int i = 1; i < wlen; ++i) { const h8 v = *(const LAS h8*)(base - i * 144);
#pragma unroll
            for (int k = 0; k < 8; ++k) sm[k] += (float)v[k]; }
        float pl[8];
#pragma unroll
        for (int k = 0; k < 8; ++k) pl[k] = sm[k] * icnt - (float)cur[k];
        bf[s] = __builtin_bit_cast(h8, pack8(pl)); }
    f32x16 Dd[2];
#pragma unroll
    for (int x = 0; x < 16; ++x) { Dd[0][x] = 0.f; Dd[1][x] = 0.f; }
#pragma unroll
    for (int s = 0; s < 4; ++s)
#pragma unroll
        for (int nb = 0; nb < 2; ++nb) { const h8 af = *(const LAS h8*)(lds + MX_WPT + ((g * 64 + 32 * nb + r) * 72 + 16 * s + 8 * h) * 2);
            Dd[nb] = __builtin_amdgcn_mfma_f32_32x32x16_f16(af, bf[s], Dd[nb], 0, 0, 0); }
#pragma unroll
    for (int nb = 0; nb < 2; ++nb)
#pragma unroll
        for (int xq = 0; xq < 4; ++xq) { const int col = 64 * g + 32 * nb + 8 * xq + 4 * h; const h4 z = __builtin_bit_cast(h4, zp[nb][xq]); const f32x4 sc = ps[nb][xq];
            u32x2 w; w.x = pkh(Dd[nb][4 * xq] * sc[0] * (float)z[0], Dd[nb][4 * xq + 1] * sc[1] * (float)z[1]); w.y = pkh(Dd[nb][4 * xq + 2] * sc[2] * (float)z[2], Dd[nb][4 * xq + 3] * sc[3] * (float)z[3]);
            *(u32x2*)(MIX + orow * D + 256 + col) = w; }
}
DI void mix_prompt_tasks(const Params& p, int l, int unit, LAS unsigned char* lds, int lane, int wave) {
    int one = 1; asm volatile("" : "+s"(one));
    if (one) task_attn(p, l, unit >> 6, (unit >> 5) & 1, wave & 3, (unit & 31) * 128 + 32 * (wave >> 2), lane_id());
    asm volatile("" : "+s"(one) :: "memory");
    if (one) task_attn(p, l, unit >> 6, (unit >> 5) & 1, wave & 3, (unit & 31) * 128 + 32 * (2 + (wave >> 2)), lane_id());
    asm volatile("s_waitcnt vmcnt(0) lgkmcnt(0)\n\ts_barrier" : "+s"(one) :: "memory");
    if (one) task_conv(p, l, unit * 64, wave, lds, lane_id());
    asm volatile("s_waitcnt lgkmcnt(0)\n\ts_barrier" : "+s"(one) :: "memory");
    if (one) task_pool(p, l, unit * 64, wave >> 2, wave & 3, lds, wave, lane_id());
    (void)lane;
}

DI void convpool_sample_unit(const Params& p, const MixPtrs& X, int l, int b, int part, LAS unsigned char* lds, int tid, int lane, int wave) {
    LAS float* cv = (LAS float*)lds;
    const int c = tid & 255, tp = tid >> 8; const size_t r0 = (size_t)MP + 4 * b;
    if (part == 0) {
        const float* cc = p.cache_conv + (size_t)(l * DB + b) * 30 * 256;
        float xa[34], wv[31];
        { const float* pc = cc + c;
#pragma unroll
          for (int ri = 0; ri < 30; ++ri) xa[ri] = pc[ri * 256];
          const u16* pn = X.PA + r0 * 256 + c;
#pragma unroll
          for (int ri = 0; ri < 4; ++ri) xa[30 + ri] = (float)(*(const _Float16*)(pn + ri * 256));
          const float* pw = p.conv_w + (size_t)l * 31 * 256 + c;
#pragma unroll
          for (int j = 0; j < 31; ++j) wv[j] = pw[j * 256]; }
        float a0 = p.conv_b[l * 256 + c], a1 = a0;
        if (tp == 0) {
#pragma unroll
            for (int j = 0; j < 31; ++j) { a0 += wv[j] * xa[j]; a1 += wv[j] * xa[j + 1]; }
        } else {
#pragma unroll
            for (int j = 0; j < 31; ++j) { a0 += wv[j] * xa[j + 2]; a1 += wv[j] * xa[j + 3]; } }
        cv[(2 * tp) * 256 + c] = a0; cv[(2 * tp + 1) * 256 + c] = a1;
        { float* oc = p.out + OFF_CONVS + (size_t)(l * DB + b) * 30 * 256; for (int e = tid; e < 26 * 64; e += NTHR) *(f32x4*)(oc + 4 * e) = *(const f32x4*)(cc + 4 * 256 + 4 * e); }
        __syncthreads();
        if (wave < 4) { const int t = wave; const f32x4 v = *(const LAS f32x4*)(cv + t * 256 + 4 * lane);
            const float mean = wave_sum((v[0] + v[1]) + (v[2] + v[3])) * (1.f / 256.f); const f32x4 d = v - mean;
            const float rstd = 1.f / sqrtf(wave_sum((d[0] * d[0] + d[1] * d[1]) + (d[2] * d[2] + d[3] * d[3])) * (1.f / 256.f) + LN_EPS);
            const f32x4 cg = *(const f32x4*)(p.cnorm_g + l * 256 + 4 * lane), cb = *(const f32x4*)(p.cnorm_b + l * 256 + 4 * lane);
            const h4 zc = *(const h4*)(X.PSZC + (r0 + t) * 256 + 4 * lane); float o[4];
#pragma unroll
            for (int k = 0; k < 4; ++k) o[k] = silu(d[k] * rstd * cg[k] + cb[k]) * (float)zc[k];
            u32x2 w; w.x = pkh(o[0], o[1]); w.y = pkh(o[2], o[3]);
            *(u32x2*)(X.MIX + (r0 + t) * D + 4 * lane) = w; }
    } else {
        const float* cp = p.cache_pool + (size_t)(l * DB + b) * 15 * 256;
        float xa[19];
        { const float* pc = cp + c;
#pragma unroll
          for (int ri = 0; ri < 15; ++ri) xa[ri] = pc[ri * 256];
          const u16* pn = X.PPV + r0 * 256 + c;
#pragma unroll
          for (int ri = 0; ri < 4; ++ri) xa[15 + ri] = (float)(*(const _Float16*)(pn + ri * 256)); }
        const int wlen = 2 << (c >> 6); float s0 = 0.f, s1 = 0.f, c0, c1;
        if (tp == 0) { c0 = xa[15]; c1 = xa[16];
#pragma unroll
            for (int i = 0; i < 16; ++i) if (i < wlen) { s0 += xa[15 - i]; s1 += xa[16 - i]; }
        } else { c0 = xa[17]; c1 = xa[18];
#pragma unroll
            for (int i = 0; i < 16; ++i) if (i < wlen) { s0 += xa[17 - i]; s1 += xa[18 - i]; } }
        const float iw = 1.f / (float)wlen;
        cv[(2 * tp) * 256 + c] = s0 * iw - c0; cv[(2 * tp + 1) * 256 + c] = s1 * iw - c1;
        { float* op = p.out + OFF_POOLS + (size_t)(l * DB + b) * 15 * 256; for (int e = tid; e < 11 * 64; e += NTHR) *(f32x4*)(op + 4 * e) = *(const f32x4*)(cp + 4 * 256 + 4 * e); }
        __syncthreads();
        const int g = c >> 6, n = c & 63; const float* pw = p.pool_w + ((size_t)l * 4 + g) * 64 * 64 + n; float y0 = 0.f, y1 = 0.f;
#pragma unroll 16
        for (int k = 0; k < 64; ++k) { const float w = pw[(size_t)k * 64]; y0 += cv[(2 * tp) * 256 + 64 * g + k] * w; y1 += cv[(2 * tp + 1) * 256 + 64 * g + k] * w; }
        const float ps = p.pool_scale[l * 256 + c];
        const float z0 = (float)(*(const _Float16*)(X.PSZP + (r0 + 2 * tp) * 256 + c)), z1 = (float)(*(const _Float16*)(X.PSZP + (r0 + 2 * tp + 1) * 256 + c));
        *(_Float16*)(X.MIX + (r0 + 2 * tp) * D + 256 + c) = (_Float16)(y0 * ps * z0); *(_Float16*)(X.MIX + (r0 + 2 * tp + 1) * D + 256 + c) = (_Float16)(y1 * ps * z1); }
    __syncthreads();
}

DI void attn_sample_unit(const Params& p, const MixPtrs& X, int l, int unit, LAS unsigned char* lds, int tid, int lane, int wave) {
    const int b = unit >> 1, hk = unit & 1; const size_t r0 = (size_t)MP + 4 * b;
    LAS float* EX = (LAS float*)lds;
    LAS float* OP = EX + 256;
    const float* ck = p.cache_k + ((size_t)(l * DB + b) * 128 * 2 + hk) * 64; const float* cvv = p.cache_v + ((size_t)(l * DB + b) * 128 * 2 + hk) * 64;
    float* ok = p.out + OFF_KS + ((size_t)(l * DB + b) * 128 * 2 + hk) * 64; float* ov = p.out + OFF_VS + ((size_t)(l * DB + b) * 128 * 2 + hk) * 64;
    f32x4 ckv[4], cvw[4];
#pragma unroll
    for (int i = 0; i < 4; ++i) { const int e = tid + 512 * i, j = e >> 4, d4 = (e & 15) * 4; ckv[i] = *(const f32x4*)(ck + (size_t)j * 128 + d4); cvw[i] = *(const f32x4*)(cvv + (size_t)j * 128 + d4); }
    const int fr = lane & 15, fq = lane >> 4;
    f32x4 O[4]; f32x4 Sa = {0.f, 0.f, 0.f, 0.f}, Sb = {0.f, 0.f, 0.f, 0.f};
    float vg[4][8];
    const int kA = 32 * wave + fr, kB = kA + 16;
    if (wave < 5) {
        h8 ka[2], kb[2], qf[2];
#pragma unroll
        for (int ks = 0; ks < 2; ++ks) { const int d0 = 32 * ks + 8 * fq;
            qf[ks] = *(const h8*)(X.PQ + (r0 + (fr >> 2)) * 512 + (4 * hk + (fr & 3)) * 64 + d0);
            if (wave < 4) { const f32x4 a0 = *(const f32x4*)(ck + (size_t)kA * 128 + d0), a1 = *(const f32x4*)(ck + (size_t)kA * 128 + d0 + 4), b0 = *(const f32x4*)(ck + (size_t)kB * 128 + d0), b1 = *(const f32x4*)(ck + (size_t)kB * 128 + d0 + 4);
                float t8[8] = {a0[0], a0[1], a0[2], a0[3], a1[0], a1[1], a1[2], a1[3]}; ka[ks] = __builtin_bit_cast(h8, pack8(t8));
                float u8[8] = {b0[0], b0[1], b0[2], b0[3], b1[0], b1[1], b1[2], b1[3]}; kb[ks] = __builtin_bit_cast(h8, pack8(u8));
            } else { const int rr = fr < 4 ? fr : 0; const u32x4 raw = *(const u32x4*)(X.PK + (r0 + rr) * 128 + hk * 64 + d0); ka[ks] = __builtin_bit_cast(h8, fr < 4 ? raw : (u32x4){0u, 0u, 0u, 0u}); kb[ks] = __builtin_bit_cast(h8, (u32x4){0u, 0u, 0u, 0u}); } }
#pragma unroll
        for (int dt = 0; dt < 4; ++dt)
#pragma unroll
            for (int j = 0; j < 8; ++j) { const int key = 32 * wave + (j < 4 ? 0 : 16) + 4 * fq + (j & 3); const int d = 16 * dt + fr;
                if (wave < 4) vg[dt][j] = cvv[(size_t)key * 128 + d];
                else vg[dt][j] = key < 132 ? (float)(*(const _Float16*)(X.PV + (r0 + (key - 128)) * 128 + hk * 64 + d)) : 0.f; }
#pragma unroll
        for (int ks = 0; ks < 2; ++ks) { Sa = __builtin_amdgcn_mfma_f32_16x16x32_f16(ka[ks], qf[ks], Sa, 0, 0, 0); Sb = __builtin_amdgcn_mfma_f32_16x16x32_f16(kb[ks], qf[ks], Sb, 0, 0, 0); }
        const int t = fr >> 2; float mx = -INFINITY;
#pragma unroll
        for (int i = 0; i < 4; ++i) { const int k0 = 32 * wave + 4 * fq + i, k1 = k0 + 16;
            Sa[i] = (k0 >= t + 1 && k0 <= t + 128) ? Sa[i] : -INFINITY; Sb[i] = (k1 >= t + 1 && k1 <= t + 128) ? Sb[i] : -INFINITY; mx = fmaxf(mx, fmaxf(Sa[i], Sb[i])); }
        mx = fmaxf(mx, xor_lane<16>(mx)); mx = max_halves(mx);
        if (fq == 0) EX[wave * 16 + fr] = mx;
    }
#pragma unroll
    for (int i = 0; i < 4; ++i) { const int e = tid + 512 * i, j = e >> 4, d4 = (e & 15) * 4; if (j >= 4) { *(f32x4*)(ok + (size_t)(j - 4) * 128 + d4) = ckv[i]; *(f32x4*)(ov + (size_t)(j - 4) * 128 + d4) = cvw[i]; } }
    __syncthreads();
    if (wave < 5) {
        const float sink2 = p.sinks[l * 8 + 4 * hk + (fr & 3)] * LOG2E;
        float m = sink2;
#pragma unroll
        for (int w = 0; w < 5; ++w) m = fmaxf(m, EX[w * 16 + fr]);
        float sum = 0.f;
#pragma unroll
        for (int i = 0; i < 4; ++i) { Sa[i] = ex2(Sa[i] - m); Sb[i] = ex2(Sb[i] - m); sum += Sa[i] + Sb[i]; }
        sum += xor_lane<16>(sum); sum = sum_halves(sum);
        if (fq == 0) EX[128 + wave * 16 + fr] = sum;
        float p8[8] = {Sa[0], Sa[1], Sa[2], Sa[3], Sb[0], Sb[1], Sb[2], Sb[3]}; const h8 pb = __builtin_bit_cast(h8, pack8(p8));
#pragma unroll
        for (int dt = 0; dt < 4; ++dt) { const h8 va = __builtin_bit_cast(h8, pack8(vg[dt])); O[dt] = __builtin_amdgcn_mfma_f32_16x16x32_f16(va, pb, (f32x4){0.f, 0.f, 0.f, 0.f}, 0, 0, 0);
#pragma unroll
            for (int i = 0; i < 4; ++i) OP[(wave * 64 + 16 * dt + 4 * fq + i) * 16 + fr] = O[dt][i]; }
    }
    __syncthreads();
    { const int qr = tid & 15, dg = tid >> 4, t = qr >> 2, g = qr & 3;
        const float sink2 = p.sinks[l * 8 + 4 * hk + g] * LOG2E; float m = sink2, den = 0.f, o0 = 0.f, o1 = 0.f;
#pragma unroll
        for (int w = 0; w < 5; ++w) { m = fmaxf(m, EX[w * 16 + qr]); den += EX[128 + w * 16 + qr]; o0 += OP[(w * 64 + 2 * dg) * 16 + qr]; o1 += OP[(w * 64 + 2 * dg + 1) * 16 + qr]; }
        const float inv = 1.f / (den + ex2(sink2 - m));
        const int col = (4 * hk + g) * 64 + 2 * dg;
        const h2 z = *(const h2*)(X.PSZA + (r0 + t) * 512 + col);
        *(unsigned*)(X.MIX + (r0 + t) * D + 512 + col) = pkh(o0 * inv * (float)z[0], o1 * inv * (float)z[1]); }
    __syncthreads();
}

template <int R>
DI void sample_ln_rows(const Params& p, int l, int row0, int lane) {
    const u16* ZH = (const u16*)(p.ws + WS_ZH); u16* XR = (u16*)(p.ws + WS_XR); u16* ZP = (u16*)(p.ws + WS_H);
    const float* lg = p.ln_g + (size_t)l * D; const float* lb = p.ln_b + (size_t)l * D;
    const float* modn = (const float*)(p.ws + WS_MOD) + (size_t)(l + 1) * NMOD * 3072;
    float v[R][16], mean[R], rstd[R];
#pragma unroll
    for (int r = 0; r < R; ++r)
#pragma unroll
        for (int j2 = 0; j2 < 2; ++j2) unpack8(*(const u32x4*)(ZH + (size_t)(row0 + r) * D + 512 * j2 + 8 * lane), v[r] + 8 * j2);
    ln_stats<R>(v, mean, rstd);
#pragma unroll
    for (int j2 = 0; j2 < 2; ++j2)
#pragma unroll
        for (int h = 0; h < 2; ++h) { const f32x4 g = *(const f32x4*)(lg + 512 * j2 + 8 * lane + 4 * h), bb = *(const f32x4*)(lb + 512 * j2 + 8 * lane + 4 * h);
#pragma unroll
            for (int r = 0; r < R; ++r)
#pragma unroll
                for (int k = 0; k < 4; ++k) v[r][8 * j2 + 4 * h + k] = v[r][8 * j2 + 4 * h + k] * rstd[r] * g[k] + bb[k]; }
    if (l == DEPTH - 1) {
#pragma unroll
        for (int r = 0; r < R; ++r) { float* y = p.out + OFF_YS + (size_t)(row0 - MP + r) * D;
#pragma unroll
            for (int j2 = 0; j2 < 2; ++j2)
#pragma unroll
                for (int h = 0; h < 2; ++h) *(f32x4*)(y + 512 * j2 + 8 * lane + 4 * h) = (f32x4){v[r][8 * j2 + 4 * h], v[r][8 * j2 + 4 * h + 1], v[r][8 * j2 + 4 * h + 2], v[r][8 * j2 + 4 * h + 3]}; }
    } else {
#pragma unroll
        for (int r = 0; r < R; ++r)
#pragma unroll
            for (int j2 = 0; j2 < 2; ++j2) *(u32x4*)(XR + (size_t)(row0 + r) * D + 512 * j2 + 8 * lane) = pack8(v[r] + 8 * j2);
        ln_stats<R>(v, mean, rstd);
#pragma unroll
        for (int r = 0; r < R; ++r) { const int row = row0 + r; const float* sh = modn + (size_t)(NB + ((row - MP) >> 2)) * 3072; const float* sc = sh + 1024;
#pragma unroll
            for (int j2 = 0; j2 < 2; ++j2) { float o[8];
#pragma unroll
                for (int h = 0; h < 2; ++h) { const f32x4 a = *(const f32x4*)(sc + 512 * j2 + 8 * lane + 4 * h), bb = *(const f32x4*)(sh + 512 * j2 + 8 * lane + 4 * h);
#pragma unroll
                    for (int k = 0; k < 4; ++k) o[4 * h + k] = v[r][8 * j2 + 4 * h + k] * rstd[r] * (1.f + a[k]) + bb[k]; }
                *(u32x4*)(ZP + (size_t)row * D + 512 * j2 + 8 * lane) = pack8(o); } }
    }
}
DI void outproj_sample_unit(const Params& p, int l, int unit, LAS unsigned char* lds, int tid, int lane, int wave) {
    const int rbk0 = unit >> 5, cb = unit & 31, R0 = MP + 64 * rbk0, n0 = 32 * cb, r = lane & 31, h = lane >> 5;
    const u16* MIX = (const u16*)(p.ws + WS_MIX); const u16* WT = (const u16*)(p.ws + WS_WOUT) + (size_t)l * D * D;
    const u16* bp = WT + (size_t)perm_out(n0 + r) * D + wave * 128 + 8 * h;
    const u16* ap = MIX + (size_t)(R0 + r) * D + wave * 128 + 8 * h;
    f32x16 acc[2];
#pragma unroll
    for (int x = 0; x < 16; ++x) { acc[0][x] = 0.f; acc[1][x] = 0.f; }
#pragma unroll
    for (int s = 0; s < 8; ++s) { const h8 bf = *(const h8*)(bp + 16 * s);
#pragma unroll
        for (int rb = 0; rb < 2; ++rb) { const h8 af = *(const h8*)(ap + (size_t)rb * 32 * D + 16 * s); acc[rb] = __builtin_amdgcn_mfma_f32_32x32x16_f16(af, bf, acc[rb], 0, 0, 0); } }
    LAS float* part = (LAS float*)lds;
#pragma unroll
    for (int rb = 0; rb < 2; ++rb)
#pragma unroll
        for (int x = 0; x < 16; ++x) part[(wave * 64 + 32 * rb + crow(x, h)) * 32 + r] = acc[rb][x];
    __syncthreads();
    const float* modl = (const float*)(p.ws + WS_MOD) + (size_t)l * NMOD * 3072;
#pragma unroll
    for (int q = 0; q < 4; ++q) { const int o = tid + 512 * q, row = o >> 5, col = o & 31; float sum = 0.f;
#pragma unroll
        for (int w = 0; w < 8; ++w) sum += part[(w * 64 + row) * 32 + col];
        const int grow = R0 + row, bidx = NB + ((grow - MP) >> 2);
        const float xr = (float)(*(const _Float16*)((const u16*)(p.ws + WS_XR) + (size_t)grow * D + n0 + col));
        *(_Float16*)((u16*)(p.ws + WS_ZH) + (size_t)grow * D + n0 + col) = (_Float16)(ALPHA * xr + (1.f + modl[(size_t)bidx * 3072 + 2048 + n0 + col]) * sum); }
    asm volatile("s_waitcnt vmcnt(0)" ::: "memory");
    __syncthreads();
    if (wave == 0 && lane == 0) {
        __builtin_amdgcn_fence(__ATOMIC_RELEASE, "agent"); asm volatile("s_waitcnt vmcnt(0)" ::: "memory");
        (void)__hip_atomic_fetch_add((unsigned*)(p.ws + WS_CTL) + CW_SCNT + 64 * (l * 8 + rbk0), 1u, __ATOMIC_RELAXED, __HIP_MEMORY_SCOPE_AGENT); }
}
DI void outproj_sample_finish(const Params& p, int l, int unit, int lane, int wave) {
    if (wave != 0) return;
    unsigned* cnt = (unsigned*)(p.ws + WS_CTL) + CW_SCNT + 64 * (l * 8 + (unit >> 5));
    for (unsigned sp = 0; sp < (1u << 20); ++sp) { if (__hip_atomic_load(cnt, __ATOMIC_RELAXED, __HIP_MEMORY_SCOPE_AGENT) >= 32u) break; __builtin_amdgcn_s_sleep(2); }
    __builtin_amdgcn_fence(__ATOMIC_ACQUIRE, "agent"); asm volatile("s_waitcnt vmcnt(0)" ::: "memory");
    sample_ln_rows<2>(p, l, MP + 64 * (unit >> 5) + 2 * (unit & 31), lane);
}

constexpr int N_PHASES = 3 + 3 * DEPTH;
typedef const __attribute__((address_space(4))) Params* KParams;
#define PHASE_BEGIN() const int lane_ = lane_id(); const int lane = lane_, wave = wave_s, tid = wave_s * 64 + lane_; \
    KParams kq = kp; asm volatile("" : "+s"(kq)); Params p; { const ParamsHead hh_ = *(const __attribute__((address_space(4))) ParamsHead*)kq; __builtin_memcpy(&p, &hh_, sizeof(ParamsHead)); }     const int gw = vcu * NWAVES + wave, NGW = G * NWAVES; (void)lane; (void)gw; (void)NGW
#define MIXPTRS() MixPtrs X; X.PA = (const u16*)(p.ws + WS_PA); X.PSZC = (const u16*)(p.ws + WS_PSZC); X.PPV = (const u16*)(p.ws + WS_PPV); X.PSZP = (const u16*)(p.ws + WS_PSZP); \
    X.PQ = (const u16*)(p.ws + WS_PQ); X.PSZA = (const u16*)(p.ws + WS_PSZA); X.PK = (const u16*)(p.ws + WS_PK); X.PV = (const u16*)(p.ws + WS_PV); X.MIX = (u16*)(p.ws + WS_MIX)
__global__ void __launch_bounds__(NTHR, 2) hymba_fwd(Params p_unused) {
#if defined(__HIP_DEVICE_COMPILE__)
    extern __shared__ __attribute__((aligned(16))) unsigned char lds_raw[];
    LAS unsigned char* lds = (LAS unsigned char*)lds_raw;
    volatile LAS unsigned* MISC = (volatile LAS unsigned*)(lds + MISC_OFF);
    const KParams kp = (KParams)__builtin_amdgcn_kernarg_segment_ptr();
    const int G = gridDim.x, bx = blockIdx.x, vcu = (G % 8 == 0) ? (bx % 8) * (G / 8) + bx / 8 : bx;
    const int wave_s = __builtin_amdgcn_readfirstlane((int)threadIdx.x >> 6);
    for (int u = threadIdx.x; u < (LDS_BYTES - RING_BYTES) / 4; u += NTHR) ((LAS unsigned*)(lds + RING_BYTES))[u] = 0u;
    __syncthreads();
    unsigned* ctl = (unsigned*)(kp->ws + WS_CTL);
    XcdBarrier bar; bar.bar = ctl + CW_BAR; bar.x = 0; bar.st = nullptr;
    if (MK_N_LAUNCHES == 1) bar = xcd_barrier_post(ctl + CW_BAR, MISC + 8);
    const int lo = kp->ph_lo, hi = kp->ph_hi;
#ifndef ONLY
#define ONLY -1
#endif
#ifndef ONLYMASK
#define ONLYMASK 0x3f
#endif
#define EN(t) ((ONLY < 0 || ONLY == (t)) && ((ONLYMASK >> (t)) & 1))
#define IN(k) (lo <= (k) && (k) < hi)
#define SEAM(k) do { if (MK_N_LAUNCHES == 1 && IN((k) + 1)) xcd_barrier(bar, wave_s); } while (0)
    if (EN(0) && IN(0)) { { PHASE_BEGIN(); p0_prologue(p, (const __attribute__((address_space(4))) float*)((const __attribute__((address_space(4))) char*)kq + __builtin_offsetof(Params, inv_freq)), lds, vcu, G, tid, lane, wave); } SEAM(0); }
    if (EN(1) && IN(1)) { { PHASE_BEGIN(); for (int u = vcu; u < DEPTH * 40; u += G) modv_unit(p, lds, u, tid, lane, wave); pre_phase(p, gw, NGW, lane); } SEAM(1); }
#pragma unroll 1
    for (int l = 0; l < DEPTH; ++l) {
        const int ph = 2 + 3 * l;
        if (EN(2) && IN(ph)) {
            { PHASE_BEGIN();
            pg8::Gemm g{(const u16*)(p.ws + WS_H), (const u16*)(p.ws + WS_WIN) + (size_t)l * DIN * D, M, DIN, D};
            pg8::StaticOrder S; S.init(M, DIN, G, bx);
            LAS float* rcl = (LAS float*)(lds + RING_BYTES + 1024);
            { int pms[3]; for (int i = 0; i < 3; ++i) { pg8::Unit u; pms[i] = S.next(i, u) ? u.pm : -1; } finalize_rc_in(p, l, pms, rcl, tid); }
            asm volatile("s_waitcnt lgkmcnt(0)" ::: "memory"); __syncthreads();
            EpiIn E{l, p.ws, p.out, rcl};
            pg8::gemm_phase<EpiIn, true>(lds, g, S, E, tid); }
            SEAM(ph);
        }
        if (EN(3) && IN(ph + 1)) {
            { PHASE_BEGIN(); MIXPTRS(); for (int u = vcu; u < 256; u += G) attn_prompt_unit(p, X, l, u, lds, tid, lane, wave); }
            { PHASE_BEGIN(); MIXPTRS(); for (int u = vcu; u < 256; u += G) conv_prompt_unit(p, X, l, u, lds, tid, lane, wave); }
            { PHASE_BEGIN(); for (int e = tid; e < 4 * 64 * 8; e += NTHR) { const int g = e >> 9, c = (e >> 3) & 63, n8 = (e & 7) * 8;
                  const f32x4 w0 = *(const f32x4*)(p.pool_w + (size_t)l * 16384 + (g * 64 + c) * 64 + n8), w1 = *(const f32x4*)(p.pool_w + (size_t)l * 16384 + (g * 64 + c) * 64 + n8 + 4);
#pragma unroll
                  for (int k = 0; k < 4; ++k) { *(LAS _Float16*)(lds + MX_WPT + ((g * 64 + n8 + k) * 72 + c) * 2) = (_Float16)w0[k]; *(LAS _Float16*)(lds + MX_WPT + ((g * 64 + n8 + 4 + k) * 72 + c) * 2) = (_Float16)w1[k]; } }
              asm volatile("s_waitcnt lgkmcnt(0)" ::: "memory"); __syncthreads(); }
            { PHASE_BEGIN(); for (int u = vcu; u < 256; u += G) { task_pool(p, l, u * 64, wave >> 2, wave & 3, lds, wave, lane); __syncthreads(); } }
            { PHASE_BEGIN(); MIXPTRS(); for (int u = vcu; u < 256; u += G) attn_sample_unit(p, X, l, u, lds, tid, lane, wave); }
            { PHASE_BEGIN(); MIXPTRS(); for (int u = vcu; u < 2 * DB; u += G) convpool_sample_unit(p, X, l, u >> 1, u & 1, lds, tid, lane, wave); }
            SEAM(ph + 1); }
        if (EN(4) && IN(ph + 2)) {
            { PHASE_BEGIN();
            pg8::Gemm g{(const u16*)(p.ws + WS_MIX), (const u16*)(p.ws + WS_WOUT) + (size_t)l * D * D, M, D, D};
            for (int u = vcu; u < 256; u += G) outproj_sample_unit(p, l, u, lds, tid, lane, wave);
            __syncthreads();
            pg8::StaticOrder S; S.init(MP, D, G, bx);
            EpiOutF E{p.ws, l, p.ln_g, p.ln_b};
            pg8::gemm_phase<EpiOutF, false>(lds, g, S, E, tid);
            for (int u = vcu; u < 256; u += G) outproj_sample_finish(p, l, u, lane, wave); }
            SEAM(ph + 2);
        }
    }
    if (EN(5) && IN(N_PHASES - 1)) { PHASE_BEGIN(); fin_phase(p, gw, NGW, lane); }
#undef IN
#undef SEAM
#endif
}


#ifdef DBG
constexpr int DBG_NS = 56;
constexpr size_t WS_DBGACC = 32 * 1024;
constexpr size_t WS_DBGZ = WS_END;
__constant__ int dbg_rows_tab[DBG_NS] = {0, 1, 2, 3, 14, 15, 16, 29, 30, 31, 32, 63, 64, 65, 127, 128, 129, 255, 256, 1000, 2047, 2048, 3967, 3968, 4065, 4066, 4080, 4081, 4094, 4095, 4096, 4097, 4127, 4224,
                            8191, 8192, 8320, 12288, 12415, 16382, 16383, 16384, 16385, 16386, 16387, 16388, 16391, 16639, 16640, 16892, 16893, 16894, 16895, 5000, 9999, 15000};
__device__ int dbg_row(int i) { return dbg_rows_tab[i]; }
__device__ void dbg_acc(float* accf, int id, float e, float r) {
    __shared__ float se[256], sr[256];
    const int t = threadIdx.x; se[t] = e; sr[t] = r; __syncthreads();
    for (int o = 128; o > 0; o >>= 1) { if (t < o) { se[t] += se[t + o]; sr[t] += sr[t + o]; } __syncthreads(); }
    if (t == 0) { atomicAdd(accf + 2 * id, se[0]); atomicAdd(accf + 2 * id + 1, sr[0]); }
    __syncthreads();
}
__device__ float dbg_h(const u16* p, size_t i) { return (float)(*(const _Float16*)(p + i)); }
__device__ float dbg_block_sum(float v) { __shared__ float sb[256]; const int t = threadIdx.x; sb[t] = v; __syncthreads(); for (int o = 128; o > 0; o >>= 1) { if (t < o) sb[t] += sb[t + o]; __syncthreads(); } const float r = sb[0]; __syncthreads(); return r; }
__device__ void dbg_ln4(float (&x)[4], float& rstd) { const float mean = dbg_block_sum(x[0] + x[1] + x[2] + x[3]) / D; float q = 0; for (int i = 0; i < 4; ++i) { x[i] -= mean; q += x[i] * x[i]; } rstd = 1.f / sqrtf(dbg_block_sum(q) / D + LN_EPS); }
#define DBG_E(fast, ref) do { const float f_ = (fast), r_ = (ref); e += (f_ - r_) * (f_ - r_); rr += r_ * r_; } while (0)
__global__ void __launch_bounds__(256) dbg_p0(Params p) {
    float* accf = (float*)(p.ws + WS_DBGACC); const int t = threadIdx.x, bid = blockIdx.x;
    { float e = 0, rr = 0; const int ri = (bid >> 2) % 9;
        const int l = bid & 3, row = ri < 6 ? ri : (ri == 6 ? 67 : 123 + ri);
        const float* c = row < NB ? p.c_prompt + (size_t)row * D : p.c_sample + (size_t)(row - NB) * D;
        for (int n = t * 12 + (bid % 12); n < 3072; n += 256 * 12) { float a = p.b_mod[l * 3072 + n];
            for (int k = 0; k < D; ++k) { const float x = c[k]; a += x / (1.f + expf(-x)) * p.w_mod[((size_t)l * D + k) * 3072 + n]; }
            DBG_E(((const float*)(p.ws + WS_MOD))[((size_t)l * NMOD + row) * 3072 + n], a); }
        dbg_acc(accf, 0, e, rr); }
    { float e = 0, rr = 0;
        for (int i = 0; i < 64; ++i) { const int l = bid & 3, col = (bid * 37 + i * 41 + t * 10) % DIN, k = (t * 4 + i * 16 + bid) % D;
            DBG_E(dbg_h((const u16*)(p.ws + WS_WIN), ((size_t)l * DIN + perm_in(col)) * D + k), p.w_in[((size_t)l * D + k) * DIN + col]); }
        dbg_acc(accf, 1, e, rr); }
    { float e = 0, rr = 0;
        for (int i = 0; i < 64; ++i) { const int l = bid & 3, col = (bid * 37 + i * 41 + t * 4) % D, k = (t * 4 + i * 16 + bid) % D;
            DBG_E(dbg_h((const u16*)(p.ws + WS_WOUT), ((size_t)l * D + perm_out(col)) * D + k), p.w_out[((size_t)l * D + k) * D + col]); }
        dbg_acc(accf, 2, e, rr); }
    { float e = 0, rr = 0;
        for (int i = 0; i < 16; ++i) { const int pi = (bid * 113 + i * 257 + t * 16) % (SEQ + DS), f = (t + i) & 31; const int pos = pi < SEQ ? pi : PAST + pi - SEQ;
            const float ang = (float)pos * p.inv_freq[f]; const f32x2 cs = ((const f32x2*)(p.ws + WS_TAB))[pi * 32 + f];
            DBG_E(cs[0], cosf(ang)); DBG_E(cs[1], sinf(ang)); }
        dbg_acc(accf, 3, e, rr); }
}
__global__ void __launch_bounds__(256) dbg_p0b(Params p) {
    float* accf = (float*)(p.ws + WS_DBGACC); const int t = threadIdx.x, bid = blockIdx.x;
    { float e = 0, rr = 0;
        const int l = bid & 3, b = (bid >> 2) & 3; const float* md = (const float*)(p.ws + WS_MOD) + ((size_t)l * NMOD + b) * 3072;
        const int col = (t * 10 + (bid >> 4) * 3 + 1) % DIN; float v1 = 0, v2 = 0, v3 = 0, v4 = 0;
        for (int c = 0; c < D; ++c) { const float w = p.w_in[((size_t)l * D + c) * DIN + col], g = l > 0 ? p.ln_g[(l - 1) * D + c] : 1.f, bb = l > 0 ? p.ln_b[(l - 1) * D + c] : 0.f, s1 = 1.f + md[1024 + c];
            v1 += g * s1 * w; v2 += bb * s1 * w; v3 += s1 * w; v4 += md[c] * w; }
        const float* mv = (const float*)(p.ws + WS_MODV) + (size_t)(l * NB + b) * 4 * DIN + perm_in(col);
        DBG_E(mv[0], v1); DBG_E(mv[2 * DIN], v3); DBG_E(mv[3 * DIN], v4); if (l > 0) DBG_E(mv[DIN], v2); else e += mv[DIN] * mv[DIN];
        dbg_acc(accf, 69, e, rr); }
    if (bid < DBG_NS) { const int row = dbg_row(bid); const bool smp = row >= MP; const int bidx = smp ? NB + ((row - MP) >> 2) : (row >> 12);
        const float* md = (const float*)(p.ws + WS_MOD) + (size_t)bidx * 3072;
        float x[4]; for (int i = 0; i < 4; ++i) { const int c = t + 256 * i; x[i] = smp ? p.x_sample[(size_t)(row - MP) * D + c] : p.x_prompt[(size_t)row * D + c]; }
        float e = 0, rr = 0; for (int i = 0; i < 4; ++i) DBG_E(dbg_h((const u16*)(p.ws + (smp ? WS_XR : WS_ZH)), (size_t)row * D + t + 256 * i), x[i]); dbg_acc(accf, 70, e, rr);
        e = 0; rr = 0;
        if (!smp) { for (int i = 0; i < 4; ++i) { const int c = t + 256 * i; DBG_E(dbg_h((const u16*)(p.ws + WS_H), (size_t)row * D + c), x[i] * (1.f + md[1024 + c])); } }
        else { float rstd; dbg_ln4(x, rstd); for (int i = 0; i < 4; ++i) { const int c = t + 256 * i; DBG_E(dbg_h((const u16*)(p.ws + WS_H), (size_t)row * D + c), x[i] * rstd * (1.f + md[1024 + c]) + md[c]); } }
        dbg_acc(accf, 71, e, rr); }
}
__global__ void __launch_bounds__(256) dbg_copyz(Params p) { const int row = dbg_row(blockIdx.x);
    for (int c = threadIdx.x; c < D; c += 256) { ((u16*)(p.ws + WS_DBGZ))[blockIdx.x * D + c] = ((const u16*)(p.ws + WS_ZH))[(size_t)row * D + c]; ((u16*)(p.ws + WS_DBGZ))[(DBG_NS + blockIdx.x) * D + c] = ((const u16*)(p.ws + WS_XR))[(size_t)row * D + c]; } }
__global__ void __launch_bounds__(256) dbg_in(Params p, int l) {
    __shared__ float pr[DIN]; __shared__ float hh[D];
    float* accf = (float*)(p.ws + WS_DBGACC); const int t = threadIdx.x, row = dbg_row(blockIdx.x), base = 4 + 16 * l;
    const bool smp = row >= MP; const int b = smp ? (row - MP) >> 2 : row >> 12, tt = smp ? (row - MP) & 3 : row & (SEQ - 1), pos = smp ? PAST + tt : tt;
    const int bidx = smp ? NB + b : b; const float* md = (const float*)(p.ws + WS_MOD) + ((size_t)l * NMOD + bidx) * 3072;
    float e, rr;
    { float x[4]; float rstd;
        for (int i = 0; i < 4; ++i) x[i] = dbg_h((const u16*)(p.ws + (smp ? WS_XR : WS_ZH)), (size_t)row * D + t + 256 * i);
        if (!smp && l > 0) { dbg_ln4(x, rstd); for (int i = 0; i < 4; ++i) { const int c = t + 256 * i; x[i] = x[i] * rstd * p.ln_g[(l - 1) * D + c] + p.ln_b[(l - 1) * D + c]; } }
        dbg_ln4(x, rstd);
        for (int i = 0; i < 4; ++i) { const int c = t + 256 * i; hh[c] = x[i] * rstd * (1.f + md[1024 + c]) + md[c]; }
        __syncthreads();
        if (smp) { e = 0; rr = 0; for (int i = 0; i < 4; ++i) { const int c = t + 256 * i; DBG_E(dbg_h((const u16*)(p.ws + WS_H), (size_t)row * D + c), hh[c]); } dbg_acc(accf, base + 1, e, rr); } }
    for (int i = 0; i < 10; ++i) { const int col = t + 256 * i; float a = 0; for (int k = 0; k < D; ++k) a += hh[k] * p.w_in[((size_t)l * D + k) * DIN + col]; pr[col] = a; }
    __syncthreads();
    const float av = pr[t] / (1.f + expf(-pr[256 + t]));
    e = 0; rr = 0; DBG_E(dbg_h((const u16*)(p.ws + WS_PA), (size_t)row * 256 + t), av); dbg_acc(accf, base + 2, e, rr);
    e = 0; rr = 0; { const float z = pr[512 + t]; DBG_E(dbg_h((const u16*)(p.ws + WS_PSZC), (size_t)row * 256 + t), z / (1.f + expf(-z))); } dbg_acc(accf, base + 3, e, rr);
    e = 0; rr = 0; DBG_E(dbg_h((const u16*)(p.ws + WS_PPV), (size_t)row * 256 + t), pr[768 + t]); dbg_acc(accf, base + 4, e, rr);
    e = 0; rr = 0; { const float z = pr[1024 + t]; DBG_E(dbg_h((const u16*)(p.ws + WS_PSZP), (size_t)row * 256 + t), z / (1.f + expf(-z))); } dbg_acc(accf, base + 5, e, rr);
    e = 0; rr = 0;
    for (int i = 0; i < 2; ++i) { const int c = t + 256 * i, hd = c >> 6, d = c & 63, f = d & 31; const float ang = (float)pos * p.inv_freq[f], cs = cosf(ang), sn = sinf(ang);
        const float x = pr[1280 + c], xo = d < 32 ? -pr[1280 + hd * 64 + d + 32] : pr[1280 + hd * 64 + d - 32];
        DBG_E(dbg_h((const u16*)(p.ws + WS_PQ), (size_t)row * 512 + c), (x * cs + xo * sn) * QSCALE); }
    dbg_acc(accf, base + 6, e, rr);
    e = 0; rr = 0; float kref = 0.f, vref = 0.f;
    if (t < 128) { const int hd = t >> 6, d = t & 63, f = d & 31; const float ang = (float)pos * p.inv_freq[f], cs = cosf(ang), sn = sinf(ang);
        const float x = pr[1792 + t], xo = d < 32 ? -pr[1792 + hd * 64 + d + 32] : pr[1792 + hd * 64 + d - 32]; kref = x * cs + xo * sn;
        DBG_E(dbg_h((const u16*)(p.ws + WS_PK), (size_t)row * 128 + t), kref); }
    dbg_acc(accf, base + 7, e, rr);
    e = 0; rr = 0; if (t < 128) { vref = pr[1920 + t]; DBG_E(dbg_h((const u16*)(p.ws + WS_PV), (size_t)row * 128 + t), vref); } dbg_acc(accf, base + 8, e, rr);
    e = 0; rr = 0; for (int i = 0; i < 2; ++i) { const float z = pr[2048 + t + 256 * i]; DBG_E(dbg_h((const u16*)(p.ws + WS_PSZA), (size_t)row * 512 + t + 256 * i), z / (1.f + expf(-z))); } dbg_acc(accf, base + 9, e, rr);
    e = 0; rr = 0;
    if (smp) { DBG_E(p.out[OFF_CONVS + ((size_t)(l * DB + b) * 30 + 26 + tt) * 256 + t], av); DBG_E(p.out[OFF_POOLS + ((size_t)(l * DB + b) * 15 + 11 + tt) * 256 + t], pr[768 + t]);
        if (t < 128) { DBG_E(p.out[OFF_KS + ((size_t)(l * DB + b) * 128 + 124 + tt) * 128 + t], kref); DBG_E(p.out[OFF_VS + ((size_t)(l * DB + b) * 128 + 124 + tt) * 128 + t], vref); } }
    else { if (tt >= SEQ - 30) DBG_E(p.out[OFF_CONVP + ((size_t)(l * NB + b) * 30 + tt - (SEQ - 30)) * 256 + t], av);
        if (tt >= SEQ - 15) DBG_E(p.out[OFF_POOLP + ((size_t)(l * NB + b) * 15 + tt - (SEQ - 15)) * 256 + t], pr[768 + t]);
        if (tt >= SEQ - 128 && t < 128) { DBG_E(p.out[OFF_KP + ((size_t)(l * NB + b) * 128 + tt - (SEQ - 128)) * 128 + t], kref); DBG_E(p.out[OFF_VP + ((size_t)(l * NB + b) * 128 + tt - (SEQ - 128)) * 128 + t], vref); } }
    dbg_acc(accf, base + 10, e, rr);
}
__global__ void __launch_bounds__(256) dbg_mix(Params p, int l) {
    __shared__ float sh[1024]; __shared__ float sc[136];
    float* accf = (float*)(p.ws + WS_DBGACC); const int t = threadIdx.x, row = dbg_row(blockIdx.x), base = 4 + 16 * l;
    const bool smp = row >= MP; const int b = smp ? (row - MP) >> 2 : row >> 12, tt = smp ? (row - MP) & 3 : row & (SEQ - 1);
    const u16 *PA = (const u16*)(p.ws + WS_PA), *PSZC = (const u16*)(p.ws + WS_PSZC), *PPV = (const u16*)(p.ws + WS_PPV), *PSZP = (const u16*)(p.ws + WS_PSZP), *PQ = (const u16*)(p.ws + WS_PQ),
              *PSZA = (const u16*)(p.ws + WS_PSZA), *PK = (const u16*)(p.ws + WS_PK), *PV = (const u16*)(p.ws + WS_PV), *MIX = (const u16*)(p.ws + WS_MIX);
    float e, rr;
    {
        float a = p.conv_b[l * 256 + t];
        for (int j = 0; j < 31; ++j) { float x;
            if (!smp) { const int ts = tt - 30 + j; x = ts >= 0 ? dbg_h(PA, ((size_t)b * SEQ + ts) * 256 + t) : 0.f; }
            else { const int ri = tt + j; x = ri < 30 ? p.cache_conv[((size_t)(l * DB + b) * 30 + ri) * 256 + t] : dbg_h(PA, ((size_t)MP + 4 * b + ri - 30) * 256 + t); }
            a += p.conv_w[((size_t)l * 31 + j) * 256 + t] * x; }
        const float mean = dbg_block_sum(a) / 256.f; const float d = a - mean; const float rstd = 1.f / sqrtf(dbg_block_sum(d * d) / 256.f + LN_EPS);
        const float y = d * rstd * p.cnorm_g[l * 256 + t] + p.cnorm_b[l * 256 + t];
        e = 0; rr = 0; DBG_E(dbg_h(MIX, (size_t)row * D + t), y / (1.f + expf(-y)) * dbg_h(PSZC, (size_t)row * 256 + t)); dbg_acc(accf, base + 11, e, rr); }
    {
        const int w = 2 << (t >> 6); float s = 0;
        for (int i = 0; i < w; ++i) { float x;
            if (!smp) { const int ts = tt - i; x = ts >= 0 ? dbg_h(PPV, ((size_t)b * SEQ + ts) * 256 + t) : 0.f; }
            else { const int ri = 15 + tt - i; x = ri < 15 ? p.cache_pool[((size_t)(l * DB + b) * 15 + ri) * 256 + t] : dbg_h(PPV, ((size_t)MP + 4 * b + ri - 15) * 256 + t); }
            s += x; }
        const float cnt = smp ? (float)w : (float)(w < tt + 1 ? w : tt + 1);
        sh[t] = s / cnt - dbg_h(PPV, (size_t)row * 256 + t); __syncthreads();
        const int g = t >> 6, n = t & 63; float y = 0; for (int c = 0; c < 64; ++c) y += sh[64 * g + c] * p.pool_w[(((size_t)l * 4 + g) * 64 + c) * 64 + n];
        e = 0; rr = 0; DBG_E(dbg_h(MIX, (size_t)row * D + 256 + t), y * p.pool_scale[l * 256 + t] * dbg_h(PSZP, (size_t)row * 256 + t)); dbg_acc(accf, base + 12, e, rr); __syncthreads(); }
    {
        e = 0; rr = 0;
        for (int hd = 0; hd < 8; ++hd) { const int hk = hd >> 2; __syncthreads();
            if (t < 64) sh[t] = dbg_h(PQ, (size_t)row * 512 + hd * 64 + t); __syncthreads();
            const float sink2 = p.sinks[l * 8 + hd] * LOG2E;
            if (t < 128) { float s = -INFINITY;
                if (!smp) { const int ts = tt - 127 + t; if (ts >= 0) { s = 0; for (int d = 0; d < 64; ++d) s += sh[d] * dbg_h(PK, ((size_t)b * SEQ + ts) * 128 + hk * 64 + d); } }
                else { const int ci = tt + 1 + t;
                    s = 0; for (int d = 0; d < 64; ++d) s += sh[d] * (ci < 128 ? p.cache_k[(((size_t)(l * DB + b) * 128 + ci) * 2 + hk) * 64 + d] : dbg_h(PK, ((size_t)MP + 4 * b + ci - 128) * 128 + hk * 64 + d)); }
                sc[t] = s; }
            __syncthreads();
            float mx = sink2; for (int k = 0; k < 128; ++k) mx = fmaxf(mx, sc[k]);
            float den = exp2f(sink2 - mx); for (int k = 0; k < 128; ++k) den += exp2f(sc[k] - mx);
            if (t < 64) { float o = 0;
                for (int k = 0; k < 128; ++k) { const float pk = exp2f(sc[k] - mx) / den; if (pk == 0.f) continue; float v;
                    if (!smp) { const int ts = tt - 127 + k; v = dbg_h(PV, ((size_t)b * SEQ + ts) * 128 + hk * 64 + t); }
                    else { const int ci = tt + 1 + k; v = ci < 128 ? p.cache_v[(((size_t)(l * DB + b) * 128 + ci) * 2 + hk) * 64 + t] : dbg_h(PV, ((size_t)MP + 4 * b + ci - 128) * 128 + hk * 64 + t); }
                    o += pk * v; }
                DBG_E(dbg_h(MIX, (size_t)row * D + 512 + hd * 64 + t), o * dbg_h(PSZA, (size_t)row * 512 + hd * 64 + t)); } }
        dbg_acc(accf, base + 13, e, rr); }
    if (smp) { e = 0; rr = 0;
        for (int i = 0; i < 26; ++i) DBG_E(p.out[OFF_CONVS + ((size_t)(l * DB + b) * 30 + i) * 256 + t], p.cache_conv[((size_t)(l * DB + b) * 30 + i + 4) * 256 + t]);
        for (int i = 0; i < 11; ++i) DBG_E(p.out[OFF_POOLS + ((size_t)(l * DB + b) * 15 + i) * 256 + t], p.cache_pool[((size_t)(l * DB + b) * 15 + i + 4) * 256 + t]);
        for (int i = 0; i < 124; ++i) if (t < 128) { DBG_E(p.out[OFF_KS + ((size_t)(l * DB + b) * 128 + i) * 128 + t], p.cache_k[((size_t)(l * DB + b) * 128 + i + 4) * 128 + t]);
            DBG_E(p.out[OFF_VS + ((size_t)(l * DB + b) * 128 + i) * 128 + t], p.cache_v[((size_t)(l * DB + b) * 128 + i + 4) * 128 + t]); }
        dbg_acc(accf, base + 15, e, rr); }
}
__global__ void __launch_bounds__(256) dbg_out(Params p, int l) {
    __shared__ float mm[D];
    float* accf = (float*)(p.ws + WS_DBGACC); const int t = threadIdx.x, row = dbg_row(blockIdx.x), base = 4 + 16 * l;
    const bool smp = row >= MP; const int bidx = smp ? NB + ((row - MP) >> 2) : (row >> 12);
    for (int c = t; c < D; c += 256) mm[c] = dbg_h((const u16*)(p.ws + WS_MIX), (size_t)row * D + c);
    __syncthreads();
    const float* md = (const float*)(p.ws + WS_MOD) + ((size_t)l * NMOD + bidx) * 3072 + 2048;
    const float* mdn = (const float*)(p.ws + WS_MOD) + ((size_t)(l + 1) * NMOD + bidx) * 3072;
    float x1[4], z[4], rstd;
    for (int i = 0; i < 4; ++i) x1[i] = dbg_h((const u16*)(p.ws + WS_DBGZ), (size_t)((smp ? DBG_NS : 0) + blockIdx.x) * D + t + 256 * i);
    if (!smp && l > 0) { dbg_ln4(x1, rstd); for (int i = 0; i < 4; ++i) { const int c = t + 256 * i; x1[i] = x1[i] * rstd * p.ln_g[(l - 1) * D + c] + p.ln_b[(l - 1) * D + c]; } }
    float e = 0, rr = 0;
    for (int i = 0; i < 4; ++i) { const int c = t + 256 * i; float a = 0; for (int k = 0; k < D; ++k) a += mm[k] * p.w_out[((size_t)l * D + k) * D + c];
        z[i] = ALPHA * x1[i] + (1.f + md[c]) * a; DBG_E(dbg_h((const u16*)(p.ws + WS_ZH), (size_t)row * D + c), z[i]); }
    dbg_acc(accf, base + 14, e, rr);
    e = 0; rr = 0;
    if (!smp) { if (l < DEPTH - 1) for (int i = 0; i < 4; ++i) { const int c = t + 256 * i; DBG_E(dbg_h((const u16*)(p.ws + WS_H), (size_t)row * D + c), z[i] * p.ln_g[l * D + c] * (1.f + mdn[1024 + c])); } }
    else { dbg_ln4(z, rstd); for (int i = 0; i < 4; ++i) { const int c = t + 256 * i; z[i] = z[i] * rstd * p.ln_g[l * D + c] + p.ln_b[l * D + c]; }
        if (l == DEPTH - 1) { for (int i = 0; i < 4; ++i) DBG_E(p.out[OFF_YS + (size_t)(row - MP) * D + t + 256 * i], z[i]); }
        else { for (int i = 0; i < 4; ++i) DBG_E(dbg_h((const u16*)(p.ws + WS_XR), (size_t)row * D + t + 256 * i), z[i]);
            dbg_ln4(z, rstd); for (int i = 0; i < 4; ++i) { const int c = t + 256 * i; DBG_E(dbg_h((const u16*)(p.ws + WS_H), (size_t)row * D + c), z[i] * rstd * (1.f + mdn[1024 + c]) + mdn[c]); } } }
    dbg_acc(accf, base + 0, e, rr);
    if (l == 0) { dbg_acc(accf, 100, smp ? 0.f : e, smp ? 0.f : rr); dbg_acc(accf, 101, smp ? e : 0.f, smp ? rr : 0.f); }
}
__global__ void __launch_bounds__(256) dbg_fin(Params p) {
    float* accf = (float*)(p.ws + WS_DBGACC); const int t = threadIdx.x, row = dbg_row(blockIdx.x);
    if (row >= MP) return;
    float x[4]; for (int i = 0; i < 4; ++i) x[i] = dbg_h((const u16*)(p.ws + WS_ZH), (size_t)row * D + t + 256 * i);
    float rstd; dbg_ln4(x, rstd); float e = 0, rr = 0;
    for (int i = 0; i < 4; ++i) { const int c = t + 256 * i; DBG_E(p.out[(size_t)row * D + c], x[i] * rstd * p.ln_g[3 * D + c] + p.ln_b[3 * D + c]); }
    dbg_acc(accf, 68, e, rr);
}
#ifndef DBG_REPORT_ID
#define DBG_REPORT_ID -1
#endif
__global__ void __launch_bounds__(256) dbg_report(Params p) {
    const float* accf = (const float*)(p.ws + WS_DBGACC);
    float code = 1000.f;
    if (DBG_REPORT_ID >= 0) { const float e = accf[2 * DBG_REPORT_ID], r = accf[2 * DBG_REPORT_ID + 1]; code = (r > 0.f ? e / r : 9.9f) * 1e12f; if (!(code > 100.f)) code = 100.f; }
    else for (int i = 0; i < 128; ++i) { const float e = accf[2 * i], r = accf[2 * i + 1]; const bool expected = i <= 71 && !(i >= 4 && i < 68 && ((i - 4) & 15) == 0 && (i - 4) / 16 == 99);
        if ((r > 0.f && !(e / r < 1e-3f)) || (r == 0.f && (e > 0.f || expected)) || e != e || r != r) { code = (float)(i + 1) * 1e4f; break; } }
    const float S = sqrtf(code);
    for (size_t i = (size_t)blockIdx.x * 256 + threadIdx.x; i < (size_t)MP * D; i += (size_t)gridDim.x * 256) p.out[i] = S;
}
#endif

extern "C" void kernel_launch(void* const* d_in, const int* in_sizes, int n_in, void* d_out, int out_size, void* d_ws, size_t ws_size, hipStream_t stream) {
    static int grid = 0;
    if (grid == 0) {
        if (n_in != 21 || (size_t)out_size != OUT_TOTAL || ws_size < WS_END) { fprintf(stderr, "kernel_launch: unexpected shapes (n_in %d, out %d, ws %zu)\n", n_in, out_size, ws_size); grid = -1; return; }
        int dev = 0, cus = 0;
        if (hipGetDevice(&dev) != hipSuccess || hipDeviceGetAttribute(&cus, hipDeviceAttributeMultiprocessorCount, dev) != hipSuccess) { grid = -1; return; }
        if (hipFuncSetAttribute((const void*)hymba_fwd, hipFuncAttributeMaxDynamicSharedMemorySize, LDS_BYTES) != hipSuccess) { fprintf(stderr, "kernel_launch: hipFuncSetAttribute failed\n"); grid = -1; return; }
        (void)hipGetLastError();
        grid = cus;
    }
    if (grid < 0) return;
    (void)hipMemsetAsync((char*)d_ws + WS_CTL, 0, CTL_ZERO_BYTES, stream);
    Params a{};
    a.x_prompt = (const float*)d_in[0]; a.x_sample = (const float*)d_in[1]; a.cache_conv = (const float*)d_in[2]; a.cache_pool = (const float*)d_in[3];
    a.cache_k = (const float*)d_in[4]; a.cache_v = (const float*)d_in[5]; a.c_prompt = (const float*)d_in[6]; a.c_sample = (const float*)d_in[7];
    a.w_in = (const float*)d_in[8]; a.w_out = (const float*)d_in[9]; a.conv_w = (const float*)d_in[10]; a.conv_b = (const float*)d_in[11];
    a.cnorm_g = (const float*)d_in[12]; a.cnorm_b = (const float*)d_in[13]; a.pool_w = (const float*)d_in[14]; a.pool_scale = (const float*)d_in[15];
    a.sinks = (const float*)d_in[16]; a.w_mod = (const float*)d_in[17]; a.b_mod = (const float*)d_in[18]; a.ln_g = (const float*)d_in[19]; a.ln_b = (const float*)d_in[20];
    a.out = (float*)d_out; a.ws = (unsigned char*)d_ws;
    for (int i = 0; i < 32; ++i) a.inv_freq[i] = (float)std::pow(10000.0, -(double)i * (2.0 / 64.0));
    if (MK_N_LAUNCHES == 1) { a.ph_lo = 0; a.ph_hi = N_PHASES; hipLaunchKernelGGL(hymba_fwd, dim3(grid), dim3(NTHR), LDS_BYTES, stream, a); }
    else for (int ph = 0; ph < N_PHASES; ++ph) {
#ifdef DBG
        if (ph >= 2 && ph < N_PHASES - 1 && (ph - 2) % 3 == 2) hipLaunchKernelGGL(dbg_copyz, dim3(DBG_NS), dim3(256), 0, stream, a);
#endif
        a.ph_lo = ph; a.ph_hi = ph + 1; hipLaunchKernelGGL(hymba_fwd, dim3(grid), dim3(NTHR), LDS_BYTES, stream, a);
#ifdef DBG
        if (ph == 0) hipLaunchKernelGGL(dbg_p0, dim3(144), dim3(256), 0, stream, a);
        else if (ph == 1) hipLaunchKernelGGL(dbg_p0b, dim3(144), dim3(256), 0, stream, a);
        else if (ph == N_PHASES - 1) { hipLaunchKernelGGL(dbg_fin, dim3(DBG_NS), dim3(256), 0, stream, a); hipLaunchKernelGGL(dbg_report, dim3(1024), dim3(256), 0, stream, a); }
        else { const int l = (ph - 2) / 3, k = (ph - 2) % 3;
            if (k == 0) hipLaunchKernelGGL(dbg_in, dim3(DBG_NS), dim3(256), 0, stream, a, l);
            if (k == 1) hipLaunchKernelGGL(dbg_mix, dim3(DBG_NS), dim3(256), 0, stream, a, l);
            if (k == 2) hipLaunchKernelGGL(dbg_out, dim3(DBG_NS), dim3(256), 0, stream, a, l); }
#endif
    }
}
```

```cpp
#include <hip/hip_runtime.h>
#include <cstdint>
#include <cstdio>
#include <cmath>

#define DBG_REPORT_ID -1
#ifndef MK_N_LAUNCHES
#define MK_N_LAUNCHES 1
#endif

#define DI __device__ __forceinline__
#define GAS __attribute__((address_space(1)))
#define LAS __attribute__((address_space(3)))
typedef unsigned short u16;
typedef _Float16 h8 __attribute__((ext_vector_type(8)));
typedef _Float16 h4 __attribute__((ext_vector_type(4)));
typedef _Float16 h2 __attribute__((ext_vector_type(2)));
typedef float f32x2 __attribute__((ext_vector_type(2)));
typedef float f32x4 __attribute__((ext_vector_type(4)));
typedef float f32x16 __attribute__((ext_vector_type(16)));
typedef unsigned u32x4 __attribute__((ext_vector_type(4)));
typedef unsigned u32x2 __attribute__((ext_vector_type(2)));
typedef short v4i16_t __attribute__((ext_vector_type(4)));

constexpr int D = 1024, DIN = 2560, NB = 4, SEQ = 4096, DEPTH = 4, DB = 128, DS = 4;
constexpr int MP = NB * SEQ, MS = DB * DS, M = MP + MS;
constexpr int NMOD = NB + DB;
constexpr int PAST = 8192;
constexpr float LN_EPS = 1e-5f;
constexpr float ALPHA = 1.681792830507429f;
constexpr float LOG2E = 1.4426950408889634f;
constexpr float QSCALE = 0.125f * LOG2E;
constexpr size_t OFF_YP = 0, OFF_YS = OFF_YP + (size_t)MP * D, OFF_CONVP = OFF_YS + (size_t)MS * D, OFF_POOLP = OFF_CONVP + (size_t)DEPTH * NB * 30 * 256,
                 OFF_KP = OFF_POOLP + (size_t)DEPTH * NB * 15 * 256, OFF_VP = OFF_KP + (size_t)DEPTH * NB * 128 * 128, OFF_CONVS = OFF_VP + (size_t)DEPTH * NB * 128 * 128,
                 OFF_POOLS = OFF_CONVS + (size_t)DEPTH * DB * 30 * 256, OFF_KS = OFF_POOLS + (size_t)DEPTH * DB * 15 * 256, OFF_VS = OFF_KS + (size_t)DEPTH * DB * 128 * 128,
                 OUT_TOTAL = OFF_VS + (size_t)DEPTH * DB * 128 * 128;
constexpr size_t MiB = 1u << 20;
constexpr size_t WS_CTL = 0, CTL_ZERO_BYTES = 64 * 1024;
constexpr size_t WS_WIN = 1 * MiB;
constexpr size_t WS_WOUT = 21 * MiB;
constexpr size_t WS_MOD = 29 * MiB;
constexpr size_t WS_TAB = 36 * MiB;
constexpr size_t WS_ZH = 38 * MiB;
constexpr size_t WS_XR = 71 * MiB;
constexpr size_t WS_MIX = 104 * MiB;
constexpr size_t WS_PA = 137 * MiB;
constexpr size_t WS_PSZC = WS_PA + (size_t)M * 256 * 2, WS_PPV = WS_PSZC + (size_t)M * 256 * 2, WS_PSZP = WS_PPV + (size_t)M * 256 * 2;
constexpr size_t WS_PQ = WS_PSZP + (size_t)M * 256 * 2;
constexpr size_t WS_PSZA = WS_PQ + (size_t)M * 512 * 2;
constexpr size_t WS_PK = WS_PSZA + (size_t)M * 512 * 2;
constexpr size_t WS_PV = WS_PK + (size_t)M * 128 * 2;
constexpr size_t WS_H = WS_PV + (size_t)M * 128 * 2;
constexpr size_t WS_PS = WS_H + (size_t)M * D * 2;
constexpr size_t WS_RC0 = WS_PS + 2 * (size_t)MP * 24 * 4;
constexpr size_t WS_MODV = WS_RC0 + (size_t)MP * 16;
constexpr size_t WS_LNC = WS_MODV + (size_t)DEPTH * NB * 4 * DIN * 4;
constexpr size_t WS_VT = WS_LNC + 256;
constexpr size_t WS_END = WS_VT + (size_t)NB * 2 * 64 * SEQ * 2;
static_assert(WS_END <= 256 * MiB, "d_ws map");
constexpr int CW_BAR = 1024;
constexpr int CW_SCNT = 12288;

DI unsigned pkh(float a, float b) { f32x2 v = {a, b}; h2 r = __builtin_convertvector(v, h2); return __builtin_bit_cast(unsigned, r); }
DI u32x4 pack8(const float* v) { u32x4 w; w.x = pkh(v[0], v[1]); w.y = pkh(v[2], v[3]); w.z = pkh(v[4], v[5]); w.w = pkh(v[6], v[7]); return w; }
DI void unpack8(u32x4 w, float* o) {
    const h8 v = __builtin_bit_cast(h8, w);
#pragma unroll
    for (int j = 0; j < 8; ++j) o[j] = (float)v[j];
}
DI float ex2(float x) { return __builtin_amdgcn_exp2f(x); }
DI float sigm(float x) { return __builtin_amdgcn_rcpf(1.f + ex2(-x * LOG2E)); }
DI float silu(float x) { return x * sigm(x); }
template <int O> DI float xor_lane(float v) {
    return __builtin_bit_cast(float, __builtin_amdgcn_ds_swizzle(__builtin_bit_cast(int, v), (O << 10) | 0x1f));
}
DI float sum_halves(float v) { float a = v, b = v; asm volatile("s_nop 1\n\tv_permlane32_swap_b32 %0, %1" : "+v"(a), "+v"(b)); return a + b; }
DI float max_halves(float v) { float a = v, b = v; asm volatile("s_nop 1\n\tv_permlane32_swap_b32 %0, %1" : "+v"(a), "+v"(b)); return fmaxf(a, b); }
template <int CTRL, int ROWMASK> DI float dpp_f(float v, float ident) { return __builtin_bit_cast(float, __builtin_amdgcn_update_dpp(__builtin_bit_cast(int, ident), __builtin_bit_cast(int, v), CTRL, ROWMASK, 0xf, false)); }
DI float wave_sum(float v) {
    v += dpp_f<0xB1, 0xf>(v, 0.f); v += dpp_f<0x4E, 0xf>(v, 0.f); v += dpp_f<0x141, 0xf>(v, 0.f); v += dpp_f<0x140, 0xf>(v, 0.f);
    v += dpp_f<0x142, 0xa>(v, 0.f); v += dpp_f<0x143, 0xc>(v, 0.f);
    return __builtin_bit_cast(float, __builtin_amdgcn_readlane(__builtin_bit_cast(int, v), 63));
}
DI float wave_max(float v) {
    const float NI = -INFINITY;
    v = fmaxf(v, dpp_f<0xB1, 0xf>(v, NI)); v = fmaxf(v, dpp_f<0x4E, 0xf>(v, NI)); v = fmaxf(v, dpp_f<0x141, 0xf>(v, NI)); v = fmaxf(v, dpp_f<0x140, 0xf>(v, NI));
    v = fmaxf(v, dpp_f<0x142, 0xa>(v, NI)); v = fmaxf(v, dpp_f<0x143, 0xc>(v, NI));
    return __builtin_bit_cast(float, __builtin_amdgcn_readlane(__builtin_bit_cast(int, v), 63));
}
DI int lane_id() { int l_; asm volatile("v_mbcnt_lo_u32_b32 %0, -1, 0\n\tv_mbcnt_hi_u32_b32 %0, -1, %0" : "=v"(l_)); return l_; }
DI int crow(int r, int hi) { return (r & 3) + 8 * (r >> 2) + 4 * hi; }

__host__ __device__ __forceinline__ int pperm(int bj, int c7) { return 128 * bj + 32 * (c7 >> 5) + 16 * ((c7 >> 2) & 1) + 4 * ((c7 >> 3) & 3) + (c7 & 3); }
__host__ __device__ __forceinline__ int perm_in(int col) {
    if (col < 512) { const int bj = col >> 8, ch = col & 255; return 256 * (ch >> 7) + pperm(bj, ch & 127); }
    if (col < 1280) { const int base = col < 768 ? 512 : (col < 1024 ? 768 : 1024); const int x = col - base; return base + pperm(x >> 7, x & 127); }
    if (col < 1792) { const int x = col - 1280, head = x >> 6, d = x & 63; return 256 * (5 + (head >> 2)) + pperm(d >> 5, 32 * (head & 3) + (d & 31)); }
    if (col < 2048) { const int x = col - 1792, hh = x >> 6, d = x & 63; return 1792 + pperm(d >> 5, 32 * hh + (d & 31)); }
    { const int x = col - 2048; return 2048 + 256 * (x >> 8) + pperm((x >> 7) & 1, x & 127); }
}
__host__ __device__ __forceinline__ int perm_out(int col) { const int y = col & 255; return (col & ~255) + pperm(y >> 7, y & 127); }

namespace pg8 {
constexpr int BM = 256, BK = 64, HALF = 128, HTB = HALF * BK * 2, STAGE_BYTES = 8 * HTB, NXCD = 8, WGM = 8;
__host__ __device__ __forceinline__ int lds_byte(int r, int c) { const int st = (r >> 4) * 2 + (c >> 5), rr = r & 15, cc = c & 31, ob = rr * 64 + cc * 2; return st * 1024 + (ob ^ (((ob >> 9) & 1) << 5)); }
__host__ __device__ __forceinline__ void stage_rc(int b, int& R, int& C) { const int st = b / 1024, sb = b % 1024, swz = sb ^ (((sb >> 9) & 1) << 5); R = (st >> 1) * 16 + swz / 64; C = (st & 1) * 32 + (swz % 64) / 2; }
struct Unit { int pm, pn; };
struct Gemm { const u16* A; const u16* Bt; int M, N, K; };
struct StaticOrder {
    int nM, nN, nwg, G, c;
    __host__ __device__ void init(int M_, int N_, int G_, int c_) { nM = M_ / BM; nN = N_ / BM; nwg = nM * nN; G = G_; c = c_; }
    __host__ __device__ bool next(int i, Unit& u) const {
        const long L = (long)i * G + c; if (L >= nwg) return false;
        int wgid = (int)L; { const int q = nwg / NXCD, r = nwg % NXCD, xcd = wgid % NXCD, off = wgid / NXCD; wgid = (xcd < r ? xcd * (q + 1) : r * (q + 1) + (xcd - r) * q) + off; }
        const int nig = WGM * nN, gid = wgid / nig, fm = gid * WGM, gsz = (nM - fm) < WGM ? (nM - fm) : WGM;
        u.pm = fm + ((wgid % nig) % gsz); u.pn = (wgid % nig) / gsz; return true;
    }
};

template <class Epi, bool ALIGN_EPI>
DI void gemm_phase(LAS unsigned char* lds, const Gemm g, const StaticOrder& S, const Epi& E, const int tid) {
    const int wid = __builtin_amdgcn_readfirstlane(tid >> 6), lane = tid & 63, wr = wid >> 2, wc = wid & 3, fr = lane & 15, fq = lane >> 4;
    const int K = g.K, nt = K / BK;
    unsigned voffA[2];
#pragma unroll
    for (int i = 0; i < 2; ++i) { int R, C; stage_rc(tid * 16 + i * 8192, R, C); voffA[i] = (unsigned)(R * K + C) * 2u; }
    const size_t kstep = (size_t)(BK * 2);
    const size_t hstep = (size_t)HALF * K * 2;
    const size_t tstep = 2 * hstep;
    const unsigned ldsw = (unsigned)wid * 1024u;
    const int aoff = lds_byte(wr * 64 + fr, fq * 8), boff = lds_byte(wc * 32 + fr, fq * 8);
#define PG8_SA(b, h) (((b) * 2 + (h)) * HTB)
#define PG8_SB(b, h) ((4 + (b) * 2 + (h)) * HTB)
#define PG8_STAGE(bufoff, gbase) do { _Pragma("unroll") for (int _i = 0; _i < 2; ++_i) \
        __builtin_amdgcn_global_load_lds((const unsigned*)((const char*)(gbase) + voffA[_i]), (LAS unsigned*)(lds + (bufoff) + ldsw + _i * 8192), 16, 0, 0); } while (0)
#define PG8_LDA(dst, b, h) do { _Pragma("unroll") for (int m = 0; m < 4; ++m) _Pragma("unroll") for (int k = 0; k < 2; ++k) dst[m][k] = *(const LAS h8*)(lds + PG8_SA(b, h) + aoff + m * 2048 + k * 1024); } while (0)
#define PG8_LDB(dst, b, h) do { _Pragma("unroll") for (int n = 0; n < 2; ++n) _Pragma("unroll") for (int k = 0; k < 2; ++k) dst[n][k] = *(const LAS h8*)(lds + PG8_SB(b, h) + boff + n * 2048 + k * 1024); } while (0)
#define PG8_MMA(ai, bj, At, Bt) do { __builtin_amdgcn_s_setprio(1); _Pragma("unroll") for (int m = 0; m < 4; ++m) _Pragma("unroll") for (int n = 0; n < 2; ++n) _Pragma("unroll") for (int k = 0; k < 2; ++k) \
        acc[ai][bj][m][n] = __builtin_amdgcn_mfma_f32_16x16x32_f16(Bt[n][k], At[m][k], acc[ai][bj][m][n], 0, 0, 0); __builtin_amdgcn_s_setprio(0); } while (0)
#define PG8_WAIT_V(n) asm volatile("s_waitcnt vmcnt(" #n ")" ::: "memory")
#define PG8_WAIT_L(n) asm volatile("s_waitcnt lgkmcnt(" #n ")" ::: "memory")
#define PG8_BAR __builtin_amdgcn_s_barrier()
#define PG8_SCHED __builtin_amdgcn_sched_barrier(0)
    Unit cur, nxt; int ui = 0;
    if (!S.next(0, cur)) return;
    f32x4 acc[2][2][4][2];
#pragma unroll
    for (int a = 0; a < 2; ++a)
#pragma unroll
        for (int b = 0; b < 2; ++b)
#pragma unroll
            for (int m = 0; m < 4; ++m)
#pragma unroll
                for (int n = 0; n < 2; ++n) acc[a][b][m][n] = (f32x4){0.f, 0.f, 0.f, 0.f};
    h8 At[4][2], B0[2][2], B1[2][2];
    const char* cA = (const char*)g.A + (size_t)cur.pm * tstep; const char* cB = (const char*)g.Bt + (size_t)cur.pn * tstep;
    PG8_STAGE(PG8_SB(0, 0), cB); PG8_STAGE(PG8_SB(0, 1), cB + hstep); PG8_STAGE(PG8_SA(0, 0), cA); PG8_STAGE(PG8_SA(0, 1), cA + hstep);
    if (wr == 1) PG8_BAR;
    PG8_WAIT_V(2); PG8_BAR;
    PG8_STAGE(PG8_SB(1, 0), cB + kstep); PG8_STAGE(PG8_SA(1, 0), cA + kstep); PG8_STAGE(PG8_SB(1, 1), cB + hstep + kstep);
    PG8_WAIT_V(6); PG8_BAR;
    for (;;) {
        const bool has_next = S.next(ui + 1, nxt);
        const char* nA = has_next ? (const char*)g.A + (size_t)nxt.pm * tstep : cA; const char* nB = has_next ? (const char*)g.Bt + (size_t)nxt.pn * tstep : cB;
        for (int t = 0; t < nt; t += 2) {
            const bool last = (t == nt - 2);
            const char* a1 = cA + (size_t)(t + 1) * kstep;
            const char* a2 = last ? nA : cA + (size_t)(t + 2) * kstep; const char* b2 = last ? nB : cB + (size_t)(t + 2) * kstep;
            const char* a3 = a2 + kstep; const char* b3 = b2 + kstep;
            PG8_LDB(B0, 0, 0); PG8_LDB(B1, 0, 1); PG8_SCHED; PG8_LDA(At, 0, 0); PG8_STAGE(PG8_SA(1, 1), a1 + hstep);
            PG8_WAIT_V(8); PG8_WAIT_L(0); PG8_BAR; PG8_MMA(0, 0, At, B0); PG8_MMA(0, 1, At, B1); PG8_BAR; PG8_SCHED;
            PG8_LDA(At, 0, 1); PG8_STAGE(PG8_SB(0, 0), b2); PG8_STAGE(PG8_SB(0, 1), b2 + hstep); PG8_STAGE(PG8_SA(0, 0), a2);
            PG8_WAIT_V(8); PG8_WAIT_L(0); PG8_BAR; PG8_MMA(1, 0, At, B0); PG8_MMA(1, 1, At, B1); PG8_BAR; PG8_SCHED;
            PG8_LDB(B0, 1, 0); PG8_LDB(B1, 1, 1); PG8_SCHED; PG8_LDA(At, 1, 0); PG8_STAGE(PG8_SA(0, 1), a2 + hstep);
            PG8_WAIT_V(8); PG8_WAIT_L(0); PG8_BAR; PG8_MMA(0, 0, At, B0); PG8_MMA(0, 1, At, B1); PG8_BAR; PG8_SCHED;
            PG8_LDA(At, 1, 1); PG8_STAGE(PG8_SB(1, 0), b3); PG8_STAGE(PG8_SB(1, 1), b3 + hstep); PG8_STAGE(PG8_SA(1, 0), a3);
            PG8_WAIT_V(8); PG8_WAIT_L(0); PG8_BAR; PG8_MMA(1, 0, At, B0); PG8_MMA(1, 1, At, B1); PG8_BAR; PG8_SCHED;
        }
        if constexpr (ALIGN_EPI) { if (wr == 0) PG8_BAR; }
        if constexpr (!Epi::AFTER_DRAIN) E(acc, cur, ui, wr, wc, fr, fq);
        if (!has_next) break;
#pragma unroll
        for (int a = 0; a < 2; ++a)
#pragma unroll
            for (int b = 0; b < 2; ++b)
#pragma unroll
                for (int m = 0; m < 4; ++m)
#pragma unroll
                    for (int n = 0; n < 2; ++n) acc[a][b][m][n] = (f32x4){0.f, 0.f, 0.f, 0.f};
        cur = nxt; cA = nA; cB = nB; ++ui;
        if constexpr (ALIGN_EPI) { if (wr == 1) PG8_BAR; }
    }
    PG8_WAIT_V(0);
    if constexpr (!ALIGN_EPI) { if (wr == 0) PG8_BAR; }
    PG8_BAR;
    if constexpr (Epi::AFTER_DRAIN) E.fused(acc, cur, wr, wc, fr, fq, lds, tid);
#undef PG8_SA
#undef PG8_SB
#undef PG8_STAGE
#undef PG8_LDA
#undef PG8_LDB
#undef PG8_MMA
#undef PG8_WAIT_V
#undef PG8_WAIT_L
#undef PG8_BAR
#undef PG8_SCHED
}
}

struct Params {
    const float* x_prompt; const float* x_sample; const float* cache_conv; const float* cache_pool; const float* cache_k; const float* cache_v;
    const float* c_prompt; const float* c_sample; const float* w_in; const float* w_out; const float* conv_w; const float* conv_b; const float* cnorm_g; const float* cnorm_b;
    const float* pool_w; const float* pool_scale; const float* sinks; const float* w_mod; const float* b_mod; const float* ln_g; const float* ln_b;
    float* out; unsigned char* ws;
    int ph_lo, ph_hi;
    float inv_freq[32];
};
struct ParamsHead { const float* ptrs[21]; float* out; unsigned char* ws; int ph_lo, ph_hi; };
static_assert(sizeof(ParamsHead) == __builtin_offsetof(Params, inv_freq), "ParamsHead mirrors the head of Params");

DI void row_info(int row, bool& smp, int& b, int& t) { smp = row >= MP; if (!smp) { b = row >> 12; t = row & (SEQ - 1); } else { const int s = row - MP; b = s >> 2; t = s & 3; } }
DI void st8f(float* dst, const float* v) { *(f32x4*)dst = (f32x4){v[0], v[1], v[2], v[3]}; *(f32x4*)(dst + 4) = (f32x4){v[4], v[5], v[6], v[7]}; }

struct EpiIn {
    static constexpr bool AFTER_DRAIN = false;
    int l; unsigned char* ws; float* out; const LAS float* rcl;
    DI void operator()(f32x4 (&acc)[2][2][4][2], const pg8::Unit& u, int ui, int wr, int wc, int fr, int fq) const {
        asm volatile("" : "+v"(fr), "+v"(fq));
        const int pn = u.pn;
        if (u.pm < MP / 256) {
            const LAS f32x4* rc = (const LAS f32x4*)rcl + ui * 256 + wr * 64 + fr;
            const float* mv = (const float*)(ws + WS_MODV) + (size_t)(l * NB + (u.pm >> 4)) * 4 * DIN + pn * 256 + wc * 32 + 4 * fq;
#pragma unroll
            for (int bj = 0; bj < 2; ++bj)
#pragma unroll
                for (int n = 0; n < 2; ++n) { const float* mp = mv + 128 * bj + 16 * n;
                    const f32x4 v1 = *(const f32x4*)mp, v2 = *(const f32x4*)(mp + DIN), v3 = *(const f32x4*)(mp + 2 * DIN), v4 = *(const f32x4*)(mp + 3 * DIN);
#pragma unroll
                    for (int ai = 0; ai < 2; ++ai)
#pragma unroll
                        for (int m = 0; m < 4; ++m) { const f32x4 r = rc[ai * 128 + m * 16];
                            acc[ai][bj][m][n] = r[0] * acc[ai][bj][m][n] - r[1] * v1 + r[2] * v2 - r[3] * v3 + v4; } }
        }
        unsigned char* const W = ws; float* const O = out;
#define ST16(byteoff, vals) (*(u32x4*)(W + (size_t)(unsigned)(byteoff)) = pack8(vals))
#define STF8(fidx, vals) st8f(O + (size_t)(unsigned)(fidx), vals)
#pragma unroll
        for (int ai = 0; ai < 2; ++ai)
#pragma unroll
            for (int m = 0; m < 4; ++m) {
                const unsigned row = (unsigned)(u.pm * 256 + ai * 128 + wr * 64 + m * 16 + fr);
                const bool smp = row >= (unsigned)MP; const unsigned b = smp ? (row - MP) >> 2 : row >> 12, t = smp ? (row - MP) & 3u : row & (unsigned)(SEQ - 1);
                if (pn < 2) {
                    const unsigned c8 = pn * 128 + wc * 32 + fq * 8; float a[8];
#pragma unroll
                    for (int n = 0; n < 2; ++n)
#pragma unroll
                        for (int j = 0; j < 4; ++j) a[4 * n + j] = acc[ai][0][m][n][j] * sigm(acc[ai][1][m][n][j]);
                    ST16((unsigned)WS_PA + (row * 256 + c8) * 2, a);
                    if (smp) STF8((unsigned)OFF_CONVS + ((l * DB + b) * 30 + 26 + t) * 256 + c8, a);
                    else if (t >= SEQ - 30) STF8((unsigned)OFF_CONVP + ((l * NB + b) * 30 + (t - (SEQ - 30))) * 256 + c8, a);
                } else if (pn == 2 || pn == 4) {
                    const unsigned base = pn == 2 ? (unsigned)WS_PSZC : (unsigned)WS_PSZP;
#pragma unroll
                    for (int bj = 0; bj < 2; ++bj) { const unsigned c8 = bj * 128 + wc * 32 + fq * 8; float v[8];
#pragma unroll
                        for (int n = 0; n < 2; ++n)
#pragma unroll
                            for (int j = 0; j < 4; ++j) v[4 * n + j] = silu(acc[ai][bj][m][n][j]);
                        ST16(base + (row * 256 + c8) * 2, v); }
                } else if (pn == 3) {
#pragma unroll
                    for (int bj = 0; bj < 2; ++bj) { const unsigned c8 = bj * 128 + wc * 32 + fq * 8; float v[8];
#pragma unroll
                        for (int n = 0; n < 2; ++n)
#pragma unroll
                            for (int j = 0; j < 4; ++j) v[4 * n + j] = acc[ai][bj][m][n][j];
                        ST16((unsigned)WS_PPV + (row * 256 + c8) * 2, v);
                        if (smp) STF8((unsigned)OFF_POOLS + ((l * DB + b) * 15 + 11 + t) * 256 + c8, v);
                        else if (t >= SEQ - 15) STF8((unsigned)OFF_POOLP + ((l * NB + b) * 15 + (t - (SEQ - 15))) * 256 + c8, v); }
                } else if (pn >= 8) {
#pragma unroll
                    for (int bj = 0; bj < 2; ++bj) { const unsigned c8 = (pn - 8) * 256 + bj * 128 + wc * 32 + fq * 8; float v[8];
#pragma unroll
                        for (int n = 0; n < 2; ++n)
#pragma unroll
                            for (int j = 0; j < 4; ++j) v[4 * n + j] = silu(acc[ai][bj][m][n][j]);
                        ST16((unsigned)WS_PSZA + (row * 512 + c8) * 2, v); }
                } else if (pn == 7 && wc >= 2) {
                    const unsigned hv = wc - 2;
#pragma unroll
                    for (int bj = 0; bj < 2; ++bj) { const unsigned d8 = 32 * bj + 8 * fq; float v[8];
#pragma unroll
                        for (int n = 0; n < 2; ++n)
#pragma unroll
                            for (int j = 0; j < 4; ++j) v[4 * n + j] = acc[ai][bj][m][n][j];
                        ST16((unsigned)WS_PV + (row * 128 + hv * 64 + d8) * 2, v);
                        if (smp) STF8((unsigned)OFF_VS + (((l * DB + b) * 128 + 124 + t) * 2 + hv) * 64 + d8, v);
                        else if (t >= SEQ - 128) STF8((unsigned)OFF_VP + (((l * NB + b) * 128 + (t - (SEQ - 128))) * 2 + hv) * 64 + d8, v); }
                } else {
                    const unsigned d8 = 8 * fq; const unsigned pidx = smp ? SEQ + t : t;
                    const f32x4* tp = (const f32x4*)(W + (size_t)((unsigned)WS_TAB + (pidx * 32 + d8) * 8));
                    float x1[8], x2[8], o1[8], o2[8];
#pragma unroll
                    for (int n = 0; n < 2; ++n)
#pragma unroll
                        for (int j = 0; j < 4; ++j) { x1[4 * n + j] = acc[ai][0][m][n][j]; x2[4 * n + j] = acc[ai][1][m][n][j]; }
                    const float sc = pn == 7 ? 1.f : QSCALE;
#pragma unroll
                    for (int k2 = 0; k2 < 4; ++k2) { const f32x4 cs = tp[k2];
                        o1[2 * k2] = (x1[2 * k2] * cs[0] - x2[2 * k2] * cs[1]) * sc;         o2[2 * k2] = (x2[2 * k2] * cs[0] + x1[2 * k2] * cs[1]) * sc;
                        o1[2 * k2 + 1] = (x1[2 * k2 + 1] * cs[2] - x2[2 * k2 + 1] * cs[3]) * sc; o2[2 * k2 + 1] = (x2[2 * k2 + 1] * cs[2] + x1[2 * k2 + 1] * cs[3]) * sc; }
                    if (pn == 7) { const unsigned hk = wc;
                        ST16((unsigned)WS_PK + (row * 128 + hk * 64 + d8) * 2, o1); ST16((unsigned)WS_PK + (row * 128 + hk * 64 + 32 + d8) * 2, o2);
                        if (smp) { const unsigned di = (unsigned)OFF_KS + (((l * DB + b) * 128 + 124 + t) * 2 + hk) * 64 + d8; STF8(di, o1); STF8(di + 32, o2); }
                        else if (t >= SEQ - 128) { const unsigned di = (unsigned)OFF_KP + (((l * NB + b) * 128 + (t - (SEQ - 128))) * 2 + hk) * 64 + d8; STF8(di, o1); STF8(di + 32, o2); }
                    } else { const unsigned head = (pn - 5) * 4 + wc;
                        ST16((unsigned)WS_PQ + (row * 512 + head * 64 + d8) * 2, o1); ST16((unsigned)WS_PQ + (row * 512 + head * 64 + 32 + d8) * 2, o2); }
                }
            }
#undef ST16
#undef STF8
    }
};

struct EpiOutF {
    static constexpr bool AFTER_DRAIN = true;
    unsigned char* ws; int l; const float* ln_g; const float* ln_b;
    DI void operator()(f32x4 (&)[2][2][4][2], const pg8::Unit&, int, int, int, int, int) const {}
    DI void fused(f32x4 (&acc)[2][2][4][2], const pg8::Unit& u, int wr, int wc, int fr, int fq, LAS unsigned char* lds, int tid) const {
        LAS float* CV = (LAS float*)lds;
        LAS float* RS = (LAS float*)(lds + 8192);
        LAS float* PW = (LAS float*)(lds + 12288);
        u16* ZH = (u16*)(ws + WS_ZH); u16* ZP = (u16*)(ws + WS_H);
        const float* MOD = (const float*)(ws + WS_MOD); const int b = u.pm >> 4;
        const float* PSp = (const float*)(ws + WS_PS) + (size_t)((l + 1) & 1) * MP * 24; float* PSc = (float*)(ws + WS_PS) + (size_t)(l & 1) * MP * 24;
        if (tid < 256) { const int col = u.pn * 256 + tid;
            CV[tid] = l > 0 ? ln_g[(l - 1) * D + col] : 1.f; CV[256 + tid] = l > 0 ? ln_b[(l - 1) * D + col] : 0.f;
            CV[512 + tid] = MOD[((size_t)l * NMOD + b) * 3072 + 2048 + col]; CV[768 + tid] = ln_g[l * D + col]; CV[1024 + tid] = ln_b[l * D + col];
            CV[1280 + tid] = l < DEPTH - 1 ? MOD[((size_t)(l + 1) * NMOD + b) * 3072 + 1024 + col] : 0.f;
        } else { const int row = tid - 256; float mu = 0.f, rstd = 1.f;
            if (l > 0) { const float* ps = PSp + (size_t)(u.pm * 256 + row) * 24; const float s1 = (ps[0] + ps[6]) + (ps[12] + ps[18]), s2 = (ps[1] + ps[7]) + (ps[13] + ps[19]);
                mu = s1 * (1.f / D); rstd = 1.f / sqrtf(s2 * (1.f / D) - mu * mu + LN_EPS); }
            RS[2 * row] = mu; RS[2 * row + 1] = rstd; }
        __syncthreads();
#pragma unroll
        for (int ai = 0; ai < 2; ++ai) {
        u32x4 zpv[4][2];
#pragma unroll
        for (int mm = 0; mm < 4; ++mm)
#pragma unroll
            for (int bj = 0; bj < 2; ++bj) zpv[mm][bj] = *(const u32x4*)(ZH + ((size_t)u.pm * 256 + ai * 128 + wr * 64 + mm * 16 + fr) * D + u.pn * 256 + bj * 128 + wc * 32 + fq * 8);
#pragma unroll
        for (int mm = 0; mm < 4; ++mm) { const int m = mm;
            const int rt = ai * 128 + wr * 64 + m * 16 + fr; const size_t row = (size_t)u.pm * 256 + rt;
            const float mu = RS[2 * rt], rstd = RS[2 * rt + 1];
            float s1 = 0.f, s2 = 0.f, s3 = 0.f, s4 = 0.f, s5 = 0.f, s6 = 0.f;
#pragma unroll
            for (int bj = 0; bj < 2; ++bj) { const int cl = bj * 128 + wc * 32 + fq * 8; const size_t off = row * D + u.pn * 256 + cl;
                float zp[8], zq[8], zo[8]; unpack8(zpv[mm][bj], zp);
#pragma unroll
                for (int hh = 0; hh < 2; ++hh) {
                    const f32x4 gp = *(const LAS f32x4*)(CV + cl + 4 * hh), bp = *(const LAS f32x4*)(CV + 256 + cl + 4 * hh), gt = *(const LAS f32x4*)(CV + 512 + cl + 4 * hh),
                                gg = *(const LAS f32x4*)(CV + 768 + cl + 4 * hh), bb = *(const LAS f32x4*)(CV + 1024 + cl + 4 * hh), sn = *(const LAS f32x4*)(CV + 1280 + cl + 4 * hh);
                    const f32x4 av = acc[ai][bj][m][hh];
#pragma unroll
                    for (int j = 0; j < 4; ++j) { const int k = 4 * hh + j;
                        const float x1 = l > 0 ? (zp[k] - mu) * rstd * gp[j] + bp[j] : zp[k];
                        const float z = ALPHA * x1 + (1.f + gt[j]) * av[j], uu = z * gg[j];
                        s1 += z; s2 += z * z; s3 += uu; s4 += uu * uu; s5 += uu * gg[j]; s6 += uu * bb[j];
                        zq[k] = z; zo[k] = uu * (1.f + sn[j]); } }
                *(u32x4*)(ZH + off) = pack8(zq);
                if (l < DEPTH - 1) *(u32x4*)(ZP + off) = pack8(zo); }
            s1 = sum_halves(s1 + xor_lane<16>(s1)); s2 = sum_halves(s2 + xor_lane<16>(s2)); s3 = sum_halves(s3 + xor_lane<16>(s3)); s4 = sum_halves(s4 + xor_lane<16>(s4)); s5 = sum_halves(s5 + xor_lane<16>(s5)); s6 = sum_halves(s6 + xor_lane<16>(s6));
            if (fq == 0) { LAS float* pw = PW + (rt * 4 + wc) * 6; pw[0] = s1; pw[1] = s2; pw[2] = s3; pw[3] = s4; pw[4] = s5; pw[5] = s6; } }
        asm volatile("" ::: "memory"); }
        __syncthreads();
        if (tid < 256 && l < DEPTH - 1) { float* ps = PSc + (size_t)(u.pm * 256 + tid) * 24 + u.pn * 6; const LAS float* pw = PW + tid * 24;
#pragma unroll
            for (int k = 0; k < 6; ++k) ps[k] = (pw[k] + pw[6 + k]) + (pw[12 + k] + pw[18 + k]); }
    }
};

#define XB_TMO      128
#define XB_XCNT(j)  (256  + 64 * (j))
#define XB_XSUB(j)  (1280 + 64 * (j))
#define XB_XGEN(j)  (2304 + 64 * (j))
#define XB_TOP      3328
#define XB_TOPGEN   3392
#define XCD_BAR_WORDS 3456
#define XB_SPIN_CAP (1u << 18)
DI unsigned xb_ld(unsigned* p)              { return __hip_atomic_load(p, __ATOMIC_RELAXED, __HIP_MEMORY_SCOPE_AGENT); }
DI unsigned xb_add(unsigned* p, unsigned v) { return __hip_atomic_fetch_add(p, v, __ATOMIC_RELAXED, __HIP_MEMORY_SCOPE_AGENT); }
DI unsigned xb_xcc_id() { return (unsigned)__builtin_amdgcn_s_getreg((3 << 11) | 20) & 0xFu; }
#define XB_SPIN(cond, bar) do { unsigned _sp = 0; while (cond) { __builtin_amdgcn_s_sleep(1); \
    if ((++_sp & 255u) == 0u) { if (xb_ld(&(bar)[XB_TMO])) break; if (_sp > XB_SPIN_CAP) { atomicAdd(&(bar)[XB_TMO], 1u); break; } } } } while (0)
struct XcdBarrier { unsigned* bar; unsigned x; volatile LAS unsigned* st; };
DI XcdBarrier xcd_barrier_post(unsigned* bar, volatile LAS unsigned* st) {
    XcdBarrier b; b.bar = bar; b.x = xb_xcc_id(); b.st = st;
    if (threadIdx.x == 0) (void)xb_add(&bar[XB_XCNT(b.x)], 1u);
    return b;
}
DI void xcd_barrier_complete(unsigned* bar, unsigned x, unsigned& nloc, unsigned& nx) {
    const unsigned G = gridDim.x * gridDim.y * gridDim.z;
    unsigned sum, cnt, mine, sp = 0u;
    for (;;) {
        sum = 0u; cnt = 0u; mine = 0u;
#pragma unroll
        for (unsigned j = 0; j < 16; ++j) { const unsigned c = xb_ld(&bar[XB_XCNT(j)]); sum += c; cnt += (c > 0u) ? 1u : 0u; mine = (j == x) ? c : mine; }
        if (sum == G) break;
        __builtin_amdgcn_s_sleep(1);
        if ((++sp & 255u) == 0u) { if (xb_ld(&bar[XB_TMO])) break; if (sp > XB_SPIN_CAP) { atomicAdd(&bar[XB_TMO], 1u); break; } }
    }
    nloc = mine > 0u ? mine : 1u; nx = cnt > 0u ? cnt : 1u;
}
DI void xcd_barrier(const XcdBarrier& b, const int wave_s) {
    asm volatile("s_waitcnt vmcnt(0)" ::: "memory");
    __syncthreads();
    if (wave_s == 0 && lane_id() == 0) {
        unsigned* bar = b.bar;
        __builtin_amdgcn_s_waitcnt(0);
        unsigned nloc = b.st[0], nx = b.st[1];
        if (nloc == 0u) { xcd_barrier_complete(bar, b.x, nloc, nx); b.st[0] = nloc; b.st[1] = nx; }
        const unsigned old = xb_add(&bar[XB_XSUB(b.x)], 1u);
        const unsigned gen = old / nloc;
        if (old + 1u == (gen + 1u) * nloc) {
            __builtin_amdgcn_fence(__ATOMIC_RELEASE, "agent");
            asm volatile("s_waitcnt vmcnt(0)" ::: "memory");
            const unsigned og = xb_add(&bar[XB_TOP], 1u);
            const unsigned tg = og / nx;
            if (og + 1u == (tg + 1u) * nx) xb_add(&bar[XB_TOPGEN], 1u);
            else XB_SPIN(xb_ld(&bar[XB_TOPGEN]) == tg, bar);
            __builtin_amdgcn_fence(__ATOMIC_ACQUIRE, "agent");
            xb_add(&bar[XB_XGEN(b.x)], 1u);
            asm volatile("s_waitcnt vmcnt(0)" ::: "memory");
        } else {
            XB_SPIN(xb_ld(&bar[XB_XGEN(b.x)]) == gen, bar);
            __builtin_amdgcn_fence(__ATOMIC_ACQUIRE, "agent");
            asm volatile("s_waitcnt vmcnt(0)" ::: "memory");
        }
    }
    __syncthreads();
}

constexpr int NWAVES = 8, NTHR = 512;
constexpr int LDS_BYTES = 147456;
constexpr int RING_BYTES = 131072, MISC_OFF = RING_BYTES + 320;

DI void p0_transpose_item(const float* W, int K, int N, u16* WT, LAS float* scr, int item, int lane, bool isin) {
    const int nblk = N / 32, kb = item / nblk, nb = item % nblk, k0 = 64 * kb, n0 = 32 * nb;
    float wv[32];
    { const float* wp = W + (size_t)(k0 + (lane >> 5)) * N + n0 + (lane & 31);
#pragma unroll
      for (int i = 0; i < 32; ++i) wv[i] = wp[(size_t)(2 * i) * N]; }
#pragma unroll
    for (int i = 0; i < 32; ++i) scr[(2 * i + (lane >> 5)) * 33 + (lane & 31)] = wv[i];
    asm volatile("s_waitcnt lgkmcnt(0)" ::: "memory");
    const int c = lane & 7;
#pragma unroll
    for (int j = 0; j < 4; ++j) { const int n = (lane >> 3) + 8 * j; const LAS float* s = scr + (8 * c) * 33 + n;
        u32x4 o; o.x = pkh(s[0 * 33], s[1 * 33]); o.y = pkh(s[2 * 33], s[3 * 33]); o.z = pkh(s[4 * 33], s[5 * 33]); o.w = pkh(s[6 * 33], s[7 * 33]);
        const int dst = isin ? perm_in(n0 + n) : perm_out(n0 + n);
        *(u32x4*)(WT + (size_t)dst * K + k0 + 8 * c) = o; }
    asm volatile("s_waitcnt lgkmcnt(0)" ::: "memory");
}
DI void mod_unit(const Params& p, LAS unsigned char* lds, int unit, int tid, int lane, int wave) {
    const int l = unit >> 6, n0 = (unit & 63) * 48;
    const float* W = p.w_mod + (size_t)l * D * 3072;
    float* MOD = (float*)(p.ws + WS_MOD);
    const int fr = lane & 15, fq = lane >> 4;
    f32x4 acc[9][3];
#pragma unroll
    for (int rt = 0; rt < 9; ++rt)
#pragma unroll
        for (int ct = 0; ct < 3; ++ct) acc[rt][ct] = (f32x4){0.f, 0.f, 0.f, 0.f};
    float wn[3][8];
#pragma unroll
    for (int ct = 0; ct < 3; ++ct) { const float* wp = W + (size_t)(wave * 128 + fq * 8) * 3072 + n0 + 16 * ct + fr;
#pragma unroll
        for (int j = 0; j < 8; ++j) wn[ct][j] = wp[(size_t)j * 3072]; }
#pragma unroll
    for (int ks = 0; ks < 4; ++ks) {
        const int k0 = wave * 128 + ks * 32 + fq * 8;
        h8 bfr[3];
#pragma unroll
        for (int ct = 0; ct < 3; ++ct)
#pragma unroll
            for (int j = 0; j < 8; ++j) bfr[ct][j] = (_Float16)wn[ct][j];
        if (ks < 3) {
#pragma unroll
            for (int ct = 0; ct < 3; ++ct) { const float* wp = W + (size_t)(k0 + 32) * 3072 + n0 + 16 * ct + fr;
#pragma unroll
                for (int j = 0; j < 8; ++j) wn[ct][j] = wp[(size_t)j * 3072]; } }
#pragma unroll
        for (int rt = 0; rt < 9; ++rt) { const int row = 16 * rt + fr; h8 a;
            if (row < NMOD) { const float* c = row < NB ? p.c_prompt + (size_t)row * D : p.c_sample + (size_t)(row - NB) * D;
                const f32x4 c0 = *(const f32x4*)(c + k0), c1 = *(const f32x4*)(c + k0 + 4);
#pragma unroll
                for (int j = 0; j < 4; ++j) { a[j] = (_Float16)silu(c0[j]); a[4 + j] = (_Float16)silu(c1[j]); } }
            else {
#pragma unroll
                for (int j = 0; j < 8; ++j) a[j] = (_Float16)0.f; }
#pragma unroll
            for (int ct = 0; ct < 3; ++ct) acc[rt][ct] = __builtin_amdgcn_mfma_f32_16x16x32_f16(a, bfr[ct], acc[rt][ct], 0, 0, 0); }
    }
    LAS float* part = (LAS float*)lds;
#pragma unroll
    for (int rg = 0; rg < 3; ++rg) {
        __syncthreads();
#pragma unroll
        for (int r3 = 0; r3 < 3; ++r3)
#pragma unroll
            for (int ct = 0; ct < 3; ++ct)
#pragma unroll
                for (int i = 0; i < 4; ++i) part[(wave * 48 + r3 * 16 + 4 * fq + i) * 48 + 16 * ct + fr] = acc[rg * 3 + r3][ct][i];
        __syncthreads();
        for (int o = tid; o < 48 * 48; o += NTHR) { const int r48 = o / 48, col = o % 48, row = 48 * rg + r48; float sacc = 0.f;
#pragma unroll
            for (int w = 0; w < 8; ++w) sacc += part[(w * 48 + r48) * 48 + col];
            if (row < NMOD) MOD[((size_t)l * NMOD + row) * 3072 + n0 + col] = sacc + p.b_mod[(size_t)l * 3072 + n0 + col]; }
    }
    __syncthreads();
}
DI void sincos_d(double a, float& c, float& s) {
    const double k = __builtin_rint(a * 0.63661977236758134308);
    const double r = __builtin_fma(-k, 1.2246467991473532e-16 * 0.5, __builtin_fma(-k, 1.5707963267948966, a));
    const double r2 = r * r;
    double sp = -1.0 / 6227020800.0; sp = sp * r2 + 1.0 / 39916800.0; sp = sp * r2 - 1.0 / 362880.0; sp = sp * r2 + 1.0 / 5040.0; sp = sp * r2 - 1.0 / 120.0; sp = sp * r2 + 1.0 / 6.0;
    const double sn = r - r * r2 * sp;
    double cp = 1.0 / 87178291200.0; cp = cp * r2 - 1.0 / 479001600.0; cp = cp * r2 + 1.0 / 3628800.0; cp = cp * r2 - 1.0 / 40320.0; cp = cp * r2 + 1.0 / 720.0; cp = cp * r2 - 1.0 / 24.0; cp = cp * r2 + 0.5;
    const double cn = 1.0 - r2 * cp;
    const long long q = (long long)k & 3;
    const double cc = (q == 0) ? cn : (q == 1) ? -sn : (q == 2) ? -cn : sn;
    const double ss = (q == 0) ? sn : (q == 1) ? cn : (q == 2) ? -sn : -cn;
    c = (float)cc; s = (float)ss;
}
DI void p0_prologue(const Params& p, const __attribute__((address_space(4))) float* invf, LAS unsigned char* lds, int vcu, int G, int tid, int lane, int wave) {
    for (int u = vcu; u < 256; u += G) mod_unit(p, lds, u, tid, lane, wave);
    LAS float* scr = (LAS float*)(lds + wave * 16384);
    const int gw = vcu * NWAVES + wave, NGW = G * NWAVES;
    constexpr int I_IN = (D / 64) * (DIN / 32), I_OUT = (D / 64) * (D / 32);
    for (int it = gw; it < DEPTH * (I_IN + I_OUT); it += NGW) {
        const int l = it / (I_IN + I_OUT), r = it % (I_IN + I_OUT);
        if (r < I_IN) p0_transpose_item(p.w_in + (size_t)l * D * DIN, D, DIN, (u16*)(p.ws + WS_WIN) + (size_t)l * DIN * D, scr, r, lane, true);
        else p0_transpose_item(p.w_out + (size_t)l * D * D, D, D, (u16*)(p.ws + WS_WOUT) + (size_t)l * D * D, scr, r - I_IN, lane, false);
    }
    if (vcu == 0 && wave < DEPTH) {
        float a = 0.f, b2 = 0.f, c2 = 0.f, d = 0.f, e = 0.f;
        for (int c = lane; c < D; c += 64) { const float g = p.ln_g[wave * D + c], bb = p.ln_b[wave * D + c]; a += g; b2 += g * g; c2 += g * bb; d += bb; e += bb * bb; }
        a = wave_sum(a); b2 = wave_sum(b2); c2 = wave_sum(c2); d = wave_sum(d); e = wave_sum(e);
        if (lane == 0) { float* o = (float*)(p.ws + WS_LNC) + wave * 8; o[0] = a; o[1] = b2; o[2] = c2; o[3] = d; o[4] = e; } }
    f32x2* tab = (f32x2*)(p.ws + WS_TAB);
    for (int e = vcu * NTHR + tid; e < (SEQ + DS) * 32; e += G * NTHR) {
        const int pi = e >> 5, i = e & 31; const int pos = pi < SEQ ? pi : PAST + (pi - SEQ);
        const float ang = (float)pos * invf[i];
        float c, s; sincos_d((double)ang, c, s);
        tab[e] = (f32x2){c, s};
    }
}

template <int R>
DI void ln_stats(float (&v)[R][16], float (&mean)[R], float (&rstd)[R]) {
    float s[R];
#pragma unroll
    for (int r = 0; r < R; ++r) { s[r] = 0.f;
#pragma unroll
        for (int k = 0; k < 16; ++k) s[r] += v[r][k]; }
#pragma unroll
    for (int r = 0; r < R; ++r) s[r] = wave_sum(s[r]);
#pragma unroll
    for (int r = 0; r < R; ++r) { mean[r] = s[r] * (1.f / D); s[r] = 0.f;
#pragma unroll
        for (int k = 0; k < 16; ++k) { v[r][k] -= mean[r]; s[r] += v[r][k] * v[r][k]; } }
#pragma unroll
    for (int r = 0; r < R; ++r) s[r] = wave_sum(s[r]);
#pragma unroll
    for (int r = 0; r < R; ++r) rstd[r] = 1.f / sqrtf(s[r] * (1.f / D) + LN_EPS);
}
constexpr int LNR = 3;
DI void pre_phase(const Params& p, int gw, int NGW, int lane) {
    const float* modl = (const float*)(p.ws + WS_MOD);
    u16* ZH = (u16*)(p.ws + WS_ZH); u16* XR = (u16*)(p.ws + WS_XR); u16* ZP = (u16*)(p.ws + WS_H); f32x4* RC0 = (f32x4*)(p.ws + WS_RC0);
    for (int row0 = gw; row0 < M; row0 += LNR * NGW) {
        float v[LNR][16]; bool ok[LNR]; float mean[LNR], rstd[LNR]; int rows[LNR];
#pragma unroll
        for (int r = 0; r < LNR; ++r) { rows[r] = row0 + r * NGW; ok[r] = rows[r] < M; if (!ok[r]) rows[r] = row0; }
#pragma unroll
        for (int r = 0; r < LNR; ++r) { const int row = rows[r]; const float* x = row < MP ? p.x_prompt + (size_t)row * D : p.x_sample + (size_t)(row - MP) * D;
#pragma unroll
            for (int j2 = 0; j2 < 2; ++j2) { const f32x4 a = *(const f32x4*)(x + 512 * j2 + 8 * lane), b = *(const f32x4*)(x + 512 * j2 + 8 * lane + 4);
#pragma unroll
                for (int k = 0; k < 4; ++k) { v[r][8 * j2 + k] = a[k]; v[r][8 * j2 + 4 + k] = b[k]; } } }
#pragma unroll
        for (int r = 0; r < LNR; ++r) if (ok[r]) { u16* dst = rows[r] < MP ? ZH : XR;
#pragma unroll
            for (int j2 = 0; j2 < 2; ++j2) *(u32x4*)(dst + (size_t)rows[r] * D + 512 * j2 + 8 * lane) = pack8(v[r] + 8 * j2); }
        ln_stats<LNR>(v, mean, rstd);
#pragma unroll
        for (int r = 0; r < LNR; ++r) if (ok[r]) { const int row = rows[r]; const bool smp = row >= MP; const int bidx = smp ? NB + ((row - MP) >> 2) : (row >> 12);
            const float* sh = modl + (size_t)bidx * 3072; const float* sc = sh + 1024;
            if (!smp && lane == 0) RC0[row] = (f32x4){rstd[r], 0.f, rstd[r], rstd[r] * mean[r]};
#pragma unroll
            for (int j2 = 0; j2 < 2; ++j2) { float o[8];
#pragma unroll
                for (int h = 0; h < 2; ++h) { const f32x4 a = *(const f32x4*)(sc + 512 * j2 + 8 * lane + 4 * h), bb = *(const f32x4*)(sh + 512 * j2 + 8 * lane + 4 * h);
#pragma unroll
                    for (int k = 0; k < 4; ++k) o[4 * h + k] = smp ? v[r][8 * j2 + 4 * h + k] * rstd[r] * (1.f + a[k]) + bb[k] : (v[r][8 * j2 + 4 * h + k] + mean[r]) * (1.f + a[k]); }
                *(u32x4*)(ZP + (size_t)row * D + 512 * j2 + 8 * lane) = pack8(o); } }
    }
}
DI void modv_unit(const Params& p, LAS unsigned char* lds, int unit, int tid, int lane, int wave) {
    const int l = unit / 40, cb = unit % 40, col = 64 * cb + lane;
    const float* W = p.w_in + (size_t)l * D * DIN + col; const float* modl = (const float*)(p.ws + WS_MOD) + (size_t)l * NMOD * 3072;
    LAS float* part = (LAS float*)lds;
    LAS float* cf = (LAS float*)(lds + 32768) + wave * 128 * 12;
    __syncthreads();
#pragma unroll
    for (int hlf = 0; hlf < 2; ++hlf) { const int ci = 64 * hlf + lane, c = wave * 128 + ci; LAS float* o = cf + ci * 12;
        o[0] = l > 0 ? p.ln_g[(l - 1) * D + c] : 1.f; o[1] = l > 0 ? p.ln_b[(l - 1) * D + c] : 0.f;
#pragma unroll
        for (int b = 0; b < 4; ++b) { o[2 + b] = 1.f + modl[b * 3072 + 1024 + c]; o[6 + b] = modl[b * 3072 + c]; } }
    asm volatile("s_waitcnt lgkmcnt(0)" ::: "memory");
    float acc[4][4];
#pragma unroll
    for (int b = 0; b < 4; ++b)
#pragma unroll
        for (int k = 0; k < 4; ++k) acc[b][k] = 0.f;
#pragma unroll 1
    for (int c0 = 0; c0 < 128; c0 += 32) { float wv[32];
#pragma unroll
        for (int i = 0; i < 32; ++i) wv[i] = W[(size_t)(wave * 128 + c0 + i) * DIN];
#pragma unroll
        for (int i = 0; i < 32; ++i) { const LAS f32x4* cp = (const LAS f32x4*)(cf + (c0 + i) * 12); const f32x4 q0 = cp[0], q1 = cp[1], q2 = cp[2];
            const float g = q0[0], bb = q0[1]; const float s1[4] = {q0[2], q0[3], q1[0], q1[1]}; const float sh[4] = {q1[2], q1[3], q2[0], q2[1]};
#pragma unroll
            for (int b = 0; b < 4; ++b) { const float sw = s1[b] * wv[i]; acc[b][0] += g * sw; acc[b][1] += bb * sw; acc[b][2] += sw; acc[b][3] += sh[b] * wv[i]; } } }
#pragma unroll
    for (int b = 0; b < 4; ++b)
#pragma unroll
        for (int k = 0; k < 4; ++k) part[(wave * 16 + b * 4 + k) * 64 + lane] = acc[b][k];
    __syncthreads();
    float* MODV = (float*)(p.ws + WS_MODV);
    for (int o = tid; o < 1024; o += NTHR) { const int idx = o >> 6, ln = o & 63; float sum = 0.f;
#pragma unroll
        for (int w = 0; w < 8; ++w) sum += part[(w * 16 + idx) * 64 + ln];
        MODV[((size_t)(l * NB + (idx >> 2)) * 4 + (idx & 3)) * DIN + perm_in(64 * cb + ln)] = sum; }
    __syncthreads();
}
DI void finalize_rc_in(const Params& p, int l, const int (&pms)[3], LAS float* rcl, int tid) {
    const int row = tid & 255;
    const int ua = tid >> 8, ub = 2;
    const bool hasA = pms[ua] >= 0 && pms[ua] < MP / 256, hasB = tid < 256 && pms[2] >= 0 && pms[2] < MP / 256;
    f32x4 ldA[6], ldB[6];
    const size_t rA = (size_t)(hasA ? pms[ua] : 0) * 256 + row, rB = (size_t)(hasB ? pms[2] : 0) * 256 + row;
    if (l == 0) { ldA[0] = ((const f32x4*)(p.ws + WS_RC0))[rA]; ldB[0] = ((const f32x4*)(p.ws + WS_RC0))[rB]; }
    else { const f32x4* psA = (const f32x4*)((const float*)(p.ws + WS_PS) + (size_t)((l - 1) & 1) * MP * 24 + rA * 24); const f32x4* psB = (const f32x4*)((const float*)(p.ws + WS_PS) + (size_t)((l - 1) & 1) * MP * 24 + rB * 24);
#pragma unroll
        for (int k = 0; k < 6; ++k) { ldA[k] = psA[k]; ldB[k] = psB[k]; } }
    auto fin = [&](const f32x4 (&ld)[6]) -> f32x4 {
        if (l == 0) return ld[0];
        const float* lnc = (const float*)(p.ws + WS_LNC) + (l - 1) * 8;
        float f[24];
#pragma unroll
        for (int k = 0; k < 6; ++k) { f[4 * k] = ld[k][0]; f[4 * k + 1] = ld[k][1]; f[4 * k + 2] = ld[k][2]; f[4 * k + 3] = ld[k][3]; }
        float S[6];
#pragma unroll
        for (int k = 0; k < 6; ++k) S[k] = (f[k] + f[6 + k]) + (f[12 + k] + f[18 + k]);
        float N1 = 1.f / D, two = 2.f; asm volatile("" : "+v"(N1), "+v"(two));
        const float mu = S[0] * N1, rstd = 1.f / sqrtf(S[1] * N1 - mu * mu + LN_EPS);
        const float m2 = (rstd * (S[2] - mu * lnc[0]) + lnc[3]) * N1;
        const float e2 = (rstd * rstd * (S[3] - two * mu * S[4] + mu * mu * lnc[1]) + two * rstd * (S[5] - mu * lnc[2]) + lnc[4]) * N1;
        const float rstd2 = 1.f / sqrtf(e2 - m2 * m2 + LN_EPS);
        return (f32x4){rstd * rstd2, rstd * rstd2 * mu, rstd2, rstd2 * m2}; };
    if (hasA) *(LAS f32x4*)(rcl + ua * 1024 + 4 * row) = fin(ldA);
    if (hasB) *(LAS f32x4*)(rcl + ub * 1024 + 4 * row) = fin(ldB);
}
DI void fin_phase(const Params& p, int gw, int NGW, int lane) {
    const u16* ZH = (const u16*)(p.ws + WS_ZH);
    const float* lg = p.ln_g + (size_t)(DEPTH - 1) * D; const float* lb = p.ln_b + (size_t)(DEPTH - 1) * D;
    for (int row0 = gw; row0 < MP; row0 += LNR * NGW) {
        float v[LNR][16]; bool ok[LNR]; float mean[LNR], rstd[LNR]; int rows[LNR];
#pragma unroll
        for (int r = 0; r < LNR; ++r) { rows[r] = row0 + r * NGW; ok[r] = rows[r] < MP; if (!ok[r]) rows[r] = row0; }
#pragma unroll
        for (int r = 0; r < LNR; ++r)
#pragma unroll
            for (int j2 = 0; j2 < 2; ++j2) unpack8(*(const u32x4*)(ZH + (size_t)rows[r] * D + 512 * j2 + 8 * lane), v[r] + 8 * j2);
        ln_stats<LNR>(v, mean, rstd);
#pragma unroll
        for (int j2 = 0; j2 < 2; ++j2)
#pragma unroll
            for (int h = 0; h < 2; ++h) { const f32x4 g = *(const f32x4*)(lg + 512 * j2 + 8 * lane + 4 * h), bb = *(const f32x4*)(lb + 512 * j2 + 8 * lane + 4 * h);
#pragma unroll
                for (int r = 0; r < LNR; ++r) if (ok[r]) { f32x4 o;
#pragma unroll
                    for (int k = 0; k < 4; ++k) o[k] = v[r][8 * j2 + 4 * h + k] * rstd[r] * g[k] + bb[k];
                    *(f32x4*)(p.out + (size_t)rows[r] * D + 512 * j2 + 8 * lane + 4 * h) = o; } }
    }
}

struct MixPtrs { const u16 *PA, *PSZC, *PPV, *PSZP, *PQ, *PSZA, *PK, *PV; u16* MIX; };
DI v4i16_t ds_tr(const LAS unsigned char* a) { return __builtin_amdgcn_ds_read_tr16_b64_v4i16((LAS v4i16_t*)a); }

DI void attn_prompt_unit(const Params& p, const MixPtrs& X, int l, int unit, LAS unsigned char* lds, int tid, int lane, int wave) {
    const int xg = unit >> 5, b = xg >> 1, hk = (unit >> 4) & 1, nb = (xg & 1) * 16 + (unit & 15), q0 = nb * 128; const size_t rb = (size_t)b * SEQ;
    LAS unsigned char* Ks = lds; LAS unsigned char* Vs = lds + 36864;
    const int g = wave & 3, qh = wave >> 2, head = 4 * hk + g, r = lane & 31, h = lane >> 5;
    u32x4 kvr[4], vvr[4];
#pragma unroll
    for (int i = 0; i < 4; ++i) { const int c = tid + 512 * i, key = c >> 3, ch = c & 7, tk = q0 - 128 + key, tkc = tk < 0 ? 0 : tk;
        kvr[i] = *(const u32x4*)(X.PK + (rb + tkc) * 128 + hk * 64 + ch * 8); vvr[i] = *(const u32x4*)(X.PV + (rb + tkc) * 128 + hk * 64 + ch * 8); }
    h8 qfA[4], qfB[4]; u32x2 zgA[2][4], zgB[2][4];
    { const size_t qr0 = rb + q0 + 64 * qh + r, qr1 = qr0 + 32;
#pragma unroll
      for (int s = 0; s < 4; ++s) { qfA[s] = *(const h8*)(X.PQ + qr0 * 512 + head * 64 + 16 * s + 8 * h); qfB[s] = *(const h8*)(X.PQ + qr1 * 512 + head * 64 + 16 * s + 8 * h); }
#pragma unroll
      for (int db = 0; db < 2; ++db)
#pragma unroll
          for (int xq = 0; xq < 4; ++xq) { const int col = head * 64 + 32 * db + 8 * xq + 4 * h; zgA[db][xq] = *(const u32x2*)(X.PSZA + qr0 * 512 + col); zgB[db][xq] = *(const u32x2*)(X.PSZA + qr1 * 512 + col); } }
#pragma unroll
    for (int i = 0; i < 4; ++i) { const int c = tid + 512 * i, key = c >> 3, ch = c & 7;
        *(LAS u32x4*)(Ks + key * 144 + ch * 16) = kvr[i]; *(LAS u32x4*)(Vs + (ch >> 2) * 16384 + key * 64 + (ch & 3) * 16) = vvr[i]; }
    __syncthreads();
    const float sink2 = p.sinks[l * 8 + head] * LOG2E;
    const int trq = (lane & 15) >> 2, trp = lane & 3, trg = (lane >> 4) & 1;
    const float NEG = -INFINITY;
    auto half = [&](const h8 (&qf)[4], const u32x2 (&zg)[2][4], const int e) {
        const int ql = 64 * qh + 32 * e; const size_t qrow = rb + q0 + ql + r;
        f32x16 S[5];
#pragma unroll
        for (int i = 0; i < 5; ++i) { const int kl = ql + 32 * i; const bool valid = (nb > 0) || (kl >= 128);
#pragma unroll
            for (int x = 0; x < 16; ++x) S[i][x] = 0.f;
            if (valid) {
#pragma unroll
                for (int s = 0; s < 4; ++s) { const h8 kf = *(const LAS h8*)(Ks + (kl + r) * 144 + (16 * s + 8 * h) * 2); S[i] = __builtin_amdgcn_mfma_f32_32x32x16_f16(kf, qf[s], S[i], 0, 0, 0); }
            } else {
#pragma unroll
                for (int x = 0; x < 16; ++x) S[i][x] = NEG; }
            if (i == 0) {
#pragma unroll
                for (int x = 0; x < 16; ++x) if (!(crow(x, h) > r)) S[i][x] = NEG; }
            if (i == 4) {
#pragma unroll
                for (int x = 0; x < 16; ++x) if (!(crow(x, h) <= r)) S[i][x] = NEG; }
        }
        float mx = sink2;
#pragma unroll
        for (int i = 0; i < 5; ++i)
#pragma unroll
            for (int x = 0; x < 16; ++x) mx = fmaxf(mx, S[i][x]);
        mx = max_halves(mx);
        float sum = 0.f;
#pragma unroll
        for (int i = 0; i < 5; ++i)
#pragma unroll
            for (int x = 0; x < 16; ++x) { S[i][x] = ex2(S[i][x] - mx); sum += S[i][x]; }
        sum = sum_halves(sum);
        const float inv = 1.f / (sum + ex2(sink2 - mx));
        f32x16 O[2];
#pragma unroll
        for (int x = 0; x < 16; ++x) { O[0][x] = 0.f; O[1][x] = 0.f; }
#pragma unroll
        for (int i = 0; i < 5; ++i) { const int kl = ql + 32 * i; const bool valid = (nb > 0) || (kl >= 128);
            if (valid) {
#pragma unroll
                for (int s2 = 0; s2 < 2; ++s2) { float pv8[8];
#pragma unroll
                    for (int j = 0; j < 8; ++j) pv8[j] = S[i][8 * s2 + j] * inv;
                    const h8 pa = __builtin_bit_cast(h8, pack8(pv8));
#pragma unroll
                    for (int db = 0; db < 2; ++db) { const LAS unsigned char* va = Vs + db * 16384 + (kl + 16 * s2 + 4 * h + trq) * 64 + trg * 32 + trp * 8;
                        const v4i16_t lo = ds_tr(va), hi = ds_tr(va + 512);
                        const h8 vf = __builtin_bit_cast(h8, __builtin_shufflevector(lo, hi, 0, 1, 2, 3, 4, 5, 6, 7));
                        O[db] = __builtin_amdgcn_mfma_f32_32x32x16_f16(vf, pa, O[db], 0, 0, 0); } } } }
#pragma unroll
        for (int db = 0; db < 2; ++db)
#pragma unroll
            for (int xq = 0; xq < 4; ++xq) { const int col = head * 64 + 32 * db + 8 * xq + 4 * h; const h4 z = __builtin_bit_cast(h4, zg[db][xq]);
                u32x2 w; w.x = pkh(O[db][4 * xq] * (float)z[0], O[db][4 * xq + 1] * (float)z[1]); w.y = pkh(O[db][4 * xq + 2] * (float)z[2], O[db][4 * xq + 3] * (float)z[3]);
                *(u32x2*)(X.MIX + qrow * D + 512 + col) = w; }
    };
    half(qfA, zgA, 0);
    half(qfB, zgB, 1);
    __syncthreads();
}

DI void conv_prompt_unit(const Params& p, const MixPtrs& X, int l, int unit, LAS unsigned char* lds, int tid, int lane, int wave) {
    const int R0 = unit * 64, b = R0 >> 12, t0 = R0 & (SEQ - 1); const size_t rb = (size_t)b * SEQ;
    LAS unsigned char* WL = lds + 94 * 512;
    u32x4 tv[6]; f32x4 wq[4];
#pragma unroll
    for (int i = 0; i < 6; ++i) { const int c = tid + 512 * i, cc = c < 94 * 32 ? c : 94 * 32 - 1, row = cc >> 5, ch = cc & 31, tk = t0 - 30 + row, tkc = tk < 0 ? 0 : tk;
        tv[i] = *(const u32x4*)(X.PA + (rb + tkc) * 256 + ch * 8); }
#pragma unroll
    for (int i = 0; i < 4; ++i) { const int c = tid + 512 * i, cc = c < 31 * 64 ? c : 31 * 64 - 1; wq[i] = *(const f32x4*)(p.conv_w + (size_t)l * 31 * 256 + 4 * cc); }
    const f32x4 bias = *(const f32x4*)(p.conv_b + l * 256 + 4 * lane), cg = *(const f32x4*)(p.cnorm_g + l * 256 + 4 * lane), cb = *(const f32x4*)(p.cnorm_b + l * 256 + 4 * lane);
    u32x2 zcv[8];
#pragma unroll
    for (int tt = 0; tt < 8; ++tt) zcv[tt] = *(const u32x2*)(X.PSZC + ((size_t)R0 + 8 * wave + tt) * 256 + 4 * lane);
#pragma unroll
    for (int i = 0; i < 6; ++i) { const int c = tid + 512 * i, row = c >> 5, ch = c & 31; const unsigned msk = (unsigned)-(int)(t0 - 30 + row >= 0);
        if (c < 94 * 32) *(LAS u32x4*)(lds + row * 512 + ch * 16) = (u32x4){tv[i][0] & msk, tv[i][1] & msk, tv[i][2] & msk, tv[i][3] & msk}; }
#pragma unroll
    for (int i = 0; i < 4; ++i) { const int c = tid + 512 * i; if (c < 31 * 64) *(LAS f32x4*)(WL + c * 16) = wq[i]; }
    __syncthreads();
    f32x4 acc[8], win[8];
#pragma unroll
    for (int tt = 0; tt < 8; ++tt) acc[tt] = bias;
    const LAS unsigned char* arow = lds + (8 * wave) * 512 + lane * 8;
#pragma unroll
    for (int k = 0; k < 7; ++k) win[k] = __builtin_convertvector(*(const LAS h4*)(arow + k * 512), f32x4);
#pragma unroll 1
    for (int jb = 0; jb < 4; ++jb) {
#pragma unroll
        for (int jj = 0; jj < 8; ++jj) { const int j = 8 * jb + jj;
            if (j < 31) {
                win[(jj + 7) & 7] = __builtin_convertvector(*(const LAS h4*)(arow + (j + 7) * 512), f32x4);
                const f32x4 w = *(const LAS f32x4*)(WL + j * 1024 + lane * 16);
#pragma unroll
                for (int tt = 0; tt < 8; ++tt) acc[tt] += w * win[(jj + tt) & 7]; } } }
#pragma unroll
    for (int tt = 0; tt < 8; ++tt) { const size_t row = (size_t)R0 + 8 * wave + tt;
        const float mean = wave_sum((acc[tt][0] + acc[tt][1]) + (acc[tt][2] + acc[tt][3])) * (1.f / 256.f);
        const f32x4 d = acc[tt] - mean;
        const float rstd = 1.f / sqrtf(wave_sum((d[0] * d[0] + d[1] * d[1]) + (d[2] * d[2] + d[3] * d[3])) * (1.f / 256.f) + LN_EPS);
        const h4 zc = __builtin_bit_cast(h4, zcv[tt]); float o[4];
#pragma unroll
        for (int k = 0; k < 4; ++k) o[k] = silu(d[k] * rstd * cg[k] + cb[k]) * (float)zc[k];
        u32x2 w; w.x = pkh(o[0], o[1]); w.y = pkh(o[2], o[3]);
        *(u32x2*)(X.MIX + row * D + 4 * lane) = w; }
    __syncthreads();
}

DI void pool_prompt_unit(const Params& p, const MixPtrs& X, int l, int unit, LAS unsigned char* lds, int tid, int lane, int wave) {
    const int R0 = unit * 64, b = R0 >> 12, t0 = R0 & (SEQ - 1); const size_t rb = (size_t)b * SEQ;
    LAS unsigned char* PL = lds + 79 * 512;
    for (int c = tid; c < 79 * 32; c += NTHR) { const int row = c >> 5, ch = c & 31, tk = t0 - 15 + row; u32x4 v = (u32x4){0u, 0u, 0u, 0u};
        if (tk >= 0) v = *(const u32x4*)(X.PPV + (rb + tk) * 256 + ch * 8);
        *(LAS u32x4*)(lds + row * 512 + ch * 16) = v; }
    __syncthreads();
    { const int wlen = 2 << (lane >> 4);
        const LAS unsigned char* prow = lds + (8 * wave + 15) * 512 + lane * 8;
        f32x4 sm[8];
#pragma unroll
        for (int tt = 0; tt < 8; ++tt) sm[tt] = (f32x4){0.f, 0.f, 0.f, 0.f};
#pragma unroll 1
        for (int i = 0; i < 16; ++i) { if (i < wlen) {
#pragma unroll
            for (int tt = 0; tt < 8; ++tt) sm[tt] += __builtin_convertvector(*(const LAS h4*)(prow + (tt - i) * 512), f32x4); } }
#pragma unroll
        for (int tt = 0; tt < 8; ++tt) {
            const int t = t0 + 8 * wave + tt; const float cnt = (float)(wlen < t + 1 ? wlen : t + 1);
            const f32x4 cur = __builtin_convertvector(*(const LAS h4*)(prow + tt * 512), f32x4);
            const f32x4 pl = sm[tt] * (1.f / cnt) - cur;
            u32x2 w; w.x = pkh(pl[0], pl[1]); w.y = pkh(pl[2], pl[3]);
            *(LAS u32x2*)(PL + (8 * wave + tt) * 528 + lane * 8) = w; } }
    __syncthreads();
    { const int g = wave & 3, th = wave >> 2, r = lane & 31, h = lane >> 5;
        const float* pw = p.pool_w + ((size_t)l * 4 + g) * 64 * 64 + r;
        f32x16 Dd[2];
#pragma unroll
        for (int x = 0; x < 16; ++x) { Dd[0][x] = 0.f; Dd[1][x] = 0.f; }
#pragma unroll 1
        for (int s = 0; s < 4; ++s) { const h8 bf = *(const LAS h8*)(PL + (32 * th + r) * 528 + (64 * g + 16 * s + 8 * h) * 2);
#pragma unroll
            for (int nb = 0; nb < 2; ++nb) { h8 af;
#pragma unroll
                for (int j = 0; j < 8; ++j) af[j] = (_Float16)pw[(size_t)(16 * s + 8 * h + j) * 64 + 32 * nb];
                Dd[nb] = __builtin_amdgcn_mfma_f32_32x32x16_f16(af, bf, Dd[nb], 0, 0, 0); } }
        const size_t row = (size_t)R0 + 32 * th + r;
#pragma unroll
        for (int nb = 0; nb < 2; ++nb)
#pragma unroll
            for (int xq = 0; xq < 4; ++xq) { const int col = 64 * g + 32 * nb + 8 * xq + 4 * h;
                const f32x4 ps = *(const f32x4*)(p.pool_scale + l * 256 + col); const h4 z = *(const h4*)(X.PSZP + row * 256 + col);
                u32x2 w; w.x = pkh(Dd[nb][4 * xq] * ps[0] * (float)z[0], Dd[nb][4 * xq + 1] * ps[1] * (float)z[1]); w.y = pkh(Dd[nb][4 * xq + 2] * ps[2] * (float)z[2], Dd[nb][4 * xq + 3] * ps[3] * (float)z[3]);
                *(u32x2*)(X.MIX + row * D + 256 + col) = w; } }
    __syncthreads();
}


constexpr int MX_WCV = 0;
constexpr int MX_WPT = 81920;
constexpr int MX_SCR = 0, MX_SCR_W = 7168;
constexpr int MX_TQ = RING_BYTES + 640;
DI void mix_stage_weights(const Params& p, int l, LAS unsigned char* lds, int tid) {
    for (int c = tid; c < 31 * 64; c += NTHR) *(LAS f32x4*)(lds + MX_WCV + c * 16) = *(const f32x4*)(p.conv_w + (size_t)l * 31 * 256 + 4 * c);
    for (int e = tid; e < 4 * 64 * 64; e += NTHR) { const int g = e >> 12, c = (e >> 6) & 63, n = e & 63;
        *(LAS _Float16*)(lds + MX_WPT + ((g * 64 + n) * 72 + c) * 2) = (_Float16)p.pool_w[(size_t)l * 16384 + e]; }
    if (tid == 0) *(LAS unsigned*)(lds + MX_TQ) = 0u;
}
DI void task_attn(const Params& p, int l, int b, int hk, int g, int tq0, int lane) {
    const int head = 4 * hk + g, r = lane & 31, h = lane >> 5; const size_t rb = (size_t)b * SEQ; const size_t qrow = rb + tq0 + r;
    const float sink2 = p.sinks[l * 8 + head] * LOG2E; const float NEG = -INFINITY;
    const u16* PQ = (const u16*)(p.ws + WS_PQ); const u16* PK = (const u16*)(p.ws + WS_PK);
    f32x16 S[5];
    {   h8 qf[4];
#pragma unroll
        for (int s = 0; s < 4; ++s) qf[s] = *(const h8*)(PQ + qrow * 512 + head * 64 + 16 * s + 8 * h);
        h8 kf[5][4];
#pragma unroll
        for (int i = 0; i < 5; ++i) { const int tk = tq0 - 128 + 32 * i, tkc = tk < 0 ? 0 : tk;
#pragma unroll
            for (int s = 0; s < 4; ++s) kf[i][s] = *(const h8*)(PK + (rb + tkc + r) * 128 + hk * 64 + 16 * s + 8 * h); }
#pragma unroll
        for (int i = 0; i < 5; ++i) { const int tk = tq0 - 128 + 32 * i;
#pragma unroll
            for (int x = 0; x < 16; ++x) S[i][x] = 0.f;
#pragma unroll
            for (int s = 0; s < 4; ++s) S[i] = __builtin_amdgcn_mfma_f32_32x32x16_f16(kf[i][s], qf[s], S[i], 0, 0, 0);
#pragma unroll
            for (int x = 0; x < 16; ++x) S[i][x] = tk >= 0 ? S[i][x] : NEG; } }
#pragma unroll
    for (int x = 0; x < 16; ++x) { if (!(crow(x, h) > r)) S[0][x] = NEG; if (!(crow(x, h) <= r)) S[4][x] = NEG; }
    float mx = sink2;
#pragma unroll
    for (int i = 0; i < 5; ++i)
#pragma unroll
        for (int x = 0; x < 16; ++x) mx = fmaxf(mx, S[i][x]);
    mx = max_halves(mx);
    float sum = 0.f;
#pragma unroll
    for (int i = 0; i < 5; ++i)
#pragma unroll
        for (int x = 0; x < 16; ++x) { S[i][x] = ex2(S[i][x] - mx); sum += S[i][x]; }
    sum = sum_halves(sum);
    const float inv = 1.f / (sum + ex2(sink2 - mx));
    u32x4 pa[5][2];
#pragma unroll
    for (int i = 0; i < 5; ++i)
#pragma unroll
        for (int s2 = 0; s2 < 2; ++s2) { float pv8[8];
#pragma unroll
            for (int j = 0; j < 8; ++j) pv8[j] = S[i][8 * s2 + j] * inv;
            pa[i][s2] = pack8(pv8); }
    int voff = ((b * 2 + hk) * 64 + r) * SEQ + (tq0 - 128) + 4 * h;
    asm volatile("" : "+v"(voff) : "v"(pa[0][0]), "v"(pa[0][1]), "v"(pa[1][0]), "v"(pa[1][1]), "v"(pa[2][0]), "v"(pa[2][1]), "v"(pa[3][0]), "v"(pa[3][1]), "v"(pa[4][0]), "v"(pa[4][1]));
    const u16* vtb = (const u16*)(p.ws + WS_VT) + voff;
    u32x2 vlo[5][2][2], vhi[5][2][2];
#pragma unroll
    for (int i = 0; i < 5; ++i) { const int tk = tq0 - 128 + 32 * i; const int adj = tk < 0 ? -tk : 0;
#pragma unroll
        for (int s2 = 0; s2 < 2; ++s2)
#pragma unroll
            for (int db = 0; db < 2; ++db) { const u16* vp = vtb + (size_t)db * 32 * SEQ + 32 * i + 16 * s2 + adj; vlo[i][s2][db] = *(const u32x2*)vp; vhi[i][s2][db] = *(const u32x2*)(vp + 8); } }
    f32x16 O[2];
#pragma unroll
    for (int x = 0; x < 16; ++x) { O[0][x] = 0.f; O[1][x] = 0.f; }
#pragma unroll
    for (int i = 0; i < 5; ++i)
#pragma unroll
        for (int s2 = 0; s2 < 2; ++s2)
#pragma unroll
            for (int db = 0; db < 2; ++db) { const u32x4 vv = {vlo[i][s2][db][0], vlo[i][s2][db][1], vhi[i][s2][db][0], vhi[i][s2][db][1]};
                O[db] = __builtin_amdgcn_mfma_f32_32x32x16_f16(__builtin_bit_cast(h8, vv), __builtin_bit_cast(h8, pa[i][s2]), O[db], 0, 0, 0); }
    const u16* PSZA = (const u16*)(p.ws + WS_PSZA); u16* MIX = (u16*)(p.ws + WS_MIX);
    u32x2 zg[2][4];
#pragma unroll
    for (int db = 0; db < 2; ++db)
#pragma unroll
        for (int xq = 0; xq < 4; ++xq) zg[db][xq] = *(const u32x2*)(PSZA + qrow * 512 + head * 64 + 32 * db + 8 * xq + 4 * h);
#pragma unroll
    for (int db = 0; db < 2; ++db)
#pragma unroll
        for (int xq = 0; xq < 4; ++xq) { const int col = head * 64 + 32 * db + 8 * xq + 4 * h; const h4 z = __builtin_bit_cast(h4, zg[db][xq]);
            u32x2 w; w.x = pkh(O[db][4 * xq] * (float)z[0], O[db][4 * xq + 1] * (float)z[1]); w.y = pkh(O[db][4 * xq + 2] * (float)z[2], O[db][4 * xq + 3] * (float)z[3]);
            *(u32x2*)(MIX + qrow * D + 512 + col) = w; }
}
constexpr int MX_X = 68608;
DI void conv_tile_dma(const Params& p, int R0, LAS unsigned char* lds, int wave, int lane) {
    const int b = R0 >> 12, t0 = R0 & (SEQ - 1);
    const unsigned char* PA = p.ws + WS_PA;
#pragma unroll
    for (int i = 0; i < 6; ++i) { const int piece = wave + 8 * i;
        if (piece < 47) { const int row = 2 * piece + (lane >> 5); int tk = t0 - 30 + row; tk = tk < 0 ? 0 : tk;
            __builtin_amdgcn_global_load_lds((const unsigned*)(PA + ((size_t)b * SEQ + tk) * 512 + (lane & 31) * 16), (LAS unsigned*)(lds + MX_X + piece * 1024), 16, 0, 0); } }
}
DI void task_conv(const Params& p, int l, int R0, int sub, LAS unsigned char* lds, int lane) {
    const int t0 = (R0 & (SEQ - 1)) + 8 * sub; const size_t rowb = (size_t)R0 + 8 * sub;
    const f32x4 bias = *(const f32x4*)(p.conv_b + l * 256 + 4 * lane), cg = *(const f32x4*)(p.cnorm_g + l * 256 + 4 * lane), cb = *(const f32x4*)(p.cnorm_b + l * 256 + 4 * lane);
    const LAS unsigned char* arow = lds + MX_X + (8 * sub) * 512 + lane * 8;
    const LAS unsigned char* wl = lds + MX_WCV + lane * 16;
    f32x4 acc[8], win[8];
#pragma unroll
    for (int tt = 0; tt < 8; ++tt) acc[tt] = bias;
#pragma unroll
    for (int k = 0; k < 7; ++k) { const f32x4 v = __builtin_convertvector(*(const LAS h4*)(arow + k * 512), f32x4); win[k] = (t0 - 30 + k >= 0) ? v : (f32x4){0.f, 0.f, 0.f, 0.f}; }
#pragma unroll 1
    for (int jb = 0; jb < 4; ++jb) {
#pragma unroll
        for (int jj = 0; jj < 8; ++jj) { const int j = 8 * jb + jj;
            if (j < 31) {
                const f32x4 v = __builtin_convertvector(*(const LAS h4*)(arow + (j + 7) * 512), f32x4);
                win[(jj + 7) & 7] = (t0 - 30 + j + 7 >= 0) ? v : (f32x4){0.f, 0.f, 0.f, 0.f};
                const f32x4 w = *(const LAS f32x4*)(wl + j * 1024);
#pragma unroll
                for (int tt = 0; tt < 8; ++tt) acc[tt] += w * win[(jj + tt) & 7]; } } }
    const u16* PSZC = (const u16*)(p.ws + WS_PSZC); u16* MIX = (u16*)(p.ws + WS_MIX);
#pragma unroll
    for (int tt = 0; tt < 8; ++tt) { const size_t row = rowb + tt;
        const float mean = wave_sum((acc[tt][0] + acc[tt][1]) + (acc[tt][2] + acc[tt][3])) * (1.f / 256.f);
        const f32x4 d = acc[tt] - mean;
        const float rstd = 1.f / sqrtf(wave_sum((d[0] * d[0] + d[1] * d[1]) + (d[2] * d[2] + d[3] * d[3])) * (1.f / 256.f) + LN_EPS);
        const h4 z = *(const h4*)(PSZC + row * 256 + 4 * lane); float o[4];
#pragma unroll
        for (int k = 0; k < 4; ++k) o[k] = silu(d[k] * rstd * cg[k] + cb[k]) * (float)z[k];
        u32x2 w; w.x = pkh(o[0], o[1]); w.y = pkh(o[2], o[3]);
        *(u32x2*)(MIX + row * D + 4 * lane) = w; }
}
DI void task_pool(const Params& p, int l, int R0, int th, int g, LAS unsigned char* lds, int wave, int lane) {
    const u16* PPV = (const u16*)(p.ws + WS_PPV); const u16* PSZP = (const u16*)(p.ws + WS_PSZP); u16* MIX = (u16*)(p.ws + WS_MIX);
    const int b = R0 >> 12, T0 = (R0 & (SEQ - 1)) + 32 * th; const size_t rb = (size_t)b * SEQ;
    LAS unsigned char* scr = lds + MX_SCR + wave * MX_SCR_W;
    const int r = lane & 31, h = lane >> 5;
    u32x4 tl[6];
#pragma unroll
    for (int i = 0; i < 6; ++i) { const int row = (lane >> 3) + 8 * i, tk = T0 - 15 + row; const int tkc = tk < 0 ? 0 : (row < 47 ? tk : T0 + 31);
        const u32x4 v = *(const u32x4*)(PPV + (rb + tkc) * 256 + 64 * g + 8 * (lane & 7)); const unsigned msk = (unsigned)-(int)(tk >= 0); tl[i] = (u32x4){v[0] & msk, v[1] & msk, v[2] & msk, v[3] & msk}; }
    const size_t orow = rb + T0 + r;
    u32x2 zp[2][4]; f32x4 ps[2][4];
#pragma unroll
    for (int nb = 0; nb < 2; ++nb)
#pragma unroll
        for (int xq = 0; xq < 4; ++xq) { const int col = 64 * g + 32 * nb + 8 * xq + 4 * h; zp[nb][xq] = *(const u32x2*)(PSZP + orow * 256 + col); ps[nb][xq] = *(const f32x4*)(p.pool_scale + l * 256 + col); }
#pragma unroll
    for (int i = 0; i < 6; ++i) { const int row = (lane >> 3) + 8 * i; if (row < 47) *(LAS u32x4*)(scr + row * 144 + (lane & 7) * 16) = tl[i]; }
    asm volatile("s_waitcnt lgkmcnt(0)" ::: "memory");
    const int wlen = 2 << g; const int t = T0 + r; const float icnt = 1.f / (float)(wlen < t + 1 ? wlen : t + 1);
    h8 bf[4];
#pragma unroll
    for (int s = 0; s < 4; ++s) { const LAS unsigned char* base = scr + (15 + r) * 144 + (16 * s + 8 * h) * 2; float sm[8];
        const h8 cur = *(const LAS h8*)base;
#pragma unroll
        for (int k = 0; k < 8; ++k) sm[k] = (float)cur[k];
        for (int i = 1; i < wlen; ++i) { const h8 v = *(const LAS h8*)(base - i * 144);
#pragma unroll
            for (int k = 0; k < 8; ++k) sm[k] += (float)v[k]; }
        float pl[8];
#pragma unroll
        for (int k = 0; k < 8; ++k) pl[k] = sm[k] * icnt - (float)cur[k];
        bf[s] = __builtin_bit_cast(h8, pack8(pl)); }
    f32x16 Dd[2];
#pragma unroll
    for (int x = 0; x < 16; ++x) { Dd[0][x] = 0.f; Dd[1][x] = 0.f; }
#pragma unroll
    for (int s = 0; s < 4; ++s)
#pragma unroll
        for (int nb = 0; nb < 2; ++nb) { const h8 af = *(const LAS h8*)(lds + MX_WPT + ((g * 64 + 32 * nb + r) * 72 + 16 * s + 8 * h) * 2);
            Dd[nb] = __builtin_amdgcn_mfma_f32_32x32x16_f16(af, bf[s], Dd[nb], 0, 0, 0); }
#pragma unroll
    for (int nb = 0; nb < 2; ++nb)
#pragma unroll
        for (int xq = 0; xq < 4; ++xq) { const int col = 64 * g + 32 * nb + 8 * xq + 4 * h; const h4 z = __builtin_bit_cast(h4, zp[nb][xq]); const f32x4 sc = ps[nb][xq];
            u32x2 w; w.x = pkh(Dd[nb][4 * xq] * sc[0] * (float)z[0], Dd[nb][4 * xq + 1] * sc[1] * (float)z[1]); w.y = pkh(Dd[nb][4 * xq + 2] * sc[2] * (float)z[2], Dd[nb][4 * xq + 3] * sc[3] * (float)z[3]);
            *(u32x2*)(MIX + orow * D + 256 + col) = w; }
}
DI void mix_prompt_tasks(const Params& p, int l, int unit, LAS unsigned char* lds, int lane, int wave) {
    int one = 1; asm volatile("" : "+s"(one));
    if (one) task_attn(p, l, unit >> 6, (unit >> 5) & 1, wave & 3, (unit & 31) * 128 + 32 * (wave >> 2), lane_id());
    asm volatile("" : "+s"(one) :: "memory");
    if (one) task_attn(p, l, unit >> 6, (unit >> 5) & 1, wave & 3, (unit & 31) * 128 + 32 * (2 + (wave >> 2)), lane_id());
    asm volatile("s_waitcnt vmcnt(0) lgkmcnt(0)\n\ts_barrier" : "+s"(one) :: "memory");
    if (one) task_conv(p, l, unit * 64, wave, lds, lane_id());
    asm volatile("s_waitcnt lgkmcnt(0)\n\ts_barrier" : "+s"(one) :: "memory");
    if (one) task_pool(p, l, unit * 64, wave >> 2, wave & 3, lds, wave, lane_id());
    (void)lane;
}

DI void convpool_sample_unit(const Params& p, const MixPtrs& X, int l, int b, int part, LAS unsigned char* lds, int tid, int lane, int wave) {
    LAS float* cv = (LAS float*)lds;
    const int c = tid & 255, tp = tid >> 8; const size_t r0 = (size_t)MP + 4 * b;
    if (part == 0) {
        const float* cc = p.cache_conv + (size_t)(l * DB + b) * 30 * 256;
        float xa[34], wv[31];
        { const float* pc = cc + c;
#pragma unroll
          for (int ri = 0; ri < 30; ++ri) xa[ri] = pc[ri * 256];
          const u16* pn = X.PA + r0 * 256 + c;
#pragma unroll
          for (int ri = 0; ri < 4; ++ri) xa[30 + ri] = (float)(*(const _Float16*)(pn + ri * 256));
          const float* pw = p.conv_w + (size_t)l * 31 * 256 + c;
#pragma unroll
          for (int j = 0; j < 31; ++j) wv[j] = pw[j * 256]; }
        float a0 = p.conv_b[l * 256 + c], a1 = a0;
        if (tp == 0) {
#pragma unroll
            for (int j = 0; j < 31; ++j) { a0 += wv[j] * xa[j]; a1 += wv[j] * xa[j + 1]; }
        } else {
#pragma unroll
            for (int j = 0; j < 31; ++j) { a0 += wv[j] * xa[j + 2]; a1 += wv[j] * xa[j + 3]; } }
        cv[(2 * tp) * 256 + c] = a0; cv[(2 * tp + 1) * 256 + c] = a1;
        { float* oc = p.out + OFF_CONVS + (size_t)(l * DB + b) * 30 * 256; for (int e = tid; e < 26 * 64; e += NTHR) *(f32x4*)(oc + 4 * e) = *(const f32x4*)(cc + 4 * 256 + 4 * e); }
        __syncthreads();
        if (wave < 4) { const int t = wave; const f32x4 v = *(const LAS f32x4*)(cv + t * 256 + 4 * lane);
            const float mean = wave_sum((v[0] + v[1]) + (v[2] + v[3])) * (1.f / 256.f); const f32x4 d = v - mean;
            const float rstd = 1.f / sqrtf(wave_sum((d[0] * d[0] + d[1] * d[1]) + (d[2] * d[2] + d[3] * d[3])) * (1.f / 256.f) + LN_EPS);
            const f32x4 cg = *(const f32x4*)(p.cnorm_g + l * 256 + 4 * lane), cb = *(const f32x4*)(p.cnorm_b + l * 256 + 4 * lane);
            const h4 zc = *(const h4*)(X.PSZC + (r0 + t) * 256 + 4 * lane); float o[4];
#pragma unroll
            for (int k = 0; k < 4; ++k) o[k] = silu(d[k] * rstd * cg[k] + cb[k]) * (float)zc[k];
            u32x2 w; w.x = pkh(o[0], o[1]); w.y = pkh(o[2], o[3]);
            *(u32x2*)(X.MIX + (r0 + t) * D + 4 * lane) = w; }
    } else {
        const float* cp = p.cache_pool + (size_t)(l * DB + b) * 15 * 256;
        float xa[19];
        { const float* pc = cp + c;
#pragma unroll
          for (int ri = 0; ri < 15; ++ri) xa[ri] = pc[ri * 256];
          const u16* pn = X.PPV + r0 * 256 + c;
#pragma unroll
          for (int ri = 0; ri < 4; ++ri) xa[15 + ri] = (float)(*(const _Float16*)(pn + ri * 256)); }
        const int wlen = 2 << (c >> 6); float s0 = 0.f, s1 = 0.f, c0, c1;
        if (tp == 0) { c0 = xa[15]; c1 = xa[16];
#pragma unroll
            for (int i = 0; i < 16; ++i) if (i < wlen) { s0 += xa[15 - i]; s1 += xa[16 - i]; }
        } else { c0 = xa[17]; c1 = xa[18];
#pragma unroll
            for (int i = 0; i < 16; ++i) if (i < wlen) { s0 += xa[17 - i]; s1 += xa[18 - i]; } }
        const float iw = 1.f / (float)wlen;
        cv[(2 * tp) * 256 + c] = s0 * iw - c0; cv[(2 * tp + 1) * 256 + c] = s1 * iw - c1;
        { float* op = p.out + OFF_POOLS + (size_t)(l * DB + b) * 15 * 256; for (int e = tid; e < 11 * 64; e += NTHR) *(f32x4*)(op + 4 * e) = *(const f32x4*)(cp + 4 * 256 + 4 * e); }
        __syncthreads();
        const int g = c >> 6, n = c & 63; const float* pw = p.pool_w + ((size_t)l * 4 + g) * 64 * 64 + n; float y0 = 0.f, y1 = 0.f;
#pragma unroll 16
        for (int k = 0; k < 64; ++k) { const float w = pw[(size_t)k * 64]; y0 += cv[(2 * tp) * 256 + 64 * g + k] * w; y1 += cv[(2 * tp + 1) * 256 + 64 * g + k] * w; }
        const float ps = p.pool_scale[l * 256 + c];
        const float z0 = (float)(*(const _Float16*)(X.PSZP + (r0 + 2 * tp) * 256 + c)), z1 = (float)(*(const _Float16*)(X.PSZP + (r0 + 2 * tp + 1) * 256 + c));
        *(_Float16*)(X.MIX + (r0 + 2 * tp) * D + 256 + c) = (_Float16)(y0 * ps * z0); *(_Float16*)(X.MIX + (r0 + 2 * tp + 1) * D + 256 + c) = (_Float16)(y1 * ps * z1); }
    __syncthreads();
}

DI void attn_sample_unit(const Params& p, const MixPtrs& X, int l, int unit, LAS unsigned char* lds, int tid, int lane, int wave) {
    const int b = unit >> 1, hk = unit & 1; const size_t r0 = (size_t)MP + 4 * b;
    LAS float* EX = (LAS float*)lds;
    LAS float* OP = EX + 256;
    const float* ck = p.cache_k + ((size_t)(l * DB + b) * 128 * 2 + hk) * 64; const float* cvv = p.cache_v + ((size_t)(l * DB + b) * 128 * 2 + hk) * 64;
    float* ok = p.out + OFF_KS + ((size_t)(l * DB + b) * 128 * 2 + hk) * 64; float* ov = p.out + OFF_VS + ((size_t)(l * DB + b) * 128 * 2 + hk) * 64;
    f32x4 ckv[4], cvw[4];
#pragma unroll
    for (int i = 0; i < 4; ++i) { const int e = tid + 512 * i, j = e >> 4, d4 = (e & 15) * 4; ckv[i] = *(const f32x4*)(ck + (size_t)j * 128 + d4); cvw[i] = *(const f32x4*)(cvv + (size_t)j * 128 + d4); }
    const int fr = lane & 15, fq = lane >> 4;
    f32x4 O[4]; f32x4 Sa = {0.f, 0.f, 0.f, 0.f}, Sb = {0.f, 0.f, 0.f, 0.f};
    float vg[4][8];
    const int kA = 32 * wave + fr, kB = kA + 16;
    if (wave < 5) {
        h8 ka[2], kb[2], qf[2];
#pragma unroll
        for (int ks = 0; ks < 2; ++ks) { const int d0 = 32 * ks + 8 * fq;
            qf[ks] = *(const h8*)(X.PQ + (r0 + (fr >> 2)) * 512 + (4 * hk + (fr & 3)) * 64 + d0);
            if (wave < 4) { const f32x4 a0 = *(const f32x4*)(ck + (size_t)kA * 128 + d0), a1 = *(const f32x4*)(ck + (size_t)kA * 128 + d0 + 4), b0 = *(const f32x4*)(ck + (size_t)kB * 128 + d0), b1 = *(const f32x4*)(ck + (size_t)kB * 128 + d0 + 4);
                float t8[8] = {a0[0], a0[1], a0[2], a0[3], a1[0], a1[1], a1[2], a1[3]}; ka[ks] = __builtin_bit_cast(h8, pack8(t8));
                float u8[8] = {b0[0], b0[1], b0[2], b0[3], b1[0], b1[1], b1[2], b1[3]}; kb[ks] = __builtin_bit_cast(h8, pack8(u8));
            } else { const int rr = fr < 4 ? fr : 0; const u32x4 raw = *(const u32x4*)(X.PK + (r0 + rr) * 128 + hk * 64 + d0); ka[ks] = __builtin_bit_cast(h8, fr < 4 ? raw : (u32x4){0u, 0u, 0u, 0u}); kb[ks] = __builtin_bit_cast(h8, (u32x4){0u, 0u, 0u, 0u}); } }
#pragma unroll
        for (int dt = 0; dt < 4; ++dt)
#pragma unroll
            for (int j = 0; j < 8; ++j) { const int key = 32 * wave + (j < 4 ? 0 : 16) + 4 * fq + (j & 3); const int d = 16 * dt + fr;
                if (wave < 4) vg[dt][j] = cvv[(size_t)key * 128 + d];
                else vg[dt][j] = key < 132 ? (float)(*(const _Float16*)(X.PV + (r0 + (key - 128)) * 128 + hk * 64 + d)) : 0.f; }
#pragma unroll
        for (int ks = 0; ks < 2; ++ks) { Sa = __builtin_amdgcn_mfma_f32_16x16x32_f16(ka[ks], qf[ks], Sa, 0, 0, 0); Sb = __builtin_amdgcn_mfma_f32_16x16x32_f16(kb[ks], qf[ks], Sb, 0, 0, 0); }
        const int t = fr >> 2; float mx = -INFINITY;
#pragma unroll
        for (int i = 0; i < 4; ++i) { const int k0 = 32 * wave + 4 * fq + i, k1 = k0 + 16;
            Sa[i] = (k0 >= t + 1 && k0 <= t + 128) ? Sa[i] : -INFINITY; Sb[i] = (k1 >= t + 1 && k1 <= t + 128) ? Sb[i] : -INFINITY; mx = fmaxf(mx, fmaxf(Sa[i], Sb[i])); }
        mx = fmaxf(mx, xor_lane<16>(mx)); mx = max_halves(mx);
        if (fq == 0) EX[wave * 16 + fr] = mx;
    }
#pragma unroll
    for (int i = 0; i < 4; ++i) { const int e = tid + 512 * i, j = e >> 4, d4 = (e & 15) * 4; if (j >= 4) { *(f32x4*)(ok + (size_t)(j - 4) * 128 + d4) = ckv[i]; *(f32x4*)(ov + (size_t)(j - 4) * 128 + d4) = cvw[i]; } }
    __syncthreads();
    if (wave < 5) {
        const float sink2 = p.sinks[l * 8 + 4 * hk + (fr & 3)] * LOG2E;
        float m = sink2;
#pragma unroll
        for (int w = 0; w < 5; ++w) m = fmaxf(m, EX[w * 16 + fr]);
        float sum = 0.f;
#pragma unroll
        for (int i = 0; i < 4; ++i) { Sa[i] = ex2(Sa[i] - m); Sb[i] = ex2(Sb[i] - m); sum += Sa[i] + Sb[i]; }
        sum += xor_lane<16>(sum); sum = sum_halves(sum);
        if (fq == 0) EX[128 + wave * 16 + fr] = sum;
        float p8[8] = {Sa[0], Sa[1], Sa[2], Sa[3], Sb[0], Sb[1], Sb[2], Sb[3]}; const h8 pb = __builtin_bit_cast(h8, pack8(p8));
#pragma unroll
        for (int dt = 0; dt < 4; ++dt) { const h8 va = __builtin_bit_cast(h8, pack8(vg[dt])); O[dt] = __builtin_amdgcn_mfma_f32_16x16x32_f16(va, pb, (f32x4){0.f, 0.f, 0.f, 0.f}, 0, 0, 0);
#pragma unroll
            for (int i = 0; i < 4; ++i) OP[(wave * 64 + 16 * dt + 4 * fq + i) * 16 + fr] = O[dt][i]; }
    }
    __syncthreads();
    { const int qr = tid & 15, dg = tid >> 4, t = qr >> 2, g = qr & 3;
        const float sink2 = p.sinks[l * 8 + 4 * hk + g] * LOG2E; float m = sink2, den = 0.f, o0 = 0.f, o1 = 0.f;
#pragma unroll
        for (int w = 0; w < 5; ++w) { m = fmaxf(m, EX[w * 16 + qr]); den += EX[128 + w * 16 + qr]; o0 += OP[(w * 64 + 2 * dg) * 16 + qr]; o1 += OP[(w * 64 + 2 * dg + 1) * 16 + qr]; }
        const float inv = 1.f / (den + ex2(sink2 - m));
        const int col = (4 * hk + g) * 64 + 2 * dg;
        const h2 z = *(const h2*)(X.PSZA + (r0 + t) * 512 + col);
        *(unsigned*)(X.MIX + (r0 + t) * D + 512 + col) = pkh(o0 * inv * (float)z[0], o1 * inv * (float)z[1]); }
    __syncthreads();
}

template <int R>
DI void sample_ln_rows(const Params& p, int l, int row0, int lane) {
    const u16* ZH = (const u16*)(p.ws + WS_ZH); u16* XR = (u16*)(p.ws + WS_XR); u16* ZP = (u16*)(p.ws + WS_H);
    const float* lg = p.ln_g + (size_t)l * D; const float* lb = p.ln_b + (size_t)l * D;
    const float* modn = (const float*)(p.ws + WS_MOD) + (size_t)(l + 1) * NMOD * 3072;
    float v[R][16], mean[R], rstd[R];
#pragma unroll
    for (int r = 0; r < R; ++r)
#pragma unroll
        for (int j2 = 0; j2 < 2; ++j2) unpack8(*(const u32x4*)(ZH + (size_t)(row0 + r) * D + 512 * j2 + 8 * lane), v[r] + 8 * j2);
    ln_stats<R>(v, mean, rstd);
#pragma unroll
    for (int j2 = 0; j2 < 2; ++j2)
#pragma unroll
        for (int h = 0; h < 2; ++h) { const f32x4 g = *(const f32x4*)(lg + 512 * j2 + 8 * lane + 4 * h), bb = *(const f32x4*)(lb + 512 * j2 + 8 * lane + 4 * h);
#pragma unroll
            for (int r = 0; r < R; ++r)
#pragma unroll
                for (int k = 0; k < 4; ++k) v[r][8 * j2 + 4 * h + k] = v[r][8 * j2 + 4 * h + k] * rstd[r] * g[k] + bb[k]; }
    if (l == DEPTH - 1) {
#pragma unroll
        for (int r = 0; r < R; ++r) { float* y = p.out + OFF_YS + (size_t)(row0 - MP + r) * D;
#pragma unroll
            for (int j2 = 0; j2 < 2; ++j2)
#pragma unroll
                for (int h = 0; h < 2; ++h) *(f32x4*)(y + 512 * j2 + 8 * lane + 4 * h) = (f32x4){v[r][8 * j2 + 4 * h], v[r][8 * j2 + 4 * h + 1], v[r][8 * j2 + 4 * h + 2], v[r][8 * j2 + 4 * h + 3]}; }
    } else {
#pragma unroll
        for (int r = 0; r < R; ++r)
#pragma unroll
            for (int j2 = 0; j2 < 2; ++j2) *(u32x4*)(XR + (size_t)(row0 + r) * D + 512 * j2 + 8 * lane) = pack8(v[r] + 8 * j2);
        ln_stats<R>(v, mean, rstd);
#pragma unroll
        for (int r = 0; r < R; ++r) { const int row = row0 + r; const float* sh = modn + (size_t)(NB + ((row - MP) >> 2)) * 3072; const float* sc = sh + 1024;
#pragma unroll
            for (int j2 = 0; j2 < 2; ++j2) { float o[8];
#pragma unroll
                for (int h = 0; h < 2; ++h) { const f32x4 a = *(const f32x4*)(sc + 512 * j2 + 8 * lane + 4 * h), bb = *(const f32x4*)(sh + 512 * j2 + 8 * lane + 4 * h);
#pragma unroll
                    for (int k = 0; k < 4; ++k) o[4 * h + k] = v[r][8 * j2 + 4 * h + k] * rstd[r] * (1.f + a[k]) + bb[k]; }
                *(u32x4*)(ZP + (size_t)row * D + 512 * j2 + 8 * lane) = pack8(o); } }
    }
}
DI void outproj_sample_unit(const Params& p, int l, int unit, LAS unsigned char* lds, int tid, int lane, int wave) {
    const int rbk0 = unit >> 5, cb = unit & 31, R0 = MP + 64 * rbk0, n0 = 32 * cb, r = lane & 31, h = lane >> 5;
    const u16* MIX = (const u16*)(p.ws + WS_MIX); const u16* WT = (const u16*)(p.ws + WS_WOUT) + (size_t)l * D * D;
    const u16* bp = WT + (size_t)perm_out(n0 + r) * D + wave * 128 + 8 * h;
    const u16* ap = MIX + (size_t)(R0 + r) * D + wave * 128 + 8 * h;
    f32x16 acc[2];
#pragma unroll
    for (int x = 0; x < 16; ++x) { acc[0][x] = 0.f; acc[1][x] = 0.f; }
#pragma unroll
    for (int s = 0; s < 8; ++s) { const h8 bf = *(const h8*)(bp + 16 * s);
#pragma unroll
        for (int rb = 0; rb < 2; ++rb) { const h8 af = *(const h8*)(ap + (size_t)rb * 32 * D + 16 * s); acc[rb] = __builtin_amdgcn_mfma_f32_32x32x16_f16(af, bf, acc[rb], 0, 0, 0); } }
    LAS float* part = (LAS float*)lds;
#pragma unroll
    for (int rb = 0; rb < 2; ++rb)
#pragma unroll
        for (int x = 0; x < 16; ++x) part[(wave * 64 + 32 * rb + crow(x, h)) * 32 + r] = acc[rb][x];
    __syncthreads();
    const float* modl = (const float*)(p.ws + WS_MOD) + (size_t)l * NMOD * 3072;
#pragma unroll
    for (int q = 0; q < 4; ++q) { const int o = tid + 512 * q, row = o >> 5, col = o & 31; float sum = 0.f;
#pragma unroll
        for (int w = 0; w < 8; ++w) sum += part[(w * 64 + row) * 32 + col];
        const int grow = R0 + row, bidx = NB + ((grow - MP) >> 2);
        const float xr = (float)(*(const _Float16*)((const u16*)(p.ws + WS_XR) + (size_t)grow * D + n0 + col));
        *(_Float16*)((u16*)(p.ws + WS_ZH) + (size_t)grow * D + n0 + col) = (_Float16)(ALPHA * xr + (1.f + modl[(size_t)bidx * 3072 + 2048 + n0 + col]) * sum); }
    asm volatile("s_waitcnt vmcnt(0)" ::: "memory");
    __syncthreads();
    if (wave == 0 && lane == 0) {
        __builtin_amdgcn_fence(__ATOMIC_RELEASE, "agent"); asm volatile("s_waitcnt vmcnt(0)" ::: "memory");
        (void)__hip_atomic_fetch_add((unsigned*)(p.ws + WS_CTL) + CW_SCNT + 64 * (l * 8 + rbk0), 1u, __ATOMIC_RELAXED, __HIP_MEMORY_SCOPE_AGENT); }
}
DI void outproj_sample_finish(const Params& p, int l, int unit, int lane, int wave) {
    if (wave != 0) return;
    unsigned* cnt = (unsigned*)(p.ws + WS_CTL) + CW_SCNT + 64 * (l * 8 + (unit >> 5));
    for (unsigned sp = 0; sp < (1u << 20); ++sp) { if (__hip_atomic_load(cnt, __ATOMIC_RELAXED, __HIP_MEMORY_SCOPE_AGENT) >= 32u) break; __builtin_amdgcn_s_sleep(2); }
    __builtin_amdgcn_fence(__ATOMIC_ACQUIRE, "agent"); asm volatile("s_waitcnt vmcnt(0)" ::: "memory");
    sample_ln_rows<2>(p, l, MP + 64 * (unit >> 5) + 2 * (unit & 31), lane);
}

constexpr int N_PHASES = 3 + 3 * DEPTH;
typedef const __attribute__((address_space(4))) Params* KParams;
#define PHASE_BEGIN() const int lane_ = lane_id(); const int lane = lane_, wave = wave_s, tid = wave_s * 64 + lane_; \
    KParams kq = kp; asm volatile("" : "+s"(kq)); Params p; { const ParamsHead hh_ = *(const __attribute__((address_space(4))) ParamsHead*)kq; __builtin_memcpy(&p, &hh_, sizeof(ParamsHead)); }     const int gw = vcu * NWAVES + wave, NGW = G * NWAVES; (void)lane; (void)gw; (void)NGW
#define MIXPTRS() MixPtrs X; X.PA = (const u16*)(p.ws + WS_PA); X.PSZC = (const u16*)(p.ws + WS_PSZC); X.PPV = (const u16*)(p.ws + WS_PPV); X.PSZP = (const u16*)(p.ws + WS_PSZP); \
    X.PQ = (const u16*)(p.ws + WS_PQ); X.PSZA = (const u16*)(p.ws + WS_PSZA); X.PK = (const u16*)(p.ws + WS_PK); X.PV = (const u16*)(p.ws + WS_PV); X.MIX = (u16*)(p.ws + WS_MIX)
__global__ void __launch_bounds__(NTHR, 2) hymba_fwd(Params p_unused) {
#if defined(__HIP_DEVICE_COMPILE__)
    extern __shared__ __attribute__((aligned(16))) unsigned char lds_raw[];
    LAS unsigned char* lds = (LAS unsigned char*)lds_raw;
    volatile LAS unsigned* MISC = (volatile LAS unsigned*)(lds + MISC_OFF);
    const KParams kp = (KParams)__builtin_amdgcn_kernarg_segment_ptr();
    const int G = gridDim.x, bx = blockIdx.x, vcu = (G % 8 == 0) ? (bx % 8) * (G / 8) + bx / 8 : bx;
    const int wave_s = __builtin_amdgcn_readfirstlane((int)threadIdx.x >> 6);
    for (int u = threadIdx.x; u < (LDS_BYTES - RING_BYTES) / 4; u += NTHR) ((LAS unsigned*)(lds + RING_BYTES))[u] = 0u;
    __syncthreads();
    unsigned* ctl = (unsigned*)(kp->ws + WS_CTL);
    XcdBarrier bar; bar.bar = ctl + CW_BAR; bar.x = 0; bar.st = nullptr;
    if (MK_N_LAUNCHES == 1) bar = xcd_barrier_post(ctl + CW_BAR, MISC + 8);
    const int lo = kp->ph_lo, hi = kp->ph_hi;
#ifndef ONLY
#define ONLY -1
#endif
#ifndef ONLYMASK
#define ONLYMASK 0x3f
#endif
#define EN(t) ((ONLY < 0 || ONLY == (t)) && ((ONLYMASK >> (t)) & 1))
#define IN(k) (lo <= (k) && (k) < hi)
#define SEAM(k) do { if (MK_N_LAUNCHES == 1 && IN((k) + 1)) xcd_barrier(bar, wave_s); } while (0)
    if (EN(0) && IN(0)) { { PHASE_BEGIN(); p0_prologue(p, (const __attribute__((address_space(4))) float*)((const __attribute__((address_space(4))) char*)kq + __builtin_offsetof(Params, inv_freq)), lds, vcu, G, tid, lane, wave); } SEAM(0); }
    if (EN(1) && IN(1)) { { PHASE_BEGIN(); for (int u = vcu; u < DEPTH * 40; u += G) modv_unit(p, lds, u, tid, lane, wave); pre_phase(p, gw, NGW, lane); } SEAM(1); }
#pragma unroll 1
    for (int l = 0; l < DEPTH; ++l) {
        const int ph = 2 + 3 * l;
        if (EN(2) && IN(ph)) {
            { PHASE_BEGIN();
            pg8::Gemm g{(const u16*)(p.ws + WS_H), (const u16*)(p.ws + WS_WIN) + (size_t)l * DIN * D, M, DIN, D};
            pg8::StaticOrder S; S.init(M, DIN, G, bx);
            LAS float* rcl = (LAS float*)(lds + RING_BYTES + 1024);
            { int pms[3]; for (int i = 0; i < 3; ++i) { pg8::Unit u; pms[i] = S.next(i, u) ? u.pm : -1; } finalize_rc_in(p, l, pms, rcl, tid); }
            asm volatile("s_waitcnt lgkmcnt(0)" ::: "memory"); __syncthreads();
            EpiIn E{l, p.ws, p.out, rcl};
            pg8::gemm_phase<EpiIn, true>(lds, g, S, E, tid); }
            SEAM(ph);
        }
        if (EN(3) && IN(ph + 1)) {
            { PHASE_BEGIN(); MIXPTRS(); for (int u = vcu; u < 256; u += G) attn_prompt_unit(p, X, l, u, lds, tid, lane, wave); }
            { PHASE_BEGIN(); MIXPTRS(); for (int u = vcu; u < 256; u += G) conv_prompt_unit(p, X, l, u, lds, tid, lane, wave); }
            { PHASE_BEGIN(); for (int e = tid; e < 4 * 64 * 8; e += NTHR) { const int g = e >> 9, c = (e >> 3) & 63, n8 = (e & 7) * 8;
                  const f32x4 w0 = *(const f32x4*)(p.pool_w + (size_t)l * 16384 + (g * 64 + c) * 64 + n8), w1 = *(const f32x4*)(p.pool_w + (size_t)l * 16384 + (g * 64 + c) * 64 + n8 + 4);
#pragma unroll
                  for (int k = 0; k < 4; ++k) { *(LAS _Float16*)(lds + MX_WPT + ((g * 64 + n8 + k) * 72 + c) * 2) = (_Float16)w0[k]; *(LAS _Float16*)(lds + MX_WPT + ((g * 64 + n8 + 4 + k) * 72 + c) * 2) = (_Float16)w1[k]; } }
              asm volatile("s_waitcnt lgkmcnt(0)" ::: "memory"); __syncthreads(); }
            { PHASE_BEGIN(); for (int u = vcu; u < 256; u += G) { task_pool(p, l, u * 64, wave >> 2, (wave >> 2) ? 3 - (wave & 3) : (wave & 3), lds, wave, lane); __syncthreads(); } }
            { PHASE_BEGIN(); MIXPTRS(); for (int u = vcu; u < 256; u += G) attn_sample_unit(p, X, l, u, lds, tid, lane, wave); }
            { PHASE_BEGIN(); MIXPTRS(); for (int u = vcu; u < 2 * DB; u += G) convpool_sample_unit(p, X, l, u >> 1, u & 1, lds, tid, lane, wave); }
            SEAM(ph + 1); }
        if (EN(4) && IN(ph + 2)) {
            { PHASE_BEGIN();
            pg8::Gemm g{(const u16*)(p.ws + WS_MIX), (const u16*)(p.ws + WS_WOUT) + (size_t)l * D * D, M, D, D};
            for (int u = vcu; u < 256; u += G) outproj_sample_unit(p, l, u, lds, tid, lane, wave);
            __syncthreads();
            pg8::StaticOrder S; S.init(MP, D, G, bx);
            EpiOutF E{p.ws, l, p.ln_g, p.ln_b};
            pg8::gemm_phase<EpiOutF, false>(lds, g, S, E, tid);
            for (int u = vcu; u < 256; u += G) outproj_sample_finish(p, l, u, lane, wave); }
            SEAM(ph + 2);
        }
    }
    if (EN(5) && IN(N_PHASES - 1)) { PHASE_BEGIN(); fin_phase(p, gw, NGW, lane); }
#undef IN
#undef SEAM
#endif
}


#ifdef DBG
constexpr int DBG_NS = 56;
constexpr size_t WS_DBGACC = 32 * 1024;
constexpr size_t WS_DBGZ = WS_END;
__constant__ int dbg_rows_tab[DBG_NS] = {0, 1, 2, 3, 14, 15, 16, 29, 30, 31, 32, 63, 64, 65, 127, 128, 129, 255, 256, 1000, 2047, 2048, 3967, 3968, 4065, 4066, 4080, 4081, 4094, 4095, 4096, 4097, 4127, 4224,
                            8191, 8192, 8320, 12288, 12415, 16382, 16383, 16384, 16385, 16386, 16387, 16388, 16391, 16639, 16640, 16892, 16893, 16894, 16895, 5000, 9999, 15000};
__device__ int dbg_row(int i) { return dbg_rows_tab[i]; }
__device__ void dbg_acc(float* accf, int id, float e, float r) {
    __shared__ float se[256], sr[256];
    const int t = threadIdx.x; se[t] = e; sr[t] = r; __syncthreads();
    for (int o = 128; o > 0; o >>= 1) { if (t < o) { se[t] += se[t + o]; sr[t] += sr[t + o]; } __syncthreads(); }
    if (t == 0) { atomicAdd(accf + 2 * id, se[0]); atomicAdd(accf + 2 * id + 1, sr[0]); }
    __syncthreads();
}
__device__ float dbg_h(const u16* p, size_t i) { return (float)(*(const _Float16*)(p + i)); }
__device__ float dbg_block_sum(float v) { __shared__ float sb[256]; const int t = threadIdx.x; sb[t] = v; __syncthreads(); for (int o = 128; o > 0; o >>= 1) { if (t < o) sb[t] += sb[t + o]; __syncthreads(); } const float r = sb[0]; __syncthreads(); return r; }
__device__ void dbg_ln4(float (&x)[4], float& rstd) { const float mean = dbg_block_sum(x[0] + x[1] + x[2] + x[3]) / D; float q = 0; for (int i = 0; i < 4; ++i) { x[i] -= mean; q += x[i] * x[i]; } rstd = 1.f / sqrtf(dbg_block_sum(q) / D + LN_EPS); }
#define DBG_E(fast, ref) do { const float f_ = (fast), r_ = (ref); e += (f_ - r_) * (f_ - r_); rr += r_ * r_; } while (0)
__global__ void __launch_bounds__(256) dbg_p0(Params p) {
    float* accf = (float*)(p.ws + WS_DBGACC); const int t = threadIdx.x, bid = blockIdx.x;
    { float e = 0, rr = 0; const int ri = (bid >> 2) % 9;
        const int l = bid & 3, row = ri < 6 ? ri : (ri == 6 ? 67 : 123 + ri);
        const float* c = row < NB ? p.c_prompt + (size_t)row * D : p.c_sample + (size_t)(row - NB) * D;
        for (int n = t * 12 + (bid % 12); n < 3072; n += 256 * 12) { float a = p.b_mod[l * 3072 + n];
            for (int k = 0; k < D; ++k) { const float x = c[k]; a += x / (1.f + expf(-x)) * p.w_mod[((size_t)l * D + k) * 3072 + n]; }
            DBG_E(((const float*)(p.ws + WS_MOD))[((size_t)l * NMOD + row) * 3072 + n], a); }
        dbg_acc(accf, 0, e, rr); }
    { float e = 0, rr = 0;
        for (int i = 0; i < 64; ++i) { const int l = bid & 3, col = (bid * 37 + i * 41 + t * 10) % DIN, k = (t * 4 + i * 16 + bid) % D;
            DBG_E(dbg_h((const u16*)(p.ws + WS_WIN), ((size_t)l * DIN + perm_in(col)) * D + k), p.w_in[((size_t)l * D + k) * DIN + col]); }
        dbg_acc(accf, 1, e, rr); }
    { float e = 0, rr = 0;
        for (int i = 0; i < 64; ++i) { const int l = bid & 3, col = (bid * 37 + i * 41 + t * 4) % D, k = (t * 4 + i * 16 + bid) % D;
            DBG_E(dbg_h((const u16*)(p.ws + WS_WOUT), ((size_t)l * D + perm_out(col)) * D + k), p.w_out[((size_t)l * D + k) * D + col]); }
        dbg_acc(accf, 2, e, rr); }
    { float e = 0, rr = 0;
        for (int i = 0; i < 16; ++i) { const int pi = (bid * 113 + i * 257 + t * 16) % (SEQ + DS), f = (t + i) & 31; const int pos = pi < SEQ ? pi : PAST + pi - SEQ;
            const float ang = (float)pos * p.inv_freq[f]; const f32x2 cs = ((const f32x2*)(p.ws + WS_TAB))[pi * 32 + f];
            DBG_E(cs[0], cosf(ang)); DBG_E(cs[1], sinf(ang)); }
        dbg_acc(accf, 3, e, rr); }
}
__global__ void __launch_bounds__(256) dbg_p0b(Params p) {
    float* accf = (float*)(p.ws + WS_DBGACC); const int t = threadIdx.x, bid = blockIdx.x;
    { float e = 0, rr = 0;
        const int l = bid & 3, b = (bid >> 2) & 3; const float* md = (const float*)(p.ws + WS_MOD) + ((size_t)l * NMOD + b) * 3072;
        const int col = (t * 10 + (bid >> 4) * 3 + 1) % DIN; float v1 = 0, v2 = 0, v3 = 0, v4 = 0;
        for (int c = 0; c < D; ++c) { const float w = p.w_in[((size_t)l * D + c) * DIN + col], g = l > 0 ? p.ln_g[(l - 1) * D + c] : 1.f, bb = l > 0 ? p.ln_b[(l - 1) * D + c] : 0.f, s1 = 1.f + md[1024 + c];
            v1 += g * s1 * w; v2 += bb * s1 * w; v3 += s1 * w; v4 += md[c] * w; }
        const float* mv = (const float*)(p.ws + WS_MODV) + (size_t)(l * NB + b) * 4 * DIN + perm_in(col);
        DBG_E(mv[0], v1); DBG_E(mv[2 * DIN], v3); DBG_E(mv[3 * DIN], v4); if (l > 0) DBG_E(mv[DIN], v2); else e += mv[DIN] * mv[DIN];
        dbg_acc(accf, 69, e, rr); }
    if (bid < DBG_NS) { const int row = dbg_row(bid); const bool smp = row >= MP; const int bidx = smp ? NB + ((row - MP) >> 2) : (row >> 12);
        const float* md = (const float*)(p.ws + WS_MOD) + (size_t)bidx * 3072;
        float x[4]; for (int i = 0; i < 4; ++i) { const int c = t + 256 * i; x[i] = smp ? p.x_sample[(size_t)(row - MP) * D + c] : p.x_prompt[(size_t)row * D + c]; }
        float e = 0, rr = 0; for (int i = 0; i < 4; ++i) DBG_E(dbg_h((const u16*)(p.ws + (smp ? WS_XR : WS_ZH)), (size_t)row * D + t + 256 * i), x[i]); dbg_acc(accf, 70, e, rr);
        e = 0; rr = 0;
        if (!smp) { for (int i = 0; i < 4; ++i) { const int c = t + 256 * i; DBG_E(dbg_h((const u16*)(p.ws + WS_H), (size_t)row * D + c), x[i] * (1.f + md[1024 + c])); } }
        else { float rstd; dbg_ln4(x, rstd); for (int i = 0; i < 4; ++i) { const int c = t + 256 * i; DBG_E(dbg_h((const u16*)(p.ws + WS_H), (size_t)row * D + c), x[i] * rstd * (1.f + md[1024 + c]) + md[c]); } }
        dbg_acc(accf, 71, e, rr); }
}
__global__ void __launch_bounds__(256) dbg_copyz(Params p) { const int row = dbg_row(blockIdx.x);
    for (int c = threadIdx.x; c < D; c += 256) { ((u16*)(p.ws + WS_DBGZ))[blockIdx.x * D + c] = ((const u16*)(p.ws + WS_ZH))[(size_t)row * D + c]; ((u16*)(p.ws + WS_DBGZ))[(DBG_NS + blockIdx.x) * D + c] = ((const u16*)(p.ws + WS_XR))[(size_t)row * D + c]; } }
__global__ void __launch_bounds__(256) dbg_in(Params p, int l) {
    __shared__ float pr[DIN]; __shared__ float hh[D];
    float* accf = (float*)(p.ws + WS_DBGACC); const int t = threadIdx.x, row = dbg_row(blockIdx.x), base = 4 + 16 * l;
    const bool smp = row >= MP; const int b = smp ? (row - MP) >> 2 : row >> 12, tt = smp ? (row - MP) & 3 : row & (SEQ - 1), pos = smp ? PAST + tt : tt;
    const int bidx = smp ? NB + b : b; const float* md = (const float*)(p.ws + WS_MOD) + ((size_t)l * NMOD + bidx) * 3072;
    float e, rr;
    { float x[4]; float rstd;
        for (int i = 0; i < 4; ++i) x[i] = dbg_h((const u16*)(p.ws + (smp ? WS_XR : WS_ZH)), (size_t)row * D + t + 256 * i);
        if (!smp && l > 0) { dbg_ln4(x, rstd); for (int i = 0; i < 4; ++i) { const int c = t + 256 * i; x[i] = x[i] * rstd * p.ln_g[(l - 1) * D + c] + p.ln_b[(l - 1) * D + c]; } }
        dbg_ln4(x, rstd);
        for (int i = 0; i < 4; ++i) { const int c = t + 256 * i; hh[c] = x[i] * rstd * (1.f + md[1024 + c]) + md[c]; }
        __syncthreads();
        if (smp) { e = 0; rr = 0; for (int i = 0; i < 4; ++i) { const int c = t + 256 * i; DBG_E(dbg_h((const u16*)(p.ws + WS_H), (size_t)row * D + c), hh[c]); } dbg_acc(accf, base + 1, e, rr); } }
    for (int i = 0; i < 10; ++i) { const int col = t + 256 * i; float a = 0; for (int k = 0; k < D; ++k) a += hh[k] * p.w_in[((size_t)l * D + k) * DIN + col]; pr[col] = a; }
    __syncthreads();
    const float av = pr[t] / (1.f + expf(-pr[256 + t]));
    e = 0; rr = 0; DBG_E(dbg_h((const u16*)(p.ws + WS_PA), (size_t)row * 256 + t), av); dbg_acc(accf, base + 2, e, rr);
    e = 0; rr = 0; { const float z = pr[512 + t]; DBG_E(dbg_h((const u16*)(p.ws + WS_PSZC), (size_t)row * 256 + t), z / (1.f + expf(-z))); } dbg_acc(accf, base + 3, e, rr);
    e = 0; rr = 0; DBG_E(dbg_h((const u16*)(p.ws + WS_PPV), (size_t)row * 256 + t), pr[768 + t]); dbg_acc(accf, base + 4, e, rr);
    e = 0; rr = 0; { const float z = pr[1024 + t]; DBG_E(dbg_h((const u16*)(p.ws + WS_PSZP), (size_t)row * 256 + t), z / (1.f + expf(-z))); } dbg_acc(accf, base + 5, e, rr);
    e = 0; rr = 0;
    for (int i = 0; i < 2; ++i) { const int c = t + 256 * i, hd = c >> 6, d = c & 63, f = d & 31; const float ang = (float)pos * p.inv_freq[f], cs = cosf(ang), sn = sinf(ang);
        const float x = pr[1280 + c], xo = d < 32 ? -pr[1280 + hd * 64 + d + 32] : pr[1280 + hd * 64 + d - 32];
        DBG_E(dbg_h((const u16*)(p.ws + WS_PQ), (size_t)row * 512 + c), (x * cs + xo * sn) * QSCALE); }
    dbg_acc(accf, base + 6, e, rr);
    e = 0; rr = 0; float kref = 0.f, vref = 0.f;
    if (t < 128) { const int hd = t >> 6, d = t & 63, f = d & 31; const float ang = (float)pos * p.inv_freq[f], cs = cosf(ang), sn = sinf(ang);
        const float x = pr[1792 + t], xo = d < 32 ? -pr[1792 + hd * 64 + d + 32] : pr[1792 + hd * 64 + d - 32]; kref = x * cs + xo * sn;
        DBG_E(dbg_h((const u16*)(p.ws + WS_PK), (size_t)row * 128 + t), kref); }
    dbg_acc(accf, base + 7, e, rr);
    e = 0; rr = 0; if (t < 128) { vref = pr[1920 + t]; DBG_E(dbg_h((const u16*)(p.ws + WS_PV), (size_t)row * 128 + t), vref); } dbg_acc(accf, base + 8, e, rr);
    e = 0; rr = 0; for (int i = 0; i < 2; ++i) { const float z = pr[2048 + t + 256 * i]; DBG_E(dbg_h((const u16*)(p.ws + WS_PSZA), (size_t)row * 512 + t + 256 * i), z / (1.f + expf(-z))); } dbg_acc(accf, base + 9, e, rr);
    e = 0; rr = 0;
    if (smp) { DBG_E(p.out[OFF_CONVS + ((size_t)(l * DB + b) * 30 + 26 + tt) * 256 + t], av); DBG_E(p.out[OFF_POOLS + ((size_t)(l * DB + b) * 15 + 11 + tt) * 256 + t], pr[768 + t]);
        if (t < 128) { DBG_E(p.out[OFF_KS + ((size_t)(l * DB + b) * 128 + 124 + tt) * 128 + t], kref); DBG_E(p.out[OFF_VS + ((size_t)(l * DB + b) * 128 + 124 + tt) * 128 + t], vref); } }
    else { if (tt >= SEQ - 30) DBG_E(p.out[OFF_CONVP + ((size_t)(l * NB + b) * 30 + tt - (SEQ - 30)) * 256 + t], av);
        if (tt >= SEQ - 15) DBG_E(p.out[OFF_POOLP + ((size_t)(l * NB + b) * 15 + tt - (SEQ - 15)) * 256 + t], pr[768 + t]);
        if (tt >= SEQ - 128 && t < 128) { DBG_E(p.out[OFF_KP + ((size_t)(l * NB + b) * 128 + tt - (SEQ - 128)) * 128 + t], kref); DBG_E(p.out[OFF_VP + ((size_t)(l * NB + b) * 128 + tt - (SEQ - 128)) * 128 + t], vref); } }
    dbg_acc(accf, base + 10, e, rr);
}
__global__ void __launch_bounds__(256) dbg_mix(Params p, int l) {
    __shared__ float sh[1024]; __shared__ float sc[136];
    float* accf = (float*)(p.ws + WS_DBGACC); const int t = threadIdx.x, row = dbg_row(blockIdx.x), base = 4 + 16 * l;
    const bool smp = row >= MP; const int b = smp ? (row - MP) >> 2 : row >> 12, tt = smp ? (row - MP) & 3 : row & (SEQ - 1);
    const u16 *PA = (const u16*)(p.ws + WS_PA), *PSZC = (const u16*)(p.ws + WS_PSZC), *PPV = (const u16*)(p.ws + WS_PPV), *PSZP = (const u16*)(p.ws + WS_PSZP), *PQ = (const u16*)(p.ws + WS_PQ),
              *PSZA = (const u16*)(p.ws + WS_PSZA), *PK = (const u16*)(p.ws + WS_PK), *PV = (const u16*)(p.ws + WS_PV), *MIX = (const u16*)(p.ws + WS_MIX);
    float e, rr;
    {
        float a = p.conv_b[l * 256 + t];
        for (int j = 0; j < 31; ++j) { float x;
            if (!smp) { const int ts = tt - 30 + j; x = ts >= 0 ? dbg_h(PA, ((size_t)b * SEQ + ts) * 256 + t) : 0.f; }
            else { const int ri = tt + j; x = ri < 30 ? p.cache_conv[((size_t)(l * DB + b) * 30 + ri) * 256 + t] : dbg_h(PA, ((size_t)MP + 4 * b + ri - 30) * 256 + t); }
            a += p.conv_w[((size_t)l * 31 + j) * 256 + t] * x; }
        const float mean = dbg_block_sum(a) / 256.f; const float d = a - mean; const float rstd = 1.f / sqrtf(dbg_block_sum(d * d) / 256.f + LN_EPS);
        const float y = d * rstd * p.cnorm_g[l * 256 + t] + p.cnorm_b[l * 256 + t];
        e = 0; rr = 0; DBG_E(dbg_h(MIX, (size_t)row * D + t), y / (1.f + expf(-y)) * dbg_h(PSZC, (size_t)row * 256 + t)); dbg_acc(accf, base + 11, e, rr); }
    {
        const int w = 2 << (t >> 6); float s = 0;
        for (int i = 0; i < w; ++i) { float x;
            if (!smp) { const int ts = tt - i; x = ts >= 0 ? dbg_h(PPV, ((size_t)b * SEQ + ts) * 256 + t) : 0.f; }
            else { const int ri = 15 + tt - i; x = ri < 15 ? p.cache_pool[((size_t)(l * DB + b) * 15 + ri) * 256 + t] : dbg_h(PPV, ((size_t)MP + 4 * b + ri - 15) * 256 + t); }
            s += x; }
        const float cnt = smp ? (float)w : (float)(w < tt + 1 ? w : tt + 1);
        sh[t] = s / cnt - dbg_h(PPV, (size_t)row * 256 + t); __syncthreads();
        const int g = t >> 6, n = t & 63; float y = 0; for (int c = 0; c < 64; ++c) y += sh[64 * g + c] * p.pool_w[(((size_t)l * 4 + g) * 64 + c) * 64 + n];
        e = 0; rr = 0; DBG_E(dbg_h(MIX, (size_t)row * D + 256 + t), y * p.pool_scale[l * 256 + t] * dbg_h(PSZP, (size_t)row * 256 + t)); dbg_acc(accf, base + 12, e, rr); __syncthreads(); }
    {
        e = 0; rr = 0;
        for (int hd = 0; hd < 8; ++hd) { const int hk = hd >> 2; __syncthreads();
            if (t < 64) sh[t] = dbg_h(PQ, (size_t)row * 512 + hd * 64 + t); __syncthreads();
            const float sink2 = p.sinks[l * 8 + hd] * LOG2E;
            if (t < 128) { float s = -INFINITY;
                if (!smp) { const int ts = tt - 127 + t; if (ts >= 0) { s = 0; for (int d = 0; d < 64; ++d) s += sh[d] * dbg_h(PK, ((size_t)b * SEQ + ts) * 128 + hk * 64 + d); } }
                else { const int ci = tt + 1 + t;
                    s = 0; for (int d = 0; d < 64; ++d) s += sh[d] * (ci < 128 ? p.cache_k[(((size_t)(l * DB + b) * 128 + ci) * 2 + hk) * 64 + d] : dbg_h(PK, ((size_t)MP + 4 * b + ci - 128) * 128 + hk * 64 + d)); }
                sc[t] = s; }
            __syncthreads();
            float mx = sink2; for (int k = 0; k < 128; ++k) mx = fmaxf(mx, sc[k]);
            float den = exp2f(sink2 - mx); for (int k = 0; k < 128; ++k) den += exp2f(sc[k] - mx);
            if (t < 64) { float o = 0;
                for (int k = 0; k < 128; ++k) { const float pk = exp2f(sc[k] - mx) / den; if (pk == 0.f) continue; float v;
                    if (!smp) { const int ts = tt - 127 + k; v = dbg_h(PV, ((size_t)b * SEQ + ts) * 128 + hk * 64 + t); }
                    else { const int ci = tt + 1 + k; v = ci < 128 ? p.cache_v[(((size_t)(l * DB + b) * 128 + ci) * 2 + hk) * 64 + t] : dbg_h(PV, ((size_t)MP + 4 * b + ci - 128) * 128 + hk * 64 + t); }
                    o += pk * v; }
                DBG_E(dbg_h(MIX, (size_t)row * D + 512 + hd * 64 + t), o * dbg_h(PSZA, (size_t)row * 512 + hd * 64 + t)); } }
        dbg_acc(accf, base + 13, e, rr); }
    if (smp) { e = 0; rr = 0;
        for (int i = 0; i < 26; ++i) DBG_E(p.out[OFF_CONVS + ((size_t)(l * DB + b) * 30 + i) * 256 + t], p.cache_conv[((size_t)(l * DB + b) * 30 + i + 4) * 256 + t]);
        for (int i = 0; i < 11; ++i) DBG_E(p.out[OFF_POOLS + ((size_t)(l * DB + b) * 15 + i) * 256 + t], p.cache_pool[((size_t)(l * DB + b) * 15 + i + 4) * 256 + t]);
        for (int i = 0; i < 124; ++i) if (t < 128) { DBG_E(p.out[OFF_KS + ((size_t)(l * DB + b) * 128 + i) * 128 + t], p.cache_k[((size_t)(l * DB + b) * 128 + i + 4) * 128 + t]);
            DBG_E(p.out[OFF_VS + ((size_t)(l * DB + b) * 128 + i) * 128 + t], p.cache_v[((size_t)(l * DB + b) * 128 + i + 4) * 128 + t]); }
        dbg_acc(accf, base + 15, e, rr); }
}
__global__ void __launch_bounds__(256) dbg_out(Params p, int l) {
    __shared__ float mm[D];
    float* accf = (float*)(p.ws + WS_DBGACC); const int t = threadIdx.x, row = dbg_row(blockIdx.x), base = 4 + 16 * l;
    const bool smp = row >= MP; const int bidx = smp ? NB + ((row - MP) >> 2) : (row >> 12);
    for (int c = t; c < D; c += 256) mm[c] = dbg_h((const u16*)(p.ws + WS_MIX), (size_t)row * D + c);
    __syncthreads();
    const float* md = (const float*)(p.ws + WS_MOD) + ((size_t)l * NMOD + bidx) * 3072 + 2048;
    const float* mdn = (const float*)(p.ws + WS_MOD) + ((size_t)(l + 1) * NMOD + bidx) * 3072;
    float x1[4], z[4], rstd;
    for (int i = 0; i < 4; ++i) x1[i] = dbg_h((const u16*)(p.ws + WS_DBGZ), (size_t)((smp ? DBG_NS : 0) + blockIdx.x) * D + t + 256 * i);
    if (!smp && l > 0) { dbg_ln4(x1, rstd); for (int i = 0; i < 4; ++i) { const int c = t + 256 * i; x1[i] = x1[i] * rstd * p.ln_g[(l - 1) * D + c] + p.ln_b[(l - 1) * D + c]; } }
    float e = 0, rr = 0;
    for (int i = 0; i < 4; ++i) { const int c = t + 256 * i; float a = 0; for (int k = 0; k < D; ++k) a += mm[k] * p.w_out[((size_t)l * D + k) * D + c];
        z[i] = ALPHA * x1[i] + (1.f + md[c]) * a; DBG_E(dbg_h((const u16*)(p.ws + WS_ZH), (size_t)row * D + c), z[i]); }
    dbg_acc(accf, base + 14, e, rr);
    e = 0; rr = 0;
    if (!smp) { if (l < DEPTH - 1) for (int i = 0; i < 4; ++i) { const int c = t + 256 * i; DBG_E(dbg_h((const u16*)(p.ws + WS_H), (size_t)row * D + c), z[i] * p.ln_g[l * D + c] * (1.f + mdn[1024 + c])); } }
    else { dbg_ln4(z, rstd); for (int i = 0; i < 4; ++i) { const int c = t + 256 * i; z[i] = z[i] * rstd * p.ln_g[l * D + c] + p.ln_b[l * D + c]; }
        if (l == DEPTH - 1) { for (int i = 0; i < 4; ++i) DBG_E(p.out[OFF_YS + (size_t)(row - MP) * D + t + 256 * i], z[i]); }
        else { for (int i = 0; i < 4; ++i) DBG_E(dbg_h((const u16*)(p.ws + WS_XR), (size_t)row * D + t + 256 * i), z[i]);
            dbg_ln4(z, rstd); for (int i = 0; i < 4; ++i) { const int c = t + 256 * i; DBG_E(dbg_h((const u16*)(p.ws + WS_H), (size_t)row * D + c), z[i] * rstd * (1.f + mdn[1024 + c]) + mdn[c]); } } }
    dbg_acc(accf, base + 0, e, rr);
    if (l == 0) { dbg_acc(accf, 100, smp ? 0.f : e, smp ? 0.f : rr); dbg_acc(accf, 101, smp ? e : 0.f, smp ? rr : 0.f); }
}
__global__ void __launch_bounds__(256) dbg_fin(Params p) {
    float* accf = (float*)(p.ws + WS_DBGACC); const int t = threadIdx.x, row = dbg_row(blockIdx.x);
    if (row >= MP) return;
    float x[4]; for (int i = 0; i < 4; ++i) x[i] = dbg_h((const u16*)(p.ws + WS_ZH), (size_t)row * D + t + 256 * i);
    float rstd; dbg_ln4(x, rstd); float e = 0, rr = 0;
    for (int i = 0; i < 4; ++i) { const int c = t + 256 * i; DBG_E(p.out[(size_t)row * D + c], x[i] * rstd * p.ln_g[3 * D + c] + p.ln_b[3 * D + c]); }
    dbg_acc(accf, 68, e, rr);
}
#ifndef DBG_REPORT_ID
#define DBG_REPORT_ID -1
#endif
__global__ void __launch_bounds__(256) dbg_report(Params p) {
    const float* accf = (const float*)(p.ws + WS_DBGACC);
    float code = 1000.f;
    if (DBG_REPORT_ID >= 0) { const float e = accf[2 * DBG_REPORT_ID], r = accf[2 * DBG_REPORT_ID + 1]; code = (r > 0.f ? e / r : 9.9f) * 1e12f; if (!(code > 100.f)) code = 100.f; }
    else for (int i = 0; i < 128; ++i) { const float e = accf[2 * i], r = accf[2 * i + 1]; const bool expected = i <= 71 && !(i >= 4 && i < 68 && ((i - 4) & 15) == 0 && (i - 4) / 16 == 99);
        if ((r > 0.f && !(e / r < 1e-3f)) || (r == 0.f && (e > 0.f || expected)) || e != e || r != r) { code = (float)(i + 1) * 1e4f; break; } }
    const float S = sqrtf(code);
    for (size_t i = (size_t)blockIdx.x * 256 + threadIdx.x; i < (size_t)MP * D; i += (size_t)gridDim.x * 256) p.out[i] = S;
}
#endif

extern "C" void kernel_launch(void* const* d_in, const int* in_sizes, int n_in, void* d_out, int out_size, void* d_ws, size_t ws_size, hipStream_t stream) {
    static int grid = 0;
    if (grid == 0) {
        if (n_in != 21 || (size_t)out_size != OUT_TOTAL || ws_size < WS_END) { fprintf(stderr, "kernel_launch: unexpected shapes (n_in %d, out %d, ws %zu)\n", n_in, out_size, ws_size); grid = -1; return; }
        int dev = 0, cus = 0;
        if (hipGetDevice(&dev) != hipSuccess || hipDeviceGetAttribute(&cus, hipDeviceAttributeMultiprocessorCount, dev) != hipSuccess) { grid = -1; return; }
        if (hipFuncSetAttribute((const void*)hymba_fwd, hipFuncAttributeMaxDynamicSharedMemorySize, LDS_BYTES) != hipSuccess) { fprintf(stderr, "kernel_launch: hipFuncSetAttribute failed\n"); grid = -1; return; }
        (void)hipGetLastError();
        grid = cus;
    }
    if (grid < 0) return;
    (void)hipMemsetAsync((char*)d_ws + WS_CTL, 0, CTL_ZERO_BYTES, stream);
    Params a{};
    a.x_prompt = (const float*)d_in[0]; a.x_sample = (const float*)d_in[1]; a.cache_conv = (const float*)d_in[2]; a.cache_pool = (const float*)d_in[3];
    a.cache_k = (const float*)d_in[4]; a.cache_v = (const float*)d_in[5]; a.c_prompt = (const float*)d_in[6]; a.c_sample = (const float*)d_in[7];
    a.w_in = (const float*)d_in[8]; a.w_out = (const float*)d_in[9]; a.conv_w = (const float*)d_in[10]; a.conv_b = (const float*)d_in[11];
    a.cnorm_g = (const float*)d_in[12]; a.cnorm_b = (const float*)d_in[13]; a.pool_w = (const float*)d_in[14]; a.pool_scale = (const float*)d_in[15];
    a.sinks = (const float*)d_in[16]; a.w_mod = (const float*)d_in[17]; a.b_mod = (const float*)d_in[18]; a.ln_g = (const float*)d_in[19]; a.ln_b = (const float*)d_in[20];
    a.out = (float*)d_out; a.ws = (unsigned char*)d_ws;
    for (int i = 0; i < 32; ++i) a.inv_freq[i] = (float)std::pow(10000.0, -(double)i * (2.0 / 64.0));
    if (MK_N_LAUNCHES == 1) { a.ph_lo = 0; a.ph_hi = N_PHASES; hipLaunchKernelGGL(hymba_fwd, dim3(grid), dim3(NTHR), LDS_BYTES, stream, a); }
    else for (int ph = 0; ph < N_PHASES; ++ph) {
#ifdef DBG
        if (ph >= 2 && ph < N_PHASES - 1 && (ph - 2) % 3 == 2) hipLaunchKernelGGL(dbg_copyz, dim3(DBG_NS), dim3(256), 0, stream, a);
#endif
        a.ph_lo = ph; a.ph_hi = ph + 1; hipLaunchKernelGGL(hymba_fwd, dim3(grid), dim3(NTHR), LDS_BYTES, stream, a);
#ifdef DBG
        if (ph == 0) hipLaunchKernelGGL(dbg_p0, dim3(144), dim3(256), 0, stream, a);
        else if (ph == 1) hipLaunchKernelGGL(dbg_p0b, dim3(144), dim3(256), 0, stream, a);
        else if (ph == N_PHASES - 1) { hipLaunchKernelGGL(dbg_fin, dim3(DBG_NS), dim3(256), 0, stream, a); hipLaunchKernelGGL(dbg_report, dim3(1024), dim3(256), 0, stream, a); }
        else { const int l = (ph - 2) / 3, k = (ph - 2) % 3;
            if (k == 0) hipLaunchKernelGGL(dbg_in, dim3(DBG_NS), dim3(256), 0, stream, a, l);
            if (k == 1) hipLaunchKernelGGL(dbg_mix, dim3(DBG_NS), dim3(256), 0, stream, a, l);
            if (k == 2) hipLaunchKernelGGL(dbg_out, dim3(DBG_NS), dim3(256), 0, stream, a, l); }
#endif
    }
}
```

```cpp
#include <hip/hip_runtime.h>
#include <cstdint>
#include <cstdio>
#include <cmath>

#define DBG_REPORT_ID -1
#ifndef MK_N_LAUNCHES
#define MK_N_LAUNCHES 1
#endif

#define DI __device__ __forceinline__
#define GAS __attribute__((address_space(1)))
#define LAS __attribute__((address_space(3)))
typedef unsigned short u16;
typedef _Float16 h8 __attribute__((ext_vector_type(8)));
typedef _Float16 h4 __attribute__((ext_vector_type(4)));
typedef _Float16 h2 __attribute__((ext_vector_type(2)));
typedef float f32x2 __attribute__((ext_vector_type(2)));
typedef float f32x4 __attribute__((ext_vector_type(4)));
typedef float f32x16 __attribute__((ext_vector_type(16)));
typedef unsigned u32x4 __attribute__((ext_vector_type(4)));
typedef unsigned u32x2 __attribute__((ext_vector_type(2)));
typedef short v4i16_t __attribute__((ext_vector_type(4)));

constexpr int D = 1024, DIN = 2560, NB = 4, SEQ = 4096, DEPTH = 4, DB = 128, DS = 4;
constexpr int MP = NB * SEQ, MS = DB * DS, M = MP + MS;
constexpr int NMOD = NB + DB;
constexpr int PAST = 8192;
constexpr float LN_EPS = 1e-5f;
constexpr float ALPHA = 1.681792830507429f;
constexpr float LOG2E = 1.4426950408889634f;
constexpr float QSCALE = 0.125f * LOG2E;
constexpr size_t OFF_YP = 0, OFF_YS = OFF_YP + (size_t)MP * D, OFF_CONVP = OFF_YS + (size_t)MS * D, OFF_POOLP = OFF_CONVP + (size_t)DEPTH * NB * 30 * 256,
                 OFF_KP = OFF_POOLP + (size_t)DEPTH * NB * 15 * 256, OFF_VP = OFF_KP + (size_t)DEPTH * NB * 128 * 128, OFF_CONVS = OFF_VP + (size_t)DEPTH * NB * 128 * 128,
                 OFF_POOLS = OFF_CONVS + (size_t)DEPTH * DB * 30 * 256, OFF_KS = OFF_POOLS + (size_t)DEPTH * DB * 15 * 256, OFF_VS = OFF_KS + (size_t)DEPTH * DB * 128 * 128,
                 OUT_TOTAL = OFF_VS + (size_t)DEPTH * DB * 128 * 128;
constexpr size_t MiB = 1u << 20;
constexpr size_t WS_CTL = 0, CTL_ZERO_BYTES = 64 * 1024;
constexpr size_t WS_WIN = 1 * MiB;
constexpr size_t WS_WOUT = 21 * MiB;
constexpr size_t WS_MOD = 29 * MiB;
constexpr size_t WS_TAB = 36 * MiB;
constexpr size_t WS_ZH = 38 * MiB;
constexpr size_t WS_XR = 71 * MiB;
constexpr size_t WS_MIX = 104 * MiB;
constexpr size_t WS_PA = 137 * MiB;
constexpr size_t WS_PSZC = WS_PA + (size_t)M * 256 * 2, WS_PPV = WS_PSZC + (size_t)M * 256 * 2, WS_PSZP = WS_PPV + (size_t)M * 256 * 2;
constexpr size_t WS_PQ = WS_PSZP + (size_t)M * 256 * 2;
constexpr size_t WS_PSZA = WS_PQ + (size_t)M * 512 * 2;
constexpr size_t WS_PK = WS_PSZA + (size_t)M * 512 * 2;
constexpr size_t WS_PV = WS_PK + (size_t)M * 128 * 2;
constexpr size_t WS_H = WS_PV + (size_t)M * 128 * 2;
constexpr size_t WS_PS = WS_H + (size_t)M * D * 2;
constexpr size_t WS_RC0 = WS_PS + 2 * (size_t)MP * 24 * 4;
constexpr size_t WS_MODV = WS_RC0 + (size_t)MP * 16;
constexpr size_t WS_LNC = WS_MODV + (size_t)DEPTH * NB * 4 * DIN * 4;
constexpr size_t WS_VT = WS_LNC + 256;
constexpr size_t WS_END = WS_VT + (size_t)NB * 2 * 64 * SEQ * 2;
static_assert(WS_END <= 256 * MiB, "d_ws map");
constexpr int CW_BAR = 1024;
constexpr int CW_SCNT = 12288;

DI unsigned pkh(float a, float b) { f32x2 v = {a, b}; h2 r = __builtin_convertvector(v, h2); return __builtin_bit_cast(unsigned, r); }
DI u32x4 pack8(const float* v) { u32x4 w; w.x = pkh(v[0], v[1]); w.y = pkh(v[2], v[3]); w.z = pkh(v[4], v[5]); w.w = pkh(v[6], v[7]); return w; }
DI void unpack8(u32x4 w, float* o) {
    const h8 v = __builtin_bit_cast(h8, w);
#pragma unroll
    for (int j = 0; j < 8; ++j) o[j] = (float)v[j];
}
DI float ex2(float x) { return __builtin_amdgcn_exp2f(x); }
DI float sigm(float x) { return __builtin_amdgcn_rcpf(1.f + ex2(-x * LOG2E)); }
DI float silu(float x) { return x * sigm(x); }
template <int O> DI float xor_lane(float v) {
    return __builtin_bit_cast(float, __builtin_amdgcn_ds_swizzle(__builtin_bit_cast(int, v), (O << 10) | 0x1f));
}
DI float sum_halves(float v) { float a = v, b = v; asm volatile("s_nop 1\n\tv_permlane32_swap_b32 %0, %1" : "+v"(a), "+v"(b)); return a + b; }
DI float max_halves(float v) { float a = v, b = v; asm volatile("s_nop 1\n\tv_permlane32_swap_b32 %0, %1" : "+v"(a), "+v"(b)); return fmaxf(a, b); }
template <int CTRL, int ROWMASK> DI float dpp_f(float v, float ident) { return __builtin_bit_cast(float, __builtin_amdgcn_update_dpp(__builtin_bit_cast(int, ident), __builtin_bit_cast(int, v), CTRL, ROWMASK, 0xf, false)); }
DI float wave_sum(float v) {
    v += dpp_f<0xB1, 0xf>(v, 0.f); v += dpp_f<0x4E, 0xf>(v, 0.f); v += dpp_f<0x141, 0xf>(v, 0.f); v += dpp_f<0x140, 0xf>(v, 0.f);
    v += dpp_f<0x142, 0xa>(v, 0.f); v += dpp_f<0x143, 0xc>(v, 0.f);
    return __builtin_bit_cast(float, __builtin_amdgcn_readlane(__builtin_bit_cast(int, v), 63));
}
DI float wave_max(float v) {
    const float NI = -INFINITY;
    v = fmaxf(v, dpp_f<0xB1, 0xf>(v, NI)); v = fmaxf(v, dpp_f<0x4E, 0xf>(v, NI)); v = fmaxf(v, dpp_f<0x141, 0xf>(v, NI)); v = fmaxf(v, dpp_f<0x140, 0xf>(v, NI));
    v = fmaxf(v, dpp_f<0x142, 0xa>(v, NI)); v = fmaxf(v, dpp_f<0x143, 0xc>(v, NI));
    return __builtin_bit_cast(float, __builtin_amdgcn_readlane(__builtin_bit_cast(int, v), 63));
}
DI int lane_id() { int l_; asm volatile("v_mbcnt_lo_u32_b32 %0, -1, 0\n\tv_mbcnt_hi_u32_b32 %0, -1, %0" : "=v"(l_)); return l_; }
DI int crow(int r, int hi) { return (r & 3) + 8 * (r >> 2) + 4 * hi; }

__host__ __device__ __forceinline__ int pperm(int bj, int c7) { return 128 * bj + 32 * (c7 >> 5) + 16 * ((c7 >> 2) & 1) + 4 * ((c7 >> 3) & 3) + (c7 & 3); }
__host__ __device__ __forceinline__ int perm_in(int col) {
    if (col < 512) { const int bj = col >> 8, ch = col & 255; return 256 * (ch >> 7) + pperm(bj, ch & 127); }
    if (col < 1280) { const int base = col < 768 ? 512 : (col < 1024 ? 768 : 1024); const int x = col - base; return base + pperm(x >> 7, x & 127); }
    if (col < 1792) { const int x = col - 1280, head = x >> 6, d = x & 63; return 256 * (5 + (head >> 2)) + pperm(d >> 5, 32 * (head & 3) + (d & 31)); }
    if (col < 2048) { const int x = col - 1792, hh = x >> 6, d = x & 63; return 1792 + pperm(d >> 5, 32 * hh + (d & 31)); }
    { const int x = col - 2048; return 2048 + 256 * (x >> 8) + pperm((x >> 7) & 1, x & 127); }
}
__host__ __device__ __forceinline__ int perm_out(int col) { const int y = col & 255; return (col & ~255) + pperm(y >> 7, y & 127); }

namespace pg8 {
constexpr int BM = 256, BK = 64, HALF = 128, HTB = HALF * BK * 2, STAGE_BYTES = 8 * HTB, NXCD = 8, WGM = 8;
__host__ __device__ __forceinline__ int lds_byte(int r, int c) { const int st = (r >> 4) * 2 + (c >> 5), rr = r & 15, cc = c & 31, ob = rr * 64 + cc * 2; return st * 1024 + (ob ^ (((ob >> 9) & 1) << 5)); }
__host__ __device__ __forceinline__ void stage_rc(int b, int& R, int& C) { const int st = b / 1024, sb = b % 1024, swz = sb ^ (((sb >> 9) & 1) << 5); R = (st >> 1) * 16 + swz / 64; C = (st & 1) * 32 + (swz % 64) / 2; }
struct Unit { int pm, pn; };
struct Gemm { const u16* A; const u16* Bt; int M, N, K; };
struct StaticOrder {
    int nM, nN, nwg, G, c;
    __host__ __device__ __forceinline__ void init(int M_, int N_, int G_, int c_) { nM = M_ / BM; nN = N_ / BM; nwg = nM * nN; G = G_; c = c_; }
    __host__ __device__ __forceinline__ bool next(int i, Unit& u) const {
        const long L = (long)i * G + c; if (L >= nwg) return false;
        int wgid = (int)L; { const int q = nwg / NXCD, r = nwg % NXCD, xcd = wgid % NXCD, off = wgid / NXCD; wgid = (xcd < r ? xcd * (q + 1) : r * (q + 1) + (xcd - r) * q) + off; }
        const int nig = WGM * nN, gid = wgid / nig, fm = gid * WGM, gsz = (nM - fm) < WGM ? (nM - fm) : WGM;
        u.pm = fm + ((wgid % nig) % gsz); u.pn = (wgid % nig) / gsz; return true;
    }
};

template <class Epi, bool ALIGN_EPI>
DI void gemm_phase(LAS unsigned char* lds, const Gemm g, const StaticOrder& S, const Epi& E, const int tid) {
    const int wid = __builtin_amdgcn_readfirstlane(tid >> 6), lane = tid & 63, wr = wid >> 2, wc = wid & 3, fr = lane & 15, fq = lane >> 4;
    const int K = g.K, nt = K / BK;
    unsigned voffA[2];
#pragma unroll
    for (int i = 0; i < 2; ++i) { int R, C; stage_rc(tid * 16 + i * 8192, R, C); voffA[i] = (unsigned)(R * K + C) * 2u; }
    const size_t kstep = (size_t)(BK * 2);
    const size_t hstep = (size_t)HALF * K * 2;
    const size_t tstep = 2 * hstep;
    const unsigned ldsw = (unsigned)wid * 1024u;
    const int aoff = lds_byte(wr * 64 + fr, fq * 8), boff = lds_byte(wc * 32 + fr, fq * 8);
#define PG8_SA(b, h) (((b) * 2 + (h)) * HTB)
#define PG8_SB(b, h) ((4 + (b) * 2 + (h)) * HTB)
#define PG8_STAGE(bufoff, gbase) do { _Pragma("unroll") for (int _i = 0; _i < 2; ++_i) \
        __builtin_amdgcn_global_load_lds((const unsigned*)((const char*)(gbase) + voffA[_i]), (LAS unsigned*)(lds + (bufoff) + ldsw + _i * 8192), 16, 0, 0); } while (0)
#define PG8_LDA(dst, b, h) do { _Pragma("unroll") for (int m = 0; m < 4; ++m) _Pragma("unroll") for (int k = 0; k < 2; ++k) dst[m][k] = *(const LAS h8*)(lds + PG8_SA(b, h) + aoff + m * 2048 + k * 1024); } while (0)
#define PG8_LDB(dst, b, h) do { _Pragma("unroll") for (int n = 0; n < 2; ++n) _Pragma("unroll") for (int k = 0; k < 2; ++k) dst[n][k] = *(const LAS h8*)(lds + PG8_SB(b, h) + boff + n * 2048 + k * 1024); } while (0)
#define PG8_MMA(ai, bj, At, Bt) do { __builtin_amdgcn_s_setprio(1); _Pragma("unroll") for (int m = 0; m < 4; ++m) _Pragma("unroll") for (int n = 0; n < 2; ++n) _Pragma("unroll") for (int k = 0; k < 2; ++k) \
        acc[ai][bj][m][n] = __builtin_amdgcn_mfma_f32_16x16x32_f16(Bt[n][k], At[m][k], acc[ai][bj][m][n], 0, 0, 0); __builtin_amdgcn_s_setprio(0); } while (0)
#define PG8_WAIT_V(n) asm volatile("s_waitcnt vmcnt(" #n ")" ::: "memory")
#define PG8_WAIT_L(n) asm volatile("s_waitcnt lgkmcnt(" #n ")" ::: "memory")
#define PG8_BAR __builtin_amdgcn_s_barrier()
#define PG8_SCHED __builtin_amdgcn_sched_barrier(0)
    Unit cur, nxt; int ui = 0;
    if (!S.next(0, cur)) return;
    f32x4 acc[2][2][4][2];
#pragma unroll
    for (int a = 0; a < 2; ++a)
#pragma unroll
        for (int b = 0; b < 2; ++b)
#pragma unroll
            for (int m = 0; m < 4; ++m)
#pragma unroll
                for (int n = 0; n < 2; ++n) acc[a][b][m][n] = (f32x4){0.f, 0.f, 0.f, 0.f};
    h8 At[4][2], B0[2][2], B1[2][2];
    const char* cA = (const char*)g.A + (size_t)cur.pm * tstep; const char* cB = (const char*)g.Bt + (size_t)cur.pn * tstep;
    PG8_STAGE(PG8_SB(0, 0), cB); PG8_STAGE(PG8_SB(0, 1), cB + hstep); PG8_STAGE(PG8_SA(0, 0), cA); PG8_STAGE(PG8_SA(0, 1), cA + hstep);
    if (wr == 1) PG8_BAR;
    PG8_WAIT_V(2); PG8_BAR;
    PG8_STAGE(PG8_SB(1, 0), cB + kstep); PG8_STAGE(PG8_SA(1, 0), cA + kstep); PG8_STAGE(PG8_SB(1, 1), cB + hstep + kstep);
    PG8_WAIT_V(6); PG8_BAR;
    for (;;) {
        const bool has_next = S.next(ui + 1, nxt);
        const char* nA = has_next ? (const char*)g.A + (size_t)nxt.pm * tstep : cA; const char* nB = has_next ? (const char*)g.Bt + (size_t)nxt.pn * tstep : cB;
        for (int t = 0; t < nt; t += 2) {
            const bool last = (t == nt - 2);
            const char* a1 = cA + (size_t)(t + 1) * kstep;
            const char* a2 = last ? nA : cA + (size_t)(t + 2) * kstep; const char* b2 = last ? nB : cB + (size_t)(t + 2) * kstep;
            const char* a3 = a2 + kstep; const char* b3 = b2 + kstep;
            PG8_LDB(B0, 0, 0); PG8_LDB(B1, 0, 1); PG8_SCHED; PG8_LDA(At, 0, 0); PG8_STAGE(PG8_SA(1, 1), a1 + hstep);
            PG8_WAIT_V(8); PG8_WAIT_L(0); PG8_BAR; PG8_MMA(0, 0, At, B0); PG8_MMA(0, 1, At, B1); PG8_BAR; PG8_SCHED;
            PG8_LDA(At, 0, 1); PG8_STAGE(PG8_SB(0, 0), b2); PG8_STAGE(PG8_SB(0, 1), b2 + hstep); PG8_STAGE(PG8_SA(0, 0), a2);
            PG8_WAIT_V(8); PG8_WAIT_L(0); PG8_BAR; PG8_MMA(1, 0, At, B0); PG8_MMA(1, 1, At, B1); PG8_BAR; PG8_SCHED;
            PG8_LDB(B0, 1, 0); PG8_LDB(B1, 1, 1); PG8_SCHED; PG8_LDA(At, 1, 0); PG8_STAGE(PG8_SA(0, 1), a2 + hstep);
            PG8_WAIT_V(8); PG8_WAIT_L(0); PG8_BAR; PG8_MMA(0, 0, At, B0); PG8_MMA(0, 1, At, B1); PG8_BAR; PG8_SCHED;
            PG8_LDA(At, 1, 1); PG8_STAGE(PG8_SB(1, 0), b3); PG8_STAGE(PG8_SB(1, 1), b3 + hstep); PG8_STAGE(PG8_SA(1, 0), a3);
            PG8_WAIT_V(8); PG8_WAIT_L(0); PG8_BAR; PG8_MMA(1, 0, At, B0); PG8_MMA(1, 1, At, B1); PG8_BAR; PG8_SCHED;
        }
        if constexpr (ALIGN_EPI) { if (wr == 0) PG8_BAR; }
        if constexpr (!Epi::AFTER_DRAIN) E(acc, cur, ui, wr, wc, fr, fq);
        if (!has_next) break;
#pragma unroll
        for (int a = 0; a < 2; ++a)
#pragma unroll
            for (int b = 0; b < 2; ++b)
#pragma unroll
                for (int m = 0; m < 4; ++m)
#pragma unroll
                    for (int n = 0; n < 2; ++n) acc[a][b][m][n] = (f32x4){0.f, 0.f, 0.f, 0.f};
        cur = nxt; cA = nA; cB = nB; ++ui;
        if constexpr (ALIGN_EPI) { if (wr == 1) PG8_BAR; }
    }
    PG8_WAIT_V(0);
    if constexpr (!ALIGN_EPI) { if (wr == 0) PG8_BAR; }
    PG8_BAR;
    if constexpr (Epi::AFTER_DRAIN) E.fused(acc, cur, wr, wc, fr, fq, lds, tid);
#undef PG8_SA
#undef PG8_SB
#undef PG8_STAGE
#undef PG8_LDA
#undef PG8_LDB
#undef PG8_MMA
#undef PG8_WAIT_V
#undef PG8_WAIT_L
#undef PG8_BAR
#undef PG8_SCHED
}
}

struct Params {
    const float* x_prompt; const float* x_sample; const float* cache_conv; const float* cache_pool; const float* cache_k; const float* cache_v;
    const float* c_prompt; const float* c_sample; const float* w_in; const float* w_out; const float* conv_w; const float* conv_b; const float* cnorm_g; const float* cnorm_b;
    const float* pool_w; const float* pool_scale; const float* sinks; const float* w_mod; const float* b_mod; const float* ln_g; const float* ln_b;
    float* out; unsigned char* ws;
    int ph_lo, ph_hi;
    float inv_freq[32];
};
struct ParamsHead { const float* ptrs[21]; float* out; unsigned char* ws; int ph_lo, ph_hi; };
static_assert(sizeof(ParamsHead) == __builtin_offsetof(Params, inv_freq), "ParamsHead mirrors the head of Params");

DI void row_info(int row, bool& smp, int& b, int& t) { smp = row >= MP; if (!smp) { b = row >> 12; t = row & (SEQ - 1); } else { const int s = row - MP; b = s >> 2; t = s & 3; } }
DI void st8f(float* dst, const float* v) { *(f32x4*)dst = (f32x4){v[0], v[1], v[2], v[3]}; *(f32x4*)(dst + 4) = (f32x4){v[4], v[5], v[6], v[7]}; }

struct EpiIn {
    static constexpr bool AFTER_DRAIN = false;
    int l; unsigned char* ws; float* out; const LAS float* rcl;
    DI void operator()(f32x4 (&acc)[2][2][4][2], const pg8::Unit& u, int ui, int wr, int wc, int fr, int fq) const {
        asm volatile("" : "+v"(fr), "+v"(fq));
        const int pn = u.pn;
        if (u.pm < MP / 256) {
            const LAS f32x4* rc = (const LAS f32x4*)rcl + ui * 256 + wr * 64 + fr;
            const float* mv = (const float*)(ws + WS_MODV) + (size_t)(l * NB + (u.pm >> 4)) * 4 * DIN + pn * 256 + wc * 32 + 4 * fq;
#pragma unroll
            for (int bj = 0; bj < 2; ++bj)
#pragma unroll
                for (int n = 0; n < 2; ++n) { const float* mp = mv + 128 * bj + 16 * n;
                    const f32x4 v1 = *(const f32x4*)mp, v2 = *(const f32x4*)(mp + DIN), v3 = *(const f32x4*)(mp + 2 * DIN), v4 = *(const f32x4*)(mp + 3 * DIN);
#pragma unroll
                    for (int ai = 0; ai < 2; ++ai)
#pragma unroll
                        for (int m = 0; m < 4; ++m) { const f32x4 r = rc[ai * 128 + m * 16];
                            acc[ai][bj][m][n] = r[0] * acc[ai][bj][m][n] - r[1] * v1 + r[2] * v2 - r[3] * v3 + v4; } }
        }
        unsigned char* const W = ws; float* const O = out;
#define ST16(byteoff, vals) (*(u32x4*)(W + (size_t)(unsigned)(byteoff)) = pack8(vals))
#define STF8(fidx, vals) st8f(O + (size_t)(unsigned)(fidx), vals)
#pragma unroll
        for (int ai = 0; ai < 2; ++ai)
#pragma unroll
            for (int m = 0; m < 4; ++m) {
                const unsigned row = (unsigned)(u.pm * 256 + ai * 128 + wr * 64 + m * 16 + fr);
                const bool smp = row >= (unsigned)MP; const unsigned b = smp ? (row - MP) >> 2 : row >> 12, t = smp ? (row - MP) & 3u : row & (unsigned)(SEQ - 1);
                if (pn < 2) {
                    const unsigned c8 = pn * 128 + wc * 32 + fq * 8; float a[8];
#pragma unroll
                    for (int n = 0; n < 2; ++n)
#pragma unroll
                        for (int j = 0; j < 4; ++j) a[4 * n + j] = acc[ai][0][m][n][j] * sigm(acc[ai][1][m][n][j]);
                    ST16((unsigned)WS_PA + (row * 256 + c8) * 2, a);
                    if (smp) STF8((unsigned)OFF_CONVS + ((l * DB + b) * 30 + 26 + t) * 256 + c8, a);
                    else if (t >= SEQ - 30) STF8((unsigned)OFF_CONVP + ((l * NB + b) * 30 + (t - (SEQ - 30))) * 256 + c8, a);
                } else if (pn == 2 || pn == 4) {
                    const unsigned base = pn == 2 ? (unsigned)WS_PSZC : (unsigned)WS_PSZP;
#pragma unroll
                    for (int bj = 0; bj < 2; ++bj) { const unsigned c8 = bj * 128 + wc * 32 + fq * 8; float v[8];
#pragma unroll
                        for (int n = 0; n < 2; ++n)
#pragma unroll
                            for (int j = 0; j < 4; ++j) v[4 * n + j] = silu(acc[ai][bj][m][n][j]);
                        ST16(base + (row * 256 + c8) * 2, v); }
                } else if (pn == 3) {
#pragma unroll
                    for (int bj = 0; bj < 2; ++bj) { const unsigned c8 = bj * 128 + wc * 32 + fq * 8; float v[8];
#pragma unroll
                        for (int n = 0; n < 2; ++n)
#pragma unroll
                            for (int j = 0; j < 4; ++j) v[4 * n + j] = acc[ai][bj][m][n][j];
                        ST16((unsigned)WS_PPV + (row * 256 + c8) * 2, v);
                        if (smp) STF8((unsigned)OFF_POOLS + ((l * DB + b) * 15 + 11 + t) * 256 + c8, v);
                        else if (t >= SEQ - 15) STF8((unsigned)OFF_POOLP + ((l * NB + b) * 15 + (t - (SEQ - 15))) * 256 + c8, v); }
                } else if (pn >= 8) {
#pragma unroll
                    for (int bj = 0; bj < 2; ++bj) { const unsigned c8 = (pn - 8) * 256 + bj * 128 + wc * 32 + fq * 8; float v[8];
#pragma unroll
                        for (int n = 0; n < 2; ++n)
#pragma unroll
                            for (int j = 0; j < 4; ++j) v[4 * n + j] = silu(acc[ai][bj][m][n][j]);
                        ST16((unsigned)WS_PSZA + (row * 512 + c8) * 2, v); }
                } else if (pn == 7 && wc >= 2) {
                    const unsigned hv = wc - 2;
#pragma unroll
                    for (int bj = 0; bj < 2; ++bj) { const unsigned d8 = 32 * bj + 8 * fq; float v[8];
#pragma unroll
                        for (int n = 0; n < 2; ++n)
#pragma unroll
                            for (int j = 0; j < 4; ++j) v[4 * n + j] = acc[ai][bj][m][n][j];
                        ST16((unsigned)WS_PV + (row * 128 + hv * 64 + d8) * 2, v);
                        if (smp) STF8((unsigned)OFF_VS + (((l * DB + b) * 128 + 124 + t) * 2 + hv) * 64 + d8, v);
                        else if (t >= SEQ - 128) STF8((unsigned)OFF_VP + (((l * NB + b) * 128 + (t - (SEQ - 128))) * 2 + hv) * 64 + d8, v); }
                } else {
                    const unsigned d8 = 8 * fq; const unsigned pidx = smp ? SEQ + t : t;
                    const f32x4* tp = (const f32x4*)(W + (size_t)((unsigned)WS_TAB + (pidx * 32 + d8) * 8));
                    float x1[8], x2[8], o1[8], o2[8];
#pragma unroll
                    for (int n = 0; n < 2; ++n)
#pragma unroll
                        for (int j = 0; j < 4; ++j) { x1[4 * n + j] = acc[ai][0][m][n][j]; x2[4 * n + j] = acc[ai][1][m][n][j]; }
                    const float sc = pn == 7 ? 1.f : QSCALE;
#pragma unroll
                    for (int k2 = 0; k2 < 4; ++k2) { const f32x4 cs = tp[k2];
                        o1[2 * k2] = (x1[2 * k2] * cs[0] - x2[2 * k2] * cs[1]) * sc;         o2[2 * k2] = (x2[2 * k2] * cs[0] + x1[2 * k2] * cs[1]) * sc;
                        o1[2 * k2 + 1] = (x1[2 * k2 + 1] * cs[2] - x2[2 * k2 + 1] * cs[3]) * sc; o2[2 * k2 + 1] = (x2[2 * k2 + 1] * cs[2] + x1[2 * k2 + 1] * cs[3]) * sc; }
                    if (pn == 7) { const unsigned hk = wc;
                        ST16((unsigned)WS_PK + (row * 128 + hk * 64 + d8) * 2, o1); ST16((unsigned)WS_PK + (row * 128 + hk * 64 + 32 + d8) * 2, o2);
                        if (smp) { const unsigned di = (unsigned)OFF_KS + (((l * DB + b) * 128 + 124 + t) * 2 + hk) * 64 + d8; STF8(di, o1); STF8(di + 32, o2); }
                        else if (t >= SEQ - 128) { const unsigned di = (unsigned)OFF_KP + (((l * NB + b) * 128 + (t - (SEQ - 128))) * 2 + hk) * 64 + d8; STF8(di, o1); STF8(di + 32, o2); }
                    } else { const unsigned head = (pn - 5) * 4 + wc;
                        ST16((unsigned)WS_PQ + (row * 512 + head * 64 + d8) * 2, o1); ST16((unsigned)WS_PQ + (row * 512 + head * 64 + 32 + d8) * 2, o2); }
                }
            }
#undef ST16
#undef STF8
    }
};

struct EpiOutF {
    static constexpr bool AFTER_DRAIN = true;
    unsigned char* ws; int l; const float* ln_g; const float* ln_b;
    DI void operator()(f32x4 (&)[2][2][4][2], const pg8::Unit&, int, int, int, int, int) const {}
    DI void fused(f32x4 (&acc)[2][2][4][2], const pg8::Unit& u, int wr, int wc, int fr, int fq, LAS unsigned char* lds, int tid) const {
        LAS float* CV = (LAS float*)lds;
        LAS float* RS = (LAS float*)(lds + 8192);
        LAS float* PW = (LAS float*)(lds + 12288);
        u16* ZH = (u16*)(ws + WS_ZH); u16* ZP = (u16*)(ws + WS_H);
        const float* MOD = (const float*)(ws + WS_MOD); const int b = u.pm >> 4;
        const float* PSp = (const float*)(ws + WS_PS) + (size_t)((l + 1) & 1) * MP * 24; float* PSc = (float*)(ws + WS_PS) + (size_t)(l & 1) * MP * 24;
        if (tid < 256) { const int col = u.pn * 256 + tid;
            CV[tid] = l > 0 ? ln_g[(l - 1) * D + col] : 1.f; CV[256 + tid] = l > 0 ? ln_b[(l - 1) * D + col] : 0.f;
            CV[512 + tid] = MOD[((size_t)l * NMOD + b) * 3072 + 2048 + col]; CV[768 + tid] = ln_g[l * D + col]; CV[1024 + tid] = ln_b[l * D + col];
            CV[1280 + tid] = l < DEPTH - 1 ? MOD[((size_t)(l + 1) * NMOD + b) * 3072 + 1024 + col] : 0.f;
        } else { const int row = tid - 256; float mu = 0.f, rstd = 1.f;
            if (l > 0) { const float* ps = PSp + (size_t)(u.pm * 256 + row) * 24; const float s1 = (ps[0] + ps[6]) + (ps[12] + ps[18]), s2 = (ps[1] + ps[7]) + (ps[13] + ps[19]);
                mu = s1 * (1.f / D); rstd = 1.f / sqrtf(s2 * (1.f / D) - mu * mu + LN_EPS); }
            RS[2 * row] = mu; RS[2 * row + 1] = rstd; }
        __syncthreads();
#pragma unroll
        for (int ai = 0; ai < 2; ++ai) {
        u32x4 zpv[4][2];
#pragma unroll
        for (int mm = 0; mm < 4; ++mm)
#pragma unroll
            for (int bj = 0; bj < 2; ++bj) zpv[mm][bj] = *(const u32x4*)(ZH + ((size_t)u.pm * 256 + ai * 128 + wr * 64 + mm * 16 + fr) * D + u.pn * 256 + bj * 128 + wc * 32 + fq * 8);
#pragma unroll
        for (int mm = 0; mm < 4; ++mm) { const int m = mm;
            const int rt = ai * 128 + wr * 64 + m * 16 + fr; const size_t row = (size_t)u.pm * 256 + rt;
            const float mu = RS[2 * rt], rstd = RS[2 * rt + 1];
            float s1 = 0.f, s2 = 0.f, s3 = 0.f, s4 = 0.f, s5 = 0.f, s6 = 0.f;
#pragma unroll
            for (int bj = 0; bj < 2; ++bj) { const int cl = bj * 128 + wc * 32 + fq * 8; const size_t off = row * D + u.pn * 256 + cl;
                float zp[8], zq[8], zo[8]; unpack8(zpv[mm][bj], zp);
#pragma unroll
                for (int hh = 0; hh < 2; ++hh) {
                    const f32x4 gp = *(const LAS f32x4*)(CV + cl + 4 * hh), bp = *(const LAS f32x4*)(CV + 256 + cl + 4 * hh), gt = *(const LAS f32x4*)(CV + 512 + cl + 4 * hh),
                                gg = *(const LAS f32x4*)(CV + 768 + cl + 4 * hh), bb = *(const LAS f32x4*)(CV + 1024 + cl + 4 * hh), sn = *(const LAS f32x4*)(CV + 1280 + cl + 4 * hh);
                    const f32x4 av = acc[ai][bj][m][hh];
#pragma unroll
                    for (int j = 0; j < 4; ++j) { const int k = 4 * hh + j;
                        const float x1 = l > 0 ? (zp[k] - mu) * rstd * gp[j] + bp[j] : zp[k];
                        const float z = ALPHA * x1 + (1.f + gt[j]) * av[j], uu = z * gg[j];
                        s1 += z; s2 += z * z; s3 += uu; s4 += uu * uu; s5 += uu * gg[j]; s6 += uu * bb[j];
                        zq[k] = z; zo[k] = uu * (1.f + sn[j]); } }
                *(u32x4*)(ZH + off) = pack8(zq);
                if (l < DEPTH - 1) *(u32x4*)(ZP + off) = pack8(zo); }
            s1 = sum_halves(s1 + xor_lane<16>(s1)); s2 = sum_halves(s2 + xor_lane<16>(s2)); s3 = sum_halves(s3 + xor_lane<16>(s3)); s4 = sum_halves(s4 + xor_lane<16>(s4)); s5 = sum_halves(s5 + xor_lane<16>(s5)); s6 = sum_halves(s6 + xor_lane<16>(s6));
            if (fq == 0) { LAS float* pw = PW + (rt * 4 + wc) * 6; pw[0] = s1; pw[1] = s2; pw[2] = s3; pw[3] = s4; pw[4] = s5; pw[5] = s6; } }
        asm volatile("" ::: "memory"); }
        __syncthreads();
        if (tid < 256 && l < DEPTH - 1) { float* ps = PSc + (size_t)(u.pm * 256 + tid) * 24 + u.pn * 6; const LAS float* pw = PW + tid * 24;
#pragma unroll
            for (int k = 0; k < 6; ++k) ps[k] = (pw[k] + pw[6 + k]) + (pw[12 + k] + pw[18 + k]); }
    }
};

#define XB_TMO      128
#define XB_XCNT(j)  (256  + 64 * (j))
#define XB_XSUB(j)  (1280 + 64 * (j))
#define XB_XGEN(j)  (2304 + 64 * (j))
#define XB_TOP      3328
#define XB_TOPGEN   3392
#define XCD_BAR_WORDS 3456
#define XB_SPIN_CAP (1u << 18)
DI unsigned xb_ld(unsigned* p)              { return __hip_atomic_load(p, __ATOMIC_RELAXED, __HIP_MEMORY_SCOPE_AGENT); }
DI unsigned xb_add(unsigned* p, unsigned v) { return __hip_atomic_fetch_add(p, v, __ATOMIC_RELAXED, __HIP_MEMORY_SCOPE_AGENT); }
DI unsigned xb_xcc_id() { return (unsigned)__builtin_amdgcn_s_getreg((3 << 11) | 20) & 0xFu; }
#define XB_SPIN(cond, bar) do { unsigned _sp = 0; while (cond) { __builtin_amdgcn_s_sleep(1); \
    if ((++_sp & 255u) == 0u) { if (xb_ld(&(bar)[XB_TMO])) break; if (_sp > XB_SPIN_CAP) { atomicAdd(&(bar)[XB_TMO], 1u); break; } } } } while (0)
struct XcdBarrier { unsigned* bar; unsigned x; volatile LAS unsigned* st; };
DI XcdBarrier xcd_barrier_post(unsigned* bar, volatile LAS unsigned* st) {
    XcdBarrier b; b.bar = bar; b.x = xb_xcc_id(); b.st = st;
    if (threadIdx.x == 0) (void)xb_add(&bar[XB_XCNT(b.x)], 1u);
    return b;
}
DI void xcd_barrier_complete(unsigned* bar, unsigned x, unsigned& nloc, unsigned& nx) {
    const unsigned G = gridDim.x * gridDim.y * gridDim.z;
    unsigned sum, cnt, mine, sp = 0u;
    for (;;) {
        sum = 0u; cnt = 0u; mine = 0u;
#pragma unroll
        for (unsigned j = 0; j < 16; ++j) { const unsigned c = xb_ld(&bar[XB_XCNT(j)]); sum += c; cnt += (c > 0u) ? 1u : 0u; mine = (j == x) ? c : mine; }
        if (sum == G) break;
        __builtin_amdgcn_s_sleep(1);
        if ((++sp & 255u) == 0u) { if (xb_ld(&bar[XB_TMO])) break; if (sp > XB_SPIN_CAP) { atomicAdd(&bar[XB_TMO], 1u); break; } }
    }
    nloc = mine > 0u ? mine : 1u; nx = cnt > 0u ? cnt : 1u;
}
DI void xcd_barrier(const XcdBarrier& b, const int wave_s) {
    asm volatile("s_waitcnt vmcnt(0)" ::: "memory");
    __syncthreads();
    if (wave_s == 0 && lane_id() == 0) {
        unsigned* bar = b.bar;
        __builtin_amdgcn_s_waitcnt(0);
        unsigned nloc = b.st[0], nx = b.st[1];
        if (nloc == 0u) { xcd_barrier_complete(bar, b.x, nloc, nx); b.st[0] = nloc; b.st[1] = nx; }
        const unsigned old = xb_add(&bar[XB_XSUB(b.x)], 1u);
        const unsigned gen = old / nloc;
        if (old + 1u == (gen + 1u) * nloc) {
            __builtin_amdgcn_fence(__ATOMIC_RELEASE, "agent");
            asm volatile("s_waitcnt vmcnt(0)" ::: "memory");
            const unsigned og = xb_add(&bar[XB_TOP], 1u);
            const unsigned tg = og / nx;
            if (og + 1u == (tg + 1u) * nx) xb_add(&bar[XB_TOPGEN], 1u);
            else XB_SPIN(xb_ld(&bar[XB_TOPGEN]) == tg, bar);
            __builtin_amdgcn_fence(__ATOMIC_ACQUIRE, "agent");
            xb_add(&bar[XB_XGEN(b.x)], 1u);
            asm volatile("s_waitcnt vmcnt(0)" ::: "memory");
        } else {
            XB_SPIN(xb_ld(&bar[XB_XGEN(b.x)]) == gen, bar);
            __builtin_amdgcn_fence(__ATOMIC_ACQUIRE, "agent");
            asm volatile("s_waitcnt vmcnt(0)" ::: "memory");
        }
    }
    __syncthreads();
}

constexpr int NWAVES = 8, NTHR = 512;
constexpr int LDS_BYTES = 147456;
constexpr int RING_BYTES = 131072, MISC_OFF = RING_BYTES + 320;

DI void p0_transpose_item(const float* W, int K, int N, u16* WT, LAS float* scr, int item, int lane, bool isin) {
    const int nblk = N / 32, kb = item / nblk, nb = item % nblk, k0 = 64 * kb, n0 = 32 * nb;
    float wv[32];
    { const float* wp = W + (size_t)(k0 + (lane >> 5)) * N + n0 + (lane & 31);
#pragma unroll
      for (int i = 0; i < 32; ++i) wv[i] = wp[(size_t)(2 * i) * N]; }
#pragma unroll
    for (int i = 0; i < 32; ++i) scr[(2 * i + (lane >> 5)) * 33 + (lane & 31)] = wv[i];
    asm volatile("s_waitcnt lgkmcnt(0)" ::: "memory");
    const int c = lane & 7;
#pragma unroll
    for (int j = 0; j < 4; ++j) { const int n = (lane >> 3) + 8 * j; const LAS float* s = scr + (8 * c) * 33 + n;
        u32x4 o; o.x = pkh(s[0 * 33], s[1 * 33]); o.y = pkh(s[2 * 33], s[3 * 33]); o.z = pkh(s[4 * 33], s[5 * 33]); o.w = pkh(s[6 * 33], s[7 * 33]);
        const int dst = isin ? perm_in(n0 + n) : perm_out(n0 + n);
        *(u32x4*)(WT + (size_t)dst * K + k0 + 8 * c) = o; }
    asm volatile("s_waitcnt lgkmcnt(0)" ::: "memory");
}
DI void transpose_layer(const Params& p, int l, LAS unsigned char* lds, int widx, int nw, int lane, int wave) {
    LAS float* scr = (LAS float*)(lds + wave * 16384);
    constexpr int I_IN = (D / 64) * (DIN / 32), I_OUT = (D / 64) * (D / 32);
    for (int r = widx; r < I_IN + I_OUT; r += nw) {
        if (r < I_IN) p0_transpose_item(p.w_in + (size_t)l * D * DIN, D, DIN, (u16*)(p.ws + WS_WIN) + (size_t)l * DIN * D, scr, r, lane, true);
        else p0_transpose_item(p.w_out + (size_t)l * D * D, D, D, (u16*)(p.ws + WS_WOUT) + (size_t)l * D * D, scr, r - I_IN, lane, false);
    }
}
DI void mod_unit(const Params& p, LAS unsigned char* lds, int unit, int tid, int lane, int wave) {
    const int l = unit >> 6, n0 = (unit & 63) * 48;
    const float* W = p.w_mod + (size_t)l * D * 3072;
    float* MOD = (float*)(p.ws + WS_MOD);
    const int fr = lane & 15, fq = lane >> 4;
    f32x4 acc[9][3];
#pragma unroll
    for (int rt = 0; rt < 9; ++rt)
#pragma unroll
        for (int ct = 0; ct < 3; ++ct) acc[rt][ct] = (f32x4){0.f, 0.f, 0.f, 0.f};
    float wn[3][8];
#pragma unroll
    for (int ct = 0; ct < 3; ++ct) { const float* wp = W + (size_t)(wave * 128 + fq * 8) * 3072 + n0 + 16 * ct + fr;
#pragma unroll
        for (int j = 0; j < 8; ++j) wn[ct][j] = wp[(size_t)j * 3072]; }
#pragma unroll
    for (int ks = 0; ks < 4; ++ks) {
        const int k0 = wave * 128 + ks * 32 + fq * 8;
        h8 bfr[3];
#pragma unroll
        for (int ct = 0; ct < 3; ++ct)
#pragma unroll
            for (int j = 0; j < 8; ++j) bfr[ct][j] = (_Float16)wn[ct][j];
        if (ks < 3) {
#pragma unroll
            for (int ct = 0; ct < 3; ++ct) { const float* wp = W + (size_t)(k0 + 32) * 3072 + n0 + 16 * ct + fr;
#pragma unroll
                for (int j = 0; j < 8; ++j) wn[ct][j] = wp[(size_t)j * 3072]; } }
#pragma unroll
        for (int rt = 0; rt < 9; ++rt) { const int row = 16 * rt + fr; h8 a;
            if (row < NMOD) { const float* c = row < NB ? p.c_prompt + (size_t)row * D : p.c_sample + (size_t)(row - NB) * D;
                const f32x4 c0 = *(const f32x4*)(c + k0), c1 = *(const f32x4*)(c + k0 + 4);
#pragma unroll
                for (int j = 0; j < 4; ++j) { a[j] = (_Float16)silu(c0[j]); a[4 + j] = (_Float16)silu(c1[j]); } }
            else {
#pragma unroll
                for (int j = 0; j < 8; ++j) a[j] = (_Float16)0.f; }
#pragma unroll
            for (int ct = 0; ct < 3; ++ct) acc[rt][ct] = __builtin_amdgcn_mfma_f32_16x16x32_f16(a, bfr[ct], acc[rt][ct], 0, 0, 0); }
    }
    LAS float* part = (LAS float*)lds;
#pragma unroll
    for (int rg = 0; rg < 3; ++rg) {
        __syncthreads();
#pragma unroll
        for (int r3 = 0; r3 < 3; ++r3)
#pragma unroll
            for (int ct = 0; ct < 3; ++ct)
#pragma unroll
                for (int i = 0; i < 4; ++i) part[(wave * 48 + r3 * 16 + 4 * fq + i) * 48 + 16 * ct + fr] = acc[rg * 3 + r3][ct][i];
        __syncthreads();
        for (int o = tid; o < 48 * 48; o += NTHR) { const int r48 = o / 48, col = o % 48, row = 48 * rg + r48; float sacc = 0.f;
#pragma unroll
            for (int w = 0; w < 8; ++w) sacc += part[(w * 48 + r48) * 48 + col];
            if (row < NMOD) MOD[((size_t)l * NMOD + row) * 3072 + n0 + col] = sacc + p.b_mod[(size_t)l * 3072 + n0 + col]; }
    }
    __syncthreads();
}
DI void sincos_d(double a, float& c, float& s) {
    const double k = __builtin_rint(a * 0.63661977236758134308);
    const double r = __builtin_fma(-k, 1.2246467991473532e-16 * 0.5, __builtin_fma(-k, 1.5707963267948966, a));
    const double r2 = r * r;
    double sp = -1.0 / 6227020800.0; sp = sp * r2 + 1.0 / 39916800.0; sp = sp * r2 - 1.0 / 362880.0; sp = sp * r2 + 1.0 / 5040.0; sp = sp * r2 - 1.0 / 120.0; sp = sp * r2 + 1.0 / 6.0;
    const double sn = r - r * r2 * sp;
    double cp = 1.0 / 87178291200.0; cp = cp * r2 - 1.0 / 479001600.0; cp = cp * r2 + 1.0 / 3628800.0; cp = cp * r2 - 1.0 / 40320.0; cp = cp * r2 + 1.0 / 720.0; cp = cp * r2 - 1.0 / 24.0; cp = cp * r2 + 0.5;
    const double cn = 1.0 - r2 * cp;
    const long long q = (long long)k & 3;
    const double cc = (q == 0) ? cn : (q == 1) ? -sn : (q == 2) ? -cn : sn;
    const double ss = (q == 0) ? sn : (q == 1) ? cn : (q == 2) ? -sn : -cn;
    c = (float)cc; s = (float)ss;
}
DI void p0_prologue(const Params& p, const __attribute__((address_space(4))) float* invf, LAS unsigned char* lds, int vcu, int G, int tid, int lane, int wave) {
    for (int u = vcu; u < 256; u += G) mod_unit(p, lds, u, tid, lane, wave);
    const int gw = vcu * NWAVES + wave, NGW = G * NWAVES;
    transpose_layer(p, 0, lds, gw, NGW, lane, wave);
    if (vcu == 0 && wave < DEPTH) {
        float a = 0.f, b2 = 0.f, c2 = 0.f, d = 0.f, e = 0.f;
        for (int c = lane; c < D; c += 64) { const float g = p.ln_g[wave * D + c], bb = p.ln_b[wave * D + c]; a += g; b2 += g * g; c2 += g * bb; d += bb; e += bb * bb; }
        a = wave_sum(a); b2 = wave_sum(b2); c2 = wave_sum(c2); d = wave_sum(d); e = wave_sum(e);
        if (lane == 0) { float* o = (float*)(p.ws + WS_LNC) + wave * 8; o[0] = a; o[1] = b2; o[2] = c2; o[3] = d; o[4] = e; } }
    f32x2* tab = (f32x2*)(p.ws + WS_TAB);
    for (int e = vcu * NTHR + tid; e < (SEQ + DS) * 32; e += G * NTHR) {
        const int pi = e >> 5, i = e & 31; const int pos = pi < SEQ ? pi : PAST + (pi - SEQ);
        const float ang = (float)pos * invf[i];
        float c, s; sincos_d((double)ang, c, s);
        tab[e] = (f32x2){c, s};
    }
}

template <int R>
DI void ln_stats(float (&v)[R][16], float (&mean)[R], float (&rstd)[R]) {
    float s[R];
#pragma unroll
    for (int r = 0; r < R; ++r) { s[r] = 0.f;
#pragma unroll
        for (int k = 0; k < 16; ++k) s[r] += v[r][k]; }
#pragma unroll
    for (int r = 0; r < R; ++r) s[r] = wave_sum(s[r]);
#pragma unroll
    for (int r = 0; r < R; ++r) { mean[r] = s[r] * (1.f / D); s[r] = 0.f;
#pragma unroll
        for (int k = 0; k < 16; ++k) { v[r][k] -= mean[r]; s[r] += v[r][k] * v[r][k]; } }
#pragma unroll
    for (int r = 0; r < R; ++r) s[r] = wave_sum(s[r]);
#pragma unroll
    for (int r = 0; r < R; ++r) rstd[r] = 1.f / sqrtf(s[r] * (1.f / D) + LN_EPS);
}
constexpr int LNR = 3;
DI void pre_phase(const Params& p, int gw, int NGW, int lane) {
    const float* modl = (const float*)(p.ws + WS_MOD);
    u16* ZH = (u16*)(p.ws + WS_ZH); u16* XR = (u16*)(p.ws + WS_XR); u16* ZP = (u16*)(p.ws + WS_H); f32x4* RC0 = (f32x4*)(p.ws + WS_RC0);
    for (int row0 = gw; row0 < M; row0 += LNR * NGW) {
        float v[LNR][16]; bool ok[LNR]; float mean[LNR], rstd[LNR]; int rows[LNR];
#pragma unroll
        for (int r = 0; r < LNR; ++r) { rows[r] = row0 + r * NGW; ok[r] = rows[r] < M; if (!ok[r]) rows[r] = row0; }
#pragma unroll
        for (int r = 0; r < LNR; ++r) { const int row = rows[r]; const float* x = row < MP ? p.x_prompt + (size_t)row * D : p.x_sample + (size_t)(row - MP) * D;
#pragma unroll
            for (int j2 = 0; j2 < 2; ++j2) { const f32x4 a = *(const f32x4*)(x + 512 * j2 + 8 * lane), b = *(const f32x4*)(x + 512 * j2 + 8 * lane + 4);
#pragma unroll
                for (int k = 0; k < 4; ++k) { v[r][8 * j2 + k] = a[k]; v[r][8 * j2 + 4 + k] = b[k]; } } }
#pragma unroll
        for (int r = 0; r < LNR; ++r) if (ok[r]) { u16* dst = rows[r] < MP ? ZH : XR;
#pragma unroll
            for (int j2 = 0; j2 < 2; ++j2) *(u32x4*)(dst + (size_t)rows[r] * D + 512 * j2 + 8 * lane) = pack8(v[r] + 8 * j2); }
        ln_stats<LNR>(v, mean, rstd);
#pragma unroll
        for (int r = 0; r < LNR; ++r) if (ok[r]) { const int row = rows[r]; const bool smp = row >= MP; const int bidx = smp ? NB + ((row - MP) >> 2) : (row >> 12);
            const float* sh = modl + (size_t)bidx * 3072; const float* sc = sh + 1024;
            if (!smp && lane == 0) RC0[row] = (f32x4){rstd[r], 0.f, rstd[r], rstd[r] * mean[r]};
#pragma unroll
            for (int j2 = 0; j2 < 2; ++j2) { float o[8];
#pragma unroll
                for (int h = 0; h < 2; ++h) { const f32x4 a = *(const f32x4*)(sc + 512 * j2 + 8 * lane + 4 * h), bb = *(const f32x4*)(sh + 512 * j2 + 8 * lane + 4 * h);
#pragma unroll
                    for (int k = 0; k < 4; ++k) o[4 * h + k] = smp ? v[r][8 * j2 + 4 * h + k] * rstd[r] * (1.f + a[k]) + bb[k] : (v[r][8 * j2 + 4 * h + k] + mean[r]) * (1.f + a[k]); }
                *(u32x4*)(ZP + (size_t)row * D + 512 * j2 + 8 * lane) = pack8(o); } }
    }
}
DI void modv_unit(const Params& p, LAS unsigned char* lds, int unit, int tid, int lane, int wave) {
    const int l = unit / 40, cb = unit % 40, col = 64 * cb + lane;
    const float* W = p.w_in + (size_t)l * D * DIN + col; const float* modl = (const float*)(p.ws + WS_MOD) + (size_t)l * NMOD * 3072;
    LAS float* part = (LAS float*)lds;
    LAS float* cf = (LAS float*)(lds + 32768) + wave * 128 * 12;
    __syncthreads();
#pragma unroll
    for (int hlf = 0; hlf < 2; ++hlf) { const int ci = 64 * hlf + lane, c = wave * 128 + ci; LAS float* o = cf + ci * 12;
        o[0] = l > 0 ? p.ln_g[(l - 1) * D + c] : 1.f; o[1] = l > 0 ? p.ln_b[(l - 1) * D + c] : 0.f;
#pragma unroll
        for (int b = 0; b < 4; ++b) { o[2 + b] = 1.f + modl[b * 3072 + 1024 + c]; o[6 + b] = modl[b * 3072 + c]; } }
    asm volatile("s_waitcnt lgkmcnt(0)" ::: "memory");
    float acc[4][4];
#pragma unroll
    for (int b = 0; b < 4; ++b)
#pragma unroll
        for (int k = 0; k < 4; ++k) acc[b][k] = 0.f;
#pragma unroll 1
    for (int c0 = 0; c0 < 128; c0 += 32) { float wv[32];
#pragma unroll
        for (int i = 0; i < 32; ++i) wv[i] = W[(size_t)(wave * 128 + c0 + i) * DIN];
#pragma unroll
        for (int i = 0; i < 32; ++i) { const LAS f32x4* cp = (const LAS f32x4*)(cf + (c0 + i) * 12); const f32x4 q0 = cp[0], q1 = cp[1], q2 = cp[2];
            const float g = q0[0], bb = q0[1]; const float s1[4] = {q0[2], q0[3], q1[0], q1[1]}; const float sh[4] = {q1[2], q1[3], q2[0], q2[1]};
#pragma unroll
            for (int b = 0; b < 4; ++b) { const float sw = s1[b] * wv[i]; acc[b][0] += g * sw; acc[b][1] += bb * sw; acc[b][2] += sw; acc[b][3] += sh[b] * wv[i]; } } }
#pragma unroll
    for (int b = 0; b < 4; ++b)
#pragma unroll
        for (int k = 0; k < 4; ++k) part[(wave * 16 + b * 4 + k) * 64 + lane] = acc[b][k];
    __syncthreads();
    float* MODV = (float*)(p.ws + WS_MODV);
    for (int o = tid; o < 1024; o += NTHR) { const int idx = o >> 6, ln = o & 63; float sum = 0.f;
#pragma unroll
        for (int w = 0; w < 8; ++w) sum += part[(w * 16 + idx) * 64 + ln];
        MODV[((size_t)(l * NB + (idx >> 2)) * 4 + (idx & 3)) * DIN + perm_in(64 * cb + ln)] = sum; }
    __syncthreads();
}
DI void finalize_rc_in(const Params& p, int l, const int (&pms)[3], LAS float* rcl, int tid) {
    const int row = tid & 255;
    const int ua = tid >> 8, ub = 2;
    const bool hasA = pms[ua] >= 0 && pms[ua] < MP / 256, hasB = tid < 256 && pms[2] >= 0 && pms[2] < MP / 256;
    f32x4 ldA[6], ldB[6];
    const size_t rA = (size_t)(hasA ? pms[ua] : 0) * 256 + row, rB = (size_t)(hasB ? pms[2] : 0) * 256 + row;
    if (l == 0) { ldA[0] = ((const f32x4*)(p.ws + WS_RC0))[rA]; ldB[0] = ((const f32x4*)(p.ws + WS_RC0))[rB]; }
    else { const f32x4* psA = (const f32x4*)((const float*)(p.ws + WS_PS) + (size_t)((l - 1) & 1) * MP * 24 + rA * 24); const f32x4* psB = (const f32x4*)((const float*)(p.ws + WS_PS) + (size_t)((l - 1) & 1) * MP * 24 + rB * 24);
#pragma unroll
        for (int k = 0; k < 6; ++k) { ldA[k] = psA[k]; ldB[k] = psB[k]; } }
    auto fin = [&](const f32x4 (&ld)[6]) -> f32x4 {
        if (l == 0) return ld[0];
        const float* lnc = (const float*)(p.ws + WS_LNC) + (l - 1) * 8;
        float f[24];
#pragma unroll
        for (int k = 0; k < 6; ++k) { f[4 * k] = ld[k][0]; f[4 * k + 1] = ld[k][1]; f[4 * k + 2] = ld[k][2]; f[4 * k + 3] = ld[k][3]; }
        float S[6];
#pragma unroll
        for (int k = 0; k < 6; ++k) S[k] = (f[k] + f[6 + k]) + (f[12 + k] + f[18 + k]);
        float N1 = 1.f / D, two = 2.f; asm volatile("" : "+v"(N1), "+v"(two));
        const float mu = S[0] * N1, rstd = 1.f / sqrtf(S[1] * N1 - mu * mu + LN_EPS);
        const float m2 = (rstd * (S[2] - mu * lnc[0]) + lnc[3]) * N1;
        const float e2 = (rstd * rstd * (S[3] - two * mu * S[4] + mu * mu * lnc[1]) + two * rstd * (S[5] - mu * lnc[2]) + lnc[4]) * N1;
        const float rstd2 = 1.f / sqrtf(e2 - m2 * m2 + LN_EPS);
        return (f32x4){rstd * rstd2, rstd * rstd2 * mu, rstd2, rstd2 * m2}; };
    if (hasA) *(LAS f32x4*)(rcl + ua * 1024 + 4 * row) = fin(ldA);
    if (hasB) *(LAS f32x4*)(rcl + ub * 1024 + 4 * row) = fin(ldB);
}
DI void fin_phase(const Params& p, int gw, int NGW, int lane) {
    const u16* ZH = (const u16*)(p.ws + WS_ZH);
    const float* lg = p.ln_g + (size_t)(DEPTH - 1) * D; const float* lb = p.ln_b + (size_t)(DEPTH - 1) * D;
    for (int row0 = gw; row0 < MP; row0 += LNR * NGW) {
        float v[LNR][16]; bool ok[LNR]; float mean[LNR], rstd[LNR]; int rows[LNR];
#pragma unroll
        for (int r = 0; r < LNR; ++r) { rows[r] = row0 + r * NGW; ok[r] = rows[r] < MP; if (!ok[r]) rows[r] = row0; }
#pragma unroll
        for (int r = 0; r < LNR; ++r)
#pragma unroll
            for (int j2 = 0; j2 < 2; ++j2) unpack8(*(const u32x4*)(ZH + (size_t)rows[r] * D + 512 * j2 + 8 * lane), v[r] + 8 * j2);
        ln_stats<LNR>(v, mean, rstd);
#pragma unroll
        for (int j2 = 0; j2 < 2; ++j2)
#pragma unroll
            for (int h = 0; h < 2; ++h) { const f32x4 g = *(const f32x4*)(lg + 512 * j2 + 8 * lane + 4 * h), bb = *(const f32x4*)(lb + 512 * j2 + 8 * lane + 4 * h);
#pragma unroll
                for (int r = 0; r < LNR; ++r) if (ok[r]) { f32x4 o;
#pragma unroll
                    for (int k = 0; k < 4; ++k) o[k] = v[r][8 * j2 + 4 * h + k] * rstd[r] * g[k] + bb[k];
                    *(f32x4*)(p.out + (size_t)rows[r] * D + 512 * j2 + 8 * lane + 4 * h) = o; } }
    }
}

struct MixPtrs { const u16 *PA, *PSZC, *PPV, *PSZP, *PQ, *PSZA, *PK, *PV; u16* MIX; };
DI v4i16_t ds_tr(const LAS unsigned char* a) { return __builtin_amdgcn_ds_read_tr16_b64_v4i16((LAS v4i16_t*)a); }

DI void attn_prompt_unit(const Params& p, const MixPtrs& X, int l, int unit, LAS unsigned char* lds, int tid, int lane, int wave) {
    const int xg = unit >> 5, b = xg >> 1, hk = (unit >> 4) & 1, nb = (xg & 1) * 16 + (unit & 15), q0 = nb * 128; const size_t rb = (size_t)b * SEQ;
    LAS unsigned char* Ks = lds; LAS unsigned char* Vs = lds + 36864;
    const int g = wave & 3, qh = wave >> 2, head = 4 * hk + g, r = lane & 31, h = lane >> 5;
    u32x4 kvr[4], vvr[4];
#pragma unroll
    for (int i = 0; i < 4; ++i) { const int c = tid + 512 * i, key = c >> 3, ch = c & 7, tk = q0 - 128 + key, tkc = tk < 0 ? 0 : tk;
        kvr[i] = *(const u32x4*)(X.PK + (rb + tkc) * 128 + hk * 64 + ch * 8); vvr[i] = *(const u32x4*)(X.PV + (rb + tkc) * 128 + hk * 64 + ch * 8); }
    h8 qfA[4], qfB[4]; u32x2 zgA[2][4], zgB[2][4];
    { const size_t qr0 = rb + q0 + 64 * qh + r, qr1 = qr0 + 32;
#pragma unroll
      for (int s = 0; s < 4; ++s) { qfA[s] = *(const h8*)(X.PQ + qr0 * 512 + head * 64 + 16 * s + 8 * h); qfB[s] = *(const h8*)(X.PQ + qr1 * 512 + head * 64 + 16 * s + 8 * h); }
#pragma unroll
      for (int db = 0; db < 2; ++db)
#pragma unroll
          for (int xq = 0; xq < 4; ++xq) { const int col = head * 64 + 32 * db + 8 * xq + 4 * h; zgA[db][xq] = *(const u32x2*)(X.PSZA + qr0 * 512 + col); zgB[db][xq] = *(const u32x2*)(X.PSZA + qr1 * 512 + col); } }
#pragma unroll
    for (int i = 0; i < 4; ++i) { const int c = tid + 512 * i, key = c >> 3, ch = c & 7;
        *(LAS u32x4*)(Ks + key * 144 + ch * 16) = kvr[i]; *(LAS u32x4*)(Vs + (ch >> 2) * 16384 + key * 64 + (ch & 3) * 16) = vvr[i]; }
    __syncthreads();
    const float sink2 = p.sinks[l * 8 + head] * LOG2E;
    const int trq = (lane & 15) >> 2, trp = lane & 3, trg = (lane >> 4) & 1;
    const float NEG = -INFINITY;
    auto half = [&](const h8 (&qf)[4], const u32x2 (&zg)[2][4], const int e) {
        const int ql = 64 * qh + 32 * e; const size_t qrow = rb + q0 + ql + r;
        f32x16 S[5];
#pragma unroll
        for (int i = 0; i < 5; ++i) { const int kl = ql + 32 * i; const bool valid = (nb > 0) || (kl >= 128);
#pragma unroll
            for (int x = 0; x < 16; ++x) S[i][x] = 0.f;
            if (valid) {
#pragma unroll
                for (int s = 0; s < 4; ++s) { const h8 kf = *(const LAS h8*)(Ks + (kl + r) * 144 + (16 * s + 8 * h) * 2); S[i] = __builtin_amdgcn_mfma_f32_32x32x16_f16(kf, qf[s], S[i], 0, 0, 0); }
            } else {
#pragma unroll
                for (int x = 0; x < 16; ++x) S[i][x] = NEG; }
            if (i == 0) {
#pragma unroll
                for (int x = 0; x < 16; ++x) if (!(crow(x, h) > r)) S[i][x] = NEG; }
            if (i == 4) {
#pragma unroll
                for (int x = 0; x < 16; ++x) if (!(crow(x, h) <= r)) S[i][x] = NEG; }
        }
        float mx = sink2;
#pragma unroll
        for (int i = 0; i < 5; ++i)
#pragma unroll
            for (int x = 0; x < 16; ++x) mx = fmaxf(mx, S[i][x]);
        mx = max_halves(mx);
        float sum = 0.f;
#pragma unroll
        for (int i = 0; i < 5; ++i)
#pragma unroll
            for (int x = 0; x < 16; ++x) { S[i][x] = ex2(S[i][x] - mx); sum += S[i][x]; }
        sum = sum_halves(sum);
        const float inv = 1.f / (sum + ex2(sink2 - mx));
        f32x16 O[2];
#pragma unroll
        for (int x = 0; x < 16; ++x) { O[0][x] = 0.f; O[1][x] = 0.f; }
#pragma unroll
        for (int i = 0; i < 5; ++i) { const int kl = ql + 32 * i; const bool valid = (nb > 0) || (kl >= 128);
            if (valid) {
#pragma unroll
                for (int s2 = 0; s2 < 2; ++s2) { float pv8[8];
#pragma unroll
                    for (int j = 0; j < 8; ++j) pv8[j] = S[i][8 * s2 + j] * inv;
                    const h8 pa = __builtin_bit_cast(h8, pack8(pv8));
#pragma unroll
                    for (int db = 0; db < 2; ++db) { const LAS unsigned char* va = Vs + db * 16384 + (kl + 16 * s2 + 4 * h + trq) * 64 + trg * 32 + trp * 8;
                        const v4i16_t lo = ds_tr(va), hi = ds_tr(va + 512);
                        const h8 vf = __builtin_bit_cast(h8, __builtin_shufflevector(lo, hi, 0, 1, 2, 3, 4, 5, 6, 7));
                        O[db] = __builtin_amdgcn_mfma_f32_32x32x16_f16(vf, pa, O[db], 0, 0, 0); } } } }
#pragma unroll
        for (int db = 0; db < 2; ++db)
#pragma unroll
            for (int xq = 0; xq < 4; ++xq) { const int col = head * 64 + 32 * db + 8 * xq + 4 * h; const h4 z = __builtin_bit_cast(h4, zg[db][xq]);
                u32x2 w; w.x = pkh(O[db][4 * xq] * (float)z[0], O[db][4 * xq + 1] * (float)z[1]); w.y = pkh(O[db][4 * xq + 2] * (float)z[2], O[db][4 * xq + 3] * (float)z[3]);
                *(u32x2*)(X.MIX + qrow * D + 512 + col) = w; }
    };
    half(qfA, zgA, 0);
    half(qfB, zgB, 1);
    __syncthreads();
}

DI void conv_prompt_unit(const Params& p, const MixPtrs& X, int l, int unit, LAS unsigned char* lds, int tid, int lane, int wave) {
    const int R0 = unit * 64, b = R0 >> 12, t0 = R0 & (SEQ - 1); const size_t rb = (size_t)b * SEQ;
    LAS unsigned char* WL = lds + 94 * 512;
    u32x4 tv[6]; f32x4 wq[4];
#pragma unroll
    for (int i = 0; i < 6; ++i) { const int c = tid + 512 * i, cc = c < 94 * 32 ? c : 94 * 32 - 1, row = cc >> 5, ch = cc & 31, tk = t0 - 30 + row, tkc = tk < 0 ? 0 : tk;
        tv[i] = *(const u32x4*)(X.PA + (rb + tkc) * 256 + ch * 8); }
#pragma unroll
    for (int i = 0; i < 4; ++i) { const int c = tid + 512 * i, cc = c < 31 * 64 ? c : 31 * 64 - 1; wq[i] = *(const f32x4*)(p.conv_w + (size_t)l * 31 * 256 + 4 * cc); }
    const f32x4 bias = *(const f32x4*)(p.conv_b + l * 256 + 4 * lane), cg = *(const f32x4*)(p.cnorm_g + l * 256 + 4 * lane), cb = *(const f32x4*)(p.cnorm_b + l * 256 + 4 * lane);
    u32x2 zcv[8];
#pragma unroll
    for (int tt = 0; tt < 8; ++tt) zcv[tt] = *(const u32x2*)(X.PSZC + ((size_t)R0 + 8 * wave + tt) * 256 + 4 * lane);
#pragma unroll
    for (int i = 0; i < 6; ++i) { const int c = tid + 512 * i, row = c >> 5, ch = c & 31; const unsigned msk = (unsigned)-(int)(t0 - 30 + row >= 0);
        if (c < 94 * 32) *(LAS u32x4*)(lds + row * 512 + ch * 16) = (u32x4){tv[i][0] & msk, tv[i][1] & msk, tv[i][2] & msk, tv[i][3] & msk}; }
#pragma unroll
    for (int i = 0; i < 4; ++i) { const int c = tid + 512 * i; if (c < 31 * 64) *(LAS f32x4*)(WL + c * 16) = wq[i]; }
    __syncthreads();
    f32x4 acc[8], win[8];
#pragma unroll
    for (int tt = 0; tt < 8; ++tt) acc[tt] = bias;
    const LAS unsigned char* arow = lds + (8 * wave) * 512 + lane * 8;
#pragma unroll
    for (int k = 0; k < 7; ++k) win[k] = __builtin_convertvector(*(const LAS h4*)(arow + k * 512), f32x4);
#pragma unroll 1
    for (int jb = 0; jb < 4; ++jb) {
#pragma unroll
        for (int jj = 0; jj < 8; ++jj) { const int j = 8 * jb + jj;
            if (j < 31) {
                win[(jj + 7) & 7] = __builtin_convertvector(*(const LAS h4*)(arow + (j + 7) * 512), f32x4);
                const f32x4 w = *(const LAS f32x4*)(WL + j * 1024 + lane * 16);
#pragma unroll
                for (int tt = 0; tt < 8; ++tt) acc[tt] += w * win[(jj + tt) & 7]; } } }
#pragma unroll
    for (int tt = 0; tt < 8; ++tt) { const size_t row = (size_t)R0 + 8 * wave + tt;
        const float mean = wave_sum((acc[tt][0] + acc[tt][1]) + (acc[tt][2] + acc[tt][3])) * (1.f / 256.f);
        const f32x4 d = acc[tt] - mean;
        const float rstd = 1.f / sqrtf(wave_sum((d[0] * d[0] + d[1] * d[1]) + (d[2] * d[2] + d[3] * d[3])) * (1.f / 256.f) + LN_EPS);
        const h4 zc = __builtin_bit_cast(h4, zcv[tt]); float o[4];
#pragma unroll
        for (int k = 0; k < 4; ++k) o[k] = silu(d[k] * rstd * cg[k] + cb[k]) * (float)zc[k];
        u32x2 w; w.x = pkh(o[0], o[1]); w.y = pkh(o[2], o[3]);
        *(u32x2*)(X.MIX + row * D + 4 * lane) = w; }
    __syncthreads();
}

DI void pool_prompt_unit(const Params& p, const MixPtrs& X, int l, int unit, LAS unsigned char* lds, int tid, int lane, int wave) {
    const int R0 = unit * 64, b = R0 >> 12, t0 = R0 & (SEQ - 1); const size_t rb = (size_t)b * SEQ;
    LAS unsigned char* PL = lds + 79 * 512;
    for (int c = tid; c < 79 * 32; c += NTHR) { const int row = c >> 5, ch = c & 31, tk = t0 - 15 + row; u32x4 v = (u32x4){0u, 0u, 0u, 0u};
        if (tk >= 0) v = *(const u32x4*)(X.PPV + (rb + tk) * 256 + ch * 8);
        *(LAS u32x4*)(lds + row * 512 + ch * 16) = v; }
    __syncthreads();
    { const int wlen = 2 << (lane >> 4);
        const LAS unsigned char* prow = lds + (8 * wave + 15) * 512 + lane * 8;
        f32x4 sm[8];
#pragma unroll
        for (int tt = 0; tt < 8; ++tt) sm[tt] = (f32x4){0.f, 0.f, 0.f, 0.f};
#pragma unroll 1
        for (int i = 0; i < 16; ++i) { if (i < wlen) {
#pragma unroll
            for (int tt = 0; tt < 8; ++tt) sm[tt] += __builtin_convertvector(*(const LAS h4*)(prow + (tt - i) * 512), f32x4); } }
#pragma unroll
        for (int tt = 0; tt < 8; ++tt) {
            const int t = t0 + 8 * wave + tt; const float cnt = (float)(wlen < t + 1 ? wlen : t + 1);
            const f32x4 cur = __builtin_convertvector(*(const LAS h4*)(prow + tt * 512), f32x4);
            const f32x4 pl = sm[tt] * (1.f / cnt) - cur;
            u32x2 w; w.x = pkh(pl[0], pl[1]); w.y = pkh(pl[2], pl[3]);
            *(LAS u32x2*)(PL + (8 * wave + tt) * 528 + lane * 8) = w; } }
    __syncthreads();
    { const int g = wave & 3, th = wave >> 2, r = lane & 31, h = lane >> 5;
        const float* pw = p.pool_w + ((size_t)l * 4 + g) * 64 * 64 + r;
        f32x16 Dd[2];
#pragma unroll
        for (int x = 0; x < 16; ++x) { Dd[0][x] = 0.f; Dd[1][x] = 0.f; }
#pragma unroll 1
        for (int s = 0; s < 4; ++s) { const h8 bf = *(const LAS h8*)(PL + (32 * th + r) * 528 + (64 * g + 16 * s + 8 * h) * 2);
#pragma unroll
            for (int nb = 0; nb < 2; ++nb) { h8 af;
#pragma unroll
                for (int j = 0; j < 8; ++j) af[j] = (_Float16)pw[(size_t)(16 * s + 8 * h + j) * 64 + 32 * nb];
                Dd[nb] = __builtin_amdgcn_mfma_f32_32x32x16_f16(af, bf, Dd[nb], 0, 0, 0); } }
        const size_t row = (size_t)R0 + 32 * th + r;
#pragma unroll
        for (int nb = 0; nb < 2; ++nb)
#pragma unroll
            for (int xq = 0; xq < 4; ++xq) { const int col = 64 * g + 32 * nb + 8 * xq + 4 * h;
                const f32x4 ps = *(const f32x4*)(p.pool_scale + l * 256 + col); const h4 z = *(const h4*)(X.PSZP + row * 256 + col);
                u32x2 w; w.x = pkh(Dd[nb][4 * xq] * ps[0] * (float)z[0], Dd[nb][4 * xq + 1] * ps[1] * (float)z[1]); w.y = pkh(Dd[nb][4 * xq + 2] * ps[2] * (float)z[2], Dd[nb][4 * xq + 3] * ps[3] * (float)z[3]);
                *(u32x2*)(X.MIX + row * D + 256 + col) = w; } }
    __syncthreads();
}


constexpr int MX_WCV = 0;
constexpr int MX_WPT = 81920;
constexpr int MX_SCR = 0, MX_SCR_W = 7168;
constexpr int MX_TQ = RING_BYTES + 640;
DI void mix_stage_weights(const Params& p, int l, LAS unsigned char* lds, int tid) {
    for (int c = tid; c < 31 * 64; c += NTHR) *(LAS f32x4*)(lds + MX_WCV + c * 16) = *(const f32x4*)(p.conv_w + (size_t)l * 31 * 256 + 4 * c);
    for (int e = tid; e < 4 * 64 * 64; e += NTHR) { const int g = e >> 12, c = (e >> 6) & 63, n = e & 63;
        *(LAS _Float16*)(lds + MX_WPT + ((g * 64 + n) * 72 + c) * 2) = (_Float16)p.pool_w[(size_t)l * 16384 + e]; }
    if (tid == 0) *(LAS unsigned*)(lds + MX_TQ) = 0u;
}
DI void task_attn(const Params& p, int l, int b, int hk, int g, int tq0, int lane) {
    const int head = 4 * hk + g, r = lane & 31, h = lane >> 5; const size_t rb = (size_t)b * SEQ; const size_t qrow = rb + tq0 + r;
    const float sink2 = p.sinks[l * 8 + head] * LOG2E; const float NEG = -INFINITY;
    const u16* PQ = (const u16*)(p.ws + WS_PQ); const u16* PK = (const u16*)(p.ws + WS_PK);
    f32x16 S[5];
    {   h8 qf[4];
#pragma unroll
        for (int s = 0; s < 4; ++s) qf[s] = *(const h8*)(PQ + qrow * 512 + head * 64 + 16 * s + 8 * h);
        h8 kf[5][4];
#pragma unroll
        for (int i = 0; i < 5; ++i) { const int tk = tq0 - 128 + 32 * i, tkc = tk < 0 ? 0 : tk;
#pragma unroll
            for (int s = 0; s < 4; ++s) kf[i][s] = *(const h8*)(PK + (rb + tkc + r) * 128 + hk * 64 + 16 * s + 8 * h); }
#pragma unroll
        for (int i = 0; i < 5; ++i) { const int tk = tq0 - 128 + 32 * i;
#pragma unroll
            for (int x = 0; x < 16; ++x) S[i][x] = 0.f;
#pragma unroll
            for (int s = 0; s < 4; ++s) S[i] = __builtin_amdgcn_mfma_f32_32x32x16_f16(kf[i][s], qf[s], S[i], 0, 0, 0);
#pragma unroll
            for (int x = 0; x < 16; ++x) S[i][x] = tk >= 0 ? S[i][x] : NEG; } }
#pragma unroll
    for (int x = 0; x < 16; ++x) { if (!(crow(x, h) > r)) S[0][x] = NEG; if (!(crow(x, h) <= r)) S[4][x] = NEG; }
    float mx = sink2;
#pragma unroll
    for (int i = 0; i < 5; ++i)
#pragma unroll
        for (int x = 0; x < 16; ++x) mx = fmaxf(mx, S[i][x]);
    mx = max_halves(mx);
    float sum = 0.f;
#pragma unroll
    for (int i = 0; i < 5; ++i)
#pragma unroll
        for (int x = 0; x < 16; ++x) { S[i][x] = ex2(S[i][x] - mx); sum += S[i][x]; }
    sum = sum_halves(sum);
    const float inv = 1.f / (sum + ex2(sink2 - mx));
    u32x4 pa[5][2];
#pragma unroll
    for (int i = 0; i < 5; ++i)
#pragma unroll
        for (int s2 = 0; s2 < 2; ++s2) { float pv8[8];
#pragma unroll
            for (int j = 0; j < 8; ++j) pv8[j] = S[i][8 * s2 + j] * inv;
            pa[i][s2] = pack8(pv8); }
    int voff = ((b * 2 + hk) * 64 + r) * SEQ + (tq0 - 128) + 4 * h;
    asm volatile("" : "+v"(voff) : "v"(pa[0][0]), "v"(pa[0][1]), "v"(pa[1][0]), "v"(pa[1][1]), "v"(pa[2][0]), "v"(pa[2][1]), "v"(pa[3][0]), "v"(pa[3][1]), "v"(pa[4][0]), "v"(pa[4][1]));
    const u16* vtb = (const u16*)(p.ws + WS_VT) + voff;
    u32x2 vlo[5][2][2], vhi[5][2][2];
#pragma unroll
    for (int i = 0; i < 5; ++i) { const int tk = tq0 - 128 + 32 * i; const int adj = tk < 0 ? -tk : 0;
#pragma unroll
        for (int s2 = 0; s2 < 2; ++s2)
#pragma unroll
            for (int db = 0; db < 2; ++db) { const u16* vp = vtb + (size_t)db * 32 * SEQ + 32 * i + 16 * s2 + adj; vlo[i][s2][db] = *(const u32x2*)vp; vhi[i][s2][db] = *(const u32x2*)(vp + 8); } }
    f32x16 O[2];
#pragma unroll
    for (int x = 0; x < 16; ++x) { O[0][x] = 0.f; O[1][x] = 0.f; }
#pragma unroll
    for (int i = 0; i < 5; ++i)
#pragma unroll
        for (int s2 = 0; s2 < 2; ++s2)
#pragma unroll
            for (int db = 0; db < 2; ++db) { const u32x4 vv = {vlo[i][s2][db][0], vlo[i][s2][db][1], vhi[i][s2][db][0], vhi[i][s2][db][1]};
                O[db] = __builtin_amdgcn_mfma_f32_32x32x16_f16(__builtin_bit_cast(h8, vv), __builtin_bit_cast(h8, pa[i][s2]), O[db], 0, 0, 0); }
    const u16* PSZA = (const u16*)(p.ws + WS_PSZA); u16* MIX = (u16*)(p.ws + WS_MIX);
    u32x2 zg[2][4];
#pragma unroll
    for (int db = 0; db < 2; ++db)
#pragma unroll
        for (int xq = 0; xq < 4; ++xq) zg[db][xq] = *(const u32x2*)(PSZA + qrow * 512 + head * 64 + 32 * db + 8 * xq + 4 * h);
#pragma unroll
    for (int db = 0; db < 2; ++db)
#pragma unroll
        for (int xq = 0; xq < 4; ++xq) { const int col = head * 64 + 32 * db + 8 * xq + 4 * h; const h4 z = __builtin_bit_cast(h4, zg[db][xq]);
            u32x2 w; w.x = pkh(O[db][4 * xq] * (float)z[0], O[db][4 * xq + 1] * (float)z[1]); w.y = pkh(O[db][4 * xq + 2] * (float)z[2], O[db][4 * xq + 3] * (float)z[3]);
            *(u32x2*)(MIX + qrow * D + 512 + col) = w; }
}
constexpr int MX_X = 68608;
DI void conv_tile_dma(const Params& p, int R0, LAS unsigned char* lds, int wave, int lane) {
    const int b = R0 >> 12, t0 = R0 & (SEQ - 1);
    const unsigned char* PA = p.ws + WS_PA;
#pragma unroll
    for (int i = 0; i < 6; ++i) { const int piece = wave + 8 * i;
        if (piece < 47) { const int row = 2 * piece + (lane >> 5); int tk = t0 - 30 + row; tk = tk < 0 ? 0 : tk;
            __builtin_amdgcn_global_load_lds((const unsigned*)(PA + ((size_t)b * SEQ + tk) * 512 + (lane & 31) * 16), (LAS unsigned*)(lds + MX_X + piece * 1024), 16, 0, 0); } }
}
DI void task_conv(const Params& p, int l, int R0, int sub, LAS unsigned char* lds, int lane) {
    const int t0 = (R0 & (SEQ - 1)) + 8 * sub; const size_t rowb = (size_t)R0 + 8 * sub;
    const f32x4 bias = *(const f32x4*)(p.conv_b + l * 256 + 4 * lane), cg = *(const f32x4*)(p.cnorm_g + l * 256 + 4 * lane), cb = *(const f32x4*)(p.cnorm_b + l * 256 + 4 * lane);
    const LAS unsigned char* arow = lds + MX_X + (8 * sub) * 512 + lane * 8;
    const LAS unsigned char* wl = lds + MX_WCV + lane * 16;
    f32x4 acc[8], win[8];
#pragma unroll
    for (int tt = 0; tt < 8; ++tt) acc[tt] = bias;
#pragma unroll
    for (int k = 0; k < 7; ++k) { const f32x4 v = __builtin_convertvector(*(const LAS h4*)(arow + k * 512), f32x4); win[k] = (t0 - 30 + k >= 0) ? v : (f32x4){0.f, 0.f, 0.f, 0.f}; }
#pragma unroll 1
    for (int jb = 0; jb < 4; ++jb) {
#pragma unroll
        for (int jj = 0; jj < 8; ++jj) { const int j = 8 * jb + jj;
            if (j < 31) {
                const f32x4 v = __builtin_convertvector(*(const LAS h4*)(arow + (j + 7) * 512), f32x4);
                win[(jj + 7) & 7] = (t0 - 30 + j + 7 >= 0) ? v : (f32x4){0.f, 0.f, 0.f, 0.f};
                const f32x4 w = *(const LAS f32x4*)(wl + j * 1024);
#pragma unroll
                for (int tt = 0; tt < 8; ++tt) acc[tt] += w * win[(jj + tt) & 7]; } } }
    const u16* PSZC = (const u16*)(p.ws + WS_PSZC); u16* MIX = (u16*)(p.ws + WS_MIX);
#pragma unroll
    for (int tt = 0; tt < 8; ++tt) { const size_t row = rowb + tt;
        const float mean = wave_sum((acc[tt][0] + acc[tt][1]) + (acc[tt][2] + acc[tt][3])) * (1.f / 256.f);
        const f32x4 d = acc[tt] - mean;
        const float rstd = 1.f / sqrtf(wave_sum((d[0] * d[0] + d[1] * d[1]) + (d[2] * d[2] + d[3] * d[3])) * (1.f / 256.f) + LN_EPS);
        const h4 z = *(const h4*)(PSZC + row * 256 + 4 * lane); float o[4];
#pragma unroll
        for (int k = 0; k < 4; ++k) o[k] = silu(d[k] * rstd * cg[k] + cb[k]) * (float)z[k];
        u32x2 w; w.x = pkh(o[0], o[1]); w.y = pkh(o[2], o[3]);
        *(u32x2*)(MIX + row * D + 4 * lane) = w; }
}
DI void task_pool(const Params& p, int l, int R0, int th, int g, LAS unsigned char* lds, int wave, int lane) {
    const u16* PPV = (const u16*)(p.ws + WS_PPV); const u16* PSZP = (const u16*)(p.ws + WS_PSZP); u16* MIX = (u16*)(p.ws + WS_MIX);
    const int b = R0 >> 12, T0 = (R0 & (SEQ - 1)) + 32 * th; const size_t rb = (size_t)b * SEQ;
    LAS unsigned char* scr = lds + MX_SCR + wave * MX_SCR_W;
    const int r = lane & 31, h = lane >> 5;
    u32x4 tl[6];
#pragma unroll
    for (int i = 0; i < 6; ++i) { const int row = (lane >> 3) + 8 * i, tk = T0 - 15 + row; const int tkc = tk < 0 ? 0 : (row < 47 ? tk : T0 + 31);
        const u32x4 v = *(const u32x4*)(PPV + (rb + tkc) * 256 + 64 * g + 8 * (lane & 7)); const unsigned msk = (unsigned)-(int)(tk >= 0); tl[i] = (u32x4){v[0] & msk, v[1] & msk, v[2] & msk, v[3] & msk}; }
    const size_t orow = rb + T0 + r;
    u32x2 zp[2][4]; f32x4 ps[2][4];
#pragma unroll
    for (int nb = 0; nb < 2; ++nb)
#pragma unroll
        for (int xq = 0; xq < 4; ++xq) { const int col = 64 * g + 32 * nb + 8 * xq + 4 * h; zp[nb][xq] = *(const u32x2*)(PSZP + orow * 256 + col); ps[nb][xq] = *(const f32x4*)(p.pool_scale + l * 256 + col); }
#pragma unroll
    for (int i = 0; i < 6; ++i) { const int row = (lane >> 3) + 8 * i; if (row < 47) *(LAS u32x4*)(scr + row * 144 + (lane & 7) * 16) = tl[i]; }
    asm volatile("s_waitcnt lgkmcnt(0)" ::: "memory");
    const int wlen = 2 << g; const int t = T0 + r; const float icnt = 1.f / (float)(wlen < t + 1 ? wlen : t + 1);
    h8 bf[4];
#pragma unroll
    for (int s = 0; s < 4; ++s) { const LAS unsigned char* base = scr + (15 + r) * 144 + (16 * s + 8 * h) * 2; float sm[8];
        const h8 cur = *(const LAS h8*)base;
#pragma unroll
        for (int k = 0; k < 8; ++k) sm[k] = (float)cur[k];
        for (int i = 1; i < wlen; ++i) { const h8 v = *(const LAS h8*)(base - i * 144);
#pragma unroll
            for (int k = 0; k < 8; ++k) sm[k] += (float)v[k]; }
        float pl[8];
#pragma unroll
        for (int k = 0; k < 8; ++k) pl[k] = sm[k] * icnt - (float)cur[k];
        bf[s] = __builtin_bit_cast(h8, pack8(pl)); }
    f32x16 Dd[2];
#pragma unroll
    for (int x = 0; x < 16; ++x) { Dd[0][x] = 0.f; Dd[1][x] = 0.f; }
#pragma unroll
    for (int s = 0; s < 4; ++s)
#pragma unroll
        for (int nb = 0; nb < 2; ++nb) { const h8 af = *(const LAS h8*)(lds + MX_WPT + ((g * 64 + 32 * nb + r) * 72 + 16 * s + 8 * h) * 2);
            Dd[nb] = __builtin_amdgcn_mfma_f32_32x32x16_f16(af, bf[s], Dd[nb], 0, 0, 0); }
#pragma unroll
    for (int nb = 0; nb < 2; ++nb)
#pragma unroll
        for (int xq = 0; xq < 4; ++xq) { const int col = 64 * g + 32 * nb + 8 * xq + 4 * h; const h4 z = __builtin_bit_cast(h4, zp[nb][xq]); const f32x4 sc = ps[nb][xq];
            u32x2 w; w.x = pkh(Dd[nb][4 * xq] * sc[0] * (float)z[0], Dd[nb][4 * xq + 1] * sc[1] * (float)z[1]); w.y = pkh(Dd[nb][4 * xq + 2] * sc[2] * (float)z[2], Dd[nb][4 * xq + 3] * sc[3] * (float)z[3]);
            *(u32x2*)(MIX + orow * D + 256 + col) = w; }
}
DI void mix_prompt_tasks(const Params& p, int l, int unit, LAS unsigned char* lds, int lane, int wave) {
    int one = 1; asm volatile("" : "+s"(one));
    if (one) task_attn(p, l, unit >> 6, (unit >> 5) & 1, wave & 3, (unit & 31) * 128 + 32 * (wave >> 2), lane_id());
    asm volatile("" : "+s"(one) :: "memory");
    if (one) task_attn(p, l, unit >> 6, (unit >> 5) & 1, wave & 3, (unit & 31) * 128 + 32 * (2 + (wave >> 2)), lane_id());
    asm volatile("s_waitcnt vmcnt(0) lgkmcnt(0)\n\ts_barrier" : "+s"(one) :: "memory");
    if (one) task_conv(p, l, unit * 64, wave, lds, lane_id());
    asm volatile("s_waitcnt lgkmcnt(0)\n\ts_barrier" : "+s"(one) :: "memory");
    if (one) task_pool(p, l, unit * 64, wave >> 2, wave & 3, lds, wave, lane_id());
    (void)lane;
}

DI void convpool_sample_unit(const Params& p, const MixPtrs& X, int l, int b, int part, LAS unsigned char* lds, int tid, int lane, int wave) {
    LAS float* cv = (LAS float*)lds;
    const int c = tid & 255, tp = tid >> 8; const size_t r0 = (size_t)MP + 4 * b;
    if (part == 0) {
        const float* cc = p.cache_conv + (size_t)(l * DB + b) * 30 * 256;
        float xa[34], wv[31];
        { const float* pc = cc + c;
#pragma unroll
          for (int ri = 0; ri < 30; ++ri) xa[ri] = pc[ri * 256];
          const u16* pn = X.PA + r0 * 256 + c;
#pragma unroll
          for (int ri = 0; ri < 4; ++ri) xa[30 + ri] = (float)(*(const _Float16*)(pn + ri * 256));
          const float* pw = p.conv_w + (size_t)l * 31 * 256 + c;
#pragma unroll
          for (int j = 0; j < 31; ++j) wv[j] = pw[j * 256]; }
        float a0 = p.conv_b[l * 256 + c], a1 = a0;
        if (tp == 0) {
#pragma unroll
            for (int j = 0; j < 31; ++j) { a0 += wv[j] * xa[j]; a1 += wv[j] * xa[j + 1]; }
        } else {
#pragma unroll
            for (int j = 0; j < 31; ++j) { a0 += wv[j] * xa[j + 2]; a1 += wv[j] * xa[j + 3]; } }
        cv[(2 * tp) * 256 + c] = a0; cv[(2 * tp + 1) * 256 + c] = a1;
        { float* oc = p.out + OFF_CONVS + (size_t)(l * DB + b) * 30 * 256; for (int e = tid; e < 26 * 64; e += NTHR) *(f32x4*)(oc + 4 * e) = *(const f32x4*)(cc + 4 * 256 + 4 * e); }
        __syncthreads();
        if (wave < 4) { const int t = wave; const f32x4 v = *(const LAS f32x4*)(cv + t * 256 + 4 * lane);
            const float mean = wave_sum((v[0] + v[1]) + (v[2] + v[3])) * (1.f / 256.f); const f32x4 d = v - mean;
            const float rstd = 1.f / sqrtf(wave_sum((d[0] * d[0] + d[1] * d[1]) + (d[2] * d[2] + d[3] * d[3])) * (1.f / 256.f) + LN_EPS);
            const f32x4 cg = *(const f32x4*)(p.cnorm_g + l * 256 + 4 * lane), cb = *(const f32x4*)(p.cnorm_b + l * 256 + 4 * lane);
            const h4 zc = *(const h4*)(X.PSZC + (r0 + t) * 256 + 4 * lane); float o[4];
#pragma unroll
            for (int k = 0; k < 4; ++k) o[k] = silu(d[k] * rstd * cg[k] + cb[k]) * (float)zc[k];
            u32x2 w; w.x = pkh(o[0], o[1]); w.y = pkh(o[2], o[3]);
            *(u32x2*)(X.MIX + (r0 + t) * D + 4 * lane) = w; }
    } else {
        const float* cp = p.cache_pool + (size_t)(l * DB + b) * 15 * 256;
        float xa[19];
        { const float* pc = cp + c;
#pragma unroll
          for (int ri = 0; ri < 15; ++ri) xa[ri] = pc[ri * 256];
          const u16* pn = X.PPV + r0 * 256 + c;
#pragma unroll
          for (int ri = 0; ri < 4; ++ri) xa[15 + ri] = (float)(*(const _Float16*)(pn + ri * 256)); }
        const int wlen = 2 << (c >> 6); float s0 = 0.f, s1 = 0.f, c0, c1;
        if (tp == 0) { c0 = xa[15]; c1 = xa[16];
#pragma unroll
            for (int i = 0; i < 16; ++i) if (i < wlen) { s0 += xa[15 - i]; s1 += xa[16 - i]; }
        } else { c0 = xa[17]; c1 = xa[18];
#pragma unroll
            for (int i = 0; i < 16; ++i) if (i < wlen) { s0 += xa[17 - i]; s1 += xa[18 - i]; } }
        const float iw = 1.f / (float)wlen;
        cv[(2 * tp) * 256 + c] = s0 * iw - c0; cv[(2 * tp + 1) * 256 + c] = s1 * iw - c1;
        { float* op = p.out + OFF_POOLS + (size_t)(l * DB + b) * 15 * 256; for (int e = tid; e < 11 * 64; e += NTHR) *(f32x4*)(op + 4 * e) = *(const f32x4*)(cp + 4 * 256 + 4 * e); }
        __syncthreads();
        const int g = c >> 6, n = c & 63; const float* pw = p.pool_w + ((size_t)l * 4 + g) * 64 * 64 + n; float y0 = 0.f, y1 = 0.f;
#pragma unroll 16
        for (int k = 0; k < 64; ++k) { const float w = pw[(size_t)k * 64]; y0 += cv[(2 * tp) * 256 + 64 * g + k] * w; y1 += cv[(2 * tp + 1) * 256 + 64 * g + k] * w; }
        const float ps = p.pool_scale[l * 256 + c];
        const float z0 = (float)(*(const _Float16*)(X.PSZP + (r0 + 2 * tp) * 256 + c)), z1 = (float)(*(const _Float16*)(X.PSZP + (r0 + 2 * tp + 1) * 256 + c));
        *(_Float16*)(X.MIX + (r0 + 2 * tp) * D + 256 + c) = (_Float16)(y0 * ps * z0); *(_Float16*)(X.MIX + (r0 + 2 * tp + 1) * D + 256 + c) = (_Float16)(y1 * ps * z1); }
    __syncthreads();
}

DI void attn_sample_unit(const Params& p, const MixPtrs& X, int l, int unit, LAS unsigned char* lds, int tid, int lane, int wave) {
    const int b = unit >> 1, hk = unit & 1; const size_t r0 = (size_t)MP + 4 * b;
    LAS float* EX = (LAS float*)lds;
    LAS float* OP = EX + 256;
    const float* ck = p.cache_k + ((size_t)(l * DB + b) * 128 * 2 + hk) * 64; const float* cvv = p.cache_v + ((size_t)(l * DB + b) * 128 * 2 + hk) * 64;
    float* ok = p.out + OFF_KS + ((size_t)(l * DB + b) * 128 * 2 + hk) * 64; float* ov = p.out + OFF_VS + ((size_t)(l * DB + b) * 128 * 2 + hk) * 64;
    f32x4 ckv[4], cvw[4];
#pragma unroll
    for (int i = 0; i < 4; ++i) { const int e = tid + 512 * i, j = e >> 4, d4 = (e & 15) * 4; ckv[i] = *(const f32x4*)(ck + (size_t)j * 128 + d4); cvw[i] = *(const f32x4*)(cvv + (size_t)j * 128 + d4); }
    const int fr = lane & 15, fq = lane >> 4;
    f32x4 O[4]; f32x4 Sa = {0.f, 0.f, 0.f, 0.f}, Sb = {0.f, 0.f, 0.f, 0.f};
    float vg[4][8];
    const int kA = 32 * wave + fr, kB = kA + 16;
    if (wave < 5) {
        h8 ka[2], kb[2], qf[2];
#pragma unroll
        for (int ks = 0; ks < 2; ++ks) { const int d0 = 32 * ks + 8 * fq;
            qf[ks] = *(const h8*)(X.PQ + (r0 + (fr >> 2)) * 512 + (4 * hk + (fr & 3)) * 64 + d0);
            if (wave < 4) { const f32x4 a0 = *(const f32x4*)(ck + (size_t)kA * 128 + d0), a1 = *(const f32x4*)(ck + (size_t)kA * 128 + d0 + 4), b0 = *(const f32x4*)(ck + (size_t)kB * 128 + d0), b1 = *(const f32x4*)(ck + (size_t)kB * 128 + d0 + 4);
                float t8[8] = {a0[0], a0[1], a0[2], a0[3], a1[0], a1[1], a1[2], a1[3]}; ka[ks] = __builtin_bit_cast(h8, pack8(t8));
                float u8[8] = {b0[0], b0[1], b0[2], b0[3], b1[0], b1[1], b1[2], b1[3]}; kb[ks] = __builtin_bit_cast(h8, pack8(u8));
            } else { const int rr = fr < 4 ? fr : 0; const u32x4 raw = *(const u32x4*)(X.PK + (r0 + rr) * 128 + hk * 64 + d0); ka[ks] = __builtin_bit_cast(h8, fr < 4 ? raw : (u32x4){0u, 0u, 0u, 0u}); kb[ks] = __builtin_bit_cast(h8, (u32x4){0u, 0u, 0u, 0u}); } }
#pragma unroll
        for (int dt = 0; dt < 4; ++dt)
#pragma unroll
            for (int j = 0; j < 8; ++j) { const int key = 32 * wave + (j < 4 ? 0 : 16) + 4 * fq + (j & 3); const int d = 16 * dt + fr;
                if (wave < 4) vg[dt][j] = cvv[(size_t)key * 128 + d];
                else vg[dt][j] = key < 132 ? (float)(*(const _Float16*)(X.PV + (r0 + (key - 128)) * 128 + hk * 64 + d)) : 0.f; }
#pragma unroll
        for (int ks = 0; ks < 2; ++ks) { Sa = __builtin_amdgcn_mfma_f32_16x16x32_f16(ka[ks], qf[ks], Sa, 0, 0, 0); Sb = __builtin_amdgcn_mfma_f32_16x16x32_f16(kb[ks], qf[ks], Sb, 0, 0, 0); }
        const int t = fr >> 2; float mx = -INFINITY;
#pragma unroll
        for (int i = 0; i < 4; ++i) { const int k0 = 32 * wave + 4 * fq + i, k1 = k0 + 16;
            Sa[i] = (k0 >= t + 1 && k0 <= t + 128) ? Sa[i] : -INFINITY; Sb[i] = (k1 >= t + 1 && k1 <= t + 128) ? Sb[i] : -INFINITY; mx = fmaxf(mx, fmaxf(Sa[i], Sb[i])); }
        mx = fmaxf(mx, xor_lane<16>(mx)); mx = max_halves(mx);
        if (fq == 0) EX[wave * 16 + fr] = mx;
    }
#pragma unroll
    for (int i = 0; i < 4; ++i) { const int e = tid + 512 * i, j = e >> 4, d4 = (e & 15) * 4; if (j >= 4) { *(f32x4*)(ok + (size_t)(j - 4) * 128 + d4) = ckv[i]; *(f32x4*)(ov + (size_t)(j - 4) * 128 + d4) = cvw[i]; } }
    __syncthreads();
    if (wave < 5) {
        const float sink2 = p.sinks[l * 8 + 4 * hk + (fr & 3)] * LOG2E;
        float m = sink2;
#pragma unroll
        for (int w = 0; w < 5; ++w) m = fmaxf(m, EX[w * 16 + fr]);
        float sum = 0.f;
#pragma unroll
        for (int i = 0; i < 4; ++i) { Sa[i] = ex2(Sa[i] - m); Sb[i] = ex2(Sb[i] - m); sum += Sa[i] + Sb[i]; }
        sum += xor_lane<16>(sum); sum = sum_halves(sum);
        if (fq == 0) EX[128 + wave * 16 + fr] = sum;
        float p8[8] = {Sa[0], Sa[1], Sa[2], Sa[3], Sb[0], Sb[1], Sb[2], Sb[3]}; const h8 pb = __builtin_bit_cast(h8, pack8(p8));
#pragma unroll
        for (int dt = 0; dt < 4; ++dt) { const h8 va = __builtin_bit_cast(h8, pack8(vg[dt])); O[dt] = __builtin_amdgcn_mfma_f32_16x16x32_f16(va, pb, (f32x4){0.f, 0.f, 0.f, 0.f}, 0, 0, 0);
#pragma unroll
            for (int i = 0; i < 4; ++i) OP[(wave * 64 + 16 * dt + 4 * fq + i) * 16 + fr] = O[dt][i]; }
    }
    __syncthreads();
    { const int qr = tid & 15, dg = tid >> 4, t = qr >> 2, g = qr & 3;
        const float sink2 = p.sinks[l * 8 + 4 * hk + g] * LOG2E; float m = sink2, den = 0.f, o0 = 0.f, o1 = 0.f;
#pragma unroll
        for (int w = 0; w < 5; ++w) { m = fmaxf(m, EX[w * 16 + qr]); den += EX[128 + w * 16 + qr]; o0 += OP[(w * 64 + 2 * dg) * 16 + qr]; o1 += OP[(w * 64 + 2 * dg + 1) * 16 + qr]; }
        const float inv = 1.f / (den + ex2(sink2 - m));
        const int col = (4 * hk + g) * 64 + 2 * dg;
        const h2 z = *(const h2*)(X.PSZA + (r0 + t) * 512 + col);
        *(unsigned*)(X.MIX + (r0 + t) * D + 512 + col) = pkh(o0 * inv * (float)z[0], o1 * inv * (float)z[1]); }
    __syncthreads();
}

template <int R>
DI void sample_ln_rows(const Params& p, int l, int row0, int lane) {
    const u16* ZH = (const u16*)(p.ws + WS_ZH); u16* XR = (u16*)(p.ws + WS_XR); u16* ZP = (u16*)(p.ws + WS_H);
    const float* lg = p.ln_g + (size_t)l * D; const float* lb = p.ln_b + (size_t)l * D;
    const float* modn = (const float*)(p.ws + WS_MOD) + (size_t)(l + 1) * NMOD * 3072;
    float v[R][16], mean[R], rstd[R];
#pragma unroll
    for (int r = 0; r < R; ++r)
#pragma unroll
        for (int j2 = 0; j2 < 2; ++j2) unpack8(*(const u32x4*)(ZH + (size_t)(row0 + r) * D + 512 * j2 + 8 * lane), v[r] + 8 * j2);
    ln_stats<R>(v, mean, rstd);
#pragma unroll
    for (int j2 = 0; j2 < 2; ++j2)
#pragma unroll
        for (int h = 0; h < 2; ++h) { const f32x4 g = *(const f32x4*)(lg + 512 * j2 + 8 * lane + 4 * h), bb = *(const f32x4*)(lb + 512 * j2 + 8 * lane + 4 * h);
#pragma unroll
            for (int r = 0; r < R; ++r)
#pragma unroll
                for (int k = 0; k < 4; ++k) v[r][8 * j2 + 4 * h + k] = v[r][8 * j2 + 4 * h + k] * rstd[r] * g[k] + bb[k]; }
    if (l == DEPTH - 1) {
#pragma unroll
        for (int r = 0; r < R; ++r) { float* y = p.out + OFF_YS + (size_t)(row0 - MP + r) * D;
#pragma unroll
            for (int j2 = 0; j2 < 2; ++j2)
#pragma unroll
                for (int h = 0; h < 2; ++h) *(f32x4*)(y + 512 * j2 + 8 * lane + 4 * h) = (f32x4){v[r][8 * j2 + 4 * h], v[r][8 * j2 + 4 * h + 1], v[r][8 * j2 + 4 * h + 2], v[r][8 * j2 + 4 * h + 3]}; }
    } else {
#pragma unroll
        for (int r = 0; r < R; ++r)
#pragma unroll
            for (int j2 = 0; j2 < 2; ++j2) *(u32x4*)(XR + (size_t)(row0 + r) * D + 512 * j2 + 8 * lane) = pack8(v[r] + 8 * j2);
        ln_stats<R>(v, mean, rstd);
#pragma unroll
        for (int r = 0; r < R; ++r) { const int row = row0 + r; const float* sh = modn + (size_t)(NB + ((row - MP) >> 2)) * 3072; const float* sc = sh + 1024;
#pragma unroll
            for (int j2 = 0; j2 < 2; ++j2) { float o[8];
#pragma unroll
                for (int h = 0; h < 2; ++h) { const f32x4 a = *(const f32x4*)(sc + 512 * j2 + 8 * lane + 4 * h), bb = *(const f32x4*)(sh + 512 * j2 + 8 * lane + 4 * h);
#pragma unroll
                    for (int k = 0; k < 4; ++k) o[4 * h + k] = v[r][8 * j2 + 4 * h + k] * rstd[r] * (1.f + a[k]) + bb[k]; }
                *(u32x4*)(ZP + (size_t)row * D + 512 * j2 + 8 * lane) = pack8(o); } }
    }
}
DI void outproj_sample_unit(const Params& p, int l, int unit, LAS unsigned char* lds, int tid, int lane, int wave) {
    const int rbk0 = unit >> 5, cb = unit & 31, R0 = MP + 64 * rbk0, n0 = 32 * cb, r = lane & 31, h = lane >> 5;
    const u16* MIX = (const u16*)(p.ws + WS_MIX); const u16* WT = (const u16*)(p.ws + WS_WOUT) + (size_t)l * D * D;
    const u16* bp = WT + (size_t)perm_out(n0 + r) * D + wave * 128 + 8 * h;
    const u16* ap = MIX + (size_t)(R0 + r) * D + wave * 128 + 8 * h;
    f32x16 acc[2];
#pragma unroll
    for (int x = 0; x < 16; ++x) { acc[0][x] = 0.f; acc[1][x] = 0.f; }
#pragma unroll
    for (int s = 0; s < 8; ++s) { const h8 bf = *(const h8*)(bp + 16 * s);
#pragma unroll
        for (int rb = 0; rb < 2; ++rb) { const h8 af = *(const h8*)(ap + (size_t)rb * 32 * D + 16 * s); acc[rb] = __builtin_amdgcn_mfma_f32_32x32x16_f16(af, bf, acc[rb], 0, 0, 0); } }
    LAS float* part = (LAS float*)lds;
#pragma unroll
    for (int rb = 0; rb < 2; ++rb)
#pragma unroll
        for (int x = 0; x < 16; ++x) part[(wave * 64 + 32 * rb + crow(x, h)) * 32 + r] = acc[rb][x];
    __syncthreads();
    const float* modl = (const float*)(p.ws + WS_MOD) + (size_t)l * NMOD * 3072;
#pragma unroll
    for (int q = 0; q < 4; ++q) { const int o = tid + 512 * q, row = o >> 5, col = o & 31; float sum = 0.f;
#pragma unroll
        for (int w = 0; w < 8; ++w) sum += part[(w * 64 + row) * 32 + col];
        const int grow = R0 + row, bidx = NB + ((grow - MP) >> 2);
        const float xr = (float)(*(const _Float16*)((const u16*)(p.ws + WS_XR) + (size_t)grow * D + n0 + col));
        *(_Float16*)((u16*)(p.ws + WS_ZH) + (size_t)grow * D + n0 + col) = (_Float16)(ALPHA * xr + (1.f + modl[(size_t)bidx * 3072 + 2048 + n0 + col]) * sum); }
    asm volatile("s_waitcnt vmcnt(0)" ::: "memory");
    __syncthreads();
    if (wave == 0 && lane == 0) {
        __builtin_amdgcn_fence(__ATOMIC_RELEASE, "agent"); asm volatile("s_waitcnt vmcnt(0)" ::: "memory");
        (void)__hip_atomic_fetch_add((unsigned*)(p.ws + WS_CTL) + CW_SCNT + 64 * (l * 8 + rbk0), 1u, __ATOMIC_RELAXED, __HIP_MEMORY_SCOPE_AGENT); }
}
DI void outproj_sample_finish(const Params& p, int l, int unit, int lane, int wave) {
    if (wave != 0) return;
    unsigned* cnt = (unsigned*)(p.ws + WS_CTL) + CW_SCNT + 64 * (l * 8 + (unit >> 5));
    for (unsigned sp = 0; sp < (1u << 20); ++sp) { if (__hip_atomic_load(cnt, __ATOMIC_RELAXED, __HIP_MEMORY_SCOPE_AGENT) >= 32u) break; __builtin_amdgcn_s_sleep(2); }
    __builtin_amdgcn_fence(__ATOMIC_ACQUIRE, "agent"); asm volatile("s_waitcnt vmcnt(0)" ::: "memory");
    sample_ln_rows<2>(p, l, MP + 64 * (unit >> 5) + 2 * (unit & 31), lane);
}

constexpr int N_PHASES = 3 + 3 * DEPTH;
typedef const __attribute__((address_space(4))) Params* KParams;
#define PHASE_BEGIN() const int lane_ = lane_id(); const int lane = lane_, wave = wave_s, tid = wave_s * 64 + lane_; \
    KParams kq = kp; asm volatile("" : "+s"(kq)); Params p; { const ParamsHead hh_ = *(const __attribute__((address_space(4))) ParamsHead*)kq; __builtin_memcpy(&p, &hh_, sizeof(ParamsHead)); }     const int gw = vcu * NWAVES + wave, NGW = G * NWAVES; (void)lane; (void)gw; (void)NGW
#define MIXPTRS() MixPtrs X; X.PA = (const u16*)(p.ws + WS_PA); X.PSZC = (const u16*)(p.ws + WS_PSZC); X.PPV = (const u16*)(p.ws + WS_PPV); X.PSZP = (const u16*)(p.ws + WS_PSZP); \
    X.PQ = (const u16*)(p.ws + WS_PQ); X.PSZA = (const u16*)(p.ws + WS_PSZA); X.PK = (const u16*)(p.ws + WS_PK); X.PV = (const u16*)(p.ws + WS_PV); X.MIX = (u16*)(p.ws + WS_MIX)
__global__ void __launch_bounds__(NTHR, 2) hymba_fwd(Params p_unused) {
#if defined(__HIP_DEVICE_COMPILE__)
    extern __shared__ __attribute__((aligned(16))) unsigned char lds_raw[];
    LAS unsigned char* lds = (LAS unsigned char*)lds_raw;
    volatile LAS unsigned* MISC = (volatile LAS unsigned*)(lds + MISC_OFF);
    const KParams kp = (KParams)__builtin_amdgcn_kernarg_segment_ptr();
    const int G = gridDim.x, bx = blockIdx.x, vcu = (G % 8 == 0) ? (bx % 8) * (G / 8) + bx / 8 : bx;
    const int wave_s = __builtin_amdgcn_readfirstlane((int)threadIdx.x >> 6);
    for (int u = threadIdx.x; u < (LDS_BYTES - RING_BYTES) / 4; u += NTHR) ((LAS unsigned*)(lds + RING_BYTES))[u] = 0u;
    __syncthreads();
    unsigned* ctl = (unsigned*)(kp->ws + WS_CTL);
    XcdBarrier bar; bar.bar = ctl + CW_BAR; bar.x = 0; bar.st = nullptr;
    if (MK_N_LAUNCHES == 1) bar = xcd_barrier_post(ctl + CW_BAR, MISC + 8);
    const int lo = kp->ph_lo, hi = kp->ph_hi;
#ifndef ONLY
#define ONLY -1
#endif
#ifndef ONLYMASK
#define ONLYMASK 0x3f
#endif
#define EN(t) ((ONLY < 0 || ONLY == (t)) && ((ONLYMASK >> (t)) & 1))
#define IN(k) (lo <= (k) && (k) < hi)
#define SEAM(k) do { if (MK_N_LAUNCHES == 1 && IN((k) + 1)) xcd_barrier(bar, wave_s); } while (0)
    if (EN(0) && IN(0)) { { PHASE_BEGIN(); p0_prologue(p, (const __attribute__((address_space(4))) float*)((const __attribute__((address_space(4))) char*)kq + __builtin_offsetof(Params, inv_freq)), lds, vcu, G, tid, lane, wave); } SEAM(0); }
    if (EN(1) && IN(1)) { { PHASE_BEGIN(); for (int u = vcu; u < 40; u += G) modv_unit(p, lds, u, tid, lane, wave); pre_phase(p, gw, NGW, lane); } SEAM(1); }
#pragma unroll 1
    for (int l = 0; l < DEPTH; ++l) {
        const int ph = 2 + 3 * l;
        if (EN(2) && IN(ph)) {
            { PHASE_BEGIN();
            pg8::Gemm g{(const u16*)(p.ws + WS_H), (const u16*)(p.ws + WS_WIN) + (size_t)l * DIN * D, M, DIN, D};
            pg8::StaticOrder S; S.init(M, DIN, G, bx);
            LAS float* rcl = (LAS float*)(lds + RING_BYTES + 1024);
            { int pms[3]; for (int i = 0; i < 3; ++i) { pg8::Unit u; pms[i] = S.next(i, u) ? u.pm : -1; } finalize_rc_in(p, l, pms, rcl, tid); }
            asm volatile("s_waitcnt lgkmcnt(0)" ::: "memory"); __syncthreads();
            EpiIn E{l, p.ws, p.out, rcl};
            pg8::gemm_phase<EpiIn, true>(lds, g, S, E, tid); }
            { const int fi = M / 256 * (DIN / 256) - 2 * G; const bool split = fi > 0 && fi < G;
              if (l + 1 < DEPTH && (!split || bx >= fi)) { PHASE_BEGIN(); const int ii = split ? bx - fi : vcu, ni = split ? G - fi : G;
                  transpose_layer(p, l + 1, lds, ii * NWAVES + wave, ni * NWAVES, lane, wave);
                  for (int u = ni - 1 - ii; u < 40; u += ni) modv_unit(p, lds, 40 * (l + 1) + u, tid, lane, wave); } }
            SEAM(ph);
        }
        if (EN(3) && IN(ph + 1)) {
            { PHASE_BEGIN(); MIXPTRS(); for (int u = vcu; u < 256; u += G) attn_prompt_unit(p, X, l, u, lds, tid, lane, wave); }
            { PHASE_BEGIN(); MIXPTRS(); for (int u = vcu; u < 256; u += G) conv_prompt_unit(p, X, l, u, lds, tid, lane, wave); }
            { PHASE_BEGIN(); for (int e = tid; e < 4 * 64 * 8; e += NTHR) { const int g = e >> 9, c = (e >> 3) & 63, n8 = (e & 7) * 8;
                  const f32x4 w0 = *(const f32x4*)(p.pool_w + (size_t)l * 16384 + (g * 64 + c) * 64 + n8), w1 = *(const f32x4*)(p.pool_w + (size_t)l * 16384 + (g * 64 + c) * 64 + n8 + 4);
#pragma unroll
                  for (int k = 0; k < 4; ++k) { *(LAS _Float16*)(lds + MX_WPT + ((g * 64 + n8 + k) * 72 + c) * 2) = (_Float16)w0[k]; *(LAS _Float16*)(lds + MX_WPT + ((g * 64 + n8 + 4 + k) * 72 + c) * 2) = (_Float16)w1[k]; } }
              asm volatile("s_waitcnt lgkmcnt(0)" ::: "memory"); __syncthreads(); }
            { PHASE_BEGIN(); for (int u = vcu; u < 256; u += G) { task_pool(p, l, u * 64, wave >> 2, (wave >> 2) ? 3 - (wave & 3) : (wave & 3), lds, wave, lane); __syncthreads(); } }
            { PHASE_BEGIN(); MIXPTRS(); for (int u = vcu; u < 256; u += G) attn_sample_unit(p, X, l, u, lds, tid, lane, wave); }
            { PHASE_BEGIN(); MIXPTRS(); for (int u = vcu; u < 2 * DB; u += G) convpool_sample_unit(p, X, l, u >> 1, u & 1, lds, tid, lane, wave); }
            SEAM(ph + 1); }
        if (EN(4) && IN(ph + 2)) {
            { PHASE_BEGIN();
            pg8::Gemm g{(const u16*)(p.ws + WS_MIX), (const u16*)(p.ws + WS_WOUT) + (size_t)l * D * D, M, D, D};
            for (int u = vcu; u < 256; u += G) outproj_sample_unit(p, l, u, lds, tid, lane, wave);
            __syncthreads();
            pg8::StaticOrder S; S.init(MP, D, G, bx);
            EpiOutF E{p.ws, l, p.ln_g, p.ln_b};
            pg8::gemm_phase<EpiOutF, false>(lds, g, S, E, tid);
            for (int u = vcu; u < 256; u += G) outproj_sample_finish(p, l, u, lane, wave); }
            SEAM(ph + 2);
        }
    }
    if (EN(5) && IN(N_PHASES - 1)) { PHASE_BEGIN(); fin_phase(p, gw, NGW, lane); }
#undef IN
#undef SEAM
#endif
}


#ifdef DBG
constexpr int DBG_NS = 56;
constexpr size_t WS_DBGACC = 32 * 1024;
constexpr size_t WS_DBGZ = WS_END;
__constant__ int dbg_rows_tab[DBG_NS] = {0, 1, 2, 3, 14, 15, 16, 29, 30, 31, 32, 63, 64, 65, 127, 128, 129, 255, 256, 1000, 2047, 2048, 3967, 3968, 4065, 4066, 4080, 4081, 4094, 4095, 4096, 4097, 4127, 4224,
                            8191, 8192, 8320, 12288, 12415, 16382, 16383, 16384, 16385, 16386, 16387, 16388, 16391, 16639, 16640, 16892, 16893, 16894, 16895, 5000, 9999, 15000};
__device__ int dbg_row(int i) { return dbg_rows_tab[i]; }
__device__ void dbg_acc(float* accf, int id, float e, float r) {
    __shared__ float se[256], sr[256];
    const int t = threadIdx.x; se[t] = e; sr[t] = r; __syncthreads();
    for (int o = 128; o > 0; o >>= 1) { if (t < o) { se[t] += se[t + o]; sr[t] += sr[t + o]; } __syncthreads(); }
    if (t == 0) { atomicAdd(accf + 2 * id, se[0]); atomicAdd(accf + 2 * id + 1, sr[0]); }
    __syncthreads();
}
__device__ float dbg_h(const u16* p, size_t i) { return (float)(*(const _Float16*)(p + i)); }
__device__ float dbg_block_sum(float v) { __shared__ float sb[256]; const int t = threadIdx.x; sb[t] = v; __syncthreads(); for (int o = 128; o > 0; o >>= 1) { if (t < o) sb[t] += sb[t + o]; __syncthreads(); } const float r = sb[0]; __syncthreads(); return r; }
__device__ void dbg_ln4(float (&x)[4], float& rstd) { const float mean = dbg_block_sum(x[0] + x[1] + x[2] + x[3]) / D; float q = 0; for (int i = 0; i < 4; ++i) { x[i] -= mean; q += x[i] * x[i]; } rstd = 1.f / sqrtf(dbg_block_sum(q) / D + LN_EPS); }
#define DBG_E(fast, ref) do { const float f_ = (fast), r_ = (ref); e += (f_ - r_) * (f_ - r_); rr += r_ * r_; } while (0)
__global__ void __launch_bounds__(256) dbg_p0(Params p) {
    float* accf = (float*)(p.ws + WS_DBGACC); const int t = threadIdx.x, bid = blockIdx.x;
    { float e = 0, rr = 0; const int ri = (bid >> 2) % 9;
        const int l = bid & 3, row = ri < 6 ? ri : (ri == 6 ? 67 : 123 + ri);
        const float* c = row < NB ? p.c_prompt + (size_t)row * D : p.c_sample + (size_t)(row - NB) * D;
        for (int n = t * 12 + (bid % 12); n < 3072; n += 256 * 12) { float a = p.b_mod[l * 3072 + n];
            for (int k = 0; k < D; ++k) { const float x = c[k]; a += x / (1.f + expf(-x)) * p.w_mod[((size_t)l * D + k) * 3072 + n]; }
            DBG_E(((const float*)(p.ws + WS_MOD))[((size_t)l * NMOD + row) * 3072 + n], a); }
        dbg_acc(accf, 0, e, rr); }
    { float e = 0, rr = 0;
        for (int i = 0; i < 64; ++i) { const int l = bid & 3, col = (bid * 37 + i * 41 + t * 10) % DIN, k = (t * 4 + i * 16 + bid) % D;
            DBG_E(dbg_h((const u16*)(p.ws + WS_WIN), ((size_t)l * DIN + perm_in(col)) * D + k), p.w_in[((size_t)l * D + k) * DIN + col]); }
        dbg_acc(accf, 1, e, rr); }
    { float e = 0, rr = 0;
        for (int i = 0; i < 64; ++i) { const int l = bid & 3, col = (bid * 37 + i * 41 + t * 4) % D, k = (t * 4 + i * 16 + bid) % D;
            DBG_E(dbg_h((const u16*)(p.ws + WS_WOUT), ((size_t)l * D + perm_out(col)) * D + k), p.w_out[((size_t)l * D + k) * D + col]); }
        dbg_acc(accf, 2, e, rr); }
    { float e = 0, rr = 0;
        for (int i = 0; i < 16; ++i) { const int pi = (bid * 113 + i * 257 + t * 16) % (SEQ + DS), f = (t + i) & 31; const int pos = pi < SEQ ? pi : PAST + pi - SEQ;
            const float ang = (float)pos * p.inv_freq[f]; const f32x2 cs = ((const f32x2*)(p.ws + WS_TAB))[pi * 32 + f];
            DBG_E(cs[0], cosf(ang)); DBG_E(cs[1], sinf(ang)); }
        dbg_acc(accf, 3, e, rr); }
}
__global__ void __launch_bounds__(256) dbg_p0b(Params p) {
    float* accf = (float*)(p.ws + WS_DBGACC); const int t = threadIdx.x, bid = blockIdx.x;
    { float e = 0, rr = 0;
        const int l = bid & 3, b = (bid >> 2) & 3; const float* md = (const float*)(p.ws + WS_MOD) + ((size_t)l * NMOD + b) * 3072;
        const int col = (t * 10 + (bid >> 4) * 3 + 1) % DIN; float v1 = 0, v2 = 0, v3 = 0, v4 = 0;
        for (int c = 0; c < D; ++c) { const float w = p.w_in[((size_t)l * D + c) * DIN + col], g = l > 0 ? p.ln_g[(l - 1) * D + c] : 1.f, bb = l > 0 ? p.ln_b[(l - 1) * D + c] : 0.f, s1 = 1.f + md[1024 + c];
            v1 += g * s1 * w; v2 += bb * s1 * w; v3 += s1 * w; v4 += md[c] * w; }
        const float* mv = (const float*)(p.ws + WS_MODV) + (size_t)(l * NB + b) * 4 * DIN + perm_in(col);
        DBG_E(mv[0], v1); DBG_E(mv[2 * DIN], v3); DBG_E(mv[3 * DIN], v4); if (l > 0) DBG_E(mv[DIN], v2); else e += mv[DIN] * mv[DIN];
        dbg_acc(accf, 69, e, rr); }
    if (bid < DBG_NS) { const int row = dbg_row(bid); const bool smp = row >= MP; const int bidx = smp ? NB + ((row - MP) >> 2) : (row >> 12);
        const float* md = (const float*)(p.ws + WS_MOD) + (size_t)bidx * 3072;
        float x[4]; for (int i = 0; i < 4; ++i) { const int c = t + 256 * i; x[i] = smp ? p.x_sample[(size_t)(row - MP) * D + c] : p.x_prompt[(size_t)row * D + c]; }
        float e = 0, rr = 0; for (int i = 0; i < 4; ++i) DBG_E(dbg_h((const u16*)(p.ws + (smp ? WS_XR : WS_ZH)), (size_t)row * D + t + 256 * i), x[i]); dbg_acc(accf, 70, e, rr);
        e = 0; rr = 0;
        if (!smp) { for (int i = 0; i < 4; ++i) { const int c = t + 256 * i; DBG_E(dbg_h((const u16*)(p.ws + WS_H), (size_t)row * D + c), x[i] * (1.f + md[1024 + c])); } }
        else { float rstd; dbg_ln4(x, rstd); for (int i = 0; i < 4; ++i) { const int c = t + 256 * i; DBG_E(dbg_h((const u16*)(p.ws + WS_H), (size_t)row * D + c), x[i] * rstd * (1.f + md[1024 + c]) + md[c]); } }
        dbg_acc(accf, 71, e, rr); }
}
__global__ void __launch_bounds__(256) dbg_copyz(Params p) { const int row = dbg_row(blockIdx.x);
    for (int c = threadIdx.x; c < D; c += 256) { ((u16*)(p.ws + WS_DBGZ))[blockIdx.x * D + c] = ((const u16*)(p.ws + WS_ZH))[(size_t)row * D + c]; ((u16*)(p.ws + WS_DBGZ))[(DBG_NS + blockIdx.x) * D + c] = ((const u16*)(p.ws + WS_XR))[(size_t)row * D + c]; } }
__global__ void __launch_bounds__(256) dbg_in(Params p, int l) {
    __shared__ float pr[DIN]; __shared__ float hh[D];
    float* accf = (float*)(p.ws + WS_DBGACC); const int t = threadIdx.x, row = dbg_row(blockIdx.x), base = 4 + 16 * l;
    const bool smp = row >= MP; const int b = smp ? (row - MP) >> 2 : row >> 12, tt = smp ? (row - MP) & 3 : row & (SEQ - 1), pos = smp ? PAST + tt : tt;
    const int bidx = smp ? NB + b : b; const float* md = (const float*)(p.ws + WS_MOD) + ((size_t)l * NMOD + bidx) * 3072;
    float e, rr;
    { float x[4]; float rstd;
        for (int i = 0; i < 4; ++i) x[i] = dbg_h((const u16*)(p.ws + (smp ? WS_XR : WS_ZH)), (size_t)row * D + t + 256 * i);
        if (!smp && l > 0) { dbg_ln4(x, rstd); for (int i = 0; i < 4; ++i) { const int c = t + 256 * i; x[i] = x[i] * rstd * p.ln_g[(l - 1) * D + c] + p.ln_b[(l - 1) * D + c]; } }
        dbg_ln4(x, rstd);
        for (int i = 0; i < 4; ++i) { const int c = t + 256 * i; hh[c] = x[i] * rstd * (1.f + md[1024 + c]) + md[c]; }
        __syncthreads();
        if (smp) { e = 0; rr = 0; for (int i = 0; i < 4; ++i) { const int c = t + 256 * i; DBG_E(dbg_h((const u16*)(p.ws + WS_H), (size_t)row * D + c), hh[c]); } dbg_acc(accf, base + 1, e, rr); } }
    for (int i = 0; i < 10; ++i) { const int col = t + 256 * i; float a = 0; for (int k = 0; k < D; ++k) a += hh[k] * p.w_in[((size_t)l * D + k) * DIN + col]; pr[col] = a; }
    __syncthreads();
    const float av = pr[t] / (1.f + expf(-pr[256 + t]));
    e = 0; rr = 0; DBG_E(dbg_h((const u16*)(p.ws + WS_PA), (size_t)row * 256 + t), av); dbg_acc(accf, base + 2, e, rr);
    e = 0; rr = 0; { const float z = pr[512 + t]; DBG_E(dbg_h((const u16*)(p.ws + WS_PSZC), (size_t)row * 256 + t), z / (1.f + expf(-z))); } dbg_acc(accf, base + 3, e, rr);
    e = 0; rr = 0; DBG_E(dbg_h((const u16*)(p.ws + WS_PPV), (size_t)row * 256 + t), pr[768 + t]); dbg_acc(accf, base + 4, e, rr);
    e = 0; rr = 0; { const float z = pr[1024 + t]; DBG_E(dbg_h((const u16*)(p.ws + WS_PSZP), (size_t)row * 256 + t), z / (1.f + expf(-z))); } dbg_acc(accf, base + 5, e, rr);
    e = 0; rr = 0;
    for (int i = 0; i < 2; ++i) { const int c = t + 256 * i, hd = c >> 6, d = c & 63, f = d & 31; const float ang = (float)pos * p.inv_freq[f], cs = cosf(ang), sn = sinf(ang);
        const float x = pr[1280 + c], xo = d < 32 ? -pr[1280 + hd * 64 + d + 32] : pr[1280 + hd * 64 + d - 32];
        DBG_E(dbg_h((const u16*)(p.ws + WS_PQ), (size_t)row * 512 + c), (x * cs + xo * sn) * QSCALE); }
    dbg_acc(accf, base + 6, e, rr);
    e = 0; rr = 0; float kref = 0.f, vref = 0.f;
    if (t < 128) { const int hd = t >> 6, d = t & 63, f = d & 31; const float ang = (float)pos * p.inv_freq[f], cs = cosf(ang), sn = sinf(ang);
        const float x = pr[1792 + t], xo = d < 32 ? -pr[1792 + hd * 64 + d + 32] : pr[1792 + hd * 64 + d - 32]; kref = x * cs + xo * sn;
        DBG_E(dbg_h((const u16*)(p.ws + WS_PK), (size_t)row * 128 + t), kref); }
    dbg_acc(accf, base + 7, e, rr);
    e = 0; rr = 0; if (t < 128) { vref = pr[1920 + t]; DBG_E(dbg_h((const u16*)(p.ws + WS_PV), (size_t)row * 128 + t), vref); } dbg_acc(accf, base + 8, e, rr);
    e = 0; rr = 0; for (int i = 0; i < 2; ++i) { const float z = pr[2048 + t + 256 * i]; DBG_E(dbg_h((const u16*)(p.ws + WS_PSZA), (size_t)row * 512 + t + 256 * i), z / (1.f + expf(-z))); } dbg_acc(accf, base + 9, e, rr);
    e = 0; rr = 0;
    if (smp) { DBG_E(p.out[OFF_CONVS + ((size_t)(l * DB + b) * 30 + 26 + tt) * 256 + t], av); DBG_E(p.out[OFF_POOLS + ((size_t)(l * DB + b) * 15 + 11 + tt) * 256 + t], pr[768 + t]);
        if (t < 128) { DBG_E(p.out[OFF_KS + ((size_t)(l * DB + b) * 128 + 124 + tt) * 128 + t], kref); DBG_E(p.out[OFF_VS + ((size_t)(l * DB + b) * 128 + 124 + tt) * 128 + t], vref); } }
    else { if (tt >= SEQ - 30) DBG_E(p.out[OFF_CONVP + ((size_t)(l * NB + b) * 30 + tt - (SEQ - 30)) * 256 + t], av);
        if (tt >= SEQ - 15) DBG_E(p.out[OFF_POOLP + ((size_t)(l * NB + b) * 15 + tt - (SEQ - 15)) * 256 + t], pr[768 + t]);
        if (tt >= SEQ - 128 && t < 128) { DBG_E(p.out[OFF_KP + ((size_t)(l * NB + b) * 128 + tt - (SEQ - 128)) * 128 + t], kref); DBG_E(p.out[OFF_VP + ((size_t)(l * NB + b) * 128 + tt - (SEQ - 128)) * 128 + t], vref); } }
    dbg_acc(accf, base + 10, e, rr);
}
__global__ void __launch_bounds__(256) dbg_mix(Params p, int l) {
    __shared__ float sh[1024]; __shared__ float sc[136];
    float* accf = (float*)(p.ws + WS_DBGACC); const int t = threadIdx.x, row = dbg_row(blockIdx.x), base = 4 + 16 * l;
    const bool smp = row >= MP; const int b = smp ? (row - MP) >> 2 : row >> 12, tt = smp ? (row - MP) & 3 : row & (SEQ - 1);
    const u16 *PA = (const u16*)(p.ws + WS_PA), *PSZC = (const u16*)(p.ws + WS_PSZC), *PPV = (const u16*)(p.ws + WS_PPV), *PSZP = (const u16*)(p.ws + WS_PSZP), *PQ = (const u16*)(p.ws + WS_PQ),
              *PSZA = (const u16*)(p.ws + WS_PSZA), *PK = (const u16*)(p.ws + WS_PK), *PV = (const u16*)(p.ws + WS_PV), *MIX = (const u16*)(p.ws + WS_MIX);
    float e, rr;
    {
        float a = p.conv_b[l * 256 + t];
        for (int j = 0; j < 31; ++j) { float x;
            if (!smp) { const int ts = tt - 30 + j; x = ts >= 0 ? dbg_h(PA, ((size_t)b * SEQ + ts) * 256 + t) : 0.f; }
            else { const int ri = tt + j; x = ri < 30 ? p.cache_conv[((size_t)(l * DB + b) * 30 + ri) * 256 + t] : dbg_h(PA, ((size_t)MP + 4 * b + ri - 30) * 256 + t); }
            a += p.conv_w[((size_t)l * 31 + j) * 256 + t] * x; }
        const float mean = dbg_block_sum(a) / 256.f; const float d = a - mean; const float rstd = 1.f / sqrtf(dbg_block_sum(d * d) / 256.f + LN_EPS);
        const float y = d * rstd * p.cnorm_g[l * 256 + t] + p.cnorm_b[l * 256 + t];
        e = 0; rr = 0; DBG_E(dbg_h(MIX, (size_t)row * D + t), y / (1.f + expf(-y)) * dbg_h(PSZC, (size_t)row * 256 + t)); dbg_acc(accf, base + 11, e, rr); }
    {
        const int w = 2 << (t >> 6); float s = 0;
        for (int i = 0; i < w; ++i) { float x;
            if (!smp) { const int ts = tt - i; x = ts >= 0 ? dbg_h(PPV, ((size_t)b * SEQ + ts) * 256 + t) : 0.f; }
            else { const int ri = 15 + tt - i; x = ri < 15 ? p.cache_pool[((size_t)(l * DB + b) * 15 + ri) * 256 + t] : dbg_h(PPV, ((size_t)MP + 4 * b + ri - 15) * 256 + t); }
            s += x; }
        const float cnt = smp ? (float)w : (float)(w < tt + 1 ? w : tt + 1);
        sh[t] = s / cnt - dbg_h(PPV, (size_t)row * 256 + t); __syncthreads();
        const int g = t >> 6, n = t & 63; float y = 0; for (int c = 0; c < 64; ++c) y += sh[64 * g + c] * p.pool_w[(((size_t)l * 4 + g) * 64 + c) * 64 + n];
        e = 0; rr = 0; DBG_E(dbg_h(MIX, (size_t)row * D + 256 + t), y * p.pool_scale[l * 256 + t] * dbg_h(PSZP, (size_t)row * 256 + t)); dbg_acc(accf, base + 12, e, rr); __syncthreads(); }
    {
        e = 0; rr = 0;
        for (int hd = 0; hd < 8; ++hd) { const int hk = hd >> 2; __syncthreads();
            if (t < 64) sh[t] = dbg_h(PQ, (size_t)row * 512 + hd * 64 + t); __syncthreads();
            const float sink2 = p.sinks[l * 8 + hd] * LOG2E;
            if (t < 128) { float s = -INFINITY;
                if (!smp) { const int ts = tt - 127 + t; if (ts >= 0) { s = 0; for (int d = 0; d < 64; ++d) s += sh[d] * dbg_h(PK, ((size_t)b * SEQ + ts) * 128 + hk * 64 + d); } }
                else { const int ci = tt + 1 + t;
                    s = 0; for (int d = 0; d < 64; ++d) s += sh[d] * (ci < 128 ? p.cache_k[(((size_t)(l * DB + b) * 128 + ci) * 2 + hk) * 64 + d] : dbg_h(PK, ((size_t)MP + 4 * b + ci - 128) * 128 + hk * 64 + d)); }
                sc[t] = s; }
            __syncthreads();
            float mx = sink2; for (int k = 0; k < 128; ++k) mx = fmaxf(mx, sc[k]);
            float den = exp2f(sink2 - mx); for (int k = 0; k < 128; ++k) den += exp2f(sc[k] - mx);
            if (t < 64) { float o = 0;
                for (int k = 0; k < 128; ++k) { const float pk = exp2f(sc[k] - mx) / den; if (pk == 0.f) continue; float v;
                    if (!smp) { const int ts = tt - 127 + k; v = dbg_h(PV, ((size_t)b * SEQ + ts) * 128 + hk * 64 + t); }
                    else { const int ci = tt + 1 + k; v = ci < 128 ? p.cache_v[(((size_t)(l * DB + b) * 128 + ci) * 2 + hk) * 64 + t] : dbg_h(PV, ((size_t)MP + 4 * b + ci - 128) * 128 + hk * 64 + t); }
                    o += pk * v; }
                DBG_E(dbg_h(MIX, (size_t)row * D + 512 + hd * 64 + t), o * dbg_h(PSZA, (size_t)row * 512 + hd * 64 + t)); } }
        dbg_acc(accf, base + 13, e, rr); }
    if (smp) { e = 0; rr = 0;
        for (int i = 0; i < 26; ++i) DBG_E(p.out[OFF_CONVS + ((size_t)(l * DB + b) * 30 + i) * 256 + t], p.cache_conv[((size_t)(l * DB + b) * 30 + i + 4) * 256 + t]);
        for (int i = 0; i < 11; ++i) DBG_E(p.out[OFF_POOLS + ((size_t)(l * DB + b) * 15 + i) * 256 + t], p.cache_pool[((size_t)(l * DB + b) * 15 + i + 4) * 256 + t]);
        for (int i = 0; i < 124; ++i) if (t < 128) { DBG_E(p.out[OFF_KS + ((size_t)(l * DB + b) * 128 + i) * 128 + t], p.cache_k[((size_t)(l * DB + b) * 128 + i + 4) * 128 + t]);
            DBG_E(p.out[OFF_VS + ((size_t)(l * DB + b) * 128 + i) * 128 + t], p.cache_v[((size_t)(l * DB + b) * 128 + i + 4) * 128 + t]); }
        dbg_acc(accf, base + 15, e, rr); }
}
__global__ void __launch_bounds__(256) dbg_out(Params p, int l) {
    __shared__ float mm[D];
    float* accf = (float*)(p.ws + WS_DBGACC); const int t = threadIdx.x, row = dbg_row(blockIdx.x), base = 4 + 16 * l;
    const bool smp = row >= MP; const int bidx = smp ? NB + ((row - MP) >> 2) : (row >> 12);
    for (int c = t; c < D; c += 256) mm[c] = dbg_h((const u16*)(p.ws + WS_MIX), (size_t)row * D + c);
    __syncthreads();
    const float* md = (const float*)(p.ws + WS_MOD) + ((size_t)l * NMOD + bidx) * 3072 + 2048;
    const float* mdn = (const float*)(p.ws + WS_MOD) + ((size_t)(l + 1) * NMOD + bidx) * 3072;
    float x1[4], z[4], rstd;
    for (int i = 0; i < 4; ++i) x1[i] = dbg_h((const u16*)(p.ws + WS_DBGZ), (size_t)((smp ? DBG_NS : 0) + blockIdx.x) * D + t + 256 * i);
    if (!smp && l > 0) { dbg_ln4(x1, rstd); for (int i = 0; i < 4; ++i) { const int c = t + 256 * i; x1[i] = x1[i] * rstd * p.ln_g[(l - 1) * D + c] + p.ln_b[(l - 1) * D + c]; } }
    float e = 0, rr = 0;
    for (int i = 0; i < 4; ++i) { const int c = t + 256 * i; float a = 0; for (int k = 0; k < D; ++k) a += mm[k] * p.w_out[((size_t)l * D + k) * D + c];
        z[i] = ALPHA * x1[i] + (1.f + md[c]) * a; DBG_E(dbg_h((const u16*)(p.ws + WS_ZH), (size_t)row * D + c), z[i]); }
    dbg_acc(accf, base + 14, e, rr);
    e = 0; rr = 0;
    if (!smp) { if (l < DEPTH - 1) for (int i = 0; i < 4; ++i) { const int c = t + 256 * i; DBG_E(dbg_h((const u16*)(p.ws + WS_H), (size_t)row * D + c), z[i] * p.ln_g[l * D + c] * (1.f + mdn[1024 + c])); } }
    else { dbg_ln4(z, rstd); for (int i = 0; i < 4; ++i) { const int c = t + 256 * i; z[i] = z[i] * rstd * p.ln_g[l * D + c] + p.ln_b[l * D + c]; }
        if (l == DEPTH - 1) { for (int i = 0; i < 4; ++i) DBG_E(p.out[OFF_YS + (size_t)(row - MP) * D + t + 256 * i], z[i]); }
        else { for (int i = 0; i < 4; ++i) DBG_E(dbg_h((const u16*)(p.ws + WS_XR), (size_t)row * D + t + 256 * i), z[i]);
            dbg_ln4(z, rstd); for (int i = 0; i < 4; ++i) { const int c = t + 256 * i; DBG_E(dbg_h((const u16*)(p.ws + WS_H), (size_t)row * D + c), z[i] * rstd * (1.f + mdn[1024 + c]) + mdn[c]); } } }
    dbg_acc(accf, base + 0, e, rr);
    if (l == 0) { dbg_acc(accf, 100, smp ? 0.f : e, smp ? 0.f : rr); dbg_acc(accf, 101, smp ? e : 0.f, smp ? rr : 0.f); }
}
__global__ void __launch_bounds__(256) dbg_fin(Params p) {
    float* accf = (float*)(p.ws + WS_DBGACC); const int t = threadIdx.x, row = dbg_row(blockIdx.x);
    if (row >= MP) return;
    float x[4]; for (int i = 0; i < 4; ++i) x[i] = dbg_h((const u16*)(p.ws + WS_ZH), (size_t)row * D + t + 256 * i);
    float rstd; dbg_ln4(x, rstd); float e = 0, rr = 0;
    for (int i = 0; i < 4; ++i) { const int c = t + 256 * i; DBG_E(p.out[(size_t)row * D + c], x[i] * rstd * p.ln_g[3 * D + c] + p.ln_b[3 * D + c]); }
    dbg_acc(accf, 68, e, rr);
}
#ifndef DBG_REPORT_ID
#define DBG_REPORT_ID -1
#endif
__global__ void __launch_bounds__(256) dbg_report(Params p) {
    const float* accf = (const float*)(p.ws + WS_DBGACC);
    float code = 1000.f;
    if (DBG_REPORT_ID >= 0) { const float e = accf[2 * DBG_REPORT_ID], r = accf[2 * DBG_REPORT_ID + 1]; code = (r > 0.f ? e / r : 9.9f) * 1e12f; if (!(code > 100.f)) code = 100.f; }
    else for (int i = 0; i < 128; ++i) { const float e = accf[2 * i], r = accf[2 * i + 1]; const bool expected = i <= 71 && !(i >= 4 && i < 68 && ((i - 4) & 15) == 0 && (i - 4) / 16 == 99);
        if ((r > 0.f && !(e / r < 1e-3f)) || (r == 0.f && (e > 0.f || expected)) || e != e || r != r) { code = (float)(i + 1) * 1e4f; break; } }
    const float S = sqrtf(code);
    for (size_t i = (size_t)blockIdx.x * 256 + threadIdx.x; i < (size_t)MP * D; i += (size_t)gridDim.x * 256) p.out[i] = S;
}
#endif

extern "C" void kernel_launch(void* const* d_in, const int* in_sizes, int n_in, void* d_out, int out_size, void* d_ws, size_t ws_size, hipStream_t stream) {
    static int grid = 0;
    if (grid == 0) {
        if (n_in != 21 || (size_t)out_size != OUT_TOTAL || ws_size < WS_END) { fprintf(stderr, "kernel_launch: unexpected shapes (n_in %d, out %d, ws %zu)\n", n_in, out_size, ws_size); grid = -1; return; }
        int dev = 0, cus = 0;
        if (hipGetDevice(&dev) != hipSuccess || hipDeviceGetAttribute(&cus, hipDeviceAttributeMultiprocessorCount, dev) != hipSuccess) { grid = -1; return; }
        if (hipFuncSetAttribute((const void*)hymba_fwd, hipFuncAttributeMaxDynamicSharedMemorySize, LDS_BYTES) != hipSuccess) { fprintf(stderr, "kernel_launch: hipFuncSetAttribute failed\n"); grid = -1; return; }
        (void)hipGetLastError();
        grid = cus;
    }
    if (grid < 0) return;
    (void)hipMemsetAsync((char*)d_ws + WS_CTL, 0, CTL_ZERO_BYTES, stream);
    Params a{};
    a.x_prompt = (const float*)d_in[0]; a.x_sample = (const float*)d_in[1]; a.cache_conv = (const float*)d_in[2]; a.cache_pool = (const float*)d_in[3];
    a.cache_k = (const float*)d_in[4]; a.cache_v = (const float*)d_in[5]; a.c_prompt = (const float*)d_in[6]; a.c_sample = (const float*)d_in[7];
    a.w_in = (const float*)d_in[8]; a.w_out = (const float*)d_in[9]; a.conv_w = (const float*)d_in[10]; a.conv_b = (const float*)d_in[11];
    a.cnorm_g = (const float*)d_in[12]; a.cnorm_b = (const float*)d_in[13]; a.pool_w = (const float*)d_in[14]; a.pool_scale = (const float*)d_in[15];
    a.sinks = (const float*)d_in[16]; a.w_mod = (const float*)d_in[17]; a.b_mod = (const float*)d_in[18]; a.ln_g = (const float*)d_in[19]; a.ln_b = (const float*)d_in[20];
    a.out = (float*)d_out; a.ws = (unsigned char*)d_ws;
    for (int i = 0; i < 32; ++i) a.inv_freq[i] = (float)std::pow(10000.0, -(double)i * (2.0 / 64.0));
    if (MK_N_LAUNCHES == 1) { a.ph_lo = 0; a.ph_hi = N_PHASES; hipLaunchKernelGGL(hymba_fwd, dim3(grid), dim3(NTHR), LDS_BYTES, stream, a); }
    else for (int ph = 0; ph < N_PHASES; ++ph) {
#ifdef DBG
        if (ph >= 2 && ph < N_PHASES - 1 && (ph - 2) % 3 == 2) hipLaunchKernelGGL(dbg_copyz, dim3(DBG_NS), dim3(256), 0, stream, a);
#endif
        a.ph_lo = ph; a.ph_hi = ph + 1; hipLaunchKernelGGL(hymba_fwd, dim3(grid), dim3(NTHR), LDS_BYTES, stream, a);
#ifdef DBG
        if (ph == 0) hipLaunchKernelGGL(dbg_p0, dim3(144), dim3(256), 0, stream, a);
        else if (ph == 1) hipLaunchKernelGGL(dbg_p0b, dim3(144), dim3(256), 0, stream, a);
        else if (ph == N_PHASES - 1) { hipLaunchKernelGGL(dbg_fin, dim3(DBG_NS), dim3(256), 0, stream, a); hipLaunchKernelGGL(dbg_report, dim3(1024), dim3(256), 0, stream, a); }
        else { const int l = (ph - 2) / 3, k = (ph - 2) % 3;
            if (k == 0) hipLaunchKernelGGL(dbg_in, dim3(DBG_NS), dim3(256), 0, stream, a, l);
            if (k == 1) hipLaunchKernelGGL(dbg_mix, dim3(DBG_NS), dim3(256), 0, stream, a, l);
            if (k == 2) hipLaunchKernelGGL(dbg_out, dim3(DBG_NS), dim3(256), 0, stream, a, l); }
#endif
    }
}
```

```cpp
#include <hip/hip_runtime.h>
#include <cstdint>
#include <cstdio>
#include <cmath>

#define DBG_REPORT_ID -1
#ifndef MK_N_LAUNCHES
#define MK_N_LAUNCHES 1
#endif

#define DI __device__ __forceinline__
#define GAS __attribute__((address_space(1)))
#define LAS __attribute__((address_space(3)))
typedef unsigned short u16;
typedef _Float16 h8 __attribute__((ext_vector_type(8)));
typedef _Float16 h4 __attribute__((ext_vector_type(4)));
typedef _Float16 h2 __attribute__((ext_vector_type(2)));
typedef float f32x2 __attribute__((ext_vector_type(2)));
typedef float f32x4 __attribute__((ext_vector_type(4)));
typedef float f32x16 __attribute__((ext_vector_type(16)));
typedef unsigned u32x4 __attribute__((ext_vector_type(4)));
typedef unsigned u32x2 __attribute__((ext_vector_type(2)));
typedef short v4i16_t __attribute__((ext_vector_type(4)));

constexpr int D = 1024, DIN = 2560, NB = 4, SEQ = 4096, DEPTH = 4, DB = 128, DS = 4;
constexpr int MP = NB * SEQ, MS = DB * DS, M = MP + MS;
constexpr int NMOD = NB + DB;
constexpr int PAST = 8192;
constexpr float LN_EPS = 1e-5f;
constexpr float ALPHA = 1.681792830507429f;
constexpr float LOG2E = 1.4426950408889634f;
constexpr float QSCALE = 0.125f * LOG2E;
constexpr size_t OFF_YP = 0, OFF_YS = OFF_YP + (size_t)MP * D, OFF_CONVP = OFF_YS + (size_t)MS * D, OFF_POOLP = OFF_CONVP + (size_t)DEPTH * NB * 30 * 256,
                 OFF_KP = OFF_POOLP + (size_t)DEPTH * NB * 15 * 256, OFF_VP = OFF_KP + (size_t)DEPTH * NB * 128 * 128, OFF_CONVS = OFF_VP + (size_t)DEPTH * NB * 128 * 128,
                 OFF_POOLS = OFF_CONVS + (size_t)DEPTH * DB * 30 * 256, OFF_KS = OFF_POOLS + (size_t)DEPTH * DB * 15 * 256, OFF_VS = OFF_KS + (size_t)DEPTH * DB * 128 * 128,
                 OUT_TOTAL = OFF_VS + (size_t)DEPTH * DB * 128 * 128;
constexpr size_t MiB = 1u << 20;
constexpr size_t WS_CTL = 0, CTL_ZERO_BYTES = 64 * 1024;
constexpr size_t WS_WIN = 1 * MiB;
constexpr size_t WS_WOUT = 21 * MiB;
constexpr size_t WS_MOD = 29 * MiB;
constexpr size_t WS_TAB = 36 * MiB;
constexpr size_t WS_ZH = 38 * MiB;
constexpr size_t WS_XR = 71 * MiB;
constexpr size_t WS_WINV0 = 71 * MiB;
constexpr size_t WS_MIX = 104 * MiB;
constexpr size_t WS_PA = 137 * MiB;
constexpr size_t WS_PSZC = WS_PA + (size_t)M * 256 * 2, WS_PPV = WS_PSZC + (size_t)M * 256 * 2, WS_PSZP = WS_PPV + (size_t)M * 256 * 2;
constexpr size_t WS_PQ = WS_PSZP + (size_t)M * 256 * 2;
constexpr size_t WS_PSZA = WS_PQ + (size_t)M * 512 * 2;
constexpr size_t WS_PK = WS_PSZA + (size_t)M * 512 * 2;
constexpr size_t WS_PV = WS_PK + (size_t)M * 128 * 2;
constexpr size_t WS_H = WS_PV + (size_t)M * 128 * 2;
constexpr size_t WS_PS = WS_H + (size_t)M * D * 2;
constexpr size_t WS_RC0 = WS_PS + 2 * (size_t)MP * 24 * 4;
constexpr size_t WS_MODV = WS_RC0 + (size_t)MP * 16;
constexpr size_t WS_LNC = WS_MODV + (size_t)DEPTH * NB * 4 * DIN * 4;
constexpr size_t WS_XS = WS_LNC + 256;
constexpr size_t WS_END = WS_XS + (size_t)64 * 4 * 256 * 8;
static_assert(WS_END <= 256 * MiB, "d_ws map");
constexpr int CW_BAR = 1024;
constexpr int CW_EARLY = 6400;
constexpr int CW_FIN = 5120;
constexpr int CW_SCNT = 12288;

DI unsigned pkh(float a, float b) { f32x2 v = {a, b}; h2 r = __builtin_convertvector(v, h2); return __builtin_bit_cast(unsigned, r); }
DI u32x4 pack8(const float* v) { u32x4 w; w.x = pkh(v[0], v[1]); w.y = pkh(v[2], v[3]); w.z = pkh(v[4], v[5]); w.w = pkh(v[6], v[7]); return w; }
DI void unpack8(u32x4 w, float* o) {
    const h8 v = __builtin_bit_cast(h8, w);
#pragma unroll
    for (int j = 0; j < 8; ++j) o[j] = (float)v[j];
}
DI float ex2(float x) { return __builtin_amdgcn_exp2f(x); }
DI float sigm(float x) { return __builtin_amdgcn_rcpf(1.f + ex2(-x * LOG2E)); }
DI float silu(float x) { return x * sigm(x); }
template <int O> DI float xor_lane(float v) {
    return __builtin_bit_cast(float, __builtin_amdgcn_ds_swizzle(__builtin_bit_cast(int, v), (O << 10) | 0x1f));
}
DI float sum_halves(float v) { float a = v, b = v; asm volatile("s_nop 1\n\tv_permlane32_swap_b32 %0, %1" : "+v"(a), "+v"(b)); return a + b; }
DI float max_halves(float v) { float a = v, b = v; asm volatile("s_nop 1\n\tv_permlane32_swap_b32 %0, %1" : "+v"(a), "+v"(b)); return fmaxf(a, b); }
template <int CTRL, int ROWMASK> DI float dpp_f(float v, float ident) { return __builtin_bit_cast(float, __builtin_amdgcn_update_dpp(__builtin_bit_cast(int, ident), __builtin_bit_cast(int, v), CTRL, ROWMASK, 0xf, false)); }
DI float wave_sum(float v) {
    v += dpp_f<0xB1, 0xf>(v, 0.f); v += dpp_f<0x4E, 0xf>(v, 0.f); v += dpp_f<0x141, 0xf>(v, 0.f); v += dpp_f<0x140, 0xf>(v, 0.f);
    v += dpp_f<0x142, 0xa>(v, 0.f); v += dpp_f<0x143, 0xc>(v, 0.f);
    return __builtin_bit_cast(float, __builtin_amdgcn_readlane(__builtin_bit_cast(int, v), 63));
}
DI float wave_max(float v) {
    const float NI = -INFINITY;
    v = fmaxf(v, dpp_f<0xB1, 0xf>(v, NI)); v = fmaxf(v, dpp_f<0x4E, 0xf>(v, NI)); v = fmaxf(v, dpp_f<0x141, 0xf>(v, NI)); v = fmaxf(v, dpp_f<0x140, 0xf>(v, NI));
    v = fmaxf(v, dpp_f<0x142, 0xa>(v, NI)); v = fmaxf(v, dpp_f<0x143, 0xc>(v, NI));
    return __builtin_bit_cast(float, __builtin_amdgcn_readlane(__builtin_bit_cast(int, v), 63));
}
DI int lane_id() { int l_; asm volatile("v_mbcnt_lo_u32_b32 %0, -1, 0\n\tv_mbcnt_hi_u32_b32 %0, -1, %0" : "=v"(l_)); return l_; }
DI int crow(int r, int hi) { return (r & 3) + 8 * (r >> 2) + 4 * hi; }

__host__ __device__ __forceinline__ int pperm(int bj, int c7) { return 128 * bj + 32 * (c7 >> 5) + 16 * ((c7 >> 2) & 1) + 4 * ((c7 >> 3) & 3) + (c7 & 3); }
__host__ __device__ __forceinline__ int perm_in(int col) {
    if (col < 512) { const int bj = col >> 8, ch = col & 255; return 256 * (ch >> 7) + pperm(bj, ch & 127); }
    if (col < 1280) { const int base = col < 768 ? 512 : (col < 1024 ? 768 : 1024); const int x = col - base; return base + pperm(x >> 7, x & 127); }
    if (col < 1792) { const int x = col - 1280, head = x >> 6, d = x & 63; return 256 * (5 + (head >> 2)) + pperm(d >> 5, 32 * (head & 3) + (d & 31)); }
    if (col < 2048) { const int x = col - 1792, hh = x >> 6, d = x & 63; return 1792 + pperm(d >> 5, 32 * hh + (d & 31)); }
    { const int x = col - 2048; return 2048 + 256 * (x >> 8) + pperm((x >> 7) & 1, x & 127); }
}
__host__ __device__ __forceinline__ int perm_out(int col) { const int y = col & 255; return (col & ~255) + pperm(y >> 7, y & 127); }

namespace pg8 {
constexpr int BM = 256, BK = 64, HALF = 128, HTB = HALF * BK * 2, STAGE_BYTES = 8 * HTB, NXCD = 8, WGM = 8;
__host__ __device__ __forceinline__ int lds_byte(int r, int c) { const int st = (r >> 4) * 2 + (c >> 5), rr = r & 15, cc = c & 31, ob = rr * 64 + cc * 2; return st * 1024 + (ob ^ (((ob >> 9) & 1) << 5)); }
__host__ __device__ __forceinline__ void stage_rc(int b, int& R, int& C) { const int st = b / 1024, sb = b % 1024, swz = sb ^ (((sb >> 9) & 1) << 5); R = (st >> 1) * 16 + swz / 64; C = (st & 1) * 32 + (swz % 64) / 2; }
struct Unit { int pm, pn; };
struct Gemm { const u16* A; const u16* Bt; int M, N, K; };
struct StaticOrder {
    int nM, nN, nwg, G, c;
    __host__ __device__ __forceinline__ void init(int M_, int N_, int G_, int c_) { nM = M_ / BM; nN = N_ / BM; nwg = nM * nN; G = G_; c = c_; }
    __host__ __device__ __forceinline__ bool next(int i, Unit& u) const {
        const long L = (long)i * G + c; if (L >= nwg) return false;
        int wgid = (int)L; { const int q = nwg / NXCD, r = nwg % NXCD, xcd = wgid % NXCD, off = wgid / NXCD; wgid = (xcd < r ? xcd * (q + 1) : r * (q + 1) + (xcd - r) * q) + off; }
        const int nig = WGM * nN, gid = wgid / nig, fm = gid * WGM, gsz = (nM - fm) < WGM ? (nM - fm) : WGM;
        u.pm = fm + ((wgid % nig) % gsz); u.pn = (wgid % nig) / gsz; return true;
    }
};

struct InOrder {
    int nM, nN, nwg, G, c, s0, ns;
    __host__ __device__ __forceinline__ void init(int M_, int N_, int G_, int c_, int s0_, int ns_) { nM = M_ / BM; nN = N_ / BM; nwg = nM * nN; G = G_; c = c_; s0 = s0_; ns = ns_; }
    __host__ __device__ __forceinline__ bool next(int i, Unit& u) const {
        const long L = (long)i * G + c; if (L >= nwg) return false;
        if (ns > 0 && L >= s0 && L < s0 + ns) { const int k = (int)L - s0, nsp = ns / nN; u.pm = nM - nsp + k % nsp; u.pn = k / nsp; return true; }
        const int idx = (ns > 0 && L >= s0) ? (int)L - ns : (int)L, nwp = nwg - ns, nMp = nwp / nN;
        int wgid = idx; { const int q = nwp / NXCD, r = nwp % NXCD, xcd = wgid % NXCD, off = wgid / NXCD; wgid = (xcd < r ? xcd * (q + 1) : r * (q + 1) + (xcd - r) * q) + off; }
        const int nig = WGM * nN, gid = wgid / nig, fm = gid * WGM, gsz = (nMp - fm) < WGM ? (nMp - fm) : WGM;
        u.pm = fm + ((wgid % nig) % gsz); u.pn = (wgid % nig) / gsz; return true;
    }
};

template <class Epi, bool ALIGN_EPI, class Ord>
DI void gemm_phase(LAS unsigned char* lds, const Gemm g, const Ord& S, const Epi& E, const int tid) {
    const int wid = __builtin_amdgcn_readfirstlane(tid >> 6), lane = tid & 63, wr = wid >> 2, wc = wid & 3, fr = lane & 15, fq = lane >> 4;
    const int K = g.K, nt = K / BK;
    unsigned voffA[2];
#pragma unroll
    for (int i = 0; i < 2; ++i) { int R, C; stage_rc(tid * 16 + i * 8192, R, C); voffA[i] = (unsigned)(R * K + C) * 2u; }
    const size_t kstep = (size_t)(BK * 2);
    const size_t hstep = (size_t)HALF * K * 2;
    const size_t tstep = 2 * hstep;
    const unsigned ldsw = (unsigned)wid * 1024u;
    const int aoff = lds_byte(wr * 64 + fr, fq * 8), boff = lds_byte(wc * 32 + fr, fq * 8);
#define PG8_SA(b, h) (((b) * 2 + (h)) * HTB)
#define PG8_SB(b, h) ((4 + (b) * 2 + (h)) * HTB)
#define PG8_STAGE(bufoff, gbase) do { _Pragma("unroll") for (int _i = 0; _i < 2; ++_i) \
        __builtin_amdgcn_global_load_lds((const unsigned*)((const char*)(gbase) + voffA[_i]), (LAS unsigned*)(lds + (bufoff) + ldsw + _i * 8192), 16, 0, 0); } while (0)
#define PG8_LDA(dst, b, h) do { _Pragma("unroll") for (int m = 0; m < 4; ++m) _Pragma("unroll") for (int k = 0; k < 2; ++k) dst[m][k] = *(const LAS h8*)(lds + PG8_SA(b, h) + aoff + m * 2048 + k * 1024); } while (0)
#define PG8_LDB(dst, b, h) do { _Pragma("unroll") for (int n = 0; n < 2; ++n) _Pragma("unroll") for (int k = 0; k < 2; ++k) dst[n][k] = *(const LAS h8*)(lds + PG8_SB(b, h) + boff + n * 2048 + k * 1024); } while (0)
#define PG8_MMA(ai, bj, At, Bt) do { __builtin_amdgcn_s_setprio(1); _Pragma("unroll") for (int m = 0; m < 4; ++m) _Pragma("unroll") for (int n = 0; n < 2; ++n) _Pragma("unroll") for (int k = 0; k < 2; ++k) \
        acc[ai][bj][m][n] = __builtin_amdgcn_mfma_f32_16x16x32_f16(Bt[n][k], At[m][k], acc[ai][bj][m][n], 0, 0, 0); __builtin_amdgcn_s_setprio(0); } while (0)
#define PG8_WAIT_V(n) asm volatile("s_waitcnt vmcnt(" #n ")" ::: "memory")
#define PG8_WAIT_L(n) asm volatile("s_waitcnt lgkmcnt(" #n ")" ::: "memory")
#define PG8_BAR __builtin_amdgcn_s_barrier()
#define PG8_SCHED __builtin_amdgcn_sched_barrier(0)
    Unit cur, nxt; int ui = 0;
    if (!S.next(0, cur)) return;
    f32x4 acc[2][2][4][2];
#pragma unroll
    for (int a = 0; a < 2; ++a)
#pragma unroll
        for (int b = 0; b < 2; ++b)
#pragma unroll
            for (int m = 0; m < 4; ++m)
#pragma unroll
                for (int n = 0; n < 2; ++n) acc[a][b][m][n] = (f32x4){0.f, 0.f, 0.f, 0.f};
    h8 At[4][2], B0[2][2], B1[2][2];
    const char* cA = (const char*)g.A + E.a_off(cur.pm) + (size_t)cur.pm * tstep; const char* cB = (const char*)g.Bt + E.b_off(cur.pm) + (size_t)cur.pn * tstep;
    PG8_STAGE(PG8_SB(0, 0), cB); PG8_STAGE(PG8_SB(0, 1), cB + hstep); PG8_STAGE(PG8_SA(0, 0), cA); PG8_STAGE(PG8_SA(0, 1), cA + hstep);
    if (wr == 1) PG8_BAR;
    PG8_WAIT_V(2); PG8_BAR;
    PG8_STAGE(PG8_SB(1, 0), cB + kstep); PG8_STAGE(PG8_SA(1, 0), cA + kstep); PG8_STAGE(PG8_SB(1, 1), cB + hstep + kstep);
    PG8_WAIT_V(6); PG8_BAR;
    for (;;) {
        const bool has_next = S.next(ui + 1, nxt);
        const char* nA = has_next ? (const char*)g.A + E.a_off(nxt.pm) + (size_t)nxt.pm * tstep : cA; const char* nB = has_next ? (const char*)g.Bt + E.b_off(nxt.pm) + (size_t)nxt.pn * tstep : cB;
        asm volatile(".p2align 8");
        for (int t = 0; t < nt; t += 2) {
            const bool last = (t == nt - 2);
            const char* a1 = cA + (size_t)(t + 1) * kstep;
            const char* a2 = last ? nA : cA + (size_t)(t + 2) * kstep; const char* b2 = last ? nB : cB + (size_t)(t + 2) * kstep;
            const char* a3 = a2 + kstep; const char* b3 = b2 + kstep;
            PG8_LDB(B0, 0, 0); PG8_LDB(B1, 0, 1); PG8_SCHED; PG8_LDA(At, 0, 0); PG8_STAGE(PG8_SA(1, 1), a1 + hstep);
            PG8_WAIT_V(8); PG8_WAIT_L(0); PG8_BAR; PG8_MMA(0, 0, At, B0); PG8_MMA(0, 1, At, B1); PG8_BAR; PG8_SCHED;
            PG8_LDA(At, 0, 1); PG8_STAGE(PG8_SB(0, 0), b2); PG8_STAGE(PG8_SB(0, 1), b2 + hstep); PG8_STAGE(PG8_SA(0, 0), a2);
            PG8_WAIT_V(8); PG8_WAIT_L(0); PG8_BAR; PG8_MMA(1, 0, At, B0); PG8_MMA(1, 1, At, B1); PG8_BAR; PG8_SCHED;
            PG8_LDB(B0, 1, 0); PG8_LDB(B1, 1, 1); PG8_SCHED; PG8_LDA(At, 1, 0); PG8_STAGE(PG8_SA(0, 1), a2 + hstep);
            PG8_WAIT_V(8); PG8_WAIT_L(0); PG8_BAR; PG8_MMA(0, 0, At, B0); PG8_MMA(0, 1, At, B1); PG8_BAR; PG8_SCHED;
            PG8_LDA(At, 1, 1); PG8_STAGE(PG8_SB(1, 0), b3); PG8_STAGE(PG8_SB(1, 1), b3 + hstep); PG8_STAGE(PG8_SA(1, 0), a3);
            PG8_WAIT_V(8); PG8_WAIT_L(0); PG8_BAR; PG8_MMA(1, 0, At, B0); PG8_MMA(1, 1, At, B1); PG8_BAR; PG8_SCHED;
        }
        if constexpr (ALIGN_EPI) { if (wr == 0) PG8_BAR; }
        if constexpr (!Epi::AFTER_DRAIN) E(acc, cur, ui, wr, wc, fr, fq);
        if constexpr (Epi::PUBLISH) { if (E.wants_publish(cur, ui)) { PG8_WAIT_V(0); PG8_BAR; if (wid == 0) E.publish(lane); } }
        if (!has_next) break;
#pragma unroll
        for (int a = 0; a < 2; ++a)
#pragma unroll
            for (int b = 0; b < 2; ++b)
#pragma unroll
                for (int m = 0; m < 4; ++m)
#pragma unroll
                    for (int n = 0; n < 2; ++n) acc[a][b][m][n] = (f32x4){0.f, 0.f, 0.f, 0.f};
        cur = nxt; cA = nA; cB = nB; ++ui;
        if constexpr (ALIGN_EPI) { if (wr == 1) PG8_BAR; }
    }
    PG8_WAIT_V(0);
    if constexpr (!ALIGN_EPI) { if (wr == 0) PG8_BAR; }
    PG8_BAR;
    if constexpr (Epi::AFTER_DRAIN) E.fused(acc, cur, wr, wc, fr, fq, lds, tid);
#undef PG8_SA
#undef PG8_SB
#undef PG8_STAGE
#undef PG8_LDA
#undef PG8_LDB
#undef PG8_MMA
#undef PG8_WAIT_V
#undef PG8_WAIT_L
#undef PG8_BAR
#undef PG8_SCHED
}
}

struct Params {
    const float* x_prompt; const float* x_sample; const float* cache_conv; const float* cache_pool; const float* cache_k; const float* cache_v;
    const float* c_prompt; const float* c_sample; const float* w_in; const float* w_out; const float* conv_w; const float* conv_b; const float* cnorm_g; const float* cnorm_b;
    const float* pool_w; const float* pool_scale; const float* sinks; const float* w_mod; const float* b_mod; const float* ln_g; const float* ln_b;
    float* out; unsigned char* ws;
    int ph_lo, ph_hi;
    float inv_freq[32];
};
struct ParamsHead { const float* ptrs[21]; float* out; unsigned char* ws; int ph_lo, ph_hi; };
static_assert(sizeof(ParamsHead) == __builtin_offsetof(Params, inv_freq), "ParamsHead mirrors the head of Params");

DI void row_info(int row, bool& smp, int& b, int& t) { smp = row >= MP; if (!smp) { b = row >> 12; t = row & (SEQ - 1); } else { const int s = row - MP; b = s >> 2; t = s & 3; } }
DI void st8f(float* dst, const float* v) { *(f32x4*)dst = (f32x4){v[0], v[1], v[2], v[3]}; *(f32x4*)(dst + 4) = (f32x4){v[4], v[5], v[6], v[7]}; }

struct EpiIn {
    static constexpr bool AFTER_DRAIN = false, PUBLISH = true;
    int l; unsigned char* ws; float* out; const LAS float* rcl; bool early;
    DI long a_off(int pm) const { return pm < MP / 256 ? (long)WS_ZH - (long)WS_H : 0l; }
    DI long b_off(int pm) const { return pm < MP / 256 ? (long)((l & 1) ? WS_H : WS_WINV0) + (long)(pm >> 4) * DIN * D * 2 - (long)WS_WIN - (long)l * DIN * D * 2 : 0l; }
    DI bool wants_publish(const pg8::Unit& u, int ui) const { return early && ui == 0 && u.pm >= MP / 256; }
    DI void publish(int lane) const {
        __builtin_amdgcn_fence(__ATOMIC_RELEASE, "agent"); asm volatile("s_waitcnt vmcnt(0)" ::: "memory");
        if (lane == 0) (void)__hip_atomic_fetch_add((unsigned*)(ws + WS_CTL) + CW_EARLY + 64 * l, 1u, __ATOMIC_RELAXED, __HIP_MEMORY_SCOPE_AGENT); }
    DI void operator()(f32x4 (&acc)[2][2][4][2], const pg8::Unit& u, int ui, int wr, int wc, int fr, int fq) const {
        asm volatile("" : "+v"(fr), "+v"(fq));
        const int pn = u.pn;
        if (u.pm < MP / 256) {
            const LAS f32x4* rc = (const LAS f32x4*)rcl + ui * 256 + wr * 64 + fr;
            const float* mv = (const float*)(ws + WS_MODV) + (size_t)(l * NB + (u.pm >> 4)) * 4 * DIN + pn * 256 + wc * 32 + 4 * fq;
            f32x4 V[2][2][4];
#pragma unroll
            for (int bj = 0; bj < 2; ++bj)
#pragma unroll
                for (int n = 0; n < 2; ++n)
#pragma unroll
                    for (int k = 0; k < 4; ++k) V[bj][n][k] = *(const f32x4*)(mv + 128 * bj + 16 * n + k * DIN);
#pragma unroll
            for (int bj = 0; bj < 2; ++bj)
#pragma unroll
                for (int n = 0; n < 2; ++n)
#pragma unroll
                    for (int ai = 0; ai < 2; ++ai)
#pragma unroll
                        for (int m = 0; m < 4; ++m) { const f32x4 r = rc[ai * 128 + m * 16];
                            acc[ai][bj][m][n] = r[0] * acc[ai][bj][m][n] - r[1] * V[bj][n][0] + r[2] * V[bj][n][1] - r[3] * V[bj][n][2] + V[bj][n][3]; }
        }
        unsigned char* const W = ws; float* const O = out;
#define ST16(byteoff, vals) (*(u32x4*)(W + (size_t)(unsigned)(byteoff)) = pack8(vals))
#define STF8(fidx, vals) st8f(O + (size_t)(unsigned)(fidx), vals)
#pragma unroll
        for (int ai = 0; ai < 2; ++ai)
#pragma unroll
            for (int m = 0; m < 4; ++m) {
                const unsigned row = (unsigned)(u.pm * 256 + ai * 128 + wr * 64 + m * 16 + fr);
                const bool smp = row >= (unsigned)MP; const unsigned b = smp ? (row - MP) >> 2 : row >> 12, t = smp ? (row - MP) & 3u : row & (unsigned)(SEQ - 1);
                if (pn < 2) {
                    const unsigned c8 = pn * 128 + wc * 32 + fq * 8; float a[8];
#pragma unroll
                    for (int n = 0; n < 2; ++n)
#pragma unroll
                        for (int j = 0; j < 4; ++j) a[4 * n + j] = acc[ai][0][m][n][j] * sigm(acc[ai][1][m][n][j]);
                    ST16((unsigned)WS_PA + (row * 256 + c8) * 2, a);
                    if (smp) STF8((unsigned)OFF_CONVS + ((l * DB + b) * 30 + 26 + t) * 256 + c8, a);
                    else if (t >= SEQ - 30) STF8((unsigned)OFF_CONVP + ((l * NB + b) * 30 + (t - (SEQ - 30))) * 256 + c8, a);
                } else if (pn == 2 || pn == 4) {
                    const unsigned base = pn == 2 ? (unsigned)WS_PSZC : (unsigned)WS_PSZP;
#pragma unroll
                    for (int bj = 0; bj < 2; ++bj) { const unsigned c8 = bj * 128 + wc * 32 + fq * 8; float v[8];
#pragma unroll
                        for (int n = 0; n < 2; ++n)
#pragma unroll
                            for (int j = 0; j < 4; ++j) v[4 * n + j] = silu(acc[ai][bj][m][n][j]);
                        ST16(base + (row * 256 + c8) * 2, v); }
                } else if (pn == 3) {
#pragma unroll
                    for (int bj = 0; bj < 2; ++bj) { const unsigned c8 = bj * 128 + wc * 32 + fq * 8; float v[8];
#pragma unroll
                        for (int n = 0; n < 2; ++n)
#pragma unroll
                            for (int j = 0; j < 4; ++j) v[4 * n + j] = acc[ai][bj][m][n][j];
                        ST16((unsigned)WS_PPV + (row * 256 + c8) * 2, v);
                        if (smp) STF8((unsigned)OFF_POOLS + ((l * DB + b) * 15 + 11 + t) * 256 + c8, v);
                        else if (t >= SEQ - 15) STF8((unsigned)OFF_POOLP + ((l * NB + b) * 15 + (t - (SEQ - 15))) * 256 + c8, v); }
                } else if (pn >= 8) {
#pragma unroll
                    for (int bj = 0; bj < 2; ++bj) { const unsigned c8 = (pn - 8) * 256 + bj * 128 + wc * 32 + fq * 8; float v[8];
#pragma unroll
                        for (int n = 0; n < 2; ++n)
#pragma unroll
                            for (int j = 0; j < 4; ++j) v[4 * n + j] = silu(acc[ai][bj][m][n][j]);
                        ST16((unsigned)WS_PSZA + (row * 512 + c8) * 2, v); }
                } else if (pn == 7 && wc >= 2) {
                    const unsigned hv = wc - 2;
#pragma unroll
                    for (int bj = 0; bj < 2; ++bj) { const unsigned d8 = 32 * bj + 8 * fq; float v[8];
#pragma unroll
                        for (int n = 0; n < 2; ++n)
#pragma unroll
                            for (int j = 0; j < 4; ++j) v[4 * n + j] = acc[ai][bj][m][n][j];
                        ST16((unsigned)WS_PV + (row * 128 + hv * 64 + d8) * 2, v);
                        if (smp) STF8((unsigned)OFF_VS + (((l * DB + b) * 128 + 124 + t) * 2 + hv) * 64 + d8, v);
                        else if (t >= SEQ - 128) STF8((unsigned)OFF_VP + (((l * NB + b) * 128 + (t - (SEQ - 128))) * 2 + hv) * 64 + d8, v); }
                } else {
                    const unsigned d8 = 8 * fq; const unsigned pidx = smp ? SEQ + t : t;
                    const f32x4* tp = (const f32x4*)(W + (size_t)((unsigned)WS_TAB + (pidx * 32 + d8) * 8));
                    float x1[8], x2[8], o1[8], o2[8];
#pragma unroll
                    for (int n = 0; n < 2; ++n)
#pragma unroll
                        for (int j = 0; j < 4; ++j) { x1[4 * n + j] = acc[ai][0][m][n][j]; x2[4 * n + j] = acc[ai][1][m][n][j]; }
                    const float sc = pn == 7 ? 1.f : QSCALE;
#pragma unroll
                    for (int k2 = 0; k2 < 4; ++k2) { const f32x4 cs = tp[k2];
                        o1[2 * k2] = (x1[2 * k2] * cs[0] - x2[2 * k2] * cs[1]) * sc;         o2[2 * k2] = (x2[2 * k2] * cs[0] + x1[2 * k2] * cs[1]) * sc;
                        o1[2 * k2 + 1] = (x1[2 * k2 + 1] * cs[2] - x2[2 * k2 + 1] * cs[3]) * sc; o2[2 * k2 + 1] = (x2[2 * k2 + 1] * cs[2] + x1[2 * k2 + 1] * cs[3]) * sc; }
                    if (pn == 7) { const unsigned hk = wc;
                        ST16((unsigned)WS_PK + (row * 128 + hk * 64 + d8) * 2, o1); ST16((unsigned)WS_PK + (row * 128 + hk * 64 + 32 + d8) * 2, o2);
                        if (smp) { const unsigned di = (unsigned)OFF_KS + (((l * DB + b) * 128 + 124 + t) * 2 + hk) * 64 + d8; STF8(di, o1); STF8(di + 32, o2); }
                        else if (t >= SEQ - 128) { const unsigned di = (unsigned)OFF_KP + (((l * NB + b) * 128 + (t - (SEQ - 128))) * 2 + hk) * 64 + d8; STF8(di, o1); STF8(di + 32, o2); }
                    } else { const unsigned head = (pn - 5) * 4 + wc;
                        ST16((unsigned)WS_PQ + (row * 512 + head * 64 + d8) * 2, o1); ST16((unsigned)WS_PQ + (row * 512 + head * 64 + 32 + d8) * 2, o2); }
                }
            }
#undef ST16
#undef STF8
    }
};

struct EpiOutF {
    static constexpr bool AFTER_DRAIN = true, PUBLISH = false;
    unsigned char* ws; int l; const float* ln_g; const float* ln_b; float* out;
    DI void operator()(f32x4 (&)[2][2][4][2], const pg8::Unit&, int, int, int, int, int) const {}
    DI long a_off(int) const { return 0l; }
    DI long b_off(int) const { return 0l; }
    static constexpr int SETUP_HI = 131072 + 1024;
    DI void setup_item(const pg8::Unit& u, LAS unsigned char* lds, int item) const {
        LAS float* CV = (LAS float*)lds; LAS float* RS = (LAS float*)(lds + 6144);
        const float* MOD = (const float*)(ws + WS_MOD); const int b = u.pm >> 4;
        if (item < 256) { const int col = u.pn * 256 + item;
            CV[item] = l > 0 ? ln_g[(l - 1) * D + col] : 1.f; CV[256 + item] = l > 0 ? ln_b[(l - 1) * D + col] : 0.f;
            CV[512 + item] = MOD[((size_t)l * NMOD + b) * 3072 + 2048 + col]; CV[768 + item] = ln_g[l * D + col]; CV[1024 + item] = ln_b[l * D + col];
            CV[1280 + item] = l < DEPTH - 1 ? MOD[((size_t)(l + 1) * NMOD + b) * 3072 + 1024 + col] : 0.f;
        } else { const int row = item - 256; float mu = 0.f, rstd = 1.f;
            const float* PSp = (const float*)(ws + WS_PS) + (size_t)((l + 1) & 1) * MP * 24;
            if (l > 0) { const float* ps = PSp + (size_t)(u.pm * 256 + row) * 24; const f32x2 q0 = *(const f32x2*)ps, q1 = *(const f32x2*)(ps + 6), q2 = *(const f32x2*)(ps + 12), q3 = *(const f32x2*)(ps + 18);
                const float s1 = (q0[0] + q1[0]) + (q2[0] + q3[0]), s2 = (q0[1] + q1[1]) + (q2[1] + q3[1]);
                mu = s1 * (1.f / D); rstd = 1.f / sqrtf(s2 * (1.f / D) - mu * mu + LN_EPS); }
            RS[2 * row] = mu; RS[2 * row + 1] = rstd; }
    }
    DI void fused(f32x4 (&acc)[2][2][4][2], const pg8::Unit& u, int wr, int wc, int fr, int fq, LAS unsigned char* lds, int tid) const {
        LAS float* CV = (LAS float*)lds;
        LAS float* RS = (LAS float*)(lds + 6144);
        LAS float* PW = (LAS float*)(lds + 12288);
        u16* ZH = (u16*)(ws + WS_ZH); u16* ZP = (u16*)(ws + WS_H);
        float* PSc = (float*)(ws + WS_PS) + (size_t)(l & 1) * MP * 24;
        if (MK_N_LAUNCHES != 1) setup_item(u, lds, tid);
        else *(LAS u32x4*)(lds + tid * 16) = *(const LAS u32x4*)(lds + SETUP_HI + tid * 16);
        __syncthreads();
#pragma unroll
        for (int ai = 0; ai < 2; ++ai) {
        u32x4 zpv[4][2];
#pragma unroll
        for (int mm = 0; mm < 4; ++mm)
#pragma unroll
            for (int bj = 0; bj < 2; ++bj) zpv[mm][bj] = __builtin_nontemporal_load((const u32x4*)(ZH + ((size_t)u.pm * 256 + ai * 128 + wr * 64 + mm * 16 + fr) * D + u.pn * 256 + bj * 128 + wc * 32 + fq * 8));
#pragma unroll
        for (int mm = 0; mm < 4; ++mm) { const int m = mm;
            const int rt = ai * 128 + wr * 64 + m * 16 + fr; const size_t row = (size_t)u.pm * 256 + rt;
            const float mu = RS[2 * rt], rstd = RS[2 * rt + 1];
            f32x2 S1 = {0.f, 0.f}, S2 = {0.f, 0.f}, S3 = {0.f, 0.f}, S4 = {0.f, 0.f}, S5 = {0.f, 0.f}, S6 = {0.f, 0.f};
#pragma unroll
            for (int bj = 0; bj < 2; ++bj) { const int cl = bj * 128 + wc * 32 + fq * 8; const size_t off = row * D + u.pn * 256 + cl;
                float zp[8], zq[8]; unpack8(zpv[mm][bj], zp);
#pragma unroll
                for (int hh = 0; hh < 2; ++hh) {
                    const f32x4 gp = *(const LAS f32x4*)(CV + cl + 4 * hh), bp = *(const LAS f32x4*)(CV + 256 + cl + 4 * hh), gt = *(const LAS f32x4*)(CV + 512 + cl + 4 * hh),
                                gg = *(const LAS f32x4*)(CV + 768 + cl + 4 * hh), bb = *(const LAS f32x4*)(CV + 1024 + cl + 4 * hh);
                    const f32x4 av = acc[ai][bj][m][hh];
                    const f32x4 zp4 = {zp[4 * hh], zp[4 * hh + 1], zp[4 * hh + 2], zp[4 * hh + 3]};
                    f32x4 x1 = zp4; if (l > 0) x1 = (zp4 - mu) * rstd * gp + bp;
                    const f32x4 z = ALPHA * x1 + (1.f + gt) * av, uu = z * gg;
                    const f32x2 zl = {z[0], z[1]}, zh = {z[2], z[3]}, ul = {uu[0], uu[1]}, uh = {uu[2], uu[3]};
                    const f32x2 gl = {gg[0], gg[1]}, gh = {gg[2], gg[3]}, bl = {bb[0], bb[1]}, bh = {bb[2], bb[3]};
                    S1 += zl; S1 += zh; S2 += zl * zl; S2 += zh * zh; S3 += ul; S3 += uh; S4 += ul * ul; S4 += uh * uh; S5 += ul * gl; S5 += uh * gh; S6 += ul * bl; S6 += uh * bh;
#pragma unroll
                    for (int j = 0; j < 4; ++j) zq[4 * hh + j] = z[j];
                    acc[ai][bj][m][hh] = z; }
                if (l < DEPTH - 1) *(u32x4*)(ZH + off) = pack8(zq); }
            float s1 = S1[0] + S1[1], s2 = S2[0] + S2[1], s3 = S3[0] + S3[1], s4 = S4[0] + S4[1], s5 = S5[0] + S5[1], s6 = S6[0] + S6[1];
            s1 = sum_halves(s1 + xor_lane<16>(s1)); s2 = sum_halves(s2 + xor_lane<16>(s2)); s3 = sum_halves(s3 + xor_lane<16>(s3)); s4 = sum_halves(s4 + xor_lane<16>(s4)); s5 = sum_halves(s5 + xor_lane<16>(s5)); s6 = sum_halves(s6 + xor_lane<16>(s6));
            if (fq == 0) { LAS float* pw = PW + (rt * 4 + wc) * 6; pw[0] = s1; pw[1] = s2; pw[2] = s3; pw[3] = s4; pw[4] = s5; pw[5] = s6; } }
        asm volatile("" ::: "memory"); }
        __syncthreads();
        if (tid < 256 && l < DEPTH - 1) { float* ps = PSc + (size_t)(u.pm * 256 + tid) * 24 + u.pn * 6; const LAS float* pw = PW + tid * 24;
#pragma unroll
            for (int k = 0; k < 6; ++k) ps[k] = (pw[k] + pw[6 + k]) + (pw[12 + k] + pw[18 + k]); }
        if (l == DEPTH - 1) {
            unsigned long long* XS = (unsigned long long*)(ws + WS_XS) + (size_t)u.pm * 4 * 256;
            unsigned* cnt = (unsigned*)(ws + WS_CTL) + CW_FIN + 16 * u.pm;
            if (tid < 256) { const LAS float* pw = PW + tid * 24; const float a = (pw[0] + pw[6]) + (pw[12] + pw[18]), b2 = (pw[1] + pw[7]) + (pw[13] + pw[19]);
                __hip_atomic_store(XS + u.pn * 256 + tid, ((unsigned long long)__builtin_bit_cast(unsigned, b2) << 32) | __builtin_bit_cast(unsigned, a), __ATOMIC_RELAXED, __HIP_MEMORY_SCOPE_AGENT); }
            asm volatile("s_waitcnt vmcnt(0)" ::: "memory");
            __syncthreads();
            if (tid == 0) (void)__hip_atomic_fetch_add(cnt, 1u, __ATOMIC_RELAXED, __HIP_MEMORY_SCOPE_AGENT);
            if (tid < 64) { for (unsigned sp = 0; sp < (1u << 20); ++sp) { if (__hip_atomic_load(cnt, __ATOMIC_RELAXED, __HIP_MEMORY_SCOPE_AGENT) >= 4u) break; __builtin_amdgcn_s_sleep(1); }
                __builtin_amdgcn_fence(__ATOMIC_ACQUIRE, "agent"); asm volatile("s_waitcnt vmcnt(0)" ::: "memory"); }
            __syncthreads();
            if (tid < 256) { unsigned long long xs[4];
#pragma unroll
                for (int t = 0; t < 4; ++t) xs[t] = __hip_atomic_load(XS + t * 256 + tid, __ATOMIC_RELAXED, __HIP_MEMORY_SCOPE_AGENT);
                float a = 0.f, b2 = 0.f;
#pragma unroll
                for (int t = 0; t < 4; ++t) { a += __builtin_bit_cast(float, (unsigned)xs[t]); b2 += __builtin_bit_cast(float, (unsigned)(xs[t] >> 32)); }
                const float mu = a * (1.f / D); RS[2 * tid] = mu; RS[2 * tid + 1] = 1.f / sqrtf(b2 * (1.f / D) - mu * mu + LN_EPS); }
            __syncthreads();
            float* Y = out + OFF_YP;
#pragma unroll
            for (int ai = 0; ai < 2; ++ai)
#pragma unroll
                for (int m = 0; m < 4; ++m) { const int rt = ai * 128 + wr * 64 + m * 16 + fr; const float mu = RS[2 * rt], rstd = RS[2 * rt + 1];
#pragma unroll
                    for (int bj = 0; bj < 2; ++bj) { const int cl = bj * 128 + wc * 32 + fq * 8;
#pragma unroll
                        for (int hh = 0; hh < 2; ++hh) { const f32x4 gg = *(const LAS f32x4*)(CV + 768 + cl + 4 * hh), bb = *(const LAS f32x4*)(CV + 1024 + cl + 4 * hh); f32x4 o;
#pragma unroll
                            for (int j = 0; j < 4; ++j) o[j] = (acc[ai][bj][m][hh][j] - mu) * rstd * gg[j] + bb[j];
                            *(f32x4*)(Y + ((size_t)u.pm * 256 + rt) * D + u.pn * 256 + cl + 4 * hh) = o; } } }
        }
    }
};

#define XB_TMO      128
#define XB_XCNT(j)  (256  + 64 * (j))
#define XB_XSUB(j)  (1280 + 64 * (j))
#define XB_XGEN(j)  (2304 + 64 * (j))
#define XB_TOP      3328
#define XB_TOPGEN   3392
#define XCD_BAR_WORDS 3456
#define XB_SPIN_CAP (1u << 18)
DI unsigned xb_ld(unsigned* p)              { return __hip_atomic_load(p, __ATOMIC_RELAXED, __HIP_MEMORY_SCOPE_AGENT); }
DI unsigned xb_add(unsigned* p, unsigned v) { return __hip_atomic_fetch_add(p, v, __ATOMIC_RELAXED, __HIP_MEMORY_SCOPE_AGENT); }
DI unsigned xb_xcc_id() { return (unsigned)__builtin_amdgcn_s_getreg((3 << 11) | 20) & 0xFu; }
#define XB_SPIN(cond, bar) do { unsigned _sp = 0; while (cond) { __builtin_amdgcn_s_sleep(1); \
    if ((++_sp & 255u) == 0u) { if (xb_ld(&(bar)[XB_TMO])) break; if (_sp > XB_SPIN_CAP) { atomicAdd(&(bar)[XB_TMO], 1u); break; } } } } while (0)
struct XcdBarrier { unsigned* bar; unsigned x; volatile LAS unsigned* st; };
DI XcdBarrier xcd_barrier_post(unsigned* bar, volatile LAS unsigned* st) {
    XcdBarrier b; b.bar = bar; b.x = xb_xcc_id(); b.st = st;
    if (threadIdx.x == 0) (void)xb_add(&bar[XB_XCNT(b.x)], 1u);
    return b;
}
DI void xcd_barrier_complete(unsigned* bar, unsigned x, unsigned& nloc, unsigned& nx) {
    const unsigned G = gridDim.x * gridDim.y * gridDim.z;
    unsigned sum, cnt, mine, sp = 0u;
    for (;;) {
        sum = 0u; cnt = 0u; mine = 0u;
#pragma unroll
        for (unsigned j = 0; j < 16; ++j) { const unsigned c = xb_ld(&bar[XB_XCNT(j)]); sum += c; cnt += (c > 0u) ? 1u : 0u; mine = (j == x) ? c : mine; }
        if (sum == G) break;
        __builtin_amdgcn_s_sleep(1);
        if ((++sp & 255u) == 0u) { if (xb_ld(&bar[XB_TMO])) break; if (sp > XB_SPIN_CAP) { atomicAdd(&bar[XB_TMO], 1u); break; } }
    }
    nloc = mine > 0u ? mine : 1u; nx = cnt > 0u ? cnt : 1u;
}
DI void xcd_barrier_census(const XcdBarrier& b, const int wave_s) {
    if (wave_s != 0) return;
    const int ln = lane_id(); unsigned* bar = b.bar;
    const unsigned G = gridDim.x * gridDim.y * gridDim.z;
    unsigned sum = 0u, cnt = 0u, mine = 0u;
    for (unsigned sp = 0u; sp < 4096u; ++sp) {
        const unsigned c = ln < 16 ? xb_ld(&bar[XB_XCNT(ln & 15)]) : 0u;
        sum = 0u; cnt = 0u;
#pragma unroll
        for (int j = 0; j < 16; ++j) { const unsigned cj = (unsigned)__builtin_amdgcn_readlane((int)c, j); sum += cj; cnt += (cj > 0u) ? 1u : 0u; }
        mine = (unsigned)__builtin_amdgcn_readlane((int)c, (int)b.x);
        if (sum == G) break;
        __builtin_amdgcn_s_sleep(1);
    }
    if (sum == G && ln == 0) { b.st[0] = mine > 0u ? mine : 1u; b.st[1] = cnt > 0u ? cnt : 1u; }
    asm volatile("s_waitcnt lgkmcnt(0)" ::: "memory");
}
DI void xcd_barrier(const XcdBarrier& b, const int wave_s) {
    asm volatile("s_waitcnt vmcnt(0)" ::: "memory");
    __syncthreads();
    if (wave_s == 0 && lane_id() == 0) {
        unsigned* bar = b.bar;
        __builtin_amdgcn_s_waitcnt(0);
        unsigned nloc = b.st[0], nx = b.st[1];
        if (nloc == 0u) { xcd_barrier_complete(bar, b.x, nloc, nx); b.st[0] = nloc; b.st[1] = nx; }
        const unsigned old = xb_add(&bar[XB_XSUB(b.x)], 1u);
        const unsigned gen = old / nloc;
        if (old + 1u == (gen + 1u) * nloc) {
            __builtin_amdgcn_fence(__ATOMIC_RELEASE, "agent");
            asm volatile("s_waitcnt vmcnt(0)" ::: "memory");
            const unsigned og = xb_add(&bar[XB_TOP], 1u);
            const unsigned tg = og / nx;
            if (og + 1u == (tg + 1u) * nx) xb_add(&bar[XB_TOPGEN], 1u);
            else XB_SPIN(xb_ld(&bar[XB_TOPGEN]) == tg, bar);
            __builtin_amdgcn_fence(__ATOMIC_ACQUIRE, "agent");
            xb_add(&bar[XB_XGEN(b.x)], 1u);
            asm volatile("s_waitcnt vmcnt(0)" ::: "memory");
        } else {
            XB_SPIN(xb_ld(&bar[XB_XGEN(b.x)]) == gen, bar);
            __builtin_amdgcn_fence(__ATOMIC_ACQUIRE, "agent");
            asm volatile("s_waitcnt vmcnt(0)" ::: "memory");
        }
    }
    __syncthreads();
}

template <class F>
DI void xcd_barrier_fill(const XcdBarrier& b, const int wave_s, const F& fill) {
    asm volatile("s_waitcnt vmcnt(0)" ::: "memory");
    __syncthreads();
    if (wave_s != 0) { fill(); asm volatile("s_waitcnt vmcnt(0) lgkmcnt(0)" ::: "memory"); }
    else if (lane_id() == 0) {
        unsigned* bar = b.bar;
        __builtin_amdgcn_s_waitcnt(0);
        unsigned nloc = b.st[0], nx = b.st[1];
        if (nloc == 0u) { xcd_barrier_complete(bar, b.x, nloc, nx); b.st[0] = nloc; b.st[1] = nx; }
        const unsigned old = xb_add(&bar[XB_XSUB(b.x)], 1u);
        const unsigned gen = old / nloc;
        if (old + 1u == (gen + 1u) * nloc) {
            __builtin_amdgcn_fence(__ATOMIC_RELEASE, "agent");
            asm volatile("s_waitcnt vmcnt(0)" ::: "memory");
            const unsigned og = xb_add(&bar[XB_TOP], 1u);
            const unsigned tg = og / nx;
            if (og + 1u == (tg + 1u) * nx) xb_add(&bar[XB_TOPGEN], 1u);
            else XB_SPIN(xb_ld(&bar[XB_TOPGEN]) == tg, bar);
            __builtin_amdgcn_fence(__ATOMIC_ACQUIRE, "agent");
            xb_add(&bar[XB_XGEN(b.x)], 1u);
            asm volatile("s_waitcnt vmcnt(0)" ::: "memory");
        } else {
            XB_SPIN(xb_ld(&bar[XB_XGEN(b.x)]) == gen, bar);
            __builtin_amdgcn_fence(__ATOMIC_ACQUIRE, "agent");
            asm volatile("s_waitcnt vmcnt(0)" ::: "memory");
        }
    }
    __syncthreads();
}

constexpr int NWAVES = 8, NTHR = 512;
constexpr int LDS_BYTES = 147456;
constexpr int RING_BYTES = 131072, MISC_OFF = RING_BYTES + 320;

DI void p0_transpose_item(const float* W, int K, int N, u16* WT, LAS float* scr, int item, int lane, bool isin, u16* WV = nullptr, const float* gk = nullptr, const float* sk = nullptr) {
    const int nblk = N / 32, kb = item / nblk, nb = item % nblk, k0 = 64 * kb, n0 = 32 * nb;
    float wv[32];
    { const float* wp = W + (size_t)(k0 + (lane >> 5)) * N + n0 + (lane & 31);
#pragma unroll
      for (int i = 0; i < 32; ++i) wv[i] = __builtin_nontemporal_load(wp + (size_t)(2 * i) * N); }
    const int c = lane & 7;
    float cb[4][8];
    if (WV) {
#pragma unroll
        for (int i = 0; i < 8; ++i) { const int k = k0 + 8 * c + i; const float g = gk ? gk[k] : 1.f;
#pragma unroll
            for (int b = 0; b < 4; ++b) cb[b][i] = g * (1.f + sk[(size_t)b * 3072 + k]); } }
#pragma unroll
    for (int i = 0; i < 32; ++i) scr[(2 * i + (lane >> 5)) * 33 + (lane & 31)] = wv[i];
    asm volatile("s_waitcnt lgkmcnt(0)" ::: "memory");
#pragma unroll
    for (int j = 0; j < 4; ++j) { const int n = (lane >> 3) + 8 * j; const LAS float* s = scr + (8 * c) * 33 + n;
        float f[8];
#pragma unroll
        for (int i = 0; i < 8; ++i) f[i] = s[i * 33];
        const int dst = isin ? perm_in(n0 + n) : perm_out(n0 + n);
        if (WT) *(u32x4*)(WT + (size_t)dst * K + k0 + 8 * c) = pack8(f);
        if (WV) {
#pragma unroll
            for (int b = 0; b < 4; ++b) { float fb[8];
#pragma unroll
                for (int i = 0; i < 8; ++i) fb[i] = f[i] * cb[b][i];
                *(u32x4*)(WV + ((size_t)b * N + dst) * K + k0 + 8 * c) = pack8(fb); } } }
    asm volatile("s_waitcnt lgkmcnt(0)" ::: "memory");
}
DI void transpose_layer(const Params& p, int l, LAS unsigned char* lds, int widx, int nw, int lane, int wave, int which = 0) {
    LAS float* scr = (LAS float*)(lds + wave * 16384);
    constexpr int I_IN = (D / 64) * (DIN / 32), I_OUT = (D / 64) * (D / 32);
    for (int r = (which == 2 ? I_IN : 0) + widx; r < (which == 1 ? I_IN : I_IN + I_OUT); r += nw) {
        if (r < I_IN) { if (l > 0) p0_transpose_item(p.w_in + (size_t)l * D * DIN, D, DIN, (u16*)(p.ws + WS_WIN) + (size_t)l * DIN * D, scr, r, lane, true,
                                               (u16*)(p.ws + ((l & 1) ? WS_H : WS_WINV0)), p.ln_g + (size_t)(l - 1) * D, (const float*)(p.ws + WS_MOD) + (size_t)l * NMOD * 3072 + 1024);
                        else p0_transpose_item(p.w_in, D, DIN, (u16*)(p.ws + WS_WIN), scr, r, lane, true); }
        else p0_transpose_item(p.w_out + (size_t)l * D * D, D, D, (u16*)(p.ws + WS_WOUT) + (size_t)l * D * D, scr, r - I_IN, lane, false);
    }
}
DI void variants_layer0(const Params& p, LAS unsigned char* lds, int widx, int nw, int lane, int wave) {
    LAS float* scr = (LAS float*)(lds + wave * 16384);
    for (int r = widx; r < (D / 64) * (DIN / 32); r += nw) p0_transpose_item(p.w_in, D, DIN, (u16*)(p.ws + WS_WIN), scr, r, lane, true, (u16*)(p.ws + WS_WINV0), nullptr, (const float*)(p.ws + WS_MOD) + 1024);
}
DI void mod_unit(const Params& p, LAS unsigned char* lds, int unit, int tid, int lane, int wave) {
    const int l = unit >> 6, n0 = (unit & 63) * 48;
    const float* W = p.w_mod + (size_t)l * D * 3072;
    float* MOD = (float*)(p.ws + WS_MOD);
    const int fr = lane & 15, fq = lane >> 4;
    f32x4 acc[9][3];
#pragma unroll
    for (int rt = 0; rt < 9; ++rt)
#pragma unroll
        for (int ct = 0; ct < 3; ++ct) acc[rt][ct] = (f32x4){0.f, 0.f, 0.f, 0.f};
    float wn[3][8];
#pragma unroll
    for (int ct = 0; ct < 3; ++ct) { const float* wp = W + (size_t)(wave * 128 + fq * 8) * 3072 + n0 + 16 * ct + fr;
#pragma unroll
        for (int j = 0; j < 8; ++j) wn[ct][j] = __builtin_nontemporal_load(wp + (size_t)j * 3072); }
#pragma unroll
    for (int ks = 0; ks < 4; ++ks) {
        const int k0 = wave * 128 + ks * 32 + fq * 8;
        h8 bfr[3];
#pragma unroll
        for (int ct = 0; ct < 3; ++ct)
#pragma unroll
            for (int j = 0; j < 8; ++j) bfr[ct][j] = (_Float16)wn[ct][j];
        if (ks < 3) {
#pragma unroll
            for (int ct = 0; ct < 3; ++ct) { const float* wp = W + (size_t)(k0 + 32) * 3072 + n0 + 16 * ct + fr;
#pragma unroll
                for (int j = 0; j < 8; ++j) wn[ct][j] = __builtin_nontemporal_load(wp + (size_t)j * 3072); } }
#pragma unroll
        for (int rt = 0; rt < 9; ++rt) { const int row = 16 * rt + fr; h8 a;
            if (row < NMOD) { const float* c = row < NB ? p.c_prompt + (size_t)row * D : p.c_sample + (size_t)(row - NB) * D;
                const f32x4 c0 = *(const f32x4*)(c + k0), c1 = *(const f32x4*)(c + k0 + 4);
#pragma unroll
                for (int j = 0; j < 4; ++j) { a[j] = (_Float16)silu(c0[j]); a[4 + j] = (_Float16)silu(c1[j]); } }
            else {
#pragma unroll
                for (int j = 0; j < 8; ++j) a[j] = (_Float16)0.f; }
#pragma unroll
            for (int ct = 0; ct < 3; ++ct) acc[rt][ct] = __builtin_amdgcn_mfma_f32_16x16x32_f16(a, bfr[ct], acc[rt][ct], 0, 0, 0); }
    }
    LAS float* part = (LAS float*)lds;
#pragma unroll
    for (int rg = 0; rg < 3; ++rg) {
        __syncthreads();
#pragma unroll
        for (int r3 = 0; r3 < 3; ++r3)
#pragma unroll
            for (int ct = 0; ct < 3; ++ct)
#pragma unroll
                for (int i = 0; i < 4; ++i) part[(wave * 48 + r3 * 16 + 4 * fq + i) * 48 + 16 * ct + fr] = acc[rg * 3 + r3][ct][i];
        __syncthreads();
        for (int o = tid; o < 48 * 48; o += NTHR) { const int r48 = o / 48, col = o % 48, row = 48 * rg + r48; float sacc = 0.f;
#pragma unroll
            for (int w = 0; w < 8; ++w) sacc += part[(w * 48 + r48) * 48 + col];
            if (row < NMOD) MOD[((size_t)l * NMOD + row) * 3072 + n0 + col] = sacc + p.b_mod[(size_t)l * 3072 + n0 + col]; }
    }
    __syncthreads();
}
DI void sincos_d(double a, float& c, float& s) {
    const double k = __builtin_rint(a * 0.63661977236758134308);
    const double r = __builtin_fma(-k, 1.2246467991473532e-16 * 0.5, __builtin_fma(-k, 1.5707963267948966, a));
    const double r2 = r * r;
    double sp = -1.0 / 6227020800.0; sp = sp * r2 + 1.0 / 39916800.0; sp = sp * r2 - 1.0 / 362880.0; sp = sp * r2 + 1.0 / 5040.0; sp = sp * r2 - 1.0 / 120.0; sp = sp * r2 + 1.0 / 6.0;
    const double sn = r - r * r2 * sp;
    double cp = 1.0 / 87178291200.0; cp = cp * r2 - 1.0 / 479001600.0; cp = cp * r2 + 1.0 / 3628800.0; cp = cp * r2 - 1.0 / 40320.0; cp = cp * r2 + 1.0 / 720.0; cp = cp * r2 - 1.0 / 24.0; cp = cp * r2 + 0.5;
    const double cn = 1.0 - r2 * cp;
    const long long q = (long long)k & 3;
    const double cc = (q == 0) ? cn : (q == 1) ? -sn : (q == 2) ? -cn : sn;
    const double ss = (q == 0) ? sn : (q == 1) ? cn : (q == 2) ? -sn : -cn;
    c = (float)cc; s = (float)ss;
}
DI void p0_prologue(const Params& p, const __attribute__((address_space(4))) float* invf, LAS unsigned char* lds, int vcu, int G, int tid, int lane, int wave) {
    const int gw = vcu * NWAVES + wave, NGW = G * NWAVES;
    if (vcu & 1) transpose_layer(p, 0, lds, gw, NGW, lane, wave, 2);
    for (int u = vcu; u < 256; u += G) mod_unit(p, lds, u, tid, lane, wave);
    if (!(vcu & 1)) transpose_layer(p, 0, lds, gw, NGW, lane, wave, 2);
    if (vcu == 0 && wave < DEPTH) {
        float a = 0.f, b2 = 0.f, c2 = 0.f, d = 0.f, e = 0.f;
        for (int c = lane; c < D; c += 64) { const float g = p.ln_g[wave * D + c], bb = p.ln_b[wave * D + c]; a += g; b2 += g * g; c2 += g * bb; d += bb; e += bb * bb; }
        a = wave_sum(a); b2 = wave_sum(b2); c2 = wave_sum(c2); d = wave_sum(d); e = wave_sum(e);
        if (lane == 0) { float* o = (float*)(p.ws + WS_LNC) + wave * 8; o[0] = a; o[1] = b2; o[2] = c2; o[3] = d; o[4] = e; } }
    f32x2* tab = (f32x2*)(p.ws + WS_TAB);
    for (int e = vcu * NTHR + tid; e < (SEQ + DS) * 32; e += G * NTHR) {
        const int pi = e >> 5, i = e & 31; const int pos = pi < SEQ ? pi : PAST + (pi - SEQ);
        const float ang = (float)pos * invf[i];
        float c, s; sincos_d((double)ang, c, s);
        tab[e] = (f32x2){c, s};
    }
}

template <int R>
DI void ln_stats(float (&v)[R][16], float (&mean)[R], float (&rstd)[R]) {
    float s[R];
#pragma unroll
    for (int r = 0; r < R; ++r) { s[r] = 0.f;
#pragma unroll
        for (int k = 0; k < 16; ++k) s[r] += v[r][k]; }
#pragma unroll
    for (int r = 0; r < R; ++r) s[r] = wave_sum(s[r]);
#pragma unroll
    for (int r = 0; r < R; ++r) { mean[r] = s[r] * (1.f / D); s[r] = 0.f;
#pragma unroll
        for (int k = 0; k < 16; ++k) { v[r][k] -= mean[r]; s[r] += v[r][k] * v[r][k]; } }
#pragma unroll
    for (int r = 0; r < R; ++r) s[r] = wave_sum(s[r]);
#pragma unroll
    for (int r = 0; r < R; ++r) rstd[r] = 1.f / sqrtf(s[r] * (1.f / D) + LN_EPS);
}
constexpr int LNR = 3;
DI void pre_phase(const Params& p, int gw, int NGW, int lane) {
    const float* modl = (const float*)(p.ws + WS_MOD);
    u16* ZH = (u16*)(p.ws + WS_ZH); u16* XR = (u16*)(p.ws + WS_XR); u16* ZP = (u16*)(p.ws + WS_H); f32x4* RC0 = (f32x4*)(p.ws + WS_RC0);
    for (int row0 = gw; row0 < M; row0 += LNR * NGW) {
        float v[LNR][16]; bool ok[LNR]; float mean[LNR], rstd[LNR]; int rows[LNR];
#pragma unroll
        for (int r = 0; r < LNR; ++r) { rows[r] = row0 + r * NGW; ok[r] = rows[r] < M; if (!ok[r]) rows[r] = row0; }
#pragma unroll
        for (int r = 0; r < LNR; ++r) { const int row = rows[r]; const float* x = row < MP ? p.x_prompt + (size_t)row * D : p.x_sample + (size_t)(row - MP) * D;
#pragma unroll
            for (int j2 = 0; j2 < 2; ++j2) { const f32x4 a = __builtin_nontemporal_load((const f32x4*)(x + 512 * j2 + 8 * lane)), b = __builtin_nontemporal_load((const f32x4*)(x + 512 * j2 + 8 * lane + 4));
#pragma unroll
                for (int k = 0; k < 4; ++k) { v[r][8 * j2 + k] = a[k]; v[r][8 * j2 + 4 + k] = b[k]; } } }
#pragma unroll
        for (int r = 0; r < LNR; ++r) if (ok[r]) { u16* dst = rows[r] < MP ? ZH : XR;
#pragma unroll
            for (int j2 = 0; j2 < 2; ++j2) *(u32x4*)(dst + (size_t)rows[r] * D + 512 * j2 + 8 * lane) = pack8(v[r] + 8 * j2); }
        ln_stats<LNR>(v, mean, rstd);
#pragma unroll
        for (int r = 0; r < LNR; ++r) if (ok[r]) { const int row = rows[r]; const bool smp = row >= MP; const int bidx = smp ? NB + ((row - MP) >> 2) : (row >> 12);
            const float* sh = modl + (size_t)bidx * 3072; const float* sc = sh + 1024;
            if (!smp && lane == 0) RC0[row] = (f32x4){rstd[r], 0.f, rstd[r], rstd[r] * mean[r]};
            if (smp)
#pragma unroll
            for (int j2 = 0; j2 < 2; ++j2) { float o[8];
#pragma unroll
                for (int h = 0; h < 2; ++h) { const f32x4 a = *(const f32x4*)(sc + 512 * j2 + 8 * lane + 4 * h), bb = *(const f32x4*)(sh + 512 * j2 + 8 * lane + 4 * h);
#pragma unroll
                    for (int k = 0; k < 4; ++k) o[4 * h + k] = v[r][8 * j2 + 4 * h + k] * rstd[r] * (1.f + a[k]) + bb[k]; }
                *(u32x4*)(ZP + (size_t)row * D + 512 * j2 + 8 * lane) = pack8(o); } }
    }
}
DI void modv_unit(const Params& p, LAS unsigned char* lds, int unit, int tid, int lane, int wave) {
    const int l = unit / 40, cb = unit % 40, col = 64 * cb + lane;
    const float* W = p.w_in + (size_t)l * D * DIN + col; const float* modl = (const float*)(p.ws + WS_MOD) + (size_t)l * NMOD * 3072;
    LAS float* part = (LAS float*)lds;
    LAS float* cf = (LAS float*)(lds + 32768) + wave * 128 * 12;
    __syncthreads();
#pragma unroll
    for (int hlf = 0; hlf < 2; ++hlf) { const int ci = 64 * hlf + lane, c = wave * 128 + ci; LAS float* o = cf + ci * 12;
        o[0] = l > 0 ? p.ln_g[(l - 1) * D + c] : 1.f; o[1] = l > 0 ? p.ln_b[(l - 1) * D + c] : 0.f;
#pragma unroll
        for (int b = 0; b < 4; ++b) { o[2 + b] = 1.f + modl[b * 3072 + 1024 + c]; o[6 + b] = modl[b * 3072 + c]; } }
    asm volatile("s_waitcnt lgkmcnt(0)" ::: "memory");
    float acc[4][4];
#pragma unroll
    for (int b = 0; b < 4; ++b)
#pragma unroll
        for (int k = 0; k < 4; ++k) acc[b][k] = 0.f;
#pragma unroll 1
    for (int c0 = 0; c0 < 128; c0 += 32) { float wv[32];
#pragma unroll
        for (int i = 0; i < 32; ++i) wv[i] = W[(size_t)(wave * 128 + c0 + i) * DIN];
#pragma unroll
        for (int i = 0; i < 32; ++i) { const LAS f32x4* cp = (const LAS f32x4*)(cf + (c0 + i) * 12); const f32x4 q0 = cp[0], q1 = cp[1], q2 = cp[2];
            const float g = q0[0], bb = q0[1]; const float s1[4] = {q0[2], q0[3], q1[0], q1[1]}; const float sh[4] = {q1[2], q1[3], q2[0], q2[1]};
#pragma unroll
            for (int b = 0; b < 4; ++b) { const float sw = s1[b] * wv[i]; acc[b][0] += g * sw; acc[b][1] += bb * sw; acc[b][2] += sw; acc[b][3] += sh[b] * wv[i]; } } }
#pragma unroll
    for (int b = 0; b < 4; ++b)
#pragma unroll
        for (int k = 0; k < 4; ++k) part[(wave * 16 + b * 4 + k) * 64 + lane] = acc[b][k];
    __syncthreads();
    float* MODV = (float*)(p.ws + WS_MODV);
    for (int o = tid; o < 1024; o += NTHR) { const int idx = o >> 6, ln = o & 63; float sum = 0.f;
#pragma unroll
        for (int w = 0; w < 8; ++w) sum += part[(w * 16 + idx) * 64 + ln];
        MODV[((size_t)(l * NB + (idx >> 2)) * 4 + (idx & 3)) * DIN + perm_in(64 * cb + ln)] = sum; }
    __syncthreads();
}
DI void finalize_rc_in(const Params& p, int l, const int (&pms)[3], LAS float* rcl, int tid) {
    const int row = tid & 255;
    const int ua = tid >> 8, ub = 2;
    const bool hasA = pms[ua] >= 0 && pms[ua] < MP / 256, hasB = tid < 256 && pms[2] >= 0 && pms[2] < MP / 256;
    f32x4 ldA[6], ldB[6];
    const size_t rA = (size_t)(hasA ? pms[ua] : 0) * 256 + row, rB = (size_t)(hasB ? pms[2] : 0) * 256 + row;
    if (l == 0) { ldA[0] = ((const f32x4*)(p.ws + WS_RC0))[rA]; ldB[0] = ((const f32x4*)(p.ws + WS_RC0))[rB]; }
    else { const f32x4* psA = (const f32x4*)((const float*)(p.ws + WS_PS) + (size_t)((l - 1) & 1) * MP * 24 + rA * 24); const f32x4* psB = (const f32x4*)((const float*)(p.ws + WS_PS) + (size_t)((l - 1) & 1) * MP * 24 + rB * 24);
#pragma unroll
        for (int k = 0; k < 6; ++k) { ldA[k] = psA[k]; ldB[k] = psB[k]; } }
    auto fin = [&](const f32x4 (&ld)[6]) -> f32x4 {
        if (l == 0) return ld[0];
        const float* lnc = (const float*)(p.ws + WS_LNC) + (l - 1) * 8;
        float f[24];
#pragma unroll
        for (int k = 0; k < 6; ++k) { f[4 * k] = ld[k][0]; f[4 * k + 1] = ld[k][1]; f[4 * k + 2] = ld[k][2]; f[4 * k + 3] = ld[k][3]; }
        float S[6];
#pragma unroll
        for (int k = 0; k < 6; ++k) S[k] = (f[k] + f[6 + k]) + (f[12 + k] + f[18 + k]);
        float N1 = 1.f / D, two = 2.f; asm volatile("" : "+v"(N1), "+v"(two));
        const float mu = S[0] * N1, rstd = 1.f / sqrtf(S[1] * N1 - mu * mu + LN_EPS);
        const float m2 = (rstd * (S[2] - mu * lnc[0]) + lnc[3]) * N1;
        const float e2 = (rstd * rstd * (S[3] - two * mu * S[4] + mu * mu * lnc[1]) + two * rstd * (S[5] - mu * lnc[2]) + lnc[4]) * N1;
        const float rstd2 = 1.f / sqrtf(e2 - m2 * m2 + LN_EPS);
        return (f32x4){rstd * rstd2, rstd * rstd2 * mu, rstd2, rstd2 * m2}; };
    if (hasA) *(LAS f32x4*)(rcl + ua * 1024 + 4 * row) = fin(ldA);
    if (hasB) *(LAS f32x4*)(rcl + ub * 1024 + 4 * row) = fin(ldB);
}
DI void fin_phase(const Params& p, int gw, int NGW, int lane) {
    const u16* ZH = (const u16*)(p.ws + WS_ZH);
    const float* lg = p.ln_g + (size_t)(DEPTH - 1) * D; const float* lb = p.ln_b + (size_t)(DEPTH - 1) * D;
    for (int row0 = gw; row0 < MP; row0 += LNR * NGW) {
        float v[LNR][16]; bool ok[LNR]; float mean[LNR], rstd[LNR]; int rows[LNR];
#pragma unroll
        for (int r = 0; r < LNR; ++r) { rows[r] = row0 + r * NGW; ok[r] = rows[r] < MP; if (!ok[r]) rows[r] = row0; }
#pragma unroll
        for (int r = 0; r < LNR; ++r)
#pragma unroll
            for (int j2 = 0; j2 < 2; ++j2) unpack8(*(const u32x4*)(ZH + (size_t)rows[r] * D + 512 * j2 + 8 * lane), v[r] + 8 * j2);
        ln_stats<LNR>(v, mean, rstd);
#pragma unroll
        for (int j2 = 0; j2 < 2; ++j2)
#pragma unroll
            for (int h = 0; h < 2; ++h) { const f32x4 g = *(const f32x4*)(lg + 512 * j2 + 8 * lane + 4 * h), bb = *(const f32x4*)(lb + 512 * j2 + 8 * lane + 4 * h);
#pragma unroll
                for (int r = 0; r < LNR; ++r) if (ok[r]) { f32x4 o;
#pragma unroll
                    for (int k = 0; k < 4; ++k) o[k] = v[r][8 * j2 + 4 * h + k] * rstd[r] * g[k] + bb[k];
                    *(f32x4*)(p.out + (size_t)rows[r] * D + 512 * j2 + 8 * lane + 4 * h) = o; } }
    }
}

struct MixPtrs { const u16 *PA, *PSZC, *PPV, *PSZP, *PQ, *PSZA, *PK, *PV; u16* MIX; };
DI v4i16_t ds_tr(const LAS unsigned char* a) { return __builtin_amdgcn_ds_read_tr16_b64_v4i16((LAS v4i16_t*)a); }

DI void attn_prompt_unit(const Params& p, const MixPtrs& X, int l, int unit, LAS unsigned char* lds, int tid, int lane, int wave) {
    const int xg = unit >> 5, b = xg >> 1, hk = (unit >> 4) & 1, nb = (xg & 1) * 16 + (unit & 15), q0 = nb * 128; const size_t rb = (size_t)b * SEQ;
    LAS unsigned char* Ks = lds; LAS unsigned char* Vs = lds + 36864;
    const int g = wave & 3, qh = wave >> 2, head = 4 * hk + g, r = lane & 31, h = lane >> 5;
    u32x4 kvr[4], vvr[4];
#pragma unroll
    for (int i = 0; i < 4; ++i) { const int c = tid + 512 * i, key = c >> 3, ch = c & 7, tk = q0 - 128 + key, tkc = tk < 0 ? 0 : tk;
        kvr[i] = *(const u32x4*)(X.PK + (rb + tkc) * 128 + hk * 64 + ch * 8); vvr[i] = *(const u32x4*)(X.PV + (rb + tkc) * 128 + hk * 64 + ch * 8); }
    h8 qfA[4], qfB[4]; u32x2 zgA[2][4], zgB[2][4];
    { const size_t qr0 = rb + q0 + 64 * qh + r, qr1 = qr0 + 32;
#pragma unroll
      for (int s = 0; s < 4; ++s) { qfA[s] = *(const h8*)(X.PQ + qr0 * 512 + head * 64 + 16 * s + 8 * h); qfB[s] = *(const h8*)(X.PQ + qr1 * 512 + head * 64 + 16 * s + 8 * h); }
#pragma unroll
      for (int db = 0; db < 2; ++db)
#pragma unroll
          for (int xq = 0; xq < 4; ++xq) { const int col = head * 64 + 32 * db + 8 * xq + 4 * h; zgA[db][xq] = *(const u32x2*)(X.PSZA + qr0 * 512 + col); zgB[db][xq] = *(const u32x2*)(X.PSZA + qr1 * 512 + col); } }
#pragma unroll
    for (int i = 0; i < 4; ++i) { const int c = tid + 512 * i, key = c >> 3, ch = c & 7;
        *(LAS u32x4*)(Ks + key * 144 + ch * 16) = kvr[i]; *(LAS u32x4*)(Vs + (ch >> 2) * 16384 + key * 64 + (ch & 3) * 16) = vvr[i]; }
    __syncthreads();
    const float sink2 = p.sinks[l * 8 + head] * LOG2E;
    const int trq = (lane & 15) >> 2, trp = lane & 3, trg = (lane >> 4) & 1;
    const float NEG = -INFINITY;
    auto half = [&](const h8 (&qf)[4], const u32x2 (&zg)[2][4], const int e) {
        const int ql = 64 * qh + 32 * e; const size_t qrow = rb + q0 + ql + r;
        f32x16 S[5];
#pragma unroll
        for (int i = 0; i < 5; ++i) { const int kl = ql + 32 * i; const bool valid = (nb > 0) || (kl >= 128);
#pragma unroll
            for (int x = 0; x < 16; ++x) S[i][x] = 0.f;
            if (valid) {
#pragma unroll
                for (int s = 0; s < 4; ++s) { const h8 kf = *(const LAS h8*)(Ks + (kl + r) * 144 + (16 * s + 8 * h) * 2); S[i] = __builtin_amdgcn_mfma_f32_32x32x16_f16(kf, qf[s], S[i], 0, 0, 0); }
            } else {
#pragma unroll
                for (int x = 0; x < 16; ++x) S[i][x] = NEG; }
            if (i == 0) {
#pragma unroll
                for (int x = 0; x < 16; ++x) if (!(crow(x, h) > r)) S[i][x] = NEG; }
            if (i == 4) {
#pragma unroll
                for (int x = 0; x < 16; ++x) if (!(crow(x, h) <= r)) S[i][x] = NEG; }
        }
        float mx = sink2;
#pragma unroll
        for (int i = 0; i < 5; ++i)
#pragma unroll
            for (int x = 0; x < 16; ++x) mx = fmaxf(mx, S[i][x]);
        mx = max_halves(mx);
        float sum = 0.f;
#pragma unroll
        for (int i = 0; i < 5; ++i)
#pragma unroll
            for (int x = 0; x < 16; ++x) { S[i][x] = ex2(S[i][x] - mx); sum += S[i][x]; }
        sum = sum_halves(sum);
        const float inv = 1.f / (sum + ex2(sink2 - mx));
        f32x16 O[2];
#pragma unroll
        for (int x = 0; x < 16; ++x) { O[0][x] = 0.f; O[1][x] = 0.f; }
#pragma unroll
        for (int i = 0; i < 5; ++i) { const int kl = ql + 32 * i; const bool valid = (nb > 0) || (kl >= 128);
            if (valid) {
#pragma unroll
                for (int s2 = 0; s2 < 2; ++s2) { float pv8[8];
#pragma unroll
                    for (int j = 0; j < 8; ++j) pv8[j] = S[i][8 * s2 + j] * inv;
                    const h8 pa = __builtin_bit_cast(h8, pack8(pv8));
#pragma unroll
                    for (int db = 0; db < 2; ++db) { const LAS unsigned char* va = Vs + db * 16384 + (kl + 16 * s2 + 4 * h + trq) * 64 + trg * 32 + trp * 8;
                        const v4i16_t lo = ds_tr(va), hi = ds_tr(va + 512);
                        const h8 vf = __builtin_bit_cast(h8, __builtin_shufflevector(lo, hi, 0, 1, 2, 3, 4, 5, 6, 7));
                        O[db] = __builtin_amdgcn_mfma_f32_32x32x16_f16(vf, pa, O[db], 0, 0, 0); } } } }
#pragma unroll
        for (int db = 0; db < 2; ++db)
#pragma unroll
            for (int xq = 0; xq < 4; ++xq) { const int col = head * 64 + 32 * db + 8 * xq + 4 * h; const h4 z = __builtin_bit_cast(h4, zg[db][xq]);
                u32x2 w; w.x = pkh(O[db][4 * xq] * (float)z[0], O[db][4 * xq + 1] * (float)z[1]); w.y = pkh(O[db][4 * xq + 2] * (float)z[2], O[db][4 * xq + 3] * (float)z[3]);
                *(u32x2*)(X.MIX + qrow * D + 512 + col) = w; }
    };
    half(qfA, zgA, 0);
    half(qfB, zgB, 1);
    __syncthreads();
}

constexpr int MX_WPT = 81920;
constexpr int MX_SCR = 0, MX_SCR_W = 7168;
DI void conv_prompt_unit(const Params& p, const MixPtrs& X, int l, int unit, LAS unsigned char* lds, int tid, int lane, int wave) {
    const int R0 = unit * 64, b = R0 >> 12, t0 = R0 & (SEQ - 1); const size_t rb = (size_t)b * SEQ;
    LAS unsigned char* WL = lds + 94 * 512;
    u32x4 tv[6]; f32x4 wq[4];
#pragma unroll
    for (int i = 0; i < 6; ++i) { const int c = tid + 512 * i, cc = c < 94 * 32 ? c : 94 * 32 - 1, row = cc >> 5, ch = cc & 31, tk = t0 - 30 + row, tkc = tk < 0 ? 0 : tk;
        tv[i] = *(const u32x4*)(X.PA + (rb + tkc) * 256 + ch * 8); }
#pragma unroll
    for (int i = 0; i < 4; ++i) { const int c = tid + 512 * i, cc = c < 31 * 64 ? c : 31 * 64 - 1; wq[i] = *(const f32x4*)(p.conv_w + (size_t)l * 31 * 256 + 4 * cc); }
    const f32x4 bias = *(const f32x4*)(p.conv_b + l * 256 + 4 * lane), cg = *(const f32x4*)(p.cnorm_g + l * 256 + 4 * lane), cb = *(const f32x4*)(p.cnorm_b + l * 256 + 4 * lane);
    u32x2 zcv[8];
#pragma unroll
    for (int tt = 0; tt < 8; ++tt) zcv[tt] = *(const u32x2*)(X.PSZC + ((size_t)R0 + 8 * wave + tt) * 256 + 4 * lane);
#pragma unroll
    for (int i = 0; i < 6; ++i) { const int c = tid + 512 * i, row = c >> 5, ch = c & 31; const unsigned msk = (unsigned)-(int)(t0 - 30 + row >= 0);
        if (c < 94 * 32) *(LAS u32x4*)(lds + row * 512 + ch * 16) = (u32x4){tv[i][0] & msk, tv[i][1] & msk, tv[i][2] & msk, tv[i][3] & msk}; }
#pragma unroll
    for (int i = 0; i < 4; ++i) { const int c = tid + 512 * i; if (c < 31 * 64) *(LAS f32x4*)(WL + c * 16) = wq[i]; }
    __syncthreads();
    f32x4 acc[8], win[8];
#pragma unroll
    for (int tt = 0; tt < 8; ++tt) acc[tt] = bias;
    const LAS unsigned char* arow = lds + (8 * wave) * 512 + lane * 8;
#pragma unroll
    for (int k = 0; k < 7; ++k) win[k] = __builtin_convertvector(*(const LAS h4*)(arow + k * 512), f32x4);
#pragma unroll 1
    for (int jb = 0; jb < 4; ++jb) {
#pragma unroll
        for (int jj = 0; jj < 8; ++jj) { const int j = 8 * jb + jj;
            if (j < 31) {
                win[(jj + 7) & 7] = __builtin_convertvector(*(const LAS h4*)(arow + (j + 7) * 512), f32x4);
                const f32x4 w = *(const LAS f32x4*)(WL + j * 1024 + lane * 16);
#pragma unroll
                for (int tt = 0; tt < 8; ++tt) acc[tt] += w * win[(jj + tt) & 7]; } } }
#pragma unroll
    for (int tt = 0; tt < 8; ++tt) { const size_t row = (size_t)R0 + 8 * wave + tt;
        const float mean = wave_sum((acc[tt][0] + acc[tt][1]) + (acc[tt][2] + acc[tt][3])) * (1.f / 256.f);
        const f32x4 d = acc[tt] - mean;
        const float rstd = 1.f / sqrtf(wave_sum((d[0] * d[0] + d[1] * d[1]) + (d[2] * d[2] + d[3] * d[3])) * (1.f / 256.f) + LN_EPS);
        const h4 zc = __builtin_bit_cast(h4, zcv[tt]); float o[4];
#pragma unroll
        for (int k = 0; k < 4; ++k) o[k] = silu(d[k] * rstd * cg[k] + cb[k]) * (float)zc[k];
        u32x2 w; w.x = pkh(o[0], o[1]); w.y = pkh(o[2], o[3]);
        *(u32x2*)(X.MIX + row * D + 4 * lane) = w; }
    __syncthreads();
}

DI void task_pool(const Params& p, int l, int R0, int th, int g, LAS unsigned char* lds, int wave, int lane) {
    const u16* PPV = (const u16*)(p.ws + WS_PPV); const u16* PSZP = (const u16*)(p.ws + WS_PSZP); u16* MIX = (u16*)(p.ws + WS_MIX);
    const int b = R0 >> 12, T0 = (R0 & (SEQ - 1)) + 32 * th; const size_t rb = (size_t)b * SEQ;
    LAS unsigned char* scr = lds + MX_SCR + wave * MX_SCR_W;
    const int r = lane & 31, h = lane >> 5;
    u32x4 tl[6];
#pragma unroll
    for (int i = 0; i < 6; ++i) { const int row = (lane >> 3) + 8 * i, tk = T0 - 15 + row; const int tkc = tk < 0 ? 0 : (row < 47 ? tk : T0 + 31);
        const u32x4 v = *(const u32x4*)(PPV + (rb + tkc) * 256 + 64 * g + 8 * (lane & 7)); const unsigned msk = (unsigned)-(int)(tk >= 0); tl[i] = (u32x4){v[0] & msk, v[1] & msk, v[2] & msk, v[3] & msk}; }
    const size_t orow = rb + T0 + r;
    u32x2 zp[2][4]; f32x4 ps[2][4];
#pragma unroll
    for (int nb = 0; nb < 2; ++nb)
#pragma unroll
        for (int xq = 0; xq < 4; ++xq) { const int col = 64 * g + 32 * nb + 8 * xq + 4 * h; zp[nb][xq] = *(const u32x2*)(PSZP + orow * 256 + col); ps[nb][xq] = *(const f32x4*)(p.pool_scale + l * 256 + col); }
#pragma unroll
    for (int i = 0; i < 6; ++i) { const int row = (lane >> 3) + 8 * i; if (row < 47) *(LAS u32x4*)(scr + row * 144 + (lane & 7) * 16) = tl[i]; }
    asm volatile("s_waitcnt lgkmcnt(0)" ::: "memory");
    const int wlen = 2 << g; const int t = T0 + r; const float icnt = 1.f / (float)(wlen < t + 1 ? wlen : t + 1);
    h8 bf[4];
#pragma unroll
    for (int s = 0; s < 4; ++s) { const LAS unsigned char* base = scr + (15 + r) * 144 + (16 * s + 8 * h) * 2; float sm[8];
        const h8 cur = *(const LAS h8*)base;
#pragma unroll
        for (int k = 0; k < 8; ++k) sm[k] = (float)cur[k];
        for (int i = 1; i < wlen; ++i) { const h8 v = *(const LAS h8*)(base - i * 144);
#pragma unroll
            for (int k = 0; k < 8; ++k) sm[k] += (float)v[k]; }
        float pl[8];
#pragma unroll
        for (int k = 0; k < 8; ++k) pl[k] = sm[k] * icnt - (float)cur[k];
        bf[s] = __builtin_bit_cast(h8, pack8(pl)); }
    f32x16 Dd[2];
#pragma unroll
    for (int x = 0; x < 16; ++x) { Dd[0][x] = 0.f; Dd[1][x] = 0.f; }
#pragma unroll
    for (int s = 0; s < 4; ++s)
#pragma unroll
        for (int nb = 0; nb < 2; ++nb) { const h8 af = *(const LAS h8*)(lds + MX_WPT + ((g * 64 + 32 * nb + r) * 72 + 16 * s + 8 * h) * 2);
            Dd[nb] = __builtin_amdgcn_mfma_f32_32x32x16_f16(af, bf[s], Dd[nb], 0, 0, 0); }
#pragma unroll
    for (int nb = 0; nb < 2; ++nb)
#pragma unroll
        for (int xq = 0; xq < 4; ++xq) { const int col = 64 * g + 32 * nb + 8 * xq + 4 * h; const h4 z = __builtin_bit_cast(h4, zp[nb][xq]); const f32x4 sc = ps[nb][xq];
            u32x2 w; w.x = pkh(Dd[nb][4 * xq] * sc[0] * (float)z[0], Dd[nb][4 * xq + 1] * sc[1] * (float)z[1]); w.y = pkh(Dd[nb][4 * xq + 2] * sc[2] * (float)z[2], Dd[nb][4 * xq + 3] * sc[3] * (float)z[3]);
            *(u32x2*)(MIX + orow * D + 256 + col) = w; }
}
DI void convpool_sample_unit(const Params& p, const MixPtrs& X, int l, int b, int part, LAS unsigned char* lds, int tid, int lane, int wave) {
    LAS float* cv = (LAS float*)lds;
    const int c = tid & 255, tp = tid >> 8; const size_t r0 = (size_t)MP + 4 * b;
    if (part == 0) {
        const float* cc = p.cache_conv + (size_t)(l * DB + b) * 30 * 256;
        float xa[34], wv[31];
        { const float* pc = cc + c;
#pragma unroll
          for (int ri = 0; ri < 30; ++ri) xa[ri] = __builtin_nontemporal_load(pc + ri * 256);
          const u16* pn = X.PA + r0 * 256 + c;
#pragma unroll
          for (int ri = 0; ri < 4; ++ri) xa[30 + ri] = (float)(*(const _Float16*)(pn + ri * 256));
          const float* pw = p.conv_w + (size_t)l * 31 * 256 + c;
#pragma unroll
          for (int j = 0; j < 31; ++j) wv[j] = pw[j * 256]; }
        float a0 = p.conv_b[l * 256 + c], a1 = a0;
        if (tp == 0) {
#pragma unroll
            for (int j = 0; j < 31; ++j) { a0 += wv[j] * xa[j]; a1 += wv[j] * xa[j + 1]; }
        } else {
#pragma unroll
            for (int j = 0; j < 31; ++j) { a0 += wv[j] * xa[j + 2]; a1 += wv[j] * xa[j + 3]; } }
        cv[(2 * tp) * 256 + c] = a0; cv[(2 * tp + 1) * 256 + c] = a1;
        { float* oc = p.out + OFF_CONVS + (size_t)(l * DB + b) * 30 * 256; for (int e = tid; e < 26 * 64; e += NTHR) *(f32x4*)(oc + 4 * e) = *(const f32x4*)(cc + 4 * 256 + 4 * e); }
        __syncthreads();
        if (wave < 4) { const int t = wave; const f32x4 v = *(const LAS f32x4*)(cv + t * 256 + 4 * lane);
            const float mean = wave_sum((v[0] + v[1]) + (v[2] + v[3])) * (1.f / 256.f); const f32x4 d = v - mean;
            const float rstd = 1.f / sqrtf(wave_sum((d[0] * d[0] + d[1] * d[1]) + (d[2] * d[2] + d[3] * d[3])) * (1.f / 256.f) + LN_EPS);
            const f32x4 cg = *(const f32x4*)(p.cnorm_g + l * 256 + 4 * lane), cb = *(const f32x4*)(p.cnorm_b + l * 256 + 4 * lane);
            const h4 zc = *(const h4*)(X.PSZC + (r0 + t) * 256 + 4 * lane); float o[4];
#pragma unroll
            for (int k = 0; k < 4; ++k) o[k] = silu(d[k] * rstd * cg[k] + cb[k]) * (float)zc[k];
            u32x2 w; w.x = pkh(o[0], o[1]); w.y = pkh(o[2], o[3]);
            *(u32x2*)(X.MIX + (r0 + t) * D + 4 * lane) = w; }
    } else {
        const float* cp = p.cache_pool + (size_t)(l * DB + b) * 15 * 256;
        float xa[19];
        { const float* pc = cp + c;
#pragma unroll
          for (int ri = 0; ri < 15; ++ri) xa[ri] = __builtin_nontemporal_load(pc + ri * 256);
          const u16* pn = X.PPV + r0 * 256 + c;
#pragma unroll
          for (int ri = 0; ri < 4; ++ri) xa[15 + ri] = (float)(*(const _Float16*)(pn + ri * 256)); }
        const int wlen = 2 << (c >> 6); float s0 = 0.f, s1 = 0.f, c0, c1;
        if (tp == 0) { c0 = xa[15]; c1 = xa[16];
#pragma unroll
            for (int i = 0; i < 16; ++i) if (i < wlen) { s0 += xa[15 - i]; s1 += xa[16 - i]; }
        } else { c0 = xa[17]; c1 = xa[18];
#pragma unroll
            for (int i = 0; i < 16; ++i) if (i < wlen) { s0 += xa[17 - i]; s1 += xa[18 - i]; } }
        const float iw = 1.f / (float)wlen;
        cv[(2 * tp) * 256 + c] = s0 * iw - c0; cv[(2 * tp + 1) * 256 + c] = s1 * iw - c1;
        { float* op = p.out + OFF_POOLS + (size_t)(l * DB + b) * 15 * 256; for (int e = tid; e < 11 * 64; e += NTHR) *(f32x4*)(op + 4 * e) = *(const f32x4*)(cp + 4 * 256 + 4 * e); }
        __syncthreads();
        const int g = c >> 6, n = c & 63; const float* pw = p.pool_w + ((size_t)l * 4 + g) * 64 * 64 + n; float y0 = 0.f, y1 = 0.f;
#pragma unroll 16
        for (int k = 0; k < 64; ++k) { const float w = pw[(size_t)k * 64]; y0 += cv[(2 * tp) * 256 + 64 * g + k] * w; y1 += cv[(2 * tp + 1) * 256 + 64 * g + k] * w; }
        const float ps = p.pool_scale[l * 256 + c];
        const float z0 = (float)(*(const _Float16*)(X.PSZP + (r0 + 2 * tp) * 256 + c)), z1 = (float)(*(const _Float16*)(X.PSZP + (r0 + 2 * tp + 1) * 256 + c));
        *(_Float16*)(X.MIX + (r0 + 2 * tp) * D + 256 + c) = (_Float16)(y0 * ps * z0); *(_Float16*)(X.MIX + (r0 + 2 * tp + 1) * D + 256 + c) = (_Float16)(y1 * ps * z1); }
    __syncthreads();
}

DI void attn_sample_unit(const Params& p, const MixPtrs& X, int l, int unit, LAS unsigned char* lds, int tid, int lane, int wave) {
    const int b = unit >> 1, hk = unit & 1; const size_t r0 = (size_t)MP + 4 * b;
    LAS float* EX = (LAS float*)lds;
    LAS float* OP = EX + 256;
    const float* ck = p.cache_k + ((size_t)(l * DB + b) * 128 * 2 + hk) * 64; const float* cvv = p.cache_v + ((size_t)(l * DB + b) * 128 * 2 + hk) * 64;
    float* ok = p.out + OFF_KS + ((size_t)(l * DB + b) * 128 * 2 + hk) * 64; float* ov = p.out + OFF_VS + ((size_t)(l * DB + b) * 128 * 2 + hk) * 64;
    f32x4 ckv[4], cvw[4];
#pragma unroll
    for (int i = 0; i < 4; ++i) { const int e = tid + 512 * i, j = e >> 4, d4 = (e & 15) * 4; ckv[i] = *(const f32x4*)(ck + (size_t)j * 128 + d4); cvw[i] = *(const f32x4*)(cvv + (size_t)j * 128 + d4); }
    const int fr = lane & 15, fq = lane >> 4;
    f32x4 O[4]; f32x4 Sa = {0.f, 0.f, 0.f, 0.f}, Sb = {0.f, 0.f, 0.f, 0.f};
    float vg[4][8];
    const int kA = 32 * wave + fr, kB = kA + 16;
    if (wave < 5) {
        h8 ka[2], kb[2], qf[2];
#pragma unroll
        for (int ks = 0; ks < 2; ++ks) { const int d0 = 32 * ks + 8 * fq;
            qf[ks] = *(const h8*)(X.PQ + (r0 + (fr >> 2)) * 512 + (4 * hk + (fr & 3)) * 64 + d0);
            if (wave < 4) { const f32x4 a0 = *(const f32x4*)(ck + (size_t)kA * 128 + d0), a1 = *(const f32x4*)(ck + (size_t)kA * 128 + d0 + 4), b0 = *(const f32x4*)(ck + (size_t)kB * 128 + d0), b1 = *(const f32x4*)(ck + (size_t)kB * 128 + d0 + 4);
                float t8[8] = {a0[0], a0[1], a0[2], a0[3], a1[0], a1[1], a1[2], a1[3]}; ka[ks] = __builtin_bit_cast(h8, pack8(t8));
                float u8[8] = {b0[0], b0[1], b0[2], b0[3], b1[0], b1[1], b1[2], b1[3]}; kb[ks] = __builtin_bit_cast(h8, pack8(u8));
            } else { const int rr = fr < 4 ? fr : 0; const u32x4 raw = *(const u32x4*)(X.PK + (r0 + rr) * 128 + hk * 64 + d0); ka[ks] = __builtin_bit_cast(h8, fr < 4 ? raw : (u32x4){0u, 0u, 0u, 0u}); kb[ks] = __builtin_bit_cast(h8, (u32x4){0u, 0u, 0u, 0u}); } }
#pragma unroll
        for (int dt = 0; dt < 4; ++dt)
#pragma unroll
            for (int j = 0; j < 8; ++j) { const int key = 32 * wave + (j < 4 ? 0 : 16) + 4 * fq + (j & 3); const int d = 16 * dt + fr;
                if (wave < 4) vg[dt][j] = cvv[(size_t)key * 128 + d];
                else vg[dt][j] = key < 132 ? (float)(*(const _Float16*)(X.PV + (r0 + (key - 128)) * 128 + hk * 64 + d)) : 0.f; }
#pragma unroll
        for (int ks = 0; ks < 2; ++ks) { Sa = __builtin_amdgcn_mfma_f32_16x16x32_f16(ka[ks], qf[ks], Sa, 0, 0, 0); Sb = __builtin_amdgcn_mfma_f32_16x16x32_f16(kb[ks], qf[ks], Sb, 0, 0, 0); }
        const int t = fr >> 2; float mx = -INFINITY;
#pragma unroll
        for (int i = 0; i < 4; ++i) { const int k0 = 32 * wave + 4 * fq + i, k1 = k0 + 16;
            Sa[i] = (k0 >= t + 1 && k0 <= t + 128) ? Sa[i] : -INFINITY; Sb[i] = (k1 >= t + 1 && k1 <= t + 128) ? Sb[i] : -INFINITY; mx = fmaxf(mx, fmaxf(Sa[i], Sb[i])); }
        mx = fmaxf(mx, xor_lane<16>(mx)); mx = max_halves(mx);
        if (fq == 0) EX[wave * 16 + fr] = mx;
    }
#pragma unroll
    for (int i = 0; i < 4; ++i) { const int e = tid + 512 * i, j = e >> 4, d4 = (e & 15) * 4; if (j >= 4) { *(f32x4*)(ok + (size_t)(j - 4) * 128 + d4) = ckv[i]; *(f32x4*)(ov + (size_t)(j - 4) * 128 + d4) = cvw[i]; } }
    __syncthreads();
    if (wave < 5) {
        const float sink2 = p.sinks[l * 8 + 4 * hk + (fr & 3)] * LOG2E;
        float m = sink2;
#pragma unroll
        for (int w = 0; w < 5; ++w) m = fmaxf(m, EX[w * 16 + fr]);
        float sum = 0.f;
#pragma unroll
        for (int i = 0; i < 4; ++i) { Sa[i] = ex2(Sa[i] - m); Sb[i] = ex2(Sb[i] - m); sum += Sa[i] + Sb[i]; }
        sum += xor_lane<16>(sum); sum = sum_halves(sum);
        if (fq == 0) EX[128 + wave * 16 + fr] = sum;
        float p8[8] = {Sa[0], Sa[1], Sa[2], Sa[3], Sb[0], Sb[1], Sb[2], Sb[3]}; const h8 pb = __builtin_bit_cast(h8, pack8(p8));
#pragma unroll
        for (int dt = 0; dt < 4; ++dt) { const h8 va = __builtin_bit_cast(h8, pack8(vg[dt])); O[dt] = __builtin_amdgcn_mfma_f32_16x16x32_f16(va, pb, (f32x4){0.f, 0.f, 0.f, 0.f}, 0, 0, 0);
#pragma unroll
            for (int i = 0; i < 4; ++i) OP[(wave * 64 + 16 * dt + 4 * fq + i) * 16 + fr] = O[dt][i]; }
    }
    __syncthreads();
    { const int qr = tid & 15, dg = tid >> 4, t = qr >> 2, g = qr & 3;
        const float sink2 = p.sinks[l * 8 + 4 * hk + g] * LOG2E; float m = sink2, den = 0.f, o0 = 0.f, o1 = 0.f;
#pragma unroll
        for (int w = 0; w < 5; ++w) { m = fmaxf(m, EX[w * 16 + qr]); den += EX[128 + w * 16 + qr]; o0 += OP[(w * 64 + 2 * dg) * 16 + qr]; o1 += OP[(w * 64 + 2 * dg + 1) * 16 + qr]; }
        const float inv = 1.f / (den + ex2(sink2 - m));
        const int col = (4 * hk + g) * 64 + 2 * dg;
        const h2 z = *(const h2*)(X.PSZA + (r0 + t) * 512 + col);
        *(unsigned*)(X.MIX + (r0 + t) * D + 512 + col) = pkh(o0 * inv * (float)z[0], o1 * inv * (float)z[1]); }
    __syncthreads();
}

template <int R>
DI void sample_ln_rows(const Params& p, int l, int row0, int lane) {
    const u16* ZH = (const u16*)(p.ws + WS_ZH); u16* XR = (u16*)(p.ws + WS_XR); u16* ZP = (u16*)(p.ws + WS_H);
    const float* lg = p.ln_g + (size_t)l * D; const float* lb = p.ln_b + (size_t)l * D;
    const float* modn = (const float*)(p.ws + WS_MOD) + (size_t)(l + 1) * NMOD * 3072;
    float v[R][16], mean[R], rstd[R];
#pragma unroll
    for (int r = 0; r < R; ++r)
#pragma unroll
        for (int j2 = 0; j2 < 2; ++j2) unpack8(*(const u32x4*)(ZH + (size_t)(row0 + r) * D + 512 * j2 + 8 * lane), v[r] + 8 * j2);
    ln_stats<R>(v, mean, rstd);
#pragma unroll
    for (int j2 = 0; j2 < 2; ++j2)
#pragma unroll
        for (int h = 0; h < 2; ++h) { const f32x4 g = *(const f32x4*)(lg + 512 * j2 + 8 * lane + 4 * h), bb = *(const f32x4*)(lb + 512 * j2 + 8 * lane + 4 * h);
#pragma unroll
            for (int r = 0; r < R; ++r)
#pragma unroll
                for (int k = 0; k < 4; ++k) v[r][8 * j2 + 4 * h + k] = v[r][8 * j2 + 4 * h + k] * rstd[r] * g[k] + bb[k]; }
    if (l == DEPTH - 1) {
#pragma unroll
        for (int r = 0; r < R; ++r) { float* y = p.out + OFF_YS + (size_t)(row0 - MP + r) * D;
#pragma unroll
            for (int j2 = 0; j2 < 2; ++j2)
#pragma unroll
                for (int h = 0; h < 2; ++h) *(f32x4*)(y + 512 * j2 + 8 * lane + 4 * h) = (f32x4){v[r][8 * j2 + 4 * h], v[r][8 * j2 + 4 * h + 1], v[r][8 * j2 + 4 * h + 2], v[r][8 * j2 + 4 * h + 3]}; }
    } else {
#pragma unroll
        for (int r = 0; r < R; ++r)
#pragma unroll
            for (int j2 = 0; j2 < 2; ++j2) *(u32x4*)(XR + (size_t)(row0 + r) * D + 512 * j2 + 8 * lane) = pack8(v[r] + 8 * j2);
        ln_stats<R>(v, mean, rstd);
#pragma unroll
        for (int r = 0; r < R; ++r) { const int row = row0 + r; const float* sh = modn + (size_t)(NB + ((row - MP) >> 2)) * 3072; const float* sc = sh + 1024;
#pragma unroll
            for (int j2 = 0; j2 < 2; ++j2) { float o[8];
#pragma unroll
                for (int h = 0; h < 2; ++h) { const f32x4 a = *(const f32x4*)(sc + 512 * j2 + 8 * lane + 4 * h), bb = *(const f32x4*)(sh + 512 * j2 + 8 * lane + 4 * h);
#pragma unroll
                    for (int k = 0; k < 4; ++k) o[4 * h + k] = v[r][8 * j2 + 4 * h + k] * rstd[r] * (1.f + a[k]) + bb[k]; }
                *(u32x4*)(ZP + (size_t)row * D + 512 * j2 + 8 * lane) = pack8(o); } }
    }
}
DI void outproj_sample_unit(const Params& p, int l, int unit, LAS unsigned char* lds, int tid, int lane, int wave) {
    const int rbk0 = unit >> 5, cb = unit & 31, R0 = MP + 64 * rbk0, n0 = 32 * cb, r = lane & 31, h = lane >> 5;
    const u16* MIX = (const u16*)(p.ws + WS_MIX); const u16* WT = (const u16*)(p.ws + WS_WOUT) + (size_t)l * D * D;
    const u16* bp = WT + (size_t)perm_out(n0 + r) * D + wave * 128 + 8 * h;
    const u16* ap = MIX + (size_t)(R0 + r) * D + wave * 128 + 8 * h;
    f32x16 acc[2];
#pragma unroll
    for (int x = 0; x < 16; ++x) { acc[0][x] = 0.f; acc[1][x] = 0.f; }
    h8 bfr[8], afr[2][8];
#pragma unroll
    for (int s = 0; s < 8; ++s) { bfr[s] = *(const h8*)(bp + 16 * s);
#pragma unroll
        for (int rb = 0; rb < 2; ++rb) afr[rb][s] = *(const h8*)(ap + (size_t)rb * 32 * D + 16 * s); }
#pragma unroll
    for (int s = 0; s < 8; ++s)
#pragma unroll
        for (int rb = 0; rb < 2; ++rb) acc[rb] = __builtin_amdgcn_mfma_f32_32x32x16_f16(afr[rb][s], bfr[s], acc[rb], 0, 0, 0);
    LAS float* part = (LAS float*)lds;
#pragma unroll
    for (int rb = 0; rb < 2; ++rb)
#pragma unroll
        for (int x = 0; x < 16; ++x) part[(wave * 64 + 32 * rb + crow(x, h)) * 32 + r] = acc[rb][x];
    __syncthreads();
    const float* modl = (const float*)(p.ws + WS_MOD) + (size_t)l * NMOD * 3072;
    if (tid < 256) { const int row = tid >> 2, c8 = (tid & 3) * 8;
        f32x4 s0 = {0.f, 0.f, 0.f, 0.f}, s1 = {0.f, 0.f, 0.f, 0.f};
#pragma unroll
        for (int w = 0; w < 8; ++w) { s0 += *(const LAS f32x4*)(part + (w * 64 + row) * 32 + c8); s1 += *(const LAS f32x4*)(part + (w * 64 + row) * 32 + c8 + 4); }
        const int grow = R0 + row, bidx = NB + ((grow - MP) >> 2);
        float xr8[8]; unpack8(*(const u32x4*)((const u16*)(p.ws + WS_XR) + (size_t)grow * D + n0 + c8), xr8);
        const f32x4 g0 = *(const f32x4*)(modl + (size_t)bidx * 3072 + 2048 + n0 + c8), g1 = *(const f32x4*)(modl + (size_t)bidx * 3072 + 2048 + n0 + c8 + 4);
        float z[8];
#pragma unroll
        for (int j = 0; j < 4; ++j) { z[j] = ALPHA * xr8[j] + (1.f + g0[j]) * s0[j]; z[4 + j] = ALPHA * xr8[4 + j] + (1.f + g1[j]) * s1[j]; }
        const u32x4 w = pack8(z); unsigned long long* dst = (unsigned long long*)((u16*)(p.ws + WS_ZH) + (size_t)grow * D + n0 + c8);
        __hip_atomic_store(dst, ((unsigned long long)w.y << 32) | w.x, __ATOMIC_RELAXED, __HIP_MEMORY_SCOPE_AGENT);
        __hip_atomic_store(dst + 1, ((unsigned long long)w.w << 32) | w.z, __ATOMIC_RELAXED, __HIP_MEMORY_SCOPE_AGENT); }
    asm volatile("s_waitcnt vmcnt(0)" ::: "memory");
    __syncthreads();
    if (wave == 0 && lane == 0)
        (void)__hip_atomic_fetch_add((unsigned*)(p.ws + WS_CTL) + CW_SCNT + 64 * (l * 8 + rbk0), 1u, __ATOMIC_RELAXED, __HIP_MEMORY_SCOPE_AGENT);
}
DI void outproj_sample_finish(const Params& p, int l, int unit, int lane, int wave) {
    if (wave != 0) return;
    unsigned* cnt = (unsigned*)(p.ws + WS_CTL) + CW_SCNT + 64 * (l * 8 + (unit >> 5));
    for (unsigned sp = 0; sp < (1u << 20); ++sp) { if (__hip_atomic_load(cnt, __ATOMIC_RELAXED, __HIP_MEMORY_SCOPE_AGENT) >= 32u) break; __builtin_amdgcn_s_sleep(2); }
    __builtin_amdgcn_fence(__ATOMIC_ACQUIRE, "agent"); asm volatile("s_waitcnt vmcnt(0)" ::: "memory");
    sample_ln_rows<2>(p, l, MP + 64 * (unit >> 5) + 2 * (unit & 31), lane);
}

constexpr int N_PHASES = 3 + 3 * DEPTH;
typedef const __attribute__((address_space(4))) Params* KParams;
#define PHASE_BEGIN() const int lane_ = lane_id(); const int lane = lane_, wave = wave_s, tid = wave_s * 64 + lane_; \
    KParams kq = kp; asm volatile("" : "+s"(kq)); Params p; { const ParamsHead hh_ = *(const __attribute__((address_space(4))) ParamsHead*)kq; __builtin_memcpy(&p, &hh_, sizeof(ParamsHead)); }     const int gw = vcu * NWAVES + wave, NGW = G * NWAVES; (void)lane; (void)gw; (void)NGW
#define MIXPTRS() MixPtrs X; X.PA = (const u16*)(p.ws + WS_PA); X.PSZC = (const u16*)(p.ws + WS_PSZC); X.PPV = (const u16*)(p.ws + WS_PPV); X.PSZP = (const u16*)(p.ws + WS_PSZP); \
    X.PQ = (const u16*)(p.ws + WS_PQ); X.PSZA = (const u16*)(p.ws + WS_PSZA); X.PK = (const u16*)(p.ws + WS_PK); X.PV = (const u16*)(p.ws + WS_PV); X.MIX = (u16*)(p.ws + WS_MIX)
__global__ void __launch_bounds__(NTHR, 2) hymba_fwd(Params p_unused) {
#if defined(__HIP_DEVICE_COMPILE__)
    extern __shared__ __attribute__((aligned(16))) unsigned char lds_raw[];
    LAS unsigned char* lds = (LAS unsigned char*)lds_raw;
    volatile LAS unsigned* MISC = (volatile LAS unsigned*)(lds + MISC_OFF);
    const KParams kp = (KParams)__builtin_amdgcn_kernarg_segment_ptr();
    const int G = gridDim.x, bx = blockIdx.x, vcu = (G % 8 == 0) ? (bx % 8) * (G / 8) + bx / 8 : bx;
    const int wave_s = __builtin_amdgcn_readfirstlane((int)threadIdx.x >> 6);
    for (int u = threadIdx.x; u < (LDS_BYTES - RING_BYTES) / 4; u += NTHR) ((LAS unsigned*)(lds + RING_BYTES))[u] = 0u;
    __syncthreads();
    unsigned* ctl = (unsigned*)(kp->ws + WS_CTL);
    XcdBarrier bar; bar.bar = ctl + CW_BAR; bar.x = 0; bar.st = nullptr;
    if (MK_N_LAUNCHES == 1) bar = xcd_barrier_post(ctl + CW_BAR, MISC + 8);
    const int lo = kp->ph_lo, hi = kp->ph_hi;
    const bool early = MK_N_LAUNCHES == 1 && G == 256 && lo == 0 && hi == N_PHASES;
#ifndef ONLY
#define ONLY -1
#endif
#ifndef ONLYMASK
#define ONLYMASK 0x3f
#endif
#define EN(t) ((ONLY < 0 || ONLY == (t)) && ((ONLYMASK >> (t)) & 1))
#define IN(k) (lo <= (k) && (k) < hi)
#define SEAM(k) do { if (MK_N_LAUNCHES == 1 && IN((k) + 1)) xcd_barrier(bar, wave_s); } while (0)
    if (EN(0) && IN(0)) { { PHASE_BEGIN(); p0_prologue(p, (const __attribute__((address_space(4))) float*)((const __attribute__((address_space(4))) char*)kq + __builtin_offsetof(Params, inv_freq)), lds, vcu, G, tid, lane, wave); } if (MK_N_LAUNCHES == 1 && IN(1)) xcd_barrier_census(bar, wave_s); SEAM(0); }
    if (EN(1) && IN(1)) { { PHASE_BEGIN(); for (int u = vcu; u < 40; u += G) modv_unit(p, lds, u, tid, lane, wave);
            variants_layer0(p, lds, gw, NGW, lane, wave);
            pre_phase(p, gw, NGW, lane); } SEAM(1); }
#pragma unroll 1
    for (int l = 0; l < DEPTH; ++l) {
        const int ph = 2 + 3 * l;
        if (EN(2) && IN(ph)) {
            { PHASE_BEGIN();
            pg8::Gemm g{(const u16*)(p.ws + WS_H), (const u16*)(p.ws + WS_WIN) + (size_t)l * DIN * D, M, DIN, D};
            pg8::InOrder S; S.init(M, DIN, G, bx, G - MS / 256 * (DIN / 256), early ? MS / 256 * (DIN / 256) : 0);
            LAS float* rcl = (LAS float*)(lds + RING_BYTES + 1024);
            { int pms[3]; for (int i = 0; i < 3; ++i) { pg8::Unit u; pms[i] = S.next(i, u) ? u.pm : -1; } finalize_rc_in(p, l, pms, rcl, tid); }
            asm volatile("s_waitcnt lgkmcnt(0)" ::: "memory"); __syncthreads();
            EpiIn E{l, p.ws, p.out, rcl, early};
            pg8::gemm_phase<EpiIn, true>(lds, g, S, E, tid); }
            { const int fi = M / 256 * (DIN / 256) - 2 * G; const bool split = fi > 0 && fi < G;
              if (l + 1 < DEPTH && (!split || bx >= fi)) { PHASE_BEGIN(); const int ii = split ? bx - fi : vcu, ni = split ? G - fi : G;
                  if (!early) transpose_layer(p, l + 1, lds, ii * NWAVES + wave, ni * NWAVES, lane, wave);
                  for (int u = ni - 1 - ii; u < 40; u += ni) modv_unit(p, lds, 40 * (l + 1) + u, tid, lane, wave); }
              if (early && bx >= fi) { PHASE_BEGIN(); MIXPTRS();
                  __syncthreads();
                  if (wave == 0) { unsigned* cnt = (unsigned*)(p.ws + WS_CTL) + CW_EARLY + 64 * l;
                      for (unsigned sp = 0; sp < (1u << 20); ++sp) { if (__hip_atomic_load(cnt, __ATOMIC_RELAXED, __HIP_MEMORY_SCOPE_AGENT) >= (unsigned)(MS / 256 * (DIN / 256))) break; __builtin_amdgcn_s_sleep(2); }
                      __builtin_amdgcn_fence(__ATOMIC_ACQUIRE, "agent"); asm volatile("s_waitcnt vmcnt(0)" ::: "memory"); }
                  __syncthreads();
                  for (int u = bx - fi; u < 2 * DB; u += G - fi) convpool_sample_unit(p, X, l, u >> 1, u & 1, lds, tid, lane, wave); } }
            if (MK_N_LAUNCHES == 1 && IN(ph + 1)) { PHASE_BEGIN();
                xcd_barrier_fill(bar, wave_s, [&] { for (int e = tid - 64; e < 4 * 64 * 8; e += NTHR - 64) { const int g = e >> 9, c = (e >> 3) & 63, n8 = (e & 7) * 8;
                  const f32x4 w0 = *(const f32x4*)(p.pool_w + (size_t)l * 16384 + (g * 64 + c) * 64 + n8), w1 = *(const f32x4*)(p.pool_w + (size_t)l * 16384 + (g * 64 + c) * 64 + n8 + 4);
#pragma unroll
                  for (int k = 0; k < 4; ++k) { *(LAS _Float16*)(lds + MX_WPT + ((g * 64 + n8 + k) * 72 + c) * 2) = (_Float16)w0[k]; *(LAS _Float16*)(lds + MX_WPT + ((g * 64 + n8 + 4 + k) * 72 + c) * 2) = (_Float16)w1[k]; } } }); }
        }
        if (EN(3) && IN(ph + 1)) {
#pragma unroll 1
            for (int step = 0; step < 2; ++step) {
            if ((step ^ vcu) & 1) {
            { PHASE_BEGIN(); MIXPTRS(); for (int u = vcu; u < 256; u += G) attn_sample_unit(p, X, l, u, lds, tid, lane, wave); }
            } else {
            { PHASE_BEGIN(); MIXPTRS(); for (int u = vcu; u < 256; u += G) attn_prompt_unit(p, X, l, u, lds, tid, lane, wave); }
            { PHASE_BEGIN(); MIXPTRS(); for (int u = vcu; u < 256; u += G) conv_prompt_unit(p, X, l, u, lds, tid, lane, wave); }
            if (MK_N_LAUNCHES != 1) { PHASE_BEGIN(); for (int e = tid; e < 4 * 64 * 8; e += NTHR) { const int g = e >> 9, c = (e >> 3) & 63, n8 = (e & 7) * 8;
                  const f32x4 w0 = *(const f32x4*)(p.pool_w + (size_t)l * 16384 + (g * 64 + c) * 64 + n8), w1 = *(const f32x4*)(p.pool_w + (size_t)l * 16384 + (g * 64 + c) * 64 + n8 + 4);
#pragma unroll
                  for (int k = 0; k < 4; ++k) { *(LAS _Float16*)(lds + MX_WPT + ((g * 64 + n8 + k) * 72 + c) * 2) = (_Float16)w0[k]; *(LAS _Float16*)(lds + MX_WPT + ((g * 64 + n8 + 4 + k) * 72 + c) * 2) = (_Float16)w1[k]; } }
              asm volatile("s_waitcnt lgkmcnt(0)" ::: "memory"); __syncthreads(); }
            { PHASE_BEGIN(); for (int u = vcu; u < 256; u += G) { task_pool(p, l, u * 64, wave >> 2, (wave >> 2) ? 3 - (wave & 3) : (wave & 3), lds, wave, lane); __syncthreads(); } }
            } }
            if (!early) { PHASE_BEGIN(); MIXPTRS(); for (int u = vcu; u < 2 * DB; u += G) convpool_sample_unit(p, X, l, u >> 1, u & 1, lds, tid, lane, wave); }
            if (MK_N_LAUNCHES == 1 && IN(ph + 2)) { PHASE_BEGIN();
                pg8::StaticOrder S; S.init(MP, D, G, bx); pg8::Unit u; S.next(0, u); EpiOutF E{p.ws, l, p.ln_g, p.ln_b, p.out};
                xcd_barrier_fill(bar, wave_s, [&] { for (int it = tid - 64; it < 512; it += NTHR - 64) E.setup_item(u, lds + EpiOutF::SETUP_HI, it);
                    if (early && l + 1 < DEPTH) transpose_layer(p, l + 1, lds, vcu * (NWAVES - 1) + wave - 1, G * (NWAVES - 1), lane, wave); }); } }
        if (EN(4) && IN(ph + 2)) {
            { PHASE_BEGIN();
            pg8::Gemm g{(const u16*)(p.ws + WS_MIX), (const u16*)(p.ws + WS_WOUT) + (size_t)l * D * D, M, D, D};
            for (int u = vcu; u < 256; u += G) outproj_sample_unit(p, l, u, lds, tid, lane, wave);
            __syncthreads();
            pg8::StaticOrder S; S.init(MP, D, G, bx);
            EpiOutF E{p.ws, l, p.ln_g, p.ln_b, p.out};
            pg8::gemm_phase<EpiOutF, false>(lds, g, S, E, tid);
            for (int u = vcu; u < 256; u += G) outproj_sample_finish(p, l, u, lane, wave); }
            if (l + 1 < DEPTH) SEAM(ph + 2);
        }
    }
#undef IN
#undef SEAM
#endif
}


#ifdef DBG
constexpr int DBG_NS = 56;
constexpr size_t WS_DBGACC = 32 * 1024;
constexpr size_t WS_DBGZ = WS_END;
__constant__ int dbg_rows_tab[DBG_NS] = {0, 1, 2, 3, 14, 15, 16, 29, 30, 31, 32, 63, 64, 65, 127, 128, 129, 255, 256, 1000, 2047, 2048, 3967, 3968, 4065, 4066, 4080, 4081, 4094, 4095, 4096, 4097, 4127, 4224,
                            8191, 8192, 8320, 12288, 12415, 16382, 16383, 16384, 16385, 16386, 16387, 16388, 16391, 16639, 16640, 16892, 16893, 16894, 16895, 5000, 9999, 15000};
__device__ int dbg_row(int i) { return dbg_rows_tab[i]; }
__device__ void dbg_acc(float* accf, int id, float e, float r) {
    __shared__ float se[256], sr[256];
    const int t = threadIdx.x; se[t] = e; sr[t] = r; __syncthreads();
    for (int o = 128; o > 0; o >>= 1) { if (t < o) { se[t] += se[t + o]; sr[t] += sr[t + o]; } __syncthreads(); }
    if (t == 0) { atomicAdd(accf + 2 * id, se[0]); atomicAdd(accf + 2 * id + 1, sr[0]); }
    __syncthreads();
}
__device__ float dbg_h(const u16* p, size_t i) { return (float)(*(const _Float16*)(p + i)); }
__device__ float dbg_block_sum(float v) { __shared__ float sb[256]; const int t = threadIdx.x; sb[t] = v; __syncthreads(); for (int o = 128; o > 0; o >>= 1) { if (t < o) sb[t] += sb[t + o]; __syncthreads(); } const float r = sb[0]; __syncthreads(); return r; }
__device__ void dbg_ln4(float (&x)[4], float& rstd) { const float mean = dbg_block_sum(x[0] + x[1] + x[2] + x[3]) / D; float q = 0; for (int i = 0; i < 4; ++i) { x[i] -= mean; q += x[i] * x[i]; } rstd = 1.f / sqrtf(dbg_block_sum(q) / D + LN_EPS); }
#define DBG_E(fast, ref) do { const float f_ = (fast), r_ = (ref); e += (f_ - r_) * (f_ - r_); rr += r_ * r_; } while (0)
__global__ void __launch_bounds__(256) dbg_p0(Params p) {
    float* accf = (float*)(p.ws + WS_DBGACC); const int t = threadIdx.x, bid = blockIdx.x;
    { float e = 0, rr = 0; const int ri = (bid >> 2) % 9;
        const int l = bid & 3, row = ri < 6 ? ri : (ri == 6 ? 67 : 123 + ri);
        const float* c = row < NB ? p.c_prompt + (size_t)row * D : p.c_sample + (size_t)(row - NB) * D;
        for (int n = t * 12 + (bid % 12); n < 3072; n += 256 * 12) { float a = p.b_mod[l * 3072 + n];
            for (int k = 0; k < D; ++k) { const float x = c[k]; a += x / (1.f + expf(-x)) * p.w_mod[((size_t)l * D + k) * 3072 + n]; }
            DBG_E(((const float*)(p.ws + WS_MOD))[((size_t)l * NMOD + row) * 3072 + n], a); }
        dbg_acc(accf, 0, e, rr); }
    { float e = 0, rr = 0;
        for (int i = 0; i < 64; ++i) { const int l = bid & 3, col = (bid * 37 + i * 41 + t * 10) % DIN, k = (t * 4 + i * 16 + bid) % D;
            DBG_E(dbg_h((const u16*)(p.ws + WS_WIN), ((size_t)l * DIN + perm_in(col)) * D + k), p.w_in[((size_t)l * D + k) * DIN + col]); }
        dbg_acc(accf, 1, e, rr); }
    { float e = 0, rr = 0;
        for (int i = 0; i < 64; ++i) { const int l = bid & 3, col = (bid * 37 + i * 41 + t * 4) % D, k = (t * 4 + i * 16 + bid) % D;
            DBG_E(dbg_h((const u16*)(p.ws + WS_WOUT), ((size_t)l * D + perm_out(col)) * D + k), p.w_out[((size_t)l * D + k) * D + col]); }
        dbg_acc(accf, 2, e, rr); }
    { float e = 0, rr = 0;
        for (int i = 0; i < 16; ++i) { const int pi = (bid * 113 + i * 257 + t * 16) % (SEQ + DS), f = (t + i) & 31; const int pos = pi < SEQ ? pi : PAST + pi - SEQ;
            const float ang = (float)pos * p.inv_freq[f]; const f32x2 cs = ((const f32x2*)(p.ws + WS_TAB))[pi * 32 + f];
            DBG_E(cs[0], cosf(ang)); DBG_E(cs[1], sinf(ang)); }
        dbg_acc(accf, 3, e, rr); }
}
__global__ void __launch_bounds__(256) dbg_p0b(Params p) {
    float* accf = (float*)(p.ws + WS_DBGACC); const int t = threadIdx.x, bid = blockIdx.x;
    { float e = 0, rr = 0;
        const int l = bid & 3, b = (bid >> 2) & 3; const float* md = (const float*)(p.ws + WS_MOD) + ((size_t)l * NMOD + b) * 3072;
        const int col = (t * 10 + (bid >> 4) * 3 + 1) % DIN; float v1 = 0, v2 = 0, v3 = 0, v4 = 0;
        for (int c = 0; c < D; ++c) { const float w = p.w_in[((size_t)l * D + c) * DIN + col], g = l > 0 ? p.ln_g[(l - 1) * D + c] : 1.f, bb = l > 0 ? p.ln_b[(l - 1) * D + c] : 0.f, s1 = 1.f + md[1024 + c];
            v1 += g * s1 * w; v2 += bb * s1 * w; v3 += s1 * w; v4 += md[c] * w; }
        const float* mv = (const float*)(p.ws + WS_MODV) + (size_t)(l * NB + b) * 4 * DIN + perm_in(col);
        DBG_E(mv[0], v1); DBG_E(mv[2 * DIN], v3); DBG_E(mv[3 * DIN], v4); if (l > 0) DBG_E(mv[DIN], v2); else e += mv[DIN] * mv[DIN];
        dbg_acc(accf, 69, e, rr); }
    if (bid < DBG_NS) { const int row = dbg_row(bid); const bool smp = row >= MP; const int bidx = smp ? NB + ((row - MP) >> 2) : (row >> 12);
        const float* md = (const float*)(p.ws + WS_MOD) + (size_t)bidx * 3072;
        float x[4]; for (int i = 0; i < 4; ++i) { const int c = t + 256 * i; x[i] = smp ? p.x_sample[(size_t)(row - MP) * D + c] : p.x_prompt[(size_t)row * D + c]; }
        float e = 0, rr = 0; for (int i = 0; i < 4; ++i) DBG_E(dbg_h((const u16*)(p.ws + (smp ? WS_XR : WS_ZH)), (size_t)row * D + t + 256 * i), x[i]); dbg_acc(accf, 70, e, rr);
        e = 0; rr = 0;
        if (!smp) { for (int i = 0; i < 4; ++i) { const int c = t + 256 * i; DBG_E(dbg_h((const u16*)(p.ws + WS_H), (size_t)row * D + c), x[i] * (1.f + md[1024 + c])); } }
        else { float rstd; dbg_ln4(x, rstd); for (int i = 0; i < 4; ++i) { const int c = t + 256 * i; DBG_E(dbg_h((const u16*)(p.ws + WS_H), (size_t)row * D + c), x[i] * rstd * (1.f + md[1024 + c]) + md[c]); } }
        dbg_acc(accf, 71, e, rr); }
}
__global__ void __launch_bounds__(256) dbg_copyz(Params p) { const int row = dbg_row(blockIdx.x);
    for (int c = threadIdx.x; c < D; c += 256) { ((u16*)(p.ws + WS_DBGZ))[blockIdx.x * D + c] = ((const u16*)(p.ws + WS_ZH))[(size_t)row * D + c]; ((u16*)(p.ws + WS_DBGZ))[(DBG_NS + blockIdx.x) * D + c] = ((const u16*)(p.ws + WS_XR))[(size_t)row * D + c]; } }
__global__ void __launch_bounds__(256) dbg_in(Params p, int l) {
    __shared__ float pr[DIN]; __shared__ float hh[D];
    float* accf = (float*)(p.ws + WS_DBGACC); const int t = threadIdx.x, row = dbg_row(blockIdx.x), base = 4 + 16 * l;
    const bool smp = row >= MP; const int b = smp ? (row - MP) >> 2 : row >> 12, tt = smp ? (row - MP) & 3 : row & (SEQ - 1), pos = smp ? PAST + tt : tt;
    const int bidx = smp ? NB + b : b; const float* md = (const float*)(p.ws + WS_MOD) + ((size_t)l * NMOD + bidx) * 3072;
    float e, rr;
    { float x[4]; float rstd;
        for (int i = 0; i < 4; ++i) x[i] = dbg_h((const u16*)(p.ws + (smp ? WS_XR : WS_ZH)), (size_t)row * D + t + 256 * i);
        if (!smp && l > 0) { dbg_ln4(x, rstd); for (int i = 0; i < 4; ++i) { const int c = t + 256 * i; x[i] = x[i] * rstd * p.ln_g[(l - 1) * D + c] + p.ln_b[(l - 1) * D + c]; } }
        dbg_ln4(x, rstd);
        for (int i = 0; i < 4; ++i) { const int c = t + 256 * i; hh[c] = x[i] * rstd * (1.f + md[1024 + c]) + md[c]; }
        __syncthreads();
        if (smp) { e = 0; rr = 0; for (int i = 0; i < 4; ++i) { const int c = t + 256 * i; DBG_E(dbg_h((const u16*)(p.ws + WS_H), (size_t)row * D + c), hh[c]); } dbg_acc(accf, base + 1, e, rr); } }
    for (int i = 0; i < 10; ++i) { const int col = t + 256 * i; float a = 0; for (int k = 0; k < D; ++k) a += hh[k] * p.w_in[((size_t)l * D + k) * DIN + col]; pr[col] = a; }
    __syncthreads();
    const float av = pr[t] / (1.f + expf(-pr[256 + t]));
    e = 0; rr = 0; DBG_E(dbg_h((const u16*)(p.ws + WS_PA), (size_t)row * 256 + t), av); dbg_acc(accf, base + 2, e, rr);
    e = 0; rr = 0; { const float z = pr[512 + t]; DBG_E(dbg_h((const u16*)(p.ws + WS_PSZC), (size_t)row * 256 + t), z / (1.f + expf(-z))); } dbg_acc(accf, base + 3, e, rr);
    e = 0; rr = 0; DBG_E(dbg_h((const u16*)(p.ws + WS_PPV), (size_t)row * 256 + t), pr[768 + t]); dbg_acc(accf, base + 4, e, rr);
    e = 0; rr = 0; { const float z = pr[1024 + t]; DBG_E(dbg_h((const u16*)(p.ws + WS_PSZP), (size_t)row * 256 + t), z / (1.f + expf(-z))); } dbg_acc(accf, base + 5, e, rr);
    e = 0; rr = 0;
    for (int i = 0; i < 2; ++i) { const int c = t + 256 * i, hd = c >> 6, d = c & 63, f = d & 31; const float ang = (float)pos * p.inv_freq[f], cs = cosf(ang), sn = sinf(ang);
        const float x = pr[1280 + c], xo = d < 32 ? -pr[1280 + hd * 64 + d + 32] : pr[1280 + hd * 64 + d - 32];
        DBG_E(dbg_h((const u16*)(p.ws + WS_PQ), (size_t)row * 512 + c), (x * cs + xo * sn) * QSCALE); }
    dbg_acc(accf, base + 6, e, rr);
    e = 0; rr = 0; float kref = 0.f, vref = 0.f;
    if (t < 128) { const int hd = t >> 6, d = t & 63, f = d & 31; const float ang = (float)pos * p.inv_freq[f], cs = cosf(ang), sn = sinf(ang);
        const float x = pr[1792 + t], xo = d < 32 ? -pr[1792 + hd * 64 + d + 32] : pr[1792 + hd * 64 + d - 32]; kref = x * cs + xo * sn;
        DBG_E(dbg_h((const u16*)(p.ws + WS_PK), (size_t)row * 128 + t), kref); }
    dbg_acc(accf, base + 7, e, rr);
    e = 0; rr = 0; if (t < 128) { vref = pr[1920 + t]; DBG_E(dbg_h((const u16*)(p.ws + WS_PV), (size_t)row * 128 + t), vref); } dbg_acc(accf, base + 8, e, rr);
    e = 0; rr = 0; for (int i = 0; i < 2; ++i) { const float z = pr[2048 + t + 256 * i]; DBG_E(dbg_h((const u16*)(p.ws + WS_PSZA), (size_t)row * 512 + t + 256 * i), z / (1.f + expf(-z))); } dbg_acc(accf, base + 9, e, rr);
    e = 0; rr = 0;
    if (smp) { DBG_E(p.out[OFF_CONVS + ((size_t)(l * DB + b) * 30 + 26 + tt) * 256 + t], av); DBG_E(p.out[OFF_POOLS + ((size_t)(l * DB + b) * 15 + 11 + tt) * 256 + t], pr[768 + t]);
        if (t < 128) { DBG_E(p.out[OFF_KS + ((size_t)(l * DB + b) * 128 + 124 + tt) * 128 + t], kref); DBG_E(p.out[OFF_VS + ((size_t)(l * DB + b) * 128 + 124 + tt) * 128 + t], vref); } }
    else { if (tt >= SEQ - 30) DBG_E(p.out[OFF_CONVP + ((size_t)(l * NB + b) * 30 + tt - (SEQ - 30)) * 256 + t], av);
        if (tt >= SEQ - 15) DBG_E(p.out[OFF_POOLP + ((size_t)(l * NB + b) * 15 + tt - (SEQ - 15)) * 256 + t], pr[768 + t]);
        if (tt >= SEQ - 128 && t < 128) { DBG_E(p.out[OFF_KP + ((size_t)(l * NB + b) * 128 + tt - (SEQ - 128)) * 128 + t], kref); DBG_E(p.out[OFF_VP + ((size_t)(l * NB + b) * 128 + tt - (SEQ - 128)) * 128 + t], vref); } }
    dbg_acc(accf, base + 10, e, rr);
}
__global__ void __launch_bounds__(256) dbg_mix(Params p, int l) {
    __shared__ float sh[1024]; __shared__ float sc[136];
    float* accf = (float*)(p.ws + WS_DBGACC); const int t = threadIdx.x, row = dbg_row(blockIdx.x), base = 4 + 16 * l;
    const bool smp = row >= MP; const int b = smp ? (row - MP) >> 2 : row >> 12, tt = smp ? (row - MP) & 3 : row & (SEQ - 1);
    const u16 *PA = (const u16*)(p.ws + WS_PA), *PSZC = (const u16*)(p.ws + WS_PSZC), *PPV = (const u16*)(p.ws + WS_PPV), *PSZP = (const u16*)(p.ws + WS_PSZP), *PQ = (const u16*)(p.ws + WS_PQ),
              *PSZA = (const u16*)(p.ws + WS_PSZA), *PK = (const u16*)(p.ws + WS_PK), *PV = (const u16*)(p.ws + WS_PV), *MIX = (const u16*)(p.ws + WS_MIX);
    float e, rr;
    {
        float a = p.conv_b[l * 256 + t];
        for (int j = 0; j < 31; ++j) { float x;
            if (!smp) { const int ts = tt - 30 + j; x = ts >= 0 ? dbg_h(PA, ((size_t)b * SEQ + ts) * 256 + t) : 0.f; }
            else { const int ri = tt + j; x = ri < 30 ? p.cache_conv[((size_t)(l * DB + b) * 30 + ri) * 256 + t] : dbg_h(PA, ((size_t)MP + 4 * b + ri - 30) * 256 + t); }
            a += p.conv_w[((size_t)l * 31 + j) * 256 + t] * x; }
        const float mean = dbg_block_sum(a) / 256.f; const float d = a - mean; const float rstd = 1.f / sqrtf(dbg_block_sum(d * d) / 256.f + LN_EPS);
        const float y = d * rstd * p.cnorm_g[l * 256 + t] + p.cnorm_b[l * 256 + t];
        e = 0; rr = 0; DBG_E(dbg_h(MIX, (size_t)row * D + t), y / (1.f + expf(-y)) * dbg_h(PSZC, (size_t)row * 256 + t)); dbg_acc(accf, base + 11, e, rr); }
    {
        const int w = 2 << (t >> 6); float s = 0;
        for (int i = 0; i < w; ++i) { float x;
            if (!smp) { const int ts = tt - i; x = ts >= 0 ? dbg_h(PPV, ((size_t)b * SEQ + ts) * 256 + t) : 0.f; }
            else { const int ri = 15 + tt - i; x = ri < 15 ? p.cache_pool[((size_t)(l * DB + b) * 15 + ri) * 256 + t] : dbg_h(PPV, ((size_t)MP + 4 * b + ri - 15) * 256 + t); }
            s += x; }
        const float cnt = smp ? (float)w : (float)(w < tt + 1 ? w : tt + 1);
        sh[t] = s / cnt - dbg_h(PPV, (size_t)row * 256 + t); __syncthreads();
        const int g = t >> 6, n = t & 63; float y = 0; for (int c = 0; c < 64; ++c) y += sh[64 * g + c] * p.pool_w[(((size_t)l * 4 + g) * 64 + c) * 64 + n];
        e = 0; rr = 0; DBG_E(dbg_h(MIX, (size_t)row * D + 256 + t), y * p.pool_scale[l * 256 + t] * dbg_h(PSZP, (size_t)row * 256 + t)); dbg_acc(accf, base + 12, e, rr); __syncthreads(); }
    {
        e = 0; rr = 0;
        for (int hd = 0; hd < 8; ++hd) { const int hk = hd >> 2; __syncthreads();
            if (t < 64) sh[t] = dbg_h(PQ, (size_t)row * 512 + hd * 64 + t); __syncthreads();
            const float sink2 = p.sinks[l * 8 + hd] * LOG2E;
            if (t < 128) { float s = -INFINITY;
                if (!smp) { const int ts = tt - 127 + t; if (ts >= 0) { s = 0; for (int d = 0; d < 64; ++d) s += sh[d] * dbg_h(PK, ((size_t)b * SEQ + ts) * 128 + hk * 64 + d); } }
                else { const int ci = tt + 1 + t;
                    s = 0; for (int d = 0; d < 64; ++d) s += sh[d] * (ci < 128 ? p.cache_k[(((size_t)(l * DB + b) * 128 + ci) * 2 + hk) * 64 + d] : dbg_h(PK, ((size_t)MP + 4 * b + ci - 128) * 128 + hk * 64 + d)); }
                sc[t] = s; }
            __syncthreads();
            float mx = sink2; for (int k = 0; k < 128; ++k) mx = fmaxf(mx, sc[k]);
            float den = exp2f(sink2 - mx); for (int k = 0; k < 128; ++k) den += exp2f(sc[k] - mx);
            if (t < 64) { float o = 0;
                for (int k = 0; k < 128; ++k) { const float pk = exp2f(sc[k] - mx) / den; if (pk == 0.f) continue; float v;
                    if (!smp) { const int ts = tt - 127 + k; v = dbg_h(PV, ((size_t)b * SEQ + ts) * 128 + hk * 64 + t); }
                    else { const int ci = tt + 1 + k; v = ci < 128 ? p.cache_v[(((size_t)(l * DB + b) * 128 + ci) * 2 + hk) * 64 + t] : dbg_h(PV, ((size_t)MP + 4 * b + ci - 128) * 128 + hk * 64 + t); }
                    o += pk * v; }
                DBG_E(dbg_h(MIX, (size_t)row * D + 512 + hd * 64 + t), o * dbg_h(PSZA, (size_t)row * 512 + hd * 64 + t)); } }
        dbg_acc(accf, base + 13, e, rr); }
    if (smp) { e = 0; rr = 0;
        for (int i = 0; i < 26; ++i) DBG_E(p.out[OFF_CONVS + ((size_t)(l * DB + b) * 30 + i) * 256 + t], p.cache_conv[((size_t)(l * DB + b) * 30 + i + 4) * 256 + t]);
        for (int i = 0; i < 11; ++i) DBG_E(p.out[OFF_POOLS + ((size_t)(l * DB + b) * 15 + i) * 256 + t], p.cache_pool[((size_t)(l * DB + b) * 15 + i + 4) * 256 + t]);
        for (int i = 0; i < 124; ++i) if (t < 128) { DBG_E(p.out[OFF_KS + ((size_t)(l * DB + b) * 128 + i) * 128 + t], p.cache_k[((size_t)(l * DB + b) * 128 + i + 4) * 128 + t]);
            DBG_E(p.out[OFF_VS + ((size_t)(l * DB + b) * 128 + i) * 128 + t], p.cache_v[((size_t)(l * DB + b) * 128 + i + 4) * 128 + t]); }
        dbg_acc(accf, base + 15, e, rr); }
}
__global__ void __launch_bounds__(256) dbg_out(Params p, int l) {
    __shared__ float mm[D];
    float* accf = (float*)(p.ws + WS_DBGACC); const int t = threadIdx.x, row = dbg_row(blockIdx.x), base = 4 + 16 * l;
    const bool smp = row >= MP; const int bidx = smp ? NB + ((row - MP) >> 2) : (row >> 12);
    for (int c = t; c < D; c += 256) mm[c] = dbg_h((const u16*)(p.ws + WS_MIX), (size_t)row * D + c);
    __syncthreads();
    const float* md = (const float*)(p.ws + WS_MOD) + ((size_t)l * NMOD + bidx) * 3072 + 2048;
    const float* mdn = (const float*)(p.ws + WS_MOD) + ((size_t)(l + 1) * NMOD + bidx) * 3072;
    float x1[4], z[4], rstd;
    for (int i = 0; i < 4; ++i) x1[i] = dbg_h((const u16*)(p.ws + WS_DBGZ), (size_t)((smp ? DBG_NS : 0) + blockIdx.x) * D + t + 256 * i);
    if (!smp && l > 0) { dbg_ln4(x1, rstd); for (int i = 0; i < 4; ++i) { const int c = t + 256 * i; x1[i] = x1[i] * rstd * p.ln_g[(l - 1) * D + c] + p.ln_b[(l - 1) * D + c]; } }
    float e = 0, rr = 0;
    for (int i = 0; i < 4; ++i) { const int c = t + 256 * i; float a = 0; for (int k = 0; k < D; ++k) a += mm[k] * p.w_out[((size_t)l * D + k) * D + c];
        z[i] = ALPHA * x1[i] + (1.f + md[c]) * a; DBG_E(dbg_h((const u16*)(p.ws + WS_ZH), (size_t)row * D + c), z[i]); }
    dbg_acc(accf, base + 14, e, rr);
    e = 0; rr = 0;
    if (!smp) { if (l < DEPTH - 1) for (int i = 0; i < 4; ++i) { const int c = t + 256 * i; DBG_E(dbg_h((const u16*)(p.ws + WS_H), (size_t)row * D + c), z[i] * p.ln_g[l * D + c] * (1.f + mdn[1024 + c])); } }
    else { dbg_ln4(z, rstd); for (int i = 0; i < 4; ++i) { const int c = t + 256 * i; z[i] = z[i] * rstd * p.ln_g[l * D + c] + p.ln_b[l * D + c]; }
        if (l == DEPTH - 1) { for (int i = 0; i < 4; ++i) DBG_E(p.out[OFF_YS + (size_t)(row - MP) * D + t + 256 * i], z[i]); }
        else { for (int i = 0; i < 4; ++i) DBG_E(dbg_h((const u16*)(p.ws + WS_XR), (size_t)row * D + t + 256 * i), z[i]);
            dbg_ln4(z, rstd); for (int i = 0; i < 4; ++i) { const int c = t + 256 * i; DBG_E(dbg_h((const u16*)(p.ws + WS_H), (size_t)row * D + c), z[i] * rstd * (1.f + mdn[1024 + c]) + mdn[c]); } } }
    dbg_acc(accf, base + 0, e, rr);
    if (l == 0) { dbg_acc(accf, 100, smp ? 0.f : e, smp ? 0.f : rr); dbg_acc(accf, 101, smp ? e : 0.f, smp ? rr : 0.f); }
}
__global__ void __launch_bounds__(256) dbg_fin(Params p) {
    float* accf = (float*)(p.ws + WS_DBGACC); const int t = threadIdx.x, row = dbg_row(blockIdx.x);
    if (row >= MP) return;
    float x[4]; for (int i = 0; i < 4; ++i) x[i] = dbg_h((const u16*)(p.ws + WS_ZH), (size_t)row * D + t + 256 * i);
    float rstd; dbg_ln4(x, rstd); float e = 0, rr = 0;
    for (int i = 0; i < 4; ++i) { const int c = t + 256 * i; DBG_E(p.out[(size_t)row * D + c], x[i] * rstd * p.ln_g[3 * D + c] + p.ln_b[3 * D + c]); }
    dbg_acc(accf, 68, e, rr);
}
#ifndef DBG_REPORT_ID
#define DBG_REPORT_ID -1
#endif
__global__ void __launch_bounds__(256) dbg_report(Params p) {
    const float* accf = (const float*)(p.ws + WS_DBGACC);
    float code = 1000.f;
    if (DBG_REPORT_ID >= 0) { const float e = accf[2 * DBG_REPORT_ID], r = accf[2 * DBG_REPORT_ID + 1]; code = (r > 0.f ? e / r : 9.9f) * 1e12f; if (!(code > 100.f)) code = 100.f; }
    else for (int i = 0; i < 128; ++i) { const float e = accf[2 * i], r = accf[2 * i + 1]; const bool expected = i <= 71 && !(i >= 4 && i < 68 && ((i - 4) & 15) == 0 && (i - 4) / 16 == 99);
        if ((r > 0.f && !(e / r < 1e-3f)) || (r == 0.f && (e > 0.f || expected)) || e != e || r != r) { code = (float)(i + 1) * 1e4f; break; } }
    const float S = sqrtf(code);
    for (size_t i = (size_t)blockIdx.x * 256 + threadIdx.x; i < (size_t)MP * D; i += (size_t)gridDim.x * 256) p.out[i] = S;
}
#endif

extern "C" void kernel_launch(void* const* d_in, const int* in_sizes, int n_in, void* d_out, int out_size, void* d_ws, size_t ws_size, hipStream_t stream) {
    static int grid = 0;
    if (grid == 0) {
        if (n_in != 21 || (size_t)out_size != OUT_TOTAL || ws_size < WS_END) { fprintf(stderr, "kernel_launch: unexpected shapes (n_in %d, out %d, ws %zu)\n", n_in, out_size, ws_size); grid = -1; return; }
        int dev = 0, cus = 0;
        if (hipGetDevice(&dev) != hipSuccess || hipDeviceGetAttribute(&cus, hipDeviceAttributeMultiprocessorCount, dev) != hipSuccess) { grid = -1; return; }
        if (hipFuncSetAttribute((const void*)hymba_fwd, hipFuncAttributeMaxDynamicSharedMemorySize, LDS_BYTES) != hipSuccess) { fprintf(stderr, "kernel_launch: hipFuncSetAttribute failed\n"); grid = -1; return; }
        (void)hipGetLastError();
        grid = cus;
    }
    if (grid < 0) return;
    (void)hipMemsetAsync((char*)d_ws + WS_CTL, 0, CTL_ZERO_BYTES, stream);
    Params a{};
    a.x_prompt = (const float*)d_in[0]; a.x_sample = (const float*)d_in[1]; a.cache_conv = (const float*)d_in[2]; a.cache_pool = (const float*)d_in[3];
    a.cache_k = (const float*)d_in[4]; a.cache_v = (const float*)d_in[5]; a.c_prompt = (const float*)d_in[6]; a.c_sample = (const float*)d_in[7];
    a.w_in = (const float*)d_in[8]; a.w_out = (const float*)d_in[9]; a.conv_w = (const float*)d_in[10]; a.conv_b = (const float*)d_in[11];
    a.cnorm_g = (const float*)d_in[12]; a.cnorm_b = (const float*)d_in[13]; a.pool_w = (const float*)d_in[14]; a.pool_scale = (const float*)d_in[15];
    a.sinks = (const float*)d_in[16]; a.w_mod = (const float*)d_in[17]; a.b_mod = (const float*)d_in[18]; a.ln_g = (const float*)d_in[19]; a.ln_b = (const float*)d_in[20];
    a.out = (float*)d_out; a.ws = (unsigned char*)d_ws;
    for (int i = 0; i < 32; ++i) a.inv_freq[i] = (float)std::pow(10000.0, -(double)i * (2.0 / 64.0));
    if (MK_N_LAUNCHES == 1) { a.ph_lo = 0; a.ph_hi = N_PHASES; hipLaunchKernelGGL(hymba_fwd, dim3(grid), dim3(NTHR), LDS_BYTES, stream, a); }
    else for (int ph = 0; ph < N_PHASES; ++ph) {
#ifdef DBG
        if (ph >= 2 && ph < N_PHASES - 1 && (ph - 2) % 3 == 2) hipLaunchKernelGGL(dbg_copyz, dim3(DBG_NS), dim3(256), 0, stream, a);
#endif
        a.ph_lo = ph; a.ph_hi = ph + 1; hipLaunchKernelGGL(hymba_fwd, dim3(grid), dim3(NTHR), LDS_BYTES, stream, a);
#ifdef DBG
        if (ph == 0) hipLaunchKernelGGL(dbg_p0, dim3(144), dim3(256), 0, stream, a);
        else if (ph == 1) hipLaunchKernelGGL(dbg_p0b, dim3(144), dim3(256), 0, stream, a);
        else if (ph == N_PHASES - 1) { hipLaunchKernelGGL(dbg_fin, dim3(DBG_NS), dim3(256), 0, stream, a); hipLaunchKernelGGL(dbg_report, dim3(1024), dim3(256), 0, stream, a); }
        else { const int l = (ph - 2) / 3, k = (ph - 2) % 3;
            if (k == 0) hipLaunchKernelGGL(dbg_in, dim3(DBG_NS), dim3(256), 0, stream, a, l);
            if (k == 1) hipLaunchKernelGGL(dbg_mix, dim3(DBG_NS), dim3(256), 0, stream, a, l);
            if (k == 2) hipLaunchKernelGGL(dbg_out, dim3(DBG_NS), dim3(256), 0, stream, a, l); }
#endif
    }
}
```

```cpp
#include <hip/hip_runtime.h>
#include <cstdint>
#include <cstdio>
#include <cmath>

#define DBG_REPORT_ID -1
#ifndef MK_N_LAUNCHES
#define MK_N_LAUNCHES 1
#endif

#define DI __device__ __forceinline__
#define GAS __attribute__((address_space(1)))
#define LAS __attribute__((address_space(3)))
typedef unsigned short u16;
typedef _Float16 h8 __attribute__((ext_vector_type(8)));
typedef _Float16 h4 __attribute__((ext_vector_type(4)));
typedef _Float16 h2 __attribute__((ext_vector_type(2)));
typedef float f32x2 __attribute__((ext_vector_type(2)));
typedef float f32x4 __attribute__((ext_vector_type(4)));
typedef float f32x16 __attribute__((ext_vector_type(16)));
typedef unsigned u32x4 __attribute__((ext_vector_type(4)));
typedef unsigned u32x2 __attribute__((ext_vector_type(2)));
typedef short v4i16_t __attribute__((ext_vector_type(4)));

constexpr int D = 1024, DIN = 2560, NB = 4, SEQ = 4096, DEPTH = 4, DB = 128, DS = 4;
constexpr int MP = NB * SEQ, MS = DB * DS, M = MP + MS;
constexpr int NMOD = NB + DB;
constexpr int PAST = 8192;
constexpr float LN_EPS = 1e-5f;
constexpr float ALPHA = 1.681792830507429f;
constexpr float LOG2E = 1.4426950408889634f;
constexpr float QSCALE = 0.125f * LOG2E;
constexpr size_t OFF_YP = 0, OFF_YS = OFF_YP + (size_t)MP * D, OFF_CONVP = OFF_YS + (size_t)MS * D, OFF_POOLP = OFF_CONVP + (size_t)DEPTH * NB * 30 * 256,
                 OFF_KP = OFF_POOLP + (size_t)DEPTH * NB * 15 * 256, OFF_VP = OFF_KP + (size_t)DEPTH * NB * 128 * 128, OFF_CONVS = OFF_VP + (size_t)DEPTH * NB * 128 * 128,
                 OFF_POOLS = OFF_CONVS + (size_t)DEPTH * DB * 30 * 256, OFF_KS = OFF_POOLS + (size_t)DEPTH * DB * 15 * 256, OFF_VS = OFF_KS + (size_t)DEPTH * DB * 128 * 128,
                 OUT_TOTAL = OFF_VS + (size_t)DEPTH * DB * 128 * 128;
constexpr size_t MiB = 1u << 20;
constexpr size_t WS_CTL = 0, CTL_ZERO_BYTES = 64 * 1024;
constexpr size_t WS_WIN = 1 * MiB;
constexpr size_t WS_WOUT = 21 * MiB;
constexpr size_t WS_MOD = 29 * MiB;
constexpr size_t WS_TAB = 36 * MiB;
constexpr size_t WS_ZH = 38 * MiB;
constexpr size_t WS_XR = 71 * MiB;
constexpr size_t WS_WINV0 = 71 * MiB;
constexpr size_t WS_MIX = 104 * MiB;
constexpr size_t WS_PA = 137 * MiB;
constexpr size_t WS_PSZC = WS_PA + (size_t)M * 256 * 2, WS_PPV = WS_PSZC + (size_t)M * 256 * 2, WS_PSZP = WS_PPV + (size_t)M * 256 * 2;
constexpr size_t WS_PQ = WS_PSZP + (size_t)M * 256 * 2;
constexpr size_t WS_PSZA = WS_PQ + (size_t)M * 512 * 2;
constexpr size_t WS_PK = WS_PSZA + (size_t)M * 512 * 2;
constexpr size_t WS_PV = WS_PK + (size_t)M * 128 * 2;
constexpr size_t WS_H = WS_PV + (size_t)M * 128 * 2;
constexpr size_t WS_PS = WS_H + (size_t)M * D * 2;
constexpr size_t WS_RC0 = WS_PS + 2 * (size_t)MP * 24 * 4;
constexpr size_t WS_MODV = WS_RC0 + (size_t)MP * 16;
constexpr size_t WS_LNC = WS_MODV + (size_t)DEPTH * NB * 4 * DIN * 4;
constexpr size_t WS_XS = WS_LNC + 256;
constexpr size_t WS_END = WS_XS + (size_t)64 * 4 * 256 * 8;
static_assert(WS_END <= 256 * MiB, "d_ws map");
constexpr int CW_BAR = 1024;
constexpr int CW_EARLY = 6400;
constexpr int CW_FIN = 5120;
constexpr int CW_SCNT = 12288;

DI unsigned pkh(float a, float b) { f32x2 v = {a, b}; h2 r = __builtin_convertvector(v, h2); return __builtin_bit_cast(unsigned, r); }
DI u32x4 pack8(const float* v) { u32x4 w; w.x = pkh(v[0], v[1]); w.y = pkh(v[2], v[3]); w.z = pkh(v[4], v[5]); w.w = pkh(v[6], v[7]); return w; }
DI void unpack8(u32x4 w, float* o) {
    const h8 v = __builtin_bit_cast(h8, w);
#pragma unroll
    for (int j = 0; j < 8; ++j) o[j] = (float)v[j];
}
DI float ex2(float x) { return __builtin_amdgcn_exp2f(x); }
DI float sigm(float x) { return __builtin_amdgcn_rcpf(1.f + ex2(-x * LOG2E)); }
DI float silu(float x) { return x * sigm(x); }
template <int O> DI float xor_lane(float v) {
    return __builtin_bit_cast(float, __builtin_amdgcn_ds_swizzle(__builtin_bit_cast(int, v), (O << 10) | 0x1f));
}
DI float sum_halves(float v) { float a = v, b = v; asm volatile("s_nop 1\n\tv_permlane32_swap_b32 %0, %1" : "+v"(a), "+v"(b)); return a + b; }
DI float max_halves(float v) { float a = v, b = v; asm volatile("s_nop 1\n\tv_permlane32_swap_b32 %0, %1" : "+v"(a), "+v"(b)); return fmaxf(a, b); }
template <int CTRL, int ROWMASK> DI float dpp_f(float v, float ident) { return __builtin_bit_cast(float, __builtin_amdgcn_update_dpp(__builtin_bit_cast(int, ident), __builtin_bit_cast(int, v), CTRL, ROWMASK, 0xf, false)); }
DI float wave_sum(float v) {
    v += dpp_f<0xB1, 0xf>(v, 0.f); v += dpp_f<0x4E, 0xf>(v, 0.f); v += dpp_f<0x141, 0xf>(v, 0.f); v += dpp_f<0x140, 0xf>(v, 0.f);
    v += dpp_f<0x142, 0xa>(v, 0.f); v += dpp_f<0x143, 0xc>(v, 0.f);
    return __builtin_bit_cast(float, __builtin_amdgcn_readlane(__builtin_bit_cast(int, v), 63));
}
DI float wave_max(float v) {
    const float NI = -INFINITY;
    v = fmaxf(v, dpp_f<0xB1, 0xf>(v, NI)); v = fmaxf(v, dpp_f<0x4E, 0xf>(v, NI)); v = fmaxf(v, dpp_f<0x141, 0xf>(v, NI)); v = fmaxf(v, dpp_f<0x140, 0xf>(v, NI));
    v = fmaxf(v, dpp_f<0x142, 0xa>(v, NI)); v = fmaxf(v, dpp_f<0x143, 0xc>(v, NI));
    return __builtin_bit_cast(float, __builtin_amdgcn_readlane(__builtin_bit_cast(int, v), 63));
}
DI int lane_id() { int l_; asm volatile("v_mbcnt_lo_u32_b32 %0, -1, 0\n\tv_mbcnt_hi_u32_b32 %0, -1, %0" : "=v"(l_)); return l_; }
DI int crow(int r, int hi) { return (r & 3) + 8 * (r >> 2) + 4 * hi; }

__host__ __device__ __forceinline__ int pperm(int bj, int c7) { return 128 * bj + 32 * (c7 >> 5) + 16 * ((c7 >> 2) & 1) + 4 * ((c7 >> 3) & 3) + (c7 & 3); }
__host__ __device__ __forceinline__ int perm_in(int col) {
    if (col < 512) { const int bj = col >> 8, ch = col & 255; return 256 * (ch >> 7) + pperm(bj, ch & 127); }
    if (col < 1280) { const int base = col < 768 ? 512 : (col < 1024 ? 768 : 1024); const int x = col - base; return base + pperm(x >> 7, x & 127); }
    if (col < 1792) { const int x = col - 1280, head = x >> 6, d = x & 63; return 256 * (5 + (head >> 2)) + pperm(d >> 5, 32 * (head & 3) + (d & 31)); }
    if (col < 2048) { const int x = col - 1792, hh = x >> 6, d = x & 63; return 1792 + pperm(d >> 5, 32 * hh + (d & 31)); }
    { const int x = col - 2048; return 2048 + 256 * (x >> 8) + pperm((x >> 7) & 1, x & 127); }
}
__host__ __device__ __forceinline__ int perm_out(int col) { const int y = col & 255; return (col & ~255) + pperm(y >> 7, y & 127); }

namespace pg8 {
constexpr int BM = 256, BK = 64, HALF = 128, HTB = HALF * BK * 2, STAGE_BYTES = 8 * HTB, NXCD = 8, WGM = 8;
__host__ __device__ __forceinline__ int lds_byte(int r, int c) { const int st = (r >> 4) * 2 + (c >> 5), rr = r & 15, cc = c & 31, ob = rr * 64 + cc * 2; return st * 1024 + (ob ^ (((ob >> 9) & 1) << 5)); }
__host__ __device__ __forceinline__ void stage_rc(int b, int& R, int& C) { const int st = b / 1024, sb = b % 1024, swz = sb ^ (((sb >> 9) & 1) << 5); R = (st >> 1) * 16 + swz / 64; C = (st & 1) * 32 + (swz % 64) / 2; }
struct Unit { int pm, pn; };
struct Gemm { const u16* A; const u16* Bt; int M, N, K; };
struct StaticOrder {
    int nM, nN, nwg, G, c;
    __host__ __device__ __forceinline__ void init(int M_, int N_, int G_, int c_) { nM = M_ / BM; nN = N_ / BM; nwg = nM * nN; G = G_; c = c_; }
    __host__ __device__ __forceinline__ bool next(int i, Unit& u) const {
        const long L = (long)i * G + c; if (L >= nwg) return false;
        int wgid = (int)L; { const int q = nwg / NXCD, r = nwg % NXCD, xcd = wgid % NXCD, off = wgid / NXCD; wgid = (xcd < r ? xcd * (q + 1) : r * (q + 1) + (xcd - r) * q) + off; }
        const int nig = WGM * nN, gid = wgid / nig, fm = gid * WGM, gsz = (nM - fm) < WGM ? (nM - fm) : WGM;
        u.pm = fm + ((wgid % nig) % gsz); u.pn = (wgid % nig) / gsz; return true;
    }
};

struct InOrder {
    int nM, nN, nwg, G, c, s0, ns;
    __host__ __device__ __forceinline__ void init(int M_, int N_, int G_, int c_, int s0_, int ns_) { nM = M_ / BM; nN = N_ / BM; nwg = nM * nN; G = G_; c = c_; s0 = s0_; ns = ns_; }
    __host__ __device__ __forceinline__ bool next(int i, Unit& u) const {
        const long L = (long)i * G + c; if (L >= nwg) return false;
        if (ns > 0 && L >= s0 && L < s0 + ns) { const int k = (int)L - s0, nsp = ns / nN; u.pm = nM - nsp + k % nsp; u.pn = k / nsp; return true; }
        const int idx = (ns > 0 && L >= s0) ? (int)L - ns : (int)L, nwp = nwg - ns, nMp = nwp / nN;
        int wgid = idx; { const int q = nwp / NXCD, r = nwp % NXCD, xcd = wgid % NXCD, off = wgid / NXCD; wgid = (xcd < r ? xcd * (q + 1) : r * (q + 1) + (xcd - r) * q) + off; }
        const int nig = WGM * nN, gid = wgid / nig, fm = gid * WGM, gsz = (nMp - fm) < WGM ? (nMp - fm) : WGM;
        u.pm = fm + ((wgid % nig) % gsz); u.pn = (wgid % nig) / gsz; return true;
    }
};

template <class Epi, bool ALIGN_EPI, class Ord>
DI void gemm_phase(LAS unsigned char* lds, const Gemm g, const Ord& S, const Epi& E, const int tid) {
    const int wid = __builtin_amdgcn_readfirstlane(tid >> 6), lane = tid & 63, wr = wid >> 2, wc = wid & 3, fr = lane & 15, fq = lane >> 4;
    const int K = g.K, nt = K / BK;
    unsigned voffA[2];
#pragma unroll
    for (int i = 0; i < 2; ++i) { int R, C; stage_rc(tid * 16 + i * 8192, R, C); voffA[i] = (unsigned)(R * K + C) * 2u; }
    const size_t kstep = (size_t)(BK * 2);
    const size_t hstep = (size_t)HALF * K * 2;
    const size_t tstep = 2 * hstep;
    const unsigned ldsw = (unsigned)wid * 1024u;
    const int aoff = lds_byte(wr * 64 + fr, fq * 8), boff = lds_byte(wc * 32 + fr, fq * 8);
#define PG8_SA(b, h) (((b) * 2 + (h)) * HTB)
#define PG8_SB(b, h) ((4 + (b) * 2 + (h)) * HTB)
#define PG8_STAGE(bufoff, gbase) do { _Pragma("unroll") for (int _i = 0; _i < 2; ++_i) \
        __builtin_amdgcn_global_load_lds((const unsigned*)((const char*)(gbase) + voffA[_i]), (LAS unsigned*)(lds + (bufoff) + ldsw + _i * 8192), 16, 0, 0); } while (0)
#define PG8_LDA(dst, b, h) do { _Pragma("unroll") for (int m = 0; m < 4; ++m) _Pragma("unroll") for (int k = 0; k < 2; ++k) dst[m][k] = *(const LAS h8*)(lds + PG8_SA(b, h) + aoff + m * 2048 + k * 1024); } while (0)
#define PG8_LDB(dst, b, h) do { _Pragma("unroll") for (int n = 0; n < 2; ++n) _Pragma("unroll") for (int k = 0; k < 2; ++k) dst[n][k] = *(const LAS h8*)(lds + PG8_SB(b, h) + boff + n * 2048 + k * 1024); } while (0)
#define PG8_MMA(ai, bj, At, Bt) do { __builtin_amdgcn_s_setprio(1); _Pragma("unroll") for (int m = 0; m < 4; ++m) _Pragma("unroll") for (int n = 0; n < 2; ++n) _Pragma("unroll") for (int k = 0; k < 2; ++k) \
        acc[ai][bj][m][n] = __builtin_amdgcn_mfma_f32_16x16x32_f16(Bt[n][k], At[m][k], acc[ai][bj][m][n], 0, 0, 0); __builtin_amdgcn_s_setprio(0); } while (0)
#define PG8_WAIT_V(n) asm volatile("s_waitcnt vmcnt(" #n ")" ::: "memory")
#define PG8_WAIT_L(n) asm volatile("s_waitcnt lgkmcnt(" #n ")" ::: "memory")
#define PG8_BAR __builtin_amdgcn_s_barrier()
#define PG8_SCHED __builtin_amdgcn_sched_barrier(0)
    Unit cur, nxt; int ui = 0;
    if (!S.next(0, cur)) return;
    f32x4 acc[2][2][4][2];
#pragma unroll
    for (int a = 0; a < 2; ++a)
#pragma unroll
        for (int b = 0; b < 2; ++b)
#pragma unroll
            for (int m = 0; m < 4; ++m)
#pragma unroll
                for (int n = 0; n < 2; ++n) acc[a][b][m][n] = (f32x4){0.f, 0.f, 0.f, 0.f};
    h8 At[4][2], B0[2][2], B1[2][2];
    const char* cA = (const char*)g.A + E.a_off(cur.pm) + (size_t)cur.pm * tstep; const char* cB = (const char*)g.Bt + E.b_off(cur.pm) + (size_t)cur.pn * tstep;
    PG8_STAGE(PG8_SB(0, 0), cB); PG8_STAGE(PG8_SB(0, 1), cB + hstep); PG8_STAGE(PG8_SA(0, 0), cA); PG8_STAGE(PG8_SA(0, 1), cA + hstep);
    if (wr == 1) PG8_BAR;
    PG8_WAIT_V(2); PG8_BAR;
    PG8_STAGE(PG8_SB(1, 0), cB + kstep); PG8_STAGE(PG8_SA(1, 0), cA + kstep); PG8_STAGE(PG8_SB(1, 1), cB + hstep + kstep);
    PG8_WAIT_V(6); PG8_BAR;
    for (;;) {
        const bool has_next = S.next(ui + 1, nxt);
        const char* nA = has_next ? (const char*)g.A + E.a_off(nxt.pm) + (size_t)nxt.pm * tstep : cA; const char* nB = has_next ? (const char*)g.Bt + E.b_off(nxt.pm) + (size_t)nxt.pn * tstep : cB;
        asm volatile(".p2align 8");
        for (int t = 0; t < nt; t += 2) {
            const bool last = (t == nt - 2);
            const char* a1 = cA + (size_t)(t + 1) * kstep;
            const char* a2 = last ? nA : cA + (size_t)(t + 2) * kstep; const char* b2 = last ? nB : cB + (size_t)(t + 2) * kstep;
            const char* a3 = a2 + kstep; const char* b3 = b2 + kstep;
            PG8_LDB(B0, 0, 0); PG8_LDB(B1, 0, 1); PG8_SCHED; PG8_LDA(At, 0, 0); PG8_STAGE(PG8_SA(1, 1), a1 + hstep);
            PG8_WAIT_V(8); PG8_WAIT_L(0); PG8_BAR; PG8_MMA(0, 0, At, B0); PG8_MMA(0, 1, At, B1); PG8_BAR; PG8_SCHED;
            PG8_LDA(At, 0, 1); PG8_STAGE(PG8_SB(0, 0), b2); PG8_STAGE(PG8_SB(0, 1), b2 + hstep); PG8_STAGE(PG8_SA(0, 0), a2);
            PG8_WAIT_V(8); PG8_WAIT_L(0); PG8_BAR; PG8_MMA(1, 0, At, B0); PG8_MMA(1, 1, At, B1); PG8_BAR; PG8_SCHED;
            PG8_LDB(B0, 1, 0); PG8_LDB(B1, 1, 1); PG8_SCHED; PG8_LDA(At, 1, 0); PG8_STAGE(PG8_SA(0, 1), a2 + hstep);
            PG8_WAIT_V(8); PG8_WAIT_L(0); PG8_BAR; PG8_MMA(0, 0, At, B0); PG8_MMA(0, 1, At, B1); PG8_BAR; PG8_SCHED;
            PG8_LDA(At, 1, 1); PG8_STAGE(PG8_SB(1, 0), b3); PG8_STAGE(PG8_SB(1, 1), b3 + hstep); PG8_STAGE(PG8_SA(1, 0), a3);
            PG8_WAIT_V(8); PG8_WAIT_L(0); PG8_BAR; PG8_MMA(1, 0, At, B0); PG8_MMA(1, 1, At, B1); PG8_BAR; PG8_SCHED;
        }
        if constexpr (ALIGN_EPI) { if (wr == 0) PG8_BAR; }
        if constexpr (!Epi::AFTER_DRAIN) E(acc, cur, ui, wr, wc, fr, fq);
        if constexpr (Epi::PUBLISH) { if (E.wants_publish(cur, ui)) { PG8_WAIT_V(0); PG8_BAR; if (wid == 0) E.publish(lane); } }
        if (!has_next) break;
#pragma unroll
        for (int a = 0; a < 2; ++a)
#pragma unroll
            for (int b = 0; b < 2; ++b)
#pragma unroll
                for (int m = 0; m < 4; ++m)
#pragma unroll
                    for (int n = 0; n < 2; ++n) acc[a][b][m][n] = (f32x4){0.f, 0.f, 0.f, 0.f};
        cur = nxt; cA = nA; cB = nB; ++ui;
        if constexpr (ALIGN_EPI) { if (wr == 1) PG8_BAR; }
    }
    PG8_WAIT_V(0);
    if constexpr (!ALIGN_EPI) { if (wr == 0) PG8_BAR; }
    PG8_BAR;
    if constexpr (Epi::AFTER_DRAIN) E.fused(acc, cur, wr, wc, fr, fq, lds, tid);
#undef PG8_SA
#undef PG8_SB
#undef PG8_STAGE
#undef PG8_LDA
#undef PG8_LDB
#undef PG8_MMA
#undef PG8_WAIT_V
#undef PG8_WAIT_L
#undef PG8_BAR
#undef PG8_SCHED
}
}

struct Params {
    const float* x_prompt; const float* x_sample; const float* cache_conv; const float* cache_pool; const float* cache_k; const float* cache_v;
    const float* c_prompt; const float* c_sample; const float* w_in; const float* w_out; const float* conv_w; const float* conv_b; const float* cnorm_g; const float* cnorm_b;
    const float* pool_w; const float* pool_scale; const float* sinks; const float* w_mod; const float* b_mod; const float* ln_g; const float* ln_b;
    float* out; unsigned char* ws;
    int ph_lo, ph_hi;
    float inv_freq[32];
};
struct ParamsHead { const float* ptrs[21]; float* out; unsigned char* ws; int ph_lo, ph_hi; };
static_assert(sizeof(ParamsHead) == __builtin_offsetof(Params, inv_freq), "ParamsHead mirrors the head of Params");

DI void row_info(int row, bool& smp, int& b, int& t) { smp = row >= MP; if (!smp) { b = row >> 12; t = row & (SEQ - 1); } else { const int s = row - MP; b = s >> 2; t = s & 3; } }
DI void st8f(float* dst, const float* v) { *(f32x4*)dst = (f32x4){v[0], v[1], v[2], v[3]}; *(f32x4*)(dst + 4) = (f32x4){v[4], v[5], v[6], v[7]}; }

struct EpiIn {
    static constexpr bool AFTER_DRAIN = false, PUBLISH = true;
    int l; unsigned char* ws; float* out; const LAS float* rcl; bool early;
    DI long a_off(int pm) const { return pm < MP / 256 ? (long)WS_ZH - (long)WS_H : 0l; }
    DI long b_off(int pm) const { return pm < MP / 256 ? (long)((l & 1) ? WS_H : WS_WINV0) + (long)(pm >> 4) * DIN * D * 2 - (long)WS_WIN - (long)l * DIN * D * 2 : 0l; }
    DI bool wants_publish(const pg8::Unit& u, int ui) const { return early && ui == 0 && u.pm >= MP / 256; }
    DI void publish(int lane) const {
        __builtin_amdgcn_fence(__ATOMIC_RELEASE, "agent"); asm volatile("s_waitcnt vmcnt(0)" ::: "memory");
        if (lane == 0) (void)__hip_atomic_fetch_add((unsigned*)(ws + WS_CTL) + CW_EARLY + 64 * l, 1u, __ATOMIC_RELAXED, __HIP_MEMORY_SCOPE_AGENT); }
    DI void operator()(f32x4 (&acc)[2][2][4][2], const pg8::Unit& u, int ui, int wr, int wc, int fr, int fq) const {
        asm volatile("" : "+v"(fr), "+v"(fq));
        const int pn = u.pn;
        if (u.pm < MP / 256) {
            const LAS f32x4* rc = (const LAS f32x4*)rcl + ui * 256 + wr * 64 + fr;
            const float* mv = (const float*)(ws + WS_MODV) + (size_t)(l * NB + (u.pm >> 4)) * 4 * DIN + pn * 256 + wc * 32 + 4 * fq;
            f32x4 V[2][2][4];
#pragma unroll
            for (int bj = 0; bj < 2; ++bj)
#pragma unroll
                for (int n = 0; n < 2; ++n)
#pragma unroll
                    for (int k = 0; k < 4; ++k) V[bj][n][k] = *(const f32x4*)(mv + 128 * bj + 16 * n + k * DIN);
#pragma unroll
            for (int bj = 0; bj < 2; ++bj)
#pragma unroll
                for (int n = 0; n < 2; ++n)
#pragma unroll
                    for (int ai = 0; ai < 2; ++ai)
#pragma unroll
                        for (int m = 0; m < 4; ++m) { const f32x4 r = rc[ai * 128 + m * 16];
                            acc[ai][bj][m][n] = r[0] * acc[ai][bj][m][n] - r[1] * V[bj][n][0] + r[2] * V[bj][n][1] - r[3] * V[bj][n][2] + V[bj][n][3]; }
        }
        unsigned char* const W = ws; float* const O = out;
#define ST16(byteoff, vals) (*(u32x4*)(W + (size_t)(unsigned)(byteoff)) = pack8(vals))
#define STF8(fidx, vals) st8f(O + (size_t)(unsigned)(fidx), vals)
#pragma unroll
        for (int ai = 0; ai < 2; ++ai)
#pragma unroll
            for (int m = 0; m < 4; ++m) {
                const unsigned row = (unsigned)(u.pm * 256 + ai * 128 + wr * 64 + m * 16 + fr);
                const bool smp = row >= (unsigned)MP; const unsigned b = smp ? (row - MP) >> 2 : row >> 12, t = smp ? (row - MP) & 3u : row & (unsigned)(SEQ - 1);
                if (pn < 2) {
                    const unsigned c8 = pn * 128 + wc * 32 + fq * 8; float a[8];
#pragma unroll
                    for (int n = 0; n < 2; ++n)
#pragma unroll
                        for (int j = 0; j < 4; ++j) a[4 * n + j] = acc[ai][0][m][n][j] * sigm(acc[ai][1][m][n][j]);
                    ST16((unsigned)WS_PA + (row * 256 + c8) * 2, a);
                    if (smp) STF8((unsigned)OFF_CONVS + ((l * DB + b) * 30 + 26 + t) * 256 + c8, a);
                    else if (t >= SEQ - 30) STF8((unsigned)OFF_CONVP + ((l * NB + b) * 30 + (t - (SEQ - 30))) * 256 + c8, a);
                } else if (pn == 2 || pn == 4) {
                    const unsigned base = pn == 2 ? (unsigned)WS_PSZC : (unsigned)WS_PSZP;
#pragma unroll
                    for (int bj = 0; bj < 2; ++bj) { const unsigned c8 = bj * 128 + wc * 32 + fq * 8; float v[8];
#pragma unroll
                        for (int n = 0; n < 2; ++n)
#pragma unroll
                            for (int j = 0; j < 4; ++j) v[4 * n + j] = silu(acc[ai][bj][m][n][j]);
                        ST16(base + (row * 256 + c8) * 2, v); }
                } else if (pn == 3) {
#pragma unroll
                    for (int bj = 0; bj < 2; ++bj) { const unsigned c8 = bj * 128 + wc * 32 + fq * 8; float v[8];
#pragma unroll
                        for (int n = 0; n < 2; ++n)
#pragma unroll
                            for (int j = 0; j < 4; ++j) v[4 * n + j] = acc[ai][bj][m][n][j];
                        ST16((unsigned)WS_PPV + (row * 256 + c8) * 2, v);
                        if (smp) STF8((unsigned)OFF_POOLS + ((l * DB + b) * 15 + 11 + t) * 256 + c8, v);
                        else if (t >= SEQ - 15) STF8((unsigned)OFF_POOLP + ((l * NB + b) * 15 + (t - (SEQ - 15))) * 256 + c8, v); }
                } else if (pn >= 8) {
#pragma unroll
                    for (int bj = 0; bj < 2; ++bj) { const unsigned c8 = (pn - 8) * 256 + bj * 128 + wc * 32 + fq * 8; float v[8];
#pragma unroll
                        for (int n = 0; n < 2; ++n)
#pragma unroll
                            for (int j = 0; j < 4; ++j) v[4 * n + j] = silu(acc[ai][bj][m][n][j]);
                        ST16((unsigned)WS_PSZA + (row * 512 + c8) * 2, v); }
                } else if (pn == 7 && wc >= 2) {
                    const unsigned hv = wc - 2;
#pragma unroll
                    for (int bj = 0; bj < 2; ++bj) { const unsigned d8 = 32 * bj + 8 * fq; float v[8];
#pragma unroll
                        for (int n = 0; n < 2; ++n)
#pragma unroll
                            for (int j = 0; j < 4; ++j) v[4 * n + j] = acc[ai][bj][m][n][j];
                        ST16((unsigned)WS_PV + (row * 128 + hv * 64 + d8) * 2, v);
                        if (smp) STF8((unsigned)OFF_VS + (((l * DB + b) * 128 + 124 + t) * 2 + hv) * 64 + d8, v);
                        else if (t >= SEQ - 128) STF8((unsigned)OFF_VP + (((l * NB + b) * 128 + (t - (SEQ - 128))) * 2 + hv) * 64 + d8, v); }
                } else {
                    const unsigned d8 = 8 * fq; const unsigned pidx = smp ? SEQ + t : t;
                    const f32x4* tp = (const f32x4*)(W + (size_t)((unsigned)WS_TAB + (pidx * 32 + d8) * 8));
                    float x1[8], x2[8], o1[8], o2[8];
#pragma unroll
                    for (int n = 0; n < 2; ++n)
#pragma unroll
                        for (int j = 0; j < 4; ++j) { x1[4 * n + j] = acc[ai][0][m][n][j]; x2[4 * n + j] = acc[ai][1][m][n][j]; }
                    const float sc = pn == 7 ? 1.f : QSCALE;
#pragma unroll
                    for (int k2 = 0; k2 < 4; ++k2) { const f32x4 cs = tp[k2];
                        o1[2 * k2] = (x1[2 * k2] * cs[0] - x2[2 * k2] * cs[1]) * sc;         o2[2 * k2] = (x2[2 * k2] * cs[0] + x1[2 * k2] * cs[1]) * sc;
                        o1[2 * k2 + 1] = (x1[2 * k2 + 1] * cs[2] - x2[2 * k2 + 1] * cs[3]) * sc; o2[2 * k2 + 1] = (x2[2 * k2 + 1] * cs[2] + x1[2 * k2 + 1] * cs[3]) * sc; }
                    if (pn == 7) { const unsigned hk = wc;
                        ST16((unsigned)WS_PK + (row * 128 + hk * 64 + d8) * 2, o1); ST16((unsigned)WS_PK + (row * 128 + hk * 64 + 32 + d8) * 2, o2);
                        if (smp) { const unsigned di = (unsigned)OFF_KS + (((l * DB + b) * 128 + 124 + t) * 2 + hk) * 64 + d8; STF8(di, o1); STF8(di + 32, o2); }
                        else if (t >= SEQ - 128) { const unsigned di = (unsigned)OFF_KP + (((l * NB + b) * 128 + (t - (SEQ - 128))) * 2 + hk) * 64 + d8; STF8(di, o1); STF8(di + 32, o2); }
                    } else { const unsigned head = (pn - 5) * 4 + wc;
                        ST16((unsigned)WS_PQ + (row * 512 + head * 64 + d8) * 2, o1); ST16((unsigned)WS_PQ + (row * 512 + head * 64 + 32 + d8) * 2, o2); }
                }
            }
#undef ST16
#undef STF8
    }
};

struct EpiOutF {
    static constexpr bool AFTER_DRAIN = true, PUBLISH = false;
    unsigned char* ws; int l; const float* ln_g; const float* ln_b; float* out;
    DI void operator()(f32x4 (&)[2][2][4][2], const pg8::Unit&, int, int, int, int, int) const {}
    DI long a_off(int) const { return 0l; }
    DI long b_off(int) const { return 0l; }
    static constexpr int SETUP_HI = 131072 + 1024;
    DI void setup_item(const pg8::Unit& u, LAS unsigned char* lds, int item) const {
        LAS float* CV = (LAS float*)lds; LAS float* RS = (LAS float*)(lds + 6144);
        const float* MOD = (const float*)(ws + WS_MOD); const int b = u.pm >> 4;
        if (item < 256) { const int col = u.pn * 256 + item;
            CV[item] = l > 0 ? ln_g[(l - 1) * D + col] : 1.f; CV[256 + item] = l > 0 ? ln_b[(l - 1) * D + col] : 0.f;
            CV[512 + item] = MOD[((size_t)l * NMOD + b) * 3072 + 2048 + col]; CV[768 + item] = ln_g[l * D + col]; CV[1024 + item] = ln_b[l * D + col];
            CV[1280 + item] = l < DEPTH - 1 ? MOD[((size_t)(l + 1) * NMOD + b) * 3072 + 1024 + col] : 0.f;
        } else { const int row = item - 256; float mu = 0.f, rstd = 1.f;
            const float* PSp = (const float*)(ws + WS_PS) + (size_t)((l + 1) & 1) * MP * 24;
            if (l > 0) { const float* ps = PSp + (size_t)(u.pm * 256 + row) * 24; const f32x2 q0 = *(const f32x2*)ps, q1 = *(const f32x2*)(ps + 6), q2 = *(const f32x2*)(ps + 12), q3 = *(const f32x2*)(ps + 18);
                const float s1 = (q0[0] + q1[0]) + (q2[0] + q3[0]), s2 = (q0[1] + q1[1]) + (q2[1] + q3[1]);
                mu = s1 * (1.f / D); rstd = 1.f / sqrtf(s2 * (1.f / D) - mu * mu + LN_EPS); }
            RS[2 * row] = mu; RS[2 * row + 1] = rstd; }
    }
    DI void fused(f32x4 (&acc)[2][2][4][2], const pg8::Unit& u, int wr, int wc, int fr, int fq, LAS unsigned char* lds, int tid) const {
        LAS float* CV = (LAS float*)lds;
        LAS float* RS = (LAS float*)(lds + 6144);
        LAS float* PW = (LAS float*)(lds + 12288);
        u16* ZH = (u16*)(ws + WS_ZH); u16* ZP = (u16*)(ws + WS_H);
        float* PSc = (float*)(ws + WS_PS) + (size_t)(l & 1) * MP * 24;
        if (MK_N_LAUNCHES != 1) setup_item(u, lds, tid);
        else *(LAS u32x4*)(lds + tid * 16) = *(const LAS u32x4*)(lds + SETUP_HI + tid * 16);
        __syncthreads();
#pragma unroll
        for (int ai = 0; ai < 2; ++ai) {
        u32x4 zpv[4][2];
#pragma unroll
        for (int mm = 0; mm < 4; ++mm)
#pragma unroll
            for (int bj = 0; bj < 2; ++bj) zpv[mm][bj] = __builtin_nontemporal_load((const u32x4*)(ZH + ((size_t)u.pm * 256 + ai * 128 + wr * 64 + mm * 16 + fr) * D + u.pn * 256 + bj * 128 + wc * 32 + fq * 8));
#pragma unroll
        for (int mm = 0; mm < 4; ++mm) { const int m = mm;
            const int rt = ai * 128 + wr * 64 + m * 16 + fr; const size_t row = (size_t)u.pm * 256 + rt;
            const float mu = RS[2 * rt], rstd = RS[2 * rt + 1];
            f32x2 S1 = {0.f, 0.f}, S2 = {0.f, 0.f}, S3 = {0.f, 0.f}, S4 = {0.f, 0.f}, S5 = {0.f, 0.f}, S6 = {0.f, 0.f};
#pragma unroll
            for (int bj = 0; bj < 2; ++bj) { const int cl = bj * 128 + wc * 32 + fq * 8; const size_t off = row * D + u.pn * 256 + cl;
                float zp[8], zq[8]; unpack8(zpv[mm][bj], zp);
#pragma unroll
                for (int hh = 0; hh < 2; ++hh) {
                    const f32x4 gp = *(const LAS f32x4*)(CV + cl + 4 * hh), bp = *(const LAS f32x4*)(CV + 256 + cl + 4 * hh), gt = *(const LAS f32x4*)(CV + 512 + cl + 4 * hh),
                                gg = *(const LAS f32x4*)(CV + 768 + cl + 4 * hh), bb = *(const LAS f32x4*)(CV + 1024 + cl + 4 * hh);
                    const f32x4 av = acc[ai][bj][m][hh];
                    const f32x4 zp4 = {zp[4 * hh], zp[4 * hh + 1], zp[4 * hh + 2], zp[4 * hh + 3]};
                    f32x4 x1 = zp4; if (l > 0) x1 = (zp4 - mu) * rstd * gp + bp;
                    const f32x4 z = ALPHA * x1 + (1.f + gt) * av, uu = z * gg;
                    const f32x2 zl = {z[0], z[1]}, zh = {z[2], z[3]}, ul = {uu[0], uu[1]}, uh = {uu[2], uu[3]};
                    const f32x2 gl = {gg[0], gg[1]}, gh = {gg[2], gg[3]}, bl = {bb[0], bb[1]}, bh = {bb[2], bb[3]};
                    S1 += zl; S1 += zh; S2 += zl * zl; S2 += zh * zh; S3 += ul; S3 += uh; S4 += ul * ul; S4 += uh * uh; S5 += ul * gl; S5 += uh * gh; S6 += ul * bl; S6 += uh * bh;
#pragma unroll
                    for (int j = 0; j < 4; ++j) zq[4 * hh + j] = z[j];
                    acc[ai][bj][m][hh] = z; }
                if (l < DEPTH - 1) *(u32x4*)(ZH + off) = pack8(zq); }
            float s1 = S1[0] + S1[1], s2 = S2[0] + S2[1], s3 = S3[0] + S3[1], s4 = S4[0] + S4[1], s5 = S5[0] + S5[1], s6 = S6[0] + S6[1];
            s1 = sum_halves(s1 + xor_lane<16>(s1)); s2 = sum_halves(s2 + xor_lane<16>(s2)); s3 = sum_halves(s3 + xor_lane<16>(s3)); s4 = sum_halves(s4 + xor_lane<16>(s4)); s5 = sum_halves(s5 + xor_lane<16>(s5)); s6 = sum_halves(s6 + xor_lane<16>(s6));
            if (fq == 0) { LAS float* pw = PW + (rt * 4 + wc) * 6; pw[0] = s1; pw[1] = s2; pw[2] = s3; pw[3] = s4; pw[4] = s5; pw[5] = s6; } }
        asm volatile("" ::: "memory"); }
        __syncthreads();
        if (tid < 256 && l < DEPTH - 1) { float* ps = PSc + (size_t)(u.pm * 256 + tid) * 24 + u.pn * 6; const LAS float* pw = PW + tid * 24;
#pragma unroll
            for (int k = 0; k < 6; ++k) ps[k] = (pw[k] + pw[6 + k]) + (pw[12 + k] + pw[18 + k]); }
        if (l == DEPTH - 1) {
            unsigned long long* XS = (unsigned long long*)(ws + WS_XS) + (size_t)u.pm * 4 * 256;
            unsigned* cnt = (unsigned*)(ws + WS_CTL) + CW_FIN + 16 * u.pm;
            if (tid < 256) { const LAS float* pw = PW + tid * 24; const float a = (pw[0] + pw[6]) + (pw[12] + pw[18]), b2 = (pw[1] + pw[7]) + (pw[13] + pw[19]);
                __hip_atomic_store(XS + u.pn * 256 + tid, ((unsigned long long)__builtin_bit_cast(unsigned, b2) << 32) | __builtin_bit_cast(unsigned, a), __ATOMIC_RELAXED, __HIP_MEMORY_SCOPE_AGENT); }
            asm volatile("s_waitcnt vmcnt(0)" ::: "memory");
            __syncthreads();
            if (tid == 0) (void)__hip_atomic_fetch_add(cnt, 1u, __ATOMIC_RELAXED, __HIP_MEMORY_SCOPE_AGENT);
            if (tid < 64) { for (unsigned sp = 0; sp < (1u << 20); ++sp) { if (__hip_atomic_load(cnt, __ATOMIC_RELAXED, __HIP_MEMORY_SCOPE_AGENT) >= 4u) break; __builtin_amdgcn_s_sleep(1); }
                __builtin_amdgcn_fence(__ATOMIC_ACQUIRE, "agent"); asm volatile("s_waitcnt vmcnt(0)" ::: "memory"); }
            __syncthreads();
            if (tid < 256) { unsigned long long xs[4];
#pragma unroll
                for (int t = 0; t < 4; ++t) xs[t] = __hip_atomic_load(XS + t * 256 + tid, __ATOMIC_RELAXED, __HIP_MEMORY_SCOPE_AGENT);
                float a = 0.f, b2 = 0.f;
#pragma unroll
                for (int t = 0; t < 4; ++t) { a += __builtin_bit_cast(float, (unsigned)xs[t]); b2 += __builtin_bit_cast(float, (unsigned)(xs[t] >> 32)); }
                const float mu = a * (1.f / D); RS[2 * tid] = mu; RS[2 * tid + 1] = 1.f / sqrtf(b2 * (1.f / D) - mu * mu + LN_EPS); }
            __syncthreads();
            float* Y = out + OFF_YP;
#pragma unroll
            for (int ai = 0; ai < 2; ++ai)
#pragma unroll
                for (int m = 0; m < 4; ++m) { const int rt = ai * 128 + wr * 64 + m * 16 + fr; const float mu = RS[2 * rt], rstd = RS[2 * rt + 1];
#pragma unroll
                    for (int bj = 0; bj < 2; ++bj) { const int cl = bj * 128 + wc * 32 + fq * 8;
#pragma unroll
                        for (int hh = 0; hh < 2; ++hh) { const f32x4 gg = *(const LAS f32x4*)(CV + 768 + cl + 4 * hh), bb = *(const LAS f32x4*)(CV + 1024 + cl + 4 * hh); f32x4 o;
#pragma unroll
                            for (int j = 0; j < 4; ++j) o[j] = (acc[ai][bj][m][hh][j] - mu) * rstd * gg[j] + bb[j];
                            *(f32x4*)(Y + ((size_t)u.pm * 256 + rt) * D + u.pn * 256 + cl + 4 * hh) = o; } } }
        }
    }
};

#define XB_TMO      128
#define XB_XCNT(j)  (256  + 64 * (j))
#define XB_XSUB(j)  (1280 + 64 * (j))
#define XB_XGEN(j)  (2304 + 64 * (j))
#define XB_TOP      3328
#define XB_TOPGEN   3392
#define XCD_BAR_WORDS 3456
#define XB_SPIN_CAP (1u << 18)
DI unsigned xb_ld(unsigned* p)              { return __hip_atomic_load(p, __ATOMIC_RELAXED, __HIP_MEMORY_SCOPE_AGENT); }
DI unsigned xb_add(unsigned* p, unsigned v) { return __hip_atomic_fetch_add(p, v, __ATOMIC_RELAXED, __HIP_MEMORY_SCOPE_AGENT); }
DI unsigned xb_xcc_id() { return (unsigned)__builtin_amdgcn_s_getreg((3 << 11) | 20) & 0xFu; }
#define XB_SPIN(cond, bar) do { unsigned _sp = 0; while (cond) { __builtin_amdgcn_s_sleep(1); \
    if ((++_sp & 255u) == 0u) { if (xb_ld(&(bar)[XB_TMO])) break; if (_sp > XB_SPIN_CAP) { atomicAdd(&(bar)[XB_TMO], 1u); break; } } } } while (0)
struct XcdBarrier { unsigned* bar; unsigned x; volatile LAS unsigned* st; };
DI XcdBarrier xcd_barrier_post(unsigned* bar, volatile LAS unsigned* st) {
    XcdBarrier b; b.bar = bar; b.x = xb_xcc_id(); b.st = st;
    if (threadIdx.x == 0) (void)xb_add(&bar[XB_XCNT(b.x)], 1u);
    return b;
}
DI void xcd_barrier_complete(unsigned* bar, unsigned x, unsigned& nloc, unsigned& nx) {
    const unsigned G = gridDim.x * gridDim.y * gridDim.z;
    unsigned sum, cnt, mine, sp = 0u;
    for (;;) {
        sum = 0u; cnt = 0u; mine = 0u;
#pragma unroll
        for (unsigned j = 0; j < 16; ++j) { const unsigned c = xb_ld(&bar[XB_XCNT(j)]); sum += c; cnt += (c > 0u) ? 1u : 0u; mine = (j == x) ? c : mine; }
        if (sum == G) break;
        __builtin_amdgcn_s_sleep(1);
        if ((++sp & 255u) == 0u) { if (xb_ld(&bar[XB_TMO])) break; if (sp > XB_SPIN_CAP) { atomicAdd(&bar[XB_TMO], 1u); break; } }
    }
    nloc = mine > 0u ? mine : 1u; nx = cnt > 0u ? cnt : 1u;
}
DI void xcd_barrier_census(const XcdBarrier& b, const int wave_s) {
    if (wave_s != 0) return;
    const int ln = lane_id(); unsigned* bar = b.bar;
    const unsigned G = gridDim.x * gridDim.y * gridDim.z;
    unsigned sum = 0u, cnt = 0u, mine = 0u;
    for (unsigned sp = 0u; sp < 4096u; ++sp) {
        const unsigned c = ln < 16 ? xb_ld(&bar[XB_XCNT(ln & 15)]) : 0u;
        sum = 0u; cnt = 0u;
#pragma unroll
        for (int j = 0; j < 16; ++j) { const unsigned cj = (unsigned)__builtin_amdgcn_readlane((int)c, j); sum += cj; cnt += (cj > 0u) ? 1u : 0u; }
        mine = (unsigned)__builtin_amdgcn_readlane((int)c, (int)b.x);
        if (sum == G) break;
        __builtin_amdgcn_s_sleep(1);
    }
    if (sum == G && ln == 0) { b.st[0] = mine > 0u ? mine : 1u; b.st[1] = cnt > 0u ? cnt : 1u; }
    asm volatile("s_waitcnt lgkmcnt(0)" ::: "memory");
}
DI void xcd_barrier(const XcdBarrier& b, const int wave_s) {
    asm volatile("s_waitcnt vmcnt(0)" ::: "memory");
    __syncthreads();
    if (wave_s == 0 && lane_id() == 0) {
        unsigned* bar = b.bar;
        __builtin_amdgcn_s_waitcnt(0);
        unsigned nloc = b.st[0], nx = b.st[1];
        if (nloc == 0u) { xcd_barrier_complete(bar, b.x, nloc, nx); b.st[0] = nloc; b.st[1] = nx; }
        const unsigned old = xb_add(&bar[XB_XSUB(b.x)], 1u);
        const unsigned gen = old / nloc;
        if (old + 1u == (gen + 1u) * nloc) {
            __builtin_amdgcn_fence(__ATOMIC_RELEASE, "agent");
            asm volatile("s_waitcnt vmcnt(0)" ::: "memory");
            const unsigned og = xb_add(&bar[XB_TOP], 1u);
            const unsigned tg = og / nx;
            if (og + 1u == (tg + 1u) * nx) xb_add(&bar[XB_TOPGEN], 1u);
            else XB_SPIN(xb_ld(&bar[XB_TOPGEN]) == tg, bar);
            __builtin_amdgcn_fence(__ATOMIC_ACQUIRE, "agent");
            xb_add(&bar[XB_XGEN(b.x)], 1u);
            asm volatile("s_waitcnt vmcnt(0)" ::: "memory");
        } else {
            XB_SPIN(xb_ld(&bar[XB_XGEN(b.x)]) == gen, bar);
            __builtin_amdgcn_fence(__ATOMIC_ACQUIRE, "agent");
            asm volatile("s_waitcnt vmcnt(0)" ::: "memory");
        }
    }
    __syncthreads();
}

template <class F>
DI void xcd_barrier_fill(const XcdBarrier& b, const int wave_s, const F& fill) {
    asm volatile("s_waitcnt vmcnt(0)" ::: "memory");
    __syncthreads();
    if (wave_s != 0) { fill(); asm volatile("s_waitcnt vmcnt(0) lgkmcnt(0)" ::: "memory"); }
    else if (lane_id() == 0) {
        unsigned* bar = b.bar;
        __builtin_amdgcn_s_waitcnt(0);
        unsigned nloc = b.st[0], nx = b.st[1];
        if (nloc == 0u) { xcd_barrier_complete(bar, b.x, nloc, nx); b.st[0] = nloc; b.st[1] = nx; }
        const unsigned old = xb_add(&bar[XB_XSUB(b.x)], 1u);
        const unsigned gen = old / nloc;
        if (old + 1u == (gen + 1u) * nloc) {
            __builtin_amdgcn_fence(__ATOMIC_RELEASE, "agent");
            asm volatile("s_waitcnt vmcnt(0)" ::: "memory");
            const unsigned og = xb_add(&bar[XB_TOP], 1u);
            const unsigned tg = og / nx;
            if (og + 1u == (tg + 1u) * nx) xb_add(&bar[XB_TOPGEN], 1u);
            else XB_SPIN(xb_ld(&bar[XB_TOPGEN]) == tg, bar);
            __builtin_amdgcn_fence(__ATOMIC_ACQUIRE, "agent");
            xb_add(&bar[XB_XGEN(b.x)], 1u);
            asm volatile("s_waitcnt vmcnt(0)" ::: "memory");
        } else {
            XB_SPIN(xb_ld(&bar[XB_XGEN(b.x)]) == gen, bar);
            __builtin_amdgcn_fence(__ATOMIC_ACQUIRE, "agent");
            asm volatile("s_waitcnt vmcnt(0)" ::: "memory");
        }
    }
    __syncthreads();
}

constexpr int NWAVES = 8, NTHR = 512;
constexpr int LDS_BYTES = 147456;
constexpr int RING_BYTES = 131072, MISC_OFF = RING_BYTES + 320;

DI void p0_transpose_item(const float* W, int K, int N, u16* WT, LAS float* scr, int item, int lane, bool isin, u16* WV = nullptr, const float* gk = nullptr, const float* sk = nullptr) {
    const int nblk = N / 32, kb = item / nblk, nb = item % nblk, k0 = 64 * kb, n0 = 32 * nb;
    float wv[32];
    { const float* wp = W + (size_t)(k0 + (lane >> 5)) * N + n0 + (lane & 31);
#pragma unroll
      for (int i = 0; i < 32; ++i) wv[i] = __builtin_nontemporal_load(wp + (size_t)(2 * i) * N); }
#pragma unroll
    for (int i = 0; i < 32; ++i) scr[(2 * i + (lane >> 5)) * 33 + (lane & 31)] = wv[i];
    asm volatile("s_waitcnt lgkmcnt(0)" ::: "memory");
    const int c = lane & 7;
    float cb[4][8];
    if (WV) {
#pragma unroll
        for (int i = 0; i < 8; ++i) { const int k = k0 + 8 * c + i; const float g = gk ? gk[k] : 1.f;
#pragma unroll
            for (int b = 0; b < 4; ++b) cb[b][i] = g * (1.f + sk[(size_t)b * 3072 + k]); } }
#pragma unroll
    for (int j = 0; j < 4; ++j) { const int n = (lane >> 3) + 8 * j; const LAS float* s = scr + (8 * c) * 33 + n;
        float f[8];
#pragma unroll
        for (int i = 0; i < 8; ++i) f[i] = s[i * 33];
        const int dst = isin ? perm_in(n0 + n) : perm_out(n0 + n);
        if (WT) *(u32x4*)(WT + (size_t)dst * K + k0 + 8 * c) = pack8(f);
        if (WV) {
#pragma unroll
            for (int b = 0; b < 4; ++b) { float fb[8];
#pragma unroll
                for (int i = 0; i < 8; ++i) fb[i] = f[i] * cb[b][i];
                *(u32x4*)(WV + ((size_t)b * N + dst) * K + k0 + 8 * c) = pack8(fb); } } }
    asm volatile("s_waitcnt lgkmcnt(0)" ::: "memory");
}
DI void transpose_layer(const Params& p, int l, LAS unsigned char* lds, int widx, int nw, int lane, int wave, int which = 0) {
    LAS float* scr = (LAS float*)(lds + wave * 16384);
    constexpr int I_IN = (D / 64) * (DIN / 32), I_OUT = (D / 64) * (D / 32);
    for (int r = (which == 2 ? I_IN : 0) + widx; r < (which == 1 ? I_IN : I_IN + I_OUT); r += nw) {
        if (r < I_IN) { if (l > 0) p0_transpose_item(p.w_in + (size_t)l * D * DIN, D, DIN, (u16*)(p.ws + WS_WIN) + (size_t)l * DIN * D, scr, r, lane, true,
                                               (u16*)(p.ws + ((l & 1) ? WS_H : WS_WINV0)), p.ln_g + (size_t)(l - 1) * D, (const float*)(p.ws + WS_MOD) + (size_t)l * NMOD * 3072 + 1024);
                        else p0_transpose_item(p.w_in, D, DIN, (u16*)(p.ws + WS_WIN), scr, r, lane, true); }
        else p0_transpose_item(p.w_out + (size_t)l * D * D, D, D, (u16*)(p.ws + WS_WOUT) + (size_t)l * D * D, scr, r - I_IN, lane, false);
    }
}
DI void variants_layer0(const Params& p, LAS unsigned char* lds, int widx, int nw, int lane, int wave) {
    LAS float* scr = (LAS float*)(lds + wave * 16384);
    for (int r = widx; r < (D / 64) * (DIN / 32); r += nw) p0_transpose_item(p.w_in, D, DIN, (u16*)(p.ws + WS_WIN), scr, r, lane, true, (u16*)(p.ws + WS_WINV0), nullptr, (const float*)(p.ws + WS_MOD) + 1024);
}
DI void mod_unit(const Params& p, LAS unsigned char* lds, int unit, int tid, int lane, int wave) {
    const int l = unit >> 6, n0 = (unit & 63) * 48;
    const float* W = p.w_mod + (size_t)l * D * 3072;
    float* MOD = (float*)(p.ws + WS_MOD);
    const int fr = lane & 15, fq = lane >> 4;
    f32x4 acc[9][3];
#pragma unroll
    for (int rt = 0; rt < 9; ++rt)
#pragma unroll
        for (int ct = 0; ct < 3; ++ct) acc[rt][ct] = (f32x4){0.f, 0.f, 0.f, 0.f};
    float wn[3][8];
#pragma unroll
    for (int ct = 0; ct < 3; ++ct) { const float* wp = W + (size_t)(wave * 128 + fq * 8) * 3072 + n0 + 16 * ct + fr;
#pragma unroll
        for (int j = 0; j < 8; ++j) wn[ct][j] = __builtin_nontemporal_load(wp + (size_t)j * 3072); }
#pragma unroll
    for (int ks = 0; ks < 4; ++ks) {
        const int k0 = wave * 128 + ks * 32 + fq * 8;
        h8 bfr[3];
#pragma unroll
        for (int ct = 0; ct < 3; ++ct)
#pragma unroll
            for (int j = 0; j < 8; ++j) bfr[ct][j] = (_Float16)wn[ct][j];
        if (ks < 3) {
#pragma unroll
            for (int ct = 0; ct < 3; ++ct) { const float* wp = W + (size_t)(k0 + 32) * 3072 + n0 + 16 * ct + fr;
#pragma unroll
                for (int j = 0; j < 8; ++j) wn[ct][j] = __builtin_nontemporal_load(wp + (size_t)j * 3072); } }
#pragma unroll
        for (int rt = 0; rt < 9; ++rt) { const int row = 16 * rt + fr; h8 a;
            if (row < NMOD) { const float* c = row < NB ? p.c_prompt + (size_t)row * D : p.c_sample + (size_t)(row - NB) * D;
                const f32x4 c0 = *(const f32x4*)(c + k0), c1 = *(const f32x4*)(c + k0 + 4);
#pragma unroll
                for (int j = 0; j < 4; ++j) { a[j] = (_Float16)silu(c0[j]); a[4 + j] = (_Float16)silu(c1[j]); } }
            else {
#pragma unroll
                for (int j = 0; j < 8; ++j) a[j] = (_Float16)0.f; }
#pragma unroll
            for (int ct = 0; ct < 3; ++ct) acc[rt][ct] = __builtin_amdgcn_mfma_f32_16x16x32_f16(a, bfr[ct], acc[rt][ct], 0, 0, 0); }
    }
    LAS float* part = (LAS float*)lds;
#pragma unroll
    for (int rg = 0; rg < 3; ++rg) {
        __syncthreads();
#pragma unroll
        for (int r3 = 0; r3 < 3; ++r3)
#pragma unroll
            for (int ct = 0; ct < 3; ++ct)
#pragma unroll
                for (int i = 0; i < 4; ++i) part[(wave * 48 + r3 * 16 + 4 * fq + i) * 48 + 16 * ct + fr] = acc[rg * 3 + r3][ct][i];
        __syncthreads();
        for (int o = tid; o < 48 * 48; o += NTHR) { const int r48 = o / 48, col = o % 48, row = 48 * rg + r48; float sacc = 0.f;
#pragma unroll
            for (int w = 0; w < 8; ++w) sacc += part[(w * 48 + r48) * 48 + col];
            if (row < NMOD) MOD[((size_t)l * NMOD + row) * 3072 + n0 + col] = sacc + p.b_mod[(size_t)l * 3072 + n0 + col]; }
    }
    __syncthreads();
}
DI void sincos_d(double a, float& c, float& s) {
    const double k = __builtin_rint(a * 0.63661977236758134308);
    const double r = __builtin_fma(-k, 1.2246467991473532e-16 * 0.5, __builtin_fma(-k, 1.5707963267948966, a));
    const double r2 = r * r;
    double sp = -1.0 / 6227020800.0; sp = sp * r2 + 1.0 / 39916800.0; sp = sp * r2 - 1.0 / 362880.0; sp = sp * r2 + 1.0 / 5040.0; sp = sp * r2 - 1.0 / 120.0; sp = sp * r2 + 1.0 / 6.0;
    const double sn = r - r * r2 * sp;
    double cp = 1.0 / 87178291200.0; cp = cp * r2 - 1.0 / 479001600.0; cp = cp * r2 + 1.0 / 3628800.0; cp = cp * r2 - 1.0 / 40320.0; cp = cp * r2 + 1.0 / 720.0; cp = cp * r2 - 1.0 / 24.0; cp = cp * r2 + 0.5;
    const double cn = 1.0 - r2 * cp;
    const long long q = (long long)k & 3;
    const double cc = (q == 0) ? cn : (q == 1) ? -sn : (q == 2) ? -cn : sn;
    const double ss = (q == 0) ? sn : (q == 1) ? cn : (q == 2) ? -sn : -cn;
    c = (float)cc; s = (float)ss;
}
DI void p0_prologue(const Params& p, const __attribute__((address_space(4))) float* invf, LAS unsigned char* lds, int vcu, int G, int tid, int lane, int wave) {
    const int gw = vcu * NWAVES + wave, NGW = G * NWAVES;
    if (vcu & 1) transpose_layer(p, 0, lds, gw, NGW, lane, wave, 2);
    for (int u = vcu; u < 256; u += G) mod_unit(p, lds, u, tid, lane, wave);
    if (!(vcu & 1)) transpose_layer(p, 0, lds, gw, NGW, lane, wave, 2);
    if (vcu == 0 && wave < DEPTH) {
        float a = 0.f, b2 = 0.f, c2 = 0.f, d = 0.f, e = 0.f;
        for (int c = lane; c < D; c += 64) { const float g = p.ln_g[wave * D + c], bb = p.ln_b[wave * D + c]; a += g; b2 += g * g; c2 += g * bb; d += bb; e += bb * bb; }
        a = wave_sum(a); b2 = wave_sum(b2); c2 = wave_sum(c2); d = wave_sum(d); e = wave_sum(e);
        if (lane == 0) { float* o = (float*)(p.ws + WS_LNC) + wave * 8; o[0] = a; o[1] = b2; o[2] = c2; o[3] = d; o[4] = e; } }
    f32x2* tab = (f32x2*)(p.ws + WS_TAB);
    for (int e = vcu * NTHR + tid; e < (SEQ + DS) * 32; e += G * NTHR) {
        const int pi = e >> 5, i = e & 31; const int pos = pi < SEQ ? pi : PAST + (pi - SEQ);
        const float ang = (float)pos * invf[i];
        float c, s; sincos_d((double)ang, c, s);
        tab[e] = (f32x2){c, s};
    }
}

template <int R>
DI void ln_stats(float (&v)[R][16], float (&mean)[R], float (&rstd)[R]) {
    float s[R];
#pragma unroll
    for (int r = 0; r < R; ++r) { s[r] = 0.f;
#pragma unroll
        for (int k = 0; k < 16; ++k) s[r] += v[r][k]; }
#pragma unroll
    for (int r = 0; r < R; ++r) s[r] = wave_sum(s[r]);
#pragma unroll
    for (int r = 0; r < R; ++r) { mean[r] = s[r] * (1.f / D); s[r] = 0.f;
#pragma unroll
        for (int k = 0; k < 16; ++k) { v[r][k] -= mean[r]; s[r] += v[r][k] * v[r][k]; } }
#pragma unroll
    for (int r = 0; r < R; ++r) s[r] = wave_sum(s[r]);
#pragma unroll
    for (int r = 0; r < R; ++r) rstd[r] = 1.f / sqrtf(s[r] * (1.f / D) + LN_EPS);
}
constexpr int LNR = 3;
DI void pre_phase(const Params& p, int gw, int NGW, int lane) {
    const float* modl = (const float*)(p.ws + WS_MOD);
    u16* ZH = (u16*)(p.ws + WS_ZH); u16* XR = (u16*)(p.ws + WS_XR); u16* ZP = (u16*)(p.ws + WS_H); f32x4* RC0 = (f32x4*)(p.ws + WS_RC0);
    for (int row0 = gw; row0 < M; row0 += LNR * NGW) {
        float v[LNR][16]; bool ok[LNR]; float mean[LNR], rstd[LNR]; int rows[LNR];
#pragma unroll
        for (int r = 0; r < LNR; ++r) { rows[r] = row0 + r * NGW; ok[r] = rows[r] < M; if (!ok[r]) rows[r] = row0; }
#pragma unroll
        for (int r = 0; r < LNR; ++r) { const int row = rows[r]; const float* x = row < MP ? p.x_prompt + (size_t)row * D : p.x_sample + (size_t)(row - MP) * D;
#pragma unroll
            for (int j2 = 0; j2 < 2; ++j2) { const f32x4 a = __builtin_nontemporal_load((const f32x4*)(x + 512 * j2 + 8 * lane)), b = __builtin_nontemporal_load((const f32x4*)(x + 512 * j2 + 8 * lane + 4));
#pragma unroll
                for (int k = 0; k < 4; ++k) { v[r][8 * j2 + k] = a[k]; v[r][8 * j2 + 4 + k] = b[k]; } } }
#pragma unroll
        for (int r = 0; r < LNR; ++r) if (ok[r]) { u16* dst = rows[r] < MP ? ZH : XR;
#pragma unroll
            for (int j2 = 0; j2 < 2; ++j2) *(u32x4*)(dst + (size_t)rows[r] * D + 512 * j2 + 8 * lane) = pack8(v[r] + 8 * j2); }
        ln_stats<LNR>(v, mean, rstd);
#pragma unroll
        for (int r = 0; r < LNR; ++r) if (ok[r]) { const int row = rows[r]; const bool smp = row >= MP; const int bidx = smp ? NB + ((row - MP) >> 2) : (row >> 12);
            const float* sh = modl + (size_t)bidx * 3072; const float* sc = sh + 1024;
            if (!smp && lane == 0) RC0[row] = (f32x4){rstd[r], 0.f, rstd[r], rstd[r] * mean[r]};
            if (smp)
#pragma unroll
            for (int j2 = 0; j2 < 2; ++j2) { float o[8];
#pragma unroll
                for (int h = 0; h < 2; ++h) { const f32x4 a = *(const f32x4*)(sc + 512 * j2 + 8 * lane + 4 * h), bb = *(const f32x4*)(sh + 512 * j2 + 8 * lane + 4 * h);
#pragma unroll
                    for (int k = 0; k < 4; ++k) o[4 * h + k] = v[r][8 * j2 + 4 * h + k] * rstd[r] * (1.f + a[k]) + bb[k]; }
                *(u32x4*)(ZP + (size_t)row * D + 512 * j2 + 8 * lane) = pack8(o); } }
    }
}
DI void modv_unit(const Params& p, LAS unsigned char* lds, int unit, int tid, int lane, int wave) {
    const int l = unit / 40, cb = unit % 40, col = 64 * cb + lane;
    const float* W = p.w_in + (size_t)l * D * DIN + col; const float* modl = (const float*)(p.ws + WS_MOD) + (size_t)l * NMOD * 3072;
    LAS float* part = (LAS float*)lds;
    LAS float* cf = (LAS float*)(lds + 32768) + wave * 128 * 12;
    __syncthreads();
#pragma unroll
    for (int hlf = 0; hlf < 2; ++hlf) { const int ci = 64 * hlf + lane, c = wave * 128 + ci; LAS float* o = cf + ci * 12;
        o[0] = l > 0 ? p.ln_g[(l - 1) * D + c] : 1.f; o[1] = l > 0 ? p.ln_b[(l - 1) * D + c] : 0.f;
#pragma unroll
        for (int b = 0; b < 4; ++b) { o[2 + b] = 1.f + modl[b * 3072 + 1024 + c]; o[6 + b] = modl[b * 3072 + c]; } }
    asm volatile("s_waitcnt lgkmcnt(0)" ::: "memory");
    float acc[4][4];
#pragma unroll
    for (int b = 0; b < 4; ++b)
#pragma unroll
        for (int k = 0; k < 4; ++k) acc[b][k] = 0.f;
#pragma unroll 1
    for (int c0 = 0; c0 < 128; c0 += 32) { float wv[32];
#pragma unroll
        for (int i = 0; i < 32; ++i) wv[i] = W[(size_t)(wave * 128 + c0 + i) * DIN];
#pragma unroll
        for (int i = 0; i < 32; ++i) { const LAS f32x4* cp = (const LAS f32x4*)(cf + (c0 + i) * 12); const f32x4 q0 = cp[0], q1 = cp[1], q2 = cp[2];
            const float g = q0[0], bb = q0[1]; const float s1[4] = {q0[2], q0[3], q1[0], q1[1]}; const float sh[4] = {q1[2], q1[3], q2[0], q2[1]};
#pragma unroll
            for (int b = 0; b < 4; ++b) { const float sw = s1[b] * wv[i]; acc[b][0] += g * sw; acc[b][1] += bb * sw; acc[b][2] += sw; acc[b][3] += sh[b] * wv[i]; } } }
#pragma unroll
    for (int b = 0; b < 4; ++b)
#pragma unroll
        for (int k = 0; k < 4; ++k) part[(wave * 16 + b * 4 + k) * 64 + lane] = acc[b][k];
    __syncthreads();
    float* MODV = (float*)(p.ws + WS_MODV);
    for (int o = tid; o < 1024; o += NTHR) { const int idx = o >> 6, ln = o & 63; float sum = 0.f;
#pragma unroll
        for (int w = 0; w < 8; ++w) sum += part[(w * 16 + idx) * 64 + ln];
        MODV[((size_t)(l * NB + (idx >> 2)) * 4 + (idx & 3)) * DIN + perm_in(64 * cb + ln)] = sum; }
    __syncthreads();
}
DI void finalize_rc_in(const Params& p, int l, const int (&pms)[3], LAS float* rcl, int tid) {
    const int row = tid & 255;
    const int ua = tid >> 8, ub = 2;
    const bool hasA = pms[ua] >= 0 && pms[ua] < MP / 256, hasB = tid < 256 && pms[2] >= 0 && pms[2] < MP / 256;
    f32x4 ldA[6], ldB[6];
    const size_t rA = (size_t)(hasA ? pms[ua] : 0) * 256 + row, rB = (size_t)(hasB ? pms[2] : 0) * 256 + row;
    if (l == 0) { ldA[0] = ((const f32x4*)(p.ws + WS_RC0))[rA]; ldB[0] = ((const f32x4*)(p.ws + WS_RC0))[rB]; }
    else { const f32x4* psA = (const f32x4*)((const float*)(p.ws + WS_PS) + (size_t)((l - 1) & 1) * MP * 24 + rA * 24); const f32x4* psB = (const f32x4*)((const float*)(p.ws + WS_PS) + (size_t)((l - 1) & 1) * MP * 24 + rB * 24);
#pragma unroll
        for (int k = 0; k < 6; ++k) { ldA[k] = psA[k]; ldB[k] = psB[k]; } }
    auto fin = [&](const f32x4 (&ld)[6]) -> f32x4 {
        if (l == 0) return ld[0];
        const float* lnc = (const float*)(p.ws + WS_LNC) + (l - 1) * 8;
        float f[24];
#pragma unroll
        for (int k = 0; k < 6; ++k) { f[4 * k] = ld[k][0]; f[4 * k + 1] = ld[k][1]; f[4 * k + 2] = ld[k][2]; f[4 * k + 3] = ld[k][3]; }
        float S[6];
#pragma unroll
        for (int k = 0; k < 6; ++k) S[k] = (f[k] + f[6 + k]) + (f[12 + k] + f[18 + k]);
        float N1 = 1.f / D, two = 2.f; asm volatile("" : "+v"(N1), "+v"(two));
        const float mu = S[0] * N1, rstd = 1.f / sqrtf(S[1] * N1 - mu * mu + LN_EPS);
        const float m2 = (rstd * (S[2] - mu * lnc[0]) + lnc[3]) * N1;
        const float e2 = (rstd * rstd * (S[3] - two * mu * S[4] + mu * mu * lnc[1]) + two * rstd * (S[5] - mu * lnc[2]) + lnc[4]) * N1;
        const float rstd2 = 1.f / sqrtf(e2 - m2 * m2 + LN_EPS);
        return (f32x4){rstd * rstd2, rstd * rstd2 * mu, rstd2, rstd2 * m2}; };
    if (hasA) *(LAS f32x4*)(rcl + ua * 1024 + 4 * row) = fin(ldA);
    if (hasB) *(LAS f32x4*)(rcl + ub * 1024 + 4 * row) = fin(ldB);
}
DI void fin_phase(const Params& p, int gw, int NGW, int lane) {
    const u16* ZH = (const u16*)(p.ws + WS_ZH);
    const float* lg = p.ln_g + (size_t)(DEPTH - 1) * D; const float* lb = p.ln_b + (size_t)(DEPTH - 1) * D;
    for (int row0 = gw; row0 < MP; row0 += LNR * NGW) {
        float v[LNR][16]; bool ok[LNR]; float mean[LNR], rstd[LNR]; int rows[LNR];
#pragma unroll
        for (int r = 0; r < LNR; ++r) { rows[r] = row0 + r * NGW; ok[r] = rows[r] < MP; if (!ok[r]) rows[r] = row0; }
#pragma unroll
        for (int r = 0; r < LNR; ++r)
#pragma unroll
            for (int j2 = 0; j2 < 2; ++j2) unpack8(*(const u32x4*)(ZH + (size_t)rows[r] * D + 512 * j2 + 8 * lane), v[r] + 8 * j2);
        ln_stats<LNR>(v, mean, rstd);
#pragma unroll
        for (int j2 = 0; j2 < 2; ++j2)
#pragma unroll
            for (int h = 0; h < 2; ++h) { const f32x4 g = *(const f32x4*)(lg + 512 * j2 + 8 * lane + 4 * h), bb = *(const f32x4*)(lb + 512 * j2 + 8 * lane + 4 * h);
#pragma unroll
                for (int r = 0; r < LNR; ++r) if (ok[r]) { f32x4 o;
#pragma unroll
                    for (int k = 0; k < 4; ++k) o[k] = v[r][8 * j2 + 4 * h + k] * rstd[r] * g[k] + bb[k];
                    *(f32x4*)(p.out + (size_t)rows[r] * D + 512 * j2 + 8 * lane + 4 * h) = o; } }
    }
}

struct MixPtrs { const u16 *PA, *PSZC, *PPV, *PSZP, *PQ, *PSZA, *PK, *PV; u16* MIX; };
DI v4i16_t ds_tr(const LAS unsigned char* a) { return __builtin_amdgcn_ds_read_tr16_b64_v4i16((LAS v4i16_t*)a); }

DI void attn_prompt_unit(const Params& p, const MixPtrs& X, int l, int unit, LAS unsigned char* lds, int tid, int lane, int wave) {
    const int xg = unit >> 5, b = xg >> 1, hk = (unit >> 4) & 1, nb = (xg & 1) * 16 + (unit & 15), q0 = nb * 128; const size_t rb = (size_t)b * SEQ;
    LAS unsigned char* Ks = lds; LAS unsigned char* Vs = lds + 36864;
    const int g = wave & 3, qh = wave >> 2, head = 4 * hk + g, r = lane & 31, h = lane >> 5;
    u32x4 kvr[4], vvr[4];
#pragma unroll
    for (int i = 0; i < 4; ++i) { const int c = tid + 512 * i, key = c >> 3, ch = c & 7, tk = q0 - 128 + key, tkc = tk < 0 ? 0 : tk;
        kvr[i] = *(const u32x4*)(X.PK + (rb + tkc) * 128 + hk * 64 + ch * 8); vvr[i] = *(const u32x4*)(X.PV + (rb + tkc) * 128 + hk * 64 + ch * 8); }
    h8 qfA[4], qfB[4]; u32x2 zgA[2][4], zgB[2][4];
    { const size_t qr0 = rb + q0 + 64 * qh + r, qr1 = qr0 + 32;
#pragma unroll
      for (int s = 0; s < 4; ++s) { qfA[s] = *(const h8*)(X.PQ + qr0 * 512 + head * 64 + 16 * s + 8 * h); qfB[s] = *(const h8*)(X.PQ + qr1 * 512 + head * 64 + 16 * s + 8 * h); }
#pragma unroll
      for (int db = 0; db < 2; ++db)
#pragma unroll
          for (int xq = 0; xq < 4; ++xq) { const int col = head * 64 + 32 * db + 8 * xq + 4 * h; zgA[db][xq] = *(const u32x2*)(X.PSZA + qr0 * 512 + col); zgB[db][xq] = *(const u32x2*)(X.PSZA + qr1 * 512 + col); } }
#pragma unroll
    for (int i = 0; i < 4; ++i) { const int c = tid + 512 * i, key = c >> 3, ch = c & 7;
        *(LAS u32x4*)(Ks + key * 144 + ch * 16) = kvr[i]; *(LAS u32x4*)(Vs + (ch >> 2) * 16384 + key * 64 + (ch & 3) * 16) = vvr[i]; }
    __syncthreads();
    const float sink2 = p.sinks[l * 8 + head] * LOG2E;
    const int trq = (lane & 15) >> 2, trp = lane & 3, trg = (lane >> 4) & 1;
    const float NEG = -INFINITY;
    auto half = [&](const h8 (&qf)[4], const u32x2 (&zg)[2][4], const int e) {
        const int ql = 64 * qh + 32 * e; const size_t qrow = rb + q0 + ql + r;
        f32x16 S[5];
#pragma unroll
        for (int i = 0; i < 5; ++i) { const int kl = ql + 32 * i; const bool valid = (nb > 0) || (kl >= 128);
#pragma unroll
            for (int x = 0; x < 16; ++x) S[i][x] = 0.f;
            if (valid) {
#pragma unroll
                for (int s = 0; s < 4; ++s) { const h8 kf = *(const LAS h8*)(Ks + (kl + r) * 144 + (16 * s + 8 * h) * 2); S[i] = __builtin_amdgcn_mfma_f32_32x32x16_f16(kf, qf[s], S[i], 0, 0, 0); }
            } else {
#pragma unroll
                for (int x = 0; x < 16; ++x) S[i][x] = NEG; }
            if (i == 0) {
#pragma unroll
                for (int x = 0; x < 16; ++x) if (!(crow(x, h) > r)) S[i][x] = NEG; }
            if (i == 4) {
#pragma unroll
                for (int x = 0; x < 16; ++x) if (!(crow(x, h) <= r)) S[i][x] = NEG; }
        }
        float mx = sink2;
#pragma unroll
        for (int i = 0; i < 5; ++i)
#pragma unroll
            for (int x = 0; x < 16; ++x) mx = fmaxf(mx, S[i][x]);
        mx = max_halves(mx);
        float sum = 0.f;
#pragma unroll
        for (int i = 0; i < 5; ++i)
#pragma unroll
            for (int x = 0; x < 16; ++x) { S[i][x] = ex2(S[i][x] - mx); sum += S[i][x]; }
        sum = sum_halves(sum);
        const float inv = 1.f / (sum + ex2(sink2 - mx));
        f32x16 O[2];
#pragma unroll
        for (int x = 0; x < 16; ++x) { O[0][x] = 0.f; O[1][x] = 0.f; }
#pragma unroll
        for (int i = 0; i < 5; ++i) { const int kl = ql + 32 * i; const bool valid = (nb > 0) || (kl >= 128);
            if (valid) {
#pragma unroll
                for (int s2 = 0; s2 < 2; ++s2) { float pv8[8];
#pragma unroll
                    for (int j = 0; j < 8; ++j) pv8[j] = S[i][8 * s2 + j] * inv;
                    const h8 pa = __builtin_bit_cast(h8, pack8(pv8));
#pragma unroll
                    for (int db = 0; db < 2; ++db) { const LAS unsigned char* va = Vs + db * 16384 + (kl + 16 * s2 + 4 * h + trq) * 64 + trg * 32 + trp * 8;
                        const v4i16_t lo = ds_tr(va), hi = ds_tr(va + 512);
                        const h8 vf = __builtin_bit_cast(h8, __builtin_shufflevector(lo, hi, 0, 1, 2, 3, 4, 5, 6, 7));
                        O[db] = __builtin_amdgcn_mfma_f32_32x32x16_f16(vf, pa, O[db], 0, 0, 0); } } } }
#pragma unroll
        for (int db = 0; db < 2; ++db)
#pragma unroll
            for (int xq = 0; xq < 4; ++xq) { const int col = head * 64 + 32 * db + 8 * xq + 4 * h; const h4 z = __builtin_bit_cast(h4, zg[db][xq]);
                u32x2 w; w.x = pkh(O[db][4 * xq] * (float)z[0], O[db][4 * xq + 1] * (float)z[1]); w.y = pkh(O[db][4 * xq + 2] * (float)z[2], O[db][4 * xq + 3] * (float)z[3]);
                *(u32x2*)(X.MIX + qrow * D + 512 + col) = w; }
    };
    half(qfA, zgA, 0);
    half(qfB, zgB, 1);
    __syncthreads();
}

constexpr int MX_WPT = 81920;
constexpr int MX_SCR = 0, MX_SCR_W = 7168;
DI void conv_prompt_unit(const Params& p, const MixPtrs& X, int l, int unit, LAS unsigned char* lds, int tid, int lane, int wave) {
    const int R0 = unit * 64, b = R0 >> 12, t0 = R0 & (SEQ - 1); const size_t rb = (size_t)b * SEQ;
    LAS unsigned char* WL = lds + 94 * 512;
    u32x4 tv[6]; f32x4 wq[4];
#pragma unroll
    for (int i = 0; i < 6; ++i) { const int c = tid + 512 * i, cc = c < 94 * 32 ? c : 94 * 32 - 1, row = cc >> 5, ch = cc & 31, tk = t0 - 30 + row, tkc = tk < 0 ? 0 : tk;
        tv[i] = *(const u32x4*)(X.PA + (rb + tkc) * 256 + ch * 8); }
#pragma unroll
    for (int i = 0; i < 4; ++i) { const int c = tid + 512 * i, cc = c < 31 * 64 ? c : 31 * 64 - 1; wq[i] = *(const f32x4*)(p.conv_w + (size_t)l * 31 * 256 + 4 * cc); }
    const f32x4 bias = *(const f32x4*)(p.conv_b + l * 256 + 4 * lane), cg = *(const f32x4*)(p.cnorm_g + l * 256 + 4 * lane), cb = *(const f32x4*)(p.cnorm_b + l * 256 + 4 * lane);
    u32x2 zcv[8];
#pragma unroll
    for (int tt = 0; tt < 8; ++tt) zcv[tt] = *(const u32x2*)(X.PSZC + ((size_t)R0 + 8 * wave + tt) * 256 + 4 * lane);
#pragma unroll
    for (int i = 0; i < 6; ++i) { const int c = tid + 512 * i, row = c >> 5, ch = c & 31; const unsigned msk = (unsigned)-(int)(t0 - 30 + row >= 0);
        if (c < 94 * 32) *(LAS u32x4*)(lds + row * 512 + ch * 16) = (u32x4){tv[i][0] & msk, tv[i][1] & msk, tv[i][2] & msk, tv[i][3] & msk}; }
#pragma unroll
    for (int i = 0; i < 4; ++i) { const int c = tid + 512 * i; if (c < 31 * 64) *(LAS f32x4*)(WL + c * 16) = wq[i]; }
    __syncthreads();
    f32x4 acc[8], win[8];
#pragma unroll
    for (int tt = 0; tt < 8; ++tt) acc[tt] = bias;
    const LAS unsigned char* arow = lds + (8 * wave) * 512 + lane * 8;
#pragma unroll
    for (int k = 0; k < 7; ++k) win[k] = __builtin_convertvector(*(const LAS h4*)(arow + k * 512), f32x4);
#pragma unroll 1
    for (int jb = 0; jb < 4; ++jb) {
#pragma unroll
        for (int jj = 0; jj < 8; ++jj) { const int j = 8 * jb + jj;
            if (j < 31) {
                win[(jj + 7) & 7] = __builtin_convertvector(*(const LAS h4*)(arow + (j + 7) * 512), f32x4);
                const f32x4 w = *(const LAS f32x4*)(WL + j * 1024 + lane * 16);
#pragma unroll
                for (int tt = 0; tt < 8; ++tt) acc[tt] += w * win[(jj + tt) & 7]; } } }
#pragma unroll
    for (int tt = 0; tt < 8; ++tt) { const size_t row = (size_t)R0 + 8 * wave + tt;
        const float mean = wave_sum((acc[tt][0] + acc[tt][1]) + (acc[tt][2] + acc[tt][3])) * (1.f / 256.f);
        const f32x4 d = acc[tt] - mean;
        const float rstd = 1.f / sqrtf(wave_sum((d[0] * d[0] + d[1] * d[1]) + (d[2] * d[2] + d[3] * d[3])) * (1.f / 256.f) + LN_EPS);
        const h4 zc = __builtin_bit_cast(h4, zcv[tt]); float o[4];
#pragma unroll
        for (int k = 0; k < 4; ++k) o[k] = silu(d[k] * rstd * cg[k] + cb[k]) * (float)zc[k];
        u32x2 w; w.x = pkh(o[0], o[1]); w.y = pkh(o[2], o[3]);
        *(u32x2*)(X.MIX + row * D + 4 * lane) = w; }
    __syncthreads();
}

DI void task_pool(const Params& p, int l, int R0, int th, int g, LAS unsigned char* lds, int wave, int lane) {
    const u16* PPV = (const u16*)(p.ws + WS_PPV); const u16* PSZP = (const u16*)(p.ws + WS_PSZP); u16* MIX = (u16*)(p.ws + WS_MIX);
    const int b = R0 >> 12, T0 = (R0 & (SEQ - 1)) + 32 * th; const size_t rb = (size_t)b * SEQ;
    LAS unsigned char* scr = lds + MX_SCR + wave * MX_SCR_W;
    const int r = lane & 31, h = lane >> 5;
    u32x4 tl[6];
#pragma unroll
    for (int i = 0; i < 6; ++i) { const int row = (lane >> 3) + 8 * i, tk = T0 - 15 + row; const int tkc = tk < 0 ? 0 : (row < 47 ? tk : T0 + 31);
        const u32x4 v = *(const u32x4*)(PPV + (rb + tkc) * 256 + 64 * g + 8 * (lane & 7)); const unsigned msk = (unsigned)-(int)(tk >= 0); tl[i] = (u32x4){v[0] & msk, v[1] & msk, v[2] & msk, v[3] & msk}; }
    const size_t orow = rb + T0 + r;
    u32x2 zp[2][4]; f32x4 ps[2][4];
#pragma unroll
    for (int nb = 0; nb < 2; ++nb)
#pragma unroll
        for (int xq = 0; xq < 4; ++xq) { const int col = 64 * g + 32 * nb + 8 * xq + 4 * h; zp[nb][xq] = *(const u32x2*)(PSZP + orow * 256 + col); ps[nb][xq] = *(const f32x4*)(p.pool_scale + l * 256 + col); }
#pragma unroll
    for (int i = 0; i < 6; ++i) { const int row = (lane >> 3) + 8 * i; if (row < 47) *(LAS u32x4*)(scr + row * 144 + (lane & 7) * 16) = tl[i]; }
    asm volatile("s_waitcnt lgkmcnt(0)" ::: "memory");
    const int wlen = 2 << g; const int t = T0 + r; const float icnt = 1.f / (float)(wlen < t + 1 ? wlen : t + 1);
    h8 bf[4];
#pragma unroll
    for (int s = 0; s < 4; ++s) { const LAS unsigned char* base = scr + (15 + r) * 144 + (16 * s + 8 * h) * 2; float sm[8];
        const h8 cur = *(const LAS h8*)base;
#pragma unroll
        for (int k = 0; k < 8; ++k) sm[k] = (float)cur[k];
        for (int i = 1; i < wlen; ++i) { const h8 v = *(const LAS h8*)(base - i * 144);
#pragma unroll
            for (int k = 0; k < 8; ++k) sm[k] += (float)v[k]; }
        float pl[8];
#pragma unroll
        for (int k = 0; k < 8; ++k) pl[k] = sm[k] * icnt - (float)cur[k];
        bf[s] = __builtin_bit_cast(h8, pack8(pl)); }
    f32x16 Dd[2];
#pragma unroll
    for (int x = 0; x < 16; ++x) { Dd[0][x] = 0.f; Dd[1][x] = 0.f; }
#pragma unroll
    for (int s = 0; s < 4; ++s)
#pragma unroll
        for (int nb = 0; nb < 2; ++nb) { const h8 af = *(const LAS h8*)(lds + MX_WPT + ((g * 64 + 32 * nb + r) * 72 + 16 * s + 8 * h) * 2);
            Dd[nb] = __builtin_amdgcn_mfma_f32_32x32x16_f16(af, bf[s], Dd[nb], 0, 0, 0); }
#pragma unroll
    for (int nb = 0; nb < 2; ++nb)
#pragma unroll
        for (int xq = 0; xq < 4; ++xq) { const int col = 64 * g + 32 * nb + 8 * xq + 4 * h; const h4 z = __builtin_bit_cast(h4, zp[nb][xq]); const f32x4 sc = ps[nb][xq];
            u32x2 w; w.x = pkh(Dd[nb][4 * xq] * sc[0] * (float)z[0], Dd[nb][4 * xq + 1] * sc[1] * (float)z[1]); w.y = pkh(Dd[nb][4 * xq + 2] * sc[2] * (float)z[2], Dd[nb][4 * xq + 3] * sc[3] * (float)z[3]);
            *(u32x2*)(MIX + orow * D + 256 + col) = w; }
}
DI void convpool_sample_unit(const Params& p, const MixPtrs& X, int l, int b, int part, LAS unsigned char* lds, int tid, int lane, int wave) {
    LAS float* cv = (LAS float*)lds;
    const int c = tid & 255, tp = tid >> 8; const size_t r0 = (size_t)MP + 4 * b;
    if (part == 0) {
        const float* cc = p.cache_conv + (size_t)(l * DB + b) * 30 * 256;
        float xa[34], wv[31];
        { const float* pc = cc + c;
#pragma unroll
          for (int ri = 0; ri < 30; ++ri) xa[ri] = __builtin_nontemporal_load(pc + ri * 256);
          const u16* pn = X.PA + r0 * 256 + c;
#pragma unroll
          for (int ri = 0; ri < 4; ++ri) xa[30 + ri] = (float)(*(const _Float16*)(pn + ri * 256));
          const float* pw = p.conv_w + (size_t)l * 31 * 256 + c;
#pragma unroll
          for (int j = 0; j < 31; ++j) wv[j] = pw[j * 256]; }
        float a0 = p.conv_b[l * 256 + c], a1 = a0;
        if (tp == 0) {
#pragma unroll
            for (int j = 0; j < 31; ++j) { a0 += wv[j] * xa[j]; a1 += wv[j] * xa[j + 1]; }
        } else {
#pragma unroll
            for (int j = 0; j < 31; ++j) { a0 += wv[j] * xa[j + 2]; a1 += wv[j] * xa[j + 3]; } }
        cv[(2 * tp) * 256 + c] = a0; cv[(2 * tp + 1) * 256 + c] = a1;
        { float* oc = p.out + OFF_CONVS + (size_t)(l * DB + b) * 30 * 256; for (int e = tid; e < 26 * 64; e += NTHR) *(f32x4*)(oc + 4 * e) = *(const f32x4*)(cc + 4 * 256 + 4 * e); }
        __syncthreads();
        if (wave < 4) { const int t = wave; const f32x4 v = *(const LAS f32x4*)(cv + t * 256 + 4 * lane);
            const float mean = wave_sum((v[0] + v[1]) + (v[2] + v[3])) * (1.f / 256.f); const f32x4 d = v - mean;
            const float rstd = 1.f / sqrtf(wave_sum((d[0] * d[0] + d[1] * d[1]) + (d[2] * d[2] + d[3] * d[3])) * (1.f / 256.f) + LN_EPS);
            const f32x4 cg = *(const f32x4*)(p.cnorm_g + l * 256 + 4 * lane), cb = *(const f32x4*)(p.cnorm_b + l * 256 + 4 * lane);
            const h4 zc = *(const h4*)(X.PSZC + (r0 + t) * 256 + 4 * lane); float o[4];
#pragma unroll
            for (int k = 0; k < 4; ++k) o[k] = silu(d[k] * rstd * cg[k] + cb[k]) * (float)zc[k];
            u32x2 w; w.x = pkh(o[0], o[1]); w.y = pkh(o[2], o[3]);
            *(u32x2*)(X.MIX + (r0 + t) * D + 4 * lane) = w; }
    } else {
        const float* cp = p.cache_pool + (size_t)(l * DB + b) * 15 * 256;
        float xa[19];
        { const float* pc = cp + c;
#pragma unroll
          for (int ri = 0; ri < 15; ++ri) xa[ri] = __builtin_nontemporal_load(pc + ri * 256);
          const u16* pn = X.PPV + r0 * 256 + c;
#pragma unroll
          for (int ri = 0; ri < 4; ++ri) xa[15 + ri] = (float)(*(const _Float16*)(pn + ri * 256)); }
        const int wlen = 2 << (c >> 6); float s0 = 0.f, s1 = 0.f, c0, c1;
        if (tp == 0) { c0 = xa[15]; c1 = xa[16];
#pragma unroll
            for (int i = 0; i < 16; ++i) if (i < wlen) { s0 += xa[15 - i]; s1 += xa[16 - i]; }
        } else { c0 = xa[17]; c1 = xa[18];
#pragma unroll
            for (int i = 0; i < 16; ++i) if (i < wlen) { s0 += xa[17 - i]; s1 += xa[18 - i]; } }
        const float iw = 1.f / (float)wlen;
        cv[(2 * tp) * 256 + c] = s0 * iw - c0; cv[(2 * tp + 1) * 256 + c] = s1 * iw - c1;
        { float* op = p.out + OFF_POOLS + (size_t)(l * DB + b) * 15 * 256; for (int e = tid; e < 11 * 64; e += NTHR) *(f32x4*)(op + 4 * e) = *(const f32x4*)(cp + 4 * 256 + 4 * e); }
        __syncthreads();
        const int g = c >> 6, n = c & 63; const float* pw = p.pool_w + ((size_t)l * 4 + g) * 64 * 64 + n; float y0 = 0.f, y1 = 0.f;
#pragma unroll 16
        for (int k = 0; k < 64; ++k) { const float w = pw[(size_t)k * 64]; y0 += cv[(2 * tp) * 256 + 64 * g + k] * w; y1 += cv[(2 * tp + 1) * 256 + 64 * g + k] * w; }
        const float ps = p.pool_scale[l * 256 + c];
        const float z0 = (float)(*(const _Float16*)(X.PSZP + (r0 + 2 * tp) * 256 + c)), z1 = (float)(*(const _Float16*)(X.PSZP + (r0 + 2 * tp + 1) * 256 + c));
        *(_Float16*)(X.MIX + (r0 + 2 * tp) * D + 256 + c) = (_Float16)(y0 * ps * z0); *(_Float16*)(X.MIX + (r0 + 2 * tp + 1) * D + 256 + c) = (_Float16)(y1 * ps * z1); }
    __syncthreads();
}

DI void attn_sample_unit(const Params& p, const MixPtrs& X, int l, int unit, LAS unsigned char* lds, int tid, int lane, int wave) {
    const int b = unit >> 1, hk = unit & 1; const size_t r0 = (size_t)MP + 4 * b;
    LAS float* EX = (LAS float*)lds;
    LAS float* OP = EX + 256;
    const float* ck = p.cache_k + ((size_t)(l * DB + b) * 128 * 2 + hk) * 64; const float* cvv = p.cache_v + ((size_t)(l * DB + b) * 128 * 2 + hk) * 64;
    float* ok = p.out + OFF_KS + ((size_t)(l * DB + b) * 128 * 2 + hk) * 64; float* ov = p.out + OFF_VS + ((size_t)(l * DB + b) * 128 * 2 + hk) * 64;
    f32x4 ckv[4], cvw[4];
#pragma unroll
    for (int i = 0; i < 4; ++i) { const int e = tid + 512 * i, j = e >> 4, d4 = (e & 15) * 4; ckv[i] = *(const f32x4*)(ck + (size_t)j * 128 + d4); cvw[i] = *(const f32x4*)(cvv + (size_t)j * 128 + d4); }
    const int fr = lane & 15, fq = lane >> 4;
    f32x4 O[4]; f32x4 Sa = {0.f, 0.f, 0.f, 0.f}, Sb = {0.f, 0.f, 0.f, 0.f};
    float vg[4][8];
    const int kA = 32 * wave + fr, kB = kA + 16;
    if (wave < 5) {
        h8 ka[2], kb[2], qf[2];
#pragma unroll
        for (int ks = 0; ks < 2; ++ks) { const int d0 = 32 * ks + 8 * fq;
            qf[ks] = *(const h8*)(X.PQ + (r0 + (fr >> 2)) * 512 + (4 * hk + (fr & 3)) * 64 + d0);
            if (wave < 4) { const f32x4 a0 = *(const f32x4*)(ck + (size_t)kA * 128 + d0), a1 = *(const f32x4*)(ck + (size_t)kA * 128 + d0 + 4), b0 = *(const f32x4*)(ck + (size_t)kB * 128 + d0), b1 = *(const f32x4*)(ck + (size_t)kB * 128 + d0 + 4);
                float t8[8] = {a0[0], a0[1], a0[2], a0[3], a1[0], a1[1], a1[2], a1[3]}; ka[ks] = __builtin_bit_cast(h8, pack8(t8));
                float u8[8] = {b0[0], b0[1], b0[2], b0[3], b1[0], b1[1], b1[2], b1[3]}; kb[ks] = __builtin_bit_cast(h8, pack8(u8));
            } else { const int rr = fr < 4 ? fr : 0; const u32x4 raw = *(const u32x4*)(X.PK + (r0 + rr) * 128 + hk * 64 + d0); ka[ks] = __builtin_bit_cast(h8, fr < 4 ? raw : (u32x4){0u, 0u, 0u, 0u}); kb[ks] = __builtin_bit_cast(h8, (u32x4){0u, 0u, 0u, 0u}); } }
#pragma unroll
        for (int dt = 0; dt < 4; ++dt)
#pragma unroll
            for (int j = 0; j < 8; ++j) { const int key = 32 * wave + (j < 4 ? 0 : 16) + 4 * fq + (j & 3); const int d = 16 * dt + fr;
                if (wave < 4) vg[dt][j] = cvv[(size_t)key * 128 + d];
                else vg[dt][j] = key < 132 ? (float)(*(const _Float16*)(X.PV + (r0 + (key - 128)) * 128 + hk * 64 + d)) : 0.f; }
#pragma unroll
        for (int ks = 0; ks < 2; ++ks) { Sa = __builtin_amdgcn_mfma_f32_16x16x32_f16(ka[ks], qf[ks], Sa, 0, 0, 0); Sb = __builtin_amdgcn_mfma_f32_16x16x32_f16(kb[ks], qf[ks], Sb, 0, 0, 0); }
        const int t = fr >> 2; float mx = -INFINITY;
#pragma unroll
        for (int i = 0; i < 4; ++i) { const int k0 = 32 * wave + 4 * fq + i, k1 = k0 + 16;
            Sa[i] = (k0 >= t + 1 && k0 <= t + 128) ? Sa[i] : -INFINITY; Sb[i] = (k1 >= t + 1 && k1 <= t + 128) ? Sb[i] : -INFINITY; mx = fmaxf(mx, fmaxf(Sa[i], Sb[i])); }
        mx = fmaxf(mx, xor_lane<16>(mx)); mx = max_halves(mx);
        if (fq == 0) EX[wave * 16 + fr] = mx;
    }
#pragma unroll
    for (int i = 0; i < 4; ++i) { const int e = tid + 512 * i, j = e >> 4, d4 = (e & 15) * 4; if (j >= 4) { *(f32x4*)(ok + (size_t)(j - 4) * 128 + d4) = ckv[i]; *(f32x4*)(ov + (size_t)(j - 4) * 128 + d4) = cvw[i]; } }
    __syncthreads();
    if (wave < 5) {
        const float sink2 = p.sinks[l * 8 + 4 * hk + (fr & 3)] * LOG2E;
        float m = sink2;
#pragma unroll
        for (int w = 0; w < 5; ++w) m = fmaxf(m, EX[w * 16 + fr]);
        float sum = 0.f;
#pragma unroll
        for (int i = 0; i < 4; ++i) { Sa[i] = ex2(Sa[i] - m); Sb[i] = ex2(Sb[i] - m); sum += Sa[i] + Sb[i]; }
        sum += xor_lane<16>(sum); sum = sum_halves(sum);
        if (fq == 0) EX[128 + wave * 16 + fr] = sum;
        float p8[8] = {Sa[0], Sa[1], Sa[2], Sa[3], Sb[0], Sb[1], Sb[2], Sb[3]}; const h8 pb = __builtin_bit_cast(h8, pack8(p8));
#pragma unroll
        for (int dt = 0; dt < 4; ++dt) { const h8 va = __builtin_bit_cast(h8, pack8(vg[dt])); O[dt] = __builtin_amdgcn_mfma_f32_16x16x32_f16(va, pb, (f32x4){0.f, 0.f, 0.f, 0.f}, 0, 0, 0);
#pragma unroll
            for (int i = 0; i < 4; ++i) OP[(wave * 64 + 16 * dt + 4 * fq + i) * 16 + fr] = O[dt][i]; }
    }
    __syncthreads();
    { const int qr = tid & 15, dg = tid >> 4, t = qr >> 2, g = qr & 3;
        const float sink2 = p.sinks[l * 8 + 4 * hk + g] * LOG2E; float m = sink2, den = 0.f, o0 = 0.f, o1 = 0.f;
#pragma unroll
        for (int w = 0; w < 5; ++w) { m = fmaxf(m, EX[w * 16 + qr]); den += EX[128 + w * 16 + qr]; o0 += OP[(w * 64 + 2 * dg) * 16 + qr]; o1 += OP[(w * 64 + 2 * dg + 1) * 16 + qr]; }
        const float inv = 1.f / (den + ex2(sink2 - m));
        const int col = (4 * hk + g) * 64 + 2 * dg;
        const h2 z = *(const h2*)(X.PSZA + (r0 + t) * 512 + col);
        *(unsigned*)(X.MIX + (r0 + t) * D + 512 + col) = pkh(o0 * inv * (float)z[0], o1 * inv * (float)z[1]); }
    __syncthreads();
}

template <int R>
DI void sample_ln_rows(const Params& p, int l, int row0, int lane) {
    const u16* ZH = (const u16*)(p.ws + WS_ZH); u16* XR = (u16*)(p.ws + WS_XR); u16* ZP = (u16*)(p.ws + WS_H);
    const float* lg = p.ln_g + (size_t)l * D; const float* lb = p.ln_b + (size_t)l * D;
    const float* modn = (const float*)(p.ws + WS_MOD) + (size_t)(l + 1) * NMOD * 3072;
    float v[R][16], mean[R], rstd[R];
#pragma unroll
    for (int r = 0; r < R; ++r)
#pragma unroll
        for (int j2 = 0; j2 < 2; ++j2) unpack8(*(const u32x4*)(ZH + (size_t)(row0 + r) * D + 512 * j2 + 8 * lane), v[r] + 8 * j2);
    ln_stats<R>(v, mean, rstd);
#pragma unroll
    for (int j2 = 0; j2 < 2; ++j2)
#pragma unroll
        for (int h = 0; h < 2; ++h) { const f32x4 g = *(const f32x4*)(lg + 512 * j2 + 8 * lane + 4 * h), bb = *(const f32x4*)(lb + 512 * j2 + 8 * lane + 4 * h);
#pragma unroll
            for (int r = 0; r < R; ++r)
#pragma unroll
                for (int k = 0; k < 4; ++k) v[r][8 * j2 + 4 * h + k] = v[r][8 * j2 + 4 * h + k] * rstd[r] * g[k] + bb[k]; }
    if (l == DEPTH - 1) {
#pragma unroll
        for (int r = 0; r < R; ++r) { float* y = p.out + OFF_YS + (size_t)(row0 - MP + r) * D;
#pragma unroll
            for (int j2 = 0; j2 < 2; ++j2)
#pragma unroll
                for (int h = 0; h < 2; ++h) *(f32x4*)(y + 512 * j2 + 8 * lane + 4 * h) = (f32x4){v[r][8 * j2 + 4 * h], v[r][8 * j2 + 4 * h + 1], v[r][8 * j2 + 4 * h + 2], v[r][8 * j2 + 4 * h + 3]}; }
    } else {
#pragma unroll
        for (int r = 0; r < R; ++r)
#pragma unroll
            for (int j2 = 0; j2 < 2; ++j2) *(u32x4*)(XR + (size_t)(row0 + r) * D + 512 * j2 + 8 * lane) = pack8(v[r] + 8 * j2);
        ln_stats<R>(v, mean, rstd);
#pragma unroll
        for (int r = 0; r < R; ++r) { const int row = row0 + r; const float* sh = modn + (size_t)(NB + ((row - MP) >> 2)) * 3072; const float* sc = sh + 1024;
#pragma unroll
            for (int j2 = 0; j2 < 2; ++j2) { float o[8];
#pragma unroll
                for (int h = 0; h < 2; ++h) { const f32x4 a = *(const f32x4*)(sc + 512 * j2 + 8 * lane + 4 * h), bb = *(const f32x4*)(sh + 512 * j2 + 8 * lane + 4 * h);
#pragma unroll
                    for (int k = 0; k < 4; ++k) o[4 * h + k] = v[r][8 * j2 + 4 * h + k] * rstd[r] * (1.f + a[k]) + bb[k]; }
                *(u32x4*)(ZP + (size_t)row * D + 512 * j2 + 8 * lane) = pack8(o); } }
    }
}
DI void outproj_sample_unit(const Params& p, int l, int unit, LAS unsigned char* lds, int tid, int lane, int wave) {
    const int rbk0 = unit >> 5, cb = unit & 31, R0 = MP + 64 * rbk0, n0 = 32 * cb, r = lane & 31, h = lane >> 5;
    const u16* MIX = (const u16*)(p.ws + WS_MIX); const u16* WT = (const u16*)(p.ws + WS_WOUT) + (size_t)l * D * D;
    const u16* bp = WT + (size_t)perm_out(n0 + r) * D + wave * 128 + 8 * h;
    const u16* ap = MIX + (size_t)(R0 + r) * D + wave * 128 + 8 * h;
    f32x16 acc[2];
#pragma unroll
    for (int x = 0; x < 16; ++x) { acc[0][x] = 0.f; acc[1][x] = 0.f; }
    h8 bfr[8], afr[2][8];
#pragma unroll
    for (int s = 0; s < 8; ++s) { bfr[s] = *(const h8*)(bp + 16 * s);
#pragma unroll
        for (int rb = 0; rb < 2; ++rb) afr[rb][s] = *(const h8*)(ap + (size_t)rb * 32 * D + 16 * s); }
#pragma unroll
    for (int s = 0; s < 8; ++s)
#pragma unroll
        for (int rb = 0; rb < 2; ++rb) acc[rb] = __builtin_amdgcn_mfma_f32_32x32x16_f16(afr[rb][s], bfr[s], acc[rb], 0, 0, 0);
    LAS float* part = (LAS float*)lds;
#pragma unroll
    for (int rb = 0; rb < 2; ++rb)
#pragma unroll
        for (int x = 0; x < 16; ++x) part[(wave * 64 + 32 * rb + crow(x, h)) * 32 + r] = acc[rb][x];
    __syncthreads();
    const float* modl = (const float*)(p.ws + WS_MOD) + (size_t)l * NMOD * 3072;
    if (tid < 256) { const int row = tid >> 2, c8 = (tid & 3) * 8;
        f32x4 s0 = {0.f, 0.f, 0.f, 0.f}, s1 = {0.f, 0.f, 0.f, 0.f};
#pragma unroll
        for (int w = 0; w < 8; ++w) { s0 += *(const LAS f32x4*)(part + (w * 64 + row) * 32 + c8); s1 += *(const LAS f32x4*)(part + (w * 64 + row) * 32 + c8 + 4); }
        const int grow = R0 + row, bidx = NB + ((grow - MP) >> 2);
        float xr8[8]; unpack8(*(const u32x4*)((const u16*)(p.ws + WS_XR) + (size_t)grow * D + n0 + c8), xr8);
        const f32x4 g0 = *(const f32x4*)(modl + (size_t)bidx * 3072 + 2048 + n0 + c8), g1 = *(const f32x4*)(modl + (size_t)bidx * 3072 + 2048 + n0 + c8 + 4);
        float z[8];
#pragma unroll
        for (int j = 0; j < 4; ++j) { z[j] = ALPHA * xr8[j] + (1.f + g0[j]) * s0[j]; z[4 + j] = ALPHA * xr8[4 + j] + (1.f + g1[j]) * s1[j]; }
        const u32x4 w = pack8(z); unsigned long long* dst = (unsigned long long*)((u16*)(p.ws + WS_ZH) + (size_t)grow * D + n0 + c8);
        __hip_atomic_store(dst, ((unsigned long long)w.y << 32) | w.x, __ATOMIC_RELAXED, __HIP_MEMORY_SCOPE_AGENT);
        __hip_atomic_store(dst + 1, ((unsigned long long)w.w << 32) | w.z, __ATOMIC_RELAXED, __HIP_MEMORY_SCOPE_AGENT); }
    asm volatile("s_waitcnt vmcnt(0)" ::: "memory");
    __syncthreads();
    if (wave == 0 && lane == 0)
        (void)__hip_atomic_fetch_add((unsigned*)(p.ws + WS_CTL) + CW_SCNT + 64 * (l * 8 + rbk0), 1u, __ATOMIC_RELAXED, __HIP_MEMORY_SCOPE_AGENT);
}
DI void outproj_sample_finish(const Params& p, int l, int unit, int lane, int wave) {
    if (wave != 0) return;
    unsigned* cnt = (unsigned*)(p.ws + WS_CTL) + CW_SCNT + 64 * (l * 8 + (unit >> 5));
    for (unsigned sp = 0; sp < (1u << 20); ++sp) { if (__hip_atomic_load(cnt, __ATOMIC_RELAXED, __HIP_MEMORY_SCOPE_AGENT) >= 32u) break; __builtin_amdgcn_s_sleep(2); }
    __builtin_amdgcn_fence(__ATOMIC_ACQUIRE, "agent"); asm volatile("s_waitcnt vmcnt(0)" ::: "memory");
    sample_ln_rows<2>(p, l, MP + 64 * (unit >> 5) + 2 * (unit & 31), lane);
}

constexpr int N_PHASES = 3 + 3 * DEPTH;
typedef const __attribute__((address_space(4))) Params* KParams;
#define PHASE_BEGIN() const int lane_ = lane_id(); const int lane = lane_, wave = wave_s, tid = wave_s * 64 + lane_; \
    KParams kq = kp; asm volatile("" : "+s"(kq)); Params p; { const ParamsHead hh_ = *(const __attribute__((address_space(4))) ParamsHead*)kq; __builtin_memcpy(&p, &hh_, sizeof(ParamsHead)); }     const int gw = vcu * NWAVES + wave, NGW = G * NWAVES; (void)lane; (void)gw; (void)NGW
#define MIXPTRS() MixPtrs X; X.PA = (const u16*)(p.ws + WS_PA); X.PSZC = (const u16*)(p.ws + WS_PSZC); X.PPV = (const u16*)(p.ws + WS_PPV); X.PSZP = (const u16*)(p.ws + WS_PSZP); \
    X.PQ = (const u16*)(p.ws + WS_PQ); X.PSZA = (const u16*)(p.ws + WS_PSZA); X.PK = (const u16*)(p.ws + WS_PK); X.PV = (const u16*)(p.ws + WS_PV); X.MIX = (u16*)(p.ws + WS_MIX)
__global__ void __launch_bounds__(NTHR, 2) hymba_fwd(Params p_unused) {
#if defined(__HIP_DEVICE_COMPILE__)
    extern __shared__ __attribute__((aligned(16))) unsigned char lds_raw[];
    LAS unsigned char* lds = (LAS unsigned char*)lds_raw;
    volatile LAS unsigned* MISC = (volatile LAS unsigned*)(lds + MISC_OFF);
    const KParams kp = (KParams)__builtin_amdgcn_kernarg_segment_ptr();
    const int G = gridDim.x, bx = blockIdx.x, vcu = (G % 8 == 0) ? (bx % 8) * (G / 8) + bx / 8 : bx;
    const int wave_s = __builtin_amdgcn_readfirstlane((int)threadIdx.x >> 6);
    for (int u = threadIdx.x; u < (LDS_BYTES - RING_BYTES) / 4; u += NTHR) ((LAS unsigned*)(lds + RING_BYTES))[u] = 0u;
    __syncthreads();
    unsigned* ctl = (unsigned*)(kp->ws + WS_CTL);
    XcdBarrier bar; bar.bar = ctl + CW_BAR; bar.x = 0; bar.st = nullptr;
    if (MK_N_LAUNCHES == 1) bar = xcd_barrier_post(ctl + CW_BAR, MISC + 8);
    const int lo = kp->ph_lo, hi = kp->ph_hi;
    const bool early = MK_N_LAUNCHES == 1 && G == 256 && lo == 0 && hi == N_PHASES;
#ifndef ONLY
#define ONLY -1
#endif
#ifndef ONLYMASK
#define ONLYMASK 0x3f
#endif
#define EN(t) ((ONLY < 0 || ONLY == (t)) && ((ONLYMASK >> (t)) & 1))
#define IN(k) (lo <= (k) && (k) < hi)
#define SEAM(k) do { if (MK_N_LAUNCHES == 1 && IN((k) + 1)) xcd_barrier(bar, wave_s); } while (0)
    if (EN(0) && IN(0)) { { PHASE_BEGIN(); p0_prologue(p, (const __attribute__((address_space(4))) float*)((const __attribute__((address_space(4))) char*)kq + __builtin_offsetof(Params, inv_freq)), lds, vcu, G, tid, lane, wave); } if (MK_N_LAUNCHES == 1 && IN(1)) xcd_barrier_census(bar, wave_s); SEAM(0); }
    if (EN(1) && IN(1)) { { PHASE_BEGIN(); for (int u = vcu; u < 40; u += G) modv_unit(p, lds, u, tid, lane, wave);
            variants_layer0(p, lds, gw, NGW, lane, wave);
            pre_phase(p, gw, NGW, lane); } SEAM(1); }
#pragma unroll 1
    for (int l = 0; l < DEPTH; ++l) {
        const int ph = 2 + 3 * l;
        if (EN(2) && IN(ph)) {
            { PHASE_BEGIN();
            pg8::Gemm g{(const u16*)(p.ws + WS_H), (const u16*)(p.ws + WS_WIN) + (size_t)l * DIN * D, M, DIN, D};
            pg8::InOrder S; S.init(M, DIN, G, bx, G - MS / 256 * (DIN / 256), early ? MS / 256 * (DIN / 256) : 0);
            LAS float* rcl = (LAS float*)(lds + RING_BYTES + 1024);
            { int pms[3]; for (int i = 0; i < 3; ++i) { pg8::Unit u; pms[i] = S.next(i, u) ? u.pm : -1; } finalize_rc_in(p, l, pms, rcl, tid); }
            asm volatile("s_waitcnt lgkmcnt(0)" ::: "memory"); __syncthreads();
            EpiIn E{l, p.ws, p.out, rcl, early};
            pg8::gemm_phase<EpiIn, true>(lds, g, S, E, tid); }
            { const int fi = M / 256 * (DIN / 256) - 2 * G; const bool split = fi > 0 && fi < G;
              if (l + 1 < DEPTH && (!split || bx >= fi)) { PHASE_BEGIN(); const int ii = split ? bx - fi : vcu, ni = split ? G - fi : G;
                  if (!early) transpose_layer(p, l + 1, lds, ii * NWAVES + wave, ni * NWAVES, lane, wave);
                  for (int u = ni - 1 - ii; u < 40; u += ni) modv_unit(p, lds, 40 * (l + 1) + u, tid, lane, wave); }
              if (early && bx >= fi) { PHASE_BEGIN(); MIXPTRS();
                  __syncthreads();
                  if (wave == 0) { unsigned* cnt = (unsigned*)(p.ws + WS_CTL) + CW_EARLY + 64 * l;
                      for (unsigned sp = 0; sp < (1u << 20); ++sp) { if (__hip_atomic_load(cnt, __ATOMIC_RELAXED, __HIP_MEMORY_SCOPE_AGENT) >= (unsigned)(MS / 256 * (DIN / 256))) break; __builtin_amdgcn_s_sleep(2); }
                      __builtin_amdgcn_fence(__ATOMIC_ACQUIRE, "agent"); asm volatile("s_waitcnt vmcnt(0)" ::: "memory"); }
                  __syncthreads();
                  for (int u = bx - fi; u < 2 * DB; u += G - fi) convpool_sample_unit(p, X, l, u >> 1, u & 1, lds, tid, lane, wave); } }
            if (MK_N_LAUNCHES == 1 && IN(ph + 1)) { PHASE_BEGIN();
                xcd_barrier_fill(bar, wave_s, [&] {
                  if (vcu & 1) { const int sb = vcu >> 1, shk = vcu & 1; unsigned x = 0u;
                    const float* ck = p.cache_k + ((size_t)(l * DB + sb) * 128 * 2 + shk) * 64; const float* cv = p.cache_v + ((size_t)(l * DB + sb) * 128 * 2 + shk) * 64;
#pragma unroll 5
                    for (int c = tid - 64; c < 4096; c += NTHR - 64) { const int j = (c >> 4) & 127, d4 = (c & 15) * 4; const u32x4 v = *(const u32x4*)(((c >> 11) ? cv : ck) + (size_t)j * 128 + d4); x ^= v.x ^ v.y ^ v.z ^ v.w; }
                    if (x == 0x9E3779B9u) MISC[40] = x; }
                  for (int e = tid - 64; e < 4 * 64 * 8; e += NTHR - 64) { const int g = e >> 9, c = (e >> 3) & 63, n8 = (e & 7) * 8;
                  const f32x4 w0 = *(const f32x4*)(p.pool_w + (size_t)l * 16384 + (g * 64 + c) * 64 + n8), w1 = *(const f32x4*)(p.pool_w + (size_t)l * 16384 + (g * 64 + c) * 64 + n8 + 4);
#pragma unroll
                  for (int k = 0; k < 4; ++k) { *(LAS _Float16*)(lds + MX_WPT + ((g * 64 + n8 + k) * 72 + c) * 2) = (_Float16)w0[k]; *(LAS _Float16*)(lds + MX_WPT + ((g * 64 + n8 + 4 + k) * 72 + c) * 2) = (_Float16)w1[k]; } } }); }
        }
        if (EN(3) && IN(ph + 1)) {
#pragma unroll 1
            for (int step = 0; step < 2; ++step) {
            if ((step ^ vcu) & 1) {
            { PHASE_BEGIN(); MIXPTRS(); for (int u = vcu; u < 256; u += G) attn_sample_unit(p, X, l, u, lds, tid, lane, wave); }
            } else {
            { PHASE_BEGIN(); MIXPTRS(); for (int u = vcu; u < 256; u += G) attn_prompt_unit(p, X, l, u, lds, tid, lane, wave); }
            { PHASE_BEGIN(); MIXPTRS(); for (int u = vcu; u < 256; u += G) conv_prompt_unit(p, X, l, u, lds, tid, lane, wave); }
            if (MK_N_LAUNCHES != 1) { PHASE_BEGIN(); for (int e = tid; e < 4 * 64 * 8; e += NTHR) { const int g = e >> 9, c = (e >> 3) & 63, n8 = (e & 7) * 8;
                  const f32x4 w0 = *(const f32x4*)(p.pool_w + (size_t)l * 16384 + (g * 64 + c) * 64 + n8), w1 = *(const f32x4*)(p.pool_w + (size_t)l * 16384 + (g * 64 + c) * 64 + n8 + 4);
#pragma unroll
                  for (int k = 0; k < 4; ++k) { *(LAS _Float16*)(lds + MX_WPT + ((g * 64 + n8 + k) * 72 + c) * 2) = (_Float16)w0[k]; *(LAS _Float16*)(lds + MX_WPT + ((g * 64 + n8 + 4 + k) * 72 + c) * 2) = (_Float16)w1[k]; } }
              asm volatile("s_waitcnt lgkmcnt(0)" ::: "memory"); __syncthreads(); }
            { PHASE_BEGIN(); for (int u = vcu; u < 256; u += G) { task_pool(p, l, u * 64, wave >> 2, (wave >> 2) ? 3 - (wave & 3) : (wave & 3), lds, wave, lane); __syncthreads(); } }
            } }
            if (!early) { PHASE_BEGIN(); MIXPTRS(); for (int u = vcu; u < 2 * DB; u += G) convpool_sample_unit(p, X, l, u >> 1, u & 1, lds, tid, lane, wave); }
            if (MK_N_LAUNCHES == 1 && IN(ph + 2)) { PHASE_BEGIN();
                pg8::StaticOrder S; S.init(MP, D, G, bx); pg8::Unit u; S.next(0, u); EpiOutF E{p.ws, l, p.ln_g, p.ln_b, p.out};
                xcd_barrier_fill(bar, wave_s, [&] { for (int it = tid - 64; it < 512; it += NTHR - 64) E.setup_item(u, lds + EpiOutF::SETUP_HI, it);
                    if (early && l + 1 < DEPTH) transpose_layer(p, l + 1, lds, vcu * (NWAVES - 1) + wave - 1, G * (NWAVES - 1), lane, wave); }); } }
        if (EN(4) && IN(ph + 2)) {
            { PHASE_BEGIN();
            pg8::Gemm g{(const u16*)(p.ws + WS_MIX), (const u16*)(p.ws + WS_WOUT) + (size_t)l * D * D, M, D, D};
            for (int u = vcu; u < 256; u += G) outproj_sample_unit(p, l, u, lds, tid, lane, wave);
            __syncthreads();
            pg8::StaticOrder S; S.init(MP, D, G, bx);
            EpiOutF E{p.ws, l, p.ln_g, p.ln_b, p.out};
            pg8::gemm_phase<EpiOutF, false>(lds, g, S, E, tid);
            for (int u = vcu; u < 256; u += G) outproj_sample_finish(p, l, u, lane, wave); }
            if (l + 1 < DEPTH) SEAM(ph + 2);
        }
    }
#undef IN
#undef SEAM
#endif
}


#ifdef DBG
constexpr int DBG_NS = 56;
constexpr size_t WS_DBGACC = 32 * 1024;
constexpr size_t WS_DBGZ = WS_END;
__constant__ int dbg_rows_tab[DBG_NS] = {0, 1, 2, 3, 14, 15, 16, 29, 30, 31, 32, 63, 64, 65, 127, 128, 129, 255, 256, 1000, 2047, 2048, 3967, 3968, 4065, 4066, 4080, 4081, 4094, 4095, 4096, 4097, 4127, 4224,
                            8191, 8192, 8320, 12288, 12415, 16382, 16383, 16384, 16385, 16386, 16387, 16388, 16391, 16639, 16640, 16892, 16893, 16894, 16895, 5000, 9999, 15000};
__device__ int dbg_row(int i) { return dbg_rows_tab[i]; }
__device__ void dbg_acc(float* accf, int id, float e, float r) {
    __shared__ float se[256], sr[256];
    const int t = threadIdx.x; se[t] = e; sr[t] = r; __syncthreads();
    for (int o = 128; o > 0; o >>= 1) { if (t < o) { se[t] += se[t + o]; sr[t] += sr[t + o]; } __syncthreads(); }
    if (t == 0) { atomicAdd(accf + 2 * id, se[0]); atomicAdd(accf + 2 * id + 1, sr[0]); }
    __syncthreads();
}
__device__ float dbg_h(const u16* p, size_t i) { return (float)(*(const _Float16*)(p + i)); }
__device__ float dbg_block_sum(float v) { __shared__ float sb[256]; const int t = threadIdx.x; sb[t] = v; __syncthreads(); for (int o = 128; o > 0; o >>= 1) { if (t < o) sb[t] += sb[t + o]; __syncthreads(); } const float r = sb[0]; __syncthreads(); return r; }
__device__ void dbg_ln4(float (&x)[4], float& rstd) { const float mean = dbg_block_sum(x[0] + x[1] + x[2] + x[3]) / D; float q = 0; for (int i = 0; i < 4; ++i) { x[i] -= mean; q += x[i] * x[i]; } rstd = 1.f / sqrtf(dbg_block_sum(q) / D + LN_EPS); }
#define DBG_E(fast, ref) do { const float f_ = (fast), r_ = (ref); e += (f_ - r_) * (f_ - r_); rr += r_ * r_; } while (0)
__global__ void __launch_bounds__(256) dbg_p0(Params p) {
    float* accf = (float*)(p.ws + WS_DBGACC); const int t = threadIdx.x, bid = blockIdx.x;
    { float e = 0, rr = 0; const int ri = (bid >> 2) % 9;
        const int l = bid & 3, row = ri < 6 ? ri : (ri == 6 ? 67 : 123 + ri);
        const float* c = row < NB ? p.c_prompt + (size_t)row * D : p.c_sample + (size_t)(row - NB) * D;
        for (int n = t * 12 + (bid % 12); n < 3072; n += 256 * 12) { float a = p.b_mod[l * 3072 + n];
            for (int k = 0; k < D; ++k) { const float x = c[k]; a += x / (1.f + expf(-x)) * p.w_mod[((size_t)l * D + k) * 3072 + n]; }
            DBG_E(((const float*)(p.ws + WS_MOD))[((size_t)l * NMOD + row) * 3072 + n], a); }
        dbg_acc(accf, 0, e, rr); }
    { float e = 0, rr = 0;
        for (int i = 0; i < 64; ++i) { const int l = bid & 3, col = (bid * 37 + i * 41 + t * 10) % DIN, k = (t * 4 + i * 16 + bid) % D;
            DBG_E(dbg_h((const u16*)(p.ws + WS_WIN), ((size_t)l * DIN + perm_in(col)) * D + k), p.w_in[((size_t)l * D + k) * DIN + col]); }
        dbg_acc(accf, 1, e, rr); }
    { float e = 0, rr = 0;
        for (int i = 0; i < 64; ++i) { const int l = bid & 3, col = (bid * 37 + i * 41 + t * 4) % D, k = (t * 4 + i * 16 + bid) % D;
            DBG_E(dbg_h((const u16*)(p.ws + WS_WOUT), ((size_t)l * D + perm_out(col)) * D + k), p.w_out[((size_t)l * D + k) * D + col]); }
        dbg_acc(accf, 2, e, rr); }
    { float e = 0, rr = 0;
        for (int i = 0; i < 16; ++i) { const int pi = (bid * 113 + i * 257 + t * 16) % (SEQ + DS), f = (t + i) & 31; const int pos = pi < SEQ ? pi : PAST + pi - SEQ;
            const float ang = (float)pos * p.inv_freq[f]; const f32x2 cs = ((const f32x2*)(p.ws + WS_TAB))[pi * 32 + f];
            DBG_E(cs[0], cosf(ang)); DBG_E(cs[1], sinf(ang)); }
        dbg_acc(accf, 3, e, rr); }
}
__global__ void __launch_bounds__(256) dbg_p0b(Params p) {
    float* accf = (float*)(p.ws + WS_DBGACC); const int t = threadIdx.x, bid = blockIdx.x;
    { float e = 0, rr = 0;
        const int l = bid & 3, b = (bid >> 2) & 3; const float* md = (const float*)(p.ws + WS_MOD) + ((size_t)l * NMOD + b) * 3072;
        const int col = (t * 10 + (bid >> 4) * 3 + 1) % DIN; float v1 = 0, v2 = 0, v3 = 0, v4 = 0;
        for (int c = 0; c < D; ++c) { const float w = p.w_in[((size_t)l * D + c) * DIN + col], g = l > 0 ? p.ln_g[(l - 1) * D + c] : 1.f, bb = l > 0 ? p.ln_b[(l - 1) * D + c] : 0.f, s1 = 1.f + md[1024 + c];
            v1 += g * s1 * w; v2 += bb * s1 * w; v3 += s1 * w; v4 += md[c] * w; }
        const float* mv = (const float*)(p.ws + WS_MODV) + (size_t)(l * NB + b) * 4 * DIN + perm_in(col);
        DBG_E(mv[0], v1); DBG_E(mv[2 * DIN], v3); DBG_E(mv[3 * DIN], v4); if (l > 0) DBG_E(mv[DIN], v2); else e += mv[DIN] * mv[DIN];
        dbg_acc(accf, 69, e, rr); }
    if (bid < DBG_NS) { const int row = dbg_row(bid); const bool smp = row >= MP; const int bidx = smp ? NB + ((row - MP) >> 2) : (row >> 12);
        const float* md = (const float*)(p.ws + WS_MOD) + (size_t)bidx * 3072;
        float x[4]; for (int i = 0; i < 4; ++i) { const int c = t + 256 * i; x[i] = smp ? p.x_sample[(size_t)(row - MP) * D + c] : p.x_prompt[(size_t)row * D + c]; }
        float e = 0, rr = 0; for (int i = 0; i < 4; ++i) DBG_E(dbg_h((const u16*)(p.ws + (smp ? WS_XR : WS_ZH)), (size_t)row * D + t + 256 * i), x[i]); dbg_acc(accf, 70, e, rr);
        e = 0; rr = 0;
        if (!smp) { for (int i = 0; i < 4; ++i) { const int c = t + 256 * i; DBG_E(dbg_h((const u16*)(p.ws + WS_H), (size_t)row * D + c), x[i] * (1.f + md[1024 + c])); } }
        else { float rstd; dbg_ln4(x, rstd); for (int i = 0; i < 4; ++i) { const int c = t + 256 * i; DBG_E(dbg_h((const u16*)(p.ws + WS_H), (size_t)row * D + c), x[i] * rstd * (1.f + md[1024 + c]) + md[c]); } }
        dbg_acc(accf, 71, e, rr); }
}
__global__ void __launch_bounds__(256) dbg_copyz(Params p) { const int row = dbg_row(blockIdx.x);
    for (int c = threadIdx.x; c < D; c += 256) { ((u16*)(p.ws + WS_DBGZ))[blockIdx.x * D + c] = ((const u16*)(p.ws + WS_ZH))[(size_t)row * D + c]; ((u16*)(p.ws + WS_DBGZ))[(DBG_NS + blockIdx.x) * D + c] = ((const u16*)(p.ws + WS_XR))[(size_t)row * D + c]; } }
__global__ void __launch_bounds__(256) dbg_in(Params p, int l) {
    __shared__ float pr[DIN]; __shared__ float hh[D];
    float* accf = (float*)(p.ws + WS_DBGACC); const int t = threadIdx.x, row = dbg_row(blockIdx.x), base = 4 + 16 * l;
    const bool smp = row >= MP; const int b = smp ? (row - MP) >> 2 : row >> 12, tt = smp ? (row - MP) & 3 : row & (SEQ - 1), pos = smp ? PAST + tt : tt;
    const int bidx = smp ? NB + b : b; const float* md = (const float*)(p.ws + WS_MOD) + ((size_t)l * NMOD + bidx) * 3072;
    float e, rr;
    { float x[4]; float rstd;
        for (int i = 0; i < 4; ++i) x[i] = dbg_h((const u16*)(p.ws + (smp ? WS_XR : WS_ZH)), (size_t)row * D + t + 256 * i);
        if (!smp && l > 0) { dbg_ln4(x, rstd); for (int i = 0; i < 4; ++i) { const int c = t + 256 * i; x[i] = x[i] * rstd * p.ln_g[(l - 1) * D + c] + p.ln_b[(l - 1) * D + c]; } }
        dbg_ln4(x, rstd);
        for (int i = 0; i < 4; ++i) { const int c = t + 256 * i; hh[c] = x[i] * rstd * (1.f + md[1024 + c]) + md[c]; }
        __syncthreads();
        if (smp) { e = 0; rr = 0; for (int i = 0; i < 4; ++i) { const int c = t + 256 * i; DBG_E(dbg_h((const u16*)(p.ws + WS_H), (size_t)row * D + c), hh[c]); } dbg_acc(accf, base + 1, e, rr); } }
    for (int i = 0; i < 10; ++i) { const int col = t + 256 * i; float a = 0; for (int k = 0; k < D; ++k) a += hh[k] * p.w_in[((size_t)l * D + k) * DIN + col]; pr[col] = a; }
    __syncthreads();
    const float av = pr[t] / (1.f + expf(-pr[256 + t]));
    e = 0; rr = 0; DBG_E(dbg_h((const u16*)(p.ws + WS_PA), (size_t)row * 256 + t), av); dbg_acc(accf, base + 2, e, rr);
    e = 0; rr = 0; { const float z = pr[512 + t]; DBG_E(dbg_h((const u16*)(p.ws + WS_PSZC), (size_t)row * 256 + t), z / (1.f + expf(-z))); } dbg_acc(accf, base + 3, e, rr);
    e = 0; rr = 0; DBG_E(dbg_h((const u16*)(p.ws + WS_PPV), (size_t)row * 256 + t), pr[768 + t]); dbg_acc(accf, base + 4, e, rr);
    e = 0; rr = 0; { const float z = pr[1024 + t]; DBG_E(dbg_h((const u16*)(p.ws + WS_PSZP), (size_t)row * 256 + t), z / (1.f + expf(-z))); } dbg_acc(accf, base + 5, e, rr);
    e = 0; rr = 0;
    for (int i = 0; i < 2; ++i) { const int c = t + 256 * i, hd = c >> 6, d = c & 63, f = d & 31; const float ang = (float)pos * p.inv_freq[f], cs = cosf(ang), sn = sinf(ang);
        const float x = pr[1280 + c], xo = d < 32 ? -pr[1280 + hd * 64 + d + 32] : pr[1280 + hd * 64 + d - 32];
        DBG_E(dbg_h((const u16*)(p.ws + WS_PQ), (size_t)row * 512 + c), (x * cs + xo * sn) * QSCALE); }
    dbg_acc(accf, base + 6, e, rr);
    e = 0; rr = 0; float kref = 0.f, vref = 0.f;
    if (t < 128) { const int hd = t >> 6, d = t & 63, f = d & 31; const float ang = (float)pos * p.inv_freq[f], cs = cosf(ang), sn = sinf(ang);
        const float x = pr[1792 + t], xo = d < 32 ? -pr[1792 + hd * 64 + d + 32] : pr[1792 + hd * 64 + d - 32]; kref = x * cs + xo * sn;
        DBG_E(dbg_h((const u16*)(p.ws + WS_PK), (size_t)row * 128 + t), kref); }
    dbg_acc(accf, base + 7, e, rr);
    e = 0; rr = 0; if (t < 128) { vref = pr[1920 + t]; DBG_E(dbg_h((const u16*)(p.ws + WS_PV), (size_t)row * 128 + t), vref); } dbg_acc(accf, base + 8, e, rr);
    e = 0; rr = 0; for (int i = 0; i < 2; ++i) { const float z = pr[2048 + t + 256 * i]; DBG_E(dbg_h((const u16*)(p.ws + WS_PSZA), (size_t)row * 512 + t + 256 * i), z / (1.f + expf(-z))); } dbg_acc(accf, base + 9, e, rr);
    e = 0; rr = 0;
    if (smp) { DBG_E(p.out[OFF_CONVS + ((size_t)(l * DB + b) * 30 + 26 + tt) * 256 + t], av); DBG_E(p.out[OFF_POOLS + ((size_t)(l * DB + b) * 15 + 11 + tt) * 256 + t], pr[768 + t]);
        if (t < 128) { DBG_E(p.out[OFF_KS + ((size_t)(l * DB + b) * 128 + 124 + tt) * 128 + t], kref); DBG_E(p.out[OFF_VS + ((size_t)(l * DB + b) * 128 + 124 + tt) * 128 + t], vref); } }
    else { if (tt >= SEQ - 30) DBG_E(p.out[OFF_CONVP + ((size_t)(l * NB + b) * 30 + tt - (SEQ - 30)) * 256 + t], av);
        if (tt >= SEQ - 15) DBG_E(p.out[OFF_POOLP + ((size_t)(l * NB + b) * 15 + tt - (SEQ - 15)) * 256 + t], pr[768 + t]);
        if (tt >= SEQ - 128 && t < 128) { DBG_E(p.out[OFF_KP + ((size_t)(l * NB + b) * 128 + tt - (SEQ - 128)) * 128 + t], kref); DBG_E(p.out[OFF_VP + ((size_t)(l * NB + b) * 128 + tt - (SEQ - 128)) * 128 + t], vref); } }
    dbg_acc(accf, base + 10, e, rr);
}
__global__ void __launch_bounds__(256) dbg_mix(Params p, int l) {
    __shared__ float sh[1024]; __shared__ float sc[136];
    float* accf = (float*)(p.ws + WS_DBGACC); const int t = threadIdx.x, row = dbg_row(blockIdx.x), base = 4 + 16 * l;
    const bool smp = row >= MP; const int b = smp ? (row - MP) >> 2 : row >> 12, tt = smp ? (row - MP) & 3 : row & (SEQ - 1);
    const u16 *PA = (const u16*)(p.ws + WS_PA), *PSZC = (const u16*)(p.ws + WS_PSZC), *PPV = (const u16*)(p.ws + WS_PPV), *PSZP = (const u16*)(p.ws + WS_PSZP), *PQ = (const u16*)(p.ws + WS_PQ),
              *PSZA = (const u16*)(p.ws + WS_PSZA), *PK = (const u16*)(p.ws + WS_PK), *PV = (const u16*)(p.ws + WS_PV), *MIX = (const u16*)(p.ws + WS_MIX);
    float e, rr;
    {
        float a = p.conv_b[l * 256 + t];
        for (int j = 0; j < 31; ++j) { float x;
            if (!smp) { const int ts = tt - 30 + j; x = ts >= 0 ? dbg_h(PA, ((size_t)b * SEQ + ts) * 256 + t) : 0.f; }
            else { const int ri = tt + j; x = ri < 30 ? p.cache_conv[((size_t)(l * DB + b) * 30 + ri) * 256 + t] : dbg_h(PA, ((size_t)MP + 4 * b + ri - 30) * 256 + t); }
            a += p.conv_w[((size_t)l * 31 + j) * 256 + t] * x; }
        const float mean = dbg_block_sum(a) / 256.f; const float d = a - mean; const float rstd = 1.f / sqrtf(dbg_block_sum(d * d) / 256.f + LN_EPS);
        const float y = d * rstd * p.cnorm_g[l * 256 + t] + p.cnorm_b[l * 256 + t];
        e = 0; rr = 0; DBG_E(dbg_h(MIX, (size_t)row * D + t), y / (1.f + expf(-y)) * dbg_h(PSZC, (size_t)row * 256 + t)); dbg_acc(accf, base + 11, e, rr); }
    {
        const int w = 2 << (t >> 6); float s = 0;
        for (int i = 0; i < w; ++i) { float x;
            if (!smp) { const int ts = tt - i; x = ts >= 0 ? dbg_h(PPV, ((size_t)b * SEQ + ts) * 256 + t) : 0.f; }
            else { const int ri = 15 + tt - i; x = ri < 15 ? p.cache_pool[((size_t)(l * DB + b) * 15 + ri) * 256 + t] : dbg_h(PPV, ((size_t)MP + 4 * b + ri - 15) * 256 + t); }
            s += x; }
        const float cnt = smp ? (float)w : (float)(w < tt + 1 ? w : tt + 1);
        sh[t] = s / cnt - dbg_h(PPV, (size_t)row * 256 + t); __syncthreads();
        const int g = t >> 6, n = t & 63; float y = 0; for (int c = 0; c < 64; ++c) y += sh[64 * g + c] * p.pool_w[(((size_t)l * 4 + g) * 64 + c) * 64 + n];
        e = 0; rr = 0; DBG_E(dbg_h(MIX, (size_t)row * D + 256 + t), y * p.pool_scale[l * 256 + t] * dbg_h(PSZP, (size_t)row * 256 + t)); dbg_acc(accf, base + 12, e, rr); __syncthreads(); }
    {
        e = 0; rr = 0;
        for (int hd = 0; hd < 8; ++hd) { const int hk = hd >> 2; __syncthreads();
            if (t < 64) sh[t] = dbg_h(PQ, (size_t)row * 512 + hd * 64 + t); __syncthreads();
            const float sink2 = p.sinks[l * 8 + hd] * LOG2E;
            if (t < 128) { float s = -INFINITY;
                if (!smp) { const int ts = tt - 127 + t; if (ts >= 0) { s = 0; for (int d = 0; d < 64; ++d) s += sh[d] * dbg_h(PK, ((size_t)b * SEQ + ts) * 128 + hk * 64 + d); } }
                else { const int ci = tt + 1 + t;
                    s = 0; for (int d = 0; d < 64; ++d) s += sh[d] * (ci < 128 ? p.cache_k[(((size_t)(l * DB + b) * 128 + ci) * 2 + hk) * 64 + d] : dbg_h(PK, ((size_t)MP + 4 * b + ci - 128) * 128 + hk * 64 + d)); }
                sc[t] = s; }
            __syncthreads();
            float mx = sink2; for (int k = 0; k < 128; ++k) mx = fmaxf(mx, sc[k]);
            float den = exp2f(sink2 - mx); for (int k = 0; k < 128; ++k) den += exp2f(sc[k] - mx);
            if (t < 64) { float o = 0;
                for (int k = 0; k < 128; ++k) { const float pk = exp2f(sc[k] - mx) / den; if (pk == 0.f) continue; float v;
                    if (!smp) { const int ts = tt - 127 + k; v = dbg_h(PV, ((size_t)b * SEQ + ts) * 128 + hk * 64 + t); }
                    else { const int ci = tt + 1 + k; v = ci < 128 ? p.cache_v[(((size_t)(l * DB + b) * 128 + ci) * 2 + hk) * 64 + t] : dbg_h(PV, ((size_t)MP + 4 * b + ci - 128) * 128 + hk * 64 + t); }
                    o += pk * v; }
                DBG_E(dbg_h(MIX, (size_t)row * D + 512 + hd * 64 + t), o * dbg_h(PSZA, (size_t)row * 512 + hd * 64 + t)); } }
        dbg_acc(accf, base + 13, e, rr); }
    if (smp) { e = 0; rr = 0;
        for (int i = 0; i < 26; ++i) DBG_E(p.out[OFF_CONVS + ((size_t)(l * DB + b) * 30 + i) * 256 + t], p.cache_conv[((size_t)(l * DB + b) * 30 + i + 4) * 256 + t]);
        for (int i = 0; i < 11; ++i) DBG_E(p.out[OFF_POOLS + ((size_t)(l * DB + b) * 15 + i) * 256 + t], p.cache_pool[((size_t)(l * DB + b) * 15 + i + 4) * 256 + t]);
        for (int i = 0; i < 124; ++i) if (t < 128) { DBG_E(p.out[OFF_KS + ((size_t)(l * DB + b) * 128 + i) * 128 + t], p.cache_k[((size_t)(l * DB + b) * 128 + i + 4) * 128 + t]);
            DBG_E(p.out[OFF_VS + ((size_t)(l * DB + b) * 128 + i) * 128 + t], p.cache_v[((size_t)(l * DB + b) * 128 + i + 4) * 128 + t]); }
        dbg_acc(accf, base + 15, e, rr); }
}
__global__ void __launch_bounds__(256) dbg_out(Params p, int l) {
    __shared__ float mm[D];
    float* accf = (float*)(p.ws + WS_DBGACC); const int t = threadIdx.x, row = dbg_row(blockIdx.x), base = 4 + 16 * l;
    const bool smp = row >= MP; const int bidx = smp ? NB + ((row - MP) >> 2) : (row >> 12);
    for (int c = t; c < D; c += 256) mm[c] = dbg_h((const u16*)(p.ws + WS_MIX), (size_t)row * D + c);
    __syncthreads();
    const float* md = (const float*)(p.ws + WS_MOD) + ((size_t)l * NMOD + bidx) * 3072 + 2048;
    const float* mdn = (const float*)(p.ws + WS_MOD) + ((size_t)(l + 1) * NMOD + bidx) * 3072;
    float x1[4], z[4], rstd;
    for (int i = 0; i < 4; ++i) x1[i] = dbg_h((const u16*)(p.ws + WS_DBGZ), (size_t)((smp ? DBG_NS : 0) + blockIdx.x) * D + t + 256 * i);
    if (!smp && l > 0) { dbg_ln4(x1, rstd); for (int i = 0; i < 4; ++i) { const int c = t + 256 * i; x1[i] = x1[i] * rstd * p.ln_g[(l - 1) * D + c] + p.ln_b[(l - 1) * D + c]; } }
    float e = 0, rr = 0;
    for (int i = 0; i < 4; ++i) { const int c = t + 256 * i; float a = 0; for (int k = 0; k < D; ++k) a += mm[k] * p.w_out[((size_t)l * D + k) * D + c];
        z[i] = ALPHA * x1[i] + (1.f + md[c]) * a; DBG_E(dbg_h((const u16*)(p.ws + WS_ZH), (size_t)row * D + c), z[i]); }
    dbg_acc(accf, base + 14, e, rr);
    e = 0; rr = 0;
    if (!smp) { if (l < DEPTH - 1) for (int i = 0; i < 4; ++i) { const int c = t + 256 * i; DBG_E(dbg_h((const u16*)(p.ws + WS_H), (size_t)row * D + c), z[i] * p.ln_g[l * D + c] * (1.f + mdn[1024 + c])); } }
    else { dbg_ln4(z, rstd); for (int i = 0; i < 4; ++i) { const int c = t + 256 * i; z[i] = z[i] * rstd * p.ln_g[l * D + c] + p.ln_b[l * D + c]; }
        if (l == DEPTH - 1) { for (int i = 0; i < 4; ++i) DBG_E(p.out[OFF_YS + (size_t)(row - MP) * D + t + 256 * i], z[i]); }
        else { for (int i = 0; i < 4; ++i) DBG_E(dbg_h((const u16*)(p.ws + WS_XR), (size_t)row * D + t + 256 * i), z[i]);
            dbg_ln4(z, rstd); for (int i = 0; i < 4; ++i) { const int c = t + 256 * i; DBG_E(dbg_h((const u16*)(p.ws + WS_H), (size_t)row * D + c), z[i] * rstd * (1.f + mdn[1024 + c]) + mdn[c]); } } }
    dbg_acc(accf, base + 0, e, rr);
    if (l == 0) { dbg_acc(accf, 100, smp ? 0.f : e, smp ? 0.f : rr); dbg_acc(accf, 101, smp ? e : 0.f, smp ? rr : 0.f); }
}
__global__ void __launch_bounds__(256) dbg_fin(Params p) {
    float* accf = (float*)(p.ws + WS_DBGACC); const int t = threadIdx.x, row = dbg_row(blockIdx.x);
    if (row >= MP) return;
    float x[4]; for (int i = 0; i < 4; ++i) x[i] = dbg_h((const u16*)(p.ws + WS_ZH), (size_t)row * D + t + 256 * i);
    float rstd; dbg_ln4(x, rstd); float e = 0, rr = 0;
    for (int i = 0; i < 4; ++i) { const int c = t + 256 * i; DBG_E(p.out[(size_t)row * D + c], x[i] * rstd * p.ln_g[3 * D + c] + p.ln_b[3 * D + c]); }
    dbg_acc(accf, 68, e, rr);
}
#ifndef DBG_REPORT_ID
#define DBG_REPORT_ID -1
#endif
__global__ void __launch_bounds__(256) dbg_report(Params p) {
    const float* accf = (const float*)(p.ws + WS_DBGACC);
    float code = 1000.f;
    if (DBG_REPORT_ID >= 0) { const float e = accf[2 * DBG_REPORT_ID], r = accf[2 * DBG_REPORT_ID + 1]; code = (r > 0.f ? e / r : 9.9f) * 1e12f; if (!(code > 100.f)) code = 100.f; }
    else for (int i = 0; i < 128; ++i) { const float e = accf[2 * i], r = accf[2 * i + 1]; const bool expected = i <= 71 && !(i >= 4 && i < 68 && ((i - 4) & 15) == 0 && (i - 4) / 16 == 99);
        if ((r > 0.f && !(e / r < 1e-3f)) || (r == 0.f && (e > 0.f || expected)) || e != e || r != r) { code = (float)(i + 1) * 1e4f; break; } }
    const float S = sqrtf(code);
    for (size_t i = (size_t)blockIdx.x * 256 + threadIdx.x; i < (size_t)MP * D; i += (size_t)gridDim.x * 256) p.out[i] = S;
}
#endif

extern "C" void kernel_launch(void* const* d_in, const int* in_sizes, int n_in, void* d_out, int out_size, void* d_ws, size_t ws_size, hipStream_t stream) {
    static int grid = 0;
    if (grid == 0) {
        if (n_in != 21 || (size_t)out_size != OUT_TOTAL || ws_size < WS_END) { fprintf(stderr, "kernel_launch: unexpected shapes (n_in %d, out %d, ws %zu)\n", n_in, out_size, ws_size); grid = -1; return; }
        int dev = 0, cus = 0;
        if (hipGetDevice(&dev) != hipSuccess || hipDeviceGetAttribute(&cus, hipDeviceAttributeMultiprocessorCount, dev) != hipSuccess) { grid = -1; return; }
        if (hipFuncSetAttribute((const void*)hymba_fwd, hipFuncAttributeMaxDynamicSharedMemorySize, LDS_BYTES) != hipSuccess) { fprintf(stderr, "kernel_launch: hipFuncSetAttribute failed\n"); grid = -1; return; }
        (void)hipGetLastError();
        grid = cus;
    }
    if (grid < 0) return;
    (void)hipMemsetAsync((char*)d_ws + WS_CTL, 0, CTL_ZERO_BYTES, stream);
    Params a{};
    a.x_prompt = (const float*)d_in[0]; a.x_sample = (const float*)d_in[1]; a.cache_conv = (const float*)d_in[2]; a.cache_pool = (const float*)d_in[3];
    a.cache_k = (const float*)d_in[4]; a.cache_v = (const float*)d_in[5]; a.c_prompt = (const float*)d_in[6]; a.c_sample = (const float*)d_in[7];
    a.w_in = (const float*)d_in[8]; a.w_out = (const float*)d_in[9]; a.conv_w = (const float*)d_in[10]; a.conv_b = (const float*)d_in[11];
    a.cnorm_g = (const float*)d_in[12]; a.cnorm_b = (const float*)d_in[13]; a.pool_w = (const float*)d_in[14]; a.pool_scale = (const float*)d_in[15];
    a.sinks = (const float*)d_in[16]; a.w_mod = (const float*)d_in[17]; a.b_mod = (const float*)d_in[18]; a.ln_g = (const float*)d_in[19]; a.ln_b = (const float*)d_in[20];
    a.out = (float*)d_out; a.ws = (unsigned char*)d_ws;
    for (int i = 0; i < 32; ++i) a.inv_freq[i] = (float)std::pow(10000.0, -(double)i * (2.0 / 64.0));
    if (MK_N_LAUNCHES == 1) { a.ph_lo = 0; a.ph_hi = N_PHASES; hipLaunchKernelGGL(hymba_fwd, dim3(grid), dim3(NTHR), LDS_BYTES, stream, a); }
    else for (int ph = 0; ph < N_PHASES; ++ph) {
#ifdef DBG
        if (ph >= 2 && ph < N_PHASES - 1 && (ph - 2) % 3 == 2) hipLaunchKernelGGL(dbg_copyz, dim3(DBG_NS), dim3(256), 0, stream, a);
#endif
        a.ph_lo = ph; a.ph_hi = ph + 1; hipLaunchKernelGGL(hymba_fwd, dim3(grid), dim3(NTHR), LDS_BYTES, stream, a);
#ifdef DBG
        if (ph == 0) hipLaunchKernelGGL(dbg_p0, dim3(144), dim3(256), 0, stream, a);
        else if (ph == 1) hipLaunchKernelGGL(dbg_p0b, dim3(144), dim3(256), 0, stream, a);
        else if (ph == N_PHASES - 1) { hipLaunchKernelGGL(dbg_fin, dim3(DBG_NS), dim3(256), 0, stream, a); hipLaunchKernelGGL(dbg_report, dim3(1024), dim3(256), 0, stream, a); }
        else { const int l = (ph - 2) / 3, k = (ph - 2) % 3;
            if (k == 0) hipLaunchKernelGGL(dbg_in, dim3(DBG_NS), dim3(256), 0, stream, a, l);
            if (k == 1) hipLaunchKernelGGL(dbg_mix, dim3(DBG_NS), dim3(256), 0, stream, a, l);
            if (k == 2) hipLaunchKernelGGL(dbg_out, dim3(DBG_NS), dim3(256), 0, stream, a, l); }
#endif
    }
}
```
